# Optimizing an MI355X kernel written in HIP

```python
import math
import jax, jax.numpy as jnp
from jax import lax
import numpy as np

D_MODEL = 1024
BATCH = 8
SEQ = 4096
DEPTH = 4

CTX_LEN = 256
GRID_W = 64
CHUNK = 64
EPS = 1e-6
N_MOD = 6

GDN_HEADS = 4
GDN_DK = 128
GDN_DV = 128
GDN_W = GDN_HEADS * GDN_DV
CONV_K = 3

RWKV_HEADS = 8
RWKV_N = 64
RWKV_W = RWKV_HEADS * RWKV_N
DECAY_LORA = 64
ICL_LORA = 64
GATE_LORA = 128
RWKV_GN_EPS = 64e-5

MLSTM_HEADS = 4
MLSTM_DQK = 64
MLSTM_DV = 128
MLSTM_QK_W = MLSTM_HEADS * MLSTM_DQK
MLSTM_V_W = MLSTM_HEADS * MLSTM_DV

N_BRANCH = 3
BRANCH_W = 512

GDN_COLS = 4 * GDN_W + 4 * GDN_HEADS
RWKV_COLS = 3 * RWKV_W + 2 * DECAY_LORA + 2 * ICL_LORA + GATE_LORA
MLSTM_COLS = 2 * MLSTM_QK_W + 2 * MLSTM_V_W + 4 * MLSTM_HEADS
GATE_COLS = N_BRANCH * D_MODEL
IN_COLS = GDN_COLS + RWKV_COLS + MLSTM_COLS + GATE_COLS

N_EXPERTS = 16
CAP_FACTOR = 2
MOE_D_FF = 512

kernel_name = "hybrid_gdn_rwkv7_mlstm_ec_moe_dit"


def split_cols(p, sizes):
    return jnp.split(p, np.cumsum(sizes)[:-1].tolist(), axis=-1)


def rmsnorm(x, g):
    xf = x.astype(jnp.float32)
    y = xf * lax.rsqrt(jnp.mean(xf * xf, axis=-1, keepdims=True) + EPS)
    return (y * g.astype(jnp.float32)).astype(x.dtype)


def l2norm(x):
    xf = x.astype(jnp.float32)
    return (xf * lax.rsqrt(jnp.sum(xf * xf, axis=-1, keepdims=True) + EPS)).astype(x.dtype)


def modulate(h, shift, scale):
    return h * (1 + scale[:, None]) + shift[:, None]


def dwconv_grid(t, w, rows):
    B, T, C = t.shape
    img = t.reshape(B, rows, T // rows, C)
    out = lax.conv_general_dilated(img, w[:, :, None, :].astype(t.dtype), (1, 1), 'SAME',
                                   dimension_numbers=('NHWC', 'HWIO', 'NHWC'),
                                   feature_group_count=C)
    return out.reshape(B, T, C)


def qshift(p, rows):
    B, T, C = p.shape
    g = p.reshape(B, rows, T // rows, C // 4, 4)
    z_col = jnp.zeros_like(g[:, :, :1, :, 0])
    z_row = jnp.zeros_like(g[:, :1, :, :, 0])
    from_left = jnp.concatenate([z_col, g[:, :, :-1, :, 0]], axis=2)
    from_right = jnp.concatenate([g[:, :, 1:, :, 1], z_col], axis=2)
    from_up = jnp.concatenate([z_row, g[:, :-1, :, :, 2]], axis=1)
    from_down = jnp.concatenate([g[:, 1:, :, :, 3], z_row], axis=1)
    return jnp.stack([from_left, from_right, from_up, from_down], axis=-1).reshape(B, T, C)


def to_chunks(t):
    B, T, H = t.shape[:3]
    t = t.reshape(B, T // CHUNK, CHUNK, H, *t.shape[3:])
    return jnp.moveaxis(t, (1, 3), (0, 2))


def from_chunks(t):
    t = jnp.moveaxis(t, (0, 2), (1, 3))
    B, n, L, H = t.shape[:4]
    return t.reshape(B, n * L, H, *t.shape[4:])


def run_two_directions(scan_fn, ctx_dirs, lat_dirs, state0):
    yc, yx = 0, 0
    for d in range(2):
        f = (lambda t: jnp.flip(t, axis=1)) if d == 1 else (lambda t: t)
        yc_d, state = scan_fn(tuple(f(t) for t in ctx_dirs[d]), state0)
        yx_d, _ = scan_fn(tuple(f(t) for t in lat_dirs[d]), state)
        yc = yc + f(yc_d)
        yx = yx + f(yx_d)
    return yc, yx


def gdn_chunked(inp, S0):
    dtype = inp[2].dtype
    q, k, v, g, beta = [to_chunks(t.astype(jnp.float32)) for t in inp]
    dv = v.shape[-1]
    G = jnp.cumsum(g, axis=-1)
    idx = jnp.arange(CHUNK)
    causal = idx[:, None] >= idx[None, :]
    strict = idx[:, None] > idx[None, :]
    decay = jnp.exp(jnp.where(causal, G[..., :, None] - G[..., None, :], -jnp.inf))
    kb = k * beta[..., None]
    Lm = jnp.where(strict, jnp.einsum('nbhik,nbhjk->nbhij', kb, k) * decay, 0.0)
    M = Lm + jnp.eye(CHUNK, dtype=jnp.float32)
    rhs = jnp.concatenate([v * beta[..., None], kb * jnp.exp(G)[..., None]], axis=-1)
    sol = lax.linalg.triangular_solve(M, rhs, left_side=True, lower=True, unit_diagonal=True)
    u, w = sol[..., :dv], sol[..., dv:]
    Aqk = jnp.einsum('nbhik,nbhjk->nbhij', q, k) * decay
    qg = q * jnp.exp(G)[..., None]
    g_last = G[..., -1]
    kg = k * jnp.exp(g_last[..., None] - G)[..., None]

    def step(S, xs):
        u_c, w_c, qg_c, A_c, kg_c, gl = xs
        v_new = u_c - jnp.einsum('bhlk,bhkv->bhlv', w_c, S)
        o = jnp.einsum('bhlk,bhkv->bhlv', qg_c, S) + jnp.einsum('bhij,bhjv->bhiv', A_c, v_new)
        S = S * jnp.exp(gl)[..., None, None] + jnp.einsum('bhlk,bhlv->bhkv', kg_c, v_new)
        return S, o

    S, o = lax.scan(step, S0, (u, w, qg, Aqk, kg, g_last))
    return from_chunks(o).astype(dtype), S


def rwkv7_scan(inp, S0):
    dtype = inp[3].dtype
    xs = tuple(jnp.moveaxis(t.astype(jnp.float32), 1, 0) for t in inp)

    def step(S, xt):
        r_t, w_t, k_t, v_t, a_t, b_t = xt
        sa = jnp.einsum('bhvk,bhk->bhv', S, a_t)
        S = S * w_t[:, :, None, :] + sa[..., None] * b_t[:, :, None, :] + v_t[..., None] * k_t[:, :, None, :]
        return S, jnp.einsum('bhvk,bhk->bhv', S, r_t)

    S, y = lax.scan(step, S0, xs)
    return jnp.moveaxis(y, 0, 1).astype(dtype), S


def mlstm_chunked(inp, state):
    dtype = inp[2].dtype
    q, k, v, ig, lf = [to_chunks(t.astype(jnp.float32)) for t in inp]
    idx = jnp.arange(CHUNK)
    causal = idx[:, None] >= idx[None, :]
    b = jnp.cumsum(lf, axis=-1)
    Dm = jnp.where(causal, b[..., :, None] - b[..., None, :] + ig[..., None, :], -jnp.inf)
    m_intra = jnp.max(Dm, axis=-1)
    qk = jnp.einsum('nbhik,nbhjk->nbhij', q, k)
    b_last = b[..., -1]
    dl = b_last[..., None] - b + ig

    def step(carry, xs):
        C, nv, m = carry
        q_c, k_c, v_c, b_c, D_c, mi_c, qk_c, dl_c, bl_c = xs
        m_t = jnp.maximum(b_c + m[..., None], mi_c)
        inter = jnp.exp(b_c + m[..., None] - m_t)
        P = qk_c * jnp.exp(D_c - m_t[..., None])
        num = inter[..., None] * jnp.einsum('bhlk,bhkv->bhlv', q_c, C) + jnp.einsum('bhij,bhjv->bhiv', P, v_c)
        den = inter * jnp.einsum('bhlk,bhk->bhl', q_c, nv) + jnp.sum(P, axis=-1)
        h = num / jnp.maximum(jnp.abs(den), jnp.exp(-m_t))[..., None]
        m_new = jnp.maximum(bl_c + m, jnp.max(dl_c, axis=-1))
        wk = k_c * jnp.exp(dl_c - m_new[..., None])[..., None]
        dec = jnp.exp(bl_c + m - m_new)
        C = dec[..., None, None] * C + jnp.einsum('bhlk,bhlv->bhkv', wk, v_c)
        nv = dec[..., None] * nv + jnp.sum(wk, axis=-2)
        return (C, nv, m_new), h

    state, h = lax.scan(step, state, (q, k, v, b, Dm, m_intra, qk, dl, b_last))
    return from_chunks(h).astype(dtype), state


def gdn_branch(pc, px, rows_x, conv_w, a_log, dt_bias, norm_g):
    def prep(p, rows):
        B, T, _ = p.shape
        qkv, z, bg, ag = split_cols(p, (3 * GDN_W, GDN_W, 2 * GDN_HEADS, 2 * GDN_HEADS))
        qkv = jax.nn.silu(dwconv_grid(qkv, conv_w, rows))
        q, k, v = [t.reshape(B, T, GDN_HEADS, GDN_DK) for t in jnp.split(qkv, 3, axis=-1)]
        q = l2norm(q) * (GDN_DK ** -0.5)
        k = l2norm(k)
        beta = jax.nn.sigmoid(bg.reshape(B, T, 2, GDN_HEADS))
        g = -jnp.exp(a_log) * jax.nn.softplus(ag.reshape(B, T, 2, GDN_HEADS) + dt_bias)
        return [(q, k, v, g[:, :, d], beta[:, :, d]) for d in range(2)], z

    dc, zc = prep(pc, 1)
    dx, zx = prep(px, rows_x)
    S0 = jnp.zeros((pc.shape[0], GDN_HEADS, GDN_DK, GDN_DV), jnp.float32)
    oc, ox = run_two_directions(gdn_chunked, dc, dx, S0)

    def finish(o, z):
        B, T = o.shape[:2]
        return (rmsnorm(o, norm_g) * jax.nn.silu(z.reshape(B, T, GDN_HEADS, GDN_DV))).reshape(B, T, GDN_W)

    return finish(oc, zc), finish(ox, zx)


def rwkv_branch(pc, px, rows_x, mu, w0, w_up, a0, a_up, g_up, k_k, k_a, r_k, ln_g, ln_b):
    def prep(p, rows):
        B, T, _ = p.shape
        p = p + (qshift(p, rows) - p) * mu
        r, k, v, wd, ad, gd = split_cols(p, (RWKV_W, RWKV_W, RWKV_W, 2 * DECAY_LORA, 2 * ICL_LORA, GATE_LORA))
        hd = lambda t: t.reshape(B, T, RWKV_HEADS, RWKV_N)
        kk = l2norm(hd(k * k_k))
        g = jax.nn.sigmoid(gd) @ g_up
        wd = wd.reshape(B, T, 2, DECAY_LORA)
        ad = ad.reshape(B, T, 2, ICL_LORA)
        dirs, bonus = [], 0
        for d in range(2):
            w_raw = w0[d] + jnp.tanh(wd[:, :, d]) @ w_up[d]
            decay = jnp.exp(-jnp.exp(-jax.nn.softplus(-w_raw) - 0.5))
            a = jax.nn.sigmoid(a0[d] + ad[:, :, d] @ a_up[d])
            kd = hd(k * (1 + (a - 1) * k_a))
            dirs.append((hd(r), hd(decay), kd, hd(v), -kk, kk * hd(a)))
            bonus = bonus + jnp.sum(hd(r) * kd * r_k, axis=-1, keepdims=True) * hd(v)
        return dirs, bonus, g

    dc, bc, gc = prep(pc, 1)
    dx, bx, gx = prep(px, rows_x)
    S0 = jnp.zeros((pc.shape[0], RWKV_HEADS, RWKV_N, RWKV_N), jnp.float32)
    yc, yx = run_two_directions(rwkv7_scan, dc, dx, S0)

    def finish(y, bonus, g):
        B, T = y.shape[:2]
        yf = y.astype(jnp.float32)
        m = jnp.mean(yf, axis=-1, keepdims=True)
        var = jnp.mean(jnp.square(yf - m), axis=-1, keepdims=True)
        yn = ((yf - m) * lax.rsqrt(var + RWKV_GN_EPS)).reshape(B, T, RWKV_W) * ln_g + ln_b
        return (yn.astype(g.dtype) + bonus.reshape(B, T, RWKV_W)) * g

    return finish(yc, bc, gc), finish(yx, bx, gx)


def mlstm_branch(pc, px, i_bias, f_bias, norm_g):
    def prep(p):
        B, T, _ = p.shape
        q, k, v, o, ig, fg = split_cols(p, (MLSTM_QK_W, MLSTM_QK_W, MLSTM_V_W, MLSTM_V_W, 2 * MLSTM_HEADS, 2 * MLSTM_HEADS))
        q = q.reshape(B, T, MLSTM_HEADS, MLSTM_DQK) * (MLSTM_DQK ** -0.5)
        k = k.reshape(B, T, MLSTM_HEADS, MLSTM_DQK)
        v = v.reshape(B, T, MLSTM_HEADS, MLSTM_DV)
        ig = ig.reshape(B, T, 2, MLSTM_HEADS) + i_bias
        lf = jax.nn.log_sigmoid(fg.reshape(B, T, 2, MLSTM_HEADS) + f_bias)
        return [(q, k, v, ig[:, :, d], lf[:, :, d]) for d in range(2)], jax.nn.sigmoid(o)

    dc, oc = prep(pc)
    dx, ox = prep(px)
    B = pc.shape[0]
    state0 = (jnp.zeros((B, MLSTM_HEADS, MLSTM_DQK, MLSTM_DV), jnp.float32),
              jnp.zeros((B, MLSTM_HEADS, MLSTM_DQK), jnp.float32),
              jnp.zeros((B, MLSTM_HEADS), jnp.float32))
    hc, hx = run_two_directions(mlstm_chunked, dc, dx, state0)

    def finish(h, o):
        Bh, T = h.shape[:2]
        return rmsnorm(h, norm_g).reshape(Bh, T, MLSTM_V_W) * o

    return finish(hc, oc), finish(hx, ox)


def merge_branches(branches, gate_pre, w_branch, w_out):
    gates = jnp.split(gate_pre, N_BRANCH, axis=-1)
    merged = sum(jax.nn.sigmoid(gates[i]) * (branches[i] @ w_branch[i]) for i in range(N_BRANCH))
    return merged @ w_out


def moe_ec(h, router_w, w1, w3, w2):
    B, n, _ = h.shape
    cap = max(1, CAP_FACTOR * n // N_EXPERTS)
    probs = jax.nn.softmax((h @ router_w).astype(jnp.float32), axis=-1)
    aff, idx = lax.top_k(jnp.swapaxes(probs, 1, 2), cap)
    bidx = jnp.arange(B)[:, None, None]
    xe = h[bidx, idx]
    hid = jax.nn.silu(jnp.einsum('becd,edf->becf', xe, w1)) * jnp.einsum('becd,edf->becf', xe, w3)
    ye = jnp.einsum('becf,efd->becd', hid, w2) * aff[..., None].astype(h.dtype)
    return jnp.zeros_like(h).at[bidx, idx].add(ye)


def setup_inputs(seed: int = 0) -> dict:
    key = jax.random.key(seed)
    ks = jax.random.split(key, 34)
    f32 = jnp.float32
    L = DEPTH

    def nrm(i, shape, scale=1.0):
        return scale * jax.random.normal(ks[i], shape, f32)

    def unif(i, shape, lo, hi):
        return jax.random.uniform(ks[i], shape, f32, lo, hi)

    dt = jnp.exp(unif(11, (L, 2, GDN_HEADS), math.log(1e-3), math.log(1e-1)))
    return {
        "x": nrm(0, (BATCH, SEQ, D_MODEL)),
        "c": nrm(1, (BATCH, D_MODEL)),
        "ctx": nrm(2, (BATCH, CTX_LEN, D_MODEL)),
        "c_ctx": nrm(3, (D_MODEL,)),
        "ada_w": nrm(4, (L, D_MODEL, N_MOD * D_MODEL), 0.5 * D_MODEL ** -0.5),
        "ada_b": nrm(5, (L, N_MOD * D_MODEL), 0.02),
        "norm1_g": 1.0 + nrm(6, (L, D_MODEL), 0.02),
        "norm2_g": 1.0 + nrm(7, (L, D_MODEL), 0.02),
        "w_in": nrm(8, (L, D_MODEL, IN_COLS), D_MODEL ** -0.5),
        "gdn_conv": nrm(9, (L, CONV_K, CONV_K, 3 * GDN_W), 1.0 / CONV_K),
        "gdn_a_log": jnp.log(unif(10, (L, 2, GDN_HEADS), 1.0, 16.0)),
        "gdn_dt_bias": dt + jnp.log(-jnp.expm1(-dt)),
        "gdn_norm_g": 1.0 + nrm(12, (L, GDN_DV), 0.02),
        "rwkv_mu": unif(13, (L, RWKV_COLS), 0.0, 1.0),
        "rwkv_w0": jnp.linspace(-6.5, -1.5, RWKV_W, dtype=f32) + nrm(14, (L, 2, RWKV_W), 0.1),
        "rwkv_w_up": nrm(15, (L, 2, DECAY_LORA, RWKV_W), 0.1),
        "rwkv_a0": nrm(16, (L, 2, RWKV_W), 0.1),
        "rwkv_a_up": nrm(17, (L, 2, ICL_LORA, RWKV_W), 0.1),
        "rwkv_g_up": nrm(18, (L, GATE_LORA, RWKV_W), GATE_LORA ** -0.5),
        "rwkv_k_k": 0.85 + nrm(19, (L, RWKV_W), 0.05),
        "rwkv_k_a": 1.0 + nrm(20, (L, RWKV_W), 0.05),
        "rwkv_r_k": -0.04 + nrm(21, (L, RWKV_HEADS, RWKV_N), 0.05),
        "rwkv_ln_g": 1.0 + nrm(22, (L, RWKV_W), 0.02),
        "rwkv_ln_b": nrm(23, (L, RWKV_W), 0.02),
        "mlstm_i_bias": nrm(24, (L, 2, MLSTM_HEADS), 0.1),
        "mlstm_f_bias": jnp.linspace(3.0, 6.0, MLSTM_HEADS, dtype=f32) + nrm(25, (L, 2, MLSTM_HEADS), 0.1),
        "mlstm_norm_g": 1.0 + nrm(26, (L, MLSTM_DV), 0.02),
        "w_branch": nrm(27, (L, N_BRANCH, BRANCH_W, D_MODEL), BRANCH_W ** -0.5),
        "w_out": nrm(28, (L, D_MODEL, D_MODEL), D_MODEL ** -0.5),
        "router_w": nrm(29, (L, D_MODEL, N_EXPERTS), D_MODEL ** -0.5),
        "moe_w1": nrm(30, (L, N_EXPERTS, D_MODEL, MOE_D_FF), D_MODEL ** -0.5),
        "moe_w3": nrm(31, (L, N_EXPERTS, D_MODEL, MOE_D_FF), D_MODEL ** -0.5),
        "moe_w2": nrm(32, (L, N_EXPERTS, MOE_D_FF, D_MODEL), MOE_D_FF ** -0.5),
        "final_g": 1.0 + nrm(33, (D_MODEL,), 0.02),
    }


def reference(x, c, ctx, c_ctx, ada_w, ada_b, norm1_g, norm2_g, w_in, gdn_conv, gdn_a_log,
              gdn_dt_bias, gdn_norm_g, rwkv_mu, rwkv_w0, rwkv_w_up, rwkv_a0, rwkv_a_up, rwkv_g_up,
              rwkv_k_k, rwkv_k_a, rwkv_r_k, rwkv_ln_g, rwkv_ln_b, mlstm_i_bias, mlstm_f_bias,
              mlstm_norm_g, w_branch, w_out, router_w, moe_w1, moe_w3, moe_w2, final_g):
    rows = x.shape[1] // GRID_W
    s_lat = jax.nn.silu(c)
    s_ctx = jax.nn.silu(c_ctx)[None]
    col_groups = (GDN_COLS, RWKV_COLS, MLSTM_COLS, GATE_COLS)
    for l in range(DEPTH):
        last = l == DEPTH - 1
        mod_x = jnp.split(s_lat @ ada_w[l] + ada_b[l], N_MOD, axis=-1)
        mod_c = jnp.split(s_ctx @ ada_w[l] + ada_b[l], N_MOD, axis=-1)
        hx = modulate(rmsnorm(x, norm1_g[l]), mod_x[0], mod_x[1])
        hc = modulate(rmsnorm(ctx, norm1_g[l]), mod_c[0], mod_c[1])
        gdn_x, rwkv_x, mlstm_x, gate_x = split_cols(hx @ w_in[l], col_groups)
        gdn_c, rwkv_c, mlstm_c, gate_c = split_cols(hc @ w_in[l], col_groups)
        a_c, a_x = gdn_branch(gdn_c, gdn_x, rows, gdn_conv[l], gdn_a_log[l], gdn_dt_bias[l], gdn_norm_g[l])
        b_c, b_x = rwkv_branch(rwkv_c, rwkv_x, rows, rwkv_mu[l], rwkv_w0[l], rwkv_w_up[l], rwkv_a0[l],
                               rwkv_a_up[l], rwkv_g_up[l], rwkv_k_k[l], rwkv_k_a[l], rwkv_r_k[l],
                               rwkv_ln_g[l], rwkv_ln_b[l])
        m_c, m_x = mlstm_branch(mlstm_c, mlstm_x, mlstm_i_bias[l], mlstm_f_bias[l], mlstm_norm_g[l])
        x = x + mod_x[2][:, None] * merge_branches((a_x, b_x, m_x), gate_x, w_branch[l], w_out[l])
        h2x = modulate(rmsnorm(x, norm2_g[l]), mod_x[3], mod_x[4])
        x = x + mod_x[5][:, None] * moe_ec(h2x, router_w[l], moe_w1[l], moe_w3[l], moe_w2[l])
        if not last:
            ctx = ctx + mod_c[2][:, None] * merge_branches((a_c, b_c, m_c), gate_c, w_branch[l], w_out[l])
            h2c = modulate(rmsnorm(ctx, norm2_g[l]), mod_c[3], mod_c[4])
            ctx = ctx + mod_c[5][:, None] * moe_ec(h2c, router_w[l], moe_w1[l], moe_w3[l], moe_w2[l])
    return rmsnorm(x, final_g)
```

```cpp
#ifndef CPU_EMU
#include <hip/hip_runtime.h>
#include <cstdio>
#include <cstdint>
typedef _Float16 half_t;
typedef _Float16 half8 __attribute__((ext_vector_type(8)));
typedef _Float16 half4 __attribute__((ext_vector_type(4)));
typedef float f32x4 __attribute__((ext_vector_type(4)));
typedef float f32x2 __attribute__((ext_vector_type(2)));
#define LAS __attribute__((address_space(3)))
#define SYNC() __syncthreads()
#define WAVE_SYNC() __builtin_amdgcn_wave_barrier()
template <int M> __device__ __forceinline__ float shfl_xor_t(float v, int tid) {
    if constexpr (M < 32) return __int_as_float(__builtin_amdgcn_ds_swizzle(__float_as_int(v), (M << 10) | 0x1f));
    else return __int_as_float(__builtin_amdgcn_ds_bpermute(((tid ^ 32) & 63) << 2, __float_as_int(v)));
}
#define SHFL_XOR(v, m) shfl_xor_t<m>((v), tid)
#define LDS_ATOMIC_INC(p) __hip_atomic_fetch_add((p), 1u, __ATOMIC_RELAXED, __HIP_MEMORY_SCOPE_WORKGROUP)
#endif

#ifndef CFG_BATCH
#define CFG_BATCH 8
#define CFG_SEQ 4096
#define CFG_CTX 256
#define CFG_DEPTH 4
#define CFG_NGROUP 2
#endif
constexpr int BATCH = CFG_BATCH, SEQ = CFG_SEQ, CTXL = CFG_CTX, DEPTH = CFG_DEPTH, NGROUP = CFG_NGROUP;
#ifndef SKIP_MASK
#define SKIP_MASK 0
#endif
constexpr int NT = 512;
constexpr int D = 1024;
constexpr int IN_COLS = 8608, NP = 8704;
constexpr int C_Z = 1536, C_BG = 2048;
constexpr int C_RWKV = 2064;
constexpr int C_ML = 3984, C_MLO = 5008, C_MLIG = 5520, C_MLFG = 5528;
constexpr int C_GATE = 5536;
constexpr int BG = BATCH / NGROUP;
constexpr int RL = BG * SEQ, RC = BG * CTXL, RG = RL + RC;
constexpr int RGP = (RG + 255) / 256 * 256;
constexpr int CAPL = SEQ / 8, CAPC = CTXL / 8;
constexpr int RPE = (BG * (CAPL + CAPC) + 255) / 256 * 256;
constexpr int TPE = RPE / 256;
constexpr int NCH = RGP / 64;
static_assert(RL % 256 == 0, "latent rows per group must be a multiple of 256");
static_assert(SEQ % 64 == 0 && CTXL % 64 == 0, "chunks");

constexpr size_t al256(size_t x) { return (x + 255) / 256 * 256; }
constexpr size_t cmax(size_t a, size_t b) { return a > b ? a : b; }
constexpr size_t OFF_BAR = 0;
constexpr size_t OFF_MOD = 16384;
constexpr size_t OFF_CTXR = al256(OFF_MOD + (size_t)DEPTH * (BATCH + 1) * 6144 * 4);
constexpr size_t OFF_WIN = al256(OFF_CTXR + (size_t)BATCH * CTXL * D * 4);
constexpr size_t OFF_WBR = al256(OFF_WIN + (size_t)NP * 1024 * 2);
constexpr size_t OFF_WOUT = al256(OFF_WBR + (size_t)3 * 1024 * 512 * 2);
constexpr size_t OFF_WUP = al256(OFF_WOUT + (size_t)1024 * 1024 * 2);
constexpr size_t OFF_WDN = al256(OFF_WUP + (size_t)16 * 1024 * 1024 * 2);
constexpr size_t OFF_WLORA = al256(OFF_WDN + (size_t)16 * 1024 * 512 * 2);
constexpr size_t OFF_H = al256(OFF_WLORA + (size_t)2560 * 384 * 2);
constexpr size_t OFF_P = al256(OFF_H + (size_t)RGP * 1024 * 2);
constexpr size_t SZ_XE = (size_t)16 * RPE * 1024 * 2, SZ_HID = (size_t)16 * RPE * 512 * 2;
constexpr size_t OFF_XE = OFF_P, OFF_HID = OFF_XE + SZ_XE, OFF_YE = OFF_HID + SZ_HID;
constexpr size_t OFF_GQKV = al256(OFF_P + cmax((size_t)RGP * NP * 2, 2 * SZ_XE + SZ_HID));
constexpr size_t OFF_BR = OFF_GQKV;
constexpr size_t OFF_GBG = al256(OFF_GQKV + (size_t)RGP * 1536 * 2);
constexpr size_t OFF_GTA = al256(OFF_GBG + (size_t)RGP * 16 * 4);
constexpr size_t OFF_GG = al256(OFF_GTA + (size_t)NCH * 4 * 2 * 2 * 4096 * 2);
constexpr size_t OFF_RW = al256(OFF_GG + (size_t)NCH * 4 * 2 * 64 * 4);
constexpr size_t OFF_RLO = al256(OFF_RW + (size_t)RGP * 4 * 512 * 2);
constexpr size_t OFF_SO = al256(OFF_RLO + (size_t)RGP * 2560 * 2);
constexpr size_t OFF_RLI = OFF_SO;
constexpr size_t OFF_SOG = OFF_SO, OFF_SOM = OFF_SOG + (size_t)2 * RGP * 512 * 2, OFF_SOR = OFF_SOM + (size_t)2 * RGP * 512 * 2;
constexpr size_t OFF_PROB = al256(OFF_SOR + (size_t)2 * RGP * 512 * 4);
constexpr size_t OFF_SLOT = al256(OFF_PROB + (size_t)RGP * 16 * 4);
constexpr size_t OFF_SEL = al256(OFF_SLOT + (size_t)RGP * 16 * 4);
constexpr size_t OFF_AFF = al256(OFF_SEL + (size_t)16 * RPE * 4);
constexpr size_t WS_TOTAL = al256(OFF_AFF + (size_t)16 * RPE * 4);
constexpr int SMEM_BYTES = 152 * 1024;

struct Params { const float* in[34]; float* out; unsigned char* ws; };
enum { I_X = 0, I_C, I_CTX, I_CCTX, I_ADAW, I_ADAB, I_N1G, I_N2G, I_WIN, I_GCONV, I_GALOG, I_GDTB, I_GNG, I_RMU, I_RW0, I_RWUP, I_RA0, I_RAUP, I_RGUP,
       I_RKK, I_RKA, I_RRK, I_RLNG, I_RLNB, I_MIB, I_MFB, I_MNG, I_WBR, I_WOUT, I_ROUT, I_W1, I_W3, I_W2, I_FING };

#ifndef CPU_EMU
__device__ __forceinline__ int tid_fresh() { int t = threadIdx.x; asm volatile("" : "+v"(t)); return t; }
#else
static inline int tid_fresh() { return threadIdx.x; }
#endif
__device__ __forceinline__ float sigm(float x) { return 1.f / (1.f + expf(-x)); }
__device__ __forceinline__ float siluf(float x) { return x / (1.f + expf(-x)); }
__device__ __forceinline__ float softplusf(float x) { return x > 20.f ? x : log1pf(expf(x)); }
#define wave_sum(x) wave_sum_(x, tid)
__device__ __forceinline__ float wave_sum_(float v, int tid) { v += SHFL_XOR(v, 32); v += SHFL_XOR(v, 16); v += SHFL_XOR(v, 8); v += SHFL_XOR(v, 4); v += SHFL_XOR(v, 2); v += SHFL_XOR(v, 1); return v; }

__device__ __forceinline__ const float* res_src(const Params& p, int l, int g, int r) {
    if (r < RL) { const size_t t = (size_t)(g * BG) * SEQ + r; return (l == 0 ? p.in[I_X] : p.out) + t * D; }
    const size_t t = (size_t)(g * BG) * CTXL + (r - RL); return (l == 0 ? p.in[I_CTX] : (const float*)(p.ws + OFF_CTXR)) + t * D;
}
__device__ __forceinline__ float* res_dst(const Params& p, int g, int r) {
    if (r < RL) { const size_t t = (size_t)(g * BG) * SEQ + r; return p.out + t * D; }
    const size_t t = (size_t)(g * BG) * CTXL + (r - RL); return (float*)(p.ws + OFF_CTXR) + t * D;
}
__device__ __forceinline__ const float* mod_row(const Params& p, int l, int g, int r) {
    const int s = r < RL ? (g * BG + r / SEQ) : BATCH; return (const float*)(p.ws + OFF_MOD) + ((size_t)l * (BATCH + 1) + s) * 6144;
}

#ifndef CPU_EMU
#define XB_TMO      128
#define XB_XCNT(j)  (256  + 64 * (j))
#define XB_XSUB(j)  (1280 + 64 * (j))
#define XB_XGEN(j)  (2304 + 64 * (j))
#define XB_TOP      3328
#define XB_TOPGEN   3392
#define XCD_BAR_WORDS 3456
#define XB_SPIN_CAP (1u << 22)
__device__ __forceinline__ unsigned xb_ld(unsigned* p)              { return __hip_atomic_load(p, __ATOMIC_RELAXED, __HIP_MEMORY_SCOPE_AGENT); }
__device__ __forceinline__ unsigned xb_add(unsigned* p, unsigned v) { return __hip_atomic_fetch_add(p, v, __ATOMIC_RELAXED, __HIP_MEMORY_SCOPE_AGENT); }
__device__ __forceinline__ unsigned xb_xcc_id() { return (unsigned)__builtin_amdgcn_s_getreg((3 << 11) | 20) & 0xFu; }
#define XB_SPIN(cond, bar) do { unsigned _sp = 0; while (cond) { __builtin_amdgcn_s_sleep(1); \
    if ((++_sp & 255u) == 0u) { if (xb_ld(&(bar)[XB_TMO])) break; if (_sp > XB_SPIN_CAP) { atomicAdd(&(bar)[XB_TMO], 1u); break; } } } } while (0)
struct XcdBarrier { unsigned* bar; unsigned x; volatile LAS unsigned* st; };
__device__ __forceinline__ XcdBarrier xcd_barrier_post(unsigned* bar, volatile LAS unsigned* st) {
    XcdBarrier b; b.bar = bar; b.x = xb_xcc_id(); b.st = st;
    if (threadIdx.x == 0) (void)xb_add(&bar[XB_XCNT(b.x)], 1u);
    return b;
}
__device__ __forceinline__ void xcd_barrier_complete(unsigned* bar, unsigned x, unsigned& nloc, unsigned& nx) {
    const unsigned G = gridDim.x * gridDim.y * gridDim.z;
    unsigned sum, cnt, mine, sp = 0u;
    for (;;) {
        sum = 0u; cnt = 0u; mine = 0u;
#pragma unroll
        for (unsigned j = 0; j < 16; ++j) { const unsigned c = xb_ld(&bar[XB_XCNT(j)]); sum += c; cnt += (c > 0u) ? 1u : 0u; mine = (j == x) ? c : mine; }
        if (sum == G) break;
        __builtin_amdgcn_s_sleep(1);
        if ((++sp & 255u) == 0u) { if (xb_ld(&bar[XB_TMO])) break; if (sp > XB_SPIN_CAP) { atomicAdd(&bar[XB_TMO], 1u); break; } }
    }
    nloc = mine > 0u ? mine : 1u; nx = cnt > 0u ? cnt : 1u;
}
__device__ __forceinline__ void xcd_barrier(const XcdBarrier& b) {
    asm volatile("s_waitcnt vmcnt(0)" ::: "memory");
    __syncthreads();
    if (threadIdx.x == 0) {
        unsigned* bar = b.bar;
        __builtin_amdgcn_s_waitcnt(0);
        unsigned nloc = b.st[0], nx = b.st[1];
        if (nloc == 0u) { xcd_barrier_complete(bar, b.x, nloc, nx); b.st[0] = nloc; b.st[1] = nx; }
        const unsigned old = xb_add(&bar[XB_XSUB(b.x)], 1u);
        const unsigned gen = old / nloc;
        if (old + 1u == (gen + 1u) * nloc) {
            __builtin_amdgcn_fence(__ATOMIC_RELEASE, "agent");
            asm volatile("s_waitcnt vmcnt(0)" ::: "memory");
            const unsigned og = xb_add(&bar[XB_TOP], 1u);
            const unsigned tg = og / nx;
            if (og + 1u == (tg + 1u) * nx) xb_add(&bar[XB_TOPGEN], 1u);
            else XB_SPIN(xb_ld(&bar[XB_TOPGEN]) == tg, bar);
            __builtin_amdgcn_fence(__ATOMIC_ACQUIRE, "agent");
            xb_add(&bar[XB_XGEN(b.x)], 1u);
            asm volatile("s_waitcnt vmcnt(0)" ::: "memory");
        } else {
            XB_SPIN(xb_ld(&bar[XB_XGEN(b.x)]) == gen, bar);
            __builtin_amdgcn_fence(__ATOMIC_ACQUIRE, "agent");
            asm volatile("s_waitcnt vmcnt(0)" ::: "memory");
        }
    }
    __syncthreads();
}
#define GRID_SYNC() do { XcdBarrier gb_; gb_.bar = (unsigned*)(p.ws + OFF_BAR); gb_.x = xb_xcc_id(); gb_.st = (volatile LAS unsigned*)(lds + SMEM_BYTES - 16); xcd_barrier(gb_); } while (0)
#else
#define GRID_SYNC() emu_grid_sync()
#endif

namespace pg8 {
constexpr int BM = 256, BK = 64, HALF = 128, HTB = HALF * BK * 2, STAGE_BYTES = 8 * HTB, NXCD = 8, WGM = 8;
__host__ __device__ __forceinline__ int lds_byte(int r, int c) { const int st = (r >> 4) * 2 + (c >> 5), rr = r & 15, cc = c & 31, ob = rr * 64 + cc * 2; return st * 1024 + (ob ^ (((ob >> 9) & 1) << 5)); }
__host__ __device__ __forceinline__ void stage_rc(int b, int& R, int& C) { const int st = b / 1024, sb = b % 1024, swz = sb ^ (((sb >> 9) & 1) << 5); R = (st >> 1) * 16 + swz / 64; C = (st & 1) * 32 + (swz % 64) / 2; }
__host__ __device__ __forceinline__ int perm32(int rho) { const int n = rho >> 4, i = rho & 15; return 8 * (i >> 2) + 4 * n + (i & 3); }
struct Unit { int pm, pn, pb; };
struct Gemm { const half_t* A; const half_t* Bt; int K; };
struct StaticOrder {
    int nM, nN, nwg, G, c;
    __device__ void init(int nM_, int nN_, int G_, int c_) { nM = nM_; nN = nN_; nwg = nM * nN; G = G_; c = c_; }
    __device__ bool next(int i, Unit& u) const {
        const long L = (long)i * G + c; if (L >= nwg) return false;
        int wgid = (int)L; { const int q = nwg / NXCD, r = nwg % NXCD, xcd = wgid % NXCD, off = wgid / NXCD; wgid = (xcd < r ? xcd * (q + 1) : r * (q + 1) + (xcd - r) * q) + off; }
        const int nig = WGM * nN, gid = wgid / nig, fm = gid * WGM, gsz = (nM - fm) < WGM ? (nM - fm) : WGM;
        u.pm = fm + ((wgid % nig) % gsz); u.pn = (wgid % nig) / gsz; u.pb = u.pn; return true;
    }
};
struct ExpertOrder {
    int G, c;
    __device__ void init(int G_, int c_) { G = G_; c = c_; }
    __device__ bool next(int i, Unit& u) const {
        const long L = (long)i * G + c; if (L >= 16 * TPE * 4) return false;
        const int e = (int)L / (TPE * 4), rem = (int)L % (TPE * 4);
        u.pm = e * TPE + rem / 4; u.pn = rem % 4; u.pb = e * 4 + u.pn; return true;
    }
};

#ifndef CPU_EMU
template <class Epi, class Sched>
__device__ __forceinline__ void gemm_phase(LAS unsigned char* lds, const Gemm g, const Sched& S, const Epi& E) {
    const int tid = tid_fresh(), wid = __builtin_amdgcn_readfirstlane(tid >> 6), lane = tid & 63, wr = wid >> 2, wc = wid & 3, fr = lane & 15, fq = lane >> 4;
    const int K = g.K, nt = K / BK;
    unsigned voffA[2], voffB[2];
#pragma unroll
    for (int i = 0; i < 2; ++i) { int R, C; stage_rc(tid * 16 + i * 8192, R, C); const int Rb = Epi::PERM ? ((R & ~31) + perm32(R & 31)) : R;
        voffA[i] = (unsigned)(R * K + C) * 2u; voffB[i] = (unsigned)(Rb * K + C) * 2u; }
    const size_t kstep = (size_t)(BK * 2);
    const size_t hstep = (size_t)HALF * K * 2;
    const size_t tstep = 2 * hstep;
    const unsigned ldsw = (unsigned)wid * 1024u;
    const int aoff = lds_byte(wr * 64 + fr, fq * 8), boff = lds_byte(wc * 32 + fr, fq * 8);
#define PG8_SA(b, h) (((b) * 2 + (h)) * HTB)
#define PG8_SB(b, h) ((4 + (b) * 2 + (h)) * HTB)
#define PG8_STAGE(bufoff, gbase, voff) do { _Pragma("unroll") for (int _i = 0; _i < 2; ++_i) \
        __builtin_amdgcn_global_load_lds((const unsigned*)((const char*)(gbase) + (voff)[_i]), (LAS unsigned*)(lds + (bufoff) + ldsw + _i * 8192), 16, 0, 0); } while (0)
#define PG8_LDA(dst, b, h) do { _Pragma("unroll") for (int m = 0; m < 4; ++m) _Pragma("unroll") for (int k = 0; k < 2; ++k) dst[m][k] = *(const LAS half8*)(lds + PG8_SA(b, h) + aoff + m * 2048 + k * 1024); } while (0)
#define PG8_LDB(dst, b, h) do { _Pragma("unroll") for (int n = 0; n < 2; ++n) _Pragma("unroll") for (int k = 0; k < 2; ++k) dst[n][k] = *(const LAS half8*)(lds + PG8_SB(b, h) + boff + n * 2048 + k * 1024); } while (0)
#define PG8_MMA(ai, bj, At, Bt) do { __builtin_amdgcn_s_setprio(1); _Pragma("unroll") for (int m = 0; m < 4; ++m) _Pragma("unroll") for (int n = 0; n < 2; ++n) _Pragma("unroll") for (int k = 0; k < 2; ++k) \
        acc[ai][bj][m][n] = __builtin_amdgcn_mfma_f32_16x16x32_f16(Bt[n][k], At[m][k], acc[ai][bj][m][n], 0, 0, 0); __builtin_amdgcn_s_setprio(0); } while (0)
#define PG8_WAIT_V(n) asm volatile("s_waitcnt vmcnt(" #n ")" ::: "memory")
#define PG8_WAIT_L(n) asm volatile("s_waitcnt lgkmcnt(" #n ")" ::: "memory")
#define PG8_BAR __builtin_amdgcn_s_barrier()
#define PG8_SCHED __builtin_amdgcn_sched_barrier(0)
    Unit cur, nxt; int ui = 0;
    if (!S.next(0, cur)) return;
    f32x4 acc[2][2][4][2];
#pragma unroll
    for (int a = 0; a < 2; ++a)
#pragma unroll
        for (int b = 0; b < 2; ++b)
#pragma unroll
            for (int m = 0; m < 4; ++m)
#pragma unroll
                for (int n = 0; n < 2; ++n) acc[a][b][m][n] = (f32x4){0.f, 0.f, 0.f, 0.f};
    half8 At[4][2], B0[2][2], B1[2][2];
    const char* cA = (const char*)g.A + (size_t)cur.pm * tstep; const char* cB = (const char*)g.Bt + (size_t)cur.pb * tstep;
    PG8_STAGE(PG8_SB(0, 0), cB, voffB); PG8_STAGE(PG8_SA(0, 0), cA, voffA); PG8_STAGE(PG8_SB(0, 1), cB + hstep, voffB); PG8_STAGE(PG8_SA(0, 1), cA + hstep, voffA);
    if (wr == 1) PG8_BAR;
    PG8_WAIT_V(4); PG8_BAR;
    PG8_STAGE(PG8_SB(1, 0), cB + kstep, voffB); PG8_STAGE(PG8_SA(1, 0), cA + kstep, voffA); PG8_STAGE(PG8_SB(1, 1), cB + hstep + kstep, voffB);
    PG8_WAIT_V(6); PG8_BAR;
    for (;;) {
        const bool has_next = S.next(ui + 1, nxt);
        const char* nA = has_next ? (const char*)g.A + (size_t)nxt.pm * tstep : cA; const char* nB = has_next ? (const char*)g.Bt + (size_t)nxt.pb * tstep : cB;
#pragma unroll 1
        for (int t = 0; t < nt; t += 2) {
            const bool last = (t == nt - 2);
            const char* a1 = cA + (size_t)(t + 1) * kstep;
            const char* a2 = last ? nA : cA + (size_t)(t + 2) * kstep; const char* b2 = last ? nB : cB + (size_t)(t + 2) * kstep;
            const char* a3 = a2 + kstep; const char* b3 = b2 + kstep;
            PG8_LDB(B0, 0, 0); PG8_SCHED; PG8_LDA(At, 0, 0); PG8_STAGE(PG8_SA(1, 1), a1 + hstep, voffA);
            PG8_WAIT_L(8); PG8_BAR; PG8_WAIT_L(0); PG8_MMA(0, 0, At, B0); PG8_BAR; PG8_SCHED;
            PG8_LDB(B1, 0, 1); PG8_STAGE(PG8_SB(0, 0), b2, voffB);
            PG8_BAR; PG8_WAIT_L(0); PG8_MMA(0, 1, At, B1); PG8_BAR;
            PG8_LDA(At, 0, 1); PG8_STAGE(PG8_SA(0, 0), a2, voffA);
            PG8_BAR; PG8_WAIT_L(0); PG8_MMA(1, 0, At, B0); PG8_BAR; PG8_SCHED;
            PG8_STAGE(PG8_SB(0, 1), b2 + hstep, voffB);
            PG8_WAIT_V(6); PG8_BAR; PG8_MMA(1, 1, At, B1); PG8_BAR;
            PG8_LDB(B0, 1, 0); PG8_SCHED; PG8_LDA(At, 1, 0); PG8_STAGE(PG8_SA(0, 1), a2 + hstep, voffA);
            PG8_WAIT_L(8); PG8_BAR; PG8_WAIT_L(0); PG8_MMA(0, 0, At, B0); PG8_BAR; PG8_SCHED;
            PG8_LDB(B1, 1, 1); PG8_STAGE(PG8_SB(1, 0), b3, voffB);
            PG8_BAR; PG8_WAIT_L(0); PG8_MMA(0, 1, At, B1); PG8_BAR;
            PG8_LDA(At, 1, 1); PG8_STAGE(PG8_SA(1, 0), a3, voffA);
            PG8_BAR; PG8_WAIT_L(0); PG8_MMA(1, 0, At, B0); PG8_BAR; PG8_SCHED;
            PG8_STAGE(PG8_SB(1, 1), b3 + hstep, voffB);
            PG8_WAIT_V(6); PG8_BAR; PG8_MMA(1, 1, At, B1); PG8_BAR;
        }
        E(acc, cur, wr, wc, fr, fq);
        if (!has_next) break;
#pragma unroll
        for (int a = 0; a < 2; ++a)
#pragma unroll
            for (int b = 0; b < 2; ++b)
#pragma unroll
                for (int m = 0; m < 4; ++m)
#pragma unroll
                    for (int n = 0; n < 2; ++n) acc[a][b][m][n] = (f32x4){0.f, 0.f, 0.f, 0.f};
        cur = nxt; cA = nA; cB = nB; ++ui;
    }
    PG8_WAIT_V(0);
    if (wr == 0) PG8_BAR;
    PG8_BAR;
#undef PG8_SA
#undef PG8_SB
#undef PG8_STAGE
#undef PG8_LDA
#undef PG8_LDB
#undef PG8_MMA
#undef PG8_WAIT_V
#undef PG8_WAIT_L
#undef PG8_BAR
#undef PG8_SCHED
}
#else
static float* emu_fa[64]; static float* emu_fb[64];
template <class Epi, class Sched>
void gemm_phase(LAS unsigned char* lds, const Gemm g, const Sched& S, const Epi& E) {
    const int tid = tid_fresh(), wid = tid >> 6, lane = tid & 63, wr = wid >> 2, wc = wid & 3, fr = lane & 15, fq = lane >> 4;
    const int K = g.K; const int bid = blockIdx.x;
    Unit u;
    for (int ui = 0; S.next(ui, u); ++ui) {
        SYNC();
        if (tid == 0) {
            if (!emu_fa[bid]) { emu_fa[bid] = (float*)malloc(256 * 1024 * 4); emu_fb[bid] = (float*)malloc(256 * 1024 * 4); }
            for (int r = 0; r < 256; ++r) for (int k = 0; k < K; ++k) { emu_fa[bid][r * K + k] = (float)g.A[((size_t)u.pm * 256 + r) * K + k]; emu_fb[bid][r * K + k] = (float)g.Bt[((size_t)u.pb * 256 + r) * K + k]; }
        }
        SYNC();
        f32x4 acc[2][2][4][2];
        for (int ai = 0; ai < 2; ++ai) for (int bj = 0; bj < 2; ++bj) for (int m = 0; m < 4; ++m) for (int n = 0; n < 2; ++n) for (int i = 0; i < 4; ++i) {
            const int row = 128 * ai + 64 * wr + 16 * m + fr;
            const int col = Epi::PERM ? (128 * bj + 32 * wc + 8 * fq + 4 * n + i) : (128 * bj + 32 * wc + 16 * n + 4 * fq + i);
            const float* a = emu_fa[bid] + row * K; const float* b = emu_fb[bid] + col * K; float s = 0.f;
            for (int k = 0; k < K; ++k) s += a[k] * b[k];
            acc[ai][bj][m][n][i] = s; }
        E(acc, u, wr, wc, fr, fq);
    }
    SYNC();
}
#endif
}
using pg8::Unit;

struct EpiP {
    static constexpr bool PERM = true;
    half_t* P;
    __device__ __forceinline__ void operator()(const f32x4 (&acc)[2][2][4][2], const Unit& u, int wr, int wc, int fr, int fq) const {
        const int row0 = u.pm * 256 + wr * 64 + fr, col0 = u.pn * 256 + wc * 32 + 8 * fq;
#pragma unroll
        for (int bj = 0; bj < 2; ++bj) {
            const int col = col0 + bj * 128;
            const bool sg = (col >= C_GATE && col < IN_COLS) || (col >= C_MLO && col < C_MLIG);
#pragma unroll
            for (int ai = 0; ai < 2; ++ai)
#pragma unroll
                for (int m = 0; m < 4; ++m) {
                    half8 h;
#pragma unroll
                    for (int n = 0; n < 2; ++n)
#pragma unroll
                        for (int i = 0; i < 4; ++i) { float v = acc[ai][bj][m][n][i]; if (sg) v = sigm(v); h[4 * n + i] = (half_t)v; }
                    *(half8*)(P + (size_t)(row0 + ai * 128 + m * 16) * NP + col) = h;
                }
        }
    }
};
struct EpiLora {
    static constexpr bool PERM = true;
    half_t* O; const float* w0; const float* a0;
    __device__ __forceinline__ void operator()(const f32x4 (&acc)[2][2][4][2], const Unit& u, int wr, int wc, int fr, int fq) const {
        const int row0 = u.pm * 256 + wr * 64 + fr, col0 = u.pn * 256 + wc * 32 + 8 * fq;
#pragma unroll
        for (int bj = 0; bj < 2; ++bj) {
            const int col = col0 + bj * 128, blk = col >> 9;
            float bias[8];
#pragma unroll
            for (int j = 0; j < 8; ++j) bias[j] = blk < 2 ? w0[col + j] : (blk < 4 ? a0[col - 1024 + j] : 0.f);
#pragma unroll
            for (int ai = 0; ai < 2; ++ai)
#pragma unroll
                for (int m = 0; m < 4; ++m) {
                    half8 h;
#pragma unroll
                    for (int n = 0; n < 2; ++n)
#pragma unroll
                        for (int i = 0; i < 4; ++i) { float v = acc[ai][bj][m][n][i] + bias[4 * n + i];
                            if (blk < 2) v = sigm(v) * 0.6065306597126334f; else if (blk < 4) v = sigm(v);
                            h[4 * n + i] = (half_t)v; }
                    *(half8*)(O + (size_t)(row0 + ai * 128 + m * 16) * 2560 + col) = h;
                }
        }
    }
};
struct EpiMerge {
    static constexpr bool PERM = true;
    half_t* M; const half_t* P; int bi;
    __device__ __forceinline__ void operator()(const f32x4 (&acc)[2][2][4][2], const Unit& u, int wr, int wc, int fr, int fq) const {
        const int row0 = u.pm * 256 + wr * 64 + fr, col0 = u.pn * 256 + wc * 32 + 8 * fq;
#pragma unroll
        for (int ai = 0; ai < 2; ++ai)
#pragma unroll
            for (int m = 0; m < 4; ++m) {
                const size_t row = (size_t)(row0 + ai * 128 + m * 16);
#pragma unroll
                for (int bj = 0; bj < 2; ++bj) {
                    const int col = col0 + bj * 128;
                    const half8 gt = *(const half8*)(P + row * NP + C_GATE + bi * 1024 + col);
                    half8 o; if (bi > 0) o = *(const half8*)(M + row * 1024 + col);
#pragma unroll
                    for (int n = 0; n < 2; ++n)
#pragma unroll
                        for (int i = 0; i < 4; ++i) { float v = (float)gt[4 * n + i] * acc[ai][bj][m][n][i]; if (bi > 0) v += (float)o[4 * n + i]; o[4 * n + i] = (half_t)v; }
                    *(half8*)(M + row * 1024 + col) = o;
                }
            }
    }
};
struct EpiOut {
    static constexpr bool PERM = false;
    Params p; int l, g;
    __device__ __forceinline__ void operator()(const f32x4 (&acc)[2][2][4][2], const Unit& u, int wr, int wc, int fr, int fq) const {
        const int row0 = u.pm * 256 + wr * 64 + fr, col0 = u.pn * 256 + wc * 32 + 4 * fq;
#pragma unroll
        for (int ai = 0; ai < 2; ++ai)
#pragma unroll
            for (int m = 0; m < 4; ++m) {
                const int row = row0 + ai * 128 + m * 16;
                if (row < RG) {
                    const float* src = res_src(p, l, g, row); float* dst = res_dst(p, g, row); const float* md = mod_row(p, l, g, row) + 2 * 1024;
#pragma unroll
                    for (int bj = 0; bj < 2; ++bj)
#pragma unroll
                        for (int n = 0; n < 2; ++n) { const int col = col0 + bj * 128 + n * 16;
                            const f32x4 xo = *(const f32x4*)(src + col), mv = *(const f32x4*)(md + col);
                            *(f32x4*)(dst + col) = xo + mv * acc[ai][bj][m][n]; }
                }
            }
    }
};
struct EpiUp {
    static constexpr bool PERM = true;
    half_t* HID;
    __device__ __forceinline__ void operator()(const f32x4 (&acc)[2][2][4][2], const Unit& u, int wr, int wc, int fr, int fq) const {
        const int row0 = u.pm * 256 + wr * 64 + fr, col = u.pn * 128 + wc * 32 + 8 * fq;
#pragma unroll
        for (int ai = 0; ai < 2; ++ai)
#pragma unroll
            for (int m = 0; m < 4; ++m) {
                half8 h;
#pragma unroll
                for (int n = 0; n < 2; ++n)
#pragma unroll
                    for (int i = 0; i < 4; ++i) h[4 * n + i] = (half_t)(siluf(acc[ai][0][m][n][i]) * acc[ai][1][m][n][i]);
                *(half8*)(HID + (size_t)(row0 + ai * 128 + m * 16) * 512 + col) = h;
            }
    }
};
struct EpiDown {
    static constexpr bool PERM = true;
    half_t* YE; const float* AFF;
    __device__ __forceinline__ void operator()(const f32x4 (&acc)[2][2][4][2], const Unit& u, int wr, int wc, int fr, int fq) const {
        const int row0 = u.pm * 256 + wr * 64 + fr, col0 = u.pn * 256 + wc * 32 + 8 * fq;
#pragma unroll
        for (int ai = 0; ai < 2; ++ai)
#pragma unroll
            for (int m = 0; m < 4; ++m) {
                const size_t row = (size_t)(row0 + ai * 128 + m * 16); const float af = AFF[row];
#pragma unroll
                for (int bj = 0; bj < 2; ++bj) {
                    half8 h;
#pragma unroll
                    for (int n = 0; n < 2; ++n)
#pragma unroll
                        for (int i = 0; i < 4; ++i) h[4 * n + i] = (half_t)(acc[ai][bj][m][n][i] * af);
                    *(half8*)(YE + row * 1024 + col0 + bj * 128) = h;
                }
            }
    }
};

__device__ __forceinline__ void ph_mod(const Params& p, LAS unsigned char* lds) {
    LAS float* sv = (LAS float*)lds; LAS float* red = sv + (BATCH + 1) * 1024;
    const int tid = tid_fresh();
    for (int i = tid; i < (BATCH + 1) * 1024; i += NT) { const int s = i >> 10, k = i & 1023; const float cv = s < BATCH ? p.in[I_C][s * 1024 + k] : p.in[I_CCTX][k]; sv[i] = siluf(cv); }
    SYNC();
    float* mod = (float*)(p.ws + OFF_MOD);
    for (int item = blockIdx.x; item < DEPTH * 48; item += gridDim.x) {
        const int l = item / 48, j = (item % 48) * 128 + (tid & 127), kq = tid >> 7;
        float acc[BATCH + 1];
#pragma unroll
        for (int s = 0; s <= BATCH; ++s) acc[s] = 0.f;
        const float* w = p.in[I_ADAW] + (size_t)l * 1024 * 6144 + j;
        for (int k = kq * 256; k < kq * 256 + 256; ++k) { const float wv = w[(size_t)k * 6144];
#pragma unroll
            for (int s = 0; s <= BATCH; ++s) acc[s] += sv[s * 1024 + k] * wv; }
#pragma unroll
        for (int s = 0; s <= BATCH; ++s) red[tid * (BATCH + 1) + s] = acc[s];
        SYNC();
        if (tid < 128) {
#pragma unroll
            for (int s = 0; s <= BATCH; ++s) { float v = p.in[I_ADAB][l * 6144 + j];
                for (int q = 0; q < 4; ++q) v += red[(q * 128 + tid) * (BATCH + 1) + s];
                mod[((size_t)l * (BATCH + 1) + s) * 6144 + j] = v; }
        }
        SYNC();
    }
}

__device__ __forceinline__ void tconv_tile(const float* src, int sld, int k0, int n0, int nvalid, half_t* dst, int dld, int drow0, int dcol0, LAS float* tile) {
    const int tid = tid_fresh(), r = tid >> 4, c4 = (tid & 15) * 4;
#pragma unroll
    for (int j = 0; j < 2; ++j) { const int k = r + 32 * j; f32x4 v = {0.f, 0.f, 0.f, 0.f};
        if (src && n0 + c4 < nvalid) v = *(const f32x4*)(src + (size_t)(k0 + k) * sld + n0 + c4);
        tile[k * 65 + c4] = v[0]; tile[k * 65 + c4 + 1] = v[1]; tile[k * 65 + c4 + 2] = v[2]; tile[k * 65 + c4 + 3] = v[3]; }
    SYNC();
    const int n = tid >> 3, k8 = (tid & 7) * 8; half8 h;
#pragma unroll
    for (int i = 0; i < 8; ++i) h[i] = (half_t)tile[(k8 + i) * 65 + n];
    *(half8*)(dst + (size_t)(drow0 + n) * dld + dcol0 + k8) = h;
    SYNC();
}
__device__ __forceinline__ void ph_convert(const Params& p, int l, LAS unsigned char* lds) {
    LAS float* tile = (LAS float*)lds;
    constexpr int N_WIN = 16 * (NP / 64), N_WBR = 3 * 128, N_WOUT = 256, N_W13 = 2 * 2048, N_W2 = 2048, N_LORA = 240;
    constexpr int TOTAL = N_WIN + N_WBR + N_WOUT + N_W13 + N_W2 + N_LORA;
    half_t* ws16 = (half_t*)p.ws;
    for (int item = blockIdx.x; item < TOTAL; item += gridDim.x) {
        int it = item;
        if (it < N_WIN) { const int kt = it % 16, ntile = it / 16;
            tconv_tile(p.in[I_WIN] + (size_t)l * 1024 * IN_COLS, IN_COLS, 64 * kt, 64 * ntile, IN_COLS, (half_t*)(p.ws + OFF_WIN), 1024, 64 * ntile, 64 * kt, tile); continue; }
        it -= N_WIN;
        if (it < N_WBR) { const int i = it / 128, rem = it % 128, kt = rem % 8, ntile = rem / 8;
            tconv_tile(p.in[I_WBR] + (size_t)(l * 3 + i) * 512 * 1024, 1024, 64 * kt, 64 * ntile, 1024, (half_t*)(p.ws + OFF_WBR) + (size_t)i * 1024 * 512, 512, 64 * ntile, 64 * kt, tile); continue; }
        it -= N_WBR;
        if (it < N_WOUT) { const int kt = it % 16, ntile = it / 16;
            tconv_tile(p.in[I_WOUT] + (size_t)l * 1024 * 1024, 1024, 64 * kt, 64 * ntile, 1024, (half_t*)(p.ws + OFF_WOUT), 1024, 64 * ntile, 64 * kt, tile); continue; }
        it -= N_WOUT;
        if (it < N_W13) { const int which = it / 2048, rem = it % 2048, e = rem / 128, r2 = rem % 128, kt = r2 % 16, ntile = r2 / 16, n0 = 64 * ntile;
            tconv_tile(p.in[which ? I_W3 : I_W1] + (size_t)(l * 16 + e) * 1024 * 512, 512, 64 * kt, n0, 512, (half_t*)(p.ws + OFF_WUP) + (size_t)e * 1024 * 1024, 1024,
                       (n0 / 128) * 256 + which * 128 + (n0 % 128), 64 * kt, tile); continue; }
        it -= N_W13;
        if (it < N_W2) { const int e = it / 128, r2 = it % 128, kt = r2 % 8, ntile = r2 / 8;
            tconv_tile(p.in[I_W2] + (size_t)(l * 16 + e) * 512 * 1024, 1024, 64 * kt, 64 * ntile, 1024, (half_t*)(p.ws + OFF_WDN) + (size_t)e * 1024 * 512, 512, 64 * ntile, 64 * kt, tile); continue; }
        it -= N_W2;
        { const int ntile = it / 6, kt = it % 6, n0 = 64 * ntile, blk = n0 / 512, nn0 = n0 % 512;
          const float* src = nullptr; int k0 = 0;
          if (blk == 0 && kt == 0) src = p.in[I_RWUP] + (size_t)(l * 2 + 0) * 64 * 512;
          else if (blk == 1 && kt == 1) src = p.in[I_RWUP] + (size_t)(l * 2 + 1) * 64 * 512;
          else if (blk == 2 && kt == 2) src = p.in[I_RAUP] + (size_t)(l * 2 + 0) * 64 * 512;
          else if (blk == 3 && kt == 3) src = p.in[I_RAUP] + (size_t)(l * 2 + 1) * 64 * 512;
          else if (blk == 4 && kt >= 4) { src = p.in[I_RGUP] + (size_t)l * 128 * 512; k0 = 64 * (kt - 4); }
          tconv_tile(src, 512, k0, nn0, 512, (half_t*)(p.ws + OFF_WLORA), 384, n0, 64 * kt, tile); }
    }
    (void)ws16;
}

__device__ __forceinline__ void ph_norm1(const Params& p, int l, int g) {
    const int tid = tid_fresh(), wid = tid >> 6, lane = tid & 63;
    half_t* H = (half_t*)(p.ws + OFF_H);
    for (int r = blockIdx.x * 8 + wid; r < RGP; r += gridDim.x * 8) {
        if (r >= RG) { for (int j = 0; j < 4; ++j) *(half4*)(H + (size_t)r * D + lane * 4 + 256 * j) = (half4){0, 0, 0, 0}; continue; }
        const float* xr = res_src(p, l, g, r); const float* md = mod_row(p, l, g, r); const float* gn = p.in[I_N1G] + l * D;
        f32x4 v[4]; float ss = 0.f;
#pragma unroll
        for (int j = 0; j < 4; ++j) { v[j] = *(const f32x4*)(xr + lane * 4 + 256 * j); ss += v[j][0] * v[j][0] + v[j][1] * v[j][1] + v[j][2] * v[j][2] + v[j][3] * v[j][3]; }
        ss = wave_sum(ss); const float rinv = rsqrtf(ss * (1.f / D) + 1e-6f);
#pragma unroll
        for (int j = 0; j < 4; ++j) { const int c = lane * 4 + 256 * j; half4 h;
#pragma unroll
            for (int i = 0; i < 4; ++i) h[i] = (half_t)(v[j][i] * rinv * gn[c + i] * (1.f + md[1024 + c + i]) + md[c + i]);
            *(half4*)(H + (size_t)r * D + c) = h; }
    }
}

struct RowGeo { int gw, gh, base, gr, gc; };
__device__ __forceinline__ RowGeo row_geo(int r) {
    RowGeo q; int i;
    if (r < RL) { const int bl = r / SEQ; i = r % SEQ; q.gw = 64; q.gh = SEQ / 64; q.base = bl * SEQ; }
    else { const int rr = r - RL, bl = rr / CTXL; i = rr % CTXL; q.gw = CTXL; q.gh = 1; q.base = RL + bl * CTXL; }
    q.gr = i / q.gw; q.gc = i % q.gw; return q;
}

__device__ __forceinline__ void ph_prep(const Params& p, int l, LAS unsigned char* lds) {
    const int tid = tid_fresh(), wid = tid >> 6, lane = tid & 63;
    LAS float* cw = (LAS float*)lds;
    for (int i = tid; i < 9 * 1536; i += NT) cw[i] = p.in[I_GCONV][(size_t)l * 9 * 1536 + i];
    SYNC();
    const half_t* P = (const half_t*)(p.ws + OFF_P);
    half_t* GQKV = (half_t*)(p.ws + OFF_GQKV); float* GBG = (float*)(p.ws + OFF_GBG);
    half_t* RW = (half_t*)(p.ws + OFF_RW); half_t* RLI = (half_t*)(p.ws + OFF_RLI);
    for (int r = blockIdx.x * 8 + wid; r < RG; r += gridDim.x * 8) {
        const RowGeo q = row_geo(r);
        float acc[3][8];
#pragma unroll
        for (int j = 0; j < 3; ++j)
#pragma unroll
            for (int e = 0; e < 8; ++e) acc[j][e] = 0.f;
        for (int kh = 0; kh < 3; ++kh) { const int nr = q.gr + kh - 1; if (nr < 0 || nr >= q.gh) continue;
            for (int kw = 0; kw < 3; ++kw) { const int nc = q.gc + kw - 1; if (nc < 0 || nc >= q.gw) continue;
                const size_t nrow = (size_t)(q.base + nr * q.gw + nc);
#pragma unroll
                for (int j = 0; j < 3; ++j) { const half8 pv = *(const half8*)(P + nrow * NP + j * 512 + 8 * lane); const LAS float* w = cw + (kh * 3 + kw) * 1536 + j * 512 + 8 * lane;
#pragma unroll
                    for (int e = 0; e < 8; ++e) acc[j][e] += (float)pv[e] * w[e]; } } }
#pragma unroll
        for (int j = 0; j < 3; ++j) {
            float ss = 0.f;
#pragma unroll
            for (int e = 0; e < 8; ++e) { acc[j][e] = siluf(acc[j][e]); ss += acc[j][e] * acc[j][e]; }
            float sc = 1.f;
            if (j < 2) { ss += SHFL_XOR(ss, 1); ss += SHFL_XOR(ss, 2); ss += SHFL_XOR(ss, 4); ss += SHFL_XOR(ss, 8); sc = rsqrtf(ss + 1e-6f) * (j == 0 ? 0.08838834764831845f : 1.f); }
            half8 h;
#pragma unroll
            for (int e = 0; e < 8; ++e) h[e] = (half_t)(acc[j][e] * sc);
            *(half8*)(GQKV + (size_t)r * 1536 + j * 512 + 8 * lane) = h;
        }
        if (lane < 16) { const float x = (float)P[(size_t)r * NP + C_BG + lane];
            float o; if (lane < 8) o = sigm(x); else { const int idx = lane - 8; o = -expf(p.in[I_GALOG][l * 8 + idx]) * softplusf(x + p.in[I_GDTB][l * 8 + idx]); }
            GBG[(size_t)r * 16 + lane] = o; }
        const int nb[4] = { q.gc > 0 ? r - 1 : -1, q.gc < q.gw - 1 ? r + 1 : -1, q.gr > 0 ? r - q.gw : -1, q.gr < q.gh - 1 ? r + q.gw : -1 };
        const float* mu = p.in[I_RMU] + (size_t)l * 1920;
        float kmix[8];
#pragma unroll
        for (int j = 0; j < 4; ++j) {
            if (j == 3 && lane >= 48) break;
            const int cj = j < 3 ? j * 512 + 8 * lane : 1536 + 8 * lane;
            const half8 self = *(const half8*)(P + (size_t)r * NP + C_RWKV + cj);
            half8 nv[4];
#pragma unroll
            for (int d = 0; d < 4; ++d) { if (nb[d] >= 0) nv[d] = *(const half8*)(P + (size_t)nb[d] * NP + C_RWKV + cj); else nv[d] = (half8){0, 0, 0, 0, 0, 0, 0, 0}; }
            float val[8];
#pragma unroll
            for (int e = 0; e < 8; ++e) { const float s = (float)self[e], nn = (float)nv[e & 3][e]; val[e] = s + (nn - s) * mu[cj + e]; }
            half8 h;
            if (j < 3) {
#pragma unroll
                for (int e = 0; e < 8; ++e) h[e] = (half_t)val[e];
                *(half8*)(RW + ((size_t)r * 4 + j) * 512 + 8 * lane) = h;
                if (j == 1) {
#pragma unroll
                    for (int e = 0; e < 8; ++e) kmix[e] = val[e]; }
            } else {
                const int c0 = 8 * lane;
#pragma unroll
                for (int e = 0; e < 8; ++e) { float v = val[e]; if (c0 < 128) v = tanhf(v); else if (c0 >= 256) v = sigm(v); h[e] = (half_t)v; }
                *(half8*)(RLI + (size_t)r * 384 + c0) = h;
            }
        }
        { float t[8], ss = 0.f; const float* kkw = p.in[I_RKK] + (size_t)l * 512 + 8 * lane;
#pragma unroll
          for (int e = 0; e < 8; ++e) { t[e] = kmix[e] * kkw[e]; ss += t[e] * t[e]; }
          ss += SHFL_XOR(ss, 1); ss += SHFL_XOR(ss, 2); ss += SHFL_XOR(ss, 4);
          const float sc = rsqrtf(ss + 1e-6f); half8 h;
#pragma unroll
          for (int e = 0; e < 8; ++e) h[e] = (half_t)(t[e] * sc);
          *(half8*)(RW + ((size_t)r * 4 + 3) * 512 + 8 * lane) = h; }
    }
}

__device__ __forceinline__ void ph_wy(const Params& p, LAS unsigned char* lds) {
    const int tid = tid_fresh();
    LAS half_t* kh = (LAS half_t*)lds;
    LAS half_t* qh = kh + 64 * 136;
    LAS float* KK = (LAS float*)(qh + 64 * 136);
    LAS float* QK = KK + 64 * 65;
    LAS float* Lm = QK + 64 * 65;
    LAS float* Xs = Lm + 2 * 64 * 65;
    LAS float* Gs = Xs + 2 * 64 * 65;
    LAS float* Bs = Gs + 128;
    const half_t* GQKV = (const half_t*)(p.ws + OFF_GQKV); const float* GBG = (const float*)(p.ws + OFF_GBG);
    half_t* GTA = (half_t*)(p.ws + OFF_GTA); float* GG = (float*)(p.ws + OFF_GG);
    for (int item = blockIdx.x; item < (RG / 64) * 4; item += gridDim.x) {
        const int cidx = item >> 2, h = item & 3, r0 = cidx * 64;
        for (int v = tid; v < 1024; v += NT) { const int row = v >> 4, c8 = (v & 15) * 8;
            *(LAS half8*)(kh + row * 136 + c8) = *(const half8*)(GQKV + (size_t)(r0 + row) * 1536 + 512 + h * 128 + c8);
            *(LAS half8*)(qh + row * 136 + c8) = *(const half8*)(GQKV + (size_t)(r0 + row) * 1536 + h * 128 + c8); }
        if (tid < 128) { const int d = tid >> 6, i = tid & 63, nat = d ? 63 - i : i;
            Bs[d * 64 + i] = GBG[(size_t)(r0 + nat) * 16 + d * 4 + h]; Gs[d * 64 + i] = GBG[(size_t)(r0 + nat) * 16 + 8 + d * 4 + h]; }
        SYNC();
        if (tid == 0 || tid == 64) { const int d = tid >> 6; float c = 0.f; for (int i = 0; i < 64; ++i) { c += Gs[d * 64 + i]; Gs[d * 64 + i] = c; } }
        { const int i = tid >> 3, j0 = (tid & 7) * 8; float kk[8], qk[8];
#pragma unroll
          for (int jj = 0; jj < 8; ++jj) { kk[jj] = 0.f; qk[jj] = 0.f; }
          for (int c = 0; c < 128; ++c) { const float ki = (float)kh[i * 136 + c], qi = (float)qh[i * 136 + c];
#pragma unroll
              for (int jj = 0; jj < 8; ++jj) { const float kj = (float)kh[(j0 + jj) * 136 + c]; kk[jj] += ki * kj; qk[jj] += qi * kj; } }
#pragma unroll
          for (int jj = 0; jj < 8; ++jj) { KK[i * 65 + j0 + jj] = kk[jj]; QK[i * 65 + j0 + jj] = qk[jj]; } }
        SYNC();
#pragma unroll 1
        for (int t = 0; t < 16; ++t) { const int idx = tid + NT * t, d = idx >> 12, i = (idx >> 6) & 63, j = idx & 63;
            const int ni = d ? 63 - i : i, nj = d ? 63 - j : j;
            Lm[d * 4160 + i * 65 + j] = (j < i) ? Bs[d * 64 + i] * KK[ni * 65 + nj] * expf(Gs[d * 64 + i] - Gs[d * 64 + j]) : 0.f; }
        SYNC();
        if (tid < 128) { const int d = tid >> 6, j = tid & 63; const LAS float* L = Lm + d * 4160; LAS float* X = Xs + d * 4160;
#pragma unroll 1
            for (int bi = 0; bi < 4; ++bi) {
                const LAS float* Lb = L + bi * 16 * 65; float a[16];
#pragma unroll
                for (int ii = 0; ii < 16; ++ii) a[ii] = (bi * 16 + ii == j) ? 1.f : 0.f;
                for (int m = 0; m < bi * 16; ++m) { const float xm = X[m * 65 + j];
#pragma unroll
                    for (int ii = 0; ii < 16; ++ii) a[ii] -= Lb[ii * 65 + m] * xm; }
#pragma unroll
                for (int ii = 0; ii < 16; ++ii) { float sacc = a[ii];
#pragma unroll
                    for (int mm = 0; mm < ii; ++mm) sacc -= Lb[ii * 65 + bi * 16 + mm] * a[mm];
                    a[ii] = sacc; }
#pragma unroll
                for (int ii = 0; ii < 16; ++ii) X[(bi * 16 + ii) * 65 + j] = a[ii];
            } }
        SYNC();
#pragma unroll 1
        for (int t = 0; t < 4; ++t) { const int v = tid + NT * t, mat = v >> 9, w = v & 511, i = w >> 3, j8 = (w & 7) * 8, d = mat >> 1, which = mat & 1;
            half8 o;
#pragma unroll
            for (int e = 0; e < 8; ++e) { const int j = j8 + e; float val;
                if (which == 0) val = Xs[d * 4160 + i * 65 + j];
                else { const int ni = d ? 63 - i : i, nj = d ? 63 - j : j; val = (j <= i) ? QK[ni * 65 + nj] * expf(Gs[d * 64 + i] - Gs[d * 64 + j]) : 0.f; }
                o[e] = (half_t)val; }
            *(half8*)(GTA + ((size_t)((cidx * 4 + h) * 2 + d) * 2 + which) * 4096 + i * 64 + j8) = o; }
        if (tid < 128) GG[(size_t)((cidx * 4 + h) * 2 + (tid >> 6)) * 64 + (tid & 63)] = Gs[tid];
        SYNC();
    }
}

__device__ __forceinline__ void scan_gdn(const Params& p, int item, LAS unsigned char* lds) {
    const int tid = tid_fresh();
    const int sl = item & 3, d = (item >> 2) & 1, h = (item >> 3) & 3, bl = item >> 5, c0 = sl * 32;
    LAS float* bufA = (LAS float*)lds;
    LAS float* bufK = bufA + 64 * 68;
    LAS float* bufW = bufK + 64 * 132;
    LAS float* S = bufW + 64 * 132;
    LAS float* U = S + 128 * 36;
    LAS float* VN = U + 64 * 36;
    LAS float* VB = VN + 64 * 36;
    LAS float* Gs = VB + 64 * 36;
    LAS float* Bs = Gs + 64;
    const half_t* GQKV = (const half_t*)(p.ws + OFF_GQKV); const float* GBG = (const float*)(p.ws + OFF_GBG);
    const half_t* GTA = (const half_t*)(p.ws + OFF_GTA); const float* GG = (const float*)(p.ws + OFF_GG);
    half_t* SOG = (half_t*)(p.ws + OFF_SOG) + (size_t)d * RGP * 512;
    for (int i = tid; i < 128 * 36; i += NT) S[i] = 0.f;
    SYNC();
    const int nchC = CTXL / 64, nchL = SEQ / 64;
    for (int cs = 0; cs < nchC + nchL; ++cs) {
        const bool isc = cs < nchC; const int cl = isc ? cs : cs - nchC, nch = isc ? nchC : nchL;
        const int cn = d ? nch - 1 - cl : cl;
        const int r0 = (isc ? RL + bl * CTXL : bl * SEQ) + cn * 64, cidx = r0 / 64;
        const size_t tb = (size_t)((cidx * 4 + h) * 2 + d);
        if (tid < 64) { Gs[tid] = GG[tb * 64 + tid]; const int nat = d ? 63 - tid : tid; Bs[tid] = GBG[(size_t)(r0 + nat) * 16 + d * 4 + h]; }
        SYNC();
        for (int v = tid; v < 512; v += NT) { const int i = v >> 3, j8 = (v & 7) * 8; const half8 t = *(const half8*)(GTA + (tb * 2 + 0) * 4096 + i * 64 + j8);
#pragma unroll
            for (int e = 0; e < 8; ++e) bufA[i * 68 + j8 + e] = (float)t[e]; }
        for (int v = tid; v < 1024; v += NT) { const int i = v >> 4, c8 = (v & 15) * 8, nat = d ? 63 - i : i; const float sc = Bs[i] * expf(Gs[i]);
            const half8 t = *(const half8*)(GQKV + (size_t)(r0 + nat) * 1536 + 512 + h * 128 + c8);
#pragma unroll
            for (int e = 0; e < 8; ++e) bufK[i * 132 + c8 + e] = (float)t[e] * sc; }
        if (tid < 256) { const int i = tid >> 2, c8 = (tid & 3) * 8, nat = d ? 63 - i : i; const half8 t = *(const half8*)(GQKV + (size_t)(r0 + nat) * 1536 + 1024 + h * 128 + c0 + c8);
#pragma unroll
            for (int e = 0; e < 8; ++e) VB[i * 36 + c8 + e] = (float)t[e] * Bs[i]; }
        SYNC();
        { const int i = tid >> 3, cg = (tid & 7) * 16; float a[16];
#pragma unroll
          for (int e = 0; e < 16; ++e) a[e] = 0.f;
          for (int j = 0; j < 64; ++j) { const float t = bufA[i * 68 + j];
#pragma unroll
              for (int e = 0; e < 16; ++e) a[e] += t * bufK[j * 132 + cg + e]; }
#pragma unroll
          for (int e = 0; e < 16; ++e) bufW[i * 132 + cg + e] = a[e]; }
        { const int i = tid >> 3, c4 = (tid & 7) * 4; float a[4] = {0.f, 0.f, 0.f, 0.f};
          for (int j = 0; j < 64; ++j) { const float t = bufA[i * 68 + j];
#pragma unroll
              for (int e = 0; e < 4; ++e) a[e] += t * VB[j * 36 + c4 + e]; }
#pragma unroll
          for (int e = 0; e < 4; ++e) U[i * 36 + c4 + e] = a[e]; }
        SYNC();
        { const int i = tid >> 3, c4 = (tid & 7) * 4; float a[4];
#pragma unroll
          for (int e = 0; e < 4; ++e) a[e] = U[i * 36 + c4 + e];
          for (int k = 0; k < 128; ++k) { const float w = bufW[i * 132 + k];
#pragma unroll
              for (int e = 0; e < 4; ++e) a[e] -= w * S[k * 36 + c4 + e]; }
#pragma unroll
          for (int e = 0; e < 4; ++e) VN[i * 36 + c4 + e] = a[e]; }
        SYNC();
        for (int v = tid; v < 512; v += NT) { const int i = v >> 3, j8 = (v & 7) * 8; const half8 t = *(const half8*)(GTA + (tb * 2 + 1) * 4096 + i * 64 + j8);
#pragma unroll
            for (int e = 0; e < 8; ++e) bufA[i * 68 + j8 + e] = (float)t[e]; }
        for (int v = tid; v < 1024; v += NT) { const int i = v >> 4, c8 = (v & 15) * 8, nat = d ? 63 - i : i; const float sc = expf(Gs[i]);
            const half8 t = *(const half8*)(GQKV + (size_t)(r0 + nat) * 1536 + h * 128 + c8);
#pragma unroll
            for (int e = 0; e < 8; ++e) bufK[i * 132 + c8 + e] = (float)t[e] * sc; }
        SYNC();
        { const int i = tid >> 3, c4 = (tid & 7) * 4, nat = d ? 63 - i : i; float a[4] = {0.f, 0.f, 0.f, 0.f};
          for (int k = 0; k < 128; ++k) { const float w = bufK[i * 132 + k];
#pragma unroll
              for (int e = 0; e < 4; ++e) a[e] += w * S[k * 36 + c4 + e]; }
          for (int j = 0; j < 64; ++j) { const float t = bufA[i * 68 + j];
#pragma unroll
              for (int e = 0; e < 4; ++e) a[e] += t * VN[j * 36 + c4 + e]; }
          half4 o;
#pragma unroll
          for (int e = 0; e < 4; ++e) o[e] = (half_t)a[e];
          *(half4*)(SOG + (size_t)(r0 + nat) * 512 + h * 128 + c0 + c4) = o; }
        SYNC();
        for (int v = tid; v < 1024; v += NT) { const int i = v >> 4, c8 = (v & 15) * 8, nat = d ? 63 - i : i; const float sc = expf(Gs[63] - Gs[i]);
            const half8 t = *(const half8*)(GQKV + (size_t)(r0 + nat) * 1536 + 512 + h * 128 + c8);
#pragma unroll
            for (int e = 0; e < 8; ++e) bufK[i * 132 + c8 + e] = (float)t[e] * sc; }
        SYNC();
        { const int k = tid >> 2, c8 = (tid & 3) * 8; const float dec = expf(Gs[63]); float a[8];
#pragma unroll
          for (int e = 0; e < 8; ++e) a[e] = S[k * 36 + c8 + e] * dec;
          for (int i = 0; i < 64; ++i) { const float w = bufK[i * 132 + k];
#pragma unroll
              for (int e = 0; e < 8; ++e) a[e] += w * VN[i * 36 + c8 + e]; }
#pragma unroll
          for (int e = 0; e < 8; ++e) S[k * 36 + c8 + e] = a[e]; }
        SYNC();
    }
}

__device__ __forceinline__ void scan_mlstm(const Params& p, int l, int item, LAS unsigned char* lds) {
    const int tid = tid_fresh();
    const int sl = item & 1, d = (item >> 1) & 1, h = (item >> 2) & 3, bl = item >> 4, c0 = sl * 64;
    LAS float* q = (LAS float*)lds;
    LAS float* k = q + 64 * 68;
    LAS float* v = k + 64 * 68;
    LAS float* Pm = v + 64 * 68;
    LAS float* C = Pm + 64 * 68;
    LAS float* nv = C + 64 * 68;
    LAS float* bc = nv + 64;
    LAS float* ig = bc + 64;
    LAS float* mt = ig + 64;
    LAS float* inter = mt + 64;
    LAS float* den = inter + 64;
    LAS float* wsc = den + 64;
    const half_t* P = (const half_t*)(p.ws + OFF_P);
    half_t* SOM = (half_t*)(p.ws + OFF_SOM) + (size_t)d * RGP * 512;
    const float ibias = p.in[I_MIB][l * 8 + d * 4 + h], fbias = p.in[I_MFB][l * 8 + d * 4 + h];
    for (int i = tid; i < 64 * 68; i += NT) C[i] = 0.f;
    if (tid < 64) nv[tid] = 0.f;
    float m = 0.f;
    SYNC();
    const int nchC = CTXL / 64, nchL = SEQ / 64;
    for (int cs = 0; cs < nchC + nchL; ++cs) {
        const bool isc = cs < nchC; const int cl = isc ? cs : cs - nchC, nch = isc ? nchC : nchL;
        const int cn = d ? nch - 1 - cl : cl;
        const int r0 = (isc ? RL + bl * CTXL : bl * SEQ) + cn * 64;
        { const int i = tid >> 3, c8 = (tid & 7) * 8, nat = d ? 63 - i : i; const half_t* pr = P + (size_t)(r0 + nat) * NP + C_ML;
          const half8 tq = *(const half8*)(pr + h * 64 + c8), tk = *(const half8*)(pr + 256 + h * 64 + c8), tv = *(const half8*)(pr + 512 + h * 128 + c0 + c8);
#pragma unroll
          for (int e = 0; e < 8; ++e) { q[i * 68 + c8 + e] = (float)tq[e] * 0.125f; k[i * 68 + c8 + e] = (float)tk[e]; v[i * 68 + c8 + e] = (float)tv[e]; } }
        if (tid < 64) { const int nat = d ? 63 - tid : tid; const half_t* pr = P + (size_t)(r0 + nat) * NP;
            ig[tid] = (float)pr[C_MLIG + d * 4 + h] + ibias; bc[tid] = -softplusf(-((float)pr[C_MLFG + d * 4 + h] + fbias)); }
        SYNC();
        if (tid == 0) { float c = 0.f; for (int i = 0; i < 64; ++i) { c += bc[i]; bc[i] = c; } }
        { const int i = tid >> 3, j0 = (tid & 7) * 8; float a[8];
#pragma unroll
          for (int e = 0; e < 8; ++e) a[e] = 0.f;
          for (int c = 0; c < 64; ++c) { const float qi = q[i * 68 + c];
#pragma unroll
              for (int e = 0; e < 8; ++e) a[e] += qi * k[(j0 + e) * 68 + c]; }
#pragma unroll
          for (int e = 0; e < 8; ++e) Pm[i * 68 + j0 + e] = a[e]; }
        SYNC();
        if (tid < 64) { const int i = tid; float mi = -INFINITY; for (int j = 0; j <= i; ++j) mi = fmaxf(mi, bc[i] - bc[j] + ig[j]);
            const float mm = fmaxf(bc[i] + m, mi); mt[i] = mm; inter[i] = expf(bc[i] + m - mm); }
        SYNC();
        { const int i = tid >> 3, j0 = (tid & 7) * 8;
#pragma unroll
          for (int e = 0; e < 8; ++e) { const int j = j0 + e; Pm[i * 68 + j] = (j <= i) ? Pm[i * 68 + j] * expf(bc[i] - bc[j] + ig[j] - mt[i]) : 0.f; } }
        SYNC();
        if (tid < 64) { const int i = tid; float s1 = 0.f, s2 = 0.f; for (int c = 0; c < 64; ++c) s1 += q[i * 68 + c] * nv[c]; for (int j = 0; j < 64; ++j) s2 += Pm[i * 68 + j];
            den[i] = inter[i] * s1 + s2; }
        SYNC();
        { const int i = tid >> 3, c8 = (tid & 7) * 8, nat = d ? 63 - i : i; float a[8], b[8];
#pragma unroll
          for (int e = 0; e < 8; ++e) { a[e] = 0.f; b[e] = 0.f; }
          for (int c = 0; c < 64; ++c) { const float qi = q[i * 68 + c], pj = Pm[i * 68 + c];
#pragma unroll
              for (int e = 0; e < 8; ++e) { a[e] += qi * C[c * 68 + c8 + e]; b[e] += pj * v[c * 68 + c8 + e]; } }
          const float dn = 1.f / fmaxf(fabsf(den[i]), expf(-mt[i])); half8 o;
#pragma unroll
          for (int e = 0; e < 8; ++e) o[e] = (half_t)((inter[i] * a[e] + b[e]) * dn);
          *(half8*)(SOM + (size_t)(r0 + nat) * 512 + h * 128 + c0 + c8) = o; }
        float mx = -INFINITY; for (int j = 0; j < 64; ++j) mx = fmaxf(mx, bc[63] - bc[j] + ig[j]);
        const float m_new = fmaxf(bc[63] + m, mx), dec = expf(bc[63] + m - m_new);
        SYNC();
        if (tid < 64) wsc[tid] = expf(bc[63] - bc[tid] + ig[tid] - m_new);
        SYNC();
        { const int kk = tid >> 3, c8 = (tid & 7) * 8; float a[8];
#pragma unroll
          for (int e = 0; e < 8; ++e) a[e] = C[kk * 68 + c8 + e] * dec;
          for (int j = 0; j < 64; ++j) { const float w = k[j * 68 + kk] * wsc[j];
#pragma unroll
              for (int e = 0; e < 8; ++e) a[e] += w * v[j * 68 + c8 + e]; }
#pragma unroll
          for (int e = 0; e < 8; ++e) C[kk * 68 + c8 + e] = a[e]; }
        if (tid < 64) { float s = nv[tid] * dec; for (int j = 0; j < 64; ++j) s += k[j * 68 + tid] * wsc[j]; nv[tid] = s; }
        m = m_new;
        SYNC();
    }
}

__device__ __forceinline__ void scan_rwkv(const Params& p, int l, int item, LAS unsigned char* lds) {
    const int tid = tid_fresh(), wid = tid >> 6, lane = tid & 63;
    const int d = item & 1, h = (item >> 1) & 7, bl = item >> 4;
    constexpr int NB = 16;
    LAS float* st = (LAS float*)lds;
    const half_t* RW = (const half_t*)(p.ws + OFF_RW); const half_t* RLO = (const half_t*)(p.ws + OFF_RLO);
    float* SOR = (float*)(p.ws + OFF_SOR) + (size_t)d * RGP * 512;
    const float* ka = p.in[I_RKA] + (size_t)l * 512 + h * 64;
    const int rr = 8 * wid + (lane >> 3), ks = lane & 7;
    float s[8];
#pragma unroll
    for (int e = 0; e < 8; ++e) s[e] = 0.f;
    for (int stream = 0; stream < 2; ++stream) {
        const int T = stream == 0 ? CTXL : SEQ, rbase = stream == 0 ? RL + bl * CTXL : bl * SEQ;
        for (int t0 = 0; t0 < T; t0 += NB) {
            SYNC();
            for (int v = tid; v < NB * 64; v += NT) { const int t = v >> 6, ch = v & 63, c = h * 64 + ch; const int step = t0 + t; const size_t row = (size_t)(rbase + (d ? T - 1 - step : step));
                const float r_ = (float)RW[(row * 4 + 0) * 512 + c], k_ = (float)RW[(row * 4 + 1) * 512 + c], v_ = (float)RW[(row * 4 + 2) * 512 + c], kk = (float)RW[(row * 4 + 3) * 512 + c];
                const float e_ = (float)RLO[row * 2560 + d * 512 + c], a_ = (float)RLO[row * 2560 + 1024 + d * 512 + c];
                LAS float* o = st + t * 384 + ch;
                o[0] = r_; o[64] = expf(-e_); o[128] = k_ * (1.f + (a_ - 1.f) * ka[ch]); o[192] = v_; o[256] = -kk; o[320] = kk * a_; }
            SYNC();
            for (int t = 0; t < NB; ++t) {
                const LAS float* o = st + t * 384 + 8 * ks;
                float sa = 0.f;
#pragma unroll
                for (int e = 0; e < 8; ++e) sa += s[e] * o[256 + e];
                sa += SHFL_XOR(sa, 1); sa += SHFL_XOR(sa, 2); sa += SHFL_XOR(sa, 4);
                const float vv = st[t * 384 + 192 + rr];
                float y = 0.f;
#pragma unroll
                for (int e = 0; e < 8; ++e) { s[e] = s[e] * o[64 + e] + sa * o[320 + e] + vv * o[128 + e]; y += s[e] * o[e]; }
                y += SHFL_XOR(y, 1); y += SHFL_XOR(y, 2); y += SHFL_XOR(y, 4);
                if (ks == 0) { const int step = t0 + t; const size_t row = (size_t)(rbase + (d ? T - 1 - step : step)); SOR[row * 512 + h * 64 + rr] = y; }
            }
        }
    }
    SYNC();
}

__device__ __forceinline__ void ph_scan(const Params& p, int l, LAS unsigned char* lds) {
    constexpr int N_R = BG * 16, N_G = BG * 32, N_M = BG * 16;
    const int G = gridDim.x, c = blockIdx.x;
    if (!(SKIP_MASK & 65536)) for (int item = c; item < N_R; item += G) { scan_rwkv(p, l, item, lds); SYNC(); }
    if (!(SKIP_MASK & 131072)) for (int item = N_R + (((c - N_R) % G) + G) % G; item < N_R + N_G; item += G) { scan_gdn(p, item - N_R, lds); SYNC(); }
    if (!(SKIP_MASK & 262144)) for (int item = N_R + N_G + (((c - N_R - N_G) % G) + G) % G; item < N_R + N_G + N_M; item += G) { scan_mlstm(p, l, item - N_R - N_G, lds); SYNC(); }
}

__device__ __forceinline__ void ph_finish(const Params& p, int l, int nrows) {
    const int tid = tid_fresh(), wid = tid >> 6, lane = tid & 63, c = 8 * lane;
    const half_t* P = (const half_t*)(p.ws + OFF_P); const half_t* RW = (const half_t*)(p.ws + OFF_RW); const half_t* RLO = (const half_t*)(p.ws + OFF_RLO);
    const half_t* SOG = (const half_t*)(p.ws + OFF_SOG); const half_t* SOM = (const half_t*)(p.ws + OFF_SOM); const float* SOR = (const float*)(p.ws + OFF_SOR);
    half_t* BR = (half_t*)(p.ws + OFF_BR);
    for (int r = blockIdx.x * 8 + wid; r < nrows; r += gridDim.x * 8) {
        { const half8 o0 = *(const half8*)(SOG + (size_t)r * 512 + c), o1 = *(const half8*)(SOG + ((size_t)RGP + r) * 512 + c), z = *(const half8*)(P + (size_t)r * NP + C_Z + c);
          float o[8], ss = 0.f;
#pragma unroll
          for (int e = 0; e < 8; ++e) { o[e] = (float)o0[e] + (float)o1[e]; ss += o[e] * o[e]; }
          ss += SHFL_XOR(ss, 1); ss += SHFL_XOR(ss, 2); ss += SHFL_XOR(ss, 4); ss += SHFL_XOR(ss, 8);
          const float rinv = rsqrtf(ss * (1.f / 128.f) + 1e-6f); const float* gn = p.in[I_GNG] + l * 128 + (c & 127); half8 out;
#pragma unroll
          for (int e = 0; e < 8; ++e) out[e] = (half_t)(o[e] * rinv * gn[e] * siluf((float)z[e]));
          *(half8*)(BR + (size_t)r * 512 + c) = out; }
        { float y[8], sm = 0.f;
#pragma unroll
          for (int e = 0; e < 8; ++e) { y[e] = SOR[(size_t)r * 512 + c + e] + SOR[((size_t)RGP + r) * 512 + c + e]; sm += y[e]; }
          sm += SHFL_XOR(sm, 1); sm += SHFL_XOR(sm, 2); sm += SHFL_XOR(sm, 4); const float mean = sm * (1.f / 64.f);
          float vs = 0.f;
#pragma unroll
          for (int e = 0; e < 8; ++e) { const float dlt = y[e] - mean; vs += dlt * dlt; }
          vs += SHFL_XOR(vs, 1); vs += SHFL_XOR(vs, 2); vs += SHFL_XOR(vs, 4); const float rinv = rsqrtf(vs * (1.f / 64.f) + 64e-5f);
          const half8 rv = *(const half8*)(RW + ((size_t)r * 4 + 0) * 512 + c), kv = *(const half8*)(RW + ((size_t)r * 4 + 1) * 512 + c), vv = *(const half8*)(RW + ((size_t)r * 4 + 2) * 512 + c);
          const half8 a0 = *(const half8*)(RLO + (size_t)r * 2560 + 1024 + c), a1 = *(const half8*)(RLO + (size_t)r * 2560 + 1536 + c), gg = *(const half8*)(RLO + (size_t)r * 2560 + 2048 + c);
          const float* ka = p.in[I_RKA] + (size_t)l * 512 + c; const float* rk = p.in[I_RRK] + (size_t)l * 512 + c;
          float bc = 0.f;
#pragma unroll
          for (int e = 0; e < 8; ++e) bc += (float)rv[e] * (float)kv[e] * (2.f + ((float)a0[e] + (float)a1[e] - 2.f) * ka[e]) * rk[e];
          bc += SHFL_XOR(bc, 1); bc += SHFL_XOR(bc, 2); bc += SHFL_XOR(bc, 4);
          const float* lg = p.in[I_RLNG] + (size_t)l * 512 + c; const float* lb = p.in[I_RLNB] + (size_t)l * 512 + c; half8 out;
#pragma unroll
          for (int e = 0; e < 8; ++e) out[e] = (half_t)(((y[e] - mean) * rinv * lg[e] + lb[e] + bc * (float)vv[e]) * (float)gg[e]);
          *(half8*)(BR + ((size_t)RGP + r) * 512 + c) = out; }
        { const half8 h0 = *(const half8*)(SOM + (size_t)r * 512 + c), h1 = *(const half8*)(SOM + ((size_t)RGP + r) * 512 + c), og = *(const half8*)(P + (size_t)r * NP + C_MLO + c);
          float o[8], ss = 0.f;
#pragma unroll
          for (int e = 0; e < 8; ++e) { o[e] = (float)h0[e] + (float)h1[e]; ss += o[e] * o[e]; }
          ss += SHFL_XOR(ss, 1); ss += SHFL_XOR(ss, 2); ss += SHFL_XOR(ss, 4); ss += SHFL_XOR(ss, 8);
          const float rinv = rsqrtf(ss * (1.f / 128.f) + 1e-6f); const float* gn = p.in[I_MNG] + l * 128 + (c & 127); half8 out;
#pragma unroll
          for (int e = 0; e < 8; ++e) out[e] = (half_t)(o[e] * rinv * gn[e] * (float)og[e]);
          *(half8*)(BR + ((size_t)2 * RGP + r) * 512 + c) = out; }
    }
}

__device__ __forceinline__ void ph_norm2(const Params& p, int l, int g, int nrows, LAS unsigned char* lds) {
    const int tid = tid_fresh(), wid = tid >> 6, lane = tid & 63;
    LAS float* rw = (LAS float*)lds;
    for (int i = tid; i < 1024 * 16; i += NT) rw[i] = p.in[I_ROUT][(size_t)l * 1024 * 16 + i];
    SYNC();
    half_t* H = (half_t*)(p.ws + OFF_H); float* PROB = (float*)(p.ws + OFF_PROB);
    for (int r = blockIdx.x * 8 + wid; r < nrows; r += gridDim.x * 8) {
        const float* xr = res_dst(p, g, r); const float* md = mod_row(p, l, g, r); const float* gn = p.in[I_N2G] + l * D;
        float ss = 0.f;
#pragma unroll
        for (int j = 0; j < 4; ++j) { const f32x4 v = *(const f32x4*)(xr + lane * 4 + 256 * j); ss += v[0] * v[0] + v[1] * v[1] + v[2] * v[2] + v[3] * v[3]; }
        ss = wave_sum(ss); const float rinv = rsqrtf(ss * (1.f / D) + 1e-6f);
        float lg[16];
#pragma unroll
        for (int e = 0; e < 16; ++e) lg[e] = 0.f;
#pragma unroll 1
        for (int j = 0; j < 4; ++j) { const int c = lane * 4 + 256 * j; half4 hh; const f32x4 v = *(const f32x4*)(xr + c);
#pragma unroll
            for (int i = 0; i < 4; ++i) { const float hv = v[i] * rinv * gn[c + i] * (1.f + md[4 * 1024 + c + i]) + md[3 * 1024 + c + i]; hh[i] = (half_t)hv;
#pragma unroll
                for (int e = 0; e < 16; ++e) lg[e] += hv * rw[(c + i) * 16 + e]; }
            *(half4*)(H + (size_t)r * D + c) = hh; }
        float mx = -INFINITY;
#pragma unroll
        for (int e = 0; e < 16; ++e) { lg[e] = wave_sum(lg[e]); mx = fmaxf(mx, lg[e]); }
        float sum = 0.f;
#pragma unroll
        for (int e = 0; e < 16; ++e) { lg[e] = expf(lg[e] - mx); sum += lg[e]; }
        const float inv = 1.f / sum;
#pragma unroll
        for (int e = 0; e < 16; ++e) if (lane == e) PROB[(size_t)r * 16 + e] = lg[e] * inv;
    }
}

__device__ __forceinline__ void ph_topk(const Params& p, int nstreams, LAS unsigned char* lds) {
    const int tid = tid_fresh();
    LAS unsigned* pv = (LAS unsigned*)lds;
    LAS unsigned* hist = pv + (SEQ > CTXL ? SEQ : CTXL);
    LAS int* eqc = (LAS int*)(hist + 256);
    LAS int* gtc = eqc + 512;
    LAS int* posx = gtc + 512;
    LAS int* selrows = posx + 512;
    LAS unsigned* sh = (LAS unsigned*)(selrows + (CAPL > CAPC ? CAPL : CAPC));
    const float* PROB = (const float*)(p.ws + OFF_PROB); int* SLOT = (int*)(p.ws + OFF_SLOT); int* SEL = (int*)(p.ws + OFF_SEL); float* AFF = (float*)(p.ws + OFF_AFF);
    const half_t* H = (const half_t*)(p.ws + OFF_H); half_t* XE = (half_t*)(p.ws + OFF_XE);
    for (int item = blockIdx.x; item < nstreams * BG * 16; item += gridDim.x) {
        const int e = item & 15, bl = (item >> 4) % BG, stc = (item >> 4) / BG;
        const int n = stc ? CTXL : SEQ, cap = n / 8, row0 = stc ? RL + bl * CTXL : bl * SEQ, slot0 = stc ? BG * CAPL + bl * CAPC : bl * CAPL;
        for (int i = tid; i < n; i += NT) pv[i] = __float_as_uint(PROB[(size_t)(row0 + i) * 16 + e]);
        unsigned prefix = 0u, mask = 0u; int kth = cap;
        for (int pass = 3; pass >= 0; --pass) {
            if (tid < 256) hist[tid] = 0u;
            SYNC();
            for (int i = tid; i < n; i += NT) { const unsigned v = pv[i]; if ((v & mask) == prefix) LDS_ATOMIC_INC(&hist[(v >> (8 * pass)) & 255u]); }
            SYNC();
            if (tid == 0) { int cum = 0, b = 255; for (; b > 0; --b) { if (cum + (int)hist[b] >= kth) break; cum += (int)hist[b]; } sh[0] = (unsigned)b; sh[1] = (unsigned)(kth - cum); }
            SYNC();
            prefix |= sh[0] << (8 * pass); mask |= 0xFFu << (8 * pass); kth = (int)sh[1];
            SYNC();
        }
        const unsigned thr = prefix; const int need_eq = kth;
        const int per = (n + NT - 1) / NT, i0 = tid * per, i1 = (i0 + per < n) ? i0 + per : n;
        { int ce = 0, cg = 0; for (int i = i0; i < i1; ++i) { const unsigned v = pv[i]; ce += (v == thr); cg += (v > thr); } eqc[tid] = ce; gtc[tid] = cg; }
        SYNC();
        if (tid == 0) { int eq = 0, pos = 0; for (int t = 0; t < NT; ++t) { const int ce = eqc[t]; int take = need_eq - eq; take = take < 0 ? 0 : (take > ce ? ce : take);
                const int selc = gtc[t] + take; eqc[t] = eq; posx[t] = pos; eq += ce; pos += selc; } }
        SYNC();
        { int eqr = eqc[tid], pos = posx[tid];
          for (int i = i0; i < i1; ++i) { const unsigned v = pv[i]; const bool sel = v > thr || (v == thr && eqr < need_eq); if (v == thr) ++eqr; const int row = row0 + i;
              if (sel) { const int slot = slot0 + pos; SEL[e * RPE + slot] = row; AFF[e * RPE + slot] = __uint_as_float(v); SLOT[(size_t)row * 16 + e] = slot; selrows[pos] = row; ++pos; }
              else SLOT[(size_t)row * 16 + e] = -1; } }
        SYNC();
        for (int idx = tid; idx < cap * 128; idx += NT) { const int j = idx >> 7, v16 = idx & 127;
            *(half8*)(XE + ((size_t)e * RPE + slot0 + j) * 1024 + v16 * 8) = *(const half8*)(H + (size_t)selrows[j] * 1024 + v16 * 8); }
        SYNC();
    }
}

__device__ __forceinline__ void ph_combine(const Params& p, int l, int g, int nrows) {
    const int tid = tid_fresh(), wid = tid >> 6, lane = tid & 63;
    const int* SLOT = (const int*)(p.ws + OFF_SLOT); const half_t* YE = (const half_t*)(p.ws + OFF_YE);
    for (int r = blockIdx.x * 8 + wid; r < nrows; r += gridDim.x * 8) {
        float* xr = res_dst(p, g, r); const float* md = mod_row(p, l, g, r) + 5 * 1024;
        float acc[2][8];
#pragma unroll
        for (int j = 0; j < 2; ++j)
#pragma unroll
            for (int e = 0; e < 8; ++e) acc[j][e] = 0.f;
        for (int ex = 0; ex < 16; ++ex) { const int s = SLOT[(size_t)r * 16 + ex]; if (s < 0) continue;
#pragma unroll
            for (int j = 0; j < 2; ++j) { const half8 y = *(const half8*)(YE + ((size_t)ex * RPE + s) * 1024 + 8 * lane + 512 * j);
#pragma unroll
                for (int e = 0; e < 8; ++e) acc[j][e] += (float)y[e]; } }
        float xv[2][8], ss = 0.f;
#pragma unroll
        for (int j = 0; j < 2; ++j)
#pragma unroll
            for (int e = 0; e < 8; ++e) { const int c = 8 * lane + 512 * j + e; xv[j][e] = xr[c] + md[c] * acc[j][e]; ss += xv[j][e] * xv[j][e]; }
        if (l == DEPTH - 1) { ss = wave_sum(ss); const float rinv = rsqrtf(ss * (1.f / D) + 1e-6f);
#pragma unroll
            for (int j = 0; j < 2; ++j)
#pragma unroll
                for (int e = 0; e < 8; ++e) { const int c = 8 * lane + 512 * j + e; xv[j][e] = xv[j][e] * rinv * p.in[I_FING][c]; } }
#pragma unroll
        for (int j = 0; j < 2; ++j) { *(f32x4*)(xr + 8 * lane + 512 * j) = (f32x4){xv[j][0], xv[j][1], xv[j][2], xv[j][3]}; *(f32x4*)(xr + 8 * lane + 512 * j + 4) = (f32x4){xv[j][4], xv[j][5], xv[j][6], xv[j][7]}; }
    }
}

#ifndef EMU_DUMP
#define EMU_DUMP(tag)
#endif
#ifndef CPU_EMU
extern __shared__ __attribute__((aligned(16))) unsigned char smem_raw[];
__global__ void __launch_bounds__(NT, 2) mega(Params p)
#else
void mega(Params p)
#endif
{
#ifndef CPU_EMU
    LAS unsigned char* lds = (LAS unsigned char*)smem_raw;
    volatile LAS unsigned* xbw = (volatile LAS unsigned*)(lds + SMEM_BYTES - 16);
    if (threadIdx.x == 0) { xbw[0] = 0u; xbw[1] = 0u; xbw[2] = 0u; xbw[3] = 0u; }
    __syncthreads();
    (void)xcd_barrier_post((unsigned*)(p.ws + OFF_BAR), xbw);
#else
    unsigned char* lds = emu_smem();
#endif
    const int G = gridDim.x, c = blockIdx.x;
    half_t* ws16 = nullptr; (void)ws16;
    if (!(SKIP_MASK & 1)) ph_mod(p, lds);
    if (!(SKIP_MASK & 2)) ph_convert(p, 0, lds);
    GRID_SYNC();
    for (int l = 0; l < DEPTH; ++l) {
        const bool last = (l == DEPTH - 1);
        const int nact = last ? RL : RG;
        const int nactp = last ? RL : RGP;
        for (int g = 0; g < NGROUP; ++g) {
            if (!(SKIP_MASK & 4)) ph_norm1(p, l, g);
            GRID_SYNC(); EMU_DUMP("norm1");
            if (!(SKIP_MASK & 8)) { pg8::StaticOrder S; S.init(RGP / 256, NP / 256, G, c); EpiP E{(half_t*)(p.ws + OFF_P)};
              pg8::gemm_phase(lds, pg8::Gemm{(const half_t*)(p.ws + OFF_H), (const half_t*)(p.ws + OFF_WIN), 1024}, S, E); }
            GRID_SYNC(); EMU_DUMP("gemm_in");
            if (!(SKIP_MASK & 16)) ph_prep(p, l, lds);
            GRID_SYNC(); EMU_DUMP("prep");
            if (!(SKIP_MASK & 32)) { pg8::StaticOrder S; S.init(RGP / 256, 10, G, c); EpiLora E{(half_t*)(p.ws + OFF_RLO), p.in[I_RW0] + (size_t)l * 1024, p.in[I_RA0] + (size_t)l * 1024};
              pg8::gemm_phase(lds, pg8::Gemm{(const half_t*)(p.ws + OFF_RLI), (const half_t*)(p.ws + OFF_WLORA), 384}, S, E); }
            if (!(SKIP_MASK & 64)) ph_wy(p, lds);
            GRID_SYNC(); EMU_DUMP("wy");
            if (!(SKIP_MASK & 128)) ph_scan(p, l, lds);
            GRID_SYNC(); EMU_DUMP("scan");
            if (!(SKIP_MASK & 256)) ph_finish(p, l, nact);
            GRID_SYNC(); EMU_DUMP("finish");
            if (!(SKIP_MASK & 512))
#pragma unroll 1
            for (int bi = 0; bi < 3; ++bi) {
                pg8::StaticOrder S; S.init(nactp / 256, 4, G, c); EpiMerge E{(half_t*)(p.ws + OFF_H), (const half_t*)(p.ws + OFF_P), bi};
                pg8::gemm_phase(lds, pg8::Gemm{(const half_t*)(p.ws + OFF_BR) + (size_t)bi * RGP * 512, (const half_t*)(p.ws + OFF_WBR) + (size_t)bi * 1024 * 512, 512}, S, E);
            }
            GRID_SYNC(); EMU_DUMP("merge");
            if (!(SKIP_MASK & 1024)) { pg8::StaticOrder S; S.init(nactp / 256, 4, G, c); EpiOut E{p, l, g};
              pg8::gemm_phase(lds, pg8::Gemm{(const half_t*)(p.ws + OFF_H), (const half_t*)(p.ws + OFF_WOUT), 1024}, S, E); }
            GRID_SYNC(); EMU_DUMP("out");
            if (!(SKIP_MASK & 2048)) ph_norm2(p, l, g, nact, lds);
            GRID_SYNC(); EMU_DUMP("norm2");
            if (!(SKIP_MASK & 4096)) ph_topk(p, last ? 1 : 2, lds);
            GRID_SYNC(); EMU_DUMP("topk");
            if (!(SKIP_MASK & 8192)) { pg8::ExpertOrder S; S.init(G, c); EpiUp E{(half_t*)(p.ws + OFF_HID)};
              pg8::gemm_phase(lds, pg8::Gemm{(const half_t*)(p.ws + OFF_XE), (const half_t*)(p.ws + OFF_WUP), 1024}, S, E); }
            GRID_SYNC();
            if (!(SKIP_MASK & 16384)) { pg8::ExpertOrder S; S.init(G, c); EpiDown E{(half_t*)(p.ws + OFF_YE), (const float*)(p.ws + OFF_AFF)};
              pg8::gemm_phase(lds, pg8::Gemm{(const half_t*)(p.ws + OFF_HID), (const half_t*)(p.ws + OFF_WDN), 512}, S, E); }
            GRID_SYNC();
            if (!(SKIP_MASK & 32768)) ph_combine(p, l, g, nact);
            if (!(SKIP_MASK & 2)) if (g == NGROUP - 1 && !last) ph_convert(p, l + 1, lds);
            GRID_SYNC(); EMU_DUMP("combine");
        }
    }
}

#ifndef CPU_EMU
extern "C" void kernel_launch(void* const* d_in, const int* in_sizes, int n_in, void* d_out, int out_size, void* d_ws, size_t ws_size, hipStream_t stream) {
    (void)in_sizes; (void)n_in; (void)out_size;
    static int grid = 0;
    if (!grid) {
        int dev = 0, cus = 0, per_cu = 0;
        hipGetDevice(&dev);
        hipDeviceGetAttribute(&cus, hipDeviceAttributeMultiprocessorCount, dev);
        hipFuncSetAttribute((const void*)mega, hipFuncAttributeMaxDynamicSharedMemorySize, SMEM_BYTES);
        hipOccupancyMaxActiveBlocksPerMultiprocessor(&per_cu, (const void*)mega, NT, SMEM_BYTES);
        if (per_cu < 1) per_cu = 1;
        grid = cus;
        if (ws_size < WS_TOTAL) fprintf(stderr, "workspace too small: %zu < %zu\n", ws_size, (size_t)WS_TOTAL);
    }
    hipMemsetAsync((unsigned char*)d_ws + OFF_BAR, 0, 16384, stream);
    Params p{};
    for (int i = 0; i < 34; ++i) p.in[i] = (const float*)d_in[i];
    p.out = (float*)d_out; p.ws = (unsigned char*)d_ws;
    hipLaunchKernelGGL(mega, dim3(grid), dim3(NT), SMEM_BYTES, stream, p);
}
#endif
```

```cpp
#ifndef CPU_EMU
#include <hip/hip_runtime.h>
#include <cstdio>
#include <cstdint>
typedef _Float16 half_t;
typedef _Float16 half8 __attribute__((ext_vector_type(8)));
typedef _Float16 half4 __attribute__((ext_vector_type(4)));
typedef float f32x4 __attribute__((ext_vector_type(4)));
typedef float f32x2 __attribute__((ext_vector_type(2)));
#define LAS __attribute__((address_space(3)))
#define SYNC() __syncthreads()
#define WAVE_SYNC() __builtin_amdgcn_wave_barrier()
template <int M> __device__ __forceinline__ float shfl_xor_t(float v, int tid) {
    if constexpr (M < 32) return __int_as_float(__builtin_amdgcn_ds_swizzle(__float_as_int(v), (M << 10) | 0x1f));
    else return __int_as_float(__builtin_amdgcn_ds_bpermute(((tid ^ 32) & 63) << 2, __float_as_int(v)));
}
#define SHFL_XOR(v, m) shfl_xor_t<m>((v), tid)
#define LDS_ATOMIC_INC(p) __hip_atomic_fetch_add((p), 1u, __ATOMIC_RELAXED, __HIP_MEMORY_SCOPE_WORKGROUP)
#endif

#ifndef CFG_BATCH
#define CFG_BATCH 8
#define CFG_SEQ 4096
#define CFG_CTX 256
#define CFG_DEPTH 4
#define CFG_NGROUP 2
#endif
constexpr int BATCH = CFG_BATCH, SEQ = CFG_SEQ, CTXL = CFG_CTX, DEPTH = CFG_DEPTH, NGROUP = CFG_NGROUP;
#ifndef SKIP_MASK
#define SKIP_MASK 0
#endif
#ifndef REPEAT_MASK
#define REPEAT_MASK 0
#endif
#define REPS(bit) for (int rep_ = 0; rep_ < ((REPEAT_MASK & (bit)) ? 2 : 1); ++rep_)
constexpr int NT = 512;
constexpr int D = 1024;
constexpr int IN_COLS = 8608, NP = 8704;
constexpr int C_Z = 1536, C_BG = 2048;
constexpr int C_RWKV = 2064;
constexpr int C_ML = 3984, C_MLO = 5008, C_MLIG = 5520, C_MLFG = 5528;
constexpr int C_GATE = 5536;
constexpr int BG = BATCH / NGROUP;
constexpr int RL = BG * SEQ, RC = BG * CTXL, RG = RL + RC;
constexpr int RGP = (RG + 255) / 256 * 256;
constexpr int CAPL = SEQ / 8, CAPC = CTXL / 8;
constexpr int RPE = (BG * (CAPL + CAPC) + 255) / 256 * 256;
constexpr int TPE = RPE / 256;
constexpr int NCH = RGP / 64;
static_assert(RL % 256 == 0, "latent rows per group must be a multiple of 256");
static_assert(SEQ % 64 == 0 && CTXL % 64 == 0, "chunks");

constexpr size_t al256(size_t x) { return (x + 255) / 256 * 256; }
constexpr size_t cmax(size_t a, size_t b) { return a > b ? a : b; }
constexpr size_t OFF_BAR = 0;
constexpr size_t OFF_MOD = 16384;
constexpr size_t OFF_CTXR = al256(OFF_MOD + (size_t)DEPTH * (BATCH + 1) * 6144 * 4);
constexpr size_t OFF_WIN = al256(OFF_CTXR + (size_t)BATCH * CTXL * D * 4);
constexpr size_t OFF_WBR = al256(OFF_WIN + (size_t)NP * 1024 * 2);
constexpr size_t OFF_WOUT = al256(OFF_WBR + (size_t)3 * 1024 * 512 * 2);
constexpr size_t OFF_WUP = al256(OFF_WOUT + (size_t)1024 * 1024 * 2);
constexpr size_t OFF_WDN = al256(OFF_WUP + (size_t)16 * 1024 * 1024 * 2);
constexpr size_t OFF_WLORA = al256(OFF_WDN + (size_t)16 * 1024 * 512 * 2);
constexpr size_t OFF_H = al256(OFF_WLORA + (size_t)2560 * 384 * 2);
constexpr size_t OFF_P = al256(OFF_H + (size_t)RGP * 1024 * 2);
constexpr size_t SZ_XE = (size_t)16 * RPE * 1024 * 2, SZ_HID = (size_t)16 * RPE * 512 * 2;
constexpr size_t OFF_XE = OFF_P, OFF_HID = OFF_XE + SZ_XE, OFF_YE = OFF_HID + SZ_HID;
constexpr size_t OFF_GQKV = al256(OFF_P + cmax((size_t)RGP * NP * 2, 2 * SZ_XE + SZ_HID));
constexpr size_t OFF_BR = OFF_GQKV;
constexpr size_t OFF_GBG = al256(OFF_GQKV + (size_t)RGP * 1536 * 2);
constexpr size_t OFF_GTA = al256(OFF_GBG + (size_t)RGP * 16 * 4);
constexpr size_t OFF_GG = al256(OFF_GTA + (size_t)NCH * 4 * 2 * 2 * 4096 * 2);
constexpr size_t OFF_RW = al256(OFF_GG + (size_t)NCH * 4 * 2 * 64 * 4);
constexpr size_t OFF_RLO = al256(OFF_RW + (size_t)RGP * 4 * 512 * 2);
constexpr size_t OFF_SO = al256(OFF_RLO + (size_t)RGP * 2560 * 2);
constexpr size_t OFF_RLI = OFF_SO;
constexpr size_t OFF_SOG = OFF_SO, OFF_SOM = OFF_SOG + (size_t)2 * RGP * 512 * 2, OFF_SOR = OFF_SOM + (size_t)2 * RGP * 512 * 2;
constexpr size_t OFF_PROB = al256(OFF_SOR + (size_t)2 * RGP * 512 * 4);
constexpr size_t OFF_SLOT = al256(OFF_PROB + (size_t)RGP * 16 * 4);
constexpr size_t OFF_SEL = al256(OFF_SLOT + (size_t)RGP * 16 * 4);
constexpr size_t OFF_AFF = al256(OFF_SEL + (size_t)16 * RPE * 4);
constexpr size_t WS_TOTAL = al256(OFF_AFF + (size_t)16 * RPE * 4);
constexpr int SMEM_BYTES = 152 * 1024;

struct Params { const float* in[34]; float* out; unsigned char* ws; };
enum { I_X = 0, I_C, I_CTX, I_CCTX, I_ADAW, I_ADAB, I_N1G, I_N2G, I_WIN, I_GCONV, I_GALOG, I_GDTB, I_GNG, I_RMU, I_RW0, I_RWUP, I_RA0, I_RAUP, I_RGUP,
       I_RKK, I_RKA, I_RRK, I_RLNG, I_RLNB, I_MIB, I_MFB, I_MNG, I_WBR, I_WOUT, I_ROUT, I_W1, I_W3, I_W2, I_FING };

#ifndef CPU_EMU
__device__ __forceinline__ int tid_fresh(int wb) { int t; asm volatile("v_mbcnt_lo_u32_b32 %0, -1, 0\n\tv_mbcnt_hi_u32_b32 %0, -1, %0" : "=v"(t)); return wb + t; }
#else
static inline int tid_fresh(int) { return threadIdx.x; }
#endif
#ifndef CPU_EMU
__device__ __forceinline__ float fexp(float x) { return __builtin_amdgcn_exp2f(x * 1.4426950408889634f); }
__device__ __forceinline__ float flog(float x) { return __builtin_amdgcn_logf(x) * 0.6931471805599453f; }
__device__ __forceinline__ float frcp(float x) { return __builtin_amdgcn_rcpf(x); }
__device__ __forceinline__ float frsq(float x) { return __builtin_amdgcn_rsqf(x); }
#else
static inline float fexp(float x) { return expf(x); }
static inline float flog(float x) { return logf(x); }
static inline float frcp(float x) { return 1.f / x; }
static inline float frsq(float x) { return 1.f / sqrtf(x); }
#endif
__device__ __forceinline__ float sigm(float x) { return frcp(1.f + fexp(-x)); }
__device__ __forceinline__ float siluf(float x) { return x * frcp(1.f + fexp(-x)); }
__device__ __forceinline__ float ftanh(float x) { return 1.f - 2.f * frcp(1.f + fexp(2.f * x)); }
__device__ __forceinline__ float softplusf(float x) { const float t = fexp(x); return x > 15.f ? x : (t < 1e-3f ? t * (1.f - 0.5f * t) : flog(1.f + t)); }
#define wave_sum(x) wave_sum_(x, tid)
__device__ __forceinline__ float wave_sum_(float v, int tid) { v += SHFL_XOR(v, 32); v += SHFL_XOR(v, 16); v += SHFL_XOR(v, 8); v += SHFL_XOR(v, 4); v += SHFL_XOR(v, 2); v += SHFL_XOR(v, 1); return v; }

__device__ __forceinline__ const float* res_src(const Params& p, int l, int g, int r) {
    if (r < RL) { const size_t t = (size_t)(g * BG) * SEQ + r; return (l == 0 ? p.in[I_X] : p.out) + t * D; }
    const size_t t = (size_t)(g * BG) * CTXL + (r - RL); return (l == 0 ? p.in[I_CTX] : (const float*)(p.ws + OFF_CTXR)) + t * D;
}
__device__ __forceinline__ float* res_dst(const Params& p, int g, int r) {
    if (r < RL) { const size_t t = (size_t)(g * BG) * SEQ + r; return p.out + t * D; }
    const size_t t = (size_t)(g * BG) * CTXL + (r - RL); return (float*)(p.ws + OFF_CTXR) + t * D;
}
__device__ __forceinline__ const float* mod_row(const Params& p, int l, int g, int r) {
    const int s = r < RL ? (g * BG + r / SEQ) : BATCH; return (const float*)(p.ws + OFF_MOD) + ((size_t)l * (BATCH + 1) + s) * 6144;
}

#ifndef CPU_EMU
#define XB_TMO      128
#define XB_XCNT(j)  (256  + 64 * (j))
#define XB_XSUB(j)  (1280 + 64 * (j))
#define XB_XGEN(j)  (2304 + 64 * (j))
#define XB_TOP      3328
#define XB_TOPGEN   3392
#define XCD_BAR_WORDS 3456
#define XB_SPIN_CAP (1u << 22)
__device__ __forceinline__ unsigned xb_ld(unsigned* p)              { return __hip_atomic_load(p, __ATOMIC_RELAXED, __HIP_MEMORY_SCOPE_AGENT); }
__device__ __forceinline__ unsigned xb_add(unsigned* p, unsigned v) { return __hip_atomic_fetch_add(p, v, __ATOMIC_RELAXED, __HIP_MEMORY_SCOPE_AGENT); }
__device__ __forceinline__ unsigned xb_xcc_id() { return (unsigned)__builtin_amdgcn_s_getreg((3 << 11) | 20) & 0xFu; }
#define XB_SPIN(cond, bar) do { unsigned _sp = 0; while (cond) { __builtin_amdgcn_s_sleep(1); \
    if ((++_sp & 255u) == 0u) { if (xb_ld(&(bar)[XB_TMO])) break; if (_sp > XB_SPIN_CAP) { atomicAdd(&(bar)[XB_TMO], 1u); break; } } } } while (0)
struct XcdBarrier { unsigned* bar; unsigned x; volatile LAS unsigned* st; };
__device__ __forceinline__ XcdBarrier xcd_barrier_post(unsigned* bar, volatile LAS unsigned* st) {
    XcdBarrier b; b.bar = bar; b.x = xb_xcc_id(); b.st = st;
    if (threadIdx.x == 0) (void)xb_add(&bar[XB_XCNT(b.x)], 1u);
    return b;
}
__device__ __forceinline__ void xcd_barrier_complete(unsigned* bar, unsigned x, unsigned& nloc, unsigned& nx) {
    const unsigned G = gridDim.x * gridDim.y * gridDim.z;
    unsigned sum, cnt, mine, sp = 0u;
    for (;;) {
        sum = 0u; cnt = 0u; mine = 0u;
#pragma unroll
        for (unsigned j = 0; j < 16; ++j) { const unsigned c = xb_ld(&bar[XB_XCNT(j)]); sum += c; cnt += (c > 0u) ? 1u : 0u; mine = (j == x) ? c : mine; }
        if (sum == G) break;
        __builtin_amdgcn_s_sleep(1);
        if ((++sp & 255u) == 0u) { if (xb_ld(&bar[XB_TMO])) break; if (sp > XB_SPIN_CAP) { atomicAdd(&bar[XB_TMO], 1u); break; } }
    }
    nloc = mine > 0u ? mine : 1u; nx = cnt > 0u ? cnt : 1u;
}
__device__ __forceinline__ void xcd_barrier(const XcdBarrier& b) {
    asm volatile("s_waitcnt vmcnt(0)" ::: "memory");
    __syncthreads();
    if (threadIdx.x == 0) {
        unsigned* bar = b.bar;
        __builtin_amdgcn_s_waitcnt(0);
        unsigned nloc = b.st[0], nx = b.st[1];
        if (nloc == 0u) { xcd_barrier_complete(bar, b.x, nloc, nx); b.st[0] = nloc; b.st[1] = nx; }
        const unsigned old = xb_add(&bar[XB_XSUB(b.x)], 1u);
        const unsigned gen = old / nloc;
        if (old + 1u == (gen + 1u) * nloc) {
            __builtin_amdgcn_fence(__ATOMIC_RELEASE, "agent");
            asm volatile("s_waitcnt vmcnt(0)" ::: "memory");
            const unsigned og = xb_add(&bar[XB_TOP], 1u);
            const unsigned tg = og / nx;
            if (og + 1u == (tg + 1u) * nx) xb_add(&bar[XB_TOPGEN], 1u);
            else XB_SPIN(xb_ld(&bar[XB_TOPGEN]) == tg, bar);
            __builtin_amdgcn_fence(__ATOMIC_ACQUIRE, "agent");
            xb_add(&bar[XB_XGEN(b.x)], 1u);
            asm volatile("s_waitcnt vmcnt(0)" ::: "memory");
        } else {
            XB_SPIN(xb_ld(&bar[XB_XGEN(b.x)]) == gen, bar);
            __builtin_amdgcn_fence(__ATOMIC_ACQUIRE, "agent");
            asm volatile("s_waitcnt vmcnt(0)" ::: "memory");
        }
    }
    __syncthreads();
}
#define GRID_SYNC() do { XcdBarrier gb_; gb_.bar = (unsigned*)(p.ws + OFF_BAR); gb_.x = xb_xcc_id(); gb_.st = (volatile LAS unsigned*)(lds + SMEM_BYTES - 16); xcd_barrier(gb_); } while (0)
#else
#define GRID_SYNC() emu_grid_sync()
#endif

namespace pg8 {
constexpr int BM = 256, BK = 64, HALF = 128, HTB = HALF * BK * 2, STAGE_BYTES = 8 * HTB, NXCD = 8, WGM = 8;
__host__ __device__ __forceinline__ int lds_byte(int r, int c) { const int st = (r >> 4) * 2 + (c >> 5), rr = r & 15, cc = c & 31, ob = rr * 64 + cc * 2; return st * 1024 + (ob ^ (((ob >> 9) & 1) << 5)); }
__host__ __device__ __forceinline__ void stage_rc(int b, int& R, int& C) { const int st = b / 1024, sb = b % 1024, swz = sb ^ (((sb >> 9) & 1) << 5); R = (st >> 1) * 16 + swz / 64; C = (st & 1) * 32 + (swz % 64) / 2; }
__host__ __device__ __forceinline__ int perm32(int rho) { const int n = rho >> 4, i = rho & 15; return 8 * (i >> 2) + 4 * n + (i & 3); }
struct Unit { int pm, pn, pb; };
struct Gemm { const half_t* A; const half_t* Bt; int K; };
struct StaticOrder {
    int nM, nN, nwg, G, c;
    __device__ void init(int nM_, int nN_, int G_, int c_) { nM = nM_; nN = nN_; nwg = nM * nN; G = G_; c = c_; }
    __device__ bool next(int i, Unit& u) const {
        const long L = (long)i * G + c; if (L >= nwg) return false;
        int wgid = (int)L; { const int q = nwg / NXCD, r = nwg % NXCD, xcd = wgid % NXCD, off = wgid / NXCD; wgid = (xcd < r ? xcd * (q + 1) : r * (q + 1) + (xcd - r) * q) + off; }
        const int nig = WGM * nN, gid = wgid / nig, fm = gid * WGM, gsz = (nM - fm) < WGM ? (nM - fm) : WGM;
        u.pm = fm + ((wgid % nig) % gsz); u.pn = (wgid % nig) / gsz; u.pb = u.pn; return true;
    }
};
struct ExpertOrder {
    int G, c;
    __device__ void init(int G_, int c_) { G = G_; c = c_; }
    __device__ bool next(int i, Unit& u) const {
        const long L = (long)i * G + c; if (L >= 16 * TPE * 4) return false;
        const int e = (int)L / (TPE * 4), rem = (int)L % (TPE * 4);
        u.pm = e * TPE + rem / 4; u.pn = rem % 4; u.pb = e * 4 + u.pn; return true;
    }
};

#ifndef CPU_EMU
template <class Epi, class Sched>
__device__ __forceinline__ void gemm_phase(int wb, LAS unsigned char* lds, const Gemm g, const Sched& S, const Epi& E) {
    const int tid = tid_fresh(wb), wid = __builtin_amdgcn_readfirstlane(tid >> 6), lane = tid & 63, wr = wid >> 2, wc = wid & 3, fr = lane & 15, fq = lane >> 4;
    const int K = g.K, nt = K / BK;
    unsigned voffA[2], voffB[2];
#pragma unroll
    for (int i = 0; i < 2; ++i) { int R, C; stage_rc(tid * 16 + i * 8192, R, C); const int Rb = Epi::PERM ? ((R & ~31) + perm32(R & 31)) : R;
        voffA[i] = (unsigned)(R * K + C) * 2u; voffB[i] = (unsigned)(Rb * K + C) * 2u; }
    const size_t kstep = (size_t)(BK * 2);
    const size_t hstep = (size_t)HALF * K * 2;
    const size_t tstep = 2 * hstep;
    const unsigned ldsw = (unsigned)wid * 1024u;
    const int aoff = lds_byte(wr * 64 + fr, fq * 8), boff = lds_byte(wc * 32 + fr, fq * 8);
#define PG8_SA(b, h) (((b) * 2 + (h)) * HTB)
#define PG8_SB(b, h) ((4 + (b) * 2 + (h)) * HTB)
#define PG8_STAGE(bufoff, gbase, voff) do { _Pragma("unroll") for (int _i = 0; _i < 2; ++_i) \
        __builtin_amdgcn_global_load_lds((const unsigned*)((const char*)(gbase) + (voff)[_i]), (LAS unsigned*)(lds + (bufoff) + ldsw + _i * 8192), 16, 0, 0); } while (0)
#define PG8_LDA(dst, b, h) do { _Pragma("unroll") for (int m = 0; m < 4; ++m) _Pragma("unroll") for (int k = 0; k < 2; ++k) dst[m][k] = *(const LAS half8*)(lds + PG8_SA(b, h) + aoff + m * 2048 + k * 1024); } while (0)
#define PG8_LDB(dst, b, h) do { _Pragma("unroll") for (int n = 0; n < 2; ++n) _Pragma("unroll") for (int k = 0; k < 2; ++k) dst[n][k] = *(const LAS half8*)(lds + PG8_SB(b, h) + boff + n * 2048 + k * 1024); } while (0)
#define PG8_MMA(ai, bj, At, Bt) do { __builtin_amdgcn_s_setprio(1); _Pragma("unroll") for (int m = 0; m < 4; ++m) _Pragma("unroll") for (int n = 0; n < 2; ++n) _Pragma("unroll") for (int k = 0; k < 2; ++k) \
        acc[ai][bj][m][n] = __builtin_amdgcn_mfma_f32_16x16x32_f16(Bt[n][k], At[m][k], acc[ai][bj][m][n], 0, 0, 0); __builtin_amdgcn_s_setprio(0); } while (0)
#define PG8_WAIT_V(n) asm volatile("s_waitcnt vmcnt(" #n ")" ::: "memory")
#define PG8_WAIT_L(n) asm volatile("s_waitcnt lgkmcnt(" #n ")" ::: "memory")
#define PG8_BAR __builtin_amdgcn_s_barrier()
#define PG8_SCHED __builtin_amdgcn_sched_barrier(0)
    Unit cur, nxt; int ui = 0;
    if (!S.next(0, cur)) return;
    f32x4 acc[2][2][4][2];
#pragma unroll
    for (int a = 0; a < 2; ++a)
#pragma unroll
        for (int b = 0; b < 2; ++b)
#pragma unroll
            for (int m = 0; m < 4; ++m)
#pragma unroll
                for (int n = 0; n < 2; ++n) acc[a][b][m][n] = (f32x4){0.f, 0.f, 0.f, 0.f};
    half8 At[4][2], B0[2][2], B1[2][2];
    const char* cA = (const char*)g.A + (size_t)cur.pm * tstep; const char* cB = (const char*)g.Bt + (size_t)cur.pb * tstep;
    PG8_STAGE(PG8_SB(0, 0), cB, voffB); PG8_STAGE(PG8_SA(0, 0), cA, voffA); PG8_STAGE(PG8_SB(0, 1), cB + hstep, voffB); PG8_STAGE(PG8_SA(0, 1), cA + hstep, voffA);
    if (wr == 1) PG8_BAR;
    PG8_WAIT_V(4); PG8_BAR;
    PG8_STAGE(PG8_SB(1, 0), cB + kstep, voffB); PG8_STAGE(PG8_SA(1, 0), cA + kstep, voffA); PG8_STAGE(PG8_SB(1, 1), cB + hstep + kstep, voffB);
    PG8_WAIT_V(6); PG8_BAR;
    for (;;) {
        const bool has_next = S.next(ui + 1, nxt);
        const char* nA = has_next ? (const char*)g.A + (size_t)nxt.pm * tstep : cA; const char* nB = has_next ? (const char*)g.Bt + (size_t)nxt.pb * tstep : cB;
#pragma unroll 1
        for (int t = 0; t < nt; t += 2) {
            const bool last = (t == nt - 2);
            const char* a1 = cA + (size_t)(t + 1) * kstep;
            const char* a2 = last ? nA : cA + (size_t)(t + 2) * kstep; const char* b2 = last ? nB : cB + (size_t)(t + 2) * kstep;
            const char* a3 = a2 + kstep; const char* b3 = b2 + kstep;
            PG8_LDB(B0, 0, 0); PG8_SCHED; PG8_LDA(At, 0, 0); PG8_STAGE(PG8_SA(1, 1), a1 + hstep, voffA);
            PG8_WAIT_L(8); PG8_BAR; PG8_WAIT_L(0); PG8_MMA(0, 0, At, B0); PG8_BAR; PG8_SCHED;
            PG8_LDB(B1, 0, 1); PG8_STAGE(PG8_SB(0, 0), b2, voffB);
            PG8_BAR; PG8_WAIT_L(0); PG8_MMA(0, 1, At, B1); PG8_BAR;
            PG8_LDA(At, 0, 1); PG8_STAGE(PG8_SA(0, 0), a2, voffA);
            PG8_BAR; PG8_WAIT_L(0); PG8_MMA(1, 0, At, B0); PG8_BAR; PG8_SCHED;
            PG8_STAGE(PG8_SB(0, 1), b2 + hstep, voffB);
            PG8_WAIT_V(6); PG8_BAR; PG8_MMA(1, 1, At, B1); PG8_BAR;
            PG8_LDB(B0, 1, 0); PG8_SCHED; PG8_LDA(At, 1, 0); PG8_STAGE(PG8_SA(0, 1), a2 + hstep, voffA);
            PG8_WAIT_L(8); PG8_BAR; PG8_WAIT_L(0); PG8_MMA(0, 0, At, B0); PG8_BAR; PG8_SCHED;
            PG8_LDB(B1, 1, 1); PG8_STAGE(PG8_SB(1, 0), b3, voffB);
            PG8_BAR; PG8_WAIT_L(0); PG8_MMA(0, 1, At, B1); PG8_BAR;
            PG8_LDA(At, 1, 1); PG8_STAGE(PG8_SA(1, 0), a3, voffA);
            PG8_BAR; PG8_WAIT_L(0); PG8_MMA(1, 0, At, B0); PG8_BAR; PG8_SCHED;
            PG8_STAGE(PG8_SB(1, 1), b3 + hstep, voffB);
            PG8_WAIT_V(6); PG8_BAR; PG8_MMA(1, 1, At, B1); PG8_BAR;
        }
        E(acc, cur, wr, wc, fr, fq);
        if (!has_next) break;
#pragma unroll
        for (int a = 0; a < 2; ++a)
#pragma unroll
            for (int b = 0; b < 2; ++b)
#pragma unroll
                for (int m = 0; m < 4; ++m)
#pragma unroll
                    for (int n = 0; n < 2; ++n) acc[a][b][m][n] = (f32x4){0.f, 0.f, 0.f, 0.f};
        cur = nxt; cA = nA; cB = nB; ++ui;
    }
    PG8_WAIT_V(0);
    if (wr == 0) PG8_BAR;
    PG8_BAR;
#undef PG8_SA
#undef PG8_SB
#undef PG8_STAGE
#undef PG8_LDA
#undef PG8_LDB
#undef PG8_MMA
#undef PG8_WAIT_V
#undef PG8_WAIT_L
#undef PG8_BAR
#undef PG8_SCHED
}
#else
static float* emu_fa[64]; static float* emu_fb[64];
template <class Epi, class Sched>
void gemm_phase(int wb, LAS unsigned char* lds, const Gemm g, const Sched& S, const Epi& E) {
    const int tid = tid_fresh(wb), wid = tid >> 6, lane = tid & 63, wr = wid >> 2, wc = wid & 3, fr = lane & 15, fq = lane >> 4;
    const int K = g.K; const int bid = blockIdx.x;
    Unit u;
    for (int ui = 0; S.next(ui, u); ++ui) {
        SYNC();
        if (tid == 0) {
            if (!emu_fa[bid]) { emu_fa[bid] = (float*)malloc(256 * 1024 * 4); emu_fb[bid] = (float*)malloc(256 * 1024 * 4); }
            for (int r = 0; r < 256; ++r) for (int k = 0; k < K; ++k) { emu_fa[bid][r * K + k] = (float)g.A[((size_t)u.pm * 256 + r) * K + k]; emu_fb[bid][r * K + k] = (float)g.Bt[((size_t)u.pb * 256 + r) * K + k]; }
        }
        SYNC();
        f32x4 acc[2][2][4][2];
        for (int ai = 0; ai < 2; ++ai) for (int bj = 0; bj < 2; ++bj) for (int m = 0; m < 4; ++m) for (int n = 0; n < 2; ++n) for (int i = 0; i < 4; ++i) {
            const int row = 128 * ai + 64 * wr + 16 * m + fr;
            const int col = Epi::PERM ? (128 * bj + 32 * wc + 8 * fq + 4 * n + i) : (128 * bj + 32 * wc + 16 * n + 4 * fq + i);
            const float* a = emu_fa[bid] + row * K; const float* b = emu_fb[bid] + col * K; float s = 0.f;
            for (int k = 0; k < K; ++k) s += a[k] * b[k];
            acc[ai][bj][m][n][i] = s; }
        E(acc, u, wr, wc, fr, fq);
    }
    SYNC();
}
#endif
}
using pg8::Unit;

struct EpiP {
    static constexpr bool PERM = true;
    half_t* P;
    __device__ __forceinline__ void operator()(const f32x4 (&acc)[2][2][4][2], const Unit& u, int wr, int wc, int fr, int fq) const {
        const int row0 = u.pm * 256 + wr * 64 + fr, col0 = u.pn * 256 + wc * 32 + 8 * fq;
#pragma unroll
        for (int bj = 0; bj < 2; ++bj) {
            const int col = col0 + bj * 128;
            const bool sg = (col >= C_GATE && col < IN_COLS) || (col >= C_MLO && col < C_MLIG);
#pragma unroll
            for (int ai = 0; ai < 2; ++ai)
#pragma unroll
                for (int m = 0; m < 4; ++m) {
                    half8 h;
#pragma unroll
                    for (int n = 0; n < 2; ++n)
#pragma unroll
                        for (int i = 0; i < 4; ++i) { float v = acc[ai][bj][m][n][i]; if (sg) v = sigm(v); h[4 * n + i] = (half_t)v; }
                    *(half8*)(P + (size_t)(row0 + ai * 128 + m * 16) * NP + col) = h;
                }
        }
    }
};
struct EpiLora {
    static constexpr bool PERM = true;
    half_t* O; const float* w0; const float* a0;
    __device__ __forceinline__ void operator()(const f32x4 (&acc)[2][2][4][2], const Unit& u, int wr, int wc, int fr, int fq) const {
        const int row0 = u.pm * 256 + wr * 64 + fr, col0 = u.pn * 256 + wc * 32 + 8 * fq;
#pragma unroll
        for (int bj = 0; bj < 2; ++bj) {
            const int col = col0 + bj * 128, blk = col >> 9;
            float bias[8];
#pragma unroll
            for (int j = 0; j < 8; ++j) bias[j] = blk < 2 ? w0[col + j] : (blk < 4 ? a0[col - 1024 + j] : 0.f);
#pragma unroll
            for (int ai = 0; ai < 2; ++ai)
#pragma unroll
                for (int m = 0; m < 4; ++m) {
                    half8 h;
#pragma unroll
                    for (int n = 0; n < 2; ++n)
#pragma unroll
                        for (int i = 0; i < 4; ++i) { float v = acc[ai][bj][m][n][i] + bias[4 * n + i];
                            if (blk < 2) v = sigm(v) * 0.6065306597126334f; else if (blk < 4) v = sigm(v);
                            h[4 * n + i] = (half_t)v; }
                    *(half8*)(O + (size_t)(row0 + ai * 128 + m * 16) * 2560 + col) = h;
                }
        }
    }
};
struct EpiMerge {
    static constexpr bool PERM = true;
    half_t* M; const half_t* P; int bi;
    __device__ __forceinline__ void operator()(const f32x4 (&acc)[2][2][4][2], const Unit& u, int wr, int wc, int fr, int fq) const {
        const int row0 = u.pm * 256 + wr * 64 + fr, col0 = u.pn * 256 + wc * 32 + 8 * fq;
#pragma unroll
        for (int ai = 0; ai < 2; ++ai)
#pragma unroll
            for (int m = 0; m < 4; ++m) {
                const size_t row = (size_t)(row0 + ai * 128 + m * 16);
#pragma unroll
                for (int bj = 0; bj < 2; ++bj) {
                    const int col = col0 + bj * 128;
                    const half8 gt = *(const half8*)(P + row * NP + C_GATE + bi * 1024 + col);
                    half8 o; if (bi > 0) o = *(const half8*)(M + row * 1024 + col);
#pragma unroll
                    for (int n = 0; n < 2; ++n)
#pragma unroll
                        for (int i = 0; i < 4; ++i) { float v = (float)gt[4 * n + i] * acc[ai][bj][m][n][i]; if (bi > 0) v += (float)o[4 * n + i]; o[4 * n + i] = (half_t)v; }
                    *(half8*)(M + row * 1024 + col) = o;
                }
            }
    }
};
struct EpiOut {
    static constexpr bool PERM = false;
    Params p; int l, g;
    __device__ __forceinline__ void operator()(const f32x4 (&acc)[2][2][4][2], const Unit& u, int wr, int wc, int fr, int fq) const {
        const int row0 = u.pm * 256 + wr * 64 + fr, col0 = u.pn * 256 + wc * 32 + 4 * fq;
#pragma unroll
        for (int ai = 0; ai < 2; ++ai)
#pragma unroll
            for (int m = 0; m < 4; ++m) {
                const int row = row0 + ai * 128 + m * 16;
                if (row < RG) {
                    const float* src = res_src(p, l, g, row); float* dst = res_dst(p, g, row); const float* md = mod_row(p, l, g, row) + 2 * 1024;
#pragma unroll
                    for (int bj = 0; bj < 2; ++bj)
#pragma unroll
                        for (int n = 0; n < 2; ++n) { const int col = col0 + bj * 128 + n * 16;
                            const f32x4 xo = *(const f32x4*)(src + col), mv = *(const f32x4*)(md + col);
                            *(f32x4*)(dst + col) = xo + mv * acc[ai][bj][m][n]; }
                }
            }
    }
};
struct EpiUp {
    static constexpr bool PERM = true;
    half_t* HID;
    __device__ __forceinline__ void operator()(const f32x4 (&acc)[2][2][4][2], const Unit& u, int wr, int wc, int fr, int fq) const {
        const int row0 = u.pm * 256 + wr * 64 + fr, col = u.pn * 128 + wc * 32 + 8 * fq;
#pragma unroll
        for (int ai = 0; ai < 2; ++ai)
#pragma unroll
            for (int m = 0; m < 4; ++m) {
                half8 h;
#pragma unroll
                for (int n = 0; n < 2; ++n)
#pragma unroll
                    for (int i = 0; i < 4; ++i) h[4 * n + i] = (half_t)(siluf(acc[ai][0][m][n][i]) * acc[ai][1][m][n][i]);
                *(half8*)(HID + (size_t)(row0 + ai * 128 + m * 16) * 512 + col) = h;
            }
    }
};
struct EpiDown {
    static constexpr bool PERM = true;
    half_t* YE; const float* AFF;
    __device__ __forceinline__ void operator()(const f32x4 (&acc)[2][2][4][2], const Unit& u, int wr, int wc, int fr, int fq) const {
        const int row0 = u.pm * 256 + wr * 64 + fr, col0 = u.pn * 256 + wc * 32 + 8 * fq;
#pragma unroll
        for (int ai = 0; ai < 2; ++ai)
#pragma unroll
            for (int m = 0; m < 4; ++m) {
                const size_t row = (size_t)(row0 + ai * 128 + m * 16); const float af = AFF[row];
#pragma unroll
                for (int bj = 0; bj < 2; ++bj) {
                    half8 h;
#pragma unroll
                    for (int n = 0; n < 2; ++n)
#pragma unroll
                        for (int i = 0; i < 4; ++i) h[4 * n + i] = (half_t)(acc[ai][bj][m][n][i] * af);
                    *(half8*)(YE + row * 1024 + col0 + bj * 128) = h;
                }
            }
    }
};

__device__ __forceinline__ void ph_mod(int wb, const Params& p, LAS unsigned char* lds) {
    LAS float* sv = (LAS float*)lds; LAS float* red = sv + (BATCH + 1) * 1024;
    const int tid = tid_fresh(wb);
    for (int i = tid; i < (BATCH + 1) * 1024; i += NT) { const int s = i >> 10, k = i & 1023; const float cv = s < BATCH ? p.in[I_C][s * 1024 + k] : p.in[I_CCTX][k]; sv[i] = siluf(cv); }
    SYNC();
    float* mod = (float*)(p.ws + OFF_MOD);
    for (int item = blockIdx.x; item < DEPTH * 48; item += gridDim.x) {
        const int l = item / 48, j = (item % 48) * 128 + (tid & 127), kq = tid >> 7;
        float acc[BATCH + 1];
#pragma unroll
        for (int s = 0; s <= BATCH; ++s) acc[s] = 0.f;
        const float* w = p.in[I_ADAW] + (size_t)l * 1024 * 6144 + j;
        for (int k = kq * 256; k < kq * 256 + 256; ++k) { const float wv = w[(size_t)k * 6144];
#pragma unroll
            for (int s = 0; s <= BATCH; ++s) acc[s] += sv[s * 1024 + k] * wv; }
#pragma unroll
        for (int s = 0; s <= BATCH; ++s) red[tid * (BATCH + 1) + s] = acc[s];
        SYNC();
        if (tid < 128) {
#pragma unroll
            for (int s = 0; s <= BATCH; ++s) { float v = p.in[I_ADAB][l * 6144 + j];
                for (int q = 0; q < 4; ++q) v += red[(q * 128 + tid) * (BATCH + 1) + s];
                mod[((size_t)l * (BATCH + 1) + s) * 6144 + j] = v; }
        }
        SYNC();
    }
}

__device__ __forceinline__ void tconv_tile(int wb, const float* src, int sld, int k0, int n0, int nvalid, half_t* dst, int dld, int drow0, int dcol0, LAS float* tile) {
    const int tid = tid_fresh(wb), r = tid >> 4, c4 = (tid & 15) * 4;
#pragma unroll
    for (int j = 0; j < 2; ++j) { const int k = r + 32 * j; f32x4 v = {0.f, 0.f, 0.f, 0.f};
        if (src && n0 + c4 < nvalid) v = *(const f32x4*)(src + (size_t)(k0 + k) * sld + n0 + c4);
        tile[k * 65 + c4] = v[0]; tile[k * 65 + c4 + 1] = v[1]; tile[k * 65 + c4 + 2] = v[2]; tile[k * 65 + c4 + 3] = v[3]; }
    SYNC();
    const int n = tid >> 3, k8 = (tid & 7) * 8; half8 h;
#pragma unroll
    for (int i = 0; i < 8; ++i) h[i] = (half_t)tile[(k8 + i) * 65 + n];
    *(half8*)(dst + (size_t)(drow0 + n) * dld + dcol0 + k8) = h;
    SYNC();
}
__device__ __forceinline__ void ph_convert(int wb, const Params& p, int l, LAS unsigned char* lds) {
    LAS float* tile = (LAS float*)lds;
    constexpr int N_WIN = 16 * (NP / 64), N_WBR = 3 * 128, N_WOUT = 256, N_W13 = 2 * 2048, N_W2 = 2048, N_LORA = 240;
    constexpr int TOTAL = N_WIN + N_WBR + N_WOUT + N_W13 + N_W2 + N_LORA;
    half_t* ws16 = (half_t*)p.ws;
    for (int item = blockIdx.x; item < TOTAL; item += gridDim.x) {
        int it = item;
        if (it < N_WIN) { const int kt = it % 16, ntile = it / 16;
            tconv_tile(wb, p.in[I_WIN] + (size_t)l * 1024 * IN_COLS, IN_COLS, 64 * kt, 64 * ntile, IN_COLS, (half_t*)(p.ws + OFF_WIN), 1024, 64 * ntile, 64 * kt, tile); continue; }
        it -= N_WIN;
        if (it < N_WBR) { const int i = it / 128, rem = it % 128, kt = rem % 8, ntile = rem / 8;
            tconv_tile(wb, p.in[I_WBR] + (size_t)(l * 3 + i) * 512 * 1024, 1024, 64 * kt, 64 * ntile, 1024, (half_t*)(p.ws + OFF_WBR) + (size_t)i * 1024 * 512, 512, 64 * ntile, 64 * kt, tile); continue; }
        it -= N_WBR;
        if (it < N_WOUT) { const int kt = it % 16, ntile = it / 16;
            tconv_tile(wb, p.in[I_WOUT] + (size_t)l * 1024 * 1024, 1024, 64 * kt, 64 * ntile, 1024, (half_t*)(p.ws + OFF_WOUT), 1024, 64 * ntile, 64 * kt, tile); continue; }
        it -= N_WOUT;
        if (it < N_W13) { const int which = it / 2048, rem = it % 2048, e = rem / 128, r2 = rem % 128, kt = r2 % 16, ntile = r2 / 16, n0 = 64 * ntile;
            tconv_tile(wb, p.in[which ? I_W3 : I_W1] + (size_t)(l * 16 + e) * 1024 * 512, 512, 64 * kt, n0, 512, (half_t*)(p.ws + OFF_WUP) + (size_t)e * 1024 * 1024, 1024,
                       (n0 / 128) * 256 + which * 128 + (n0 % 128), 64 * kt, tile); continue; }
        it -= N_W13;
        if (it < N_W2) { const int e = it / 128, r2 = it % 128, kt = r2 % 8, ntile = r2 / 8;
            tconv_tile(wb, p.in[I_W2] + (size_t)(l * 16 + e) * 512 * 1024, 1024, 64 * kt, 64 * ntile, 1024, (half_t*)(p.ws + OFF_WDN) + (size_t)e * 1024 * 512, 512, 64 * ntile, 64 * kt, tile); continue; }
        it -= N_W2;
        { const int ntile = it / 6, kt = it % 6, n0 = 64 * ntile, blk = n0 / 512, nn0 = n0 % 512;
          const float* src = nullptr; int k0 = 0;
          if (blk == 0 && kt == 0) src = p.in[I_RWUP] + (size_t)(l * 2 + 0) * 64 * 512;
          else if (blk == 1 && kt == 1) src = p.in[I_RWUP] + (size_t)(l * 2 + 1) * 64 * 512;
          else if (blk == 2 && kt == 2) src = p.in[I_RAUP] + (size_t)(l * 2 + 0) * 64 * 512;
          else if (blk == 3 && kt == 3) src = p.in[I_RAUP] + (size_t)(l * 2 + 1) * 64 * 512;
          else if (blk == 4 && kt >= 4) { src = p.in[I_RGUP] + (size_t)l * 128 * 512; k0 = 64 * (kt - 4); }
          tconv_tile(wb, src, 512, k0, nn0, 512, (half_t*)(p.ws + OFF_WLORA), 384, n0, 64 * kt, tile); }
    }
    (void)ws16;
}

__device__ __forceinline__ void ph_norm1(int wb, const Params& p, int l, int g) {
    const int tid = tid_fresh(wb), wid = tid >> 6, lane = tid & 63;
    half_t* H = (half_t*)(p.ws + OFF_H);
    for (int r = blockIdx.x * 8 + wid; r < RGP; r += gridDim.x * 8) {
        if (r >= RG) { for (int j = 0; j < 4; ++j) *(half4*)(H + (size_t)r * D + lane * 4 + 256 * j) = (half4){0, 0, 0, 0}; continue; }
        const float* xr = res_src(p, l, g, r); const float* md = mod_row(p, l, g, r); const float* gn = p.in[I_N1G] + l * D;
        f32x4 v[4]; float ss = 0.f;
#pragma unroll
        for (int j = 0; j < 4; ++j) { v[j] = *(const f32x4*)(xr + lane * 4 + 256 * j); ss += v[j][0] * v[j][0] + v[j][1] * v[j][1] + v[j][2] * v[j][2] + v[j][3] * v[j][3]; }
        ss = wave_sum(ss); const float rinv = frsq(ss * (1.f / D) + 1e-6f);
#pragma unroll
        for (int j = 0; j < 4; ++j) { const int c = lane * 4 + 256 * j; half4 h;
#pragma unroll
            for (int i = 0; i < 4; ++i) h[i] = (half_t)(v[j][i] * rinv * gn[c + i] * (1.f + md[1024 + c + i]) + md[c + i]);
            *(half4*)(H + (size_t)r * D + c) = h; }
    }
}

struct RowGeo { int gw, gh, base, gr, gc; };
__device__ __forceinline__ RowGeo row_geo(int r) {
    RowGeo q; int i;
    if (r < RL) { const int bl = r / SEQ; i = r % SEQ; q.gw = 64; q.gh = SEQ / 64; q.base = bl * SEQ; }
    else { const int rr = r - RL, bl = rr / CTXL; i = rr % CTXL; q.gw = CTXL; q.gh = 1; q.base = RL + bl * CTXL; }
    q.gr = i / q.gw; q.gc = i % q.gw; return q;
}

__device__ __forceinline__ void ph_prep(int wb, const Params& p, int l, LAS unsigned char* lds) {
    const int tid = tid_fresh(wb), wid = tid >> 6, lane = tid & 63;
    LAS float* cw = (LAS float*)lds;
    for (int i = tid; i < 9 * 1536; i += NT) cw[i] = p.in[I_GCONV][(size_t)l * 9 * 1536 + i];
    SYNC();
    const half_t* P = (const half_t*)(p.ws + OFF_P);
    half_t* GQKV = (half_t*)(p.ws + OFF_GQKV); float* GBG = (float*)(p.ws + OFF_GBG);
    half_t* RW = (half_t*)(p.ws + OFF_RW); half_t* RLI = (half_t*)(p.ws + OFF_RLI);
    for (int r = blockIdx.x * 8 + wid; r < RG; r += gridDim.x * 8) {
        const RowGeo q = row_geo(r);
        float acc[3][8];
#pragma unroll
        for (int j = 0; j < 3; ++j)
#pragma unroll
            for (int e = 0; e < 8; ++e) acc[j][e] = 0.f;
        for (int kh = 0; kh < 3; ++kh) { const int nr = q.gr + kh - 1; if (nr < 0 || nr >= q.gh) continue;
            for (int kw = 0; kw < 3; ++kw) { const int nc = q.gc + kw - 1; if (nc < 0 || nc >= q.gw) continue;
                const size_t nrow = (size_t)(q.base + nr * q.gw + nc);
#pragma unroll
                for (int j = 0; j < 3; ++j) { const half8 pv = *(const half8*)(P + nrow * NP + j * 512 + 8 * lane); const LAS float* w = cw + (kh * 3 + kw) * 1536 + j * 512 + 8 * lane;
#pragma unroll
                    for (int e = 0; e < 8; ++e) acc[j][e] += (float)pv[e] * w[e]; } } }
#pragma unroll
        for (int j = 0; j < 3; ++j) {
            float ss = 0.f;
#pragma unroll
            for (int e = 0; e < 8; ++e) { acc[j][e] = siluf(acc[j][e]); ss += acc[j][e] * acc[j][e]; }
            float sc = 1.f;
            if (j < 2) { ss += SHFL_XOR(ss, 1); ss += SHFL_XOR(ss, 2); ss += SHFL_XOR(ss, 4); ss += SHFL_XOR(ss, 8); sc = frsq(ss + 1e-6f) * (j == 0 ? 0.08838834764831845f : 1.f); }
            half8 h;
#pragma unroll
            for (int e = 0; e < 8; ++e) h[e] = (half_t)(acc[j][e] * sc);
            *(half8*)(GQKV + (size_t)r * 1536 + j * 512 + 8 * lane) = h;
        }
        if (lane < 16) { const float x = (float)P[(size_t)r * NP + C_BG + lane];
            float o; if (lane < 8) o = sigm(x); else { const int idx = lane - 8; o = -fexp(p.in[I_GALOG][l * 8 + idx]) * softplusf(x + p.in[I_GDTB][l * 8 + idx]); }
            GBG[(size_t)r * 16 + lane] = o; }
        const int nb[4] = { q.gc > 0 ? r - 1 : -1, q.gc < q.gw - 1 ? r + 1 : -1, q.gr > 0 ? r - q.gw : -1, q.gr < q.gh - 1 ? r + q.gw : -1 };
        const float* mu = p.in[I_RMU] + (size_t)l * 1920;
        float kmix[8];
#pragma unroll
        for (int j = 0; j < 4; ++j) {
            if (j == 3 && lane >= 48) break;
            const int cj = j < 3 ? j * 512 + 8 * lane : 1536 + 8 * lane;
            const half8 self = *(const half8*)(P + (size_t)r * NP + C_RWKV + cj);
            half8 nv[4];
#pragma unroll
            for (int d = 0; d < 4; ++d) { if (nb[d] >= 0) nv[d] = *(const half8*)(P + (size_t)nb[d] * NP + C_RWKV + cj); else nv[d] = (half8){0, 0, 0, 0, 0, 0, 0, 0}; }
            float val[8];
#pragma unroll
            for (int e = 0; e < 8; ++e) { const float s = (float)self[e], nn = (float)nv[e & 3][e]; val[e] = s + (nn - s) * mu[cj + e]; }
            half8 h;
            if (j < 3) {
#pragma unroll
                for (int e = 0; e < 8; ++e) h[e] = (half_t)val[e];
                *(half8*)(RW + ((size_t)r * 4 + j) * 512 + 8 * lane) = h;
                if (j == 1) {
#pragma unroll
                    for (int e = 0; e < 8; ++e) kmix[e] = val[e]; }
            } else {
                const int c0 = 8 * lane;
#pragma unroll
                for (int e = 0; e < 8; ++e) { float v = val[e]; if (c0 < 128) v = ftanh(v); else if (c0 >= 256) v = sigm(v); h[e] = (half_t)v; }
                *(half8*)(RLI + (size_t)r * 384 + c0) = h;
            }
        }
        { float t[8], ss = 0.f; const float* kkw = p.in[I_RKK] + (size_t)l * 512 + 8 * lane;
#pragma unroll
          for (int e = 0; e < 8; ++e) { t[e] = kmix[e] * kkw[e]; ss += t[e] * t[e]; }
          ss += SHFL_XOR(ss, 1); ss += SHFL_XOR(ss, 2); ss += SHFL_XOR(ss, 4);
          const float sc = frsq(ss + 1e-6f); half8 h;
#pragma unroll
          for (int e = 0; e < 8; ++e) h[e] = (half_t)(t[e] * sc);
          *(half8*)(RW + ((size_t)r * 4 + 3) * 512 + 8 * lane) = h; }
    }
}

__device__ __forceinline__ void ph_wy(int wb, const Params& p, LAS unsigned char* lds) {
    const int tid = tid_fresh(wb);
    LAS half_t* kh = (LAS half_t*)lds;
    LAS half_t* qh = kh + 64 * 136;
    LAS float* KK = (LAS float*)(qh + 64 * 136);
    LAS float* QK = KK + 64 * 65;
    LAS float* Lm = QK + 64 * 65;
    LAS float* Xs = Lm + 2 * 64 * 65;
    LAS float* Gs = Xs + 2 * 64 * 65;
    LAS float* Bs = Gs + 128;
    const half_t* GQKV = (const half_t*)(p.ws + OFF_GQKV); const float* GBG = (const float*)(p.ws + OFF_GBG);
    half_t* GTA = (half_t*)(p.ws + OFF_GTA); float* GG = (float*)(p.ws + OFF_GG);
    for (int item = blockIdx.x; item < (RG / 64) * 4; item += gridDim.x) {
        const int cidx = item >> 2, h = item & 3, r0 = cidx * 64;
        for (int v = tid; v < 1024; v += NT) { const int row = v >> 4, c8 = (v & 15) * 8;
            *(LAS half8*)(kh + row * 136 + c8) = *(const half8*)(GQKV + (size_t)(r0 + row) * 1536 + 512 + h * 128 + c8);
            *(LAS half8*)(qh + row * 136 + c8) = *(const half8*)(GQKV + (size_t)(r0 + row) * 1536 + h * 128 + c8); }
        if (tid < 128) { const int d = tid >> 6, i = tid & 63, nat = d ? 63 - i : i;
            Bs[d * 64 + i] = GBG[(size_t)(r0 + nat) * 16 + d * 4 + h]; Gs[d * 64 + i] = GBG[(size_t)(r0 + nat) * 16 + 8 + d * 4 + h]; }
        SYNC();
        if (tid == 0 || tid == 64) { const int d = tid >> 6; float c = 0.f; for (int i = 0; i < 64; ++i) { c += Gs[d * 64 + i]; Gs[d * 64 + i] = c; } }
        { const int i = tid >> 3, j0 = (tid & 7) * 8; float kk[8], qk[8];
#pragma unroll
          for (int jj = 0; jj < 8; ++jj) { kk[jj] = 0.f; qk[jj] = 0.f; }
          for (int c = 0; c < 128; ++c) { const float ki = (float)kh[i * 136 + c], qi = (float)qh[i * 136 + c];
#pragma unroll
              for (int jj = 0; jj < 8; ++jj) { const float kj = (float)kh[(j0 + jj) * 136 + c]; kk[jj] += ki * kj; qk[jj] += qi * kj; } }
#pragma unroll
          for (int jj = 0; jj < 8; ++jj) { KK[i * 65 + j0 + jj] = kk[jj]; QK[i * 65 + j0 + jj] = qk[jj]; } }
        SYNC();
#pragma unroll 1
        for (int t = 0; t < 16; ++t) { const int idx = tid + NT * t, d = idx >> 12, i = (idx >> 6) & 63, j = idx & 63;
            const int ni = d ? 63 - i : i, nj = d ? 63 - j : j;
            Lm[d * 4160 + i * 65 + j] = (j < i) ? Bs[d * 64 + i] * KK[ni * 65 + nj] * fexp(Gs[d * 64 + i] - Gs[d * 64 + j]) : 0.f; }
        SYNC();
        if (tid < 128) { const int d = tid >> 6, j = tid & 63; const LAS float* L = Lm + d * 4160; LAS float* X = Xs + d * 4160;
#pragma unroll 1
            for (int bi = 0; bi < 4; ++bi) {
                const LAS float* Lb = L + bi * 16 * 65; float a[16];
#pragma unroll
                for (int ii = 0; ii < 16; ++ii) a[ii] = (bi * 16 + ii == j) ? 1.f : 0.f;
                for (int m = 0; m < bi * 16; ++m) { const float xm = X[m * 65 + j];
#pragma unroll
                    for (int ii = 0; ii < 16; ++ii) a[ii] -= Lb[ii * 65 + m] * xm; }
#pragma unroll
                for (int ii = 0; ii < 16; ++ii) { float sacc = a[ii];
#pragma unroll
                    for (int mm = 0; mm < ii; ++mm) sacc -= Lb[ii * 65 + bi * 16 + mm] * a[mm];
                    a[ii] = sacc; }
#pragma unroll
                for (int ii = 0; ii < 16; ++ii) X[(bi * 16 + ii) * 65 + j] = a[ii];
            } }
        SYNC();
#pragma unroll 1
        for (int t = 0; t < 4; ++t) { const int v = tid + NT * t, mat = v >> 9, w = v & 511, i = w >> 3, j8 = (w & 7) * 8, d = mat >> 1, which = mat & 1;
            half8 o;
#pragma unroll
            for (int e = 0; e < 8; ++e) { const int j = j8 + e; float val;
                if (which == 0) val = Xs[d * 4160 + i * 65 + j];
                else { const int ni = d ? 63 - i : i, nj = d ? 63 - j : j; val = (j <= i) ? QK[ni * 65 + nj] * fexp(Gs[d * 64 + i] - Gs[d * 64 + j]) : 0.f; }
                o[e] = (half_t)val; }
            *(half8*)(GTA + ((size_t)((cidx * 4 + h) * 2 + d) * 2 + which) * 4096 + i * 64 + j8) = o; }
        if (tid < 128) GG[(size_t)((cidx * 4 + h) * 2 + (tid >> 6)) * 64 + (tid & 63)] = Gs[tid];
        SYNC();
    }
}

__device__ __forceinline__ void scan_gdn(int wb, const Params& p, int item, LAS unsigned char* lds) {
    const int tid = tid_fresh(wb);
    const int sl = item & 3, d = (item >> 2) & 1, h = (item >> 3) & 3, bl = item >> 5, c0 = sl * 32;
    LAS float* bufA = (LAS float*)lds;
    LAS float* bufK = bufA + 64 * 68;
    LAS float* bufW = bufK + 64 * 132;
    LAS float* S = bufW + 64 * 132;
    LAS float* U = S + 128 * 36;
    LAS float* VN = U + 64 * 36;
    LAS float* VB = VN + 64 * 36;
    LAS float* Gs = VB + 64 * 36;
    LAS float* Bs = Gs + 64;
    const half_t* GQKV = (const half_t*)(p.ws + OFF_GQKV); const float* GBG = (const float*)(p.ws + OFF_GBG);
    const half_t* GTA = (const half_t*)(p.ws + OFF_GTA); const float* GG = (const float*)(p.ws + OFF_GG);
    half_t* SOG = (half_t*)(p.ws + OFF_SOG) + (size_t)d * RGP * 512;
    for (int i = tid; i < 128 * 36; i += NT) S[i] = 0.f;
    SYNC();
    const int nchC = CTXL / 64, nchL = SEQ / 64;
    for (int cs = 0; cs < nchC + nchL; ++cs) {
        const bool isc = cs < nchC; const int cl = isc ? cs : cs - nchC, nch = isc ? nchC : nchL;
        const int cn = d ? nch - 1 - cl : cl;
        const int r0 = (isc ? RL + bl * CTXL : bl * SEQ) + cn * 64, cidx = r0 / 64;
        const size_t tb = (size_t)((cidx * 4 + h) * 2 + d);
        if (tid < 64) { Gs[tid] = GG[tb * 64 + tid]; const int nat = d ? 63 - tid : tid; Bs[tid] = GBG[(size_t)(r0 + nat) * 16 + d * 4 + h]; }
        SYNC();
        for (int v = tid; v < 512; v += NT) { const int i = v >> 3, j8 = (v & 7) * 8; const half8 t = *(const half8*)(GTA + (tb * 2 + 0) * 4096 + i * 64 + j8);
#pragma unroll
            for (int e = 0; e < 8; ++e) bufA[i * 68 + j8 + e] = (float)t[e]; }
        for (int v = tid; v < 1024; v += NT) { const int i = v >> 4, c8 = (v & 15) * 8, nat = d ? 63 - i : i; const float sc = Bs[i] * fexp(Gs[i]);
            const half8 t = *(const half8*)(GQKV + (size_t)(r0 + nat) * 1536 + 512 + h * 128 + c8);
#pragma unroll
            for (int e = 0; e < 8; ++e) bufK[i * 132 + c8 + e] = (float)t[e] * sc; }
        if (tid < 256) { const int i = tid >> 2, c8 = (tid & 3) * 8, nat = d ? 63 - i : i; const half8 t = *(const half8*)(GQKV + (size_t)(r0 + nat) * 1536 + 1024 + h * 128 + c0 + c8);
#pragma unroll
            for (int e = 0; e < 8; ++e) VB[i * 36 + c8 + e] = (float)t[e] * Bs[i]; }
        SYNC();
        { const int i = tid >> 3, cg = (tid & 7) * 16; float a[16];
#pragma unroll
          for (int e = 0; e < 16; ++e) a[e] = 0.f;
          for (int j = 0; j < 64; ++j) { const float t = bufA[i * 68 + j];
#pragma unroll
              for (int e = 0; e < 16; ++e) a[e] += t * bufK[j * 132 + cg + e]; }
#pragma unroll
          for (int e = 0; e < 16; ++e) bufW[i * 132 + cg + e] = a[e]; }
        { const int i = tid >> 3, c4 = (tid & 7) * 4; float a[4] = {0.f, 0.f, 0.f, 0.f};
          for (int j = 0; j < 64; ++j) { const float t = bufA[i * 68 + j];
#pragma unroll
              for (int e = 0; e < 4; ++e) a[e] += t * VB[j * 36 + c4 + e]; }
#pragma unroll
          for (int e = 0; e < 4; ++e) U[i * 36 + c4 + e] = a[e]; }
        SYNC();
        { const int i = tid >> 3, c4 = (tid & 7) * 4; float a[4];
#pragma unroll
          for (int e = 0; e < 4; ++e) a[e] = U[i * 36 + c4 + e];
          for (int k = 0; k < 128; ++k) { const float w = bufW[i * 132 + k];
#pragma unroll
              for (int e = 0; e < 4; ++e) a[e] -= w * S[k * 36 + c4 + e]; }
#pragma unroll
          for (int e = 0; e < 4; ++e) VN[i * 36 + c4 + e] = a[e]; }
        SYNC();
        for (int v = tid; v < 512; v += NT) { const int i = v >> 3, j8 = (v & 7) * 8; const half8 t = *(const half8*)(GTA + (tb * 2 + 1) * 4096 + i * 64 + j8);
#pragma unroll
            for (int e = 0; e < 8; ++e) bufA[i * 68 + j8 + e] = (float)t[e]; }
        for (int v = tid; v < 1024; v += NT) { const int i = v >> 4, c8 = (v & 15) * 8, nat = d ? 63 - i : i; const float sc = fexp(Gs[i]);
            const half8 t = *(const half8*)(GQKV + (size_t)(r0 + nat) * 1536 + h * 128 + c8);
#pragma unroll
            for (int e = 0; e < 8; ++e) bufK[i * 132 + c8 + e] = (float)t[e] * sc; }
        SYNC();
        { const int i = tid >> 3, c4 = (tid & 7) * 4, nat = d ? 63 - i : i; float a[4] = {0.f, 0.f, 0.f, 0.f};
          for (int k = 0; k < 128; ++k) { const float w = bufK[i * 132 + k];
#pragma unroll
              for (int e = 0; e < 4; ++e) a[e] += w * S[k * 36 + c4 + e]; }
          for (int j = 0; j < 64; ++j) { const float t = bufA[i * 68 + j];
#pragma unroll
              for (int e = 0; e < 4; ++e) a[e] += t * VN[j * 36 + c4 + e]; }
          half4 o;
#pragma unroll
          for (int e = 0; e < 4; ++e) o[e] = (half_t)a[e];
          *(half4*)(SOG + (size_t)(r0 + nat) * 512 + h * 128 + c0 + c4) = o; }
        SYNC();
        for (int v = tid; v < 1024; v += NT) { const int i = v >> 4, c8 = (v & 15) * 8, nat = d ? 63 - i : i; const float sc = fexp(Gs[63] - Gs[i]);
            const half8 t = *(const half8*)(GQKV + (size_t)(r0 + nat) * 1536 + 512 + h * 128 + c8);
#pragma unroll
            for (int e = 0; e < 8; ++e) bufK[i * 132 + c8 + e] = (float)t[e] * sc; }
        SYNC();
        { const int k = tid >> 2, c8 = (tid & 3) * 8; const float dec = fexp(Gs[63]); float a[8];
#pragma unroll
          for (int e = 0; e < 8; ++e) a[e] = S[k * 36 + c8 + e] * dec;
          for (int i = 0; i < 64; ++i) { const float w = bufK[i * 132 + k];
#pragma unroll
              for (int e = 0; e < 8; ++e) a[e] += w * VN[i * 36 + c8 + e]; }
#pragma unroll
          for (int e = 0; e < 8; ++e) S[k * 36 + c8 + e] = a[e]; }
        SYNC();
    }
}

__device__ __forceinline__ void scan_mlstm(int wb, const Params& p, int l, int item, LAS unsigned char* lds) {
    const int tid = tid_fresh(wb);
    const int sl = item & 1, d = (item >> 1) & 1, h = (item >> 2) & 3, bl = item >> 4, c0 = sl * 64;
    LAS float* q = (LAS float*)lds;
    LAS float* k = q + 64 * 68;
    LAS float* v = k + 64 * 68;
    LAS float* Pm = v + 64 * 68;
    LAS float* C = Pm + 64 * 68;
    LAS float* nv = C + 64 * 68;
    LAS float* bc = nv + 64;
    LAS float* ig = bc + 64;
    LAS float* mt = ig + 64;
    LAS float* inter = mt + 64;
    LAS float* den = inter + 64;
    LAS float* wsc = den + 64;
    const half_t* P = (const half_t*)(p.ws + OFF_P);
    half_t* SOM = (half_t*)(p.ws + OFF_SOM) + (size_t)d * RGP * 512;
    const float ibias = p.in[I_MIB][l * 8 + d * 4 + h], fbias = p.in[I_MFB][l * 8 + d * 4 + h];
    for (int i = tid; i < 64 * 68; i += NT) C[i] = 0.f;
    if (tid < 64) nv[tid] = 0.f;
    float m = 0.f;
    SYNC();
    const int nchC = CTXL / 64, nchL = SEQ / 64;
    for (int cs = 0; cs < nchC + nchL; ++cs) {
        const bool isc = cs < nchC; const int cl = isc ? cs : cs - nchC, nch = isc ? nchC : nchL;
        const int cn = d ? nch - 1 - cl : cl;
        const int r0 = (isc ? RL + bl * CTXL : bl * SEQ) + cn * 64;
        { const int i = tid >> 3, c8 = (tid & 7) * 8, nat = d ? 63 - i : i; const half_t* pr = P + (size_t)(r0 + nat) * NP + C_ML;
          const half8 tq = *(const half8*)(pr + h * 64 + c8), tk = *(const half8*)(pr + 256 + h * 64 + c8), tv = *(const half8*)(pr + 512 + h * 128 + c0 + c8);
#pragma unroll
          for (int e = 0; e < 8; ++e) { q[i * 68 + c8 + e] = (float)tq[e] * 0.125f; k[i * 68 + c8 + e] = (float)tk[e]; v[i * 68 + c8 + e] = (float)tv[e]; } }
        if (tid < 64) { const int nat = d ? 63 - tid : tid; const half_t* pr = P + (size_t)(r0 + nat) * NP;
            ig[tid] = (float)pr[C_MLIG + d * 4 + h] + ibias; bc[tid] = -softplusf(-((float)pr[C_MLFG + d * 4 + h] + fbias)); }
        SYNC();
        if (tid == 0) { float c = 0.f; for (int i = 0; i < 64; ++i) { c += bc[i]; bc[i] = c; } }
        { const int i = tid >> 3, j0 = (tid & 7) * 8; float a[8];
#pragma unroll
          for (int e = 0; e < 8; ++e) a[e] = 0.f;
          for (int c = 0; c < 64; ++c) { const float qi = q[i * 68 + c];
#pragma unroll
              for (int e = 0; e < 8; ++e) a[e] += qi * k[(j0 + e) * 68 + c]; }
#pragma unroll
          for (int e = 0; e < 8; ++e) Pm[i * 68 + j0 + e] = a[e]; }
        SYNC();
        if (tid < 64) { const int i = tid; float mi = -INFINITY; for (int j = 0; j <= i; ++j) mi = fmaxf(mi, bc[i] - bc[j] + ig[j]);
            const float mm = fmaxf(bc[i] + m, mi); mt[i] = mm; inter[i] = fexp(bc[i] + m - mm); }
        SYNC();
        { const int i = tid >> 3, j0 = (tid & 7) * 8;
#pragma unroll
          for (int e = 0; e < 8; ++e) { const int j = j0 + e; Pm[i * 68 + j] = (j <= i) ? Pm[i * 68 + j] * fexp(bc[i] - bc[j] + ig[j] - mt[i]) : 0.f; } }
        SYNC();
        if (tid < 64) { const int i = tid; float s1 = 0.f, s2 = 0.f; for (int c = 0; c < 64; ++c) s1 += q[i * 68 + c] * nv[c]; for (int j = 0; j < 64; ++j) s2 += Pm[i * 68 + j];
            den[i] = inter[i] * s1 + s2; }
        SYNC();
        { const int i = tid >> 3, c8 = (tid & 7) * 8, nat = d ? 63 - i : i; float a[8], b[8];
#pragma unroll
          for (int e = 0; e < 8; ++e) { a[e] = 0.f; b[e] = 0.f; }
          for (int c = 0; c < 64; ++c) { const float qi = q[i * 68 + c], pj = Pm[i * 68 + c];
#pragma unroll
              for (int e = 0; e < 8; ++e) { a[e] += qi * C[c * 68 + c8 + e]; b[e] += pj * v[c * 68 + c8 + e]; } }
          const float dn = frcp(fmaxf(fabsf(den[i]), fexp(-mt[i]))); half8 o;
#pragma unroll
          for (int e = 0; e < 8; ++e) o[e] = (half_t)((inter[i] * a[e] + b[e]) * dn);
          *(half8*)(SOM + (size_t)(r0 + nat) * 512 + h * 128 + c0 + c8) = o; }
        float mx = -INFINITY; for (int j = 0; j < 64; ++j) mx = fmaxf(mx, bc[63] - bc[j] + ig[j]);
        const float m_new = fmaxf(bc[63] + m, mx), dec = fexp(bc[63] + m - m_new);
        SYNC();
        if (tid < 64) wsc[tid] = fexp(bc[63] - bc[tid] + ig[tid] - m_new);
        SYNC();
        { const int kk = tid >> 3, c8 = (tid & 7) * 8; float a[8];
#pragma unroll
          for (int e = 0; e < 8; ++e) a[e] = C[kk * 68 + c8 + e] * dec;
          for (int j = 0; j < 64; ++j) { const float w = k[j * 68 + kk] * wsc[j];
#pragma unroll
              for (int e = 0; e < 8; ++e) a[e] += w * v[j * 68 + c8 + e]; }
#pragma unroll
          for (int e = 0; e < 8; ++e) C[kk * 68 + c8 + e] = a[e]; }
        if (tid < 64) { float s = nv[tid] * dec; for (int j = 0; j < 64; ++j) s += k[j * 68 + tid] * wsc[j]; nv[tid] = s; }
        m = m_new;
        SYNC();
    }
}

#ifndef CPU_EMU
template <int CTRL> __device__ __forceinline__ float dpp_f(float v) { return __int_as_float(__builtin_amdgcn_update_dpp(0, __float_as_int(v), CTRL, 0xf, 0xf, true)); }
#define RED8(v) do { v += dpp_f<0xB1>(v); v += dpp_f<0x4E>(v); v += dpp_f<0x141>(v); } while (0)
#define RED16(v) do { RED8(v); v += dpp_f<0x140>(v); } while (0)
#else
#define RED8(v) do { v += emu_shfl_xor(v, 1); v += emu_shfl_xor(v, 2); v += emu_shfl_xor(v, 7); } while (0)
#define RED16(v) do { RED8(v); v += emu_shfl_xor(v, 15); } while (0)
#endif
__device__ __forceinline__ void scan_rwkv(int wb, const Params& p, int l, int item, LAS unsigned char* lds) {
    const int tid = tid_fresh(wb), wid = tid >> 6, lane = tid & 63;
    const int d = item & 1, h = (item >> 1) & 7, bl = item >> 4;
    constexpr int NB = 16, REC = 388;
    LAS float* st = (LAS float*)lds;
    const half_t* RW = (const half_t*)(p.ws + OFF_RW); const half_t* RLO = (const half_t*)(p.ws + OFF_RLO);
    float* SOR = (float*)(p.ws + OFF_SOR) + (size_t)d * RGP * 512;
    const int rr = 8 * wid + (lane >> 3), ks = lane & 7;
    const int lt = tid >> 5, cp = tid & 31, lc = h * 64 + 2 * cp;
    const float ka0 = p.in[I_RKA][(size_t)l * 512 + lc], ka1 = p.in[I_RKA][(size_t)l * 512 + lc + 1];
    float s[8];
#pragma unroll
    for (int e = 0; e < 8; ++e) s[e] = 0.f;
    constexpr int NSTEP = CTXL + SEQ, NBATCH = NSTEP / NB;
    auto step_row = [&](int sidx) -> size_t { return sidx < CTXL ? (size_t)(RL + bl * CTXL + (d ? CTXL - 1 - sidx : sidx)) : (size_t)(bl * SEQ + (d ? SEQ - 1 - (sidx - CTXL) : sidx - CTXL)); };
    typedef _Float16 half2v_ __attribute__((ext_vector_type(2)));
    half2v_ g_r, g_k, g_v, g_kk, g_e, g_a;
    auto issue = [&](int n) { const size_t row = step_row(n * NB + lt);
        g_r = *(const half2v_*)(RW + (row * 4 + 0) * 512 + lc); g_k = *(const half2v_*)(RW + (row * 4 + 1) * 512 + lc); g_v = *(const half2v_*)(RW + (row * 4 + 2) * 512 + lc); g_kk = *(const half2v_*)(RW + (row * 4 + 3) * 512 + lc);
        g_e = *(const half2v_*)(RLO + row * 2560 + d * 512 + lc); g_a = *(const half2v_*)(RLO + row * 2560 + 1024 + d * 512 + lc); };
    auto stage = [&](int buf) { LAS float* o = st + (buf * NB + lt) * REC + 2 * cp; float br = 0.f, kr = 0.f;
#pragma unroll
        for (int e = 0; e < 2; ++e) { const float r_ = (float)g_r[e], k_ = (float)g_k[e], kk = (float)g_kk[e], a_ = (float)g_a[e];
            const float w_ = fexp(-(float)g_e[e]), kd = k_ * (1.f + (a_ - 1.f) * (e ? ka1 : ka0)), b_ = kk * a_;
            o[e] = -kk; o[64 + e] = w_ * r_; o[128 + e] = w_; o[192 + e] = b_; o[256 + e] = kd; o[320 + e] = (float)g_v[e]; br += b_ * r_; kr += kd * r_; }
        RED16(br); RED16(kr);
        if ((cp & 15) == 0) { LAS float* sc = st + (buf * NB + lt) * REC + 384; sc[cp >> 4] = br; sc[2 + (cp >> 4)] = kr; } };
    SYNC();
    issue(0); stage(0);
    SYNC();
    for (int n = 0; n < NBATCH; ++n) {
        const int buf = n & 1;
        if (n + 1 < NBATCH) issue(n + 1);
        float ysel = 0.f;
#pragma unroll 1
        for (int th = 0; th < NB / 4; ++th) {
        const int ksl = ks - 4 * (th & 1);
        f32x4 a0, a1, q0, q1, w0, w1, b0, b1, k0, k1, sc; float vv;
#define RWKV_LOAD(T_) do { const LAS float* o = st + (buf * NB + (T_)) * REC; \
            a0 = *(const LAS f32x4*)(o + 8 * ks); a1 = *(const LAS f32x4*)(o + 8 * ks + 4); q0 = *(const LAS f32x4*)(o + 64 + 8 * ks); q1 = *(const LAS f32x4*)(o + 64 + 8 * ks + 4); \
            w0 = *(const LAS f32x4*)(o + 128 + 8 * ks); w1 = *(const LAS f32x4*)(o + 128 + 8 * ks + 4); b0 = *(const LAS f32x4*)(o + 192 + 8 * ks); b1 = *(const LAS f32x4*)(o + 192 + 8 * ks + 4); \
            k0 = *(const LAS f32x4*)(o + 256 + 8 * ks); k1 = *(const LAS f32x4*)(o + 256 + 8 * ks + 4); vv = o[320 + rr]; sc = *(const LAS f32x4*)(o + 384); } while (0)
        RWKV_LOAD(th * 4);
#pragma unroll
        for (int ti = 0; ti < 4; ++ti) {
            const f32x4 ca0 = a0, ca1 = a1, cq0 = q0, cq1 = q1, cw0 = w0, cw1 = w1, cb0 = b0, cb1 = b1, ck0 = k0, ck1 = k1, csc = sc; const float cvv = vv;
            if (ti < 3) RWKV_LOAD(th * 4 + ti + 1);
            float sa = s[0] * ca0[0] + s[1] * ca0[1] + s[2] * ca0[2] + s[3] * ca0[3] + s[4] * ca1[0] + s[5] * ca1[1] + s[6] * ca1[2] + s[7] * ca1[3];
            float yw = s[0] * cq0[0] + s[1] * cq0[1] + s[2] * cq0[2] + s[3] * cq0[3] + s[4] * cq1[0] + s[5] * cq1[1] + s[6] * cq1[2] + s[7] * cq1[3];
            RED8(sa); RED8(yw);
#pragma unroll
            for (int e = 0; e < 4; ++e) { s[e] = s[e] * cw0[e] + (sa * cb0[e] + cvv * ck0[e]); s[4 + e] = s[4 + e] * cw1[e] + (sa * cb1[e] + cvv * ck1[e]); }
            const float y = yw + sa * (csc[0] + csc[1]) + cvv * (csc[2] + csc[3]);
            ysel = (ksl == ti) ? y : ysel;
#ifndef CPU_EMU
            asm volatile("" ::: "memory");
#endif
        }
#undef RWKV_LOAD
        if (th & 1) SOR[step_row(n * NB + (th >> 1) * 8 + ks) * 512 + h * 64 + rr] = ysel;
        }
        if (n + 1 < NBATCH) stage(buf ^ 1);
        SYNC();
    }
}

__device__ __forceinline__ void ph_scan(int wb, const Params& p, int l, LAS unsigned char* lds) {
    constexpr int N_R = BG * 16, N_G = BG * 32, N_M = BG * 16;
    const int G = gridDim.x, c = blockIdx.x;
    if (!(SKIP_MASK & 65536)) for (int item = c; item < N_R; item += G) { scan_rwkv(wb, p, l, item, lds); SYNC(); }
    if (!(SKIP_MASK & 131072)) for (int item = N_R + (((c - N_R) % G) + G) % G; item < N_R + N_G; item += G) { scan_gdn(wb, p, item - N_R, lds); SYNC(); }
    if (!(SKIP_MASK & 262144)) for (int item = N_R + N_G + (((c - N_R - N_G) % G) + G) % G; item < N_R + N_G + N_M; item += G) { scan_mlstm(wb, p, l, item - N_R - N_G, lds); SYNC(); }
}

__device__ __forceinline__ void ph_finish(int wb, const Params& p, int l, int nrows) {
    const int tid = tid_fresh(wb), wid = tid >> 6, lane = tid & 63, c = 8 * lane;
    const half_t* P = (const half_t*)(p.ws + OFF_P); const half_t* RW = (const half_t*)(p.ws + OFF_RW); const half_t* RLO = (const half_t*)(p.ws + OFF_RLO);
    const half_t* SOG = (const half_t*)(p.ws + OFF_SOG); const half_t* SOM = (const half_t*)(p.ws + OFF_SOM); const float* SOR = (const float*)(p.ws + OFF_SOR);
    half_t* BR = (half_t*)(p.ws + OFF_BR);
    for (int r = blockIdx.x * 8 + wid; r < nrows; r += gridDim.x * 8) {
        { const half8 o0 = *(const half8*)(SOG + (size_t)r * 512 + c), o1 = *(const half8*)(SOG + ((size_t)RGP + r) * 512 + c), z = *(const half8*)(P + (size_t)r * NP + C_Z + c);
          float o[8], ss = 0.f;
#pragma unroll
          for (int e = 0; e < 8; ++e) { o[e] = (float)o0[e] + (float)o1[e]; ss += o[e] * o[e]; }
          ss += SHFL_XOR(ss, 1); ss += SHFL_XOR(ss, 2); ss += SHFL_XOR(ss, 4); ss += SHFL_XOR(ss, 8);
          const float rinv = frsq(ss * (1.f / 128.f) + 1e-6f); const float* gn = p.in[I_GNG] + l * 128 + (c & 127); half8 out;
#pragma unroll
          for (int e = 0; e < 8; ++e) out[e] = (half_t)(o[e] * rinv * gn[e] * siluf((float)z[e]));
          *(half8*)(BR + (size_t)r * 512 + c) = out; }
        { float y[8], sm = 0.f;
#pragma unroll
          for (int e = 0; e < 8; ++e) { y[e] = SOR[(size_t)r * 512 + c + e] + SOR[((size_t)RGP + r) * 512 + c + e]; sm += y[e]; }
          sm += SHFL_XOR(sm, 1); sm += SHFL_XOR(sm, 2); sm += SHFL_XOR(sm, 4); const float mean = sm * (1.f / 64.f);
          float vs = 0.f;
#pragma unroll
          for (int e = 0; e < 8; ++e) { const float dlt = y[e] - mean; vs += dlt * dlt; }
          vs += SHFL_XOR(vs, 1); vs += SHFL_XOR(vs, 2); vs += SHFL_XOR(vs, 4); const float rinv = frsq(vs * (1.f / 64.f) + 64e-5f);
          const half8 rv = *(const half8*)(RW + ((size_t)r * 4 + 0) * 512 + c), kv = *(const half8*)(RW + ((size_t)r * 4 + 1) * 512 + c), vv = *(const half8*)(RW + ((size_t)r * 4 + 2) * 512 + c);
          const half8 a0 = *(const half8*)(RLO + (size_t)r * 2560 + 1024 + c), a1 = *(const half8*)(RLO + (size_t)r * 2560 + 1536 + c), gg = *(const half8*)(RLO + (size_t)r * 2560 + 2048 + c);
          const float* ka = p.in[I_RKA] + (size_t)l * 512 + c; const float* rk = p.in[I_RRK] + (size_t)l * 512 + c;
          float bc = 0.f;
#pragma unroll
          for (int e = 0; e < 8; ++e) bc += (float)rv[e] * (float)kv[e] * (2.f + ((float)a0[e] + (float)a1[e] - 2.f) * ka[e]) * rk[e];
          bc += SHFL_XOR(bc, 1); bc += SHFL_XOR(bc, 2); bc += SHFL_XOR(bc, 4);
          const float* lg = p.in[I_RLNG] + (size_t)l * 512 + c; const float* lb = p.in[I_RLNB] + (size_t)l * 512 + c; half8 out;
#pragma unroll
          for (int e = 0; e < 8; ++e) out[e] = (half_t)(((y[e] - mean) * rinv * lg[e] + lb[e] + bc * (float)vv[e]) * (float)gg[e]);
          *(half8*)(BR + ((size_t)RGP + r) * 512 + c) = out; }
        { const half8 h0 = *(const half8*)(SOM + (size_t)r * 512 + c), h1 = *(const half8*)(SOM + ((size_t)RGP + r) * 512 + c), og = *(const half8*)(P + (size_t)r * NP + C_MLO + c);
          float o[8], ss = 0.f;
#pragma unroll
          for (int e = 0; e < 8; ++e) { o[e] = (float)h0[e] + (float)h1[e]; ss += o[e] * o[e]; }
          ss += SHFL_XOR(ss, 1); ss += SHFL_XOR(ss, 2); ss += SHFL_XOR(ss, 4); ss += SHFL_XOR(ss, 8);
          const float rinv = frsq(ss * (1.f / 128.f) + 1e-6f); const float* gn = p.in[I_MNG] + l * 128 + (c & 127); half8 out;
#pragma unroll
          for (int e = 0; e < 8; ++e) out[e] = (half_t)(o[e] * rinv * gn[e] * (float)og[e]);
          *(half8*)(BR + ((size_t)2 * RGP + r) * 512 + c) = out; }
    }
}

__device__ __forceinline__ void ph_norm2(int wb, const Params& p, int l, int g, int nrows, LAS unsigned char* lds) {
    const int tid = tid_fresh(wb), wid = tid >> 6, lane = tid & 63;
    LAS float* rw = (LAS float*)lds;
    for (int i = tid; i < 1024 * 16; i += NT) rw[i] = p.in[I_ROUT][(size_t)l * 1024 * 16 + i];
    SYNC();
    half_t* H = (half_t*)(p.ws + OFF_H); float* PROB = (float*)(p.ws + OFF_PROB);
    for (int r = blockIdx.x * 8 + wid; r < nrows; r += gridDim.x * 8) {
        const float* xr = res_dst(p, g, r); const float* md = mod_row(p, l, g, r); const float* gn = p.in[I_N2G] + l * D;
        float ss = 0.f;
#pragma unroll
        for (int j = 0; j < 4; ++j) { const f32x4 v = *(const f32x4*)(xr + lane * 4 + 256 * j); ss += v[0] * v[0] + v[1] * v[1] + v[2] * v[2] + v[3] * v[3]; }
        ss = wave_sum(ss); const float rinv = frsq(ss * (1.f / D) + 1e-6f);
        float lg[16];
#pragma unroll
        for (int e = 0; e < 16; ++e) lg[e] = 0.f;
#pragma unroll 1
        for (int j = 0; j < 4; ++j) { const int c = lane * 4 + 256 * j; half4 hh; const f32x4 v = *(const f32x4*)(xr + c);
#pragma unroll
            for (int i = 0; i < 4; ++i) { const float hv = v[i] * rinv * gn[c + i] * (1.f + md[4 * 1024 + c + i]) + md[3 * 1024 + c + i]; hh[i] = (half_t)hv;
#pragma unroll
                for (int e = 0; e < 16; ++e) lg[e] += hv * rw[(c + i) * 16 + e]; }
            *(half4*)(H + (size_t)r * D + c) = hh; }
        float mx = -INFINITY;
#pragma unroll
        for (int e = 0; e < 16; ++e) { lg[e] = wave_sum(lg[e]); mx = fmaxf(mx, lg[e]); }
        float sum = 0.f;
#pragma unroll
        for (int e = 0; e < 16; ++e) { lg[e] = fexp(lg[e] - mx); sum += lg[e]; }
        const float inv = frcp(sum);
#pragma unroll
        for (int e = 0; e < 16; ++e) if (lane == e) PROB[(size_t)r * 16 + e] = lg[e] * inv;
    }
}

__device__ __forceinline__ void ph_topk(int wb, const Params& p, int nstreams, LAS unsigned char* lds) {
    const int tid = tid_fresh(wb);
    LAS unsigned* pv = (LAS unsigned*)lds;
    LAS unsigned* hist = pv + (SEQ > CTXL ? SEQ : CTXL);
    LAS int* eqc = (LAS int*)(hist + 256);
    LAS int* gtc = eqc + 512;
    LAS int* posx = gtc + 512;
    LAS int* selrows = posx + 512;
    LAS unsigned* sh = (LAS unsigned*)(selrows + (CAPL > CAPC ? CAPL : CAPC));
    const float* PROB = (const float*)(p.ws + OFF_PROB); int* SLOT = (int*)(p.ws + OFF_SLOT); int* SEL = (int*)(p.ws + OFF_SEL); float* AFF = (float*)(p.ws + OFF_AFF);
    const half_t* H = (const half_t*)(p.ws + OFF_H); half_t* XE = (half_t*)(p.ws + OFF_XE);
    for (int item = blockIdx.x; item < nstreams * BG * 16; item += gridDim.x) {
        const int e = item & 15, bl = (item >> 4) % BG, stc = (item >> 4) / BG;
        const int n = stc ? CTXL : SEQ, cap = n / 8, row0 = stc ? RL + bl * CTXL : bl * SEQ, slot0 = stc ? BG * CAPL + bl * CAPC : bl * CAPL;
        for (int i = tid; i < n; i += NT) pv[i] = __float_as_uint(PROB[(size_t)(row0 + i) * 16 + e]);
        unsigned prefix = 0u, mask = 0u; int kth = cap;
        for (int pass = 3; pass >= 0; --pass) {
            if (tid < 256) hist[tid] = 0u;
            SYNC();
            for (int i = tid; i < n; i += NT) { const unsigned v = pv[i]; if ((v & mask) == prefix) LDS_ATOMIC_INC(&hist[(v >> (8 * pass)) & 255u]); }
            SYNC();
            if (tid == 0) { int cum = 0, b = 255; for (; b > 0; --b) { if (cum + (int)hist[b] >= kth) break; cum += (int)hist[b]; } sh[0] = (unsigned)b; sh[1] = (unsigned)(kth - cum); }
            SYNC();
            prefix |= sh[0] << (8 * pass); mask |= 0xFFu << (8 * pass); kth = (int)sh[1];
            SYNC();
        }
        const unsigned thr = prefix; const int need_eq = kth;
        const int per = (n + NT - 1) / NT, i0 = tid * per, i1 = (i0 + per < n) ? i0 + per : n;
        { int ce = 0, cg = 0; for (int i = i0; i < i1; ++i) { const unsigned v = pv[i]; ce += (v == thr); cg += (v > thr); } eqc[tid] = ce; gtc[tid] = cg; }
        SYNC();
        if (tid == 0) { int eq = 0, pos = 0; for (int t = 0; t < NT; ++t) { const int ce = eqc[t]; int take = need_eq - eq; take = take < 0 ? 0 : (take > ce ? ce : take);
                const int selc = gtc[t] + take; eqc[t] = eq; posx[t] = pos; eq += ce; pos += selc; } }
        SYNC();
        { int eqr = eqc[tid], pos = posx[tid];
          for (int i = i0; i < i1; ++i) { const unsigned v = pv[i]; const bool sel = v > thr || (v == thr && eqr < need_eq); if (v == thr) ++eqr; const int row = row0 + i;
              if (sel) { const int slot = slot0 + pos; SEL[e * RPE + slot] = row; AFF[e * RPE + slot] = __uint_as_float(v); SLOT[(size_t)row * 16 + e] = slot; selrows[pos] = row; ++pos; }
              else SLOT[(size_t)row * 16 + e] = -1; } }
        SYNC();
        for (int idx = tid; idx < cap * 128; idx += NT) { const int j = idx >> 7, v16 = idx & 127;
            *(half8*)(XE + ((size_t)e * RPE + slot0 + j) * 1024 + v16 * 8) = *(const half8*)(H + (size_t)selrows[j] * 1024 + v16 * 8); }
        SYNC();
    }
}

__device__ __forceinline__ void ph_combine(int wb, const Params& p, int l, int g, int nrows) {
    const int tid = tid_fresh(wb), wid = tid >> 6, lane = tid & 63;
    const int* SLOT = (const int*)(p.ws + OFF_SLOT); const half_t* YE = (const half_t*)(p.ws + OFF_YE);
    for (int r = blockIdx.x * 8 + wid; r < nrows; r += gridDim.x * 8) {
        float* xr = res_dst(p, g, r); const float* md = mod_row(p, l, g, r) + 5 * 1024;
        float acc[2][8];
#pragma unroll
        for (int j = 0; j < 2; ++j)
#pragma unroll
            for (int e = 0; e < 8; ++e) acc[j][e] = 0.f;
        for (int ex = 0; ex < 16; ++ex) { const int s = SLOT[(size_t)r * 16 + ex]; if (s < 0) continue;
#pragma unroll
            for (int j = 0; j < 2; ++j) { const half8 y = *(const half8*)(YE + ((size_t)ex * RPE + s) * 1024 + 8 * lane + 512 * j);
#pragma unroll
                for (int e = 0; e < 8; ++e) acc[j][e] += (float)y[e]; } }
        float xv[2][8], ss = 0.f;
#pragma unroll
        for (int j = 0; j < 2; ++j)
#pragma unroll
            for (int e = 0; e < 8; ++e) { const int c = 8 * lane + 512 * j + e; xv[j][e] = xr[c] + md[c] * acc[j][e]; ss += xv[j][e] * xv[j][e]; }
        if (l == DEPTH - 1) { ss = wave_sum(ss); const float rinv = frsq(ss * (1.f / D) + 1e-6f);
#pragma unroll
            for (int j = 0; j < 2; ++j)
#pragma unroll
                for (int e = 0; e < 8; ++e) { const int c = 8 * lane + 512 * j + e; xv[j][e] = xv[j][e] * rinv * p.in[I_FING][c]; } }
#pragma unroll
        for (int j = 0; j < 2; ++j) { *(f32x4*)(xr + 8 * lane + 512 * j) = (f32x4){xv[j][0], xv[j][1], xv[j][2], xv[j][3]}; *(f32x4*)(xr + 8 * lane + 512 * j + 4) = (f32x4){xv[j][4], xv[j][5], xv[j][6], xv[j][7]}; }
    }
}

#ifndef EMU_DUMP
#define EMU_DUMP(tag)
#endif
#ifndef CPU_EMU
extern __shared__ __attribute__((aligned(16))) unsigned char smem_raw[];
__global__ void __launch_bounds__(NT, 2) mega(Params p)
#else
void mega(Params p)
#endif
{
#ifndef CPU_EMU
    LAS unsigned char* lds = (LAS unsigned char*)smem_raw;
    volatile LAS unsigned* xbw = (volatile LAS unsigned*)(lds + SMEM_BYTES - 16);
    if (threadIdx.x == 0) { xbw[0] = 0u; xbw[1] = 0u; xbw[2] = 0u; xbw[3] = 0u; }
    __syncthreads();
    (void)xcd_barrier_post((unsigned*)(p.ws + OFF_BAR), xbw);
#else
    unsigned char* lds = emu_smem();
#endif
#ifndef CPU_EMU
    const int wb = __builtin_amdgcn_readfirstlane((int)threadIdx.x) & ~63;
#else
    const int wb = 0;
#endif
    const int G = gridDim.x, c = blockIdx.x;
    if (!(SKIP_MASK & 1)) ph_mod(wb, p, lds);
    if (!(SKIP_MASK & 2)) ph_convert(wb, p, 0, lds);
    GRID_SYNC();
    for (int l = 0; l < DEPTH; ++l) {
        const bool last = (l == DEPTH - 1);
        const int nact = last ? RL : RG;
        const int nactp = last ? RL : RGP;
        for (int g = 0; g < NGROUP; ++g) {
            if (!(SKIP_MASK & 4)) REPS(4) ph_norm1(wb, p, l, g);
            GRID_SYNC(); EMU_DUMP("norm1");
            if (!(SKIP_MASK & 8)) REPS(8) { pg8::StaticOrder S; S.init(RGP / 256, NP / 256, G, c); EpiP E{(half_t*)(p.ws + OFF_P)};
              pg8::gemm_phase(wb, lds, pg8::Gemm{(const half_t*)(p.ws + OFF_H), (const half_t*)(p.ws + OFF_WIN), 1024}, S, E); }
            GRID_SYNC(); EMU_DUMP("gemm_in");
            if (!(SKIP_MASK & 16)) REPS(16) ph_prep(wb, p, l, lds);
            GRID_SYNC(); EMU_DUMP("prep");
            if (!(SKIP_MASK & 32)) REPS(32) { pg8::StaticOrder S; S.init(RGP / 256, 10, G, c); EpiLora E{(half_t*)(p.ws + OFF_RLO), p.in[I_RW0] + (size_t)l * 1024, p.in[I_RA0] + (size_t)l * 1024};
              pg8::gemm_phase(wb, lds, pg8::Gemm{(const half_t*)(p.ws + OFF_RLI), (const half_t*)(p.ws + OFF_WLORA), 384}, S, E); }
            if (!(SKIP_MASK & 64)) REPS(64) ph_wy(wb, p, lds);
            GRID_SYNC(); EMU_DUMP("wy");
            if (!(SKIP_MASK & 128)) REPS(128) ph_scan(wb, p, l, lds);
            GRID_SYNC(); EMU_DUMP("scan");
            if (!(SKIP_MASK & 256)) REPS(256) ph_finish(wb, p, l, nact);
            GRID_SYNC(); EMU_DUMP("finish");
            if (!(SKIP_MASK & 512)) REPS(512)
#pragma unroll 1
            for (int bi = 0; bi < 3; ++bi) {
                pg8::StaticOrder S; S.init(nactp / 256, 4, G, c); EpiMerge E{(half_t*)(p.ws + OFF_H), (const half_t*)(p.ws + OFF_P), bi};
                pg8::gemm_phase(wb, lds, pg8::Gemm{(const half_t*)(p.ws + OFF_BR) + (size_t)bi * RGP * 512, (const half_t*)(p.ws + OFF_WBR) + (size_t)bi * 1024 * 512, 512}, S, E);
            }
            GRID_SYNC(); EMU_DUMP("merge");
            if (!(SKIP_MASK & 1024)) { pg8::StaticOrder S; S.init(nactp / 256, 4, G, c); EpiOut E{p, l, g};
              pg8::gemm_phase(wb, lds, pg8::Gemm{(const half_t*)(p.ws + OFF_H), (const half_t*)(p.ws + OFF_WOUT), 1024}, S, E); }
            GRID_SYNC(); EMU_DUMP("out");
            if (!(SKIP_MASK & 2048)) REPS(2048) ph_norm2(wb, p, l, g, nact, lds);
            GRID_SYNC(); EMU_DUMP("norm2");
            if (!(SKIP_MASK & 4096)) REPS(4096) ph_topk(wb, p, last ? 1 : 2, lds);
            GRID_SYNC(); EMU_DUMP("topk");
            if (!(SKIP_MASK & 8192)) REPS(8192) { pg8::ExpertOrder S; S.init(G, c); EpiUp E{(half_t*)(p.ws + OFF_HID)};
              pg8::gemm_phase(wb, lds, pg8::Gemm{(const half_t*)(p.ws + OFF_XE), (const half_t*)(p.ws + OFF_WUP), 1024}, S, E); }
            GRID_SYNC();
            if (!(SKIP_MASK & 16384)) REPS(16384) { pg8::ExpertOrder S; S.init(G, c); EpiDown E{(half_t*)(p.ws + OFF_YE), (const float*)(p.ws + OFF_AFF)};
              pg8::gemm_phase(wb, lds, pg8::Gemm{(const half_t*)(p.ws + OFF_HID), (const half_t*)(p.ws + OFF_WDN), 512}, S, E); }
            GRID_SYNC();
            if (!(SKIP_MASK & 32768)) ph_combine(wb, p, l, g, nact);
            if (!(SKIP_MASK & 2)) if (g == NGROUP - 1 && !last) ph_convert(wb, p, l + 1, lds);
            GRID_SYNC(); EMU_DUMP("combine");
        }
    }
}

#ifndef CPU_EMU
extern "C" void kernel_launch(void* const* d_in, const int* in_sizes, int n_in, void* d_out, int out_size, void* d_ws, size_t ws_size, hipStream_t stream) {
    (void)in_sizes; (void)n_in; (void)out_size;
    static int grid = 0;
    if (!grid) {
        int dev = 0, cus = 0, per_cu = 0;
        hipGetDevice(&dev);
        hipDeviceGetAttribute(&cus, hipDeviceAttributeMultiprocessorCount, dev);
        hipFuncSetAttribute((const void*)mega, hipFuncAttributeMaxDynamicSharedMemorySize, SMEM_BYTES);
        hipOccupancyMaxActiveBlocksPerMultiprocessor(&per_cu, (const void*)mega, NT, SMEM_BYTES);
        if (per_cu < 1) per_cu = 1;
        grid = cus;
        if (ws_size < WS_TOTAL) fprintf(stderr, "workspace too small: %zu < %zu\n", ws_size, (size_t)WS_TOTAL);
    }
    hipMemsetAsync((unsigned char*)d_ws + OFF_BAR, 0, 16384, stream);
    Params p{};
    for (int i = 0; i < 34; ++i) p.in[i] = (const float*)d_in[i];
    p.out = (float*)d_out; p.ws = (unsigned char*)d_ws;
    hipLaunchKernelGGL(mega, dim3(grid), dim3(NT), SMEM_BYTES, stream, p);
}
#endif
```

```cpp
#ifndef CPU_EMU
#include <hip/hip_runtime.h>
#include <cstdio>
#include <cstdint>
typedef _Float16 half_t;
typedef _Float16 half8 __attribute__((ext_vector_type(8)));
typedef _Float16 half4 __attribute__((ext_vector_type(4)));
typedef float f32x4 __attribute__((ext_vector_type(4)));
typedef float f32x2 __attribute__((ext_vector_type(2)));
#define LAS __attribute__((address_space(3)))
#define SYNC() __syncthreads()
#define WAVE_SYNC() __builtin_amdgcn_wave_barrier()
template <int M> __device__ __forceinline__ float shfl_xor_t(float v, int tid) {
    if constexpr (M < 32) return __int_as_float(__builtin_amdgcn_ds_swizzle(__float_as_int(v), (M << 10) | 0x1f));
    else return __int_as_float(__builtin_amdgcn_ds_bpermute(((tid ^ 32) & 63) << 2, __float_as_int(v)));
}
#define SHFL_XOR(v, m) shfl_xor_t<m>((v), tid)
#define LDS_ATOMIC_INC(p) __hip_atomic_fetch_add((p), 1u, __ATOMIC_RELAXED, __HIP_MEMORY_SCOPE_WORKGROUP)
#endif

#ifndef CFG_BATCH
#define CFG_BATCH 8
#define CFG_SEQ 4096
#define CFG_CTX 256
#define CFG_DEPTH 4
#define CFG_NGROUP 2
#endif
constexpr int BATCH = CFG_BATCH, SEQ = CFG_SEQ, CTXL = CFG_CTX, DEPTH = CFG_DEPTH, NGROUP = CFG_NGROUP;
#ifndef SKIP_MASK
#define SKIP_MASK 0
#endif
#ifndef REPEAT_MASK
#define REPEAT_MASK 0
#endif
#define REPS(bit) for (int rep_ = 0; rep_ < ((REPEAT_MASK & (bit)) ? 2 : 1); ++rep_)
constexpr int NT = 512;
constexpr int D = 1024;
constexpr int IN_COLS = 8608, NP = 8704;
constexpr int C_Z = 1536, C_BG = 2048;
constexpr int C_RWKV = 2064;
constexpr int C_ML = 3984, C_MLO = 5008, C_MLIG = 5520, C_MLFG = 5528;
constexpr int C_GATE = 5536;
constexpr int BG = BATCH / NGROUP;
constexpr int RL = BG * SEQ, RC = BG * CTXL, RG = RL + RC;
constexpr int RGP = (RG + 255) / 256 * 256;
constexpr int CAPL = SEQ / 8, CAPC = CTXL / 8;
constexpr int RPE = (BG * (CAPL + CAPC) + 255) / 256 * 256;
constexpr int TPE = RPE / 256;
constexpr int NCH = RGP / 64;
static_assert(RL % 256 == 0, "latent rows per group must be a multiple of 256");
static_assert(SEQ % 64 == 0 && CTXL % 64 == 0, "chunks");

constexpr size_t al256(size_t x) { return (x + 255) / 256 * 256; }
constexpr size_t cmax(size_t a, size_t b) { return a > b ? a : b; }
constexpr size_t OFF_BAR = 0;
constexpr size_t OFF_MOD = 16384;
constexpr size_t OFF_CTXR = al256(OFF_MOD + (size_t)DEPTH * (BATCH + 1) * 6144 * 4);
constexpr size_t OFF_WIN = al256(OFF_CTXR + (size_t)BATCH * CTXL * D * 4);
constexpr size_t OFF_WBR = al256(OFF_WIN + (size_t)NP * 1024 * 2);
constexpr size_t OFF_WOUT = al256(OFF_WBR + (size_t)3 * 1024 * 512 * 2);
constexpr size_t OFF_WUP = al256(OFF_WOUT + (size_t)1024 * 1024 * 2);
constexpr size_t OFF_WDN = al256(OFF_WUP + (size_t)16 * 1024 * 1024 * 2);
constexpr size_t OFF_WLORA = al256(OFF_WDN + (size_t)16 * 1024 * 512 * 2);
constexpr size_t OFF_H = al256(OFF_WLORA + (size_t)2560 * 384 * 2);
constexpr size_t OFF_P = al256(OFF_H + (size_t)RGP * 1024 * 2);
constexpr size_t SZ_XE = (size_t)16 * RPE * 1024 * 2, SZ_HID = (size_t)16 * RPE * 512 * 2;
constexpr size_t OFF_XE = OFF_P, OFF_HID = OFF_XE + SZ_XE, OFF_YE = OFF_HID + SZ_HID;
constexpr size_t OFF_GQKV = al256(OFF_P + cmax((size_t)RGP * NP * 2, 2 * SZ_XE + SZ_HID));
constexpr size_t OFF_BR = OFF_GQKV;
constexpr size_t OFF_GBG = al256(OFF_GQKV + (size_t)RGP * 1536 * 2);
constexpr size_t OFF_GTA = al256(OFF_GBG + (size_t)RGP * 16 * 4);
constexpr size_t OFF_GG = al256(OFF_GTA + (size_t)NCH * 4 * 2 * 2 * 4096 * 2);
constexpr size_t OFF_RW = al256(OFF_GG + (size_t)NCH * 4 * 2 * 64 * 4);
constexpr size_t OFF_RLO = al256(OFF_RW + (size_t)RGP * 4 * 512 * 2);
constexpr size_t OFF_SO = al256(OFF_RLO + (size_t)RGP * 2560 * 2);
constexpr size_t OFF_RLI = OFF_SO;
constexpr size_t OFF_SOG = OFF_SO, OFF_SOM = OFF_SOG + (size_t)2 * RGP * 512 * 2, OFF_SOR = OFF_SOM + (size_t)2 * RGP * 512 * 2;
constexpr size_t OFF_PROB = al256(OFF_SOR + (size_t)2 * RGP * 512 * 4);
constexpr size_t OFF_SLOT = al256(OFF_PROB + (size_t)RGP * 16 * 4);
constexpr size_t OFF_SEL = al256(OFF_SLOT + (size_t)RGP * 16 * 4);
constexpr size_t OFF_AFF = al256(OFF_SEL + (size_t)16 * RPE * 4);
constexpr size_t WS_TOTAL = al256(OFF_AFF + (size_t)16 * RPE * 4);
constexpr int SMEM_BYTES = 152 * 1024;

struct Params { const float* in[34]; float* out; unsigned char* ws; };
enum { I_X = 0, I_C, I_CTX, I_CCTX, I_ADAW, I_ADAB, I_N1G, I_N2G, I_WIN, I_GCONV, I_GALOG, I_GDTB, I_GNG, I_RMU, I_RW0, I_RWUP, I_RA0, I_RAUP, I_RGUP,
       I_RKK, I_RKA, I_RRK, I_RLNG, I_RLNB, I_MIB, I_MFB, I_MNG, I_WBR, I_WOUT, I_ROUT, I_W1, I_W3, I_W2, I_FING };

#ifndef CPU_EMU
__device__ __forceinline__ int tid_fresh(int wb) { int t; asm volatile("v_mbcnt_lo_u32_b32 %0, -1, 0\n\tv_mbcnt_hi_u32_b32 %0, -1, %0" : "=v"(t)); return wb + t; }
#else
static inline int tid_fresh(int) { return threadIdx.x; }
#endif
#ifndef CPU_EMU
__device__ __forceinline__ float fexp(float x) { return __builtin_amdgcn_exp2f(x * 1.4426950408889634f); }
__device__ __forceinline__ float flog(float x) { return __builtin_amdgcn_logf(x) * 0.6931471805599453f; }
__device__ __forceinline__ float frcp(float x) { return __builtin_amdgcn_rcpf(x); }
__device__ __forceinline__ float frsq(float x) { return __builtin_amdgcn_rsqf(x); }
#else
static inline float fexp(float x) { return expf(x); }
static inline float flog(float x) { return logf(x); }
static inline float frcp(float x) { return 1.f / x; }
static inline float frsq(float x) { return 1.f / sqrtf(x); }
#endif
__device__ __forceinline__ float sigm(float x) { return frcp(1.f + fexp(-x)); }
__device__ __forceinline__ float siluf(float x) { return x * frcp(1.f + fexp(-x)); }
__device__ __forceinline__ float ftanh(float x) { return 1.f - 2.f * frcp(1.f + fexp(2.f * x)); }
__device__ __forceinline__ float softplusf(float x) { const float t = fexp(x); return x > 15.f ? x : (t < 1e-3f ? t * (1.f - 0.5f * t) : flog(1.f + t)); }
#define wave_sum(x) wave_sum_(x, tid)
__device__ __forceinline__ float wave_sum_(float v, int tid) { v += SHFL_XOR(v, 32); v += SHFL_XOR(v, 16); v += SHFL_XOR(v, 8); v += SHFL_XOR(v, 4); v += SHFL_XOR(v, 2); v += SHFL_XOR(v, 1); return v; }

__device__ __forceinline__ const float* res_src(const Params& p, int l, int g, int r) {
    if (r < RL) { const size_t t = (size_t)(g * BG) * SEQ + r; return (l == 0 ? p.in[I_X] : p.out) + t * D; }
    const size_t t = (size_t)(g * BG) * CTXL + (r - RL); return (l == 0 ? p.in[I_CTX] : (const float*)(p.ws + OFF_CTXR)) + t * D;
}
__device__ __forceinline__ float* res_dst(const Params& p, int g, int r) {
    if (r < RL) { const size_t t = (size_t)(g * BG) * SEQ + r; return p.out + t * D; }
    const size_t t = (size_t)(g * BG) * CTXL + (r - RL); return (float*)(p.ws + OFF_CTXR) + t * D;
}
__device__ __forceinline__ const float* mod_row(const Params& p, int l, int g, int r) {
    const int s = r < RL ? (g * BG + r / SEQ) : BATCH; return (const float*)(p.ws + OFF_MOD) + ((size_t)l * (BATCH + 1) + s) * 6144;
}

#ifndef CPU_EMU
#define XB_TMO      128
#define XB_XCNT(j)  (256  + 64 * (j))
#define XB_XSUB(j)  (1280 + 64 * (j))
#define XB_XGEN(j)  (2304 + 64 * (j))
#define XB_TOP      3328
#define XB_TOPGEN   3392
#define XCD_BAR_WORDS 3456
#define XB_SPIN_CAP (1u << 22)
__device__ __forceinline__ unsigned xb_ld(unsigned* p)              { return __hip_atomic_load(p, __ATOMIC_RELAXED, __HIP_MEMORY_SCOPE_AGENT); }
__device__ __forceinline__ unsigned xb_add(unsigned* p, unsigned v) { return __hip_atomic_fetch_add(p, v, __ATOMIC_RELAXED, __HIP_MEMORY_SCOPE_AGENT); }
__device__ __forceinline__ unsigned xb_xcc_id() { return (unsigned)__builtin_amdgcn_s_getreg((3 << 11) | 20) & 0xFu; }
#define XB_SPIN(cond, bar) do { unsigned _sp = 0; while (cond) { __builtin_amdgcn_s_sleep(1); \
    if ((++_sp & 255u) == 0u) { if (xb_ld(&(bar)[XB_TMO])) break; if (_sp > XB_SPIN_CAP) { atomicAdd(&(bar)[XB_TMO], 1u); break; } } } } while (0)
struct XcdBarrier { unsigned* bar; unsigned x; volatile LAS unsigned* st; };
__device__ __forceinline__ XcdBarrier xcd_barrier_post(unsigned* bar, volatile LAS unsigned* st) {
    XcdBarrier b; b.bar = bar; b.x = xb_xcc_id(); b.st = st;
    if (threadIdx.x == 0) (void)xb_add(&bar[XB_XCNT(b.x)], 1u);
    return b;
}
__device__ __forceinline__ void xcd_barrier_complete(unsigned* bar, unsigned x, unsigned& nloc, unsigned& nx) {
    const unsigned G = gridDim.x * gridDim.y * gridDim.z;
    unsigned sum, cnt, mine, sp = 0u;
    for (;;) {
        sum = 0u; cnt = 0u; mine = 0u;
#pragma unroll
        for (unsigned j = 0; j < 16; ++j) { const unsigned c = xb_ld(&bar[XB_XCNT(j)]); sum += c; cnt += (c > 0u) ? 1u : 0u; mine = (j == x) ? c : mine; }
        if (sum == G) break;
        __builtin_amdgcn_s_sleep(1);
        if ((++sp & 255u) == 0u) { if (xb_ld(&bar[XB_TMO])) break; if (sp > XB_SPIN_CAP) { atomicAdd(&bar[XB_TMO], 1u); break; } }
    }
    nloc = mine > 0u ? mine : 1u; nx = cnt > 0u ? cnt : 1u;
}
__device__ __forceinline__ void xcd_barrier(const XcdBarrier& b) {
    asm volatile("s_waitcnt vmcnt(0)" ::: "memory");
    __syncthreads();
    if (threadIdx.x == 0) {
        unsigned* bar = b.bar;
        __builtin_amdgcn_s_waitcnt(0);
        unsigned nloc = b.st[0], nx = b.st[1];
        if (nloc == 0u) { xcd_barrier_complete(bar, b.x, nloc, nx); b.st[0] = nloc; b.st[1] = nx; }
        const unsigned old = xb_add(&bar[XB_XSUB(b.x)], 1u);
        const unsigned gen = old / nloc;
        if (old + 1u == (gen + 1u) * nloc) {
            __builtin_amdgcn_fence(__ATOMIC_RELEASE, "agent");
            asm volatile("s_waitcnt vmcnt(0)" ::: "memory");
            const unsigned og = xb_add(&bar[XB_TOP], 1u);
            const unsigned tg = og / nx;
            if (og + 1u == (tg + 1u) * nx) xb_add(&bar[XB_TOPGEN], 1u);
            else XB_SPIN(xb_ld(&bar[XB_TOPGEN]) == tg, bar);
            __builtin_amdgcn_fence(__ATOMIC_ACQUIRE, "agent");
            xb_add(&bar[XB_XGEN(b.x)], 1u);
            asm volatile("s_waitcnt vmcnt(0)" ::: "memory");
        } else {
            XB_SPIN(xb_ld(&bar[XB_XGEN(b.x)]) == gen, bar);
            __builtin_amdgcn_fence(__ATOMIC_ACQUIRE, "agent");
            asm volatile("s_waitcnt vmcnt(0)" ::: "memory");
        }
    }
    __syncthreads();
}
#define GRID_SYNC() do { XcdBarrier gb_; gb_.bar = (unsigned*)(p.ws + OFF_BAR); gb_.x = xb_xcc_id(); gb_.st = (volatile LAS unsigned*)(lds + SMEM_BYTES - 16); xcd_barrier(gb_); } while (0)
#else
#define GRID_SYNC() emu_grid_sync()
#endif

namespace pg8 {
constexpr int BM = 256, BK = 64, HALF = 128, HTB = HALF * BK * 2, STAGE_BYTES = 8 * HTB, NXCD = 8, WGM = 8;
__host__ __device__ __forceinline__ int lds_byte(int r, int c) { const int st = (r >> 4) * 2 + (c >> 5), rr = r & 15, cc = c & 31, ob = rr * 64 + cc * 2; return st * 1024 + (ob ^ (((ob >> 9) & 1) << 5)); }
__host__ __device__ __forceinline__ void stage_rc(int b, int& R, int& C) { const int st = b / 1024, sb = b % 1024, swz = sb ^ (((sb >> 9) & 1) << 5); R = (st >> 1) * 16 + swz / 64; C = (st & 1) * 32 + (swz % 64) / 2; }
__host__ __device__ __forceinline__ int perm32(int rho) { const int n = rho >> 4, i = rho & 15; return 8 * (i >> 2) + 4 * n + (i & 3); }
struct Unit { int pm, pn, pb; };
struct Gemm { const half_t* A; const half_t* Bt; int K; };
struct StaticOrder {
    int nM, nN, nwg, G, c;
    __device__ void init(int nM_, int nN_, int G_, int c_) { nM = nM_; nN = nN_; nwg = nM * nN; G = G_; c = c_; }
    __device__ bool next(int i, Unit& u) const {
        const long L = (long)i * G + c; if (L >= nwg) return false;
        int wgid = (int)L; { const int q = nwg / NXCD, r = nwg % NXCD, xcd = wgid % NXCD, off = wgid / NXCD; wgid = (xcd < r ? xcd * (q + 1) : r * (q + 1) + (xcd - r) * q) + off; }
        const int nig = WGM * nN, gid = wgid / nig, fm = gid * WGM, gsz = (nM - fm) < WGM ? (nM - fm) : WGM;
        u.pm = fm + ((wgid % nig) % gsz); u.pn = (wgid % nig) / gsz; u.pb = u.pn; return true;
    }
};
struct ExpertOrder {
    int G, c;
    __device__ void init(int G_, int c_) { G = G_; c = c_; }
    __device__ bool next(int i, Unit& u) const {
        const long L = (long)i * G + c; if (L >= 16 * TPE * 4) return false;
        const int e = (int)L / (TPE * 4), rem = (int)L % (TPE * 4);
        u.pm = e * TPE + rem / 4; u.pn = rem % 4; u.pb = e * 4 + u.pn; return true;
    }
};

#ifndef CPU_EMU
template <class Epi, class Sched>
__device__ __forceinline__ void gemm_phase(int wb, LAS unsigned char* lds, const Gemm g, const Sched& S, const Epi& E) {
    const int tid = tid_fresh(wb), wid = __builtin_amdgcn_readfirstlane(tid >> 6), lane = tid & 63, wr = wid >> 2, wc = wid & 3, fr = lane & 15, fq = lane >> 4;
    const int K = g.K, nt = K / BK;
    unsigned voffA[2], voffB[2];
#pragma unroll
    for (int i = 0; i < 2; ++i) { int R, C; stage_rc(tid * 16 + i * 8192, R, C); const int Rb = Epi::PERM ? ((R & ~31) + perm32(R & 31)) : R;
        voffA[i] = (unsigned)(R * K + C) * 2u; voffB[i] = (unsigned)(Rb * K + C) * 2u; }
    const size_t kstep = (size_t)(BK * 2);
    const size_t hstep = (size_t)HALF * K * 2;
    const size_t tstep = 2 * hstep;
    const unsigned ldsw = (unsigned)wid * 1024u;
    const int aoff = lds_byte(wr * 64 + fr, fq * 8), boff = lds_byte(wc * 32 + fr, fq * 8);
#define PG8_SA(b, h) (((b) * 2 + (h)) * HTB)
#define PG8_SB(b, h) ((4 + (b) * 2 + (h)) * HTB)
#define PG8_STAGE(bufoff, gbase, voff) do { _Pragma("unroll") for (int _i = 0; _i < 2; ++_i) \
        __builtin_amdgcn_global_load_lds((const unsigned*)((const char*)(gbase) + (voff)[_i]), (LAS unsigned*)(lds + (bufoff) + ldsw + _i * 8192), 16, 0, 0); } while (0)
#define PG8_LDA(dst, b, h) do { _Pragma("unroll") for (int m = 0; m < 4; ++m) _Pragma("unroll") for (int k = 0; k < 2; ++k) dst[m][k] = *(const LAS half8*)(lds + PG8_SA(b, h) + aoff + m * 2048 + k * 1024); } while (0)
#define PG8_LDB(dst, b, h) do { _Pragma("unroll") for (int n = 0; n < 2; ++n) _Pragma("unroll") for (int k = 0; k < 2; ++k) dst[n][k] = *(const LAS half8*)(lds + PG8_SB(b, h) + boff + n * 2048 + k * 1024); } while (0)
#define PG8_MMA(ai, bj, At, Bt) do { __builtin_amdgcn_s_setprio(1); _Pragma("unroll") for (int m = 0; m < 4; ++m) _Pragma("unroll") for (int n = 0; n < 2; ++n) _Pragma("unroll") for (int k = 0; k < 2; ++k) \
        acc[ai][bj][m][n] = __builtin_amdgcn_mfma_f32_16x16x32_f16(Bt[n][k], At[m][k], acc[ai][bj][m][n], 0, 0, 0); __builtin_amdgcn_s_setprio(0); } while (0)
#define PG8_WAIT_V(n) asm volatile("s_waitcnt vmcnt(" #n ")" ::: "memory")
#define PG8_WAIT_L(n) asm volatile("s_waitcnt lgkmcnt(" #n ")" ::: "memory")
#define PG8_BAR __builtin_amdgcn_s_barrier()
#define PG8_SCHED __builtin_amdgcn_sched_barrier(0)
    Unit cur, nxt; int ui = 0;
    if (!S.next(0, cur)) return;
    f32x4 acc[2][2][4][2];
#pragma unroll
    for (int a = 0; a < 2; ++a)
#pragma unroll
        for (int b = 0; b < 2; ++b)
#pragma unroll
            for (int m = 0; m < 4; ++m)
#pragma unroll
                for (int n = 0; n < 2; ++n) acc[a][b][m][n] = (f32x4){0.f, 0.f, 0.f, 0.f};
    half8 At[4][2], B0[2][2], B1[2][2];
    const char* cA = (const char*)g.A + (size_t)cur.pm * tstep; const char* cB = (const char*)g.Bt + (size_t)cur.pb * tstep;
    PG8_STAGE(PG8_SB(0, 0), cB, voffB); PG8_STAGE(PG8_SA(0, 0), cA, voffA); PG8_STAGE(PG8_SB(0, 1), cB + hstep, voffB); PG8_STAGE(PG8_SA(0, 1), cA + hstep, voffA);
    if (wr == 1) PG8_BAR;
    PG8_WAIT_V(4); PG8_BAR;
    PG8_STAGE(PG8_SB(1, 0), cB + kstep, voffB); PG8_STAGE(PG8_SA(1, 0), cA + kstep, voffA); PG8_STAGE(PG8_SB(1, 1), cB + hstep + kstep, voffB);
    PG8_WAIT_V(6); PG8_BAR;
    for (;;) {
        const bool has_next = S.next(ui + 1, nxt);
        const char* nA = has_next ? (const char*)g.A + (size_t)nxt.pm * tstep : cA; const char* nB = has_next ? (const char*)g.Bt + (size_t)nxt.pb * tstep : cB;
#pragma unroll 1
        for (int t = 0; t < nt; t += 2) {
            const bool last = (t == nt - 2);
            const char* a1 = cA + (size_t)(t + 1) * kstep;
            const char* a2 = last ? nA : cA + (size_t)(t + 2) * kstep; const char* b2 = last ? nB : cB + (size_t)(t + 2) * kstep;
            const char* a3 = a2 + kstep; const char* b3 = b2 + kstep;
            PG8_LDB(B0, 0, 0); PG8_SCHED; PG8_LDA(At, 0, 0); PG8_STAGE(PG8_SA(1, 1), a1 + hstep, voffA);
            PG8_WAIT_L(8); PG8_BAR; PG8_WAIT_L(0); PG8_MMA(0, 0, At, B0); PG8_BAR; PG8_SCHED;
            PG8_LDB(B1, 0, 1); PG8_STAGE(PG8_SB(0, 0), b2, voffB);
            PG8_BAR; PG8_WAIT_L(0); PG8_MMA(0, 1, At, B1); PG8_BAR;
            PG8_LDA(At, 0, 1); PG8_STAGE(PG8_SA(0, 0), a2, voffA);
            PG8_BAR; PG8_WAIT_L(0); PG8_MMA(1, 0, At, B0); PG8_BAR; PG8_SCHED;
            PG8_STAGE(PG8_SB(0, 1), b2 + hstep, voffB);
            PG8_WAIT_V(6); PG8_BAR; PG8_MMA(1, 1, At, B1); PG8_BAR;
            PG8_LDB(B0, 1, 0); PG8_SCHED; PG8_LDA(At, 1, 0); PG8_STAGE(PG8_SA(0, 1), a2 + hstep, voffA);
            PG8_WAIT_L(8); PG8_BAR; PG8_WAIT_L(0); PG8_MMA(0, 0, At, B0); PG8_BAR; PG8_SCHED;
            PG8_LDB(B1, 1, 1); PG8_STAGE(PG8_SB(1, 0), b3, voffB);
            PG8_BAR; PG8_WAIT_L(0); PG8_MMA(0, 1, At, B1); PG8_BAR;
            PG8_LDA(At, 1, 1); PG8_STAGE(PG8_SA(1, 0), a3, voffA);
            PG8_BAR; PG8_WAIT_L(0); PG8_MMA(1, 0, At, B0); PG8_BAR; PG8_SCHED;
            PG8_STAGE(PG8_SB(1, 1), b3 + hstep, voffB);
            PG8_WAIT_V(6); PG8_BAR; PG8_MMA(1, 1, At, B1); PG8_BAR;
        }
        E(acc, cur, wr, wc, fr, fq);
        if (!has_next) break;
#pragma unroll
        for (int a = 0; a < 2; ++a)
#pragma unroll
            for (int b = 0; b < 2; ++b)
#pragma unroll
                for (int m = 0; m < 4; ++m)
#pragma unroll
                    for (int n = 0; n < 2; ++n) acc[a][b][m][n] = (f32x4){0.f, 0.f, 0.f, 0.f};
        cur = nxt; cA = nA; cB = nB; ++ui;
    }
    PG8_WAIT_V(0);
    if (wr == 0) PG8_BAR;
    PG8_BAR;
#undef PG8_SA
#undef PG8_SB
#undef PG8_STAGE
#undef PG8_LDA
#undef PG8_LDB
#undef PG8_MMA
#undef PG8_WAIT_V
#undef PG8_WAIT_L
#undef PG8_BAR
#undef PG8_SCHED
}
#else
static float* emu_fa[64]; static float* emu_fb[64];
template <class Epi, class Sched>
void gemm_phase(int wb, LAS unsigned char* lds, const Gemm g, const Sched& S, const Epi& E) {
    const int tid = tid_fresh(wb), wid = tid >> 6, lane = tid & 63, wr = wid >> 2, wc = wid & 3, fr = lane & 15, fq = lane >> 4;
    const int K = g.K; const int bid = blockIdx.x;
    Unit u;
    for (int ui = 0; S.next(ui, u); ++ui) {
        SYNC();
        if (tid == 0) {
            if (!emu_fa[bid]) { emu_fa[bid] = (float*)malloc(256 * 1024 * 4); emu_fb[bid] = (float*)malloc(256 * 1024 * 4); }
            for (int r = 0; r < 256; ++r) for (int k = 0; k < K; ++k) { emu_fa[bid][r * K + k] = (float)g.A[((size_t)u.pm * 256 + r) * K + k]; emu_fb[bid][r * K + k] = (float)g.Bt[((size_t)u.pb * 256 + r) * K + k]; }
        }
        SYNC();
        f32x4 acc[2][2][4][2];
        for (int ai = 0; ai < 2; ++ai) for (int bj = 0; bj < 2; ++bj) for (int m = 0; m < 4; ++m) for (int n = 0; n < 2; ++n) for (int i = 0; i < 4; ++i) {
            const int row = 128 * ai + 64 * wr + 16 * m + fr;
            const int col = Epi::PERM ? (128 * bj + 32 * wc + 8 * fq + 4 * n + i) : (128 * bj + 32 * wc + 16 * n + 4 * fq + i);
            const float* a = emu_fa[bid] + row * K; const float* b = emu_fb[bid] + col * K; float s = 0.f;
            for (int k = 0; k < K; ++k) s += a[k] * b[k];
            acc[ai][bj][m][n][i] = s; }
        E(acc, u, wr, wc, fr, fq);
    }
    SYNC();
}
#endif
}
using pg8::Unit;

struct EpiP {
    static constexpr bool PERM = true;
    half_t* P;
    __device__ __forceinline__ void operator()(const f32x4 (&acc)[2][2][4][2], const Unit& u, int wr, int wc, int fr, int fq) const {
        const int row0 = u.pm * 256 + wr * 64 + fr, col0 = u.pn * 256 + wc * 32 + 8 * fq;
#pragma unroll
        for (int bj = 0; bj < 2; ++bj) {
            const int col = col0 + bj * 128;
            const bool sg = (col >= C_GATE && col < IN_COLS) || (col >= C_MLO && col < C_MLIG);
#pragma unroll
            for (int ai = 0; ai < 2; ++ai)
#pragma unroll
                for (int m = 0; m < 4; ++m) {
                    half8 h;
#pragma unroll
                    for (int n = 0; n < 2; ++n)
#pragma unroll
                        for (int i = 0; i < 4; ++i) { float v = acc[ai][bj][m][n][i]; if (sg) v = sigm(v); h[4 * n + i] = (half_t)v; }
                    *(half8*)(P + (size_t)(row0 + ai * 128 + m * 16) * NP + col) = h;
                }
        }
    }
};
struct EpiLora {
    static constexpr bool PERM = true;
    half_t* O; const float* w0; const float* a0;
    __device__ __forceinline__ void operator()(const f32x4 (&acc)[2][2][4][2], const Unit& u, int wr, int wc, int fr, int fq) const {
        const int row0 = u.pm * 256 + wr * 64 + fr, col0 = u.pn * 256 + wc * 32 + 8 * fq;
#pragma unroll
        for (int bj = 0; bj < 2; ++bj) {
            const int col = col0 + bj * 128, blk = col >> 9;
            float bias[8];
#pragma unroll
            for (int j = 0; j < 8; ++j) bias[j] = blk < 2 ? w0[col + j] : (blk < 4 ? a0[col - 1024 + j] : 0.f);
#pragma unroll
            for (int ai = 0; ai < 2; ++ai)
#pragma unroll
                for (int m = 0; m < 4; ++m) {
                    half8 h;
#pragma unroll
                    for (int n = 0; n < 2; ++n)
#pragma unroll
                        for (int i = 0; i < 4; ++i) { float v = acc[ai][bj][m][n][i] + bias[4 * n + i];
                            if (blk < 2) v = sigm(v) * 0.6065306597126334f; else if (blk < 4) v = sigm(v);
                            h[4 * n + i] = (half_t)v; }
                    *(half8*)(O + (size_t)(row0 + ai * 128 + m * 16) * 2560 + col) = h;
                }
        }
    }
};
struct EpiMerge {
    static constexpr bool PERM = true;
    half_t* M; const half_t* P; int bi;
    __device__ __forceinline__ void operator()(const f32x4 (&acc)[2][2][4][2], const Unit& u, int wr, int wc, int fr, int fq) const {
        const int row0 = u.pm * 256 + wr * 64 + fr, col0 = u.pn * 256 + wc * 32 + 8 * fq;
#pragma unroll
        for (int ai = 0; ai < 2; ++ai)
#pragma unroll
            for (int m = 0; m < 4; ++m) {
                const size_t row = (size_t)(row0 + ai * 128 + m * 16);
#pragma unroll
                for (int bj = 0; bj < 2; ++bj) {
                    const int col = col0 + bj * 128;
                    const half8 gt = *(const half8*)(P + row * NP + C_GATE + bi * 1024 + col);
                    half8 o; if (bi > 0) o = *(const half8*)(M + row * 1024 + col);
#pragma unroll
                    for (int n = 0; n < 2; ++n)
#pragma unroll
                        for (int i = 0; i < 4; ++i) { float v = (float)gt[4 * n + i] * acc[ai][bj][m][n][i]; if (bi > 0) v += (float)o[4 * n + i]; o[4 * n + i] = (half_t)v; }
                    *(half8*)(M + row * 1024 + col) = o;
                }
            }
    }
};
struct EpiOut {
    static constexpr bool PERM = false;
    Params p; int l, g;
    __device__ __forceinline__ void operator()(const f32x4 (&acc)[2][2][4][2], const Unit& u, int wr, int wc, int fr, int fq) const {
        const int row0 = u.pm * 256 + wr * 64 + fr, col0 = u.pn * 256 + wc * 32 + 4 * fq;
#pragma unroll
        for (int ai = 0; ai < 2; ++ai)
#pragma unroll
            for (int m = 0; m < 4; ++m) {
                const int row = row0 + ai * 128 + m * 16;
                if (row < RG) {
                    const float* src = res_src(p, l, g, row); float* dst = res_dst(p, g, row); const float* md = mod_row(p, l, g, row) + 2 * 1024;
#pragma unroll
                    for (int bj = 0; bj < 2; ++bj)
#pragma unroll
                        for (int n = 0; n < 2; ++n) { const int col = col0 + bj * 128 + n * 16;
                            const f32x4 xo = *(const f32x4*)(src + col), mv = *(const f32x4*)(md + col);
                            *(f32x4*)(dst + col) = xo + mv * acc[ai][bj][m][n]; }
                }
            }
    }
};
struct EpiUp {
    static constexpr bool PERM = true;
    half_t* HID;
    __device__ __forceinline__ void operator()(const f32x4 (&acc)[2][2][4][2], const Unit& u, int wr, int wc, int fr, int fq) const {
        const int row0 = u.pm * 256 + wr * 64 + fr, col = u.pn * 128 + wc * 32 + 8 * fq;
#pragma unroll
        for (int ai = 0; ai < 2; ++ai)
#pragma unroll
            for (int m = 0; m < 4; ++m) {
                half8 h;
#pragma unroll
                for (int n = 0; n < 2; ++n)
#pragma unroll
                    for (int i = 0; i < 4; ++i) h[4 * n + i] = (half_t)(siluf(acc[ai][0][m][n][i]) * acc[ai][1][m][n][i]);
                *(half8*)(HID + (size_t)(row0 + ai * 128 + m * 16) * 512 + col) = h;
            }
    }
};
struct EpiDown {
    static constexpr bool PERM = true;
    half_t* YE; const float* AFF;
    __device__ __forceinline__ void operator()(const f32x4 (&acc)[2][2][4][2], const Unit& u, int wr, int wc, int fr, int fq) const {
        const int row0 = u.pm * 256 + wr * 64 + fr, col0 = u.pn * 256 + wc * 32 + 8 * fq;
#pragma unroll
        for (int ai = 0; ai < 2; ++ai)
#pragma unroll
            for (int m = 0; m < 4; ++m) {
                const size_t row = (size_t)(row0 + ai * 128 + m * 16); const float af = AFF[row];
#pragma unroll
                for (int bj = 0; bj < 2; ++bj) {
                    half8 h;
#pragma unroll
                    for (int n = 0; n < 2; ++n)
#pragma unroll
                        for (int i = 0; i < 4; ++i) h[4 * n + i] = (half_t)(acc[ai][bj][m][n][i] * af);
                    *(half8*)(YE + row * 1024 + col0 + bj * 128) = h;
                }
            }
    }
};

__device__ __forceinline__ void ph_mod(int wb, const Params& p, LAS unsigned char* lds) {
    LAS float* sv = (LAS float*)lds; LAS float* red = sv + (BATCH + 1) * 1024;
    const int tid = tid_fresh(wb);
    for (int i = tid; i < (BATCH + 1) * 1024; i += NT) { const int s = i >> 10, k = i & 1023; const float cv = s < BATCH ? p.in[I_C][s * 1024 + k] : p.in[I_CCTX][k]; sv[i] = siluf(cv); }
    SYNC();
    float* mod = (float*)(p.ws + OFF_MOD);
    for (int item = blockIdx.x; item < DEPTH * 48; item += gridDim.x) {
        const int l = item / 48, j = (item % 48) * 128 + (tid & 127), kq = tid >> 7;
        float acc[BATCH + 1];
#pragma unroll
        for (int s = 0; s <= BATCH; ++s) acc[s] = 0.f;
        const float* w = p.in[I_ADAW] + (size_t)l * 1024 * 6144 + j;
        for (int k = kq * 256; k < kq * 256 + 256; ++k) { const float wv = w[(size_t)k * 6144];
#pragma unroll
            for (int s = 0; s <= BATCH; ++s) acc[s] += sv[s * 1024 + k] * wv; }
#pragma unroll
        for (int s = 0; s <= BATCH; ++s) red[tid * (BATCH + 1) + s] = acc[s];
        SYNC();
        if (tid < 128) {
#pragma unroll
            for (int s = 0; s <= BATCH; ++s) { float v = p.in[I_ADAB][l * 6144 + j];
                for (int q = 0; q < 4; ++q) v += red[(q * 128 + tid) * (BATCH + 1) + s];
                mod[((size_t)l * (BATCH + 1) + s) * 6144 + j] = v; }
        }
        SYNC();
    }
}

__device__ __forceinline__ void tconv_tile(int wb, const float* src, int sld, int k0, int n0, int nvalid, half_t* dst, int dld, int drow0, int dcol0, LAS float* tile) {
    const int tid = tid_fresh(wb), r = tid >> 4, c4 = (tid & 15) * 4;
#pragma unroll
    for (int j = 0; j < 2; ++j) { const int k = r + 32 * j; f32x4 v = {0.f, 0.f, 0.f, 0.f};
        if (src && n0 + c4 < nvalid) v = *(const f32x4*)(src + (size_t)(k0 + k) * sld + n0 + c4);
        tile[k * 65 + c4] = v[0]; tile[k * 65 + c4 + 1] = v[1]; tile[k * 65 + c4 + 2] = v[2]; tile[k * 65 + c4 + 3] = v[3]; }
    SYNC();
    const int n = tid >> 3, k8 = (tid & 7) * 8; half8 h;
#pragma unroll
    for (int i = 0; i < 8; ++i) h[i] = (half_t)tile[(k8 + i) * 65 + n];
    *(half8*)(dst + (size_t)(drow0 + n) * dld + dcol0 + k8) = h;
    SYNC();
}
__device__ __forceinline__ void ph_convert(int wb, const Params& p, int l, LAS unsigned char* lds) {
    LAS float* tile = (LAS float*)lds;
    constexpr int N_WIN = 16 * (NP / 64), N_WBR = 3 * 128, N_WOUT = 256, N_W13 = 2 * 2048, N_W2 = 2048, N_LORA = 240;
    constexpr int TOTAL = N_WIN + N_WBR + N_WOUT + N_W13 + N_W2 + N_LORA;
    half_t* ws16 = (half_t*)p.ws;
    for (int item = blockIdx.x; item < TOTAL; item += gridDim.x) {
        int it = item;
        if (it < N_WIN) { const int kt = it % 16, ntile = it / 16;
            tconv_tile(wb, p.in[I_WIN] + (size_t)l * 1024 * IN_COLS, IN_COLS, 64 * kt, 64 * ntile, IN_COLS, (half_t*)(p.ws + OFF_WIN), 1024, 64 * ntile, 64 * kt, tile); continue; }
        it -= N_WIN;
        if (it < N_WBR) { const int i = it / 128, rem = it % 128, kt = rem % 8, ntile = rem / 8;
            tconv_tile(wb, p.in[I_WBR] + (size_t)(l * 3 + i) * 512 * 1024, 1024, 64 * kt, 64 * ntile, 1024, (half_t*)(p.ws + OFF_WBR) + (size_t)i * 1024 * 512, 512, 64 * ntile, 64 * kt, tile); continue; }
        it -= N_WBR;
        if (it < N_WOUT) { const int kt = it % 16, ntile = it / 16;
            tconv_tile(wb, p.in[I_WOUT] + (size_t)l * 1024 * 1024, 1024, 64 * kt, 64 * ntile, 1024, (half_t*)(p.ws + OFF_WOUT), 1024, 64 * ntile, 64 * kt, tile); continue; }
        it -= N_WOUT;
        if (it < N_W13) { const int which = it / 2048, rem = it % 2048, e = rem / 128, r2 = rem % 128, kt = r2 % 16, ntile = r2 / 16, n0 = 64 * ntile;
            tconv_tile(wb, p.in[which ? I_W3 : I_W1] + (size_t)(l * 16 + e) * 1024 * 512, 512, 64 * kt, n0, 512, (half_t*)(p.ws + OFF_WUP) + (size_t)e * 1024 * 1024, 1024,
                       (n0 / 128) * 256 + which * 128 + (n0 % 128), 64 * kt, tile); continue; }
        it -= N_W13;
        if (it < N_W2) { const int e = it / 128, r2 = it % 128, kt = r2 % 8, ntile = r2 / 8;
            tconv_tile(wb, p.in[I_W2] + (size_t)(l * 16 + e) * 512 * 1024, 1024, 64 * kt, 64 * ntile, 1024, (half_t*)(p.ws + OFF_WDN) + (size_t)e * 1024 * 512, 512, 64 * ntile, 64 * kt, tile); continue; }
        it -= N_W2;
        { const int ntile = it / 6, kt = it % 6, n0 = 64 * ntile, blk = n0 / 512, nn0 = n0 % 512;
          const float* src = nullptr; int k0 = 0;
          if (blk == 0 && kt == 0) src = p.in[I_RWUP] + (size_t)(l * 2 + 0) * 64 * 512;
          else if (blk == 1 && kt == 1) src = p.in[I_RWUP] + (size_t)(l * 2 + 1) * 64 * 512;
          else if (blk == 2 && kt == 2) src = p.in[I_RAUP] + (size_t)(l * 2 + 0) * 64 * 512;
          else if (blk == 3 && kt == 3) src = p.in[I_RAUP] + (size_t)(l * 2 + 1) * 64 * 512;
          else if (blk == 4 && kt >= 4) { src = p.in[I_RGUP] + (size_t)l * 128 * 512; k0 = 64 * (kt - 4); }
          tconv_tile(wb, src, 512, k0, nn0, 512, (half_t*)(p.ws + OFF_WLORA), 384, n0, 64 * kt, tile); }
    }
    (void)ws16;
}

__device__ __forceinline__ void ph_norm1(int wb, const Params& p, int l, int g) {
    const int tid = tid_fresh(wb), wid = tid >> 6, lane = tid & 63;
    half_t* H = (half_t*)(p.ws + OFF_H);
    for (int r = blockIdx.x * 8 + wid; r < RGP; r += gridDim.x * 8) {
        if (r >= RG) { for (int j = 0; j < 4; ++j) *(half4*)(H + (size_t)r * D + lane * 4 + 256 * j) = (half4){0, 0, 0, 0}; continue; }
        const float* xr = res_src(p, l, g, r); const float* md = mod_row(p, l, g, r); const float* gn = p.in[I_N1G] + l * D;
        f32x4 v[4]; float ss = 0.f;
#pragma unroll
        for (int j = 0; j < 4; ++j) { v[j] = *(const f32x4*)(xr + lane * 4 + 256 * j); ss += v[j][0] * v[j][0] + v[j][1] * v[j][1] + v[j][2] * v[j][2] + v[j][3] * v[j][3]; }
        ss = wave_sum(ss); const float rinv = frsq(ss * (1.f / D) + 1e-6f);
#pragma unroll
        for (int j = 0; j < 4; ++j) { const int c = lane * 4 + 256 * j; half4 h;
#pragma unroll
            for (int i = 0; i < 4; ++i) h[i] = (half_t)(v[j][i] * rinv * gn[c + i] * (1.f + md[1024 + c + i]) + md[c + i]);
            *(half4*)(H + (size_t)r * D + c) = h; }
    }
}

struct RowGeo { int gw, gh, base, gr, gc; };
__device__ __forceinline__ RowGeo row_geo(int r) {
    RowGeo q; int i;
    if (r < RL) { const int bl = r / SEQ; i = r % SEQ; q.gw = 64; q.gh = SEQ / 64; q.base = bl * SEQ; }
    else { const int rr = r - RL, bl = rr / CTXL; i = rr % CTXL; q.gw = CTXL; q.gh = 1; q.base = RL + bl * CTXL; }
    q.gr = i / q.gw; q.gc = i % q.gw; return q;
}

__device__ __forceinline__ void ph_prep(int wb, const Params& p, int l, LAS unsigned char* lds) {
    const int tid = tid_fresh(wb), wid = tid >> 6, lane = tid & 63;
    LAS float* cw = (LAS float*)lds;
    for (int i = tid; i < 9 * 1536; i += NT) cw[i] = p.in[I_GCONV][(size_t)l * 9 * 1536 + i];
    SYNC();
    const half_t* P = (const half_t*)(p.ws + OFF_P);
    half_t* GQKV = (half_t*)(p.ws + OFF_GQKV); float* GBG = (float*)(p.ws + OFF_GBG);
    half_t* RW = (half_t*)(p.ws + OFF_RW); half_t* RLI = (half_t*)(p.ws + OFF_RLI);
    for (int r = blockIdx.x * 8 + wid; r < RG; r += gridDim.x * 8) {
        const RowGeo q = row_geo(r);
        float acc[3][8];
#pragma unroll
        for (int j = 0; j < 3; ++j)
#pragma unroll
            for (int e = 0; e < 8; ++e) acc[j][e] = 0.f;
        for (int kh = 0; kh < 3; ++kh) { const int nr = q.gr + kh - 1; if (nr < 0 || nr >= q.gh) continue;
            for (int kw = 0; kw < 3; ++kw) { const int nc = q.gc + kw - 1; if (nc < 0 || nc >= q.gw) continue;
                const size_t nrow = (size_t)(q.base + nr * q.gw + nc);
#pragma unroll
                for (int j = 0; j < 3; ++j) { const half8 pv = *(const half8*)(P + nrow * NP + j * 512 + 8 * lane); const LAS float* w = cw + (kh * 3 + kw) * 1536 + j * 512 + 8 * lane;
#pragma unroll
                    for (int e = 0; e < 8; ++e) acc[j][e] += (float)pv[e] * w[e]; } } }
#pragma unroll
        for (int j = 0; j < 3; ++j) {
            float ss = 0.f;
#pragma unroll
            for (int e = 0; e < 8; ++e) { acc[j][e] = siluf(acc[j][e]); ss += acc[j][e] * acc[j][e]; }
            float sc = 1.f;
            if (j < 2) { ss += SHFL_XOR(ss, 1); ss += SHFL_XOR(ss, 2); ss += SHFL_XOR(ss, 4); ss += SHFL_XOR(ss, 8); sc = frsq(ss + 1e-6f) * (j == 0 ? 0.08838834764831845f : 1.f); }
            half8 h;
#pragma unroll
            for (int e = 0; e < 8; ++e) h[e] = (half_t)(acc[j][e] * sc);
            *(half8*)(GQKV + (size_t)r * 1536 + j * 512 + 8 * lane) = h;
        }
        if (lane < 16) { const float x = (float)P[(size_t)r * NP + C_BG + lane];
            float o; if (lane < 8) o = sigm(x); else { const int idx = lane - 8; o = -fexp(p.in[I_GALOG][l * 8 + idx]) * softplusf(x + p.in[I_GDTB][l * 8 + idx]); }
            GBG[(size_t)r * 16 + lane] = o; }
        const int nb[4] = { q.gc > 0 ? r - 1 : -1, q.gc < q.gw - 1 ? r + 1 : -1, q.gr > 0 ? r - q.gw : -1, q.gr < q.gh - 1 ? r + q.gw : -1 };
        const float* mu = p.in[I_RMU] + (size_t)l * 1920;
        float kmix[8];
#pragma unroll
        for (int j = 0; j < 4; ++j) {
            if (j == 3 && lane >= 48) break;
            const int cj = j < 3 ? j * 512 + 8 * lane : 1536 + 8 * lane;
            const half8 self = *(const half8*)(P + (size_t)r * NP + C_RWKV + cj);
            half8 nv[4];
#pragma unroll
            for (int d = 0; d < 4; ++d) { if (nb[d] >= 0) nv[d] = *(const half8*)(P + (size_t)nb[d] * NP + C_RWKV + cj); else nv[d] = (half8){0, 0, 0, 0, 0, 0, 0, 0}; }
            float val[8];
#pragma unroll
            for (int e = 0; e < 8; ++e) { const float s = (float)self[e], nn = (float)nv[e & 3][e]; val[e] = s + (nn - s) * mu[cj + e]; }
            half8 h;
            if (j < 3) {
#pragma unroll
                for (int e = 0; e < 8; ++e) h[e] = (half_t)val[e];
                *(half8*)(RW + ((size_t)r * 4 + j) * 512 + 8 * lane) = h;
                if (j == 1) {
#pragma unroll
                    for (int e = 0; e < 8; ++e) kmix[e] = val[e]; }
            } else {
                const int c0 = 8 * lane;
#pragma unroll
                for (int e = 0; e < 8; ++e) { float v = val[e]; if (c0 < 128) v = ftanh(v); else if (c0 >= 256) v = sigm(v); h[e] = (half_t)v; }
                *(half8*)(RLI + (size_t)r * 384 + c0) = h;
            }
        }
        { float t[8], ss = 0.f; const float* kkw = p.in[I_RKK] + (size_t)l * 512 + 8 * lane;
#pragma unroll
          for (int e = 0; e < 8; ++e) { t[e] = kmix[e] * kkw[e]; ss += t[e] * t[e]; }
          ss += SHFL_XOR(ss, 1); ss += SHFL_XOR(ss, 2); ss += SHFL_XOR(ss, 4);
          const float sc = frsq(ss + 1e-6f); half8 h;
#pragma unroll
          for (int e = 0; e < 8; ++e) h[e] = (half_t)(t[e] * sc);
          *(half8*)(RW + ((size_t)r * 4 + 3) * 512 + 8 * lane) = h; }
    }
}

__device__ __forceinline__ void ph_wy(int wb, const Params& p, LAS unsigned char* lds) {
    const int tid = tid_fresh(wb);
    LAS half_t* kh = (LAS half_t*)lds;
    LAS half_t* qh = kh + 64 * 136;
    LAS float* KK = (LAS float*)(qh + 64 * 136);
    LAS float* QK = KK + 64 * 65;
    LAS float* Lm = QK + 64 * 65;
    LAS float* Xs = Lm + 2 * 64 * 65;
    LAS float* Gs = Xs + 2 * 64 * 65;
    LAS float* Bs = Gs + 128;
    const half_t* GQKV = (const half_t*)(p.ws + OFF_GQKV); const float* GBG = (const float*)(p.ws + OFF_GBG);
    half_t* GTA = (half_t*)(p.ws + OFF_GTA); float* GG = (float*)(p.ws + OFF_GG);
    for (int item = blockIdx.x; item < (RG / 64) * 4; item += gridDim.x) {
        const int cidx = item >> 2, h = item & 3, r0 = cidx * 64;
        for (int v = tid; v < 1024; v += NT) { const int row = v >> 4, c8 = (v & 15) * 8;
            *(LAS half8*)(kh + row * 136 + c8) = *(const half8*)(GQKV + (size_t)(r0 + row) * 1536 + 512 + h * 128 + c8);
            *(LAS half8*)(qh + row * 136 + c8) = *(const half8*)(GQKV + (size_t)(r0 + row) * 1536 + h * 128 + c8); }
        if (tid < 128) { const int d = tid >> 6, i = tid & 63, nat = d ? 63 - i : i;
            Bs[d * 64 + i] = GBG[(size_t)(r0 + nat) * 16 + d * 4 + h]; Gs[d * 64 + i] = GBG[(size_t)(r0 + nat) * 16 + 8 + d * 4 + h]; }
        SYNC();
        if (tid == 0 || tid == 64) { const int d = tid >> 6; float c = 0.f; for (int i = 0; i < 64; ++i) { c += Gs[d * 64 + i]; Gs[d * 64 + i] = c; } }
        { const int i = tid >> 3, j0 = (tid & 7) * 8; float kk[8], qk[8];
#pragma unroll
          for (int jj = 0; jj < 8; ++jj) { kk[jj] = 0.f; qk[jj] = 0.f; }
          for (int c = 0; c < 128; ++c) { const float ki = (float)kh[i * 136 + c], qi = (float)qh[i * 136 + c];
#pragma unroll
              for (int jj = 0; jj < 8; ++jj) { const float kj = (float)kh[(j0 + jj) * 136 + c]; kk[jj] += ki * kj; qk[jj] += qi * kj; } }
#pragma unroll
          for (int jj = 0; jj < 8; ++jj) { KK[i * 65 + j0 + jj] = kk[jj]; QK[i * 65 + j0 + jj] = qk[jj]; } }
        SYNC();
#pragma unroll 1
        for (int t = 0; t < 16; ++t) { const int idx = tid + NT * t, d = idx >> 12, i = (idx >> 6) & 63, j = idx & 63;
            const int ni = d ? 63 - i : i, nj = d ? 63 - j : j;
            Lm[d * 4160 + i * 65 + j] = (j < i) ? Bs[d * 64 + i] * KK[ni * 65 + nj] * fexp(Gs[d * 64 + i] - Gs[d * 64 + j]) : 0.f; }
        SYNC();
        if (tid < 128) { const int d = tid >> 6, j = tid & 63; const LAS float* L = Lm + d * 4160; LAS float* X = Xs + d * 4160;
#pragma unroll 1
            for (int bi = 0; bi < 4; ++bi) {
                const LAS float* Lb = L + bi * 16 * 65; float a[16];
#pragma unroll
                for (int ii = 0; ii < 16; ++ii) a[ii] = (bi * 16 + ii == j) ? 1.f : 0.f;
                for (int m = 0; m < bi * 16; ++m) { const float xm = X[m * 65 + j];
#pragma unroll
                    for (int ii = 0; ii < 16; ++ii) a[ii] -= Lb[ii * 65 + m] * xm; }
#pragma unroll
                for (int ii = 0; ii < 16; ++ii) { float sacc = a[ii];
#pragma unroll
                    for (int mm = 0; mm < ii; ++mm) sacc -= Lb[ii * 65 + bi * 16 + mm] * a[mm];
                    a[ii] = sacc; }
#pragma unroll
                for (int ii = 0; ii < 16; ++ii) X[(bi * 16 + ii) * 65 + j] = a[ii];
            } }
        SYNC();
#pragma unroll 1
        for (int t = 0; t < 4; ++t) { const int v = tid + NT * t, mat = v >> 9, w = v & 511, i = w >> 3, j8 = (w & 7) * 8, d = mat >> 1, which = mat & 1;
            half8 o;
#pragma unroll
            for (int e = 0; e < 8; ++e) { const int j = j8 + e; float val;
                if (which == 0) val = Xs[d * 4160 + i * 65 + j] * Bs[d * 64 + j];
                else { const int ni = d ? 63 - i : i, nj = d ? 63 - j : j; val = (j <= i) ? QK[ni * 65 + nj] * fexp(Gs[d * 64 + i] - Gs[d * 64 + j]) : 0.f; }
                o[e] = (half_t)val; }
            *(half8*)(GTA + ((size_t)((cidx * 4 + h) * 2 + d) * 2 + which) * 4096 + i * 64 + j8) = o; }
        if (tid < 128) GG[(size_t)((cidx * 4 + h) * 2 + (tid >> 6)) * 64 + (tid & 63)] = Gs[tid];
        SYNC();
    }
}

#ifndef CPU_EMU
#define MFMA16(a, b, c) __builtin_amdgcn_mfma_f32_16x16x32_f16((a), (b), (c), 0, 0, 0)
#else
#define MFMA16(a, b, c) emu_mfma16((a), (b), (c))
#endif
__device__ __forceinline__ half8 ldfrag(const LAS half_t* base, int row0, int ld, int k0, int lane) { return *(const LAS half8*)(base + (row0 + (lane & 15)) * ld + k0 + 8 * (lane >> 4)); }
__device__ __forceinline__ half4 cvt4(f32x4 v) { half4 o; o[0] = (half_t)v[0]; o[1] = (half_t)v[1]; o[2] = (half_t)v[2]; o[3] = (half_t)v[3]; return o; }

__device__ __forceinline__ void scan_gdn(int wb, const Params& p, int item, LAS unsigned char* lds) {
    const int tid = tid_fresh(wb), wid = tid >> 6, lane = tid & 63, fr = lane & 15, fq = lane >> 4;
    const int d = item & 1, h = (item >> 1) & 3, bl = item >> 3;
    constexpr int L72 = 72, L136 = 136;
    LAS half_t* kT = (LAS half_t*)lds;
    LAS half_t* vT = kT + 128 * L72;
    LAS half_t* VNs = vT + 128 * L72;
    LAS half_t* Tb = VNs + 128 * L72;
    LAS half_t* Tbe = Tb + 64 * L72;
    LAS half_t* Am = Tbe + 64 * L72;
    LAS half_t* Qg = Am + 64 * L72;
    LAS half_t* Wn = Qg + 64 * L136;
    LAS half_t* ST = Wn + 64 * L136;
    LAS float* Es = (LAS float*)(ST + 128 * L136);
    const half_t* GQKV = (const half_t*)(p.ws + OFF_GQKV);
    const half_t* GTA = (const half_t*)(p.ws + OFF_GTA); const float* GG = (const float*)(p.ws + OFF_GG);
    half_t* SOG = (half_t*)(p.ws + OFF_SOG) + (size_t)d * RGP * 512;
    SYNC();
    for (int i = tid; i < 128 * L136 / 8; i += NT) *(LAS half8*)(ST + i * 8) = (half8){0, 0, 0, 0, 0, 0, 0, 0};
    f32x4 accS[8];
#pragma unroll
    for (int u = 0; u < 8; ++u) accS[u] = (f32x4){0.f, 0.f, 0.f, 0.f};
    constexpr int nchC = CTXL / 64, nchL = SEQ / 64, NCS = nchC + nchL;
    half8 pT, pA, pq[2], pk[2], pv[2]; f32x4 pg0, pg1; float pgi[2], pG = 0.f, pGl = 0.f; int nr0 = 0, cr0 = 0;
    const int ti = tid >> 3, tj8 = (tid & 7) * 8;
    auto issue = [&](int cs) {
        const bool isc = cs < nchC; const int cl = isc ? cs : cs - nchC, nch = isc ? nchC : nchL, cn = d ? nch - 1 - cl : cl;
        const int r0 = (isc ? RL + bl * CTXL : bl * SEQ) + cn * 64; nr0 = r0;
        const size_t tb = (size_t)(((r0 >> 6) * 4 + h) * 2 + d);
        pT = *(const half8*)(GTA + (tb * 2 + 0) * 4096 + ti * 64 + tj8); pA = *(const half8*)(GTA + (tb * 2 + 1) * 4096 + ti * 64 + tj8);
        pg0 = *(const f32x4*)(GG + tb * 64 + tj8); pg1 = *(const f32x4*)(GG + tb * 64 + tj8 + 4);
#pragma unroll
        for (int t = 0; t < 2; ++t) { const int v = tid + NT * t, i = v >> 4, c8 = (v & 15) * 8, nat = d ? 63 - i : i;
            pq[t] = *(const half8*)(GQKV + (size_t)(r0 + nat) * 1536 + h * 128 + c8); pgi[t] = GG[tb * 64 + i]; }
#pragma unroll
        for (int t = 0; t < 2; ++t) { const int g = wid + 8 * t, nat = d ? 63 - lane : lane;
            pk[t] = *(const half8*)(GQKV + (size_t)(r0 + nat) * 1536 + 512 + h * 128 + 8 * g); pv[t] = *(const half8*)(GQKV + (size_t)(r0 + nat) * 1536 + 1024 + h * 128 + 8 * g); }
        pG = GG[tb * 64 + (tid & 63)]; pGl = GG[tb * 64 + 63];
    };
    issue(0);
    for (int cs = 0; cs < NCS; ++cs) {
        SYNC();
        { half8 te; const float ge[8] = {pg0[0], pg0[1], pg0[2], pg0[3], pg1[0], pg1[1], pg1[2], pg1[3]};
#pragma unroll
          for (int e = 0; e < 8; ++e) te[e] = (half_t)((float)pT[e] * fexp(ge[e]));
          *(LAS half8*)(Tb + ti * L72 + tj8) = pT; *(LAS half8*)(Tbe + ti * L72 + tj8) = te; *(LAS half8*)(Am + ti * L72 + tj8) = pA; }
#pragma unroll
        for (int t = 0; t < 2; ++t) { const int v = tid + NT * t, i = v >> 4, c8 = (v & 15) * 8; const float sc = fexp(pgi[t]); half8 o;
#pragma unroll
            for (int e = 0; e < 8; ++e) o[e] = (half_t)((float)pq[t][e] * sc);
            *(LAS half8*)(Qg + i * L136 + c8) = o; }
#pragma unroll
        for (int t = 0; t < 2; ++t) { const int g = wid + 8 * t;
#pragma unroll
            for (int e = 0; e < 8; ++e) { kT[(8 * g + e) * L72 + lane] = pk[t][e]; vT[(8 * g + e) * L72 + lane] = pv[t][e]; } }
        if (tid < 64) Es[tid] = fexp(pGl - pG);
        const float dec = fexp(pGl);
        cr0 = nr0;
        if (cs + 1 < NCS) issue(cs + 1);
        SYNC();
        { f32x4 acc[4];
#pragma unroll
          for (int t = 0; t < 4; ++t) acc[t] = (f32x4){0.f, 0.f, 0.f, 0.f};
#pragma unroll
          for (int k2 = 0; k2 < 2; ++k2) { const half8 a = ldfrag(kT, 16 * wid, L72, 32 * k2, lane);
#pragma unroll
              for (int t = 0; t < 4; ++t) acc[t] = MFMA16(a, ldfrag(Tbe, 16 * t, L72, 32 * k2, lane), acc[t]); }
#pragma unroll
          for (int t = 0; t < 4; ++t) *(LAS half4*)(Wn + (16 * t + fr) * L136 + 16 * wid + 4 * fq) = cvt4(-acc[t]); }
        SYNC();
        { f32x4 acc[4];
#pragma unroll
          for (int t = 0; t < 4; ++t) acc[t] = (f32x4){0.f, 0.f, 0.f, 0.f};
#pragma unroll
          for (int k2 = 0; k2 < 2; ++k2) { const half8 b = ldfrag(vT, 16 * wid, L72, 32 * k2, lane);
#pragma unroll
              for (int t = 0; t < 4; ++t) acc[t] = MFMA16(ldfrag(Tb, 16 * t, L72, 32 * k2, lane), b, acc[t]); }
#pragma unroll
          for (int k4 = 0; k4 < 4; ++k4) { const half8 b = ldfrag(ST, 16 * wid, L136, 32 * k4, lane);
#pragma unroll
              for (int t = 0; t < 4; ++t) acc[t] = MFMA16(ldfrag(Wn, 16 * t, L136, 32 * k4, lane), b, acc[t]); }
          WAVE_SYNC();
#pragma unroll
          for (int t = 0; t < 4; ++t) { const f32x4 es = *(const LAS f32x4*)(Es + 16 * t + 4 * fq);
              *(LAS half4*)(vT + (16 * wid + fr) * L72 + 16 * t + 4 * fq) = cvt4(acc[t]); *(LAS half4*)(VNs + (16 * wid + fr) * L72 + 16 * t + 4 * fq) = cvt4(acc[t] * es); } }
        WAVE_SYNC();
        { f32x4 acc[4];
#pragma unroll
          for (int t = 0; t < 4; ++t) acc[t] = (f32x4){0.f, 0.f, 0.f, 0.f};
#pragma unroll
          for (int k4 = 0; k4 < 4; ++k4) { const half8 a = ldfrag(ST, 16 * wid, L136, 32 * k4, lane);
#pragma unroll
              for (int t = 0; t < 4; ++t) acc[t] = MFMA16(a, ldfrag(Qg, 16 * t, L136, 32 * k4, lane), acc[t]); }
#pragma unroll
          for (int k2 = 0; k2 < 2; ++k2) { const half8 a = ldfrag(vT, 16 * wid, L72, 32 * k2, lane);
#pragma unroll
              for (int t = 0; t < 4; ++t) acc[t] = MFMA16(a, ldfrag(Am, 16 * t, L72, 32 * k2, lane), acc[t]); }
#pragma unroll
          for (int t = 0; t < 4; ++t) { const int i = 16 * t + fr, nat = d ? 63 - i : i;
              *(half4*)(SOG + (size_t)(cr0 + nat) * 512 + h * 128 + 16 * wid + 4 * fq) = cvt4(acc[t]); } }
#pragma unroll
        for (int u = 0; u < 8; ++u) accS[u] = accS[u] * dec;
#pragma unroll
        for (int k2 = 0; k2 < 2; ++k2) { const half8 b = ldfrag(VNs, 16 * wid, L72, 32 * k2, lane);
#pragma unroll
            for (int u = 0; u < 8; ++u) accS[u] = MFMA16(ldfrag(kT, 16 * u, L72, 32 * k2, lane), b, accS[u]); }
        WAVE_SYNC();
#pragma unroll
        for (int u = 0; u < 8; ++u) *(LAS half4*)(ST + (16 * wid + fr) * L136 + 16 * u + 4 * fq) = cvt4(accS[u]);
        WAVE_SYNC();
    }
}

#ifndef CPU_EMU
__device__ __forceinline__ float shfl_up_f(float v, int off, int lane) { const float o = __int_as_float(__builtin_amdgcn_ds_bpermute(((lane - off) & 63) << 2, __float_as_int(v))); return lane >= off ? o : v; }
#else
static inline float shfl_up_f(float v, int off, int lane) { const float o = emu_shfl(v, (lane - off) & 63); return lane >= off ? o : v; }
#endif
__device__ __forceinline__ void scan_mlstm(int wb, const Params& p, int l, int item, LAS unsigned char* lds) {
    const int tid = tid_fresh(wb), wid = tid >> 6, lane = tid & 63, fr = lane & 15, fq = lane >> 4;
    const int d = item & 1, h = (item >> 1) & 3, bl = item >> 3;
    constexpr int L72 = 72;
    LAS half_t* q = (LAS half_t*)lds;
    LAS half_t* k = q + 64 * L72;
    LAS half_t* kT = k + 64 * L72;
    LAS half_t* vT = kT + 64 * L72;
    LAS half_t* Pm = vT + 128 * L72;
    LAS half_t* CT = Pm + 64 * L72;
    LAS half_t* nvec = CT + 128 * L72 + 64 * wid;
    LAS float* lfv = (LAS float*)(CT + 128 * L72 + 64 * 8);
    LAS float* igv = lfv + 64;
    LAS float* rowv = igv + 64;
    LAS float* colv = rowv + 64;
    LAS float* interv = colv + 64;
    LAS float* emtv = interv + 64;
    LAS float* wscv = emtv + 64;
    const half_t* P = (const half_t*)(p.ws + OFF_P);
    half_t* SOM = (half_t*)(p.ws + OFF_SOM) + (size_t)d * RGP * 512;
    const float ibias = p.in[I_MIB][l * 8 + d * 4 + h], fbias = p.in[I_MFB][l * 8 + d * 4 + h];
    SYNC();
    for (int i = tid; i < 128 * L72 / 8; i += NT) *(LAS half8*)(CT + i * 8) = (half8){0, 0, 0, 0, 0, 0, 0, 0};
    nvec[lane] = (half_t)0.f;
    f32x4 accC[4], accN[4];
#pragma unroll
    for (int u = 0; u < 4; ++u) { accC[u] = (f32x4){0.f, 0.f, 0.f, 0.f}; accN[u] = (f32x4){0.f, 0.f, 0.f, 0.f}; }
    float m = 0.f;
    constexpr int nchC = CTXL / 64, nchL = SEQ / 64, NCS = nchC + nchL;
    half8 pq, pk, pv[2]; half_t pig = (half_t)0.f, pfg = (half_t)0.f; int nr0 = 0, cr0 = 0;
    const half8 ones = {1, 1, 1, 1, 1, 1, 1, 1};
    auto issue = [&](int cs) {
        const bool isc = cs < nchC; const int cl = isc ? cs : cs - nchC, nch = isc ? nchC : nchL, cn = d ? nch - 1 - cl : cl;
        const int r0 = (isc ? RL + bl * CTXL : bl * SEQ) + cn * 64; nr0 = r0;
        const int nat = d ? 63 - lane : lane; const half_t* pr = P + (size_t)(r0 + nat) * NP + C_ML;
        pq = *(const half8*)(pr + h * 64 + 8 * wid); pk = *(const half8*)(pr + 256 + h * 64 + 8 * wid);
        pv[0] = *(const half8*)(pr + 512 + h * 128 + 8 * wid); pv[1] = *(const half8*)(pr + 512 + h * 128 + 8 * (wid + 8));
        if (tid < 64) { const half_t* pg = P + (size_t)(r0 + (d ? 63 - tid : tid)) * NP; pig = pg[C_MLIG + d * 4 + h]; pfg = pg[C_MLFG + d * 4 + h]; }
    };
    issue(0);
    for (int cs = 0; cs < NCS; ++cs) {
        SYNC();
        { half8 qs;
#pragma unroll
          for (int e = 0; e < 8; ++e) qs[e] = (half_t)((float)pq[e] * 0.125f);
          *(LAS half8*)(q + lane * L72 + 8 * wid) = qs; *(LAS half8*)(k + lane * L72 + 8 * wid) = pk;
#pragma unroll
          for (int e = 0; e < 8; ++e) { kT[(8 * wid + e) * L72 + lane] = pk[e]; vT[(8 * wid + e) * L72 + lane] = pv[0][e]; vT[(8 * (wid + 8) + e) * L72 + lane] = pv[1][e]; } }
        if (tid < 64) { igv[tid] = (float)pig + ibias; lfv[tid] = -softplusf(-((float)pfg + fbias)); }
        cr0 = nr0;
        if (cs + 1 < NCS) issue(cs + 1);
        SYNC();
        float dec;
        { float b = lfv[lane];
#pragma unroll
          for (int off = 1; off < 64; off <<= 1) { const float o = shfl_up_f(b, off, lane); b = lane >= off ? b + o : b; }
          const float cm = igv[lane] - b; float pm = cm;
#pragma unroll
          for (int off = 1; off < 64; off <<= 1) { const float o = shfl_up_f(pm, off, lane); pm = lane >= off ? fmaxf(pm, o) : pm; }
#ifndef CPU_EMU
          const float b_last = __int_as_float(__builtin_amdgcn_readlane(__float_as_int(b), 63)), pm_last = __int_as_float(__builtin_amdgcn_readlane(__float_as_int(pm), 63));
#else
          const float b_last = emu_shfl(b, 63), pm_last = emu_shfl(pm, 63);
#endif
          const float mt = fmaxf(b + m, b + pm), m_new = fmaxf(b_last + m, b_last + pm_last);
          rowv[lane] = b - mt; colv[lane] = cm; interv[lane] = fexp(b + m - mt); emtv[lane] = fexp(-mt); wscv[lane] = fexp(b_last + cm - m_new);
          dec = fexp(b_last + m - m_new); m = m_new; }
        WAVE_SYNC();
#pragma unroll
        for (int tt = 0; tt < 2; ++tt) { const int idx = 2 * wid + tt, ti = idx >> 2, tj = idx & 3;
            f32x4 acc = {0.f, 0.f, 0.f, 0.f};
            if (tj <= ti) {
#pragma unroll
                for (int k2 = 0; k2 < 2; ++k2) acc = MFMA16(ldfrag(k, 16 * tj, L72, 32 * k2, lane), ldfrag(q, 16 * ti, L72, 32 * k2, lane), acc);
                const int i = 16 * ti + fr; const float rv = rowv[i]; const f32x4 cv = *(const LAS f32x4*)(colv + 16 * tj + 4 * fq);
#pragma unroll
                for (int e = 0; e < 4; ++e) { const int j = 16 * tj + 4 * fq + e; acc[e] = (j <= i) ? acc[e] * fexp(rv + cv[e]) : 0.f; }
            }
            *(LAS half4*)(Pm + (16 * ti + fr) * L72 + 16 * tj + 4 * fq) = cvt4(acc); }
        SYNC();
        { f32x4 a1[4], a2[4], d1[4], d2[4];
#pragma unroll
          for (int t = 0; t < 4; ++t) { a1[t] = (f32x4){0.f, 0.f, 0.f, 0.f}; a2[t] = a1[t]; d1[t] = a1[t]; d2[t] = a1[t]; }
#pragma unroll
          for (int k2 = 0; k2 < 2; ++k2) { const half8 ac = ldfrag(CT, 16 * wid, L72, 32 * k2, lane), av = ldfrag(vT, 16 * wid, L72, 32 * k2, lane);
              const half8 an = *(const LAS half8*)(nvec + 32 * k2 + 8 * fq);
#pragma unroll
              for (int t = 0; t < 4; ++t) { const half8 bq = ldfrag(q, 16 * t, L72, 32 * k2, lane), bp = ldfrag(Pm, 16 * t, L72, 32 * k2, lane);
                  a1[t] = MFMA16(ac, bq, a1[t]); a2[t] = MFMA16(av, bp, a2[t]); d1[t] = MFMA16(an, bq, d1[t]); d2[t] = MFMA16(ones, bp, d2[t]); } }
#pragma unroll
          for (int t = 0; t < 4; ++t) { const int i = 16 * t + fr, nat = d ? 63 - i : i; const float it = interv[i];
              const float den = it * d1[t][0] + d2[t][0], dn = frcp(fmaxf(fabsf(den), emtv[i]));
              *(half4*)(SOM + (size_t)(cr0 + nat) * 512 + h * 128 + 16 * wid + 4 * fq) = cvt4((a1[t] * it + a2[t]) * dn); } }
#pragma unroll
        for (int u = 0; u < 4; ++u) { accC[u] = accC[u] * dec; accN[u] = accN[u] * dec; }
#pragma unroll
        for (int k2 = 0; k2 < 2; ++k2) { const half8 bv = ldfrag(vT, 16 * wid, L72, 32 * k2, lane);
            const f32x4 w0 = *(const LAS f32x4*)(wscv + 32 * k2 + 8 * fq), w1 = *(const LAS f32x4*)(wscv + 32 * k2 + 8 * fq + 4);
#pragma unroll
            for (int u = 0; u < 4; ++u) { const half8 raw = ldfrag(kT, 16 * u, L72, 32 * k2, lane); half8 ak;
#pragma unroll
                for (int e = 0; e < 4; ++e) { ak[e] = (half_t)((float)raw[e] * w0[e]); ak[4 + e] = (half_t)((float)raw[4 + e] * w1[e]); }
                accC[u] = MFMA16(ak, bv, accC[u]); accN[u] = MFMA16(ak, ones, accN[u]); } }
        WAVE_SYNC();
#pragma unroll
        for (int u = 0; u < 4; ++u) { *(LAS half4*)(CT + (16 * wid + fr) * L72 + 16 * u + 4 * fq) = cvt4(accC[u]);
            if (fr == 0) *(LAS half4*)(nvec + 16 * u + 4 * fq) = cvt4(accN[u]); }
        WAVE_SYNC();
    }
}

#ifndef CPU_EMU
template <int CTRL> __device__ __forceinline__ float dpp_f(float v) { return __int_as_float(__builtin_amdgcn_update_dpp(0, __float_as_int(v), CTRL, 0xf, 0xf, true)); }
#define RED8(v) do { v += dpp_f<0xB1>(v); v += dpp_f<0x4E>(v); v += dpp_f<0x141>(v); } while (0)
#define RED16(v) do { RED8(v); v += dpp_f<0x140>(v); } while (0)
#else
#define RED8(v) do { v += emu_shfl_xor(v, 1); v += emu_shfl_xor(v, 2); v += emu_shfl_xor(v, 7); } while (0)
#define RED16(v) do { RED8(v); v += emu_shfl_xor(v, 15); } while (0)
#endif
__device__ __forceinline__ void scan_rwkv(int wb, const Params& p, int l, int item, LAS unsigned char* lds) {
    const int tid = tid_fresh(wb), wid = tid >> 6, lane = tid & 63;
    const int d = item & 1, h = (item >> 1) & 7, bl = item >> 4;
    constexpr int NB = 16, REC = 388;
    LAS float* st = (LAS float*)lds;
    const half_t* RW = (const half_t*)(p.ws + OFF_RW); const half_t* RLO = (const half_t*)(p.ws + OFF_RLO);
    float* SOR = (float*)(p.ws + OFF_SOR) + (size_t)d * RGP * 512;
    const int rr = 8 * wid + (lane >> 3), ks = lane & 7;
    const int lt = tid >> 5, cp = tid & 31, lc = h * 64 + 2 * cp;
    const float ka0 = p.in[I_RKA][(size_t)l * 512 + lc], ka1 = p.in[I_RKA][(size_t)l * 512 + lc + 1];
    float s[8];
#pragma unroll
    for (int e = 0; e < 8; ++e) s[e] = 0.f;
    constexpr int NSTEP = CTXL + SEQ, NBATCH = NSTEP / NB;
    auto step_row = [&](int sidx) -> size_t { return sidx < CTXL ? (size_t)(RL + bl * CTXL + (d ? CTXL - 1 - sidx : sidx)) : (size_t)(bl * SEQ + (d ? SEQ - 1 - (sidx - CTXL) : sidx - CTXL)); };
    typedef _Float16 half2v_ __attribute__((ext_vector_type(2)));
    half2v_ g_r, g_k, g_v, g_kk, g_e, g_a;
    auto issue = [&](int n) { const size_t row = step_row(n * NB + lt);
        g_r = *(const half2v_*)(RW + (row * 4 + 0) * 512 + lc); g_k = *(const half2v_*)(RW + (row * 4 + 1) * 512 + lc); g_v = *(const half2v_*)(RW + (row * 4 + 2) * 512 + lc); g_kk = *(const half2v_*)(RW + (row * 4 + 3) * 512 + lc);
        g_e = *(const half2v_*)(RLO + row * 2560 + d * 512 + lc); g_a = *(const half2v_*)(RLO + row * 2560 + 1024 + d * 512 + lc); };
    auto stage = [&](int buf) { LAS float* o = st + (buf * NB + lt) * REC + 2 * cp; float br = 0.f, kr = 0.f;
#pragma unroll
        for (int e = 0; e < 2; ++e) { const float r_ = (float)g_r[e], k_ = (float)g_k[e], kk = (float)g_kk[e], a_ = (float)g_a[e];
            const float w_ = fexp(-(float)g_e[e]), kd = k_ * (1.f + (a_ - 1.f) * (e ? ka1 : ka0)), b_ = kk * a_;
            o[e] = -kk; o[64 + e] = w_ * r_; o[128 + e] = w_; o[192 + e] = b_; o[256 + e] = kd; o[320 + e] = (float)g_v[e]; br += b_ * r_; kr += kd * r_; }
        RED16(br); RED16(kr);
        if ((cp & 15) == 0) { LAS float* sc = st + (buf * NB + lt) * REC + 384; sc[cp >> 4] = br; sc[2 + (cp >> 4)] = kr; } };
    SYNC();
    issue(0); stage(0);
    SYNC();
    for (int n = 0; n < NBATCH; ++n) {
        const int buf = n & 1;
        if (n + 1 < NBATCH) issue(n + 1);
        float ysel = 0.f;
#pragma unroll 1
        for (int th = 0; th < NB / 4; ++th) {
        const int ksl = ks - 4 * (th & 1);
        f32x4 a0, a1, q0, q1, w0, w1, b0, b1, k0, k1, sc; float vv;
#define RWKV_LOAD(T_) do { const LAS float* o = st + (buf * NB + (T_)) * REC; \
            a0 = *(const LAS f32x4*)(o + 8 * ks); a1 = *(const LAS f32x4*)(o + 8 * ks + 4); q0 = *(const LAS f32x4*)(o + 64 + 8 * ks); q1 = *(const LAS f32x4*)(o + 64 + 8 * ks + 4); \
            w0 = *(const LAS f32x4*)(o + 128 + 8 * ks); w1 = *(const LAS f32x4*)(o + 128 + 8 * ks + 4); b0 = *(const LAS f32x4*)(o + 192 + 8 * ks); b1 = *(const LAS f32x4*)(o + 192 + 8 * ks + 4); \
            k0 = *(const LAS f32x4*)(o + 256 + 8 * ks); k1 = *(const LAS f32x4*)(o + 256 + 8 * ks + 4); vv = o[320 + rr]; sc = *(const LAS f32x4*)(o + 384); } while (0)
        RWKV_LOAD(th * 4);
#pragma unroll
        for (int ti = 0; ti < 4; ++ti) {
            const f32x4 ca0 = a0, ca1 = a1, cq0 = q0, cq1 = q1, cw0 = w0, cw1 = w1, cb0 = b0, cb1 = b1, ck0 = k0, ck1 = k1, csc = sc; const float cvv = vv;
            if (ti < 3) RWKV_LOAD(th * 4 + ti + 1);
            float sa = s[0] * ca0[0] + s[1] * ca0[1] + s[2] * ca0[2] + s[3] * ca0[3] + s[4] * ca1[0] + s[5] * ca1[1] + s[6] * ca1[2] + s[7] * ca1[3];
            float yw = s[0] * cq0[0] + s[1] * cq0[1] + s[2] * cq0[2] + s[3] * cq0[3] + s[4] * cq1[0] + s[5] * cq1[1] + s[6] * cq1[2] + s[7] * cq1[3];
            RED8(sa); RED8(yw);
#pragma unroll
            for (int e = 0; e < 4; ++e) { s[e] = s[e] * cw0[e] + (sa * cb0[e] + cvv * ck0[e]); s[4 + e] = s[4 + e] * cw1[e] + (sa * cb1[e] + cvv * ck1[e]); }
            const float y = yw + sa * (csc[0] + csc[1]) + cvv * (csc[2] + csc[3]);
            ysel = (ksl == ti) ? y : ysel;
#ifndef CPU_EMU
            asm volatile("" ::: "memory");
#endif
        }
#undef RWKV_LOAD
        if (th & 1) SOR[step_row(n * NB + (th >> 1) * 8 + ks) * 512 + h * 64 + rr] = ysel;
        }
        if (n + 1 < NBATCH) stage(buf ^ 1);
        SYNC();
    }
}

__device__ __forceinline__ void ph_scan(int wb, const Params& p, int l, LAS unsigned char* lds) {
    constexpr int N_R = BG * 16, N_G = BG * 8, N_M = BG * 8;
    const int G = gridDim.x, c = blockIdx.x;
    if (!(SKIP_MASK & 65536)) for (int item = c; item < N_R; item += G) REPS(65536) { scan_rwkv(wb, p, l, item, lds); SYNC(); }
    if (!(SKIP_MASK & 131072)) for (int item = N_R + (((c - N_R) % G) + G) % G; item < N_R + N_G; item += G) REPS(131072) { scan_gdn(wb, p, item - N_R, lds); SYNC(); }
    if (!(SKIP_MASK & 262144)) for (int item = N_R + N_G + (((c - N_R - N_G) % G) + G) % G; item < N_R + N_G + N_M; item += G) REPS(262144) { scan_mlstm(wb, p, l, item - N_R - N_G, lds); SYNC(); }
}

__device__ __forceinline__ void ph_finish(int wb, const Params& p, int l, int nrows) {
    const int tid = tid_fresh(wb), wid = tid >> 6, lane = tid & 63, c = 8 * lane;
    const half_t* P = (const half_t*)(p.ws + OFF_P); const half_t* RW = (const half_t*)(p.ws + OFF_RW); const half_t* RLO = (const half_t*)(p.ws + OFF_RLO);
    const half_t* SOG = (const half_t*)(p.ws + OFF_SOG); const half_t* SOM = (const half_t*)(p.ws + OFF_SOM); const float* SOR = (const float*)(p.ws + OFF_SOR);
    half_t* BR = (half_t*)(p.ws + OFF_BR);
    for (int r = blockIdx.x * 8 + wid; r < nrows; r += gridDim.x * 8) {
        { const half8 o0 = *(const half8*)(SOG + (size_t)r * 512 + c), o1 = *(const half8*)(SOG + ((size_t)RGP + r) * 512 + c), z = *(const half8*)(P + (size_t)r * NP + C_Z + c);
          float o[8], ss = 0.f;
#pragma unroll
          for (int e = 0; e < 8; ++e) { o[e] = (float)o0[e] + (float)o1[e]; ss += o[e] * o[e]; }
          ss += SHFL_XOR(ss, 1); ss += SHFL_XOR(ss, 2); ss += SHFL_XOR(ss, 4); ss += SHFL_XOR(ss, 8);
          const float rinv = frsq(ss * (1.f / 128.f) + 1e-6f); const float* gn = p.in[I_GNG] + l * 128 + (c & 127); half8 out;
#pragma unroll
          for (int e = 0; e < 8; ++e) out[e] = (half_t)(o[e] * rinv * gn[e] * siluf((float)z[e]));
          *(half8*)(BR + (size_t)r * 512 + c) = out; }
        { float y[8], sm = 0.f;
#pragma unroll
          for (int e = 0; e < 8; ++e) { y[e] = SOR[(size_t)r * 512 + c + e] + SOR[((size_t)RGP + r) * 512 + c + e]; sm += y[e]; }
          sm += SHFL_XOR(sm, 1); sm += SHFL_XOR(sm, 2); sm += SHFL_XOR(sm, 4); const float mean = sm * (1.f / 64.f);
          float vs = 0.f;
#pragma unroll
          for (int e = 0; e < 8; ++e) { const float dlt = y[e] - mean; vs += dlt * dlt; }
          vs += SHFL_XOR(vs, 1); vs += SHFL_XOR(vs, 2); vs += SHFL_XOR(vs, 4); const float rinv = frsq(vs * (1.f / 64.f) + 64e-5f);
          const half8 rv = *(const half8*)(RW + ((size_t)r * 4 + 0) * 512 + c), kv = *(const half8*)(RW + ((size_t)r * 4 + 1) * 512 + c), vv = *(const half8*)(RW + ((size_t)r * 4 + 2) * 512 + c);
          const half8 a0 = *(const half8*)(RLO + (size_t)r * 2560 + 1024 + c), a1 = *(const half8*)(RLO + (size_t)r * 2560 + 1536 + c), gg = *(const half8*)(RLO + (size_t)r * 2560 + 2048 + c);
          const float* ka = p.in[I_RKA] + (size_t)l * 512 + c; const float* rk = p.in[I_RRK] + (size_t)l * 512 + c;
          float bc = 0.f;
#pragma unroll
          for (int e = 0; e < 8; ++e) bc += (float)rv[e] * (float)kv[e] * (2.f + ((float)a0[e] + (float)a1[e] - 2.f) * ka[e]) * rk[e];
          bc += SHFL_XOR(bc, 1); bc += SHFL_XOR(bc, 2); bc += SHFL_XOR(bc, 4);
          const float* lg = p.in[I_RLNG] + (size_t)l * 512 + c; const float* lb = p.in[I_RLNB] + (size_t)l * 512 + c; half8 out;
#pragma unroll
          for (int e = 0; e < 8; ++e) out[e] = (half_t)(((y[e] - mean) * rinv * lg[e] + lb[e] + bc * (float)vv[e]) * (float)gg[e]);
          *(half8*)(BR + ((size_t)RGP + r) * 512 + c) = out; }
        { const half8 h0 = *(const half8*)(SOM + (size_t)r * 512 + c), h1 = *(const half8*)(SOM + ((size_t)RGP + r) * 512 + c), og = *(const half8*)(P + (size_t)r * NP + C_MLO + c);
          float o[8], ss = 0.f;
#pragma unroll
          for (int e = 0; e < 8; ++e) { o[e] = (float)h0[e] + (float)h1[e]; ss += o[e] * o[e]; }
          ss += SHFL_XOR(ss, 1); ss += SHFL_XOR(ss, 2); ss += SHFL_XOR(ss, 4); ss += SHFL_XOR(ss, 8);
          const float rinv = frsq(ss * (1.f / 128.f) + 1e-6f); const float* gn = p.in[I_MNG] + l * 128 + (c & 127); half8 out;
#pragma unroll
          for (int e = 0; e < 8; ++e) out[e] = (half_t)(o[e] * rinv * gn[e] * (float)og[e]);
          *(half8*)(BR + ((size_t)2 * RGP + r) * 512 + c) = out; }
    }
}

__device__ __forceinline__ void ph_norm2(int wb, const Params& p, int l, int g, int nrows, LAS unsigned char* lds) {
    const int tid = tid_fresh(wb), wid = tid >> 6, lane = tid & 63;
    LAS float* rw = (LAS float*)lds;
    for (int i = tid; i < 1024 * 16; i += NT) rw[i] = p.in[I_ROUT][(size_t)l * 1024 * 16 + i];
    SYNC();
    half_t* H = (half_t*)(p.ws + OFF_H); float* PROB = (float*)(p.ws + OFF_PROB);
    for (int r = blockIdx.x * 8 + wid; r < nrows; r += gridDim.x * 8) {
        const float* xr = res_dst(p, g, r); const float* md = mod_row(p, l, g, r); const float* gn = p.in[I_N2G] + l * D;
        float ss = 0.f;
#pragma unroll
        for (int j = 0; j < 4; ++j) { const f32x4 v = *(const f32x4*)(xr + lane * 4 + 256 * j); ss += v[0] * v[0] + v[1] * v[1] + v[2] * v[2] + v[3] * v[3]; }
        ss = wave_sum(ss); const float rinv = frsq(ss * (1.f / D) + 1e-6f);
        float lg[16];
#pragma unroll
        for (int e = 0; e < 16; ++e) lg[e] = 0.f;
#pragma unroll 1
        for (int j = 0; j < 4; ++j) { const int c = lane * 4 + 256 * j; half4 hh; const f32x4 v = *(const f32x4*)(xr + c);
#pragma unroll
            for (int i = 0; i < 4; ++i) { const float hv = v[i] * rinv * gn[c + i] * (1.f + md[4 * 1024 + c + i]) + md[3 * 1024 + c + i]; hh[i] = (half_t)hv;
#pragma unroll
                for (int e = 0; e < 16; ++e) lg[e] += hv * rw[(c + i) * 16 + e]; }
            *(half4*)(H + (size_t)r * D + c) = hh; }
        float mx = -INFINITY;
#pragma unroll
        for (int e = 0; e < 16; ++e) { lg[e] = wave_sum(lg[e]); mx = fmaxf(mx, lg[e]); }
        float sum = 0.f;
#pragma unroll
        for (int e = 0; e < 16; ++e) { lg[e] = fexp(lg[e] - mx); sum += lg[e]; }
        const float inv = frcp(sum);
#pragma unroll
        for (int e = 0; e < 16; ++e) if (lane == e) PROB[(size_t)r * 16 + e] = lg[e] * inv;
    }
}

__device__ __forceinline__ void ph_topk(int wb, const Params& p, int nstreams, LAS unsigned char* lds) {
    const int tid = tid_fresh(wb);
    LAS unsigned* pv = (LAS unsigned*)lds;
    LAS unsigned* hist = pv + (SEQ > CTXL ? SEQ : CTXL);
    LAS int* eqc = (LAS int*)(hist + 256);
    LAS int* gtc = eqc + 512;
    LAS int* posx = gtc + 512;
    LAS int* selrows = posx + 512;
    LAS unsigned* sh = (LAS unsigned*)(selrows + (CAPL > CAPC ? CAPL : CAPC));
    const float* PROB = (const float*)(p.ws + OFF_PROB); int* SLOT = (int*)(p.ws + OFF_SLOT); int* SEL = (int*)(p.ws + OFF_SEL); float* AFF = (float*)(p.ws + OFF_AFF);
    const half_t* H = (const half_t*)(p.ws + OFF_H); half_t* XE = (half_t*)(p.ws + OFF_XE);
    for (int item = blockIdx.x; item < nstreams * BG * 16; item += gridDim.x) {
        const int e = item & 15, bl = (item >> 4) % BG, stc = (item >> 4) / BG;
        const int n = stc ? CTXL : SEQ, cap = n / 8, row0 = stc ? RL + bl * CTXL : bl * SEQ, slot0 = stc ? BG * CAPL + bl * CAPC : bl * CAPL;
        for (int i = tid; i < n; i += NT) pv[i] = __float_as_uint(PROB[(size_t)(row0 + i) * 16 + e]);
        unsigned prefix = 0u, mask = 0u; int kth = cap;
        for (int pass = 3; pass >= 0; --pass) {
            if (tid < 256) hist[tid] = 0u;
            SYNC();
            for (int i = tid; i < n; i += NT) { const unsigned v = pv[i]; if ((v & mask) == prefix) LDS_ATOMIC_INC(&hist[(v >> (8 * pass)) & 255u]); }
            SYNC();
            if (tid == 0) { int cum = 0, b = 255; for (; b > 0; --b) { if (cum + (int)hist[b] >= kth) break; cum += (int)hist[b]; } sh[0] = (unsigned)b; sh[1] = (unsigned)(kth - cum); }
            SYNC();
            prefix |= sh[0] << (8 * pass); mask |= 0xFFu << (8 * pass); kth = (int)sh[1];
            SYNC();
        }
        const unsigned thr = prefix; const int need_eq = kth;
        const int per = (n + NT - 1) / NT, i0 = tid * per, i1 = (i0 + per < n) ? i0 + per : n;
        { int ce = 0, cg = 0; for (int i = i0; i < i1; ++i) { const unsigned v = pv[i]; ce += (v == thr); cg += (v > thr); } eqc[tid] = ce; gtc[tid] = cg; }
        SYNC();
        if (tid == 0) { int eq = 0, pos = 0; for (int t = 0; t < NT; ++t) { const int ce = eqc[t]; int take = need_eq - eq; take = take < 0 ? 0 : (take > ce ? ce : take);
                const int selc = gtc[t] + take; eqc[t] = eq; posx[t] = pos; eq += ce; pos += selc; } }
        SYNC();
        { int eqr = eqc[tid], pos = posx[tid];
          for (int i = i0; i < i1; ++i) { const unsigned v = pv[i]; const bool sel = v > thr || (v == thr && eqr < need_eq); if (v == thr) ++eqr; const int row = row0 + i;
              if (sel) { const int slot = slot0 + pos; SEL[e * RPE + slot] = row; AFF[e * RPE + slot] = __uint_as_float(v); SLOT[(size_t)row * 16 + e] = slot; selrows[pos] = row; ++pos; }
              else SLOT[(size_t)row * 16 + e] = -1; } }
        SYNC();
        for (int idx = tid; idx < cap * 128; idx += NT) { const int j = idx >> 7, v16 = idx & 127;
            *(half8*)(XE + ((size_t)e * RPE + slot0 + j) * 1024 + v16 * 8) = *(const half8*)(H + (size_t)selrows[j] * 1024 + v16 * 8); }
        SYNC();
    }
}

__device__ __forceinline__ void ph_combine(int wb, const Params& p, int l, int g, int nrows) {
    const int tid = tid_fresh(wb), wid = tid >> 6, lane = tid & 63;
    const int* SLOT = (const int*)(p.ws + OFF_SLOT); const half_t* YE = (const half_t*)(p.ws + OFF_YE);
    for (int r = blockIdx.x * 8 + wid; r < nrows; r += gridDim.x * 8) {
        float* xr = res_dst(p, g, r); const float* md = mod_row(p, l, g, r) + 5 * 1024;
        float acc[2][8];
#pragma unroll
        for (int j = 0; j < 2; ++j)
#pragma unroll
            for (int e = 0; e < 8; ++e) acc[j][e] = 0.f;
        for (int ex = 0; ex < 16; ++ex) { const int s = SLOT[(size_t)r * 16 + ex]; if (s < 0) continue;
#pragma unroll
            for (int j = 0; j < 2; ++j) { const half8 y = *(const half8*)(YE + ((size_t)ex * RPE + s) * 1024 + 8 * lane + 512 * j);
#pragma unroll
                for (int e = 0; e < 8; ++e) acc[j][e] += (float)y[e]; } }
        float xv[2][8], ss = 0.f;
#pragma unroll
        for (int j = 0; j < 2; ++j)
#pragma unroll
            for (int e = 0; e < 8; ++e) { const int c = 8 * lane + 512 * j + e; xv[j][e] = xr[c] + md[c] * acc[j][e]; ss += xv[j][e] * xv[j][e]; }
        if (l == DEPTH - 1) { ss = wave_sum(ss); const float rinv = frsq(ss * (1.f / D) + 1e-6f);
#pragma unroll
            for (int j = 0; j < 2; ++j)
#pragma unroll
                for (int e = 0; e < 8; ++e) { const int c = 8 * lane + 512 * j + e; xv[j][e] = xv[j][e] * rinv * p.in[I_FING][c]; } }
#pragma unroll
        for (int j = 0; j < 2; ++j) { *(f32x4*)(xr + 8 * lane + 512 * j) = (f32x4){xv[j][0], xv[j][1], xv[j][2], xv[j][3]}; *(f32x4*)(xr + 8 * lane + 512 * j + 4) = (f32x4){xv[j][4], xv[j][5], xv[j][6], xv[j][7]}; }
    }
}

#ifndef EMU_DUMP
#define EMU_DUMP(tag)
#endif
#ifndef CPU_EMU
extern __shared__ __attribute__((aligned(16))) unsigned char smem_raw[];
__global__ void __launch_bounds__(NT, 2) mega(Params p)
#else
void mega(Params p)
#endif
{
#ifndef CPU_EMU
    LAS unsigned char* lds = (LAS unsigned char*)smem_raw;
    volatile LAS unsigned* xbw = (volatile LAS unsigned*)(lds + SMEM_BYTES - 16);
    if (threadIdx.x == 0) { xbw[0] = 0u; xbw[1] = 0u; xbw[2] = 0u; xbw[3] = 0u; }
    __syncthreads();
    (void)xcd_barrier_post((unsigned*)(p.ws + OFF_BAR), xbw);
#else
    unsigned char* lds = emu_smem();
#endif
#ifndef CPU_EMU
    const int wb = __builtin_amdgcn_readfirstlane((int)threadIdx.x) & ~63;
#else
    const int wb = 0;
#endif
    const int G = gridDim.x, c = blockIdx.x;
    if (!(SKIP_MASK & 1)) ph_mod(wb, p, lds);
    if (!(SKIP_MASK & 2)) ph_convert(wb, p, 0, lds);
    GRID_SYNC();
    for (int l = 0; l < DEPTH; ++l) {
        const bool last = (l == DEPTH - 1);
        const int nact = last ? RL : RG;
        const int nactp = last ? RL : RGP;
        for (int g = 0; g < NGROUP; ++g) {
            if (!(SKIP_MASK & 4)) REPS(4) ph_norm1(wb, p, l, g);
            GRID_SYNC(); EMU_DUMP("norm1");
            if (!(SKIP_MASK & 8)) REPS(8) { pg8::StaticOrder S; S.init(RGP / 256, NP / 256, G, c); EpiP E{(half_t*)(p.ws + OFF_P)};
              pg8::gemm_phase(wb, lds, pg8::Gemm{(const half_t*)(p.ws + OFF_H), (const half_t*)(p.ws + OFF_WIN), 1024}, S, E); }
            GRID_SYNC(); EMU_DUMP("gemm_in");
            if (!(SKIP_MASK & 16)) REPS(16) ph_prep(wb, p, l, lds);
            GRID_SYNC(); EMU_DUMP("prep");
            if (!(SKIP_MASK & 32)) REPS(32) { pg8::StaticOrder S; S.init(RGP / 256, 10, G, c); EpiLora E{(half_t*)(p.ws + OFF_RLO), p.in[I_RW0] + (size_t)l * 1024, p.in[I_RA0] + (size_t)l * 1024};
              pg8::gemm_phase(wb, lds, pg8::Gemm{(const half_t*)(p.ws + OFF_RLI), (const half_t*)(p.ws + OFF_WLORA), 384}, S, E); }
            if (!(SKIP_MASK & 64)) REPS(64) ph_wy(wb, p, lds);
            GRID_SYNC(); EMU_DUMP("wy");
            if (!(SKIP_MASK & 128)) REPS(128) ph_scan(wb, p, l, lds);
            GRID_SYNC(); EMU_DUMP("scan");
            if (!(SKIP_MASK & 256)) REPS(256) ph_finish(wb, p, l, nact);
            GRID_SYNC(); EMU_DUMP("finish");
            if (!(SKIP_MASK & 512)) REPS(512)
#pragma unroll 1
            for (int bi = 0; bi < 3; ++bi) {
                pg8::StaticOrder S; S.init(nactp / 256, 4, G, c); EpiMerge E{(half_t*)(p.ws + OFF_H), (const half_t*)(p.ws + OFF_P), bi};
                pg8::gemm_phase(wb, lds, pg8::Gemm{(const half_t*)(p.ws + OFF_BR) + (size_t)bi * RGP * 512, (const half_t*)(p.ws + OFF_WBR) + (size_t)bi * 1024 * 512, 512}, S, E);
            }
            GRID_SYNC(); EMU_DUMP("merge");
            if (!(SKIP_MASK & 1024)) { pg8::StaticOrder S; S.init(nactp / 256, 4, G, c); EpiOut E{p, l, g};
              pg8::gemm_phase(wb, lds, pg8::Gemm{(const half_t*)(p.ws + OFF_H), (const half_t*)(p.ws + OFF_WOUT), 1024}, S, E); }
            GRID_SYNC(); EMU_DUMP("out");
            if (!(SKIP_MASK & 2048)) REPS(2048) ph_norm2(wb, p, l, g, nact, lds);
            GRID_SYNC(); EMU_DUMP("norm2");
            if (!(SKIP_MASK & 4096)) REPS(4096) ph_topk(wb, p, last ? 1 : 2, lds);
            GRID_SYNC(); EMU_DUMP("topk");
            if (!(SKIP_MASK & 8192)) REPS(8192) { pg8::ExpertOrder S; S.init(G, c); EpiUp E{(half_t*)(p.ws + OFF_HID)};
              pg8::gemm_phase(wb, lds, pg8::Gemm{(const half_t*)(p.ws + OFF_XE), (const half_t*)(p.ws + OFF_WUP), 1024}, S, E); }
            GRID_SYNC();
            if (!(SKIP_MASK & 16384)) REPS(16384) { pg8::ExpertOrder S; S.init(G, c); EpiDown E{(half_t*)(p.ws + OFF_YE), (const float*)(p.ws + OFF_AFF)};
              pg8::gemm_phase(wb, lds, pg8::Gemm{(const half_t*)(p.ws + OFF_HID), (const half_t*)(p.ws + OFF_WDN), 512}, S, E); }
            GRID_SYNC();
            if (!(SKIP_MASK & 32768)) ph_combine(wb, p, l, g, nact);
            if (!(SKIP_MASK & 2)) if (g == NGROUP - 1 && !last) ph_convert(wb, p, l + 1, lds);
            GRID_SYNC(); EMU_DUMP("combine");
        }
    }
}

#ifndef CPU_EMU
extern "C" void kernel_launch(void* const* d_in, const int* in_sizes, int n_in, void* d_out, int out_size, void* d_ws, size_t ws_size, hipStream_t stream) {
    (void)in_sizes; (void)n_in; (void)out_size;
    static int grid = 0;
    if (!grid) {
        int dev = 0, cus = 0, per_cu = 0;
        hipGetDevice(&dev);
        hipDeviceGetAttribute(&cus, hipDeviceAttributeMultiprocessorCount, dev);
        hipFuncSetAttribute((const void*)mega, hipFuncAttributeMaxDynamicSharedMemorySize, SMEM_BYTES);
        hipOccupancyMaxActiveBlocksPerMultiprocessor(&per_cu, (const void*)mega, NT, SMEM_BYTES);
        if (per_cu < 1) per_cu = 1;
        grid = cus;
        if (ws_size < WS_TOTAL) fprintf(stderr, "workspace too small: %zu < %zu\n", ws_size, (size_t)WS_TOTAL);
    }
    hipMemsetAsync((unsigned char*)d_ws + OFF_BAR, 0, 16384, stream);
    Params p{};
    for (int i = 0; i < 34; ++i) p.in[i] = (const float*)d_in[i];
    p.out = (float*)d_out; p.ws = (unsigned char*)d_ws;
    hipLaunchKernelGGL(mega, dim3(grid), dim3(NT), SMEM_BYTES, stream, p);
}
#endif
```

```cpp
#ifndef CPU_EMU
#include <hip/hip_runtime.h>
#include <cstdio>
#include <cstdint>
typedef _Float16 half_t;
typedef _Float16 half8 __attribute__((ext_vector_type(8)));
typedef _Float16 half4 __attribute__((ext_vector_type(4)));
typedef float f32x4 __attribute__((ext_vector_type(4)));
typedef float f32x2 __attribute__((ext_vector_type(2)));
#define LAS __attribute__((address_space(3)))
#define SYNC() __syncthreads()
#define WAVE_SYNC() __builtin_amdgcn_wave_barrier()
template <int M> __device__ __forceinline__ float shfl_xor_t(float v, int tid) {
    if constexpr (M < 32) return __int_as_float(__builtin_amdgcn_ds_swizzle(__float_as_int(v), (M << 10) | 0x1f));
    else return __int_as_float(__builtin_amdgcn_ds_bpermute(((tid ^ 32) & 63) << 2, __float_as_int(v)));
}
#define SHFL_XOR(v, m) shfl_xor_t<m>((v), tid)
#define LDS_ATOMIC_INC(p) __hip_atomic_fetch_add((p), 1u, __ATOMIC_RELAXED, __HIP_MEMORY_SCOPE_WORKGROUP)
#endif

#ifndef CFG_BATCH
#define CFG_BATCH 8
#define CFG_SEQ 4096
#define CFG_CTX 256
#define CFG_DEPTH 4
#define CFG_NGROUP 2
#endif
constexpr int BATCH = CFG_BATCH, SEQ = CFG_SEQ, CTXL = CFG_CTX, DEPTH = CFG_DEPTH, NGROUP = CFG_NGROUP;
#ifndef SKIP_MASK
#define SKIP_MASK 0
#endif
#ifndef REPEAT_MASK
#define REPEAT_MASK 0
#endif
#define REPS(bit) for (int rep_ = 0; rep_ < ((REPEAT_MASK & (bit)) ? 2 : 1); ++rep_)
constexpr int NT = 512;
constexpr int D = 1024;
constexpr int IN_COLS = 8608, NP = 8704;
constexpr int C_Z = 1536, C_BG = 2048;
constexpr int C_RWKV = 2064;
constexpr int C_ML = 3984, C_MLO = 5008, C_MLIG = 5520, C_MLFG = 5528;
constexpr int C_GATE = 5536;
constexpr int BG = BATCH / NGROUP;
constexpr int RL = BG * SEQ, RC = BG * CTXL, RG = RL + RC;
constexpr int RGP = (RG + 255) / 256 * 256;
constexpr int CAPL = SEQ / 8, CAPC = CTXL / 8;
constexpr int RPE = (BG * (CAPL + CAPC) + 255) / 256 * 256;
constexpr int TPE = RPE / 256;
constexpr int NCH = RGP / 64;
static_assert(RL % 256 == 0, "latent rows per group must be a multiple of 256");
static_assert(SEQ % 64 == 0 && CTXL % 64 == 0, "chunks");

constexpr size_t al256(size_t x) { return (x + 255) / 256 * 256; }
constexpr size_t cmax(size_t a, size_t b) { return a > b ? a : b; }
constexpr size_t OFF_BAR = 0;
constexpr size_t OFF_MOD = 16384;
constexpr size_t OFF_CTXR = al256(OFF_MOD + (size_t)DEPTH * (BATCH + 1) * 6144 * 4);
constexpr size_t OFF_WIN = al256(OFF_CTXR + (size_t)BATCH * CTXL * D * 4);
constexpr size_t OFF_WBR = al256(OFF_WIN + (size_t)NP * 1024 * 2);
constexpr size_t OFF_WOUT = al256(OFF_WBR + (size_t)3 * 1024 * 512 * 2);
constexpr size_t OFF_WUP = al256(OFF_WOUT + (size_t)1024 * 1024 * 2);
constexpr size_t OFF_WDN = al256(OFF_WUP + (size_t)16 * 1024 * 1024 * 2);
constexpr size_t OFF_WLORA = al256(OFF_WDN + (size_t)16 * 1024 * 512 * 2);
constexpr size_t OFF_H = al256(OFF_WLORA + (size_t)2560 * 384 * 2);
constexpr size_t OFF_P = al256(OFF_H + (size_t)RGP * 1024 * 2);
constexpr size_t SZ_XE = (size_t)16 * RPE * 1024 * 2, SZ_HID = (size_t)16 * RPE * 512 * 2;
constexpr size_t OFF_XE = OFF_P, OFF_HID = OFF_XE + SZ_XE, OFF_YE = OFF_HID + SZ_HID;
constexpr size_t OFF_GQKV = al256(OFF_P + cmax((size_t)RGP * NP * 2, 2 * SZ_XE + SZ_HID));
constexpr size_t OFF_BR = OFF_GQKV;
constexpr size_t OFF_GBG = al256(OFF_GQKV + (size_t)RGP * 1536 * 2);
constexpr size_t OFF_GTA = al256(OFF_GBG + (size_t)RGP * 16 * 4);
constexpr size_t OFF_GG = al256(OFF_GTA + (size_t)NCH * 4 * 2 * 2 * 4096 * 2);
constexpr size_t OFF_RW = al256(OFF_GG + (size_t)NCH * 4 * 2 * 64 * 4);
constexpr size_t OFF_RLO = al256(OFF_RW + (size_t)RGP * 4 * 512 * 2);
constexpr size_t OFF_SO = al256(OFF_RLO + (size_t)RGP * 2560 * 2);
constexpr size_t OFF_RLI = OFF_SO;
constexpr size_t OFF_SOG = OFF_SO, OFF_SOM = OFF_SOG + (size_t)2 * RGP * 512 * 2, OFF_SOR = OFF_SOM + (size_t)2 * RGP * 512 * 2;
constexpr size_t OFF_PROB = al256(OFF_SOR + (size_t)2 * RGP * 512 * 4);
constexpr size_t OFF_SLOT = al256(OFF_PROB + (size_t)RGP * 16 * 4);
constexpr size_t OFF_SEL = al256(OFF_SLOT + (size_t)RGP * 16 * 4);
constexpr size_t OFF_AFF = al256(OFF_SEL + (size_t)16 * RPE * 4);
constexpr size_t WS_TOTAL = al256(OFF_AFF + (size_t)16 * RPE * 4);
constexpr int SMEM_BYTES = 152 * 1024;

struct Params { const float* in[34]; float* out; unsigned char* ws; };
enum { I_X = 0, I_C, I_CTX, I_CCTX, I_ADAW, I_ADAB, I_N1G, I_N2G, I_WIN, I_GCONV, I_GALOG, I_GDTB, I_GNG, I_RMU, I_RW0, I_RWUP, I_RA0, I_RAUP, I_RGUP,
       I_RKK, I_RKA, I_RRK, I_RLNG, I_RLNB, I_MIB, I_MFB, I_MNG, I_WBR, I_WOUT, I_ROUT, I_W1, I_W3, I_W2, I_FING };

#ifndef CPU_EMU
__device__ __forceinline__ int tid_fresh(int wb) { int t; asm volatile("v_mbcnt_lo_u32_b32 %0, -1, 0\n\tv_mbcnt_hi_u32_b32 %0, -1, %0" : "=v"(t)); return wb + t; }
#else
static inline int tid_fresh(int) { return threadIdx.x; }
#endif
#ifndef CPU_EMU
__device__ __forceinline__ float fexp(float x) { return __builtin_amdgcn_exp2f(x * 1.4426950408889634f); }
__device__ __forceinline__ float flog(float x) { return __builtin_amdgcn_logf(x) * 0.6931471805599453f; }
__device__ __forceinline__ float frcp(float x) { return __builtin_amdgcn_rcpf(x); }
__device__ __forceinline__ float frsq(float x) { return __builtin_amdgcn_rsqf(x); }
#else
static inline float fexp(float x) { return expf(x); }
static inline float flog(float x) { return logf(x); }
static inline float frcp(float x) { return 1.f / x; }
static inline float frsq(float x) { return 1.f / sqrtf(x); }
#endif
__device__ __forceinline__ float sigm(float x) { return frcp(1.f + fexp(-x)); }
__device__ __forceinline__ float siluf(float x) { return x * frcp(1.f + fexp(-x)); }
__device__ __forceinline__ float ftanh(float x) { return 1.f - 2.f * frcp(1.f + fexp(2.f * x)); }
__device__ __forceinline__ float softplusf(float x) { const float t = fexp(x); return x > 15.f ? x : (t < 1e-3f ? t * (1.f - 0.5f * t) : flog(1.f + t)); }
#define wave_sum(x) wave_sum_(x, tid)
__device__ __forceinline__ float wave_sum_(float v, int tid) { v += SHFL_XOR(v, 32); v += SHFL_XOR(v, 16); v += SHFL_XOR(v, 8); v += SHFL_XOR(v, 4); v += SHFL_XOR(v, 2); v += SHFL_XOR(v, 1); return v; }

__device__ __forceinline__ const float* res_src(const Params& p, int l, int g, int r) {
    if (r < RL) { const size_t t = (size_t)(g * BG) * SEQ + r; return (l == 0 ? p.in[I_X] : p.out) + t * D; }
    const size_t t = (size_t)(g * BG) * CTXL + (r - RL); return (l == 0 ? p.in[I_CTX] : (const float*)(p.ws + OFF_CTXR)) + t * D;
}
__device__ __forceinline__ float* res_dst(const Params& p, int g, int r) {
    if (r < RL) { const size_t t = (size_t)(g * BG) * SEQ + r; return p.out + t * D; }
    const size_t t = (size_t)(g * BG) * CTXL + (r - RL); return (float*)(p.ws + OFF_CTXR) + t * D;
}
__device__ __forceinline__ const float* mod_row(const Params& p, int l, int g, int r) {
    const int s = r < RL ? (g * BG + r / SEQ) : BATCH; return (const float*)(p.ws + OFF_MOD) + ((size_t)l * (BATCH + 1) + s) * 6144;
}

#ifndef CPU_EMU
#define XB_TMO      128
#define XB_XCNT(j)  (256  + 64 * (j))
#define XB_XSUB(j)  (1280 + 64 * (j))
#define XB_XGEN(j)  (2304 + 64 * (j))
#define XB_TOP      3328
#define XB_TOPGEN   3392
#define XCD_BAR_WORDS 3456
#define XB_SPIN_CAP (1u << 22)
__device__ __forceinline__ unsigned xb_ld(unsigned* p)              { return __hip_atomic_load(p, __ATOMIC_RELAXED, __HIP_MEMORY_SCOPE_AGENT); }
__device__ __forceinline__ unsigned xb_add(unsigned* p, unsigned v) { return __hip_atomic_fetch_add(p, v, __ATOMIC_RELAXED, __HIP_MEMORY_SCOPE_AGENT); }
__device__ __forceinline__ unsigned xb_xcc_id() { return (unsigned)__builtin_amdgcn_s_getreg((3 << 11) | 20) & 0xFu; }
#define XB_SPIN(cond, bar) do { unsigned _sp = 0; while (cond) { __builtin_amdgcn_s_sleep(1); \
    if ((++_sp & 255u) == 0u) { if (xb_ld(&(bar)[XB_TMO])) break; if (_sp > XB_SPIN_CAP) { atomicAdd(&(bar)[XB_TMO], 1u); break; } } } } while (0)
struct XcdBarrier { unsigned* bar; unsigned x; volatile LAS unsigned* st; };
__device__ __forceinline__ XcdBarrier xcd_barrier_post(unsigned* bar, volatile LAS unsigned* st) {
    XcdBarrier b; b.bar = bar; b.x = xb_xcc_id(); b.st = st;
    if (threadIdx.x == 0) (void)xb_add(&bar[XB_XCNT(b.x)], 1u);
    return b;
}
__device__ __forceinline__ void xcd_barrier_complete(unsigned* bar, unsigned x, unsigned& nloc, unsigned& nx) {
    const unsigned G = gridDim.x * gridDim.y * gridDim.z;
    unsigned sum, cnt, mine, sp = 0u;
    for (;;) {
        sum = 0u; cnt = 0u; mine = 0u;
#pragma unroll
        for (unsigned j = 0; j < 16; ++j) { const unsigned c = xb_ld(&bar[XB_XCNT(j)]); sum += c; cnt += (c > 0u) ? 1u : 0u; mine = (j == x) ? c : mine; }
        if (sum == G) break;
        __builtin_amdgcn_s_sleep(1);
        if ((++sp & 255u) == 0u) { if (xb_ld(&bar[XB_TMO])) break; if (sp > XB_SPIN_CAP) { atomicAdd(&bar[XB_TMO], 1u); break; } }
    }
    nloc = mine > 0u ? mine : 1u; nx = cnt > 0u ? cnt : 1u;
}
__device__ __forceinline__ void xcd_barrier(const XcdBarrier& b) {
    asm volatile("s_waitcnt vmcnt(0)" ::: "memory");
    __syncthreads();
    if (threadIdx.x == 0) {
        unsigned* bar = b.bar;
        __builtin_amdgcn_s_waitcnt(0);
        unsigned nloc = b.st[0], nx = b.st[1];
        if (nloc == 0u) { xcd_barrier_complete(bar, b.x, nloc, nx); b.st[0] = nloc; b.st[1] = nx; }
        const unsigned old = xb_add(&bar[XB_XSUB(b.x)], 1u);
        const unsigned gen = old / nloc;
        if (old + 1u == (gen + 1u) * nloc) {
            __builtin_amdgcn_fence(__ATOMIC_RELEASE, "agent");
            asm volatile("s_waitcnt vmcnt(0)" ::: "memory");
            const unsigned og = xb_add(&bar[XB_TOP], 1u);
            const unsigned tg = og / nx;
            if (og + 1u == (tg + 1u) * nx) xb_add(&bar[XB_TOPGEN], 1u);
            else XB_SPIN(xb_ld(&bar[XB_TOPGEN]) == tg, bar);
            __builtin_amdgcn_fence(__ATOMIC_ACQUIRE, "agent");
            xb_add(&bar[XB_XGEN(b.x)], 1u);
            asm volatile("s_waitcnt vmcnt(0)" ::: "memory");
        } else {
            XB_SPIN(xb_ld(&bar[XB_XGEN(b.x)]) == gen, bar);
            __builtin_amdgcn_fence(__ATOMIC_ACQUIRE, "agent");
            asm volatile("s_waitcnt vmcnt(0)" ::: "memory");
        }
    }
    __syncthreads();
}
#define GRID_SYNC() do { XcdBarrier gb_; gb_.bar = (unsigned*)(p.ws + OFF_BAR); gb_.x = xb_xcc_id(); gb_.st = (volatile LAS unsigned*)(lds + SMEM_BYTES - 16); xcd_barrier(gb_); } while (0)
#else
#define GRID_SYNC() emu_grid_sync()
#endif

namespace pg8 {
constexpr int BM = 256, BK = 64, HALF = 128, HTB = HALF * BK * 2, STAGE_BYTES = 8 * HTB, NXCD = 8, WGM = 8;
__host__ __device__ __forceinline__ int lds_byte(int r, int c) { const int st = (r >> 4) * 2 + (c >> 5), rr = r & 15, cc = c & 31, ob = rr * 64 + cc * 2; return st * 1024 + (ob ^ (((ob >> 9) & 1) << 5)); }
__host__ __device__ __forceinline__ void stage_rc(int b, int& R, int& C) { const int st = b / 1024, sb = b % 1024, swz = sb ^ (((sb >> 9) & 1) << 5); R = (st >> 1) * 16 + swz / 64; C = (st & 1) * 32 + (swz % 64) / 2; }
__host__ __device__ __forceinline__ int perm32(int rho) { const int n = rho >> 4, i = rho & 15; return 8 * (i >> 2) + 4 * n + (i & 3); }
struct Unit { int pm, pn, pb; };
struct Gemm { const half_t* A; const half_t* Bt; int K; };
struct StaticOrder {
    int nM, nN, nwg, G, c;
    __device__ void init(int nM_, int nN_, int G_, int c_) { nM = nM_; nN = nN_; nwg = nM * nN; G = G_; c = c_; }
    __device__ bool next(int i, Unit& u) const {
        const long L = (long)i * G + c; if (L >= nwg) return false;
        int wgid = (int)L; { const int q = nwg / NXCD, r = nwg % NXCD, xcd = wgid % NXCD, off = wgid / NXCD; wgid = (xcd < r ? xcd * (q + 1) : r * (q + 1) + (xcd - r) * q) + off; }
        const int nig = WGM * nN, gid = wgid / nig, fm = gid * WGM, gsz = (nM - fm) < WGM ? (nM - fm) : WGM;
        u.pm = fm + ((wgid % nig) % gsz); u.pn = (wgid % nig) / gsz; u.pb = u.pn; return true;
    }
};
struct ExpertOrder {
    int G, c;
    __device__ void init(int G_, int c_) { G = G_; c = c_; }
    __device__ bool next(int i, Unit& u) const {
        const long L = (long)i * G + c; if (L >= 16 * TPE * 4) return false;
        const int e = (int)L / (TPE * 4), rem = (int)L % (TPE * 4);
        u.pm = e * TPE + rem / 4; u.pn = rem % 4; u.pb = e * 4 + u.pn; return true;
    }
};

#ifndef CPU_EMU
template <class Epi, class Sched>
__device__ __forceinline__ void gemm_phase(int wb, LAS unsigned char* lds, const Gemm g, const Sched& S, const Epi& E) {
    const int tid = tid_fresh(wb), wid = __builtin_amdgcn_readfirstlane(tid >> 6), lane = tid & 63, wr = wid >> 2, wc = wid & 3, fr = lane & 15, fq = lane >> 4;
    const int K = g.K, nt = K / BK;
    unsigned voffA[2], voffB[2];
#pragma unroll
    for (int i = 0; i < 2; ++i) { int R, C; stage_rc(tid * 16 + i * 8192, R, C); const int Rb = Epi::PERM ? ((R & ~31) + perm32(R & 31)) : R;
        voffA[i] = (unsigned)(R * K + C) * 2u; voffB[i] = (unsigned)(Rb * K + C) * 2u; }
    const size_t kstep = (size_t)(BK * 2);
    const size_t hstep = (size_t)HALF * K * 2;
    const size_t tstep = 2 * hstep;
    const unsigned ldsw = (unsigned)wid * 1024u;
    const int aoff = lds_byte(wr * 64 + fr, fq * 8), boff = lds_byte(wc * 32 + fr, fq * 8);
#define PG8_SA(b, h) (((b) * 2 + (h)) * HTB)
#define PG8_SB(b, h) ((4 + (b) * 2 + (h)) * HTB)
#define PG8_STAGE(bufoff, gbase, voff) do { _Pragma("unroll") for (int _i = 0; _i < 2; ++_i) \
        __builtin_amdgcn_global_load_lds((const unsigned*)((const char*)(gbase) + (voff)[_i]), (LAS unsigned*)(lds + (bufoff) + ldsw + _i * 8192), 16, 0, 0); } while (0)
#define PG8_LDA(dst, b, h) do { _Pragma("unroll") for (int m = 0; m < 4; ++m) _Pragma("unroll") for (int k = 0; k < 2; ++k) dst[m][k] = *(const LAS half8*)(lds + PG8_SA(b, h) + aoff + m * 2048 + k * 1024); } while (0)
#define PG8_LDB(dst, b, h) do { _Pragma("unroll") for (int n = 0; n < 2; ++n) _Pragma("unroll") for (int k = 0; k < 2; ++k) dst[n][k] = *(const LAS half8*)(lds + PG8_SB(b, h) + boff + n * 2048 + k * 1024); } while (0)
#define PG8_MMA(ai, bj, At, Bt) do { __builtin_amdgcn_s_setprio(1); _Pragma("unroll") for (int m = 0; m < 4; ++m) _Pragma("unroll") for (int n = 0; n < 2; ++n) _Pragma("unroll") for (int k = 0; k < 2; ++k) \
        acc[ai][bj][m][n] = __builtin_amdgcn_mfma_f32_16x16x32_f16(Bt[n][k], At[m][k], acc[ai][bj][m][n], 0, 0, 0); __builtin_amdgcn_s_setprio(0); } while (0)
#define PG8_WAIT_V(n) asm volatile("s_waitcnt vmcnt(" #n ")" ::: "memory")
#define PG8_WAIT_L(n) asm volatile("s_waitcnt lgkmcnt(" #n ")" ::: "memory")
#define PG8_BAR __builtin_amdgcn_s_barrier()
#define PG8_SCHED __builtin_amdgcn_sched_barrier(0)
    Unit cur, nxt; int ui = 0;
    if (!S.next(0, cur)) return;
    f32x4 acc[2][2][4][2];
#pragma unroll
    for (int a = 0; a < 2; ++a)
#pragma unroll
        for (int b = 0; b < 2; ++b)
#pragma unroll
            for (int m = 0; m < 4; ++m)
#pragma unroll
                for (int n = 0; n < 2; ++n) acc[a][b][m][n] = (f32x4){0.f, 0.f, 0.f, 0.f};
    half8 At[4][2], B0[2][2], B1[2][2];
    const char* cA = (const char*)g.A + (size_t)cur.pm * tstep; const char* cB = (const char*)g.Bt + (size_t)cur.pb * tstep;
    PG8_STAGE(PG8_SB(0, 0), cB, voffB); PG8_STAGE(PG8_SA(0, 0), cA, voffA); PG8_STAGE(PG8_SB(0, 1), cB + hstep, voffB); PG8_STAGE(PG8_SA(0, 1), cA + hstep, voffA);
    if (wr == 1) PG8_BAR;
    PG8_WAIT_V(4); PG8_BAR;
    PG8_STAGE(PG8_SB(1, 0), cB + kstep, voffB); PG8_STAGE(PG8_SA(1, 0), cA + kstep, voffA); PG8_STAGE(PG8_SB(1, 1), cB + hstep + kstep, voffB);
    PG8_WAIT_V(6); PG8_BAR;
    for (;;) {
        const bool has_next = S.next(ui + 1, nxt);
        const char* nA = has_next ? (const char*)g.A + (size_t)nxt.pm * tstep : cA; const char* nB = has_next ? (const char*)g.Bt + (size_t)nxt.pb * tstep : cB;
#pragma unroll 1
        for (int t = 0; t < nt; t += 2) {
            const bool last = (t == nt - 2);
            const char* a1 = cA + (size_t)(t + 1) * kstep;
            const char* a2 = last ? nA : cA + (size_t)(t + 2) * kstep; const char* b2 = last ? nB : cB + (size_t)(t + 2) * kstep;
            const char* a3 = a2 + kstep; const char* b3 = b2 + kstep;
            PG8_LDB(B0, 0, 0); PG8_SCHED; PG8_LDA(At, 0, 0); PG8_STAGE(PG8_SA(1, 1), a1 + hstep, voffA);
            PG8_WAIT_L(8); PG8_BAR; PG8_WAIT_L(0); PG8_MMA(0, 0, At, B0); PG8_BAR; PG8_SCHED;
            PG8_LDB(B1, 0, 1); PG8_STAGE(PG8_SB(0, 0), b2, voffB);
            PG8_BAR; PG8_WAIT_L(0); PG8_MMA(0, 1, At, B1); PG8_BAR;
            PG8_LDA(At, 0, 1); PG8_STAGE(PG8_SA(0, 0), a2, voffA);
            PG8_BAR; PG8_WAIT_L(0); PG8_MMA(1, 0, At, B0); PG8_BAR; PG8_SCHED;
            PG8_STAGE(PG8_SB(0, 1), b2 + hstep, voffB);
            PG8_WAIT_V(6); PG8_BAR; PG8_MMA(1, 1, At, B1); PG8_BAR;
            PG8_LDB(B0, 1, 0); PG8_SCHED; PG8_LDA(At, 1, 0); PG8_STAGE(PG8_SA(0, 1), a2 + hstep, voffA);
            PG8_WAIT_L(8); PG8_BAR; PG8_WAIT_L(0); PG8_MMA(0, 0, At, B0); PG8_BAR; PG8_SCHED;
            PG8_LDB(B1, 1, 1); PG8_STAGE(PG8_SB(1, 0), b3, voffB);
            PG8_BAR; PG8_WAIT_L(0); PG8_MMA(0, 1, At, B1); PG8_BAR;
            PG8_LDA(At, 1, 1); PG8_STAGE(PG8_SA(1, 0), a3, voffA);
            PG8_BAR; PG8_WAIT_L(0); PG8_MMA(1, 0, At, B0); PG8_BAR; PG8_SCHED;
            PG8_STAGE(PG8_SB(1, 1), b3 + hstep, voffB);
            PG8_WAIT_V(6); PG8_BAR; PG8_MMA(1, 1, At, B1); PG8_BAR;
        }
        E(acc, cur, wr, wc, fr, fq);
        if (!has_next) break;
#pragma unroll
        for (int a = 0; a < 2; ++a)
#pragma unroll
            for (int b = 0; b < 2; ++b)
#pragma unroll
                for (int m = 0; m < 4; ++m)
#pragma unroll
                    for (int n = 0; n < 2; ++n) acc[a][b][m][n] = (f32x4){0.f, 0.f, 0.f, 0.f};
        cur = nxt; cA = nA; cB = nB; ++ui;
    }
    PG8_WAIT_V(0);
    if (wr == 0) PG8_BAR;
    PG8_BAR;
#undef PG8_SA
#undef PG8_SB
#undef PG8_STAGE
#undef PG8_LDA
#undef PG8_LDB
#undef PG8_MMA
#undef PG8_WAIT_V
#undef PG8_WAIT_L
#undef PG8_BAR
#undef PG8_SCHED
}
#else
static float* emu_fa[64]; static float* emu_fb[64];
template <class Epi, class Sched>
void gemm_phase(int wb, LAS unsigned char* lds, const Gemm g, const Sched& S, const Epi& E) {
    const int tid = tid_fresh(wb), wid = tid >> 6, lane = tid & 63, wr = wid >> 2, wc = wid & 3, fr = lane & 15, fq = lane >> 4;
    const int K = g.K; const int bid = blockIdx.x;
    Unit u;
    for (int ui = 0; S.next(ui, u); ++ui) {
        SYNC();
        if (tid == 0) {
            if (!emu_fa[bid]) { emu_fa[bid] = (float*)malloc(256 * 1024 * 4); emu_fb[bid] = (float*)malloc(256 * 1024 * 4); }
            for (int r = 0; r < 256; ++r) for (int k = 0; k < K; ++k) { emu_fa[bid][r * K + k] = (float)g.A[((size_t)u.pm * 256 + r) * K + k]; emu_fb[bid][r * K + k] = (float)g.Bt[((size_t)u.pb * 256 + r) * K + k]; }
        }
        SYNC();
        f32x4 acc[2][2][4][2];
        for (int ai = 0; ai < 2; ++ai) for (int bj = 0; bj < 2; ++bj) for (int m = 0; m < 4; ++m) for (int n = 0; n < 2; ++n) for (int i = 0; i < 4; ++i) {
            const int row = 128 * ai + 64 * wr + 16 * m + fr;
            const int col = Epi::PERM ? (128 * bj + 32 * wc + 8 * fq + 4 * n + i) : (128 * bj + 32 * wc + 16 * n + 4 * fq + i);
            const float* a = emu_fa[bid] + row * K; const float* b = emu_fb[bid] + col * K; float s = 0.f;
            for (int k = 0; k < K; ++k) s += a[k] * b[k];
            acc[ai][bj][m][n][i] = s; }
        E(acc, u, wr, wc, fr, fq);
    }
    SYNC();
}
#endif
}
using pg8::Unit;

struct EpiP {
    static constexpr bool PERM = true;
    half_t* P;
    __device__ __forceinline__ void operator()(const f32x4 (&acc)[2][2][4][2], const Unit& u, int wr, int wc, int fr, int fq) const {
        const int row0 = u.pm * 256 + wr * 64 + fr, col0 = u.pn * 256 + wc * 32 + 8 * fq;
#pragma unroll
        for (int bj = 0; bj < 2; ++bj) {
            const int col = col0 + bj * 128;
            const bool sg = (col >= C_GATE && col < IN_COLS) || (col >= C_MLO && col < C_MLIG);
#pragma unroll
            for (int ai = 0; ai < 2; ++ai)
#pragma unroll
                for (int m = 0; m < 4; ++m) {
                    half8 h;
#pragma unroll
                    for (int n = 0; n < 2; ++n)
#pragma unroll
                        for (int i = 0; i < 4; ++i) { float v = acc[ai][bj][m][n][i]; if (sg) v = sigm(v); h[4 * n + i] = (half_t)v; }
                    *(half8*)(P + (size_t)(row0 + ai * 128 + m * 16) * NP + col) = h;
                }
        }
    }
};
struct EpiLora {
    static constexpr bool PERM = true;
    half_t* O; const float* w0; const float* a0;
    __device__ __forceinline__ void operator()(const f32x4 (&acc)[2][2][4][2], const Unit& u, int wr, int wc, int fr, int fq) const {
        const int row0 = u.pm * 256 + wr * 64 + fr, col0 = u.pn * 256 + wc * 32 + 8 * fq;
#pragma unroll
        for (int bj = 0; bj < 2; ++bj) {
            const int col = col0 + bj * 128, blk = col >> 9;
            float bias[8];
#pragma unroll
            for (int j = 0; j < 8; ++j) bias[j] = blk < 2 ? w0[col + j] : (blk < 4 ? a0[col - 1024 + j] : 0.f);
#pragma unroll
            for (int ai = 0; ai < 2; ++ai)
#pragma unroll
                for (int m = 0; m < 4; ++m) {
                    half8 h;
#pragma unroll
                    for (int n = 0; n < 2; ++n)
#pragma unroll
                        for (int i = 0; i < 4; ++i) { float v = acc[ai][bj][m][n][i] + bias[4 * n + i];
                            if (blk < 2) v = sigm(v) * 0.6065306597126334f; else if (blk < 4) v = sigm(v);
                            h[4 * n + i] = (half_t)v; }
                    *(half8*)(O + (size_t)(row0 + ai * 128 + m * 16) * 2560 + col) = h;
                }
        }
    }
};
struct EpiMerge {
    static constexpr bool PERM = true;
    half_t* M; const half_t* P; int bi;
    __device__ __forceinline__ void operator()(const f32x4 (&acc)[2][2][4][2], const Unit& u, int wr, int wc, int fr, int fq) const {
        const int row0 = u.pm * 256 + wr * 64 + fr, col0 = u.pn * 256 + wc * 32 + 8 * fq;
#pragma unroll
        for (int ai = 0; ai < 2; ++ai)
#pragma unroll
            for (int m = 0; m < 4; ++m) {
                const size_t row = (size_t)(row0 + ai * 128 + m * 16);
#pragma unroll
                for (int bj = 0; bj < 2; ++bj) {
                    const int col = col0 + bj * 128;
                    const half8 gt = *(const half8*)(P + row * NP + C_GATE + bi * 1024 + col);
                    half8 o; if (bi > 0) o = *(const half8*)(M + row * 1024 + col);
#pragma unroll
                    for (int n = 0; n < 2; ++n)
#pragma unroll
                        for (int i = 0; i < 4; ++i) { float v = (float)gt[4 * n + i] * acc[ai][bj][m][n][i]; if (bi > 0) v += (float)o[4 * n + i]; o[4 * n + i] = (half_t)v; }
                    *(half8*)(M + row * 1024 + col) = o;
                }
            }
    }
};
struct EpiOut {
    static constexpr bool PERM = false;
    Params p; int l, g;
    __device__ __forceinline__ void operator()(const f32x4 (&acc)[2][2][4][2], const Unit& u, int wr, int wc, int fr, int fq) const {
        const int row0 = u.pm * 256 + wr * 64 + fr, col0 = u.pn * 256 + wc * 32 + 4 * fq;
#pragma unroll
        for (int ai = 0; ai < 2; ++ai)
#pragma unroll
            for (int m = 0; m < 4; ++m) {
                const int row = row0 + ai * 128 + m * 16;
                if (row < RG) {
                    const float* src = res_src(p, l, g, row); float* dst = res_dst(p, g, row); const float* md = mod_row(p, l, g, row) + 2 * 1024;
#pragma unroll
                    for (int bj = 0; bj < 2; ++bj)
#pragma unroll
                        for (int n = 0; n < 2; ++n) { const int col = col0 + bj * 128 + n * 16;
                            const f32x4 xo = *(const f32x4*)(src + col), mv = *(const f32x4*)(md + col);
                            *(f32x4*)(dst + col) = xo + mv * acc[ai][bj][m][n]; }
                }
            }
    }
};
struct EpiUp {
    static constexpr bool PERM = true;
    half_t* HID;
    __device__ __forceinline__ void operator()(const f32x4 (&acc)[2][2][4][2], const Unit& u, int wr, int wc, int fr, int fq) const {
        const int row0 = u.pm * 256 + wr * 64 + fr, col = u.pn * 128 + wc * 32 + 8 * fq;
#pragma unroll
        for (int ai = 0; ai < 2; ++ai)
#pragma unroll
            for (int m = 0; m < 4; ++m) {
                half8 h;
#pragma unroll
                for (int n = 0; n < 2; ++n)
#pragma unroll
                    for (int i = 0; i < 4; ++i) h[4 * n + i] = (half_t)(siluf(acc[ai][0][m][n][i]) * acc[ai][1][m][n][i]);
                *(half8*)(HID + (size_t)(row0 + ai * 128 + m * 16) * 512 + col) = h;
            }
    }
};
struct EpiDown {
    static constexpr bool PERM = true;
    half_t* YE; const float* AFF;
    __device__ __forceinline__ void operator()(const f32x4 (&acc)[2][2][4][2], const Unit& u, int wr, int wc, int fr, int fq) const {
        const int row0 = u.pm * 256 + wr * 64 + fr, col0 = u.pn * 256 + wc * 32 + 8 * fq;
#pragma unroll
        for (int ai = 0; ai < 2; ++ai)
#pragma unroll
            for (int m = 0; m < 4; ++m) {
                const size_t row = (size_t)(row0 + ai * 128 + m * 16); const float af = AFF[row];
#pragma unroll
                for (int bj = 0; bj < 2; ++bj) {
                    half8 h;
#pragma unroll
                    for (int n = 0; n < 2; ++n)
#pragma unroll
                        for (int i = 0; i < 4; ++i) h[4 * n + i] = (half_t)(acc[ai][bj][m][n][i] * af);
                    *(half8*)(YE + row * 1024 + col0 + bj * 128) = h;
                }
            }
    }
};

__device__ __forceinline__ void ph_mod(int wb, const Params& p, LAS unsigned char* lds) {
    LAS float* sv = (LAS float*)lds; LAS float* red = sv + (BATCH + 1) * 1024;
    const int tid = tid_fresh(wb);
    for (int i = tid; i < (BATCH + 1) * 1024; i += NT) { const int s = i >> 10, k = i & 1023; const float cv = s < BATCH ? p.in[I_C][s * 1024 + k] : p.in[I_CCTX][k]; sv[i] = siluf(cv); }
    SYNC();
    float* mod = (float*)(p.ws + OFF_MOD);
    for (int item = blockIdx.x; item < DEPTH * 48; item += gridDim.x) {
        const int l = item / 48, j = (item % 48) * 128 + (tid & 127), kq = tid >> 7;
        float acc[BATCH + 1];
#pragma unroll
        for (int s = 0; s <= BATCH; ++s) acc[s] = 0.f;
        const float* w = p.in[I_ADAW] + (size_t)l * 1024 * 6144 + j;
        for (int k = kq * 256; k < kq * 256 + 256; ++k) { const float wv = w[(size_t)k * 6144];
#pragma unroll
            for (int s = 0; s <= BATCH; ++s) acc[s] += sv[s * 1024 + k] * wv; }
#pragma unroll
        for (int s = 0; s <= BATCH; ++s) red[tid * (BATCH + 1) + s] = acc[s];
        SYNC();
        if (tid < 128) {
#pragma unroll
            for (int s = 0; s <= BATCH; ++s) { float v = p.in[I_ADAB][l * 6144 + j];
                for (int q = 0; q < 4; ++q) v += red[(q * 128 + tid) * (BATCH + 1) + s];
                mod[((size_t)l * (BATCH + 1) + s) * 6144 + j] = v; }
        }
        SYNC();
    }
}

__device__ __forceinline__ void tconv_tile(int wb, const float* src, int sld, int k0, int n0, int nvalid, half_t* dst, int dld, int drow0, int dcol0, LAS float* tile) {
    const int tid = tid_fresh(wb), r = tid >> 4, c4 = (tid & 15) * 4;
#pragma unroll
    for (int j = 0; j < 2; ++j) { const int k = r + 32 * j; f32x4 v = {0.f, 0.f, 0.f, 0.f};
        if (src && n0 + c4 < nvalid) v = *(const f32x4*)(src + (size_t)(k0 + k) * sld + n0 + c4);
        tile[k * 65 + c4] = v[0]; tile[k * 65 + c4 + 1] = v[1]; tile[k * 65 + c4 + 2] = v[2]; tile[k * 65 + c4 + 3] = v[3]; }
    SYNC();
    const int n = tid >> 3, k8 = (tid & 7) * 8; half8 h;
#pragma unroll
    for (int i = 0; i < 8; ++i) h[i] = (half_t)tile[(k8 + i) * 65 + n];
    *(half8*)(dst + (size_t)(drow0 + n) * dld + dcol0 + k8) = h;
    SYNC();
}
__device__ __forceinline__ void ph_convert(int wb, const Params& p, int l, LAS unsigned char* lds) {
    LAS float* tile = (LAS float*)lds;
    constexpr int N_WIN = 16 * (NP / 64), N_WBR = 3 * 128, N_WOUT = 256, N_W13 = 2 * 2048, N_W2 = 2048, N_LORA = 240;
    constexpr int TOTAL = N_WIN + N_WBR + N_WOUT + N_W13 + N_W2 + N_LORA;
    half_t* ws16 = (half_t*)p.ws;
    for (int item = blockIdx.x; item < TOTAL; item += gridDim.x) {
        int it = item;
        if (it < N_WIN) { const int kt = it % 16, ntile = it / 16;
            tconv_tile(wb, p.in[I_WIN] + (size_t)l * 1024 * IN_COLS, IN_COLS, 64 * kt, 64 * ntile, IN_COLS, (half_t*)(p.ws + OFF_WIN), 1024, 64 * ntile, 64 * kt, tile); continue; }
        it -= N_WIN;
        if (it < N_WBR) { const int i = it / 128, rem = it % 128, kt = rem % 8, ntile = rem / 8;
            tconv_tile(wb, p.in[I_WBR] + (size_t)(l * 3 + i) * 512 * 1024, 1024, 64 * kt, 64 * ntile, 1024, (half_t*)(p.ws + OFF_WBR) + (size_t)i * 1024 * 512, 512, 64 * ntile, 64 * kt, tile); continue; }
        it -= N_WBR;
        if (it < N_WOUT) { const int kt = it % 16, ntile = it / 16;
            tconv_tile(wb, p.in[I_WOUT] + (size_t)l * 1024 * 1024, 1024, 64 * kt, 64 * ntile, 1024, (half_t*)(p.ws + OFF_WOUT), 1024, 64 * ntile, 64 * kt, tile); continue; }
        it -= N_WOUT;
        if (it < N_W13) { const int which = it / 2048, rem = it % 2048, e = rem / 128, r2 = rem % 128, kt = r2 % 16, ntile = r2 / 16, n0 = 64 * ntile;
            tconv_tile(wb, p.in[which ? I_W3 : I_W1] + (size_t)(l * 16 + e) * 1024 * 512, 512, 64 * kt, n0, 512, (half_t*)(p.ws + OFF_WUP) + (size_t)e * 1024 * 1024, 1024,
                       (n0 / 128) * 256 + which * 128 + (n0 % 128), 64 * kt, tile); continue; }
        it -= N_W13;
        if (it < N_W2) { const int e = it / 128, r2 = it % 128, kt = r2 % 8, ntile = r2 / 8;
            tconv_tile(wb, p.in[I_W2] + (size_t)(l * 16 + e) * 512 * 1024, 1024, 64 * kt, 64 * ntile, 1024, (half_t*)(p.ws + OFF_WDN) + (size_t)e * 1024 * 512, 512, 64 * ntile, 64 * kt, tile); continue; }
        it -= N_W2;
        { const int ntile = it / 6, kt = it % 6, n0 = 64 * ntile, blk = n0 / 512, nn0 = n0 % 512;
          const float* src = nullptr; int k0 = 0;
          if (blk == 0 && kt == 0) src = p.in[I_RWUP] + (size_t)(l * 2 + 0) * 64 * 512;
          else if (blk == 1 && kt == 1) src = p.in[I_RWUP] + (size_t)(l * 2 + 1) * 64 * 512;
          else if (blk == 2 && kt == 2) src = p.in[I_RAUP] + (size_t)(l * 2 + 0) * 64 * 512;
          else if (blk == 3 && kt == 3) src = p.in[I_RAUP] + (size_t)(l * 2 + 1) * 64 * 512;
          else if (blk == 4 && kt >= 4) { src = p.in[I_RGUP] + (size_t)l * 128 * 512; k0 = 64 * (kt - 4); }
          tconv_tile(wb, src, 512, k0, nn0, 512, (half_t*)(p.ws + OFF_WLORA), 384, n0, 64 * kt, tile); }
    }
    (void)ws16;
}

__device__ __forceinline__ void ph_norm1(int wb, const Params& p, int l, int g) {
    const int tid = tid_fresh(wb), wid = tid >> 6, lane = tid & 63;
    half_t* H = (half_t*)(p.ws + OFF_H);
    for (int r = blockIdx.x * 8 + wid; r < RGP; r += gridDim.x * 8) {
        if (r >= RG) { for (int j = 0; j < 4; ++j) *(half4*)(H + (size_t)r * D + lane * 4 + 256 * j) = (half4){0, 0, 0, 0}; continue; }
        const float* xr = res_src(p, l, g, r); const float* md = mod_row(p, l, g, r); const float* gn = p.in[I_N1G] + l * D;
        f32x4 v[4]; float ss = 0.f;
#pragma unroll
        for (int j = 0; j < 4; ++j) { v[j] = *(const f32x4*)(xr + lane * 4 + 256 * j); ss += v[j][0] * v[j][0] + v[j][1] * v[j][1] + v[j][2] * v[j][2] + v[j][3] * v[j][3]; }
        ss = wave_sum(ss); const float rinv = frsq(ss * (1.f / D) + 1e-6f);
#pragma unroll
        for (int j = 0; j < 4; ++j) { const int c = lane * 4 + 256 * j; half4 h;
#pragma unroll
            for (int i = 0; i < 4; ++i) h[i] = (half_t)(v[j][i] * rinv * gn[c + i] * (1.f + md[1024 + c + i]) + md[c + i]);
            *(half4*)(H + (size_t)r * D + c) = h; }
    }
}

struct RowGeo { int gw, gh, base, gr, gc; };
__device__ __forceinline__ RowGeo row_geo(int r) {
    RowGeo q; int i;
    if (r < RL) { const int bl = r / SEQ; i = r % SEQ; q.gw = 64; q.gh = SEQ / 64; q.base = bl * SEQ; }
    else { const int rr = r - RL, bl = rr / CTXL; i = rr % CTXL; q.gw = CTXL; q.gh = 1; q.base = RL + bl * CTXL; }
    q.gr = i / q.gw; q.gc = i % q.gw; return q;
}

__device__ __forceinline__ void ph_prep(int wb, const Params& p, int l, LAS unsigned char* lds) {
    const int tid = tid_fresh(wb), wid = tid >> 6, lane = tid & 63;
    LAS float* cw = (LAS float*)lds;
    for (int i = tid; i < 9 * 1536; i += NT) cw[i] = p.in[I_GCONV][(size_t)l * 9 * 1536 + i];
    SYNC();
    const half_t* P = (const half_t*)(p.ws + OFF_P);
    half_t* GQKV = (half_t*)(p.ws + OFF_GQKV); float* GBG = (float*)(p.ws + OFF_GBG);
    half_t* RW = (half_t*)(p.ws + OFF_RW); half_t* RLI = (half_t*)(p.ws + OFF_RLI);
    for (int r = blockIdx.x * 8 + wid; r < RG; r += gridDim.x * 8) {
        const RowGeo q = row_geo(r);
        float acc[3][8];
#pragma unroll
        for (int j = 0; j < 3; ++j)
#pragma unroll
            for (int e = 0; e < 8; ++e) acc[j][e] = 0.f;
        for (int kh = 0; kh < 3; ++kh) { const int nr = q.gr + kh - 1; if (nr < 0 || nr >= q.gh) continue;
            for (int kw = 0; kw < 3; ++kw) { const int nc = q.gc + kw - 1; if (nc < 0 || nc >= q.gw) continue;
                const size_t nrow = (size_t)(q.base + nr * q.gw + nc);
#pragma unroll
                for (int j = 0; j < 3; ++j) { const half8 pv = *(const half8*)(P + nrow * NP + j * 512 + 8 * lane); const LAS float* w = cw + (kh * 3 + kw) * 1536 + j * 512 + 8 * lane;
#pragma unroll
                    for (int e = 0; e < 8; ++e) acc[j][e] += (float)pv[e] * w[e]; } } }
#pragma unroll
        for (int j = 0; j < 3; ++j) {
            float ss = 0.f;
#pragma unroll
            for (int e = 0; e < 8; ++e) { acc[j][e] = siluf(acc[j][e]); ss += acc[j][e] * acc[j][e]; }
            float sc = 1.f;
            if (j < 2) { ss += SHFL_XOR(ss, 1); ss += SHFL_XOR(ss, 2); ss += SHFL_XOR(ss, 4); ss += SHFL_XOR(ss, 8); sc = frsq(ss + 1e-6f) * (j == 0 ? 0.08838834764831845f : 1.f); }
            half8 h;
#pragma unroll
            for (int e = 0; e < 8; ++e) h[e] = (half_t)(acc[j][e] * sc);
            *(half8*)(GQKV + (size_t)r * 1536 + j * 512 + 8 * lane) = h;
        }
        if (lane < 16) { const float x = (float)P[(size_t)r * NP + C_BG + lane];
            float o; if (lane < 8) o = sigm(x); else { const int idx = lane - 8; o = -fexp(p.in[I_GALOG][l * 8 + idx]) * softplusf(x + p.in[I_GDTB][l * 8 + idx]); }
            GBG[(size_t)r * 16 + lane] = o; }
        const int nb[4] = { q.gc > 0 ? r - 1 : -1, q.gc < q.gw - 1 ? r + 1 : -1, q.gr > 0 ? r - q.gw : -1, q.gr < q.gh - 1 ? r + q.gw : -1 };
        const float* mu = p.in[I_RMU] + (size_t)l * 1920;
        float kmix[8];
#pragma unroll
        for (int j = 0; j < 4; ++j) {
            if (j == 3 && lane >= 48) break;
            const int cj = j < 3 ? j * 512 + 8 * lane : 1536 + 8 * lane;
            const half8 self = *(const half8*)(P + (size_t)r * NP + C_RWKV + cj);
            half8 nv[4];
#pragma unroll
            for (int d = 0; d < 4; ++d) { if (nb[d] >= 0) nv[d] = *(const half8*)(P + (size_t)nb[d] * NP + C_RWKV + cj); else nv[d] = (half8){0, 0, 0, 0, 0, 0, 0, 0}; }
            float val[8];
#pragma unroll
            for (int e = 0; e < 8; ++e) { const float s = (float)self[e], nn = (float)nv[e & 3][e]; val[e] = s + (nn - s) * mu[cj + e]; }
            half8 h;
            if (j < 3) {
#pragma unroll
                for (int e = 0; e < 8; ++e) h[e] = (half_t)val[e];
                *(half8*)(RW + ((size_t)r * 4 + j) * 512 + 8 * lane) = h;
                if (j == 1) {
#pragma unroll
                    for (int e = 0; e < 8; ++e) kmix[e] = val[e]; }
            } else {
                const int c0 = 8 * lane;
#pragma unroll
                for (int e = 0; e < 8; ++e) { float v = val[e]; if (c0 < 128) v = ftanh(v); else if (c0 >= 256) v = sigm(v); h[e] = (half_t)v; }
                *(half8*)(RLI + (size_t)r * 384 + c0) = h;
            }
        }
        { float t[8], ss = 0.f; const float* kkw = p.in[I_RKK] + (size_t)l * 512 + 8 * lane;
#pragma unroll
          for (int e = 0; e < 8; ++e) { t[e] = kmix[e] * kkw[e]; ss += t[e] * t[e]; }
          ss += SHFL_XOR(ss, 1); ss += SHFL_XOR(ss, 2); ss += SHFL_XOR(ss, 4);
          const float sc = frsq(ss + 1e-6f); half8 h;
#pragma unroll
          for (int e = 0; e < 8; ++e) h[e] = (half_t)(t[e] * sc);
          *(half8*)(RW + ((size_t)r * 4 + 3) * 512 + 8 * lane) = h; }
    }
}

__device__ __forceinline__ void ph_wy(int wb, const Params& p, LAS unsigned char* lds) {
    const int tid = tid_fresh(wb);
    LAS half_t* kh = (LAS half_t*)lds;
    LAS half_t* qh = kh + 64 * 136;
    LAS float* KK = (LAS float*)(qh + 64 * 136);
    LAS float* QK = KK + 64 * 65;
    LAS float* Lm = QK + 64 * 65;
    LAS float* Xs = Lm + 2 * 64 * 65;
    LAS float* Gs = Xs + 2 * 64 * 65;
    LAS float* Bs = Gs + 128;
    const half_t* GQKV = (const half_t*)(p.ws + OFF_GQKV); const float* GBG = (const float*)(p.ws + OFF_GBG);
    half_t* GTA = (half_t*)(p.ws + OFF_GTA); float* GG = (float*)(p.ws + OFF_GG);
    for (int item = blockIdx.x; item < (RG / 64) * 4; item += gridDim.x) {
        const int cidx = item >> 2, h = item & 3, r0 = cidx * 64;
        for (int v = tid; v < 1024; v += NT) { const int row = v >> 4, c8 = (v & 15) * 8;
            *(LAS half8*)(kh + row * 136 + c8) = *(const half8*)(GQKV + (size_t)(r0 + row) * 1536 + 512 + h * 128 + c8);
            *(LAS half8*)(qh + row * 136 + c8) = *(const half8*)(GQKV + (size_t)(r0 + row) * 1536 + h * 128 + c8); }
        if (tid < 128) { const int d = tid >> 6, i = tid & 63, nat = d ? 63 - i : i;
            Bs[d * 64 + i] = GBG[(size_t)(r0 + nat) * 16 + d * 4 + h]; Gs[d * 64 + i] = GBG[(size_t)(r0 + nat) * 16 + 8 + d * 4 + h]; }
        SYNC();
        if (tid == 0 || tid == 64) { const int d = tid >> 6; float c = 0.f; for (int i = 0; i < 64; ++i) { c += Gs[d * 64 + i]; Gs[d * 64 + i] = c; } }
        { const int i = tid >> 3, j0 = (tid & 7) * 8; float kk[8], qk[8];
#pragma unroll
          for (int jj = 0; jj < 8; ++jj) { kk[jj] = 0.f; qk[jj] = 0.f; }
          for (int c = 0; c < 128; ++c) { const float ki = (float)kh[i * 136 + c], qi = (float)qh[i * 136 + c];
#pragma unroll
              for (int jj = 0; jj < 8; ++jj) { const float kj = (float)kh[(j0 + jj) * 136 + c]; kk[jj] += ki * kj; qk[jj] += qi * kj; } }
#pragma unroll
          for (int jj = 0; jj < 8; ++jj) { KK[i * 65 + j0 + jj] = kk[jj]; QK[i * 65 + j0 + jj] = qk[jj]; } }
        SYNC();
#pragma unroll 1
        for (int t = 0; t < 16; ++t) { const int idx = tid + NT * t, d = idx >> 12, i = (idx >> 6) & 63, j = idx & 63;
            const int ni = d ? 63 - i : i, nj = d ? 63 - j : j;
            Lm[d * 4160 + i * 65 + j] = (j < i) ? Bs[d * 64 + i] * KK[ni * 65 + nj] * fexp(Gs[d * 64 + i] - Gs[d * 64 + j]) : 0.f; }
        SYNC();
        if (tid < 128) { const int d = tid >> 6, j = tid & 63; const LAS float* L = Lm + d * 4160; LAS float* X = Xs + d * 4160;
#pragma unroll 1
            for (int bi = 0; bi < 4; ++bi) {
                const LAS float* Lb = L + bi * 16 * 65; float a[16];
#pragma unroll
                for (int ii = 0; ii < 16; ++ii) a[ii] = (bi * 16 + ii == j) ? 1.f : 0.f;
                for (int m = 0; m < bi * 16; ++m) { const float xm = X[m * 65 + j];
#pragma unroll
                    for (int ii = 0; ii < 16; ++ii) a[ii] -= Lb[ii * 65 + m] * xm; }
#pragma unroll
                for (int ii = 0; ii < 16; ++ii) { float sacc = a[ii];
#pragma unroll
                    for (int mm = 0; mm < ii; ++mm) sacc -= Lb[ii * 65 + bi * 16 + mm] * a[mm];
                    a[ii] = sacc; }
#pragma unroll
                for (int ii = 0; ii < 16; ++ii) X[(bi * 16 + ii) * 65 + j] = a[ii];
            } }
        SYNC();
#pragma unroll 1
        for (int t = 0; t < 4; ++t) { const int v = tid + NT * t, mat = v >> 9, w = v & 511, i = w >> 3, j8 = (w & 7) * 8, d = mat >> 1, which = mat & 1;
            half8 o;
#pragma unroll
            for (int e = 0; e < 8; ++e) { const int j = j8 + e; float val;
                if (which == 0) val = Xs[d * 4160 + i * 65 + j] * Bs[d * 64 + j];
                else { const int ni = d ? 63 - i : i, nj = d ? 63 - j : j; val = (j <= i) ? QK[ni * 65 + nj] * fexp(Gs[d * 64 + i] - Gs[d * 64 + j]) : 0.f; }
                o[e] = (half_t)val; }
            *(half8*)(GTA + ((size_t)((cidx * 4 + h) * 2 + d) * 2 + which) * 4096 + i * 64 + j8) = o; }
        if (tid < 128) GG[(size_t)((cidx * 4 + h) * 2 + (tid >> 6)) * 64 + (tid & 63)] = Gs[tid];
        SYNC();
    }
}

#ifndef CPU_EMU
#define MFMA16(a, b, c) __builtin_amdgcn_mfma_f32_16x16x32_f16((a), (b), (c), 0, 0, 0)
#else
#define MFMA16(a, b, c) emu_mfma16((a), (b), (c))
#endif
__device__ __forceinline__ half8 ldfrag(const LAS half_t* base, int row0, int ld, int k0, int lane) { return *(const LAS half8*)(base + (row0 + (lane & 15)) * ld + k0 + 8 * (lane >> 4)); }
__device__ __forceinline__ half4 cvt4(f32x4 v) { half4 o; o[0] = (half_t)v[0]; o[1] = (half_t)v[1]; o[2] = (half_t)v[2]; o[3] = (half_t)v[3]; return o; }

__device__ __forceinline__ void scan_gdn(int wb, const Params& p, int item, LAS unsigned char* lds) {
    const int tid = tid_fresh(wb), wid = tid >> 6, lane = tid & 63, fr = lane & 15, fq = lane >> 4;
    const int d = item & 1, h = (item >> 1) & 3, bl = item >> 3;
    constexpr int L72 = 72, L136 = 136;
    LAS half_t* kT = (LAS half_t*)lds;
    LAS half_t* vT = kT + 128 * L72;
    LAS half_t* VNs = vT + 128 * L72;
    LAS half_t* Tb = VNs + 128 * L72;
    LAS half_t* Tbe = Tb + 64 * L72;
    LAS half_t* Am = Tbe + 64 * L72;
    LAS half_t* Qg = Am + 64 * L72;
    LAS half_t* Wn = Qg + 64 * L136;
    LAS half_t* ST = Wn + 64 * L136;
    LAS float* Es = (LAS float*)(ST + 128 * L136);
    const half_t* GQKV = (const half_t*)(p.ws + OFF_GQKV);
    const half_t* GTA = (const half_t*)(p.ws + OFF_GTA); const float* GG = (const float*)(p.ws + OFF_GG);
    half_t* SOG = (half_t*)(p.ws + OFF_SOG) + (size_t)d * RGP * 512;
    SYNC();
    for (int i = tid; i < 128 * L136 / 8; i += NT) *(LAS half8*)(ST + i * 8) = (half8){0, 0, 0, 0, 0, 0, 0, 0};
    f32x4 accS[8];
#pragma unroll
    for (int u = 0; u < 8; ++u) accS[u] = (f32x4){0.f, 0.f, 0.f, 0.f};
    constexpr int nchC = CTXL / 64, nchL = SEQ / 64, NCS = nchC + nchL;
    half8 pT, pA, pq[2], pk[2], pv[2]; f32x4 pg0, pg1; float pgi[2], pG = 0.f, pGl = 0.f; int nr0 = 0, cr0 = 0;
    const int ti = tid >> 3, tj8 = (tid & 7) * 8;
    auto issue = [&](int cs) {
        const bool isc = cs < nchC; const int cl = isc ? cs : cs - nchC, nch = isc ? nchC : nchL, cn = d ? nch - 1 - cl : cl;
        const int r0 = (isc ? RL + bl * CTXL : bl * SEQ) + cn * 64; nr0 = r0;
        const size_t tb = (size_t)(((r0 >> 6) * 4 + h) * 2 + d);
        pT = *(const half8*)(GTA + (tb * 2 + 0) * 4096 + ti * 64 + tj8); pA = *(const half8*)(GTA + (tb * 2 + 1) * 4096 + ti * 64 + tj8);
        pg0 = *(const f32x4*)(GG + tb * 64 + tj8); pg1 = *(const f32x4*)(GG + tb * 64 + tj8 + 4);
#pragma unroll
        for (int t = 0; t < 2; ++t) { const int v = tid + NT * t, i = v >> 4, c8 = (v & 15) * 8, nat = d ? 63 - i : i;
            pq[t] = *(const half8*)(GQKV + (size_t)(r0 + nat) * 1536 + h * 128 + c8); pgi[t] = GG[tb * 64 + i]; }
#pragma unroll
        for (int t = 0; t < 2; ++t) { const int g = wid + 8 * t, nat = d ? 63 - lane : lane;
            pk[t] = *(const half8*)(GQKV + (size_t)(r0 + nat) * 1536 + 512 + h * 128 + 8 * g); pv[t] = *(const half8*)(GQKV + (size_t)(r0 + nat) * 1536 + 1024 + h * 128 + 8 * g); }
        pG = GG[tb * 64 + (tid & 63)]; pGl = GG[tb * 64 + 63];
    };
    issue(0);
    for (int cs = 0; cs < NCS; ++cs) {
        SYNC();
        { half8 te; const float ge[8] = {pg0[0], pg0[1], pg0[2], pg0[3], pg1[0], pg1[1], pg1[2], pg1[3]};
#pragma unroll
          for (int e = 0; e < 8; ++e) te[e] = (half_t)((float)pT[e] * fexp(ge[e]));
          *(LAS half8*)(Tb + ti * L72 + tj8) = pT; *(LAS half8*)(Tbe + ti * L72 + tj8) = te; *(LAS half8*)(Am + ti * L72 + tj8) = pA; }
#pragma unroll
        for (int t = 0; t < 2; ++t) { const int v = tid + NT * t, i = v >> 4, c8 = (v & 15) * 8; const float sc = fexp(pgi[t]); half8 o;
#pragma unroll
            for (int e = 0; e < 8; ++e) o[e] = (half_t)((float)pq[t][e] * sc);
            *(LAS half8*)(Qg + i * L136 + c8) = o; }
#pragma unroll
        for (int t = 0; t < 2; ++t) { const int g = wid + 8 * t;
#pragma unroll
            for (int e = 0; e < 8; ++e) { kT[(8 * g + e) * L72 + lane] = pk[t][e]; vT[(8 * g + e) * L72 + lane] = pv[t][e]; } }
        if (tid < 64) Es[tid] = fexp(pGl - pG);
        const float dec = fexp(pGl);
        cr0 = nr0;
        if (cs + 1 < NCS) issue(cs + 1);
        SYNC();
        { f32x4 acc[4];
#pragma unroll
          for (int t = 0; t < 4; ++t) acc[t] = (f32x4){0.f, 0.f, 0.f, 0.f};
#pragma unroll
          for (int k2 = 0; k2 < 2; ++k2) { const half8 a = ldfrag(kT, 16 * wid, L72, 32 * k2, lane);
#pragma unroll
              for (int t = 0; t < 4; ++t) acc[t] = MFMA16(a, ldfrag(Tbe, 16 * t, L72, 32 * k2, lane), acc[t]); }
#pragma unroll
          for (int t = 0; t < 4; ++t) *(LAS half4*)(Wn + (16 * t + fr) * L136 + 16 * wid + 4 * fq) = cvt4(-acc[t]); }
        SYNC();
        { f32x4 acc[4];
#pragma unroll
          for (int t = 0; t < 4; ++t) acc[t] = (f32x4){0.f, 0.f, 0.f, 0.f};
#pragma unroll
          for (int k2 = 0; k2 < 2; ++k2) { const half8 b = ldfrag(vT, 16 * wid, L72, 32 * k2, lane);
#pragma unroll
              for (int t = 0; t < 4; ++t) acc[t] = MFMA16(ldfrag(Tb, 16 * t, L72, 32 * k2, lane), b, acc[t]); }
#pragma unroll
          for (int k4 = 0; k4 < 4; ++k4) { const half8 b = ldfrag(ST, 16 * wid, L136, 32 * k4, lane);
#pragma unroll
              for (int t = 0; t < 4; ++t) acc[t] = MFMA16(ldfrag(Wn, 16 * t, L136, 32 * k4, lane), b, acc[t]); }
          WAVE_SYNC();
#pragma unroll
          for (int t = 0; t < 4; ++t) { const f32x4 es = *(const LAS f32x4*)(Es + 16 * t + 4 * fq);
              *(LAS half4*)(vT + (16 * wid + fr) * L72 + 16 * t + 4 * fq) = cvt4(acc[t]); *(LAS half4*)(VNs + (16 * wid + fr) * L72 + 16 * t + 4 * fq) = cvt4(acc[t] * es); } }
        WAVE_SYNC();
        { f32x4 acc[4];
#pragma unroll
          for (int t = 0; t < 4; ++t) acc[t] = (f32x4){0.f, 0.f, 0.f, 0.f};
#pragma unroll
          for (int k4 = 0; k4 < 4; ++k4) { const half8 a = ldfrag(ST, 16 * wid, L136, 32 * k4, lane);
#pragma unroll
              for (int t = 0; t < 4; ++t) acc[t] = MFMA16(a, ldfrag(Qg, 16 * t, L136, 32 * k4, lane), acc[t]); }
#pragma unroll
          for (int k2 = 0; k2 < 2; ++k2) { const half8 a = ldfrag(vT, 16 * wid, L72, 32 * k2, lane);
#pragma unroll
              for (int t = 0; t < 4; ++t) acc[t] = MFMA16(a, ldfrag(Am, 16 * t, L72, 32 * k2, lane), acc[t]); }
#pragma unroll
          for (int t = 0; t < 4; ++t) { const int i = 16 * t + fr, nat = d ? 63 - i : i;
              *(half4*)(SOG + (size_t)(cr0 + nat) * 512 + h * 128 + 16 * wid + 4 * fq) = cvt4(acc[t]); } }
#pragma unroll
        for (int u = 0; u < 8; ++u) accS[u] = accS[u] * dec;
#pragma unroll
        for (int k2 = 0; k2 < 2; ++k2) { const half8 b = ldfrag(VNs, 16 * wid, L72, 32 * k2, lane);
#pragma unroll
            for (int u = 0; u < 8; ++u) accS[u] = MFMA16(ldfrag(kT, 16 * u, L72, 32 * k2, lane), b, accS[u]); }
        WAVE_SYNC();
#pragma unroll
        for (int u = 0; u < 8; ++u) *(LAS half4*)(ST + (16 * wid + fr) * L136 + 16 * u + 4 * fq) = cvt4(accS[u]);
        WAVE_SYNC();
    }
}

#ifndef CPU_EMU
__device__ __forceinline__ float shfl_up_f(float v, int off, int lane) { const float o = __int_as_float(__builtin_amdgcn_ds_bpermute(((lane - off) & 63) << 2, __float_as_int(v))); return lane >= off ? o : v; }
#else
static inline float shfl_up_f(float v, int off, int lane) { const float o = emu_shfl(v, (lane - off) & 63); return lane >= off ? o : v; }
#endif
__device__ __forceinline__ void scan_mlstm(int wb, const Params& p, int l, int item, LAS unsigned char* lds) {
    const int tid = tid_fresh(wb), wid = tid >> 6, lane = tid & 63, fr = lane & 15, fq = lane >> 4;
    const int d = item & 1, h = (item >> 1) & 3, bl = item >> 3;
    constexpr int L72 = 72;
    LAS half_t* q = (LAS half_t*)lds;
    LAS half_t* k = q + 64 * L72;
    LAS half_t* kT = k + 64 * L72;
    LAS half_t* vT = kT + 64 * L72;
    LAS half_t* Pm = vT + 128 * L72;
    LAS half_t* CT = Pm + 64 * L72;
    LAS half_t* nvec = CT + 128 * L72 + 64 * wid;
    LAS float* lfv = (LAS float*)(CT + 128 * L72 + 64 * 8);
    LAS float* igv = lfv + 64;
    LAS float* rowv = igv + 64;
    LAS float* colv = rowv + 64;
    LAS float* interv = colv + 64;
    LAS float* emtv = interv + 64;
    LAS float* wscv = emtv + 64;
    const half_t* P = (const half_t*)(p.ws + OFF_P);
    half_t* SOM = (half_t*)(p.ws + OFF_SOM) + (size_t)d * RGP * 512;
    const float ibias = p.in[I_MIB][l * 8 + d * 4 + h], fbias = p.in[I_MFB][l * 8 + d * 4 + h];
    SYNC();
    for (int i = tid; i < 128 * L72 / 8; i += NT) *(LAS half8*)(CT + i * 8) = (half8){0, 0, 0, 0, 0, 0, 0, 0};
    nvec[lane] = (half_t)0.f;
    f32x4 accC[4], accN[4];
#pragma unroll
    for (int u = 0; u < 4; ++u) { accC[u] = (f32x4){0.f, 0.f, 0.f, 0.f}; accN[u] = (f32x4){0.f, 0.f, 0.f, 0.f}; }
    float m = 0.f;
    constexpr int nchC = CTXL / 64, nchL = SEQ / 64, NCS = nchC + nchL;
    half8 pq, pk, pv[2]; half_t pig = (half_t)0.f, pfg = (half_t)0.f; int nr0 = 0, cr0 = 0;
    const half8 ones = {1, 1, 1, 1, 1, 1, 1, 1};
    auto issue = [&](int cs) {
        const bool isc = cs < nchC; const int cl = isc ? cs : cs - nchC, nch = isc ? nchC : nchL, cn = d ? nch - 1 - cl : cl;
        const int r0 = (isc ? RL + bl * CTXL : bl * SEQ) + cn * 64; nr0 = r0;
        const int nat = d ? 63 - lane : lane; const half_t* pr = P + (size_t)(r0 + nat) * NP + C_ML;
        pq = *(const half8*)(pr + h * 64 + 8 * wid); pk = *(const half8*)(pr + 256 + h * 64 + 8 * wid);
        pv[0] = *(const half8*)(pr + 512 + h * 128 + 8 * wid); pv[1] = *(const half8*)(pr + 512 + h * 128 + 8 * (wid + 8));
        if (tid < 64) { const half_t* pg = P + (size_t)(r0 + (d ? 63 - tid : tid)) * NP; pig = pg[C_MLIG + d * 4 + h]; pfg = pg[C_MLFG + d * 4 + h]; }
    };
    issue(0);
    for (int cs = 0; cs < NCS; ++cs) {
        SYNC();
        { half8 qs;
#pragma unroll
          for (int e = 0; e < 8; ++e) qs[e] = (half_t)((float)pq[e] * 0.125f);
          *(LAS half8*)(q + lane * L72 + 8 * wid) = qs; *(LAS half8*)(k + lane * L72 + 8 * wid) = pk;
#pragma unroll
          for (int e = 0; e < 8; ++e) { kT[(8 * wid + e) * L72 + lane] = pk[e]; vT[(8 * wid + e) * L72 + lane] = pv[0][e]; vT[(8 * (wid + 8) + e) * L72 + lane] = pv[1][e]; } }
        if (tid < 64) { igv[tid] = (float)pig + ibias; lfv[tid] = -softplusf(-((float)pfg + fbias)); }
        cr0 = nr0;
        if (cs + 1 < NCS) issue(cs + 1);
        SYNC();
        float dec;
        { float b = lfv[lane];
#pragma unroll
          for (int off = 1; off < 64; off <<= 1) { const float o = shfl_up_f(b, off, lane); b = lane >= off ? b + o : b; }
          const float cm = igv[lane] - b; float pm = cm;
#pragma unroll
          for (int off = 1; off < 64; off <<= 1) { const float o = shfl_up_f(pm, off, lane); pm = lane >= off ? fmaxf(pm, o) : pm; }
#ifndef CPU_EMU
          const float b_last = __int_as_float(__builtin_amdgcn_readlane(__float_as_int(b), 63)), pm_last = __int_as_float(__builtin_amdgcn_readlane(__float_as_int(pm), 63));
#else
          const float b_last = emu_shfl(b, 63), pm_last = emu_shfl(pm, 63);
#endif
          const float mt = fmaxf(b + m, b + pm), m_new = fmaxf(b_last + m, b_last + pm_last);
          rowv[lane] = b - mt; colv[lane] = cm; interv[lane] = fexp(b + m - mt); emtv[lane] = fexp(-mt); wscv[lane] = fexp(b_last + cm - m_new);
          dec = fexp(b_last + m - m_new); m = m_new; }
        WAVE_SYNC();
#pragma unroll
        for (int tt = 0; tt < 2; ++tt) { const int idx = 2 * wid + tt, ti = idx >> 2, tj = idx & 3;
            f32x4 acc = {0.f, 0.f, 0.f, 0.f};
            if (tj <= ti) {
#pragma unroll
                for (int k2 = 0; k2 < 2; ++k2) acc = MFMA16(ldfrag(k, 16 * tj, L72, 32 * k2, lane), ldfrag(q, 16 * ti, L72, 32 * k2, lane), acc);
                const int i = 16 * ti + fr; const float rv = rowv[i]; const f32x4 cv = *(const LAS f32x4*)(colv + 16 * tj + 4 * fq);
#pragma unroll
                for (int e = 0; e < 4; ++e) { const int j = 16 * tj + 4 * fq + e; acc[e] = (j <= i) ? acc[e] * fexp(rv + cv[e]) : 0.f; }
            }
            *(LAS half4*)(Pm + (16 * ti + fr) * L72 + 16 * tj + 4 * fq) = cvt4(acc); }
        SYNC();
        { f32x4 a1[4], a2[4], d1[4], d2[4];
#pragma unroll
          for (int t = 0; t < 4; ++t) { a1[t] = (f32x4){0.f, 0.f, 0.f, 0.f}; a2[t] = a1[t]; d1[t] = a1[t]; d2[t] = a1[t]; }
#pragma unroll
          for (int k2 = 0; k2 < 2; ++k2) { const half8 ac = ldfrag(CT, 16 * wid, L72, 32 * k2, lane), av = ldfrag(vT, 16 * wid, L72, 32 * k2, lane);
              const half8 an = *(const LAS half8*)(nvec + 32 * k2 + 8 * fq);
#pragma unroll
              for (int t = 0; t < 4; ++t) { const half8 bq = ldfrag(q, 16 * t, L72, 32 * k2, lane), bp = ldfrag(Pm, 16 * t, L72, 32 * k2, lane);
                  a1[t] = MFMA16(ac, bq, a1[t]); a2[t] = MFMA16(av, bp, a2[t]); d1[t] = MFMA16(an, bq, d1[t]); d2[t] = MFMA16(ones, bp, d2[t]); } }
#pragma unroll
          for (int t = 0; t < 4; ++t) { const int i = 16 * t + fr, nat = d ? 63 - i : i; const float it = interv[i];
              const float den = it * d1[t][0] + d2[t][0], dn = frcp(fmaxf(fabsf(den), emtv[i]));
              *(half4*)(SOM + (size_t)(cr0 + nat) * 512 + h * 128 + 16 * wid + 4 * fq) = cvt4((a1[t] * it + a2[t]) * dn); } }
#pragma unroll
        for (int u = 0; u < 4; ++u) { accC[u] = accC[u] * dec; accN[u] = accN[u] * dec; }
#pragma unroll
        for (int k2 = 0; k2 < 2; ++k2) { const half8 bv = ldfrag(vT, 16 * wid, L72, 32 * k2, lane);
            const f32x4 w0 = *(const LAS f32x4*)(wscv + 32 * k2 + 8 * fq), w1 = *(const LAS f32x4*)(wscv + 32 * k2 + 8 * fq + 4);
#pragma unroll
            for (int u = 0; u < 4; ++u) { const half8 raw = ldfrag(kT, 16 * u, L72, 32 * k2, lane); half8 ak;
#pragma unroll
                for (int e = 0; e < 4; ++e) { ak[e] = (half_t)((float)raw[e] * w0[e]); ak[4 + e] = (half_t)((float)raw[4 + e] * w1[e]); }
                accC[u] = MFMA16(ak, bv, accC[u]); accN[u] = MFMA16(ak, ones, accN[u]); } }
        WAVE_SYNC();
#pragma unroll
        for (int u = 0; u < 4; ++u) { *(LAS half4*)(CT + (16 * wid + fr) * L72 + 16 * u + 4 * fq) = cvt4(accC[u]);
            if (fr == 0) *(LAS half4*)(nvec + 16 * u + 4 * fq) = cvt4(accN[u]); }
        WAVE_SYNC();
    }
}

#ifndef CPU_EMU
template <int CTRL> __device__ __forceinline__ float dpp_f(float v) { return __int_as_float(__builtin_amdgcn_update_dpp(0, __float_as_int(v), CTRL, 0xf, 0xf, true)); }
#define RED8(v) do { v += dpp_f<0xB1>(v); v += dpp_f<0x4E>(v); v += dpp_f<0x141>(v); } while (0)
#define RED16(v) do { RED8(v); v += dpp_f<0x140>(v); } while (0)
#else
#define RED8(v) do { v += emu_shfl_xor(v, 1); v += emu_shfl_xor(v, 2); v += emu_shfl_xor(v, 7); } while (0)
#define RED16(v) do { RED8(v); v += emu_shfl_xor(v, 15); } while (0)
#endif
__device__ __forceinline__ void scan_rwkv(int wb, const Params& p, int l, int item, LAS unsigned char* lds) {
#ifndef CPU_EMU
    const int tid = tid_fresh(wb), wid = __builtin_amdgcn_readfirstlane(tid >> 6), lane = tid & 63;
#else
    const int tid = tid_fresh(wb), wid = tid >> 6, lane = tid & 63;
#endif
    const int half = item & 1, d = (item >> 1) & 1, h = (item >> 2) & 7, bl = item >> 5;
    constexpr int NB = 16, REC = 388;
    LAS float* st = (LAS float*)lds;
    const half_t* RW = (const half_t*)(p.ws + OFF_RW); const half_t* RLO = (const half_t*)(p.ws + OFF_RLO);
    float* SOR = (float*)(p.ws + OFF_SOR) + (size_t)d * RGP * 512;
    constexpr int NSTEP = CTXL + SEQ, NBATCH = NSTEP / NB;
    auto step_row = [&](int sidx) -> size_t { return sidx < CTXL ? (size_t)(RL + bl * CTXL + (d ? CTXL - 1 - sidx : sidx)) : (size_t)(bl * SEQ + (d ? SEQ - 1 - (sidx - CTXL) : sidx - CTXL)); };
    SYNC();
    if (wid >= 4) {
        const int pt = tid - 256, lt = pt >> 4, cq = pt & 15, lc = h * 64 + 4 * cq;
        const f32x4 ka = *(const f32x4*)(p.in[I_RKA] + (size_t)l * 512 + lc);
        half4 g_r, g_k, g_v, g_kk, g_e, g_a;
        auto issue = [&](int n) { const size_t row = step_row(n * NB + lt);
            g_r = *(const half4*)(RW + (row * 4 + 0) * 512 + lc); g_k = *(const half4*)(RW + (row * 4 + 1) * 512 + lc); g_v = *(const half4*)(RW + (row * 4 + 2) * 512 + lc); g_kk = *(const half4*)(RW + (row * 4 + 3) * 512 + lc);
            g_e = *(const half4*)(RLO + row * 2560 + d * 512 + lc); g_a = *(const half4*)(RLO + row * 2560 + 1024 + d * 512 + lc); };
        auto stage = [&](int buf) { LAS float* o = st + (buf * NB + lt) * REC + 4 * cq; float br = 0.f, kr = 0.f; f32x4 oa, owr, ow, ob, okd, ov;
#pragma unroll
            for (int e = 0; e < 4; ++e) { const float r_ = (float)g_r[e], k_ = (float)g_k[e], kk = (float)g_kk[e], a_ = (float)g_a[e];
                const float w_ = fexp(-(float)g_e[e]), kd = k_ * (1.f + (a_ - 1.f) * ka[e]), b_ = kk * a_;
                oa[e] = -kk; owr[e] = w_ * r_; ow[e] = w_; ob[e] = b_; okd[e] = kd; ov[e] = (float)g_v[e]; br += b_ * r_; kr += kd * r_; }
            *(LAS f32x4*)(o) = oa; *(LAS f32x4*)(o + 64) = owr; *(LAS f32x4*)(o + 128) = ow; *(LAS f32x4*)(o + 192) = ob; *(LAS f32x4*)(o + 256) = okd; *(LAS f32x4*)(o + 320) = ov;
            RED16(br); RED16(kr);
            if (cq == 0) { LAS float* sc = st + (buf * NB + lt) * REC + 384; sc[0] = br; sc[1] = kr; } };
        issue(0); stage(0);
        if (NBATCH > 1) issue(1);
        SYNC();
        for (int n = 0; n < NBATCH; ++n) {
            if (n + 1 < NBATCH) { stage((n + 1) & 1); if (n + 2 < NBATCH) issue(n + 2); }
            SYNC();
        }
    } else {
        const int rr = 32 * half + 8 * wid + (lane >> 3), ks = lane & 7;
        f32x2 s2[4];
#pragma unroll
        for (int e = 0; e < 4; ++e) s2[e] = (f32x2){0.f, 0.f};
        SYNC();
        for (int n = 0; n < NBATCH; ++n) {
            const int buf = n & 1;
            float ysel = 0.f;
#pragma unroll 1
            for (int th = 0; th < NB / 4; ++th) {
                const int ksl = ks - 4 * (th & 1);
                f32x4 a0, a1, q0, q1, w0, w1, b0, b1, k0, k1; f32x2 sc; float vv;
#define RWKV_LOAD(T_) do { const LAS float* o = st + (buf * NB + (T_)) * REC; \
                a0 = *(const LAS f32x4*)(o + 8 * ks); a1 = *(const LAS f32x4*)(o + 8 * ks + 4); q0 = *(const LAS f32x4*)(o + 64 + 8 * ks); q1 = *(const LAS f32x4*)(o + 64 + 8 * ks + 4); \
                w0 = *(const LAS f32x4*)(o + 128 + 8 * ks); w1 = *(const LAS f32x4*)(o + 128 + 8 * ks + 4); b0 = *(const LAS f32x4*)(o + 192 + 8 * ks); b1 = *(const LAS f32x4*)(o + 192 + 8 * ks + 4); \
                k0 = *(const LAS f32x4*)(o + 256 + 8 * ks); k1 = *(const LAS f32x4*)(o + 256 + 8 * ks + 4); vv = o[320 + rr]; sc = *(const LAS f32x2*)(o + 384); } while (0)
#define LO2(v) __builtin_shufflevector(v, v, 0, 1)
#define HI2(v) __builtin_shufflevector(v, v, 2, 3)
                RWKV_LOAD(th * 4);
#pragma unroll
                for (int ti = 0; ti < 4; ++ti) {
                    const f32x4 ca0 = a0, ca1 = a1, cq0 = q0, cq1 = q1, cw0 = w0, cw1 = w1, cb0 = b0, cb1 = b1, ck0 = k0, ck1 = k1; const f32x2 csc = sc; const float cvv = vv;
                    if (ti < 3) RWKV_LOAD(th * 4 + ti + 1);
                    const f32x2 sa2 = s2[0] * LO2(ca0) + s2[1] * HI2(ca0) + s2[2] * LO2(ca1) + s2[3] * HI2(ca1);
                    const f32x2 yw2 = s2[0] * LO2(cq0) + s2[1] * HI2(cq0) + s2[2] * LO2(cq1) + s2[3] * HI2(cq1);
                    float sa = sa2[0] + sa2[1], yw = yw2[0] + yw2[1];
                    RED8(sa); RED8(yw);
                    const f32x2 sav = {sa, sa}, vvv = {cvv, cvv};
                    s2[0] = s2[0] * LO2(cw0) + (sav * LO2(cb0) + vvv * LO2(ck0)); s2[1] = s2[1] * HI2(cw0) + (sav * HI2(cb0) + vvv * HI2(ck0));
                    s2[2] = s2[2] * LO2(cw1) + (sav * LO2(cb1) + vvv * LO2(ck1)); s2[3] = s2[3] * HI2(cw1) + (sav * HI2(cb1) + vvv * HI2(ck1));
                    const float y = yw + sa * csc[0] + cvv * csc[1];
                    ysel = (ksl == ti) ? y : ysel;
#ifndef CPU_EMU
                    asm volatile("" ::: "memory");
#endif
                }
#undef RWKV_LOAD
#undef LO2
#undef HI2
                if (th & 1) SOR[step_row(n * NB + (th >> 1) * 8 + ks) * 512 + h * 64 + rr] = ysel;
            }
            SYNC();
        }
    }
}

__device__ __forceinline__ void ph_scan(int wb, const Params& p, int l, LAS unsigned char* lds) {
    constexpr int N_R = BG * 32, N_G = BG * 8, N_M = BG * 8;
    const int G = gridDim.x, c = blockIdx.x;
    if (!(SKIP_MASK & 65536)) for (int item = c; item < N_R; item += G) REPS(65536) { scan_rwkv(wb, p, l, item, lds); SYNC(); }
    if (!(SKIP_MASK & 131072)) for (int item = N_R + (((c - N_R) % G) + G) % G; item < N_R + N_G; item += G) REPS(131072) { scan_gdn(wb, p, item - N_R, lds); SYNC(); }
    if (!(SKIP_MASK & 262144)) for (int item = N_R + N_G + (((c - N_R - N_G) % G) + G) % G; item < N_R + N_G + N_M; item += G) REPS(262144) { scan_mlstm(wb, p, l, item - N_R - N_G, lds); SYNC(); }
}

__device__ __forceinline__ void ph_finish(int wb, const Params& p, int l, int nrows) {
    const int tid = tid_fresh(wb), wid = tid >> 6, lane = tid & 63, c = 8 * lane;
    const half_t* P = (const half_t*)(p.ws + OFF_P); const half_t* RW = (const half_t*)(p.ws + OFF_RW); const half_t* RLO = (const half_t*)(p.ws + OFF_RLO);
    const half_t* SOG = (const half_t*)(p.ws + OFF_SOG); const half_t* SOM = (const half_t*)(p.ws + OFF_SOM); const float* SOR = (const float*)(p.ws + OFF_SOR);
    half_t* BR = (half_t*)(p.ws + OFF_BR);
    for (int r = blockIdx.x * 8 + wid; r < nrows; r += gridDim.x * 8) {
        { const half8 o0 = *(const half8*)(SOG + (size_t)r * 512 + c), o1 = *(const half8*)(SOG + ((size_t)RGP + r) * 512 + c), z = *(const half8*)(P + (size_t)r * NP + C_Z + c);
          float o[8], ss = 0.f;
#pragma unroll
          for (int e = 0; e < 8; ++e) { o[e] = (float)o0[e] + (float)o1[e]; ss += o[e] * o[e]; }
          ss += SHFL_XOR(ss, 1); ss += SHFL_XOR(ss, 2); ss += SHFL_XOR(ss, 4); ss += SHFL_XOR(ss, 8);
          const float rinv = frsq(ss * (1.f / 128.f) + 1e-6f); const float* gn = p.in[I_GNG] + l * 128 + (c & 127); half8 out;
#pragma unroll
          for (int e = 0; e < 8; ++e) out[e] = (half_t)(o[e] * rinv * gn[e] * siluf((float)z[e]));
          *(half8*)(BR + (size_t)r * 512 + c) = out; }
        { float y[8], sm = 0.f;
#pragma unroll
          for (int e = 0; e < 8; ++e) { y[e] = SOR[(size_t)r * 512 + c + e] + SOR[((size_t)RGP + r) * 512 + c + e]; sm += y[e]; }
          sm += SHFL_XOR(sm, 1); sm += SHFL_XOR(sm, 2); sm += SHFL_XOR(sm, 4); const float mean = sm * (1.f / 64.f);
          float vs = 0.f;
#pragma unroll
          for (int e = 0; e < 8; ++e) { const float dlt = y[e] - mean; vs += dlt * dlt; }
          vs += SHFL_XOR(vs, 1); vs += SHFL_XOR(vs, 2); vs += SHFL_XOR(vs, 4); const float rinv = frsq(vs * (1.f / 64.f) + 64e-5f);
          const half8 rv = *(const half8*)(RW + ((size_t)r * 4 + 0) * 512 + c), kv = *(const half8*)(RW + ((size_t)r * 4 + 1) * 512 + c), vv = *(const half8*)(RW + ((size_t)r * 4 + 2) * 512 + c);
          const half8 a0 = *(const half8*)(RLO + (size_t)r * 2560 + 1024 + c), a1 = *(const half8*)(RLO + (size_t)r * 2560 + 1536 + c), gg = *(const half8*)(RLO + (size_t)r * 2560 + 2048 + c);
          const float* ka = p.in[I_RKA] + (size_t)l * 512 + c; const float* rk = p.in[I_RRK] + (size_t)l * 512 + c;
          float bc = 0.f;
#pragma unroll
          for (int e = 0; e < 8; ++e) bc += (float)rv[e] * (float)kv[e] * (2.f + ((float)a0[e] + (float)a1[e] - 2.f) * ka[e]) * rk[e];
          bc += SHFL_XOR(bc, 1); bc += SHFL_XOR(bc, 2); bc += SHFL_XOR(bc, 4);
          const float* lg = p.in[I_RLNG] + (size_t)l * 512 + c; const float* lb = p.in[I_RLNB] + (size_t)l * 512 + c; half8 out;
#pragma unroll
          for (int e = 0; e < 8; ++e) out[e] = (half_t)(((y[e] - mean) * rinv * lg[e] + lb[e] + bc * (float)vv[e]) * (float)gg[e]);
          *(half8*)(BR + ((size_t)RGP + r) * 512 + c) = out; }
        { const half8 h0 = *(const half8*)(SOM + (size_t)r * 512 + c), h1 = *(const half8*)(SOM + ((size_t)RGP + r) * 512 + c), og = *(const half8*)(P + (size_t)r * NP + C_MLO + c);
          float o[8], ss = 0.f;
#pragma unroll
          for (int e = 0; e < 8; ++e) { o[e] = (float)h0[e] + (float)h1[e]; ss += o[e] * o[e]; }
          ss += SHFL_XOR(ss, 1); ss += SHFL_XOR(ss, 2); ss += SHFL_XOR(ss, 4); ss += SHFL_XOR(ss, 8);
          const float rinv = frsq(ss * (1.f / 128.f) + 1e-6f); const float* gn = p.in[I_MNG] + l * 128 + (c & 127); half8 out;
#pragma unroll
          for (int e = 0; e < 8; ++e) out[e] = (half_t)(o[e] * rinv * gn[e] * (float)og[e]);
          *(half8*)(BR + ((size_t)2 * RGP + r) * 512 + c) = out; }
    }
}

__device__ __forceinline__ void ph_norm2(int wb, const Params& p, int l, int g, int nrows, LAS unsigned char* lds) {
    const int tid = tid_fresh(wb), wid = tid >> 6, lane = tid & 63;
    LAS float* rw = (LAS float*)lds;
    for (int i = tid; i < 1024 * 16; i += NT) rw[i] = p.in[I_ROUT][(size_t)l * 1024 * 16 + i];
    SYNC();
    half_t* H = (half_t*)(p.ws + OFF_H); float* PROB = (float*)(p.ws + OFF_PROB);
    for (int r = blockIdx.x * 8 + wid; r < nrows; r += gridDim.x * 8) {
        const float* xr = res_dst(p, g, r); const float* md = mod_row(p, l, g, r); const float* gn = p.in[I_N2G] + l * D;
        float ss = 0.f;
#pragma unroll
        for (int j = 0; j < 4; ++j) { const f32x4 v = *(const f32x4*)(xr + lane * 4 + 256 * j); ss += v[0] * v[0] + v[1] * v[1] + v[2] * v[2] + v[3] * v[3]; }
        ss = wave_sum(ss); const float rinv = frsq(ss * (1.f / D) + 1e-6f);
        float lg[16];
#pragma unroll
        for (int e = 0; e < 16; ++e) lg[e] = 0.f;
#pragma unroll 1
        for (int j = 0; j < 4; ++j) { const int c = lane * 4 + 256 * j; half4 hh; const f32x4 v = *(const f32x4*)(xr + c);
#pragma unroll
            for (int i = 0; i < 4; ++i) { const float hv = v[i] * rinv * gn[c + i] * (1.f + md[4 * 1024 + c + i]) + md[3 * 1024 + c + i]; hh[i] = (half_t)hv;
#pragma unroll
                for (int e = 0; e < 16; ++e) lg[e] += hv * rw[(c + i) * 16 + e]; }
            *(half4*)(H + (size_t)r * D + c) = hh; }
        float mx = -INFINITY;
#pragma unroll
        for (int e = 0; e < 16; ++e) { lg[e] = wave_sum(lg[e]); mx = fmaxf(mx, lg[e]); }
        float sum = 0.f;
#pragma unroll
        for (int e = 0; e < 16; ++e) { lg[e] = fexp(lg[e] - mx); sum += lg[e]; }
        const float inv = frcp(sum);
#pragma unroll
        for (int e = 0; e < 16; ++e) if (lane == e) PROB[(size_t)r * 16 + e] = lg[e] * inv;
    }
}

__device__ __forceinline__ void ph_topk(int wb, const Params& p, int nstreams, LAS unsigned char* lds) {
    const int tid = tid_fresh(wb);
    LAS unsigned* pv = (LAS unsigned*)lds;
    LAS unsigned* hist = pv + (SEQ > CTXL ? SEQ : CTXL);
    LAS int* eqc = (LAS int*)(hist + 256);
    LAS int* gtc = eqc + 512;
    LAS int* posx = gtc + 512;
    LAS int* selrows = posx + 512;
    LAS unsigned* sh = (LAS unsigned*)(selrows + (CAPL > CAPC ? CAPL : CAPC));
    const float* PROB = (const float*)(p.ws + OFF_PROB); int* SLOT = (int*)(p.ws + OFF_SLOT); int* SEL = (int*)(p.ws + OFF_SEL); float* AFF = (float*)(p.ws + OFF_AFF);
    const half_t* H = (const half_t*)(p.ws + OFF_H); half_t* XE = (half_t*)(p.ws + OFF_XE);
    for (int item = blockIdx.x; item < nstreams * BG * 16; item += gridDim.x) {
        const int e = item & 15, bl = (item >> 4) % BG, stc = (item >> 4) / BG;
        const int n = stc ? CTXL : SEQ, cap = n / 8, row0 = stc ? RL + bl * CTXL : bl * SEQ, slot0 = stc ? BG * CAPL + bl * CAPC : bl * CAPL;
        for (int i = tid; i < n; i += NT) pv[i] = __float_as_uint(PROB[(size_t)(row0 + i) * 16 + e]);
        unsigned prefix = 0u, mask = 0u; int kth = cap;
        for (int pass = 3; pass >= 0; --pass) {
            if (tid < 256) hist[tid] = 0u;
            SYNC();
            for (int i = tid; i < n; i += NT) { const unsigned v = pv[i]; if ((v & mask) == prefix) LDS_ATOMIC_INC(&hist[(v >> (8 * pass)) & 255u]); }
            SYNC();
            if (tid == 0) { int cum = 0, b = 255; for (; b > 0; --b) { if (cum + (int)hist[b] >= kth) break; cum += (int)hist[b]; } sh[0] = (unsigned)b; sh[1] = (unsigned)(kth - cum); }
            SYNC();
            prefix |= sh[0] << (8 * pass); mask |= 0xFFu << (8 * pass); kth = (int)sh[1];
            SYNC();
        }
        const unsigned thr = prefix; const int need_eq = kth;
        const int per = (n + NT - 1) / NT, i0 = tid * per, i1 = (i0 + per < n) ? i0 + per : n;
        { int ce = 0, cg = 0; for (int i = i0; i < i1; ++i) { const unsigned v = pv[i]; ce += (v == thr); cg += (v > thr); } eqc[tid] = ce; gtc[tid] = cg; }
        SYNC();
        if (tid == 0) { int eq = 0, pos = 0; for (int t = 0; t < NT; ++t) { const int ce = eqc[t]; int take = need_eq - eq; take = take < 0 ? 0 : (take > ce ? ce : take);
                const int selc = gtc[t] + take; eqc[t] = eq; posx[t] = pos; eq += ce; pos += selc; } }
        SYNC();
        { int eqr = eqc[tid], pos = posx[tid];
          for (int i = i0; i < i1; ++i) { const unsigned v = pv[i]; const bool sel = v > thr || (v == thr && eqr < need_eq); if (v == thr) ++eqr; const int row = row0 + i;
              if (sel) { const int slot = slot0 + pos; SEL[e * RPE + slot] = row; AFF[e * RPE + slot] = __uint_as_float(v); SLOT[(size_t)row * 16 + e] = slot; selrows[pos] = row; ++pos; }
              else SLOT[(size_t)row * 16 + e] = -1; } }
        SYNC();
        for (int idx = tid; idx < cap * 128; idx += NT) { const int j = idx >> 7, v16 = idx & 127;
            *(half8*)(XE + ((size_t)e * RPE + slot0 + j) * 1024 + v16 * 8) = *(const half8*)(H + (size_t)selrows[j] * 1024 + v16 * 8); }
        SYNC();
    }
}

__device__ __forceinline__ void ph_combine(int wb, const Params& p, int l, int g, int nrows) {
    const int tid = tid_fresh(wb), wid = tid >> 6, lane = tid & 63;
    const int* SLOT = (const int*)(p.ws + OFF_SLOT); const half_t* YE = (const half_t*)(p.ws + OFF_YE);
    for (int r = blockIdx.x * 8 + wid; r < nrows; r += gridDim.x * 8) {
        float* xr = res_dst(p, g, r); const float* md = mod_row(p, l, g, r) + 5 * 1024;
        float acc[2][8];
#pragma unroll
        for (int j = 0; j < 2; ++j)
#pragma unroll
            for (int e = 0; e < 8; ++e) acc[j][e] = 0.f;
        for (int ex = 0; ex < 16; ++ex) { const int s = SLOT[(size_t)r * 16 + ex]; if (s < 0) continue;
#pragma unroll
            for (int j = 0; j < 2; ++j) { const half8 y = *(const half8*)(YE + ((size_t)ex * RPE + s) * 1024 + 8 * lane + 512 * j);
#pragma unroll
                for (int e = 0; e < 8; ++e) acc[j][e] += (float)y[e]; } }
        float xv[2][8], ss = 0.f;
#pragma unroll
        for (int j = 0; j < 2; ++j)
#pragma unroll
            for (int e = 0; e < 8; ++e) { const int c = 8 * lane + 512 * j + e; xv[j][e] = xr[c] + md[c] * acc[j][e]; ss += xv[j][e] * xv[j][e]; }
        if (l == DEPTH - 1) { ss = wave_sum(ss); const float rinv = frsq(ss * (1.f / D) + 1e-6f);
#pragma unroll
            for (int j = 0; j < 2; ++j)
#pragma unroll
                for (int e = 0; e < 8; ++e) { const int c = 8 * lane + 512 * j + e; xv[j][e] = xv[j][e] * rinv * p.in[I_FING][c]; } }
#pragma unroll
        for (int j = 0; j < 2; ++j) { *(f32x4*)(xr + 8 * lane + 512 * j) = (f32x4){xv[j][0], xv[j][1], xv[j][2], xv[j][3]}; *(f32x4*)(xr + 8 * lane + 512 * j + 4) = (f32x4){xv[j][4], xv[j][5], xv[j][6], xv[j][7]}; }
    }
}

#ifndef EMU_DUMP
#define EMU_DUMP(tag)
#endif
#ifndef CPU_EMU
extern __shared__ __attribute__((aligned(16))) unsigned char smem_raw[];
__global__ void __launch_bounds__(NT, 2) mega(Params p)
#else
void mega(Params p)
#endif
{
#ifndef CPU_EMU
    LAS unsigned char* lds = (LAS unsigned char*)smem_raw;
    volatile LAS unsigned* xbw = (volatile LAS unsigned*)(lds + SMEM_BYTES - 16);
    if (threadIdx.x == 0) { xbw[0] = 0u; xbw[1] = 0u; xbw[2] = 0u; xbw[3] = 0u; }
    __syncthreads();
    (void)xcd_barrier_post((unsigned*)(p.ws + OFF_BAR), xbw);
#else
    unsigned char* lds = emu_smem();
#endif
#ifndef CPU_EMU
    const int wb = __builtin_amdgcn_readfirstlane((int)threadIdx.x) & ~63;
#else
    const int wb = 0;
#endif
    const int G = gridDim.x, c = blockIdx.x;
    if (!(SKIP_MASK & 1)) ph_mod(wb, p, lds);
    if (!(SKIP_MASK & 2)) ph_convert(wb, p, 0, lds);
    GRID_SYNC();
    for (int l = 0; l < DEPTH; ++l) {
        const bool last = (l == DEPTH - 1);
        const int nact = last ? RL : RG;
        const int nactp = last ? RL : RGP;
        for (int g = 0; g < NGROUP; ++g) {
            if (!(SKIP_MASK & 4)) REPS(4) ph_norm1(wb, p, l, g);
            GRID_SYNC(); EMU_DUMP("norm1");
            if (!(SKIP_MASK & 8)) REPS(8) { pg8::StaticOrder S; S.init(RGP / 256, NP / 256, G, c); EpiP E{(half_t*)(p.ws + OFF_P)};
              pg8::gemm_phase(wb, lds, pg8::Gemm{(const half_t*)(p.ws + OFF_H), (const half_t*)(p.ws + OFF_WIN), 1024}, S, E); }
            GRID_SYNC(); EMU_DUMP("gemm_in");
            if (!(SKIP_MASK & 16)) REPS(16) ph_prep(wb, p, l, lds);
            GRID_SYNC(); EMU_DUMP("prep");
            if (!(SKIP_MASK & 32)) REPS(32) { pg8::StaticOrder S; S.init(RGP / 256, 10, G, c); EpiLora E{(half_t*)(p.ws + OFF_RLO), p.in[I_RW0] + (size_t)l * 1024, p.in[I_RA0] + (size_t)l * 1024};
              pg8::gemm_phase(wb, lds, pg8::Gemm{(const half_t*)(p.ws + OFF_RLI), (const half_t*)(p.ws + OFF_WLORA), 384}, S, E); }
            if (!(SKIP_MASK & 64)) REPS(64) ph_wy(wb, p, lds);
            GRID_SYNC(); EMU_DUMP("wy");
            if (!(SKIP_MASK & 128)) REPS(128) ph_scan(wb, p, l, lds);
            GRID_SYNC(); EMU_DUMP("scan");
            if (!(SKIP_MASK & 256)) REPS(256) ph_finish(wb, p, l, nact);
            GRID_SYNC(); EMU_DUMP("finish");
            if (!(SKIP_MASK & 512)) REPS(512)
#pragma unroll 1
            for (int bi = 0; bi < 3; ++bi) {
                pg8::StaticOrder S; S.init(nactp / 256, 4, G, c); EpiMerge E{(half_t*)(p.ws + OFF_H), (const half_t*)(p.ws + OFF_P), bi};
                pg8::gemm_phase(wb, lds, pg8::Gemm{(const half_t*)(p.ws + OFF_BR) + (size_t)bi * RGP * 512, (const half_t*)(p.ws + OFF_WBR) + (size_t)bi * 1024 * 512, 512}, S, E);
            }
            GRID_SYNC(); EMU_DUMP("merge");
            if (!(SKIP_MASK & 1024)) { pg8::StaticOrder S; S.init(nactp / 256, 4, G, c); EpiOut E{p, l, g};
              pg8::gemm_phase(wb, lds, pg8::Gemm{(const half_t*)(p.ws + OFF_H), (const half_t*)(p.ws + OFF_WOUT), 1024}, S, E); }
            GRID_SYNC(); EMU_DUMP("out");
            if (!(SKIP_MASK & 2048)) REPS(2048) ph_norm2(wb, p, l, g, nact, lds);
            GRID_SYNC(); EMU_DUMP("norm2");
            if (!(SKIP_MASK & 4096)) REPS(4096) ph_topk(wb, p, last ? 1 : 2, lds);
            GRID_SYNC(); EMU_DUMP("topk");
            if (!(SKIP_MASK & 8192)) REPS(8192) { pg8::ExpertOrder S; S.init(G, c); EpiUp E{(half_t*)(p.ws + OFF_HID)};
              pg8::gemm_phase(wb, lds, pg8::Gemm{(const half_t*)(p.ws + OFF_XE), (const half_t*)(p.ws + OFF_WUP), 1024}, S, E); }
            GRID_SYNC();
            if (!(SKIP_MASK & 16384)) REPS(16384) { pg8::ExpertOrder S; S.init(G, c); EpiDown E{(half_t*)(p.ws + OFF_YE), (const float*)(p.ws + OFF_AFF)};
              pg8::gemm_phase(wb, lds, pg8::Gemm{(const half_t*)(p.ws + OFF_HID), (const half_t*)(p.ws + OFF_WDN), 512}, S, E); }
            GRID_SYNC();
            if (!(SKIP_MASK & 32768)) ph_combine(wb, p, l, g, nact);
            if (!(SKIP_MASK & 2)) if (g == NGROUP - 1 && !last) ph_convert(wb, p, l + 1, lds);
            GRID_SYNC(); EMU_DUMP("combine");
        }
    }
}

#ifndef CPU_EMU
extern "C" void kernel_launch(void* const* d_in, const int* in_sizes, int n_in, void* d_out, int out_size, void* d_ws, size_t ws_size, hipStream_t stream) {
    (void)in_sizes; (void)n_in; (void)out_size;
    static int grid = 0;
    if (!grid) {
        int dev = 0, cus = 0, per_cu = 0;
        hipGetDevice(&dev);
        hipDeviceGetAttribute(&cus, hipDeviceAttributeMultiprocessorCount, dev);
        hipFuncSetAttribute((const void*)mega, hipFuncAttributeMaxDynamicSharedMemorySize, SMEM_BYTES);
        hipOccupancyMaxActiveBlocksPerMultiprocessor(&per_cu, (const void*)mega, NT, SMEM_BYTES);
        if (per_cu < 1) per_cu = 1;
        grid = cus;
        if (ws_size < WS_TOTAL) fprintf(stderr, "workspace too small: %zu < %zu\n", ws_size, (size_t)WS_TOTAL);
    }
    hipMemsetAsync((unsigned char*)d_ws + OFF_BAR, 0, 16384, stream);
    Params p{};
    for (int i = 0; i < 34; ++i) p.in[i] = (const float*)d_in[i];
    p.out = (float*)d_out; p.ws = (unsigned char*)d_ws;
    hipLaunchKernelGGL(mega, dim3(grid), dim3(NT), SMEM_BYTES, stream, p);
}
#endif
```

```cpp
#ifndef CPU_EMU
#include <hip/hip_runtime.h>
#include <cstdio>
#include <cstdint>
typedef _Float16 half_t;
typedef _Float16 half8 __attribute__((ext_vector_type(8)));
typedef _Float16 half4 __attribute__((ext_vector_type(4)));
typedef float f32x4 __attribute__((ext_vector_type(4)));
typedef float f32x2 __attribute__((ext_vector_type(2)));
#define LAS __attribute__((address_space(3)))
#define SYNC() __syncthreads()
#define WAVE_SYNC() __builtin_amdgcn_wave_barrier()
template <int M> __device__ __forceinline__ float shfl_xor_t(float v, int tid) {
    if constexpr (M < 32) return __int_as_float(__builtin_amdgcn_ds_swizzle(__float_as_int(v), (M << 10) | 0x1f));
    else return __int_as_float(__builtin_amdgcn_ds_bpermute(((tid ^ 32) & 63) << 2, __float_as_int(v)));
}
#define SHFL_XOR(v, m) shfl_xor_t<m>((v), tid)
#define LDS_ATOMIC_INC(p) __hip_atomic_fetch_add((p), 1u, __ATOMIC_RELAXED, __HIP_MEMORY_SCOPE_WORKGROUP)
#endif

#ifndef CFG_BATCH
#define CFG_BATCH 8
#define CFG_SEQ 4096
#define CFG_CTX 256
#define CFG_DEPTH 4
#define CFG_NGROUP 2
#endif
constexpr int BATCH = CFG_BATCH, SEQ = CFG_SEQ, CTXL = CFG_CTX, DEPTH = CFG_DEPTH, NGROUP = CFG_NGROUP;
#ifndef SKIP_MASK
#define SKIP_MASK 0
#endif
#ifndef REPEAT_MASK
#define REPEAT_MASK 0
#endif
#define REPS(bit) for (int rep_ = 0; rep_ < ((REPEAT_MASK & (bit)) ? 2 : 1); ++rep_)
constexpr int NT = 512;
constexpr int D = 1024;
constexpr int IN_COLS = 8608, NP = 8704;
constexpr int C_Z = 1536, C_BG = 2048;
constexpr int C_RWKV = 2064;
constexpr int C_ML = 3984, C_MLO = 5008, C_MLIG = 5520, C_MLFG = 5528;
constexpr int C_GATE = 5536;
constexpr int BG = BATCH / NGROUP;
constexpr int RL = BG * SEQ, RC = BG * CTXL, RG = RL + RC;
constexpr int RGP = (RG + 255) / 256 * 256;
constexpr int CAPL = SEQ / 8, CAPC = CTXL / 8;
constexpr int RPE = (BG * (CAPL + CAPC) + 255) / 256 * 256;
constexpr int TPE = RPE / 256;
constexpr int NCH = RGP / 64;
static_assert(RL % 256 == 0, "latent rows per group must be a multiple of 256");
static_assert(SEQ % 64 == 0 && CTXL % 64 == 0, "chunks");

constexpr size_t al256(size_t x) { return (x + 255) / 256 * 256; }
constexpr size_t cmax(size_t a, size_t b) { return a > b ? a : b; }
constexpr size_t OFF_BAR = 0;
constexpr size_t OFF_MOD = 16384;
constexpr size_t OFF_CTXR = al256(OFF_MOD + (size_t)DEPTH * (BATCH + 1) * 6144 * 4);
constexpr size_t OFF_WIN = al256(OFF_CTXR + (size_t)BATCH * CTXL * D * 4);
constexpr size_t OFF_WBR = al256(OFF_WIN + (size_t)NP * 1024 * 2);
constexpr size_t OFF_WOUT = al256(OFF_WBR + (size_t)3 * 1024 * 512 * 2);
constexpr size_t OFF_WUP = al256(OFF_WOUT + (size_t)1024 * 1024 * 2);
constexpr size_t OFF_WDN = al256(OFF_WUP + (size_t)16 * 1024 * 1024 * 2);
constexpr size_t OFF_WLORA = al256(OFF_WDN + (size_t)16 * 1024 * 512 * 2);
constexpr size_t OFF_H = al256(OFF_WLORA + (size_t)2560 * 384 * 2);
constexpr size_t OFF_P = al256(OFF_H + (size_t)RGP * 1024 * 2);
constexpr size_t SZ_XE = (size_t)16 * RPE * 1024 * 2, SZ_HID = (size_t)16 * RPE * 512 * 2;
constexpr size_t OFF_XE = OFF_P, OFF_HID = OFF_XE + SZ_XE, OFF_YE = OFF_HID + SZ_HID;
constexpr size_t OFF_GQKV = al256(OFF_P + cmax((size_t)RGP * NP * 2, 2 * SZ_XE + SZ_HID));
constexpr size_t OFF_BR = OFF_GQKV;
constexpr size_t OFF_GBG = al256(OFF_GQKV + (size_t)RGP * 1536 * 2);
constexpr size_t OFF_GTA = al256(OFF_GBG + (size_t)RGP * 16 * 4);
constexpr size_t OFF_GG = al256(OFF_GTA + (size_t)NCH * 4 * 2 * 2 * 4096 * 2);
constexpr size_t OFF_RW = al256(OFF_GG + (size_t)NCH * 4 * 2 * 64 * 4);
constexpr size_t OFF_RLO = al256(OFF_RW + (size_t)RGP * 4 * 512 * 2);
constexpr size_t OFF_SO = al256(OFF_RLO + (size_t)RGP * 2560 * 2);
constexpr size_t OFF_RLI = OFF_SO;
constexpr size_t OFF_SOG = OFF_SO, OFF_SOM = OFF_SOG + (size_t)2 * RGP * 512 * 2, OFF_SOR = OFF_SOM + (size_t)2 * RGP * 512 * 2;
constexpr size_t OFF_PROB = al256(OFF_SOR + (size_t)2 * RGP * 512 * 4);
constexpr size_t OFF_SLOT = al256(OFF_PROB + (size_t)RGP * 16 * 4);
constexpr size_t OFF_SEL = al256(OFF_SLOT + (size_t)RGP * 16 * 4);
constexpr size_t OFF_AFF = al256(OFF_SEL + (size_t)16 * RPE * 4);
constexpr size_t WS_TOTAL = al256(OFF_AFF + (size_t)16 * RPE * 4);
constexpr int SMEM_BYTES = 152 * 1024;

struct Params { const float* in[34]; float* out; unsigned char* ws; };
enum { I_X = 0, I_C, I_CTX, I_CCTX, I_ADAW, I_ADAB, I_N1G, I_N2G, I_WIN, I_GCONV, I_GALOG, I_GDTB, I_GNG, I_RMU, I_RW0, I_RWUP, I_RA0, I_RAUP, I_RGUP,
       I_RKK, I_RKA, I_RRK, I_RLNG, I_RLNB, I_MIB, I_MFB, I_MNG, I_WBR, I_WOUT, I_ROUT, I_W1, I_W3, I_W2, I_FING };

#ifndef CPU_EMU
__device__ __forceinline__ int tid_fresh(int wb) { int t; asm volatile("v_mbcnt_lo_u32_b32 %0, -1, 0\n\tv_mbcnt_hi_u32_b32 %0, -1, %0" : "=v"(t)); return wb + t; }
#else
static inline int tid_fresh(int) { return threadIdx.x; }
#endif
#ifndef CPU_EMU
__device__ __forceinline__ float fexp(float x) { return __builtin_amdgcn_exp2f(x * 1.4426950408889634f); }
__device__ __forceinline__ float flog(float x) { return __builtin_amdgcn_logf(x) * 0.6931471805599453f; }
__device__ __forceinline__ float frcp(float x) { return __builtin_amdgcn_rcpf(x); }
__device__ __forceinline__ float frsq(float x) { return __builtin_amdgcn_rsqf(x); }
#else
static inline float fexp(float x) { return expf(x); }
static inline float flog(float x) { return logf(x); }
static inline float frcp(float x) { return 1.f / x; }
static inline float frsq(float x) { return 1.f / sqrtf(x); }
#endif
__device__ __forceinline__ float sigm(float x) { return frcp(1.f + fexp(-x)); }
__device__ __forceinline__ float siluf(float x) { return x * frcp(1.f + fexp(-x)); }
__device__ __forceinline__ float ftanh(float x) { return 1.f - 2.f * frcp(1.f + fexp(2.f * x)); }
__device__ __forceinline__ float softplusf(float x) { const float t = fexp(x); return x > 15.f ? x : (t < 1e-3f ? t * (1.f - 0.5f * t) : flog(1.f + t)); }
#define wave_sum(x) wave_sum_(x, tid)
__device__ __forceinline__ float wave_sum_(float v, int tid) { v += SHFL_XOR(v, 32); v += SHFL_XOR(v, 16); v += SHFL_XOR(v, 8); v += SHFL_XOR(v, 4); v += SHFL_XOR(v, 2); v += SHFL_XOR(v, 1); return v; }

__device__ __forceinline__ const float* res_src(const Params& p, int l, int g, int r) {
    if (r < RL) { const size_t t = (size_t)(g * BG) * SEQ + r; return (l == 0 ? p.in[I_X] : p.out) + t * D; }
    const size_t t = (size_t)(g * BG) * CTXL + (r - RL); return (l == 0 ? p.in[I_CTX] : (const float*)(p.ws + OFF_CTXR)) + t * D;
}
__device__ __forceinline__ float* res_dst(const Params& p, int g, int r) {
    if (r < RL) { const size_t t = (size_t)(g * BG) * SEQ + r; return p.out + t * D; }
    const size_t t = (size_t)(g * BG) * CTXL + (r - RL); return (float*)(p.ws + OFF_CTXR) + t * D;
}
__device__ __forceinline__ const float* mod_row(const Params& p, int l, int g, int r) {
    const int s = r < RL ? (g * BG + r / SEQ) : BATCH; return (const float*)(p.ws + OFF_MOD) + ((size_t)l * (BATCH + 1) + s) * 6144;
}

#ifndef CPU_EMU
#define XB_TMO      128
#define XB_XCNT(j)  (256  + 64 * (j))
#define XB_XSUB(j)  (1280 + 64 * (j))
#define XB_XGEN(j)  (2304 + 64 * (j))
#define XB_TOP      3328
#define XB_TOPGEN   3392
#define XCD_BAR_WORDS 3456
#define XB_SPIN_CAP (1u << 22)
__device__ __forceinline__ unsigned xb_ld(unsigned* p)              { return __hip_atomic_load(p, __ATOMIC_RELAXED, __HIP_MEMORY_SCOPE_AGENT); }
__device__ __forceinline__ unsigned xb_add(unsigned* p, unsigned v) { return __hip_atomic_fetch_add(p, v, __ATOMIC_RELAXED, __HIP_MEMORY_SCOPE_AGENT); }
__device__ __forceinline__ unsigned xb_xcc_id() { return (unsigned)__builtin_amdgcn_s_getreg((3 << 11) | 20) & 0xFu; }
#define XB_SPIN(cond, bar) do { unsigned _sp = 0; while (cond) { __builtin_amdgcn_s_sleep(1); \
    if ((++_sp & 255u) == 0u) { if (xb_ld(&(bar)[XB_TMO])) break; if (_sp > XB_SPIN_CAP) { atomicAdd(&(bar)[XB_TMO], 1u); break; } } } } while (0)
struct XcdBarrier { unsigned* bar; unsigned x; volatile LAS unsigned* st; };
__device__ __forceinline__ XcdBarrier xcd_barrier_post(unsigned* bar, volatile LAS unsigned* st) {
    XcdBarrier b; b.bar = bar; b.x = xb_xcc_id(); b.st = st;
    if (threadIdx.x == 0) (void)xb_add(&bar[XB_XCNT(b.x)], 1u);
    return b;
}
__device__ __forceinline__ void xcd_barrier_complete(unsigned* bar, unsigned x, unsigned& nloc, unsigned& nx) {
    const unsigned G = gridDim.x * gridDim.y * gridDim.z;
    unsigned sum, cnt, mine, sp = 0u;
    for (;;) {
        sum = 0u; cnt = 0u; mine = 0u;
#pragma unroll
        for (unsigned j = 0; j < 16; ++j) { const unsigned c = xb_ld(&bar[XB_XCNT(j)]); sum += c; cnt += (c > 0u) ? 1u : 0u; mine = (j == x) ? c : mine; }
        if (sum == G) break;
        __builtin_amdgcn_s_sleep(1);
        if ((++sp & 255u) == 0u) { if (xb_ld(&bar[XB_TMO])) break; if (sp > XB_SPIN_CAP) { atomicAdd(&bar[XB_TMO], 1u); break; } }
    }
    nloc = mine > 0u ? mine : 1u; nx = cnt > 0u ? cnt : 1u;
}
__device__ __forceinline__ void xcd_barrier(const XcdBarrier& b) {
    asm volatile("s_waitcnt vmcnt(0)" ::: "memory");
    __syncthreads();
    if (threadIdx.x == 0) {
        unsigned* bar = b.bar;
        __builtin_amdgcn_s_waitcnt(0);
        unsigned nloc = b.st[0], nx = b.st[1];
        if (nloc == 0u) { xcd_barrier_complete(bar, b.x, nloc, nx); b.st[0] = nloc; b.st[1] = nx; }
        const unsigned old = xb_add(&bar[XB_XSUB(b.x)], 1u);
        const unsigned gen = old / nloc;
        if (old + 1u == (gen + 1u) * nloc) {
            __builtin_amdgcn_fence(__ATOMIC_RELEASE, "agent");
            asm volatile("s_waitcnt vmcnt(0)" ::: "memory");
            const unsigned og = xb_add(&bar[XB_TOP], 1u);
            const unsigned tg = og / nx;
            if (og + 1u == (tg + 1u) * nx) xb_add(&bar[XB_TOPGEN], 1u);
            else XB_SPIN(xb_ld(&bar[XB_TOPGEN]) == tg, bar);
            __builtin_amdgcn_fence(__ATOMIC_ACQUIRE, "agent");
            xb_add(&bar[XB_XGEN(b.x)], 1u);
            asm volatile("s_waitcnt vmcnt(0)" ::: "memory");
        } else {
            XB_SPIN(xb_ld(&bar[XB_XGEN(b.x)]) == gen, bar);
            __builtin_amdgcn_fence(__ATOMIC_ACQUIRE, "agent");
            asm volatile("s_waitcnt vmcnt(0)" ::: "memory");
        }
    }
    __syncthreads();
}
#define GRID_SYNC() do { XcdBarrier gb_; gb_.bar = (unsigned*)(p.ws + OFF_BAR); gb_.x = xb_xcc_id(); gb_.st = (volatile LAS unsigned*)(lds + SMEM_BYTES - 16); xcd_barrier(gb_); } while (0)
#else
#define GRID_SYNC() emu_grid_sync()
#endif

namespace pg8 {
constexpr int BM = 256, BK = 64, HALF = 128, HTB = HALF * BK * 2, STAGE_BYTES = 8 * HTB, NXCD = 8, WGM = 8;
__host__ __device__ __forceinline__ int lds_byte(int r, int c) { const int st = (r >> 4) * 2 + (c >> 5), rr = r & 15, cc = c & 31, ob = rr * 64 + cc * 2; return st * 1024 + (ob ^ (((ob >> 9) & 1) << 5)); }
__host__ __device__ __forceinline__ void stage_rc(int b, int& R, int& C) { const int st = b / 1024, sb = b % 1024, swz = sb ^ (((sb >> 9) & 1) << 5); R = (st >> 1) * 16 + swz / 64; C = (st & 1) * 32 + (swz % 64) / 2; }
__host__ __device__ __forceinline__ int perm32(int rho) { const int n = rho >> 4, i = rho & 15; return 8 * (i >> 2) + 4 * n + (i & 3); }
struct Unit { int pm, pn, pb; };
struct Gemm { const half_t* A; const half_t* Bt; int K; };
struct StaticOrder {
    int nM, nN, nwg, G, c;
    __device__ void init(int nM_, int nN_, int G_, int c_) { nM = nM_; nN = nN_; nwg = nM * nN; G = G_; c = c_; }
    __device__ bool next(int i, Unit& u) const {
        const long L = (long)i * G + c; if (L >= nwg) return false;
        int wgid = (int)L; { const int q = nwg / NXCD, r = nwg % NXCD, xcd = wgid % NXCD, off = wgid / NXCD; wgid = (xcd < r ? xcd * (q + 1) : r * (q + 1) + (xcd - r) * q) + off; }
        const int nig = WGM * nN, gid = wgid / nig, fm = gid * WGM, gsz = (nM - fm) < WGM ? (nM - fm) : WGM;
        u.pm = fm + ((wgid % nig) % gsz); u.pn = (wgid % nig) / gsz; u.pb = u.pn; return true;
    }
};
struct ExpertOrder {
    int G, c;
    __device__ void init(int G_, int c_) { G = G_; c = c_; }
    __device__ bool next(int i, Unit& u) const {
        const long L = (long)i * G + c; if (L >= 16 * TPE * 4) return false;
        const int e = (int)L / (TPE * 4), rem = (int)L % (TPE * 4);
        u.pm = e * TPE + rem / 4; u.pn = rem % 4; u.pb = e * 4 + u.pn; return true;
    }
};

#ifndef CPU_EMU
template <class Epi, class Sched>
__device__ __forceinline__ void gemm_phase(int wb, LAS unsigned char* lds, const Gemm g, const Sched& S, const Epi& E) {
    const int tid = tid_fresh(wb), wid = __builtin_amdgcn_readfirstlane(tid >> 6), lane = tid & 63, wr = wid >> 2, wc = wid & 3, fr = lane & 15, fq = lane >> 4;
    const int K = g.K, nt = K / BK;
    unsigned voffA[2], voffB[2];
#pragma unroll
    for (int i = 0; i < 2; ++i) { int R, C; stage_rc(tid * 16 + i * 8192, R, C); const int Rb = Epi::PERM ? ((R & ~31) + perm32(R & 31)) : R;
        voffA[i] = (unsigned)(R * K + C) * 2u; voffB[i] = (unsigned)(Rb * K + C) * 2u; }
    const size_t kstep = (size_t)(BK * 2);
    const size_t hstep = (size_t)HALF * K * 2;
    const size_t tstep = 2 * hstep;
    const unsigned ldsw = (unsigned)wid * 1024u;
    const int aoff = lds_byte(wr * 64 + fr, fq * 8), boff = lds_byte(wc * 32 + fr, fq * 8);
#define PG8_SA(b, h) (((b) * 2 + (h)) * HTB)
#define PG8_SB(b, h) ((4 + (b) * 2 + (h)) * HTB)
#define PG8_STAGE(bufoff, gbase, voff) do { _Pragma("unroll") for (int _i = 0; _i < 2; ++_i) \
        __builtin_amdgcn_global_load_lds((const unsigned*)((const char*)(gbase) + (voff)[_i]), (LAS unsigned*)(lds + (bufoff) + ldsw + _i * 8192), 16, 0, 0); } while (0)
#define PG8_LDA(dst, b, h) do { _Pragma("unroll") for (int m = 0; m < 4; ++m) _Pragma("unroll") for (int k = 0; k < 2; ++k) dst[m][k] = *(const LAS half8*)(lds + PG8_SA(b, h) + aoff + m * 2048 + k * 1024); } while (0)
#define PG8_LDB(dst, b, h) do { _Pragma("unroll") for (int n = 0; n < 2; ++n) _Pragma("unroll") for (int k = 0; k < 2; ++k) dst[n][k] = *(const LAS half8*)(lds + PG8_SB(b, h) + boff + n * 2048 + k * 1024); } while (0)
#define PG8_MMA(ai, bj, At, Bt) do { __builtin_amdgcn_s_setprio(1); _Pragma("unroll") for (int m = 0; m < 4; ++m) _Pragma("unroll") for (int n = 0; n < 2; ++n) _Pragma("unroll") for (int k = 0; k < 2; ++k) \
        acc[ai][bj][m][n] = __builtin_amdgcn_mfma_f32_16x16x32_f16(Bt[n][k], At[m][k], acc[ai][bj][m][n], 0, 0, 0); __builtin_amdgcn_s_setprio(0); } while (0)
#define PG8_WAIT_V(n) asm volatile("s_waitcnt vmcnt(" #n ")" ::: "memory")
#define PG8_WAIT_L(n) asm volatile("s_waitcnt lgkmcnt(" #n ")" ::: "memory")
#define PG8_BAR __builtin_amdgcn_s_barrier()
#define PG8_SCHED __builtin_amdgcn_sched_barrier(0)
    Unit cur, nxt; int ui = 0;
    if (!S.next(0, cur)) return;
    f32x4 acc[2][2][4][2];
#pragma unroll
    for (int a = 0; a < 2; ++a)
#pragma unroll
        for (int b = 0; b < 2; ++b)
#pragma unroll
            for (int m = 0; m < 4; ++m)
#pragma unroll
                for (int n = 0; n < 2; ++n) acc[a][b][m][n] = (f32x4){0.f, 0.f, 0.f, 0.f};
    half8 At[4][2], B0[2][2], B1[2][2];
    const char* cA = (const char*)g.A + (size_t)cur.pm * tstep; const char* cB = (const char*)g.Bt + (size_t)cur.pb * tstep;
    PG8_STAGE(PG8_SB(0, 0), cB, voffB); PG8_STAGE(PG8_SA(0, 0), cA, voffA); PG8_STAGE(PG8_SB(0, 1), cB + hstep, voffB); PG8_STAGE(PG8_SA(0, 1), cA + hstep, voffA);
    if (wr == 1) PG8_BAR;
    PG8_WAIT_V(4); PG8_BAR;
    PG8_STAGE(PG8_SB(1, 0), cB + kstep, voffB); PG8_STAGE(PG8_SA(1, 0), cA + kstep, voffA); PG8_STAGE(PG8_SB(1, 1), cB + hstep + kstep, voffB);
    PG8_WAIT_V(6); PG8_BAR;
    for (;;) {
        const bool has_next = S.next(ui + 1, nxt);
        const char* nA = has_next ? (const char*)g.A + (size_t)nxt.pm * tstep : cA; const char* nB = has_next ? (const char*)g.Bt + (size_t)nxt.pb * tstep : cB;
#pragma unroll 1
        for (int t = 0; t < nt; t += 2) {
            const bool last = (t == nt - 2);
            const char* a1 = cA + (size_t)(t + 1) * kstep;
            const char* a2 = last ? nA : cA + (size_t)(t + 2) * kstep; const char* b2 = last ? nB : cB + (size_t)(t + 2) * kstep;
            const char* a3 = a2 + kstep; const char* b3 = b2 + kstep;
            PG8_LDB(B0, 0, 0); PG8_SCHED; PG8_LDA(At, 0, 0); PG8_STAGE(PG8_SA(1, 1), a1 + hstep, voffA);
            PG8_WAIT_L(8); PG8_BAR; PG8_WAIT_L(0); PG8_MMA(0, 0, At, B0); PG8_BAR; PG8_SCHED;
            PG8_LDB(B1, 0, 1); PG8_STAGE(PG8_SB(0, 0), b2, voffB);
            PG8_BAR; PG8_WAIT_L(0); PG8_MMA(0, 1, At, B1); PG8_BAR;
            PG8_LDA(At, 0, 1); PG8_STAGE(PG8_SA(0, 0), a2, voffA);
            PG8_BAR; PG8_WAIT_L(0); PG8_MMA(1, 0, At, B0); PG8_BAR; PG8_SCHED;
            PG8_STAGE(PG8_SB(0, 1), b2 + hstep, voffB);
            PG8_WAIT_V(6); PG8_BAR; PG8_MMA(1, 1, At, B1); PG8_BAR;
            PG8_LDB(B0, 1, 0); PG8_SCHED; PG8_LDA(At, 1, 0); PG8_STAGE(PG8_SA(0, 1), a2 + hstep, voffA);
            PG8_WAIT_L(8); PG8_BAR; PG8_WAIT_L(0); PG8_MMA(0, 0, At, B0); PG8_BAR; PG8_SCHED;
            PG8_LDB(B1, 1, 1); PG8_STAGE(PG8_SB(1, 0), b3, voffB);
            PG8_BAR; PG8_WAIT_L(0); PG8_MMA(0, 1, At, B1); PG8_BAR;
            PG8_LDA(At, 1, 1); PG8_STAGE(PG8_SA(1, 0), a3, voffA);
            PG8_BAR; PG8_WAIT_L(0); PG8_MMA(1, 0, At, B0); PG8_BAR; PG8_SCHED;
            PG8_STAGE(PG8_SB(1, 1), b3 + hstep, voffB);
            PG8_WAIT_V(6); PG8_BAR; PG8_MMA(1, 1, At, B1); PG8_BAR;
        }
        E(acc, cur, wr, wc, fr, fq);
        if (!has_next) break;
#pragma unroll
        for (int a = 0; a < 2; ++a)
#pragma unroll
            for (int b = 0; b < 2; ++b)
#pragma unroll
                for (int m = 0; m < 4; ++m)
#pragma unroll
                    for (int n = 0; n < 2; ++n) acc[a][b][m][n] = (f32x4){0.f, 0.f, 0.f, 0.f};
        cur = nxt; cA = nA; cB = nB; ++ui;
    }
    PG8_WAIT_V(0);
    if (wr == 0) PG8_BAR;
    PG8_BAR;
#undef PG8_SA
#undef PG8_SB
#undef PG8_STAGE
#undef PG8_LDA
#undef PG8_LDB
#undef PG8_MMA
#undef PG8_WAIT_V
#undef PG8_WAIT_L
#undef PG8_BAR
#undef PG8_SCHED
}
#else
static float* emu_fa[64]; static float* emu_fb[64];
template <class Epi, class Sched>
void gemm_phase(int wb, LAS unsigned char* lds, const Gemm g, const Sched& S, const Epi& E) {
    const int tid = tid_fresh(wb), wid = tid >> 6, lane = tid & 63, wr = wid >> 2, wc = wid & 3, fr = lane & 15, fq = lane >> 4;
    const int K = g.K; const int bid = blockIdx.x;
    Unit u;
    for (int ui = 0; S.next(ui, u); ++ui) {
        SYNC();
        if (tid == 0) {
            if (!emu_fa[bid]) { emu_fa[bid] = (float*)malloc(256 * 1024 * 4); emu_fb[bid] = (float*)malloc(256 * 1024 * 4); }
            for (int r = 0; r < 256; ++r) for (int k = 0; k < K; ++k) { emu_fa[bid][r * K + k] = (float)g.A[((size_t)u.pm * 256 + r) * K + k]; emu_fb[bid][r * K + k] = (float)g.Bt[((size_t)u.pb * 256 + r) * K + k]; }
        }
        SYNC();
        f32x4 acc[2][2][4][2];
        for (int ai = 0; ai < 2; ++ai) for (int bj = 0; bj < 2; ++bj) for (int m = 0; m < 4; ++m) for (int n = 0; n < 2; ++n) for (int i = 0; i < 4; ++i) {
            const int row = 128 * ai + 64 * wr + 16 * m + fr;
            const int col = Epi::PERM ? (128 * bj + 32 * wc + 8 * fq + 4 * n + i) : (128 * bj + 32 * wc + 16 * n + 4 * fq + i);
            const float* a = emu_fa[bid] + row * K; const float* b = emu_fb[bid] + col * K; float s = 0.f;
            for (int k = 0; k < K; ++k) s += a[k] * b[k];
            acc[ai][bj][m][n][i] = s; }
        E(acc, u, wr, wc, fr, fq);
    }
    SYNC();
}
#endif
}
using pg8::Unit;

struct EpiP {
    static constexpr bool PERM = true;
    half_t* P;
    __device__ __forceinline__ void operator()(const f32x4 (&acc)[2][2][4][2], const Unit& u, int wr, int wc, int fr, int fq) const {
        const int row0 = u.pm * 256 + wr * 64 + fr, col0 = u.pn * 256 + wc * 32 + 8 * fq;
#pragma unroll
        for (int bj = 0; bj < 2; ++bj) {
            const int col = col0 + bj * 128;
            const bool sg = (col >= C_GATE && col < IN_COLS) || (col >= C_MLO && col < C_MLIG);
#pragma unroll
            for (int ai = 0; ai < 2; ++ai)
#pragma unroll
                for (int m = 0; m < 4; ++m) {
                    half8 h;
#pragma unroll
                    for (int n = 0; n < 2; ++n)
#pragma unroll
                        for (int i = 0; i < 4; ++i) { float v = acc[ai][bj][m][n][i]; if (sg) v = sigm(v); h[4 * n + i] = (half_t)v; }
                    *(half8*)(P + (size_t)(row0 + ai * 128 + m * 16) * NP + col) = h;
                }
        }
    }
};
struct EpiLora {
    static constexpr bool PERM = true;
    half_t* O; const float* w0; const float* a0;
    __device__ __forceinline__ void operator()(const f32x4 (&acc)[2][2][4][2], const Unit& u, int wr, int wc, int fr, int fq) const {
        const int row0 = u.pm * 256 + wr * 64 + fr, col0 = u.pn * 256 + wc * 32 + 8 * fq;
#pragma unroll
        for (int bj = 0; bj < 2; ++bj) {
            const int col = col0 + bj * 128, blk = col >> 9;
            float bias[8];
#pragma unroll
            for (int j = 0; j < 8; ++j) bias[j] = blk < 2 ? w0[col + j] : (blk < 4 ? a0[col - 1024 + j] : 0.f);
#pragma unroll
            for (int ai = 0; ai < 2; ++ai)
#pragma unroll
                for (int m = 0; m < 4; ++m) {
                    half8 h;
#pragma unroll
                    for (int n = 0; n < 2; ++n)
#pragma unroll
                        for (int i = 0; i < 4; ++i) { float v = acc[ai][bj][m][n][i] + bias[4 * n + i];
                            if (blk < 2) v = sigm(v) * 0.6065306597126334f; else if (blk < 4) v = sigm(v);
                            h[4 * n + i] = (half_t)v; }
                    *(half8*)(O + (size_t)(row0 + ai * 128 + m * 16) * 2560 + col) = h;
                }
        }
    }
};
struct EpiMerge {
    static constexpr bool PERM = true;
    half_t* M; const half_t* P; int bi;
    __device__ __forceinline__ void operator()(const f32x4 (&acc)[2][2][4][2], const Unit& u, int wr, int wc, int fr, int fq) const {
        const int row0 = u.pm * 256 + wr * 64 + fr, col0 = u.pn * 256 + wc * 32 + 8 * fq;
#pragma unroll
        for (int ai = 0; ai < 2; ++ai)
#pragma unroll
            for (int m = 0; m < 4; ++m) {
                const size_t row = (size_t)(row0 + ai * 128 + m * 16);
#pragma unroll
                for (int bj = 0; bj < 2; ++bj) {
                    const int col = col0 + bj * 128;
                    const half8 gt = *(const half8*)(P + row * NP + C_GATE + bi * 1024 + col);
                    half8 o; if (bi > 0) o = *(const half8*)(M + row * 1024 + col);
#pragma unroll
                    for (int n = 0; n < 2; ++n)
#pragma unroll
                        for (int i = 0; i < 4; ++i) { float v = (float)gt[4 * n + i] * acc[ai][bj][m][n][i]; if (bi > 0) v += (float)o[4 * n + i]; o[4 * n + i] = (half_t)v; }
                    *(half8*)(M + row * 1024 + col) = o;
                }
            }
    }
};
struct EpiOut {
    static constexpr bool PERM = false;
    Params p; int l, g;
    __device__ __forceinline__ void operator()(const f32x4 (&acc)[2][2][4][2], const Unit& u, int wr, int wc, int fr, int fq) const {
        const int row0 = u.pm * 256 + wr * 64 + fr, col0 = u.pn * 256 + wc * 32 + 4 * fq;
#pragma unroll
        for (int ai = 0; ai < 2; ++ai)
#pragma unroll
            for (int m = 0; m < 4; ++m) {
                const int row = row0 + ai * 128 + m * 16;
                if (row < RG) {
                    const float* src = res_src(p, l, g, row); float* dst = res_dst(p, g, row); const float* md = mod_row(p, l, g, row) + 2 * 1024;
#pragma unroll
                    for (int bj = 0; bj < 2; ++bj)
#pragma unroll
                        for (int n = 0; n < 2; ++n) { const int col = col0 + bj * 128 + n * 16;
                            const f32x4 xo = *(const f32x4*)(src + col), mv = *(const f32x4*)(md + col);
                            *(f32x4*)(dst + col) = xo + mv * acc[ai][bj][m][n]; }
                }
            }
    }
};
struct EpiUp {
    static constexpr bool PERM = true;
    half_t* HID;
    __device__ __forceinline__ void operator()(const f32x4 (&acc)[2][2][4][2], const Unit& u, int wr, int wc, int fr, int fq) const {
        const int row0 = u.pm * 256 + wr * 64 + fr, col = u.pn * 128 + wc * 32 + 8 * fq;
#pragma unroll
        for (int ai = 0; ai < 2; ++ai)
#pragma unroll
            for (int m = 0; m < 4; ++m) {
                half8 h;
#pragma unroll
                for (int n = 0; n < 2; ++n)
#pragma unroll
                    for (int i = 0; i < 4; ++i) h[4 * n + i] = (half_t)(siluf(acc[ai][0][m][n][i]) * acc[ai][1][m][n][i]);
                *(half8*)(HID + (size_t)(row0 + ai * 128 + m * 16) * 512 + col) = h;
            }
    }
};
struct EpiDown {
    static constexpr bool PERM = true;
    half_t* YE; const float* AFF;
    __device__ __forceinline__ void operator()(const f32x4 (&acc)[2][2][4][2], const Unit& u, int wr, int wc, int fr, int fq) const {
        const int row0 = u.pm * 256 + wr * 64 + fr, col0 = u.pn * 256 + wc * 32 + 8 * fq;
#pragma unroll
        for (int ai = 0; ai < 2; ++ai)
#pragma unroll
            for (int m = 0; m < 4; ++m) {
                const size_t row = (size_t)(row0 + ai * 128 + m * 16); const float af = AFF[row];
#pragma unroll
                for (int bj = 0; bj < 2; ++bj) {
                    half8 h;
#pragma unroll
                    for (int n = 0; n < 2; ++n)
#pragma unroll
                        for (int i = 0; i < 4; ++i) h[4 * n + i] = (half_t)(acc[ai][bj][m][n][i] * af);
                    *(half8*)(YE + row * 1024 + col0 + bj * 128) = h;
                }
            }
    }
};

__device__ __forceinline__ void ph_mod(int wb, const Params& p, LAS unsigned char* lds) {
    LAS float* sv = (LAS float*)lds; LAS float* red = sv + (BATCH + 1) * 1024;
    const int tid = tid_fresh(wb);
    for (int i = tid; i < (BATCH + 1) * 1024; i += NT) { const int s = i >> 10, k = i & 1023; const float cv = s < BATCH ? p.in[I_C][s * 1024 + k] : p.in[I_CCTX][k]; sv[i] = siluf(cv); }
    SYNC();
    float* mod = (float*)(p.ws + OFF_MOD);
    for (int item = blockIdx.x; item < DEPTH * 48; item += gridDim.x) {
        const int l = item / 48, j = (item % 48) * 128 + (tid & 127), kq = tid >> 7;
        float acc[BATCH + 1];
#pragma unroll
        for (int s = 0; s <= BATCH; ++s) acc[s] = 0.f;
        const float* w = p.in[I_ADAW] + (size_t)l * 1024 * 6144 + j;
        for (int k = kq * 256; k < kq * 256 + 256; ++k) { const float wv = w[(size_t)k * 6144];
#pragma unroll
            for (int s = 0; s <= BATCH; ++s) acc[s] += sv[s * 1024 + k] * wv; }
#pragma unroll
        for (int s = 0; s <= BATCH; ++s) red[tid * (BATCH + 1) + s] = acc[s];
        SYNC();
        if (tid < 128) {
#pragma unroll
            for (int s = 0; s <= BATCH; ++s) { float v = p.in[I_ADAB][l * 6144 + j];
                for (int q = 0; q < 4; ++q) v += red[(q * 128 + tid) * (BATCH + 1) + s];
                mod[((size_t)l * (BATCH + 1) + s) * 6144 + j] = v; }
        }
        SYNC();
    }
}

__device__ __forceinline__ void tconv_tile(int wb, const float* src, int sld, int k0, int n0, int nvalid, half_t* dst, int dld, int drow0, int dcol0, LAS float* tile) {
    const int tid = tid_fresh(wb), r = tid >> 4, c4 = (tid & 15) * 4;
#pragma unroll
    for (int j = 0; j < 2; ++j) { const int k = r + 32 * j; f32x4 v = {0.f, 0.f, 0.f, 0.f};
        if (src && n0 + c4 < nvalid) v = *(const f32x4*)(src + (size_t)(k0 + k) * sld + n0 + c4);
        tile[k * 65 + c4] = v[0]; tile[k * 65 + c4 + 1] = v[1]; tile[k * 65 + c4 + 2] = v[2]; tile[k * 65 + c4 + 3] = v[3]; }
    SYNC();
    const int n = tid >> 3, k8 = (tid & 7) * 8; half8 h;
#pragma unroll
    for (int i = 0; i < 8; ++i) h[i] = (half_t)tile[(k8 + i) * 65 + n];
    *(half8*)(dst + (size_t)(drow0 + n) * dld + dcol0 + k8) = h;
    SYNC();
}
__device__ __forceinline__ void ph_convert(int wb, const Params& p, int l, LAS unsigned char* lds) {
    LAS float* tile = (LAS float*)lds;
    constexpr int N_WIN = 16 * (NP / 64), N_WBR = 3 * 128, N_WOUT = 256, N_W13 = 2 * 2048, N_W2 = 2048, N_LORA = 240;
    constexpr int TOTAL = N_WIN + N_WBR + N_WOUT + N_W13 + N_W2 + N_LORA;
    half_t* ws16 = (half_t*)p.ws;
    for (int item = blockIdx.x; item < TOTAL; item += gridDim.x) {
        int it = item;
        if (it < N_WIN) { const int kt = it % 16, ntile = it / 16;
            tconv_tile(wb, p.in[I_WIN] + (size_t)l * 1024 * IN_COLS, IN_COLS, 64 * kt, 64 * ntile, IN_COLS, (half_t*)(p.ws + OFF_WIN), 1024, 64 * ntile, 64 * kt, tile); continue; }
        it -= N_WIN;
        if (it < N_WBR) { const int i = it / 128, rem = it % 128, kt = rem % 8, ntile = rem / 8;
            tconv_tile(wb, p.in[I_WBR] + (size_t)(l * 3 + i) * 512 * 1024, 1024, 64 * kt, 64 * ntile, 1024, (half_t*)(p.ws + OFF_WBR) + (size_t)i * 1024 * 512, 512, 64 * ntile, 64 * kt, tile); continue; }
        it -= N_WBR;
        if (it < N_WOUT) { const int kt = it % 16, ntile = it / 16;
            tconv_tile(wb, p.in[I_WOUT] + (size_t)l * 1024 * 1024, 1024, 64 * kt, 64 * ntile, 1024, (half_t*)(p.ws + OFF_WOUT), 1024, 64 * ntile, 64 * kt, tile); continue; }
        it -= N_WOUT;
        if (it < N_W13) { const int which = it / 2048, rem = it % 2048, e = rem / 128, r2 = rem % 128, kt = r2 % 16, ntile = r2 / 16, n0 = 64 * ntile;
            tconv_tile(wb, p.in[which ? I_W3 : I_W1] + (size_t)(l * 16 + e) * 1024 * 512, 512, 64 * kt, n0, 512, (half_t*)(p.ws + OFF_WUP) + (size_t)e * 1024 * 1024, 1024,
                       (n0 / 128) * 256 + which * 128 + (n0 % 128), 64 * kt, tile); continue; }
        it -= N_W13;
        if (it < N_W2) { const int e = it / 128, r2 = it % 128, kt = r2 % 8, ntile = r2 / 8;
            tconv_tile(wb, p.in[I_W2] + (size_t)(l * 16 + e) * 512 * 1024, 1024, 64 * kt, 64 * ntile, 1024, (half_t*)(p.ws + OFF_WDN) + (size_t)e * 1024 * 512, 512, 64 * ntile, 64 * kt, tile); continue; }
        it -= N_W2;
        { const int ntile = it / 6, kt = it % 6, n0 = 64 * ntile, blk = n0 / 512, nn0 = n0 % 512;
          const float* src = nullptr; int k0 = 0;
          if (blk == 0 && kt == 0) src = p.in[I_RWUP] + (size_t)(l * 2 + 0) * 64 * 512;
          else if (blk == 1 && kt == 1) src = p.in[I_RWUP] + (size_t)(l * 2 + 1) * 64 * 512;
          else if (blk == 2 && kt == 2) src = p.in[I_RAUP] + (size_t)(l * 2 + 0) * 64 * 512;
          else if (blk == 3 && kt == 3) src = p.in[I_RAUP] + (size_t)(l * 2 + 1) * 64 * 512;
          else if (blk == 4 && kt >= 4) { src = p.in[I_RGUP] + (size_t)l * 128 * 512; k0 = 64 * (kt - 4); }
          tconv_tile(wb, src, 512, k0, nn0, 512, (half_t*)(p.ws + OFF_WLORA), 384, n0, 64 * kt, tile); }
    }
    (void)ws16;
}

__device__ __forceinline__ void ph_norm1(int wb, const Params& p, int l, int g) {
    const int tid = tid_fresh(wb), wid = tid >> 6, lane = tid & 63;
    half_t* H = (half_t*)(p.ws + OFF_H);
    for (int r = blockIdx.x * 8 + wid; r < RGP; r += gridDim.x * 8) {
        if (r >= RG) { for (int j = 0; j < 4; ++j) *(half4*)(H + (size_t)r * D + lane * 4 + 256 * j) = (half4){0, 0, 0, 0}; continue; }
        const float* xr = res_src(p, l, g, r); const float* md = mod_row(p, l, g, r); const float* gn = p.in[I_N1G] + l * D;
        f32x4 v[4]; float ss = 0.f;
#pragma unroll
        for (int j = 0; j < 4; ++j) { v[j] = *(const f32x4*)(xr + lane * 4 + 256 * j); ss += v[j][0] * v[j][0] + v[j][1] * v[j][1] + v[j][2] * v[j][2] + v[j][3] * v[j][3]; }
        ss = wave_sum(ss); const float rinv = frsq(ss * (1.f / D) + 1e-6f);
#pragma unroll
        for (int j = 0; j < 4; ++j) { const int c = lane * 4 + 256 * j; half4 h;
#pragma unroll
            for (int i = 0; i < 4; ++i) h[i] = (half_t)(v[j][i] * rinv * gn[c + i] * (1.f + md[1024 + c + i]) + md[c + i]);
            *(half4*)(H + (size_t)r * D + c) = h; }
    }
}

struct RowGeo { int gw, gh, base, gr, gc; };
__device__ __forceinline__ RowGeo row_geo(int r) {
    RowGeo q; int i;
    if (r < RL) { const int bl = r / SEQ; i = r % SEQ; q.gw = 64; q.gh = SEQ / 64; q.base = bl * SEQ; }
    else { const int rr = r - RL, bl = rr / CTXL; i = rr % CTXL; q.gw = CTXL; q.gh = 1; q.base = RL + bl * CTXL; }
    q.gr = i / q.gw; q.gc = i % q.gw; return q;
}

__device__ __forceinline__ void ph_prep(int wb, const Params& p, int l, LAS unsigned char* lds) {
    const int tid = tid_fresh(wb), wid = tid >> 6, lane = tid & 63;
    LAS float* cw = (LAS float*)lds;
    for (int i = tid; i < 9 * 1536; i += NT) cw[i] = p.in[I_GCONV][(size_t)l * 9 * 1536 + i];
    SYNC();
    const half_t* P = (const half_t*)(p.ws + OFF_P);
    half_t* GQKV = (half_t*)(p.ws + OFF_GQKV); float* GBG = (float*)(p.ws + OFF_GBG);
    half_t* RW = (half_t*)(p.ws + OFF_RW); half_t* RLI = (half_t*)(p.ws + OFF_RLI);
    for (int r = blockIdx.x * 8 + wid; r < RG; r += gridDim.x * 8) {
        const RowGeo q = row_geo(r);
        float acc[3][8];
#pragma unroll
        for (int j = 0; j < 3; ++j)
#pragma unroll
            for (int e = 0; e < 8; ++e) acc[j][e] = 0.f;
        for (int kh = 0; kh < 3; ++kh) { const int nr = q.gr + kh - 1; if (nr < 0 || nr >= q.gh) continue;
            for (int kw = 0; kw < 3; ++kw) { const int nc = q.gc + kw - 1; if (nc < 0 || nc >= q.gw) continue;
                const size_t nrow = (size_t)(q.base + nr * q.gw + nc);
#pragma unroll
                for (int j = 0; j < 3; ++j) { const half8 pv = *(const half8*)(P + nrow * NP + j * 512 + 8 * lane); const LAS float* w = cw + (kh * 3 + kw) * 1536 + j * 512 + 8 * lane;
#pragma unroll
                    for (int e = 0; e < 8; ++e) acc[j][e] += (float)pv[e] * w[e]; } } }
#pragma unroll
        for (int j = 0; j < 3; ++j) {
            float ss = 0.f;
#pragma unroll
            for (int e = 0; e < 8; ++e) { acc[j][e] = siluf(acc[j][e]); ss += acc[j][e] * acc[j][e]; }
            float sc = 1.f;
            if (j < 2) { ss += SHFL_XOR(ss, 1); ss += SHFL_XOR(ss, 2); ss += SHFL_XOR(ss, 4); ss += SHFL_XOR(ss, 8); sc = frsq(ss + 1e-6f) * (j == 0 ? 0.08838834764831845f : 1.f); }
            half8 h;
#pragma unroll
            for (int e = 0; e < 8; ++e) h[e] = (half_t)(acc[j][e] * sc);
            *(half8*)(GQKV + (size_t)r * 1536 + j * 512 + 8 * lane) = h;
        }
        if (lane < 16) { const float x = (float)P[(size_t)r * NP + C_BG + lane];
            float o; if (lane < 8) o = sigm(x); else { const int idx = lane - 8; o = -fexp(p.in[I_GALOG][l * 8 + idx]) * softplusf(x + p.in[I_GDTB][l * 8 + idx]); }
            GBG[(size_t)r * 16 + lane] = o; }
        const int nb[4] = { q.gc > 0 ? r - 1 : -1, q.gc < q.gw - 1 ? r + 1 : -1, q.gr > 0 ? r - q.gw : -1, q.gr < q.gh - 1 ? r + q.gw : -1 };
        const float* mu = p.in[I_RMU] + (size_t)l * 1920;
        float kmix[8];
#pragma unroll
        for (int j = 0; j < 4; ++j) {
            if (j == 3 && lane >= 48) break;
            const int cj = j < 3 ? j * 512 + 8 * lane : 1536 + 8 * lane;
            const half8 self = *(const half8*)(P + (size_t)r * NP + C_RWKV + cj);
            half8 nv[4];
#pragma unroll
            for (int d = 0; d < 4; ++d) { if (nb[d] >= 0) nv[d] = *(const half8*)(P + (size_t)nb[d] * NP + C_RWKV + cj); else nv[d] = (half8){0, 0, 0, 0, 0, 0, 0, 0}; }
            float val[8];
#pragma unroll
            for (int e = 0; e < 8; ++e) { const float s = (float)self[e], nn = (float)nv[e & 3][e]; val[e] = s + (nn - s) * mu[cj + e]; }
            half8 h;
            if (j < 3) {
#pragma unroll
                for (int e = 0; e < 8; ++e) h[e] = (half_t)val[e];
                *(half8*)(RW + ((size_t)r * 4 + j) * 512 + 8 * lane) = h;
                if (j == 1) {
#pragma unroll
                    for (int e = 0; e < 8; ++e) kmix[e] = val[e]; }
            } else {
                const int c0 = 8 * lane;
#pragma unroll
                for (int e = 0; e < 8; ++e) { float v = val[e]; if (c0 < 128) v = ftanh(v); else if (c0 >= 256) v = sigm(v); h[e] = (half_t)v; }
                *(half8*)(RLI + (size_t)r * 384 + c0) = h;
            }
        }
        { float t[8], ss = 0.f; const float* kkw = p.in[I_RKK] + (size_t)l * 512 + 8 * lane;
#pragma unroll
          for (int e = 0; e < 8; ++e) { t[e] = kmix[e] * kkw[e]; ss += t[e] * t[e]; }
          ss += SHFL_XOR(ss, 1); ss += SHFL_XOR(ss, 2); ss += SHFL_XOR(ss, 4);
          const float sc = frsq(ss + 1e-6f); half8 h;
#pragma unroll
          for (int e = 0; e < 8; ++e) h[e] = (half_t)(t[e] * sc);
          *(half8*)(RW + ((size_t)r * 4 + 3) * 512 + 8 * lane) = h; }
    }
}

#ifndef CPU_EMU
#define MFMA16(a, b, c) __builtin_amdgcn_mfma_f32_16x16x32_f16((a), (b), (c), 0, 0, 0)
#else
#define MFMA16(a, b, c) emu_mfma16((a), (b), (c))
#endif
__device__ __forceinline__ half8 ldfrag(const LAS half_t* base, int row0, int ld, int k0, int lane) { return *(const LAS half8*)(base + (row0 + (lane & 15)) * ld + k0 + 8 * (lane >> 4)); }
__device__ __forceinline__ half4 cvt4(f32x4 v) { half4 o; o[0] = (half_t)v[0]; o[1] = (half_t)v[1]; o[2] = (half_t)v[2]; o[3] = (half_t)v[3]; return o; }

#ifndef CPU_EMU
__device__ __forceinline__ float shfl_up_f(float v, int off, int lane) { const float o = __int_as_float(__builtin_amdgcn_ds_bpermute(((lane - off) & 63) << 2, __float_as_int(v))); return lane >= off ? o : v; }
#else
static inline float shfl_up_f(float v, int off, int lane) { const float o = emu_shfl(v, (lane - off) & 63); return lane >= off ? o : v; }
#endif
__device__ __forceinline__ void ph_wy(int wb, const Params& p, LAS unsigned char* lds) {
#ifndef CPU_EMU
    const int tid = tid_fresh(wb), wid = __builtin_amdgcn_readfirstlane(tid >> 6), lane = tid & 63, fr = lane & 15, fq = lane >> 4;
#else
    const int tid = tid_fresh(wb), wid = tid >> 6, lane = tid & 63, fr = lane & 15, fq = lane >> 4;
#endif
    const int slot = wid >> 1, d = wid & 1;
    LAS half_t* Lm = (LAS half_t*)(lds + wid * 16896);
    LAS half_t* Xm = Lm + 4096;
    LAS float* Gv = (LAS float*)(Xm + 4096);
    LAS float* Bv = Gv + 64;
    const half_t* GQKV = (const half_t*)(p.ws + OFF_GQKV); const float* GBG = (const float*)(p.ws + OFF_GBG);
    half_t* GTA = (half_t*)(p.ws + OFF_GTA); float* GG = (float*)(p.ws + OFF_GG);
    constexpr int n_items = (RG / 64) * 4;
    SYNC();
    for (int base = blockIdx.x * 4; base < n_items; base += gridDim.x * 4) {
        const int item = base + slot;
        if (item < n_items) {
            const int cidx = item >> 2, h = item & 3, r0 = cidx * 64;
            const size_t tb = (size_t)((cidx * 4 + h) * 2 + d);
            { const int nat = d ? 63 - lane : lane; const float beta = GBG[(size_t)(r0 + nat) * 16 + d * 4 + h]; float G = GBG[(size_t)(r0 + nat) * 16 + 8 + d * 4 + h];
#pragma unroll
              for (int off = 1; off < 64; off <<= 1) { const float o = shfl_up_f(G, off, lane); G = lane >= off ? G + o : G; }
              Gv[lane] = G; Bv[lane] = beta; GG[tb * 64 + lane] = G; }
            WAVE_SYNC();
            half8 kf[4][4];
#pragma unroll
            for (int t = 0; t < 4; ++t)
#pragma unroll
                for (int ks = 0; ks < 4; ++ks) kf[t][ks] = *(const half8*)(GQKV + (size_t)(r0 + 16 * t + fr) * 1536 + 512 + h * 128 + 32 * ks + 8 * fq);
#pragma unroll
            for (int ti = 0; ti < 4; ++ti)
#pragma unroll
                for (int tj = 0; tj < 4; ++tj) {
                    if (d ? (tj < ti) : (tj > ti)) continue;
                    f32x4 acc = {0.f, 0.f, 0.f, 0.f};
#pragma unroll
                    for (int ks = 0; ks < 4; ++ks) acc = MFMA16(kf[tj][ks], kf[ti][ks], acc);
                    const int i = 16 * ti + fr, ip = d ? 63 - i : i; const float gi = Gv[ip], bi = Bv[ip]; f32x4 val;
#pragma unroll
                    for (int e = 0; e < 4; ++e) { const int j = 16 * tj + 4 * fq + e, jp = d ? 63 - j : j; val[e] = (jp < ip) ? bi * acc[e] * fexp(gi - Gv[jp]) : 0.f; }
                    if (d) *(LAS half4*)(Lm + ip * 64 + 60 - 16 * tj - 4 * fq) = cvt4((f32x4){val[3], val[2], val[1], val[0]});
                    else *(LAS half4*)(Lm + ip * 64 + 16 * tj + 4 * fq) = cvt4(val);
                }
#pragma unroll
            for (int ti = 0; ti < 4; ++ti) {
                half8 qf[4];
#pragma unroll
                for (int ks = 0; ks < 4; ++ks) qf[ks] = *(const half8*)(GQKV + (size_t)(r0 + 16 * ti + fr) * 1536 + h * 128 + 32 * ks + 8 * fq);
#pragma unroll
                for (int tj = 0; tj < 4; ++tj) {
                    const int i = 16 * ti + fr, ip = d ? 63 - i : i; f32x4 val = {0.f, 0.f, 0.f, 0.f};
                    if (!(d ? (tj < ti) : (tj > ti))) {
                        f32x4 acc = {0.f, 0.f, 0.f, 0.f};
#pragma unroll
                        for (int ks = 0; ks < 4; ++ks) acc = MFMA16(kf[tj][ks], qf[ks], acc);
                        const float gi = Gv[ip];
#pragma unroll
                        for (int e = 0; e < 4; ++e) { const int j = 16 * tj + 4 * fq + e, jp = d ? 63 - j : j; val[e] = (jp <= ip) ? acc[e] * fexp(gi - Gv[jp]) : 0.f; }
                    }
                    half_t* ap = GTA + (tb * 2 + 1) * 4096 + ip * 64;
                    if (d) *(half4*)(ap + 60 - 16 * tj - 4 * fq) = cvt4((f32x4){val[3], val[2], val[1], val[0]});
                    else *(half4*)(ap + 16 * tj + 4 * fq) = cvt4(val);
                }
            }
            WAVE_SYNC();
#pragma unroll 1
            for (int bi = 0; bi < 4; ++bi) {
                const LAS half_t* Lb = Lm + bi * 16 * 64; float a[16];
#pragma unroll
                for (int ii = 0; ii < 16; ++ii) a[ii] = (bi * 16 + ii == lane) ? 1.f : 0.f;
                for (int m = 0; m < bi * 16; ++m) { const float xm = (float)Xm[m * 64 + lane];
#pragma unroll
                    for (int ii = 0; ii < 16; ++ii) a[ii] -= (float)Lb[ii * 64 + m] * xm; }
#pragma unroll
                for (int ii = 0; ii < 16; ++ii) { float sacc = a[ii];
#pragma unroll
                    for (int mm = 0; mm < ii; ++mm) sacc -= (float)Lb[ii * 64 + bi * 16 + mm] * a[mm];
                    a[ii] = sacc; }
#pragma unroll
                for (int ii = 0; ii < 16; ++ii) Xm[(bi * 16 + ii) * 64 + lane] = (half_t)a[ii];
            }
            WAVE_SYNC();
#pragma unroll 1
            for (int t = 0; t < 8; ++t) { const int v = lane + 64 * t, i = v >> 3, j8 = (v & 7) * 8; const half8 x = *(const LAS half8*)(Xm + i * 64 + j8); half8 o;
#pragma unroll
                for (int e = 0; e < 8; ++e) o[e] = (half_t)((float)x[e] * Bv[j8 + e]);
                *(half8*)(GTA + (tb * 2 + 0) * 4096 + i * 64 + j8) = o; }
            WAVE_SYNC();
        }
    }
    SYNC();
}

__device__ __forceinline__ void scan_gdn(int wb, const Params& p, int item, LAS unsigned char* lds) {
    const int tid = tid_fresh(wb), wid = tid >> 6, lane = tid & 63, fr = lane & 15, fq = lane >> 4;
    const int d = item & 1, h = (item >> 1) & 3, bl = item >> 3;
    constexpr int L72 = 72, L136 = 136;
    LAS half_t* kT = (LAS half_t*)lds;
    LAS half_t* vT = kT + 128 * L72;
    LAS half_t* VNs = vT + 128 * L72;
    LAS half_t* Tb = VNs + 128 * L72;
    LAS half_t* Tbe = Tb + 64 * L72;
    LAS half_t* Am = Tbe + 64 * L72;
    LAS half_t* Qg = Am + 64 * L72;
    LAS half_t* Wn = Qg + 64 * L136;
    LAS half_t* ST = Wn + 64 * L136;
    LAS float* Es = (LAS float*)(ST + 128 * L136);
    const half_t* GQKV = (const half_t*)(p.ws + OFF_GQKV);
    const half_t* GTA = (const half_t*)(p.ws + OFF_GTA); const float* GG = (const float*)(p.ws + OFF_GG);
    half_t* SOG = (half_t*)(p.ws + OFF_SOG) + (size_t)d * RGP * 512;
    SYNC();
    for (int i = tid; i < 128 * L136 / 8; i += NT) *(LAS half8*)(ST + i * 8) = (half8){0, 0, 0, 0, 0, 0, 0, 0};
    f32x4 accS[8];
#pragma unroll
    for (int u = 0; u < 8; ++u) accS[u] = (f32x4){0.f, 0.f, 0.f, 0.f};
    constexpr int nchC = CTXL / 64, nchL = SEQ / 64, NCS = nchC + nchL;
    half8 pT, pA, pq[2], pk[2], pv[2]; f32x4 pg0, pg1; float pgi[2], pG = 0.f, pGl = 0.f; int nr0 = 0, cr0 = 0;
    const int ti = tid >> 3, tj8 = (tid & 7) * 8;
    auto issue = [&](int cs) {
        const bool isc = cs < nchC; const int cl = isc ? cs : cs - nchC, nch = isc ? nchC : nchL, cn = d ? nch - 1 - cl : cl;
        const int r0 = (isc ? RL + bl * CTXL : bl * SEQ) + cn * 64; nr0 = r0;
        const size_t tb = (size_t)(((r0 >> 6) * 4 + h) * 2 + d);
        pT = *(const half8*)(GTA + (tb * 2 + 0) * 4096 + ti * 64 + tj8); pA = *(const half8*)(GTA + (tb * 2 + 1) * 4096 + ti * 64 + tj8);
        pg0 = *(const f32x4*)(GG + tb * 64 + tj8); pg1 = *(const f32x4*)(GG + tb * 64 + tj8 + 4);
#pragma unroll
        for (int t = 0; t < 2; ++t) { const int v = tid + NT * t, i = v >> 4, c8 = (v & 15) * 8, nat = d ? 63 - i : i;
            pq[t] = *(const half8*)(GQKV + (size_t)(r0 + nat) * 1536 + h * 128 + c8); pgi[t] = GG[tb * 64 + i]; }
#pragma unroll
        for (int t = 0; t < 2; ++t) { const int g = wid + 8 * t, nat = d ? 63 - lane : lane;
            pk[t] = *(const half8*)(GQKV + (size_t)(r0 + nat) * 1536 + 512 + h * 128 + 8 * g); pv[t] = *(const half8*)(GQKV + (size_t)(r0 + nat) * 1536 + 1024 + h * 128 + 8 * g); }
        pG = GG[tb * 64 + (tid & 63)]; pGl = GG[tb * 64 + 63];
    };
    issue(0);
    for (int cs = 0; cs < NCS; ++cs) {
        SYNC();
        { half8 te; const float ge[8] = {pg0[0], pg0[1], pg0[2], pg0[3], pg1[0], pg1[1], pg1[2], pg1[3]};
#pragma unroll
          for (int e = 0; e < 8; ++e) te[e] = (half_t)((float)pT[e] * fexp(ge[e]));
          *(LAS half8*)(Tb + ti * L72 + tj8) = pT; *(LAS half8*)(Tbe + ti * L72 + tj8) = te; *(LAS half8*)(Am + ti * L72 + tj8) = pA; }
#pragma unroll
        for (int t = 0; t < 2; ++t) { const int v = tid + NT * t, i = v >> 4, c8 = (v & 15) * 8; const float sc = fexp(pgi[t]); half8 o;
#pragma unroll
            for (int e = 0; e < 8; ++e) o[e] = (half_t)((float)pq[t][e] * sc);
            *(LAS half8*)(Qg + i * L136 + c8) = o; }
#pragma unroll
        for (int t = 0; t < 2; ++t) { const int g = wid + 8 * t;
#pragma unroll
            for (int e = 0; e < 8; ++e) { kT[(8 * g + e) * L72 + lane] = pk[t][e]; vT[(8 * g + e) * L72 + lane] = pv[t][e]; } }
        if (tid < 64) Es[tid] = fexp(pGl - pG);
        const float dec = fexp(pGl);
        cr0 = nr0;
        if (cs + 1 < NCS) issue(cs + 1);
        SYNC();
        { f32x4 acc[4];
#pragma unroll
          for (int t = 0; t < 4; ++t) acc[t] = (f32x4){0.f, 0.f, 0.f, 0.f};
#pragma unroll
          for (int k2 = 0; k2 < 2; ++k2) { const half8 a = ldfrag(kT, 16 * wid, L72, 32 * k2, lane);
#pragma unroll
              for (int t = 0; t < 4; ++t) acc[t] = MFMA16(a, ldfrag(Tbe, 16 * t, L72, 32 * k2, lane), acc[t]); }
#pragma unroll
          for (int t = 0; t < 4; ++t) *(LAS half4*)(Wn + (16 * t + fr) * L136 + 16 * wid + 4 * fq) = cvt4(-acc[t]); }
        SYNC();
        { f32x4 acc[4];
#pragma unroll
          for (int t = 0; t < 4; ++t) acc[t] = (f32x4){0.f, 0.f, 0.f, 0.f};
#pragma unroll
          for (int k2 = 0; k2 < 2; ++k2) { const half8 b = ldfrag(vT, 16 * wid, L72, 32 * k2, lane);
#pragma unroll
              for (int t = 0; t < 4; ++t) acc[t] = MFMA16(ldfrag(Tb, 16 * t, L72, 32 * k2, lane), b, acc[t]); }
#pragma unroll
          for (int k4 = 0; k4 < 4; ++k4) { const half8 b = ldfrag(ST, 16 * wid, L136, 32 * k4, lane);
#pragma unroll
              for (int t = 0; t < 4; ++t) acc[t] = MFMA16(ldfrag(Wn, 16 * t, L136, 32 * k4, lane), b, acc[t]); }
          WAVE_SYNC();
#pragma unroll
          for (int t = 0; t < 4; ++t) { const f32x4 es = *(const LAS f32x4*)(Es + 16 * t + 4 * fq);
              *(LAS half4*)(vT + (16 * wid + fr) * L72 + 16 * t + 4 * fq) = cvt4(acc[t]); *(LAS half4*)(VNs + (16 * wid + fr) * L72 + 16 * t + 4 * fq) = cvt4(acc[t] * es); } }
        WAVE_SYNC();
        { f32x4 acc[4];
#pragma unroll
          for (int t = 0; t < 4; ++t) acc[t] = (f32x4){0.f, 0.f, 0.f, 0.f};
#pragma unroll
          for (int k4 = 0; k4 < 4; ++k4) { const half8 a = ldfrag(ST, 16 * wid, L136, 32 * k4, lane);
#pragma unroll
              for (int t = 0; t < 4; ++t) acc[t] = MFMA16(a, ldfrag(Qg, 16 * t, L136, 32 * k4, lane), acc[t]); }
#pragma unroll
          for (int k2 = 0; k2 < 2; ++k2) { const half8 a = ldfrag(vT, 16 * wid, L72, 32 * k2, lane);
#pragma unroll
              for (int t = 0; t < 4; ++t) acc[t] = MFMA16(a, ldfrag(Am, 16 * t, L72, 32 * k2, lane), acc[t]); }
#pragma unroll
          for (int t = 0; t < 4; ++t) { const int i = 16 * t + fr, nat = d ? 63 - i : i;
              *(half4*)(SOG + (size_t)(cr0 + nat) * 512 + h * 128 + 16 * wid + 4 * fq) = cvt4(acc[t]); } }
#pragma unroll
        for (int u = 0; u < 8; ++u) accS[u] = accS[u] * dec;
#pragma unroll
        for (int k2 = 0; k2 < 2; ++k2) { const half8 b = ldfrag(VNs, 16 * wid, L72, 32 * k2, lane);
#pragma unroll
            for (int u = 0; u < 8; ++u) accS[u] = MFMA16(ldfrag(kT, 16 * u, L72, 32 * k2, lane), b, accS[u]); }
        WAVE_SYNC();
#pragma unroll
        for (int u = 0; u < 8; ++u) *(LAS half4*)(ST + (16 * wid + fr) * L136 + 16 * u + 4 * fq) = cvt4(accS[u]);
        WAVE_SYNC();
    }
}

__device__ __forceinline__ void scan_mlstm(int wb, const Params& p, int l, int item, LAS unsigned char* lds) {
    const int tid = tid_fresh(wb), wid = tid >> 6, lane = tid & 63, fr = lane & 15, fq = lane >> 4;
    const int d = item & 1, h = (item >> 1) & 3, bl = item >> 3;
    constexpr int L72 = 72;
    LAS half_t* q = (LAS half_t*)lds;
    LAS half_t* k = q + 64 * L72;
    LAS half_t* kT = k + 64 * L72;
    LAS half_t* vT = kT + 64 * L72;
    LAS half_t* Pm = vT + 128 * L72;
    LAS half_t* CT = Pm + 64 * L72;
    LAS half_t* nvec = CT + 128 * L72 + 64 * wid;
    LAS float* lfv = (LAS float*)(CT + 128 * L72 + 64 * 8);
    LAS float* igv = lfv + 64;
    LAS float* rowv = igv + 64;
    LAS float* colv = rowv + 64;
    LAS float* interv = colv + 64;
    LAS float* emtv = interv + 64;
    LAS float* wscv = emtv + 64;
    const half_t* P = (const half_t*)(p.ws + OFF_P);
    half_t* SOM = (half_t*)(p.ws + OFF_SOM) + (size_t)d * RGP * 512;
    const float ibias = p.in[I_MIB][l * 8 + d * 4 + h], fbias = p.in[I_MFB][l * 8 + d * 4 + h];
    SYNC();
    for (int i = tid; i < 128 * L72 / 8; i += NT) *(LAS half8*)(CT + i * 8) = (half8){0, 0, 0, 0, 0, 0, 0, 0};
    nvec[lane] = (half_t)0.f;
    f32x4 accC[4], accN[4];
#pragma unroll
    for (int u = 0; u < 4; ++u) { accC[u] = (f32x4){0.f, 0.f, 0.f, 0.f}; accN[u] = (f32x4){0.f, 0.f, 0.f, 0.f}; }
    float m = 0.f;
    constexpr int nchC = CTXL / 64, nchL = SEQ / 64, NCS = nchC + nchL;
    half8 pq, pk, pv[2]; half_t pig = (half_t)0.f, pfg = (half_t)0.f; int nr0 = 0, cr0 = 0;
    const half8 ones = {1, 1, 1, 1, 1, 1, 1, 1};
    auto issue = [&](int cs) {
        const bool isc = cs < nchC; const int cl = isc ? cs : cs - nchC, nch = isc ? nchC : nchL, cn = d ? nch - 1 - cl : cl;
        const int r0 = (isc ? RL + bl * CTXL : bl * SEQ) + cn * 64; nr0 = r0;
        const int nat = d ? 63 - lane : lane; const half_t* pr = P + (size_t)(r0 + nat) * NP + C_ML;
        pq = *(const half8*)(pr + h * 64 + 8 * wid); pk = *(const half8*)(pr + 256 + h * 64 + 8 * wid);
        pv[0] = *(const half8*)(pr + 512 + h * 128 + 8 * wid); pv[1] = *(const half8*)(pr + 512 + h * 128 + 8 * (wid + 8));
        if (tid < 64) { const half_t* pg = P + (size_t)(r0 + (d ? 63 - tid : tid)) * NP; pig = pg[C_MLIG + d * 4 + h]; pfg = pg[C_MLFG + d * 4 + h]; }
    };
    issue(0);
    for (int cs = 0; cs < NCS; ++cs) {
        SYNC();
        { half8 qs;
#pragma unroll
          for (int e = 0; e < 8; ++e) qs[e] = (half_t)((float)pq[e] * 0.125f);
          *(LAS half8*)(q + lane * L72 + 8 * wid) = qs; *(LAS half8*)(k + lane * L72 + 8 * wid) = pk;
#pragma unroll
          for (int e = 0; e < 8; ++e) { kT[(8 * wid + e) * L72 + lane] = pk[e]; vT[(8 * wid + e) * L72 + lane] = pv[0][e]; vT[(8 * (wid + 8) + e) * L72 + lane] = pv[1][e]; } }
        if (tid < 64) { igv[tid] = (float)pig + ibias; lfv[tid] = -softplusf(-((float)pfg + fbias)); }
        cr0 = nr0;
        if (cs + 1 < NCS) issue(cs + 1);
        SYNC();
        float dec;
        { float b = lfv[lane];
#pragma unroll
          for (int off = 1; off < 64; off <<= 1) { const float o = shfl_up_f(b, off, lane); b = lane >= off ? b + o : b; }
          const float cm = igv[lane] - b; float pm = cm;
#pragma unroll
          for (int off = 1; off < 64; off <<= 1) { const float o = shfl_up_f(pm, off, lane); pm = lane >= off ? fmaxf(pm, o) : pm; }
#ifndef CPU_EMU
          const float b_last = __int_as_float(__builtin_amdgcn_readlane(__float_as_int(b), 63)), pm_last = __int_as_float(__builtin_amdgcn_readlane(__float_as_int(pm), 63));
#else
          const float b_last = emu_shfl(b, 63), pm_last = emu_shfl(pm, 63);
#endif
          const float mt = fmaxf(b + m, b + pm), m_new = fmaxf(b_last + m, b_last + pm_last);
          rowv[lane] = b - mt; colv[lane] = cm; interv[lane] = fexp(b + m - mt); emtv[lane] = fexp(-mt); wscv[lane] = fexp(b_last + cm - m_new);
          dec = fexp(b_last + m - m_new); m = m_new; }
        WAVE_SYNC();
#pragma unroll
        for (int tt = 0; tt < 2; ++tt) { const int idx = 2 * wid + tt, ti = idx >> 2, tj = idx & 3;
            f32x4 acc = {0.f, 0.f, 0.f, 0.f};
            if (tj <= ti) {
#pragma unroll
                for (int k2 = 0; k2 < 2; ++k2) acc = MFMA16(ldfrag(k, 16 * tj, L72, 32 * k2, lane), ldfrag(q, 16 * ti, L72, 32 * k2, lane), acc);
                const int i = 16 * ti + fr; const float rv = rowv[i]; const f32x4 cv = *(const LAS f32x4*)(colv + 16 * tj + 4 * fq);
#pragma unroll
                for (int e = 0; e < 4; ++e) { const int j = 16 * tj + 4 * fq + e; acc[e] = (j <= i) ? acc[e] * fexp(rv + cv[e]) : 0.f; }
            }
            *(LAS half4*)(Pm + (16 * ti + fr) * L72 + 16 * tj + 4 * fq) = cvt4(acc); }
        SYNC();
        { f32x4 a1[4], a2[4], d1[4], d2[4];
#pragma unroll
          for (int t = 0; t < 4; ++t) { a1[t] = (f32x4){0.f, 0.f, 0.f, 0.f}; a2[t] = a1[t]; d1[t] = a1[t]; d2[t] = a1[t]; }
#pragma unroll
          for (int k2 = 0; k2 < 2; ++k2) { const half8 ac = ldfrag(CT, 16 * wid, L72, 32 * k2, lane), av = ldfrag(vT, 16 * wid, L72, 32 * k2, lane);
              const half8 an = *(const LAS half8*)(nvec + 32 * k2 + 8 * fq);
#pragma unroll
              for (int t = 0; t < 4; ++t) { const half8 bq = ldfrag(q, 16 * t, L72, 32 * k2, lane), bp = ldfrag(Pm, 16 * t, L72, 32 * k2, lane);
                  a1[t] = MFMA16(ac, bq, a1[t]); a2[t] = MFMA16(av, bp, a2[t]); d1[t] = MFMA16(an, bq, d1[t]); d2[t] = MFMA16(ones, bp, d2[t]); } }
#pragma unroll
          for (int t = 0; t < 4; ++t) { const int i = 16 * t + fr, nat = d ? 63 - i : i; const float it = interv[i];
              const float den = it * d1[t][0] + d2[t][0], dn = frcp(fmaxf(fabsf(den), emtv[i]));
              *(half4*)(SOM + (size_t)(cr0 + nat) * 512 + h * 128 + 16 * wid + 4 * fq) = cvt4((a1[t] * it + a2[t]) * dn); } }
#pragma unroll
        for (int u = 0; u < 4; ++u) { accC[u] = accC[u] * dec; accN[u] = accN[u] * dec; }
#pragma unroll
        for (int k2 = 0; k2 < 2; ++k2) { const half8 bv = ldfrag(vT, 16 * wid, L72, 32 * k2, lane);
            const f32x4 w0 = *(const LAS f32x4*)(wscv + 32 * k2 + 8 * fq), w1 = *(const LAS f32x4*)(wscv + 32 * k2 + 8 * fq + 4);
#pragma unroll
            for (int u = 0; u < 4; ++u) { const half8 raw = ldfrag(kT, 16 * u, L72, 32 * k2, lane); half8 ak;
#pragma unroll
                for (int e = 0; e < 4; ++e) { ak[e] = (half_t)((float)raw[e] * w0[e]); ak[4 + e] = (half_t)((float)raw[4 + e] * w1[e]); }
                accC[u] = MFMA16(ak, bv, accC[u]); accN[u] = MFMA16(ak, ones, accN[u]); } }
        WAVE_SYNC();
#pragma unroll
        for (int u = 0; u < 4; ++u) { *(LAS half4*)(CT + (16 * wid + fr) * L72 + 16 * u + 4 * fq) = cvt4(accC[u]);
            if (fr == 0) *(LAS half4*)(nvec + 16 * u + 4 * fq) = cvt4(accN[u]); }
        WAVE_SYNC();
    }
}

#ifndef CPU_EMU
template <int CTRL> __device__ __forceinline__ float dpp_f(float v) { return __int_as_float(__builtin_amdgcn_update_dpp(0, __float_as_int(v), CTRL, 0xf, 0xf, true)); }
#define RED8(v) do { v += dpp_f<0xB1>(v); v += dpp_f<0x4E>(v); v += dpp_f<0x141>(v); } while (0)
#define RED16(v) do { RED8(v); v += dpp_f<0x140>(v); } while (0)
#else
#define RED8(v) do { v += emu_shfl_xor(v, 1); v += emu_shfl_xor(v, 2); v += emu_shfl_xor(v, 7); } while (0)
#define RED16(v) do { RED8(v); v += emu_shfl_xor(v, 15); } while (0)
#endif
__device__ __forceinline__ void scan_rwkv(int wb, const Params& p, int l, int item, LAS unsigned char* lds) {
#ifndef CPU_EMU
    const int tid = tid_fresh(wb), wid = __builtin_amdgcn_readfirstlane(tid >> 6), lane = tid & 63;
#else
    const int tid = tid_fresh(wb), wid = tid >> 6, lane = tid & 63;
#endif
    const int half = item & 1, d = (item >> 1) & 1, h = (item >> 2) & 7, bl = item >> 5;
    constexpr int NB = 16, REC = 388;
    LAS float* st = (LAS float*)lds;
    const half_t* RW = (const half_t*)(p.ws + OFF_RW); const half_t* RLO = (const half_t*)(p.ws + OFF_RLO);
    float* SOR = (float*)(p.ws + OFF_SOR) + (size_t)d * RGP * 512;
    constexpr int NSTEP = CTXL + SEQ, NBATCH = NSTEP / NB;
    auto step_row = [&](int sidx) -> size_t { return sidx < CTXL ? (size_t)(RL + bl * CTXL + (d ? CTXL - 1 - sidx : sidx)) : (size_t)(bl * SEQ + (d ? SEQ - 1 - (sidx - CTXL) : sidx - CTXL)); };
    SYNC();
    if (wid >= 4) {
        const int pt = tid - 256, lt = pt >> 4, cq = pt & 15, lc = h * 64 + 4 * cq;
        const f32x4 ka = *(const f32x4*)(p.in[I_RKA] + (size_t)l * 512 + lc);
        half4 g_r, g_k, g_v, g_kk, g_e, g_a;
        auto issue = [&](int n) { const size_t row = step_row(n * NB + lt);
            g_r = *(const half4*)(RW + (row * 4 + 0) * 512 + lc); g_k = *(const half4*)(RW + (row * 4 + 1) * 512 + lc); g_v = *(const half4*)(RW + (row * 4 + 2) * 512 + lc); g_kk = *(const half4*)(RW + (row * 4 + 3) * 512 + lc);
            g_e = *(const half4*)(RLO + row * 2560 + d * 512 + lc); g_a = *(const half4*)(RLO + row * 2560 + 1024 + d * 512 + lc); };
        auto stage = [&](int buf) { LAS float* o = st + (buf * NB + lt) * REC + 4 * cq; float br = 0.f, kr = 0.f; f32x4 oa, owr, ow, ob, okd, ov;
#pragma unroll
            for (int e = 0; e < 4; ++e) { const float r_ = (float)g_r[e], k_ = (float)g_k[e], kk = (float)g_kk[e], a_ = (float)g_a[e];
                const float w_ = fexp(-(float)g_e[e]), kd = k_ * (1.f + (a_ - 1.f) * ka[e]), b_ = kk * a_;
                oa[e] = -kk; owr[e] = w_ * r_; ow[e] = w_; ob[e] = b_; okd[e] = kd; ov[e] = (float)g_v[e]; br += b_ * r_; kr += kd * r_; }
            *(LAS f32x4*)(o) = oa; *(LAS f32x4*)(o + 64) = owr; *(LAS f32x4*)(o + 128) = ow; *(LAS f32x4*)(o + 192) = ob; *(LAS f32x4*)(o + 256) = okd; *(LAS f32x4*)(o + 320) = ov;
            RED16(br); RED16(kr);
            if (cq == 0) { LAS float* sc = st + (buf * NB + lt) * REC + 384; sc[0] = br; sc[1] = kr; } };
        issue(0); stage(0);
        if (NBATCH > 1) issue(1);
        SYNC();
        for (int n = 0; n < NBATCH; ++n) {
            if (n + 1 < NBATCH) { stage((n + 1) & 1); if (n + 2 < NBATCH) issue(n + 2); }
            SYNC();
        }
    } else {
        const int rr = 32 * half + 8 * wid + (lane >> 3), ks = lane & 7;
        f32x2 s2[4];
#pragma unroll
        for (int e = 0; e < 4; ++e) s2[e] = (f32x2){0.f, 0.f};
        SYNC();
        for (int n = 0; n < NBATCH; ++n) {
            const int buf = n & 1;
            float ysel = 0.f;
#pragma unroll 1
            for (int th = 0; th < NB / 4; ++th) {
                const int ksl = ks - 4 * (th & 1);
                f32x4 a0, a1, q0, q1, w0, w1, b0, b1, k0, k1; f32x2 sc; float vv;
#define RWKV_LOAD(T_) do { const LAS float* o = st + (buf * NB + (T_)) * REC; \
                a0 = *(const LAS f32x4*)(o + 8 * ks); a1 = *(const LAS f32x4*)(o + 8 * ks + 4); q0 = *(const LAS f32x4*)(o + 64 + 8 * ks); q1 = *(const LAS f32x4*)(o + 64 + 8 * ks + 4); \
                w0 = *(const LAS f32x4*)(o + 128 + 8 * ks); w1 = *(const LAS f32x4*)(o + 128 + 8 * ks + 4); b0 = *(const LAS f32x4*)(o + 192 + 8 * ks); b1 = *(const LAS f32x4*)(o + 192 + 8 * ks + 4); \
                k0 = *(const LAS f32x4*)(o + 256 + 8 * ks); k1 = *(const LAS f32x4*)(o + 256 + 8 * ks + 4); vv = o[320 + rr]; sc = *(const LAS f32x2*)(o + 384); } while (0)
#define LO2(v) __builtin_shufflevector(v, v, 0, 1)
#define HI2(v) __builtin_shufflevector(v, v, 2, 3)
                RWKV_LOAD(th * 4);
#pragma unroll
                for (int ti = 0; ti < 4; ++ti) {
                    const f32x4 ca0 = a0, ca1 = a1, cq0 = q0, cq1 = q1, cw0 = w0, cw1 = w1, cb0 = b0, cb1 = b1, ck0 = k0, ck1 = k1; const f32x2 csc = sc; const float cvv = vv;
                    if (ti < 3) RWKV_LOAD(th * 4 + ti + 1);
                    const f32x2 sa2 = s2[0] * LO2(ca0) + s2[1] * HI2(ca0) + s2[2] * LO2(ca1) + s2[3] * HI2(ca1);
                    const f32x2 yw2 = s2[0] * LO2(cq0) + s2[1] * HI2(cq0) + s2[2] * LO2(cq1) + s2[3] * HI2(cq1);
                    float sa = sa2[0] + sa2[1], yw = yw2[0] + yw2[1];
                    RED8(sa); RED8(yw);
                    const f32x2 sav = {sa, sa}, vvv = {cvv, cvv};
                    s2[0] = s2[0] * LO2(cw0) + (sav * LO2(cb0) + vvv * LO2(ck0)); s2[1] = s2[1] * HI2(cw0) + (sav * HI2(cb0) + vvv * HI2(ck0));
                    s2[2] = s2[2] * LO2(cw1) + (sav * LO2(cb1) + vvv * LO2(ck1)); s2[3] = s2[3] * HI2(cw1) + (sav * HI2(cb1) + vvv * HI2(ck1));
                    const float y = yw + sa * csc[0] + cvv * csc[1];
                    ysel = (ksl == ti) ? y : ysel;
#ifndef CPU_EMU
                    asm volatile("" ::: "memory");
#endif
                }
#undef RWKV_LOAD
#undef LO2
#undef HI2
                if (th & 1) SOR[step_row(n * NB + (th >> 1) * 8 + ks) * 512 + h * 64 + rr] = ysel;
            }
            SYNC();
        }
    }
}

__device__ __forceinline__ void ph_scan(int wb, const Params& p, int l, LAS unsigned char* lds) {
    constexpr int N_R = BG * 32, N_G = BG * 8, N_M = BG * 8;
    const int G = gridDim.x, c = blockIdx.x;
    if (!(SKIP_MASK & 65536)) for (int item = c; item < N_R; item += G) REPS(65536) { scan_rwkv(wb, p, l, item, lds); SYNC(); }
    if (!(SKIP_MASK & 131072)) for (int item = N_R + (((c - N_R) % G) + G) % G; item < N_R + N_G; item += G) REPS(131072) { scan_gdn(wb, p, item - N_R, lds); SYNC(); }
    if (!(SKIP_MASK & 262144)) for (int item = N_R + N_G + (((c - N_R - N_G) % G) + G) % G; item < N_R + N_G + N_M; item += G) REPS(262144) { scan_mlstm(wb, p, l, item - N_R - N_G, lds); SYNC(); }
}

__device__ __forceinline__ void ph_finish(int wb, const Params& p, int l, int nrows) {
    const int tid = tid_fresh(wb), wid = tid >> 6, lane = tid & 63, c = 8 * lane;
    const half_t* P = (const half_t*)(p.ws + OFF_P); const half_t* RW = (const half_t*)(p.ws + OFF_RW); const half_t* RLO = (const half_t*)(p.ws + OFF_RLO);
    const half_t* SOG = (const half_t*)(p.ws + OFF_SOG); const half_t* SOM = (const half_t*)(p.ws + OFF_SOM); const float* SOR = (const float*)(p.ws + OFF_SOR);
    half_t* BR = (half_t*)(p.ws + OFF_BR);
    for (int r = blockIdx.x * 8 + wid; r < nrows; r += gridDim.x * 8) {
        { const half8 o0 = *(const half8*)(SOG + (size_t)r * 512 + c), o1 = *(const half8*)(SOG + ((size_t)RGP + r) * 512 + c), z = *(const half8*)(P + (size_t)r * NP + C_Z + c);
          float o[8], ss = 0.f;
#pragma unroll
          for (int e = 0; e < 8; ++e) { o[e] = (float)o0[e] + (float)o1[e]; ss += o[e] * o[e]; }
          ss += SHFL_XOR(ss, 1); ss += SHFL_XOR(ss, 2); ss += SHFL_XOR(ss, 4); ss += SHFL_XOR(ss, 8);
          const float rinv = frsq(ss * (1.f / 128.f) + 1e-6f); const float* gn = p.in[I_GNG] + l * 128 + (c & 127); half8 out;
#pragma unroll
          for (int e = 0; e < 8; ++e) out[e] = (half_t)(o[e] * rinv * gn[e] * siluf((float)z[e]));
          *(half8*)(BR + (size_t)r * 512 + c) = out; }
        { float y[8], sm = 0.f;
#pragma unroll
          for (int e = 0; e < 8; ++e) { y[e] = SOR[(size_t)r * 512 + c + e] + SOR[((size_t)RGP + r) * 512 + c + e]; sm += y[e]; }
          sm += SHFL_XOR(sm, 1); sm += SHFL_XOR(sm, 2); sm += SHFL_XOR(sm, 4); const float mean = sm * (1.f / 64.f);
          float vs = 0.f;
#pragma unroll
          for (int e = 0; e < 8; ++e) { const float dlt = y[e] - mean; vs += dlt * dlt; }
          vs += SHFL_XOR(vs, 1); vs += SHFL_XOR(vs, 2); vs += SHFL_XOR(vs, 4); const float rinv = frsq(vs * (1.f / 64.f) + 64e-5f);
          const half8 rv = *(const half8*)(RW + ((size_t)r * 4 + 0) * 512 + c), kv = *(const half8*)(RW + ((size_t)r * 4 + 1) * 512 + c), vv = *(const half8*)(RW + ((size_t)r * 4 + 2) * 512 + c);
          const half8 a0 = *(const half8*)(RLO + (size_t)r * 2560 + 1024 + c), a1 = *(const half8*)(RLO + (size_t)r * 2560 + 1536 + c), gg = *(const half8*)(RLO + (size_t)r * 2560 + 2048 + c);
          const float* ka = p.in[I_RKA] + (size_t)l * 512 + c; const float* rk = p.in[I_RRK] + (size_t)l * 512 + c;
          float bc = 0.f;
#pragma unroll
          for (int e = 0; e < 8; ++e) bc += (float)rv[e] * (float)kv[e] * (2.f + ((float)a0[e] + (float)a1[e] - 2.f) * ka[e]) * rk[e];
          bc += SHFL_XOR(bc, 1); bc += SHFL_XOR(bc, 2); bc += SHFL_XOR(bc, 4);
          const float* lg = p.in[I_RLNG] + (size_t)l * 512 + c; const float* lb = p.in[I_RLNB] + (size_t)l * 512 + c; half8 out;
#pragma unroll
          for (int e = 0; e < 8; ++e) out[e] = (half_t)(((y[e] - mean) * rinv * lg[e] + lb[e] + bc * (float)vv[e]) * (float)gg[e]);
          *(half8*)(BR + ((size_t)RGP + r) * 512 + c) = out; }
        { const half8 h0 = *(const half8*)(SOM + (size_t)r * 512 + c), h1 = *(const half8*)(SOM + ((size_t)RGP + r) * 512 + c), og = *(const half8*)(P + (size_t)r * NP + C_MLO + c);
          float o[8], ss = 0.f;
#pragma unroll
          for (int e = 0; e < 8; ++e) { o[e] = (float)h0[e] + (float)h1[e]; ss += o[e] * o[e]; }
          ss += SHFL_XOR(ss, 1); ss += SHFL_XOR(ss, 2); ss += SHFL_XOR(ss, 4); ss += SHFL_XOR(ss, 8);
          const float rinv = frsq(ss * (1.f / 128.f) + 1e-6f); const float* gn = p.in[I_MNG] + l * 128 + (c & 127); half8 out;
#pragma unroll
          for (int e = 0; e < 8; ++e) out[e] = (half_t)(o[e] * rinv * gn[e] * (float)og[e]);
          *(half8*)(BR + ((size_t)2 * RGP + r) * 512 + c) = out; }
    }
}

__device__ __forceinline__ void ph_norm2(int wb, const Params& p, int l, int g, int nrows, LAS unsigned char* lds) {
    const int tid = tid_fresh(wb), wid = tid >> 6, lane = tid & 63;
    LAS float* rw = (LAS float*)lds;
    for (int i = tid; i < 1024 * 16; i += NT) rw[i] = p.in[I_ROUT][(size_t)l * 1024 * 16 + i];
    SYNC();
    half_t* H = (half_t*)(p.ws + OFF_H); float* PROB = (float*)(p.ws + OFF_PROB);
    for (int r = blockIdx.x * 8 + wid; r < nrows; r += gridDim.x * 8) {
        const float* xr = res_dst(p, g, r); const float* md = mod_row(p, l, g, r); const float* gn = p.in[I_N2G] + l * D;
        float ss = 0.f;
#pragma unroll
        for (int j = 0; j < 4; ++j) { const f32x4 v = *(const f32x4*)(xr + lane * 4 + 256 * j); ss += v[0] * v[0] + v[1] * v[1] + v[2] * v[2] + v[3] * v[3]; }
        ss = wave_sum(ss); const float rinv = frsq(ss * (1.f / D) + 1e-6f);
        float lg[16];
#pragma unroll
        for (int e = 0; e < 16; ++e) lg[e] = 0.f;
#pragma unroll 1
        for (int j = 0; j < 4; ++j) { const int c = lane * 4 + 256 * j; half4 hh; const f32x4 v = *(const f32x4*)(xr + c);
#pragma unroll
            for (int i = 0; i < 4; ++i) { const float hv = v[i] * rinv * gn[c + i] * (1.f + md[4 * 1024 + c + i]) + md[3 * 1024 + c + i]; hh[i] = (half_t)hv;
#pragma unroll
                for (int e = 0; e < 16; ++e) lg[e] += hv * rw[(c + i) * 16 + e]; }
            *(half4*)(H + (size_t)r * D + c) = hh; }
        float mx = -INFINITY;
#pragma unroll
        for (int e = 0; e < 16; ++e) { lg[e] = wave_sum(lg[e]); mx = fmaxf(mx, lg[e]); }
        float sum = 0.f;
#pragma unroll
        for (int e = 0; e < 16; ++e) { lg[e] = fexp(lg[e] - mx); sum += lg[e]; }
        const float inv = frcp(sum);
#pragma unroll
        for (int e = 0; e < 16; ++e) if (lane == e) PROB[(size_t)r * 16 + e] = lg[e] * inv;
    }
}

__device__ __forceinline__ void ph_topk(int wb, const Params& p, int nstreams, LAS unsigned char* lds) {
    const int tid = tid_fresh(wb);
    LAS unsigned* pv = (LAS unsigned*)lds;
    LAS unsigned* hist = pv + (SEQ > CTXL ? SEQ : CTXL);
    LAS int* eqc = (LAS int*)(hist + 256);
    LAS int* gtc = eqc + 512;
    LAS int* posx = gtc + 512;
    LAS int* selrows = posx + 512;
    LAS unsigned* sh = (LAS unsigned*)(selrows + (CAPL > CAPC ? CAPL : CAPC));
    const float* PROB = (const float*)(p.ws + OFF_PROB); int* SLOT = (int*)(p.ws + OFF_SLOT); int* SEL = (int*)(p.ws + OFF_SEL); float* AFF = (float*)(p.ws + OFF_AFF);
    const half_t* H = (const half_t*)(p.ws + OFF_H); half_t* XE = (half_t*)(p.ws + OFF_XE);
    for (int item = blockIdx.x; item < nstreams * BG * 16; item += gridDim.x) {
        const int e = item & 15, bl = (item >> 4) % BG, stc = (item >> 4) / BG;
        const int n = stc ? CTXL : SEQ, cap = n / 8, row0 = stc ? RL + bl * CTXL : bl * SEQ, slot0 = stc ? BG * CAPL + bl * CAPC : bl * CAPL;
        for (int i = tid; i < n; i += NT) pv[i] = __float_as_uint(PROB[(size_t)(row0 + i) * 16 + e]);
        unsigned prefix = 0u, mask = 0u; int kth = cap;
        for (int pass = 3; pass >= 0; --pass) {
            if (tid < 256) hist[tid] = 0u;
            SYNC();
            for (int i = tid; i < n; i += NT) { const unsigned v = pv[i]; if ((v & mask) == prefix) LDS_ATOMIC_INC(&hist[(v >> (8 * pass)) & 255u]); }
            SYNC();
            if (tid == 0) { int cum = 0, b = 255; for (; b > 0; --b) { if (cum + (int)hist[b] >= kth) break; cum += (int)hist[b]; } sh[0] = (unsigned)b; sh[1] = (unsigned)(kth - cum); }
            SYNC();
            prefix |= sh[0] << (8 * pass); mask |= 0xFFu << (8 * pass); kth = (int)sh[1];
            SYNC();
        }
        const unsigned thr = prefix; const int need_eq = kth;
        const int per = (n + NT - 1) / NT, i0 = tid * per, i1 = (i0 + per < n) ? i0 + per : n;
        { int ce = 0, cg = 0; for (int i = i0; i < i1; ++i) { const unsigned v = pv[i]; ce += (v == thr); cg += (v > thr); } eqc[tid] = ce; gtc[tid] = cg; }
        SYNC();
        if (tid == 0) { int eq = 0, pos = 0; for (int t = 0; t < NT; ++t) { const int ce = eqc[t]; int take = need_eq - eq; take = take < 0 ? 0 : (take > ce ? ce : take);
                const int selc = gtc[t] + take; eqc[t] = eq; posx[t] = pos; eq += ce; pos += selc; } }
        SYNC();
        { int eqr = eqc[tid], pos = posx[tid];
          for (int i = i0; i < i1; ++i) { const unsigned v = pv[i]; const bool sel = v > thr || (v == thr && eqr < need_eq); if (v == thr) ++eqr; const int row = row0 + i;
              if (sel) { const int slot = slot0 + pos; SEL[e * RPE + slot] = row; AFF[e * RPE + slot] = __uint_as_float(v); SLOT[(size_t)row * 16 + e] = slot; selrows[pos] = row; ++pos; }
              else SLOT[(size_t)row * 16 + e] = -1; } }
        SYNC();
        for (int idx = tid; idx < cap * 128; idx += NT) { const int j = idx >> 7, v16 = idx & 127;
            *(half8*)(XE + ((size_t)e * RPE + slot0 + j) * 1024 + v16 * 8) = *(const half8*)(H + (size_t)selrows[j] * 1024 + v16 * 8); }
        SYNC();
    }
}

__device__ __forceinline__ void ph_combine(int wb, const Params& p, int l, int g, int nrows) {
    const int tid = tid_fresh(wb), wid = tid >> 6, lane = tid & 63;
    const int* SLOT = (const int*)(p.ws + OFF_SLOT); const half_t* YE = (const half_t*)(p.ws + OFF_YE);
    for (int r = blockIdx.x * 8 + wid; r < nrows; r += gridDim.x * 8) {
        float* xr = res_dst(p, g, r); const float* md = mod_row(p, l, g, r) + 5 * 1024;
        float acc[2][8];
#pragma unroll
        for (int j = 0; j < 2; ++j)
#pragma unroll
            for (int e = 0; e < 8; ++e) acc[j][e] = 0.f;
        for (int ex = 0; ex < 16; ++ex) { const int s = SLOT[(size_t)r * 16 + ex]; if (s < 0) continue;
#pragma unroll
            for (int j = 0; j < 2; ++j) { const half8 y = *(const half8*)(YE + ((size_t)ex * RPE + s) * 1024 + 8 * lane + 512 * j);
#pragma unroll
                for (int e = 0; e < 8; ++e) acc[j][e] += (float)y[e]; } }
        float xv[2][8], ss = 0.f;
#pragma unroll
        for (int j = 0; j < 2; ++j)
#pragma unroll
            for (int e = 0; e < 8; ++e) { const int c = 8 * lane + 512 * j + e; xv[j][e] = xr[c] + md[c] * acc[j][e]; ss += xv[j][e] * xv[j][e]; }
        if (l == DEPTH - 1) { ss = wave_sum(ss); const float rinv = frsq(ss * (1.f / D) + 1e-6f);
#pragma unroll
            for (int j = 0; j < 2; ++j)
#pragma unroll
                for (int e = 0; e < 8; ++e) { const int c = 8 * lane + 512 * j + e; xv[j][e] = xv[j][e] * rinv * p.in[I_FING][c]; } }
#pragma unroll
        for (int j = 0; j < 2; ++j) { *(f32x4*)(xr + 8 * lane + 512 * j) = (f32x4){xv[j][0], xv[j][1], xv[j][2], xv[j][3]}; *(f32x4*)(xr + 8 * lane + 512 * j + 4) = (f32x4){xv[j][4], xv[j][5], xv[j][6], xv[j][7]}; }
    }
}

#ifndef EMU_DUMP
#define EMU_DUMP(tag)
#endif
#ifndef CPU_EMU
extern __shared__ __attribute__((aligned(16))) unsigned char smem_raw[];
__global__ void __launch_bounds__(NT, 2) mega(Params p)
#else
void mega(Params p)
#endif
{
#ifndef CPU_EMU
    LAS unsigned char* lds = (LAS unsigned char*)smem_raw;
    volatile LAS unsigned* xbw = (volatile LAS unsigned*)(lds + SMEM_BYTES - 16);
    if (threadIdx.x == 0) { xbw[0] = 0u; xbw[1] = 0u; xbw[2] = 0u; xbw[3] = 0u; }
    __syncthreads();
    (void)xcd_barrier_post((unsigned*)(p.ws + OFF_BAR), xbw);
#else
    unsigned char* lds = emu_smem();
#endif
#ifndef CPU_EMU
    const int wb = __builtin_amdgcn_readfirstlane((int)threadIdx.x) & ~63;
#else
    const int wb = 0;
#endif
    const int G = gridDim.x, c = blockIdx.x;
    if (!(SKIP_MASK & 1)) ph_mod(wb, p, lds);
    if (!(SKIP_MASK & 2)) ph_convert(wb, p, 0, lds);
    GRID_SYNC();
    for (int l = 0; l < DEPTH; ++l) {
        const bool last = (l == DEPTH - 1);
        const int nact = last ? RL : RG;
        const int nactp = last ? RL : RGP;
        for (int g = 0; g < NGROUP; ++g) {
            if (!(SKIP_MASK & 4)) REPS(4) ph_norm1(wb, p, l, g);
            GRID_SYNC(); EMU_DUMP("norm1");
            if (!(SKIP_MASK & 8)) REPS(8) { pg8::StaticOrder S; S.init(RGP / 256, NP / 256, G, c); EpiP E{(half_t*)(p.ws + OFF_P)};
              pg8::gemm_phase(wb, lds, pg8::Gemm{(const half_t*)(p.ws + OFF_H), (const half_t*)(p.ws + OFF_WIN), 1024}, S, E); }
            GRID_SYNC(); EMU_DUMP("gemm_in");
            if (!(SKIP_MASK & 16)) REPS(16) ph_prep(wb, p, l, lds);
            GRID_SYNC(); EMU_DUMP("prep");
            if (!(SKIP_MASK & 32)) REPS(32) { pg8::StaticOrder S; S.init(RGP / 256, 10, G, c); EpiLora E{(half_t*)(p.ws + OFF_RLO), p.in[I_RW0] + (size_t)l * 1024, p.in[I_RA0] + (size_t)l * 1024};
              pg8::gemm_phase(wb, lds, pg8::Gemm{(const half_t*)(p.ws + OFF_RLI), (const half_t*)(p.ws + OFF_WLORA), 384}, S, E); }
            if (!(SKIP_MASK & 64)) REPS(64) ph_wy(wb, p, lds);
            GRID_SYNC(); EMU_DUMP("wy");
            if (!(SKIP_MASK & 128)) REPS(128) ph_scan(wb, p, l, lds);
            GRID_SYNC(); EMU_DUMP("scan");
            if (!(SKIP_MASK & 256)) REPS(256) ph_finish(wb, p, l, nact);
            GRID_SYNC(); EMU_DUMP("finish");
            if (!(SKIP_MASK & 512)) REPS(512)
#pragma unroll 1
            for (int bi = 0; bi < 3; ++bi) {
                pg8::StaticOrder S; S.init(nactp / 256, 4, G, c); EpiMerge E{(half_t*)(p.ws + OFF_H), (const half_t*)(p.ws + OFF_P), bi};
                pg8::gemm_phase(wb, lds, pg8::Gemm{(const half_t*)(p.ws + OFF_BR) + (size_t)bi * RGP * 512, (const half_t*)(p.ws + OFF_WBR) + (size_t)bi * 1024 * 512, 512}, S, E);
            }
            GRID_SYNC(); EMU_DUMP("merge");
            if (!(SKIP_MASK & 1024)) { pg8::StaticOrder S; S.init(nactp / 256, 4, G, c); EpiOut E{p, l, g};
              pg8::gemm_phase(wb, lds, pg8::Gemm{(const half_t*)(p.ws + OFF_H), (const half_t*)(p.ws + OFF_WOUT), 1024}, S, E); }
            GRID_SYNC(); EMU_DUMP("out");
            if (!(SKIP_MASK & 2048)) REPS(2048) ph_norm2(wb, p, l, g, nact, lds);
            GRID_SYNC(); EMU_DUMP("norm2");
            if (!(SKIP_MASK & 4096)) REPS(4096) ph_topk(wb, p, last ? 1 : 2, lds);
            GRID_SYNC(); EMU_DUMP("topk");
            if (!(SKIP_MASK & 8192)) REPS(8192) { pg8::ExpertOrder S; S.init(G, c); EpiUp E{(half_t*)(p.ws + OFF_HID)};
              pg8::gemm_phase(wb, lds, pg8::Gemm{(const half_t*)(p.ws + OFF_XE), (const half_t*)(p.ws + OFF_WUP), 1024}, S, E); }
            GRID_SYNC();
            if (!(SKIP_MASK & 16384)) REPS(16384) { pg8::ExpertOrder S; S.init(G, c); EpiDown E{(half_t*)(p.ws + OFF_YE), (const float*)(p.ws + OFF_AFF)};
              pg8::gemm_phase(wb, lds, pg8::Gemm{(const half_t*)(p.ws + OFF_HID), (const half_t*)(p.ws + OFF_WDN), 512}, S, E); }
            GRID_SYNC();
            if (!(SKIP_MASK & 32768)) ph_combine(wb, p, l, g, nact);
            if (!(SKIP_MASK & 2)) if (g == NGROUP - 1 && !last) ph_convert(wb, p, l + 1, lds);
            GRID_SYNC(); EMU_DUMP("combine");
        }
    }
}

#ifndef CPU_EMU
extern "C" void kernel_launch(void* const* d_in, const int* in_sizes, int n_in, void* d_out, int out_size, void* d_ws, size_t ws_size, hipStream_t stream) {
    (void)in_sizes; (void)n_in; (void)out_size;
    static int grid = 0;
    if (!grid) {
        int dev = 0, cus = 0, per_cu = 0;
        hipGetDevice(&dev);
        hipDeviceGetAttribute(&cus, hipDeviceAttributeMultiprocessorCount, dev);
        hipFuncSetAttribute((const void*)mega, hipFuncAttributeMaxDynamicSharedMemorySize, SMEM_BYTES);
        hipOccupancyMaxActiveBlocksPerMultiprocessor(&per_cu, (const void*)mega, NT, SMEM_BYTES);
        if (per_cu < 1) per_cu = 1;
        grid = cus;
        if (ws_size < WS_TOTAL) fprintf(stderr, "workspace too small: %zu < %zu\n", ws_size, (size_t)WS_TOTAL);
    }
    hipMemsetAsync((unsigned char*)d_ws + OFF_BAR, 0, 16384, stream);
    Params p{};
    for (int i = 0; i < 34; ++i) p.in[i] = (const float*)d_in[i];
    p.out = (float*)d_out; p.ws = (unsigned char*)d_ws;
    hipLaunchKernelGGL(mega, dim3(grid), dim3(NT), SMEM_BYTES, stream, p);
}
#endif
```

```cpp
#ifndef CPU_EMU
#include <hip/hip_runtime.h>
#include <cstdio>
#include <cstdint>
typedef _Float16 half_t;
typedef _Float16 half8 __attribute__((ext_vector_type(8)));
typedef _Float16 half4 __attribute__((ext_vector_type(4)));
typedef float f32x4 __attribute__((ext_vector_type(4)));
typedef float f32x2 __attribute__((ext_vector_type(2)));
#define LAS __attribute__((address_space(3)))
#define SYNC() __syncthreads()
#define WAVE_SYNC() __builtin_amdgcn_wave_barrier()
template <int M> __device__ __forceinline__ float shfl_xor_t(float v, int tid) {
    if constexpr (M < 32) return __int_as_float(__builtin_amdgcn_ds_swizzle(__float_as_int(v), (M << 10) | 0x1f));
    else return __int_as_float(__builtin_amdgcn_ds_bpermute(((tid ^ 32) & 63) << 2, __float_as_int(v)));
}
#define SHFL_XOR(v, m) shfl_xor_t<m>((v), tid)
#define LDS_ATOMIC_INC(p) __hip_atomic_fetch_add((p), 1u, __ATOMIC_RELAXED, __HIP_MEMORY_SCOPE_WORKGROUP)
#endif

#ifndef CFG_BATCH
#define CFG_BATCH 8
#define CFG_SEQ 4096
#define CFG_CTX 256
#define CFG_DEPTH 4
#define CFG_NGROUP 2
#endif
constexpr int BATCH = CFG_BATCH, SEQ = CFG_SEQ, CTXL = CFG_CTX, DEPTH = CFG_DEPTH, NGROUP = CFG_NGROUP;
#ifndef SKIP_MASK
#define SKIP_MASK 0
#endif
#ifndef REPEAT_MASK
#define REPEAT_MASK 0
#endif
#define REPS(bit) for (int rep_ = 0; rep_ < ((REPEAT_MASK & (bit)) ? 2 : 1); ++rep_)
constexpr int NT = 512;
constexpr int D = 1024;
constexpr int IN_COLS = 8608, NP = 8704;
constexpr int C_Z = 1536, C_BG = 2048;
constexpr int C_RWKV = 2064;
constexpr int C_ML = 3984, C_MLO = 5008, C_MLIG = 5520, C_MLFG = 5528;
constexpr int C_GATE = 5536;
constexpr int BG = BATCH / NGROUP;
constexpr int RL = BG * SEQ, RC = BG * CTXL, RG = RL + RC;
constexpr int RGP = (RG + 255) / 256 * 256;
constexpr int CAPL = SEQ / 8, CAPC = CTXL / 8;
constexpr int RPE = (BG * (CAPL + CAPC) + 255) / 256 * 256;
constexpr int TPE = RPE / 256;
constexpr int NCH = RGP / 64;
static_assert(RL % 256 == 0, "latent rows per group must be a multiple of 256");
static_assert(SEQ % 64 == 0 && CTXL % 64 == 0, "chunks");

constexpr size_t al256(size_t x) { return (x + 255) / 256 * 256; }
constexpr size_t cmax(size_t a, size_t b) { return a > b ? a : b; }
constexpr size_t OFF_BAR = 0;
constexpr size_t OFF_MOD = 16384;
constexpr size_t OFF_CTXR = al256(OFF_MOD + (size_t)DEPTH * (BATCH + 1) * 6144 * 4);
constexpr size_t OFF_WIN = al256(OFF_CTXR + (size_t)BATCH * CTXL * D * 4);
constexpr size_t OFF_WBR = al256(OFF_WIN + (size_t)NP * 1024 * 2);
constexpr size_t OFF_WOUT = al256(OFF_WBR + (size_t)3 * 1024 * 512 * 2);
constexpr size_t OFF_WUP = al256(OFF_WOUT + (size_t)1024 * 1024 * 2);
constexpr size_t OFF_WDN = al256(OFF_WUP + (size_t)16 * 1024 * 1024 * 2);
constexpr size_t OFF_WLORA = al256(OFF_WDN + (size_t)16 * 1024 * 512 * 2);
constexpr size_t OFF_H = al256(OFF_WLORA + (size_t)2560 * 384 * 2);
constexpr size_t OFF_P = al256(OFF_H + (size_t)RGP * 1024 * 2);
constexpr size_t SZ_XE = (size_t)16 * RPE * 1024 * 2, SZ_HID = (size_t)16 * RPE * 512 * 2;
constexpr size_t OFF_XE = OFF_P, OFF_HID = OFF_XE + SZ_XE, OFF_YE = OFF_HID + SZ_HID;
constexpr size_t OFF_GQKV = al256(OFF_P + cmax((size_t)RGP * NP * 2, 2 * SZ_XE + SZ_HID));
constexpr size_t OFF_BR = OFF_GQKV;
constexpr size_t OFF_GBG = al256(OFF_GQKV + (size_t)RGP * 1536 * 2);
constexpr size_t OFF_GTA = al256(OFF_GBG + (size_t)RGP * 16 * 4);
constexpr size_t OFF_GG = al256(OFF_GTA + (size_t)NCH * 4 * 2 * 2 * 4096 * 2);
constexpr size_t OFF_RW = al256(OFF_GG + (size_t)NCH * 4 * 2 * 64 * 4);
constexpr size_t OFF_RLO = al256(OFF_RW + (size_t)RGP * 4 * 512 * 2);
constexpr size_t OFF_SO = al256(OFF_RLO + (size_t)RGP * 2560 * 2);
constexpr size_t OFF_RLI = OFF_SO;
constexpr size_t OFF_SOG = OFF_SO, OFF_SOM = OFF_SOG + (size_t)2 * RGP * 512 * 2, OFF_SOR = OFF_SOM + (size_t)2 * RGP * 512 * 2;
constexpr size_t OFF_PROB = al256(OFF_SOR + (size_t)2 * RGP * 512 * 4);
constexpr size_t OFF_SLOT = al256(OFF_PROB + (size_t)RGP * 16 * 4);
constexpr size_t OFF_SEL = al256(OFF_SLOT + (size_t)RGP * 16 * 4);
constexpr size_t OFF_AFF = al256(OFF_SEL + (size_t)16 * RPE * 4);
constexpr size_t WS_TOTAL = al256(OFF_AFF + (size_t)16 * RPE * 4);
constexpr int SMEM_BYTES = 152 * 1024;

struct Params { const float* in[34]; float* out; unsigned char* ws; };
enum { I_X = 0, I_C, I_CTX, I_CCTX, I_ADAW, I_ADAB, I_N1G, I_N2G, I_WIN, I_GCONV, I_GALOG, I_GDTB, I_GNG, I_RMU, I_RW0, I_RWUP, I_RA0, I_RAUP, I_RGUP,
       I_RKK, I_RKA, I_RRK, I_RLNG, I_RLNB, I_MIB, I_MFB, I_MNG, I_WBR, I_WOUT, I_ROUT, I_W1, I_W3, I_W2, I_FING };

#ifndef CPU_EMU
__device__ __forceinline__ int tid_fresh(int wb) { int t; asm volatile("v_mbcnt_lo_u32_b32 %0, -1, 0\n\tv_mbcnt_hi_u32_b32 %0, -1, %0" : "=v"(t)); return wb + t; }
#else
static inline int tid_fresh(int) { return threadIdx.x; }
#endif
#ifndef CPU_EMU
__device__ __forceinline__ float fexp(float x) { return __builtin_amdgcn_exp2f(x * 1.4426950408889634f); }
__device__ __forceinline__ float flog(float x) { return __builtin_amdgcn_logf(x) * 0.6931471805599453f; }
__device__ __forceinline__ float frcp(float x) { return __builtin_amdgcn_rcpf(x); }
__device__ __forceinline__ float frsq(float x) { return __builtin_amdgcn_rsqf(x); }
#else
static inline float fexp(float x) { return expf(x); }
static inline float flog(float x) { return logf(x); }
static inline float frcp(float x) { return 1.f / x; }
static inline float frsq(float x) { return 1.f / sqrtf(x); }
#endif
__device__ __forceinline__ float sigm(float x) { return frcp(1.f + fexp(-x)); }
__device__ __forceinline__ float siluf(float x) { return x * frcp(1.f + fexp(-x)); }
__device__ __forceinline__ float ftanh(float x) { return 1.f - 2.f * frcp(1.f + fexp(2.f * x)); }
__device__ __forceinline__ float softplusf(float x) { const float t = fexp(x); return x > 15.f ? x : (t < 1e-3f ? t * (1.f - 0.5f * t) : flog(1.f + t)); }
#define wave_sum(x) wave_sum_(x, tid)
__device__ __forceinline__ float wave_sum_(float v, int tid) { v += SHFL_XOR(v, 32); v += SHFL_XOR(v, 16); v += SHFL_XOR(v, 8); v += SHFL_XOR(v, 4); v += SHFL_XOR(v, 2); v += SHFL_XOR(v, 1); return v; }

#ifndef CPU_EMU
#define MFMA16(a, b, c) __builtin_amdgcn_mfma_f32_16x16x32_f16((a), (b), (c), 0, 0, 0)
#else
#define MFMA16(a, b, c) emu_mfma16((a), (b), (c))
#endif
__device__ __forceinline__ half8 ldfrag(const LAS half_t* base, int row0, int ld, int k0, int lane) { return *(const LAS half8*)(base + (row0 + (lane & 15)) * ld + k0 + 8 * (lane >> 4)); }
__device__ __forceinline__ half4 cvt4(f32x4 v) { half4 o; o[0] = (half_t)v[0]; o[1] = (half_t)v[1]; o[2] = (half_t)v[2]; o[3] = (half_t)v[3]; return o; }

__device__ __forceinline__ const float* res_src(const Params& p, int l, int g, int r) {
    if (r < RL) { const size_t t = (size_t)(g * BG) * SEQ + r; return (l == 0 ? p.in[I_X] : p.out) + t * D; }
    const size_t t = (size_t)(g * BG) * CTXL + (r - RL); return (l == 0 ? p.in[I_CTX] : (const float*)(p.ws + OFF_CTXR)) + t * D;
}
__device__ __forceinline__ float* res_dst(const Params& p, int g, int r) {
    if (r < RL) { const size_t t = (size_t)(g * BG) * SEQ + r; return p.out + t * D; }
    const size_t t = (size_t)(g * BG) * CTXL + (r - RL); return (float*)(p.ws + OFF_CTXR) + t * D;
}
__device__ __forceinline__ const float* mod_row(const Params& p, int l, int g, int r) {
    const int s = r < RL ? (g * BG + r / SEQ) : BATCH; return (const float*)(p.ws + OFF_MOD) + ((size_t)l * (BATCH + 1) + s) * 6144;
}

#ifndef CPU_EMU
#define XB_TMO      128
#define XB_XCNT(j)  (256  + 64 * (j))
#define XB_XSUB(j)  (1280 + 64 * (j))
#define XB_XGEN(j)  (2304 + 64 * (j))
#define XB_TOP      3328
#define XB_TOPGEN   3392
#define XCD_BAR_WORDS 3456
#define XB_SPIN_CAP (1u << 22)
__device__ __forceinline__ unsigned xb_ld(unsigned* p)              { return __hip_atomic_load(p, __ATOMIC_RELAXED, __HIP_MEMORY_SCOPE_AGENT); }
__device__ __forceinline__ unsigned xb_add(unsigned* p, unsigned v) { return __hip_atomic_fetch_add(p, v, __ATOMIC_RELAXED, __HIP_MEMORY_SCOPE_AGENT); }
__device__ __forceinline__ unsigned xb_xcc_id() { return (unsigned)__builtin_amdgcn_s_getreg((3 << 11) | 20) & 0xFu; }
#define XB_SPIN(cond, bar) do { unsigned _sp = 0; while (cond) { __builtin_amdgcn_s_sleep(1); \
    if ((++_sp & 255u) == 0u) { if (xb_ld(&(bar)[XB_TMO])) break; if (_sp > XB_SPIN_CAP) { atomicAdd(&(bar)[XB_TMO], 1u); break; } } } } while (0)
struct XcdBarrier { unsigned* bar; unsigned x; volatile LAS unsigned* st; };
__device__ __forceinline__ XcdBarrier xcd_barrier_post(unsigned* bar, volatile LAS unsigned* st) {
    XcdBarrier b; b.bar = bar; b.x = xb_xcc_id(); b.st = st;
    if (threadIdx.x == 0) (void)xb_add(&bar[XB_XCNT(b.x)], 1u);
    return b;
}
__device__ __forceinline__ void xcd_barrier_complete(unsigned* bar, unsigned x, unsigned& nloc, unsigned& nx) {
    const unsigned G = gridDim.x * gridDim.y * gridDim.z;
    unsigned sum, cnt, mine, sp = 0u;
    for (;;) {
        sum = 0u; cnt = 0u; mine = 0u;
#pragma unroll
        for (unsigned j = 0; j < 16; ++j) { const unsigned c = xb_ld(&bar[XB_XCNT(j)]); sum += c; cnt += (c > 0u) ? 1u : 0u; mine = (j == x) ? c : mine; }
        if (sum == G) break;
        __builtin_amdgcn_s_sleep(1);
        if ((++sp & 255u) == 0u) { if (xb_ld(&bar[XB_TMO])) break; if (sp > XB_SPIN_CAP) { atomicAdd(&bar[XB_TMO], 1u); break; } }
    }
    nloc = mine > 0u ? mine : 1u; nx = cnt > 0u ? cnt : 1u;
}
__device__ __forceinline__ void xcd_barrier(const XcdBarrier& b) {
    asm volatile("s_waitcnt vmcnt(0)" ::: "memory");
    __syncthreads();
    if (threadIdx.x == 0) {
        unsigned* bar = b.bar;
        __builtin_amdgcn_s_waitcnt(0);
        unsigned nloc = b.st[0], nx = b.st[1];
        if (nloc == 0u) { xcd_barrier_complete(bar, b.x, nloc, nx); b.st[0] = nloc; b.st[1] = nx; }
        const unsigned old = xb_add(&bar[XB_XSUB(b.x)], 1u);
        const unsigned gen = old / nloc;
        if (old + 1u == (gen + 1u) * nloc) {
            __builtin_amdgcn_fence(__ATOMIC_RELEASE, "agent");
            asm volatile("s_waitcnt vmcnt(0)" ::: "memory");
            const unsigned og = xb_add(&bar[XB_TOP], 1u);
            const unsigned tg = og / nx;
            if (og + 1u == (tg + 1u) * nx) xb_add(&bar[XB_TOPGEN], 1u);
            else XB_SPIN(xb_ld(&bar[XB_TOPGEN]) == tg, bar);
            __builtin_amdgcn_fence(__ATOMIC_ACQUIRE, "agent");
            xb_add(&bar[XB_XGEN(b.x)], 1u);
            asm volatile("s_waitcnt vmcnt(0)" ::: "memory");
        } else {
            XB_SPIN(xb_ld(&bar[XB_XGEN(b.x)]) == gen, bar);
            __builtin_amdgcn_fence(__ATOMIC_ACQUIRE, "agent");
            asm volatile("s_waitcnt vmcnt(0)" ::: "memory");
        }
    }
    __syncthreads();
}
#define GRID_SYNC() do { XcdBarrier gb_; gb_.bar = (unsigned*)(p.ws + OFF_BAR); gb_.x = xb_xcc_id(); gb_.st = (volatile LAS unsigned*)(lds + SMEM_BYTES - 16); xcd_barrier(gb_); } while (0)
#else
#define GRID_SYNC() emu_grid_sync()
#endif

namespace pg8 {
constexpr int BM = 256, BK = 64, HALF = 128, HTB = HALF * BK * 2, STAGE_BYTES = 8 * HTB, NXCD = 8, WGM = 8;
__host__ __device__ __forceinline__ int lds_byte(int r, int c) { const int st = (r >> 4) * 2 + (c >> 5), rr = r & 15, cc = c & 31, ob = rr * 64 + cc * 2; return st * 1024 + (ob ^ (((ob >> 9) & 1) << 5)); }
__host__ __device__ __forceinline__ void stage_rc(int b, int& R, int& C) { const int st = b / 1024, sb = b % 1024, swz = sb ^ (((sb >> 9) & 1) << 5); R = (st >> 1) * 16 + swz / 64; C = (st & 1) * 32 + (swz % 64) / 2; }
__host__ __device__ __forceinline__ int perm32(int rho) { const int n = rho >> 4, i = rho & 15; return 8 * (i >> 2) + 4 * n + (i & 3); }
struct Unit { int pm, pn, pb; };
struct Gemm { const half_t* A; const half_t* Bt; int K; };
struct StaticOrder {
    int nM, nN, nwg, G, c;
    __device__ void init(int nM_, int nN_, int G_, int c_) { nM = nM_; nN = nN_; nwg = nM * nN; G = G_; c = c_; }
    __device__ bool next(int i, Unit& u) const {
        const long L = (long)i * G + c; if (L >= nwg) return false;
        int wgid = (int)L; { const int q = nwg / NXCD, r = nwg % NXCD, xcd = wgid % NXCD, off = wgid / NXCD; wgid = (xcd < r ? xcd * (q + 1) : r * (q + 1) + (xcd - r) * q) + off; }
        const int nig = WGM * nN, gid = wgid / nig, fm = gid * WGM, gsz = (nM - fm) < WGM ? (nM - fm) : WGM;
        u.pm = fm + ((wgid % nig) % gsz); u.pn = (wgid % nig) / gsz; u.pb = u.pn; return true;
    }
};
struct ExpertOrder {
    int G, c;
    __device__ void init(int G_, int c_) { G = G_; c = c_; }
    __device__ bool next(int i, Unit& u) const {
        const long L = (long)i * G + c; if (L >= 16 * TPE * 4) return false;
        const int e = (int)L / (TPE * 4), rem = (int)L % (TPE * 4);
        u.pm = e * TPE + rem / 4; u.pn = rem % 4; u.pb = e * 4 + u.pn; return true;
    }
};

#ifndef CPU_EMU
template <class Epi, class Sched>
__device__ __forceinline__ void gemm_phase(int wb, LAS unsigned char* lds, const Gemm g, const Sched& S, const Epi& E) {
    const int tid = tid_fresh(wb), wid = __builtin_amdgcn_readfirstlane(tid >> 6), lane = tid & 63, wr = wid >> 2, wc = wid & 3, fr = lane & 15, fq = lane >> 4;
    const int K = g.K, nt = K / BK;
    unsigned voffA[2], voffB[2];
#pragma unroll
    for (int i = 0; i < 2; ++i) { int R, C; stage_rc(tid * 16 + i * 8192, R, C); const int Rb = Epi::PERM ? ((R & ~31) + perm32(R & 31)) : R;
        voffA[i] = (unsigned)(R * K + C) * 2u; voffB[i] = (unsigned)(Rb * K + C) * 2u; }
    const size_t kstep = (size_t)(BK * 2);
    const size_t hstep = (size_t)HALF * K * 2;
    const size_t tstep = 2 * hstep;
    const unsigned ldsw = (unsigned)wid * 1024u;
    const int aoff = lds_byte(wr * 64 + fr, fq * 8), boff = lds_byte(wc * 32 + fr, fq * 8);
#define PG8_SA(b, h) (((b) * 2 + (h)) * HTB)
#define PG8_SB(b, h) ((4 + (b) * 2 + (h)) * HTB)
#define PG8_STAGE(bufoff, gbase, voff) do { _Pragma("unroll") for (int _i = 0; _i < 2; ++_i) \
        __builtin_amdgcn_global_load_lds((const unsigned*)((const char*)(gbase) + (voff)[_i]), (LAS unsigned*)(lds + (bufoff) + ldsw + _i * 8192), 16, 0, 0); } while (0)
#define PG8_LDA(dst, b, h) do { _Pragma("unroll") for (int m = 0; m < 4; ++m) _Pragma("unroll") for (int k = 0; k < 2; ++k) dst[m][k] = *(const LAS half8*)(lds + PG8_SA(b, h) + aoff + m * 2048 + k * 1024); } while (0)
#define PG8_LDB(dst, b, h) do { _Pragma("unroll") for (int n = 0; n < 2; ++n) _Pragma("unroll") for (int k = 0; k < 2; ++k) dst[n][k] = *(const LAS half8*)(lds + PG8_SB(b, h) + boff + n * 2048 + k * 1024); } while (0)
#define PG8_MMA(ai, bj, At, Bt) do { __builtin_amdgcn_s_setprio(1); _Pragma("unroll") for (int m = 0; m < 4; ++m) _Pragma("unroll") for (int n = 0; n < 2; ++n) _Pragma("unroll") for (int k = 0; k < 2; ++k) \
        acc[ai][bj][m][n] = __builtin_amdgcn_mfma_f32_16x16x32_f16(Bt[n][k], At[m][k], acc[ai][bj][m][n], 0, 0, 0); __builtin_amdgcn_s_setprio(0); } while (0)
#define PG8_WAIT_V(n) asm volatile("s_waitcnt vmcnt(" #n ")" ::: "memory")
#define PG8_WAIT_L(n) asm volatile("s_waitcnt lgkmcnt(" #n ")" ::: "memory")
#define PG8_BAR __builtin_amdgcn_s_barrier()
#define PG8_SCHED __builtin_amdgcn_sched_barrier(0)
    Unit cur, nxt; int ui = 0;
    if (!S.next(0, cur)) return;
    f32x4 acc[2][2][4][2];
#pragma unroll
    for (int a = 0; a < 2; ++a)
#pragma unroll
        for (int b = 0; b < 2; ++b)
#pragma unroll
            for (int m = 0; m < 4; ++m)
#pragma unroll
                for (int n = 0; n < 2; ++n) acc[a][b][m][n] = (f32x4){0.f, 0.f, 0.f, 0.f};
    half8 At[4][2], B0[2][2], B1[2][2];
    const char* cA = (const char*)g.A + (size_t)cur.pm * tstep; const char* cB = (const char*)g.Bt + (size_t)cur.pb * tstep;
    PG8_STAGE(PG8_SB(0, 0), cB, voffB); PG8_STAGE(PG8_SA(0, 0), cA, voffA); PG8_STAGE(PG8_SB(0, 1), cB + hstep, voffB); PG8_STAGE(PG8_SA(0, 1), cA + hstep, voffA);
    if (wr == 1) PG8_BAR;
    PG8_WAIT_V(4); PG8_BAR;
    PG8_STAGE(PG8_SB(1, 0), cB + kstep, voffB); PG8_STAGE(PG8_SA(1, 0), cA + kstep, voffA); PG8_STAGE(PG8_SB(1, 1), cB + hstep + kstep, voffB);
    PG8_WAIT_V(6); PG8_BAR;
    for (;;) {
        const bool has_next = S.next(ui + 1, nxt);
        const char* nA = has_next ? (const char*)g.A + (size_t)nxt.pm * tstep : cA; const char* nB = has_next ? (const char*)g.Bt + (size_t)nxt.pb * tstep : cB;
#pragma unroll 1
        for (int t = 0; t < nt; t += 2) {
            const bool last = (t == nt - 2);
            const char* a1 = cA + (size_t)(t + 1) * kstep;
            const char* a2 = last ? nA : cA + (size_t)(t + 2) * kstep; const char* b2 = last ? nB : cB + (size_t)(t + 2) * kstep;
            const char* a3 = a2 + kstep; const char* b3 = b2 + kstep;
            PG8_LDB(B0, 0, 0); PG8_SCHED; PG8_LDA(At, 0, 0); PG8_STAGE(PG8_SA(1, 1), a1 + hstep, voffA);
            PG8_WAIT_L(8); PG8_BAR; PG8_WAIT_L(0); PG8_MMA(0, 0, At, B0); PG8_BAR; PG8_SCHED;
            PG8_LDB(B1, 0, 1); PG8_STAGE(PG8_SB(0, 0), b2, voffB);
            PG8_BAR; PG8_WAIT_L(0); PG8_MMA(0, 1, At, B1); PG8_BAR;
            PG8_LDA(At, 0, 1); PG8_STAGE(PG8_SA(0, 0), a2, voffA);
            PG8_BAR; PG8_WAIT_L(0); PG8_MMA(1, 0, At, B0); PG8_BAR; PG8_SCHED;
            PG8_STAGE(PG8_SB(0, 1), b2 + hstep, voffB);
            PG8_WAIT_V(6); PG8_BAR; PG8_MMA(1, 1, At, B1); PG8_BAR;
            PG8_LDB(B0, 1, 0); PG8_SCHED; PG8_LDA(At, 1, 0); PG8_STAGE(PG8_SA(0, 1), a2 + hstep, voffA);
            PG8_WAIT_L(8); PG8_BAR; PG8_WAIT_L(0); PG8_MMA(0, 0, At, B0); PG8_BAR; PG8_SCHED;
            PG8_LDB(B1, 1, 1); PG8_STAGE(PG8_SB(1, 0), b3, voffB);
            PG8_BAR; PG8_WAIT_L(0); PG8_MMA(0, 1, At, B1); PG8_BAR;
            PG8_LDA(At, 1, 1); PG8_STAGE(PG8_SA(1, 0), a3, voffA);
            PG8_BAR; PG8_WAIT_L(0); PG8_MMA(1, 0, At, B0); PG8_BAR; PG8_SCHED;
            PG8_STAGE(PG8_SB(1, 1), b3 + hstep, voffB);
            PG8_WAIT_V(6); PG8_BAR; PG8_MMA(1, 1, At, B1); PG8_BAR;
        }
        E(acc, cur, wr, wc, fr, fq);
        if (!has_next) break;
#pragma unroll
        for (int a = 0; a < 2; ++a)
#pragma unroll
            for (int b = 0; b < 2; ++b)
#pragma unroll
                for (int m = 0; m < 4; ++m)
#pragma unroll
                    for (int n = 0; n < 2; ++n) acc[a][b][m][n] = (f32x4){0.f, 0.f, 0.f, 0.f};
        cur = nxt; cA = nA; cB = nB; ++ui;
    }
    PG8_WAIT_V(0);
    if (wr == 0) PG8_BAR;
    PG8_BAR;
#undef PG8_SA
#undef PG8_SB
#undef PG8_STAGE
#undef PG8_LDA
#undef PG8_LDB
#undef PG8_MMA
#undef PG8_WAIT_V
#undef PG8_WAIT_L
#undef PG8_BAR
#undef PG8_SCHED
}
#else
static float* emu_fa[64]; static float* emu_fb[64];
template <class Epi, class Sched>
void gemm_phase(int wb, LAS unsigned char* lds, const Gemm g, const Sched& S, const Epi& E) {
    const int tid = tid_fresh(wb), wid = tid >> 6, lane = tid & 63, wr = wid >> 2, wc = wid & 3, fr = lane & 15, fq = lane >> 4;
    const int K = g.K; const int bid = blockIdx.x;
    Unit u;
    for (int ui = 0; S.next(ui, u); ++ui) {
        SYNC();
        if (tid == 0) {
            if (!emu_fa[bid]) { emu_fa[bid] = (float*)malloc(256 * 1024 * 4); emu_fb[bid] = (float*)malloc(256 * 1024 * 4); }
            for (int r = 0; r < 256; ++r) for (int k = 0; k < K; ++k) { emu_fa[bid][r * K + k] = (float)g.A[((size_t)u.pm * 256 + r) * K + k]; emu_fb[bid][r * K + k] = (float)g.Bt[((size_t)u.pb * 256 + r) * K + k]; }
        }
        SYNC();
        f32x4 acc[2][2][4][2];
        for (int ai = 0; ai < 2; ++ai) for (int bj = 0; bj < 2; ++bj) for (int m = 0; m < 4; ++m) for (int n = 0; n < 2; ++n) for (int i = 0; i < 4; ++i) {
            const int row = 128 * ai + 64 * wr + 16 * m + fr;
            const int col = Epi::PERM ? (128 * bj + 32 * wc + 8 * fq + 4 * n + i) : (128 * bj + 32 * wc + 16 * n + 4 * fq + i);
            const float* a = emu_fa[bid] + row * K; const float* b = emu_fb[bid] + col * K; float s = 0.f;
            for (int k = 0; k < K; ++k) s += a[k] * b[k];
            acc[ai][bj][m][n][i] = s; }
        E(acc, u, wr, wc, fr, fq);
    }
    SYNC();
}
#endif
}
using pg8::Unit;

struct EpiP {
    static constexpr bool PERM = true;
    half_t* P;
    __device__ __forceinline__ void operator()(const f32x4 (&acc)[2][2][4][2], const Unit& u, int wr, int wc, int fr, int fq) const {
        const int row0 = u.pm * 256 + wr * 64 + fr, col0 = u.pn * 256 + wc * 32 + 8 * fq;
#pragma unroll
        for (int bj = 0; bj < 2; ++bj) {
            const int col = col0 + bj * 128;
            const bool sg = (col >= C_GATE && col < IN_COLS) || (col >= C_MLO && col < C_MLIG);
#pragma unroll
            for (int ai = 0; ai < 2; ++ai)
#pragma unroll
                for (int m = 0; m < 4; ++m) {
                    half8 h;
#pragma unroll
                    for (int n = 0; n < 2; ++n)
#pragma unroll
                        for (int i = 0; i < 4; ++i) { float v = acc[ai][bj][m][n][i]; if (sg) v = sigm(v); h[4 * n + i] = (half_t)v; }
                    *(half8*)(P + (size_t)(row0 + ai * 128 + m * 16) * NP + col) = h;
                }
        }
    }
};
struct EpiLora {
    static constexpr bool PERM = true;
    half_t* O; const float* w0; const float* a0;
    __device__ __forceinline__ void operator()(const f32x4 (&acc)[2][2][4][2], const Unit& u, int wr, int wc, int fr, int fq) const {
        const int row0 = u.pm * 256 + wr * 64 + fr, col0 = u.pn * 256 + wc * 32 + 8 * fq;
#pragma unroll
        for (int bj = 0; bj < 2; ++bj) {
            const int col = col0 + bj * 128, blk = col >> 9;
            float bias[8];
#pragma unroll
            for (int j = 0; j < 8; ++j) bias[j] = blk < 2 ? w0[col + j] : (blk < 4 ? a0[col - 1024 + j] : 0.f);
#pragma unroll
            for (int ai = 0; ai < 2; ++ai)
#pragma unroll
                for (int m = 0; m < 4; ++m) {
                    half8 h;
#pragma unroll
                    for (int n = 0; n < 2; ++n)
#pragma unroll
                        for (int i = 0; i < 4; ++i) { float v = acc[ai][bj][m][n][i] + bias[4 * n + i];
                            if (blk < 2) v = sigm(v) * 0.6065306597126334f; else if (blk < 4) v = sigm(v);
                            h[4 * n + i] = (half_t)v; }
                    *(half8*)(O + (size_t)(row0 + ai * 128 + m * 16) * 2560 + col) = h;
                }
        }
    }
};
struct EpiMerge {
    static constexpr bool PERM = true;
    half_t* M; const half_t* P; int bi;
    __device__ __forceinline__ void operator()(const f32x4 (&acc)[2][2][4][2], const Unit& u, int wr, int wc, int fr, int fq) const {
        const int row0 = u.pm * 256 + wr * 64 + fr, col0 = u.pn * 256 + wc * 32 + 8 * fq;
#pragma unroll
        for (int ai = 0; ai < 2; ++ai)
#pragma unroll
            for (int m = 0; m < 4; ++m) {
                const size_t row = (size_t)(row0 + ai * 128 + m * 16);
#pragma unroll
                for (int bj = 0; bj < 2; ++bj) {
                    const int col = col0 + bj * 128;
                    const half8 gt = *(const half8*)(P + row * NP + C_GATE + bi * 1024 + col);
                    half8 o; if (bi > 0) o = *(const half8*)(M + row * 1024 + col);
#pragma unroll
                    for (int n = 0; n < 2; ++n)
#pragma unroll
                        for (int i = 0; i < 4; ++i) { float v = (float)gt[4 * n + i] * acc[ai][bj][m][n][i]; if (bi > 0) v += (float)o[4 * n + i]; o[4 * n + i] = (half_t)v; }
                    *(half8*)(M + row * 1024 + col) = o;
                }
            }
    }
};
struct EpiOut {
    static constexpr bool PERM = false;
    Params p; int l, g;
    __device__ __forceinline__ void operator()(const f32x4 (&acc)[2][2][4][2], const Unit& u, int wr, int wc, int fr, int fq) const {
        const int row0 = u.pm * 256 + wr * 64 + fr, col0 = u.pn * 256 + wc * 32 + 4 * fq;
#pragma unroll
        for (int ai = 0; ai < 2; ++ai)
#pragma unroll
            for (int m = 0; m < 4; ++m) {
                const int row = row0 + ai * 128 + m * 16;
                if (row < RG) {
                    const float* src = res_src(p, l, g, row); float* dst = res_dst(p, g, row); const float* md = mod_row(p, l, g, row) + 2 * 1024;
#pragma unroll
                    for (int bj = 0; bj < 2; ++bj)
#pragma unroll
                        for (int n = 0; n < 2; ++n) { const int col = col0 + bj * 128 + n * 16;
                            const f32x4 xo = *(const f32x4*)(src + col), mv = *(const f32x4*)(md + col);
                            *(f32x4*)(dst + col) = xo + mv * acc[ai][bj][m][n]; }
                }
            }
    }
};
struct EpiUp {
    static constexpr bool PERM = true;
    half_t* HID;
    __device__ __forceinline__ void operator()(const f32x4 (&acc)[2][2][4][2], const Unit& u, int wr, int wc, int fr, int fq) const {
        const int row0 = u.pm * 256 + wr * 64 + fr, col = u.pn * 128 + wc * 32 + 8 * fq;
#pragma unroll
        for (int ai = 0; ai < 2; ++ai)
#pragma unroll
            for (int m = 0; m < 4; ++m) {
                half8 h;
#pragma unroll
                for (int n = 0; n < 2; ++n)
#pragma unroll
                    for (int i = 0; i < 4; ++i) h[4 * n + i] = (half_t)(siluf(acc[ai][0][m][n][i]) * acc[ai][1][m][n][i]);
                *(half8*)(HID + (size_t)(row0 + ai * 128 + m * 16) * 512 + col) = h;
            }
    }
};
struct EpiDown {
    static constexpr bool PERM = true;
    half_t* YE; const float* AFF;
    __device__ __forceinline__ void operator()(const f32x4 (&acc)[2][2][4][2], const Unit& u, int wr, int wc, int fr, int fq) const {
        const int row0 = u.pm * 256 + wr * 64 + fr, col0 = u.pn * 256 + wc * 32 + 8 * fq;
#pragma unroll
        for (int ai = 0; ai < 2; ++ai)
#pragma unroll
            for (int m = 0; m < 4; ++m) {
                const size_t row = (size_t)(row0 + ai * 128 + m * 16); const float af = AFF[row];
#pragma unroll
                for (int bj = 0; bj < 2; ++bj) {
                    half8 h;
#pragma unroll
                    for (int n = 0; n < 2; ++n)
#pragma unroll
                        for (int i = 0; i < 4; ++i) h[4 * n + i] = (half_t)(acc[ai][bj][m][n][i] * af);
                    *(half8*)(YE + row * 1024 + col0 + bj * 128) = h;
                }
            }
    }
};

__device__ __forceinline__ void ph_mod(int wb, const Params& p, LAS unsigned char* lds) {
    LAS float* sv = (LAS float*)lds; LAS float* red = sv + (BATCH + 1) * 1024;
    const int tid = tid_fresh(wb);
    for (int i = tid; i < (BATCH + 1) * 1024; i += NT) { const int s = i >> 10, k = i & 1023; const float cv = s < BATCH ? p.in[I_C][s * 1024 + k] : p.in[I_CCTX][k]; sv[i] = siluf(cv); }
    SYNC();
    float* mod = (float*)(p.ws + OFF_MOD);
    for (int item = blockIdx.x; item < DEPTH * 48; item += gridDim.x) {
        const int l = item / 48, j = (item % 48) * 128 + (tid & 127), kq = tid >> 7;
        float acc[BATCH + 1];
#pragma unroll
        for (int s = 0; s <= BATCH; ++s) acc[s] = 0.f;
        const float* w = p.in[I_ADAW] + (size_t)l * 1024 * 6144 + j;
        for (int k = kq * 256; k < kq * 256 + 256; ++k) { const float wv = w[(size_t)k * 6144];
#pragma unroll
            for (int s = 0; s <= BATCH; ++s) acc[s] += sv[s * 1024 + k] * wv; }
#pragma unroll
        for (int s = 0; s <= BATCH; ++s) red[tid * (BATCH + 1) + s] = acc[s];
        SYNC();
        if (tid < 128) {
#pragma unroll
            for (int s = 0; s <= BATCH; ++s) { float v = p.in[I_ADAB][l * 6144 + j];
                for (int q = 0; q < 4; ++q) v += red[(q * 128 + tid) * (BATCH + 1) + s];
                mod[((size_t)l * (BATCH + 1) + s) * 6144 + j] = v; }
        }
        SYNC();
    }
}

__device__ __forceinline__ void tconv_tile(int wb, const float* src, int sld, int k0, int n0, int nvalid, half_t* dst, int dld, int drow0, int dcol0, LAS float* tile) {
    const int tid = tid_fresh(wb), r = tid >> 4, c4 = (tid & 15) * 4;
#pragma unroll
    for (int j = 0; j < 2; ++j) { const int k = r + 32 * j; f32x4 v = {0.f, 0.f, 0.f, 0.f};
        if (src && n0 + c4 < nvalid) v = *(const f32x4*)(src + (size_t)(k0 + k) * sld + n0 + c4);
        tile[k * 65 + c4] = v[0]; tile[k * 65 + c4 + 1] = v[1]; tile[k * 65 + c4 + 2] = v[2]; tile[k * 65 + c4 + 3] = v[3]; }
    SYNC();
    const int n = tid >> 3, k8 = (tid & 7) * 8; half8 h;
#pragma unroll
    for (int i = 0; i < 8; ++i) h[i] = (half_t)tile[(k8 + i) * 65 + n];
    *(half8*)(dst + (size_t)(drow0 + n) * dld + dcol0 + k8) = h;
    SYNC();
}
__device__ __forceinline__ void ph_convert(int wb, const Params& p, int l, LAS unsigned char* lds) {
    LAS float* tile = (LAS float*)lds;
    constexpr int N_WIN = 16 * (NP / 64), N_WBR = 3 * 128, N_WOUT = 256, N_W13 = 2 * 2048, N_W2 = 2048, N_LORA = 240;
    constexpr int TOTAL = N_WIN + N_WBR + N_WOUT + N_W13 + N_W2 + N_LORA;
    half_t* ws16 = (half_t*)p.ws;
    for (int item = blockIdx.x; item < TOTAL; item += gridDim.x) {
        int it = item;
        if (it < N_WIN) { const int kt = it % 16, ntile = it / 16;
            tconv_tile(wb, p.in[I_WIN] + (size_t)l * 1024 * IN_COLS, IN_COLS, 64 * kt, 64 * ntile, IN_COLS, (half_t*)(p.ws + OFF_WIN), 1024, 64 * ntile, 64 * kt, tile); continue; }
        it -= N_WIN;
        if (it < N_WBR) { const int i = it / 128, rem = it % 128, kt = rem % 8, ntile = rem / 8;
            tconv_tile(wb, p.in[I_WBR] + (size_t)(l * 3 + i) * 512 * 1024, 1024, 64 * kt, 64 * ntile, 1024, (half_t*)(p.ws + OFF_WBR) + (size_t)i * 1024 * 512, 512, 64 * ntile, 64 * kt, tile); continue; }
        it -= N_WBR;
        if (it < N_WOUT) { const int kt = it % 16, ntile = it / 16;
            tconv_tile(wb, p.in[I_WOUT] + (size_t)l * 1024 * 1024, 1024, 64 * kt, 64 * ntile, 1024, (half_t*)(p.ws + OFF_WOUT), 1024, 64 * ntile, 64 * kt, tile); continue; }
        it -= N_WOUT;
        if (it < N_W13) { const int which = it / 2048, rem = it % 2048, e = rem / 128, r2 = rem % 128, kt = r2 % 16, ntile = r2 / 16, n0 = 64 * ntile;
            tconv_tile(wb, p.in[which ? I_W3 : I_W1] + (size_t)(l * 16 + e) * 1024 * 512, 512, 64 * kt, n0, 512, (half_t*)(p.ws + OFF_WUP) + (size_t)e * 1024 * 1024, 1024,
                       (n0 / 128) * 256 + which * 128 + (n0 % 128), 64 * kt, tile); continue; }
        it -= N_W13;
        if (it < N_W2) { const int e = it / 128, r2 = it % 128, kt = r2 % 8, ntile = r2 / 8;
            tconv_tile(wb, p.in[I_W2] + (size_t)(l * 16 + e) * 512 * 1024, 1024, 64 * kt, 64 * ntile, 1024, (half_t*)(p.ws + OFF_WDN) + (size_t)e * 1024 * 512, 512, 64 * ntile, 64 * kt, tile); continue; }
        it -= N_W2;
        { const int ntile = it / 6, kt = it % 6, n0 = 64 * ntile, blk = n0 / 512, nn0 = n0 % 512;
          const float* src = nullptr; int k0 = 0;
          if (blk == 0 && kt == 0) src = p.in[I_RWUP] + (size_t)(l * 2 + 0) * 64 * 512;
          else if (blk == 1 && kt == 1) src = p.in[I_RWUP] + (size_t)(l * 2 + 1) * 64 * 512;
          else if (blk == 2 && kt == 2) src = p.in[I_RAUP] + (size_t)(l * 2 + 0) * 64 * 512;
          else if (blk == 3 && kt == 3) src = p.in[I_RAUP] + (size_t)(l * 2 + 1) * 64 * 512;
          else if (blk == 4 && kt >= 4) { src = p.in[I_RGUP] + (size_t)l * 128 * 512; k0 = 64 * (kt - 4); }
          tconv_tile(wb, src, 512, k0, nn0, 512, (half_t*)(p.ws + OFF_WLORA), 384, n0, 64 * kt, tile); }
    }
    (void)ws16;
}

__device__ __forceinline__ void ph_norm1(int wb, const Params& p, int l, int g) {
    const int tid = tid_fresh(wb), wid = tid >> 6, lane = tid & 63;
    half_t* H = (half_t*)(p.ws + OFF_H);
    constexpr int RU = 4;
    const int rstep = gridDim.x * 8; const float* gn = p.in[I_N1G] + l * D;
    for (int r0 = blockIdx.x * 8 + wid; r0 < RGP; r0 += rstep * RU) {
        f32x4 v[RU][4]; float ss[RU];
#pragma unroll
        for (int u = 0; u < RU; ++u) { const int r = r0 + u * rstep;
#pragma unroll
            for (int j = 0; j < 4; ++j) v[u][j] = (f32x4){0.f, 0.f, 0.f, 0.f};
            if (r < RG) { const float* xr = res_src(p, l, g, r);
#pragma unroll
                for (int j = 0; j < 4; ++j) v[u][j] = *(const f32x4*)(xr + lane * 4 + 256 * j); } }
#pragma unroll
        for (int u = 0; u < RU; ++u) { float a = 0.f;
#pragma unroll
            for (int j = 0; j < 4; ++j) a += v[u][j][0] * v[u][j][0] + v[u][j][1] * v[u][j][1] + v[u][j][2] * v[u][j][2] + v[u][j][3] * v[u][j][3];
            ss[u] = a; }
#pragma unroll
        for (int u = 0; u < RU; ++u) ss[u] = wave_sum(ss[u]);
#pragma unroll
        for (int u = 0; u < RU; ++u) { const int r = r0 + u * rstep; if (r >= RGP) continue;
            if (r >= RG) { for (int j = 0; j < 4; ++j) *(half4*)(H + (size_t)r * D + lane * 4 + 256 * j) = (half4){0, 0, 0, 0}; continue; }
            const float* md = mod_row(p, l, g, r); const float rinv = frsq(ss[u] * (1.f / D) + 1e-6f);
#pragma unroll
            for (int j = 0; j < 4; ++j) { const int c = lane * 4 + 256 * j; const f32x4 gv = *(const f32x4*)(gn + c), sh = *(const f32x4*)(md + c), sc = *(const f32x4*)(md + 1024 + c);
                *(half4*)(H + (size_t)r * D + c) = cvt4(v[u][j] * rinv * gv * (sc + 1.f) + sh); } }
    }
}

struct RowGeo { int gw, gh, base, gr, gc; };
__device__ __forceinline__ RowGeo row_geo(int r) {
    RowGeo q; int i;
    if (r < RL) { const int bl = r / SEQ; i = r % SEQ; q.gw = 64; q.gh = SEQ / 64; q.base = bl * SEQ; }
    else { const int rr = r - RL, bl = rr / CTXL; i = rr % CTXL; q.gw = CTXL; q.gh = 1; q.base = RL + bl * CTXL; }
    q.gr = i / q.gw; q.gc = i % q.gw; return q;
}

__device__ __forceinline__ void ph_prep(int wb, const Params& p, int l, LAS unsigned char* lds) {
    const int tid = tid_fresh(wb), wid = tid >> 6, lane = tid & 63;
    LAS float* cw = (LAS float*)lds;
    for (int i = tid; i < 9 * 1536; i += NT) cw[i] = p.in[I_GCONV][(size_t)l * 9 * 1536 + i];
    SYNC();
    const half_t* P = (const half_t*)(p.ws + OFF_P);
    half_t* GQKV = (half_t*)(p.ws + OFF_GQKV); float* GBG = (float*)(p.ws + OFF_GBG);
    half_t* RW = (half_t*)(p.ws + OFF_RW); half_t* RLI = (half_t*)(p.ws + OFF_RLI);
    for (int r = blockIdx.x * 8 + wid; r < RG; r += gridDim.x * 8) {
        const RowGeo q = row_geo(r);
        float acc[3][8];
#pragma unroll
        for (int j = 0; j < 3; ++j)
#pragma unroll
            for (int e = 0; e < 8; ++e) acc[j][e] = 0.f;
        for (int kh = 0; kh < 3; ++kh) { const int nr = q.gr + kh - 1; if (nr < 0 || nr >= q.gh) continue;
            for (int kw = 0; kw < 3; ++kw) { const int nc = q.gc + kw - 1; if (nc < 0 || nc >= q.gw) continue;
                const size_t nrow = (size_t)(q.base + nr * q.gw + nc);
#pragma unroll
                for (int j = 0; j < 3; ++j) { const half8 pv = *(const half8*)(P + nrow * NP + j * 512 + 8 * lane); const LAS float* w = cw + (kh * 3 + kw) * 1536 + j * 512 + 8 * lane;
#pragma unroll
                    for (int e = 0; e < 8; ++e) acc[j][e] += (float)pv[e] * w[e]; } } }
#pragma unroll
        for (int j = 0; j < 3; ++j) {
            float ss = 0.f;
#pragma unroll
            for (int e = 0; e < 8; ++e) { acc[j][e] = siluf(acc[j][e]); ss += acc[j][e] * acc[j][e]; }
            float sc = 1.f;
            if (j < 2) { ss += SHFL_XOR(ss, 1); ss += SHFL_XOR(ss, 2); ss += SHFL_XOR(ss, 4); ss += SHFL_XOR(ss, 8); sc = frsq(ss + 1e-6f) * (j == 0 ? 0.08838834764831845f : 1.f); }
            half8 h;
#pragma unroll
            for (int e = 0; e < 8; ++e) h[e] = (half_t)(acc[j][e] * sc);
            *(half8*)(GQKV + (size_t)r * 1536 + j * 512 + 8 * lane) = h;
        }
        if (lane < 16) { const float x = (float)P[(size_t)r * NP + C_BG + lane];
            float o; if (lane < 8) o = sigm(x); else { const int idx = lane - 8; o = -fexp(p.in[I_GALOG][l * 8 + idx]) * softplusf(x + p.in[I_GDTB][l * 8 + idx]); }
            GBG[(size_t)r * 16 + lane] = o; }
        const int nb[4] = { q.gc > 0 ? r - 1 : -1, q.gc < q.gw - 1 ? r + 1 : -1, q.gr > 0 ? r - q.gw : -1, q.gr < q.gh - 1 ? r + q.gw : -1 };
        const float* mu = p.in[I_RMU] + (size_t)l * 1920;
        float kmix[8];
#pragma unroll
        for (int j = 0; j < 4; ++j) {
            if (j == 3 && lane >= 48) break;
            const int cj = j < 3 ? j * 512 + 8 * lane : 1536 + 8 * lane;
            const half8 self = *(const half8*)(P + (size_t)r * NP + C_RWKV + cj);
            half8 nv[4];
#pragma unroll
            for (int d = 0; d < 4; ++d) { if (nb[d] >= 0) nv[d] = *(const half8*)(P + (size_t)nb[d] * NP + C_RWKV + cj); else nv[d] = (half8){0, 0, 0, 0, 0, 0, 0, 0}; }
            float val[8];
#pragma unroll
            for (int e = 0; e < 8; ++e) { const float s = (float)self[e], nn = (float)nv[e & 3][e]; val[e] = s + (nn - s) * mu[cj + e]; }
            half8 h;
            if (j < 3) {
#pragma unroll
                for (int e = 0; e < 8; ++e) h[e] = (half_t)val[e];
                *(half8*)(RW + ((size_t)r * 4 + j) * 512 + 8 * lane) = h;
                if (j == 1) {
#pragma unroll
                    for (int e = 0; e < 8; ++e) kmix[e] = val[e]; }
            } else {
                const int c0 = 8 * lane;
#pragma unroll
                for (int e = 0; e < 8; ++e) { float v = val[e]; if (c0 < 128) v = ftanh(v); else if (c0 >= 256) v = sigm(v); h[e] = (half_t)v; }
                *(half8*)(RLI + (size_t)r * 384 + c0) = h;
            }
        }
        { float t[8], ss = 0.f; const float* kkw = p.in[I_RKK] + (size_t)l * 512 + 8 * lane;
#pragma unroll
          for (int e = 0; e < 8; ++e) { t[e] = kmix[e] * kkw[e]; ss += t[e] * t[e]; }
          ss += SHFL_XOR(ss, 1); ss += SHFL_XOR(ss, 2); ss += SHFL_XOR(ss, 4);
          const float sc = frsq(ss + 1e-6f); half8 h;
#pragma unroll
          for (int e = 0; e < 8; ++e) h[e] = (half_t)(t[e] * sc);
          *(half8*)(RW + ((size_t)r * 4 + 3) * 512 + 8 * lane) = h; }
    }
}

#ifndef CPU_EMU
__device__ __forceinline__ float shfl_up_f(float v, int off, int lane) { const float o = __int_as_float(__builtin_amdgcn_ds_bpermute(((lane - off) & 63) << 2, __float_as_int(v))); return lane >= off ? o : v; }
#else
static inline float shfl_up_f(float v, int off, int lane) { const float o = emu_shfl(v, (lane - off) & 63); return lane >= off ? o : v; }
#endif
__device__ __forceinline__ void ph_wy(int wb, const Params& p, LAS unsigned char* lds) {
#ifndef CPU_EMU
    const int tid = tid_fresh(wb), wid = __builtin_amdgcn_readfirstlane(tid >> 6), lane = tid & 63, fr = lane & 15, fq = lane >> 4;
#else
    const int tid = tid_fresh(wb), wid = tid >> 6, lane = tid & 63, fr = lane & 15, fq = lane >> 4;
#endif
    const int slot = wid >> 1, d = wid & 1;
    LAS half_t* Lm = (LAS half_t*)(lds + wid * 16896);
    LAS half_t* Xm = Lm + 4096;
    LAS float* Gv = (LAS float*)(Xm + 4096);
    LAS float* Bv = Gv + 64;
    const half_t* GQKV = (const half_t*)(p.ws + OFF_GQKV); const float* GBG = (const float*)(p.ws + OFF_GBG);
    half_t* GTA = (half_t*)(p.ws + OFF_GTA); float* GG = (float*)(p.ws + OFF_GG);
    constexpr int n_items = (RG / 64) * 4;
    SYNC();
    for (int base = blockIdx.x * 4; base < n_items; base += gridDim.x * 4) {
        const int item = base + slot;
        if (item < n_items) {
            const int cidx = item >> 2, h = item & 3, r0 = cidx * 64;
            const size_t tb = (size_t)((cidx * 4 + h) * 2 + d);
            { const int nat = d ? 63 - lane : lane; const float beta = GBG[(size_t)(r0 + nat) * 16 + d * 4 + h]; float G = GBG[(size_t)(r0 + nat) * 16 + 8 + d * 4 + h];
#pragma unroll
              for (int off = 1; off < 64; off <<= 1) { const float o = shfl_up_f(G, off, lane); G = lane >= off ? G + o : G; }
              Gv[lane] = G; Bv[lane] = beta; GG[tb * 64 + lane] = G; }
            WAVE_SYNC();
            half8 kf[4][4];
#pragma unroll
            for (int t = 0; t < 4; ++t)
#pragma unroll
                for (int ks = 0; ks < 4; ++ks) kf[t][ks] = *(const half8*)(GQKV + (size_t)(r0 + 16 * t + fr) * 1536 + 512 + h * 128 + 32 * ks + 8 * fq);
#pragma unroll
            for (int ti = 0; ti < 4; ++ti)
#pragma unroll
                for (int tj = 0; tj < 4; ++tj) {
                    if (d ? (tj < ti) : (tj > ti)) continue;
                    f32x4 acc = {0.f, 0.f, 0.f, 0.f};
#pragma unroll
                    for (int ks = 0; ks < 4; ++ks) acc = MFMA16(kf[tj][ks], kf[ti][ks], acc);
                    const int i = 16 * ti + fr, ip = d ? 63 - i : i; const float gi = Gv[ip], bi = Bv[ip]; f32x4 val;
#pragma unroll
                    for (int e = 0; e < 4; ++e) { const int j = 16 * tj + 4 * fq + e, jp = d ? 63 - j : j; val[e] = (jp < ip) ? bi * acc[e] * fexp(gi - Gv[jp]) : 0.f; }
                    if (d) *(LAS half4*)(Lm + ip * 64 + 60 - 16 * tj - 4 * fq) = cvt4((f32x4){val[3], val[2], val[1], val[0]});
                    else *(LAS half4*)(Lm + ip * 64 + 16 * tj + 4 * fq) = cvt4(val);
                }
#pragma unroll
            for (int ti = 0; ti < 4; ++ti) {
                half8 qf[4];
#pragma unroll
                for (int ks = 0; ks < 4; ++ks) qf[ks] = *(const half8*)(GQKV + (size_t)(r0 + 16 * ti + fr) * 1536 + h * 128 + 32 * ks + 8 * fq);
#pragma unroll
                for (int tj = 0; tj < 4; ++tj) {
                    const int i = 16 * ti + fr, ip = d ? 63 - i : i; f32x4 val = {0.f, 0.f, 0.f, 0.f};
                    if (!(d ? (tj < ti) : (tj > ti))) {
                        f32x4 acc = {0.f, 0.f, 0.f, 0.f};
#pragma unroll
                        for (int ks = 0; ks < 4; ++ks) acc = MFMA16(kf[tj][ks], qf[ks], acc);
                        const float gi = Gv[ip];
#pragma unroll
                        for (int e = 0; e < 4; ++e) { const int j = 16 * tj + 4 * fq + e, jp = d ? 63 - j : j; val[e] = (jp <= ip) ? acc[e] * fexp(gi - Gv[jp]) : 0.f; }
                    }
                    half_t* ap = GTA + (tb * 2 + 1) * 4096 + ip * 64;
                    if (d) *(half4*)(ap + 60 - 16 * tj - 4 * fq) = cvt4((f32x4){val[3], val[2], val[1], val[0]});
                    else *(half4*)(ap + 16 * tj + 4 * fq) = cvt4(val);
                }
            }
            WAVE_SYNC();
#pragma unroll 1
            for (int bi = 0; bi < 4; ++bi) {
                const LAS half_t* Lb = Lm + bi * 16 * 64; float a[16];
#pragma unroll
                for (int ii = 0; ii < 16; ++ii) a[ii] = (bi * 16 + ii == lane) ? 1.f : 0.f;
                for (int m = 0; m < bi * 16; ++m) { const float xm = (float)Xm[m * 64 + lane];
#pragma unroll
                    for (int ii = 0; ii < 16; ++ii) a[ii] -= (float)Lb[ii * 64 + m] * xm; }
#pragma unroll
                for (int ii = 0; ii < 16; ++ii) { float sacc = a[ii];
#pragma unroll
                    for (int mm = 0; mm < ii; ++mm) sacc -= (float)Lb[ii * 64 + bi * 16 + mm] * a[mm];
                    a[ii] = sacc; }
#pragma unroll
                for (int ii = 0; ii < 16; ++ii) Xm[(bi * 16 + ii) * 64 + lane] = (half_t)a[ii];
            }
            WAVE_SYNC();
#pragma unroll 1
            for (int t = 0; t < 8; ++t) { const int v = lane + 64 * t, i = v >> 3, j8 = (v & 7) * 8; const half8 x = *(const LAS half8*)(Xm + i * 64 + j8); half8 o;
#pragma unroll
                for (int e = 0; e < 8; ++e) o[e] = (half_t)((float)x[e] * Bv[j8 + e]);
                *(half8*)(GTA + (tb * 2 + 0) * 4096 + i * 64 + j8) = o; }
            WAVE_SYNC();
        }
    }
    SYNC();
}

__device__ __forceinline__ void scan_gdn(int wb, const Params& p, int item, LAS unsigned char* lds) {
    const int tid = tid_fresh(wb), wid = tid >> 6, lane = tid & 63, fr = lane & 15, fq = lane >> 4;
    const int d = item & 1, h = (item >> 1) & 3, bl = item >> 3;
    constexpr int L72 = 72, L136 = 136;
    LAS half_t* kT = (LAS half_t*)lds;
    LAS half_t* vT = kT + 128 * L72;
    LAS half_t* VNs = vT + 128 * L72;
    LAS half_t* Tb = VNs + 128 * L72;
    LAS half_t* Tbe = Tb + 64 * L72;
    LAS half_t* Am = Tbe + 64 * L72;
    LAS half_t* Qg = Am + 64 * L72;
    LAS half_t* Wn = Qg + 64 * L136;
    LAS half_t* ST = Wn + 64 * L136;
    LAS float* Es = (LAS float*)(ST + 128 * L136);
    const half_t* GQKV = (const half_t*)(p.ws + OFF_GQKV);
    const half_t* GTA = (const half_t*)(p.ws + OFF_GTA); const float* GG = (const float*)(p.ws + OFF_GG);
    half_t* SOG = (half_t*)(p.ws + OFF_SOG) + (size_t)d * RGP * 512;
    SYNC();
    for (int i = tid; i < 128 * L136 / 8; i += NT) *(LAS half8*)(ST + i * 8) = (half8){0, 0, 0, 0, 0, 0, 0, 0};
    f32x4 accS[8];
#pragma unroll
    for (int u = 0; u < 8; ++u) accS[u] = (f32x4){0.f, 0.f, 0.f, 0.f};
    constexpr int nchC = CTXL / 64, nchL = SEQ / 64, NCS = nchC + nchL;
    half8 pT, pA, pq[2], pk[2], pv[2]; f32x4 pg0, pg1; float pgi[2], pG = 0.f, pGl = 0.f; int nr0 = 0, cr0 = 0;
    const int ti = tid >> 3, tj8 = (tid & 7) * 8;
    auto issue = [&](int cs) {
        const bool isc = cs < nchC; const int cl = isc ? cs : cs - nchC, nch = isc ? nchC : nchL, cn = d ? nch - 1 - cl : cl;
        const int r0 = (isc ? RL + bl * CTXL : bl * SEQ) + cn * 64; nr0 = r0;
        const size_t tb = (size_t)(((r0 >> 6) * 4 + h) * 2 + d);
        pT = *(const half8*)(GTA + (tb * 2 + 0) * 4096 + ti * 64 + tj8); pA = *(const half8*)(GTA + (tb * 2 + 1) * 4096 + ti * 64 + tj8);
        pg0 = *(const f32x4*)(GG + tb * 64 + tj8); pg1 = *(const f32x4*)(GG + tb * 64 + tj8 + 4);
#pragma unroll
        for (int t = 0; t < 2; ++t) { const int v = tid + NT * t, i = v >> 4, c8 = (v & 15) * 8, nat = d ? 63 - i : i;
            pq[t] = *(const half8*)(GQKV + (size_t)(r0 + nat) * 1536 + h * 128 + c8); pgi[t] = GG[tb * 64 + i]; }
#pragma unroll
        for (int t = 0; t < 2; ++t) { const int g = wid + 8 * t, nat = d ? 63 - lane : lane;
            pk[t] = *(const half8*)(GQKV + (size_t)(r0 + nat) * 1536 + 512 + h * 128 + 8 * g); pv[t] = *(const half8*)(GQKV + (size_t)(r0 + nat) * 1536 + 1024 + h * 128 + 8 * g); }
        pG = GG[tb * 64 + (tid & 63)]; pGl = GG[tb * 64 + 63];
    };
    issue(0);
    for (int cs = 0; cs < NCS; ++cs) {
        SYNC();
        { half8 te; const float ge[8] = {pg0[0], pg0[1], pg0[2], pg0[3], pg1[0], pg1[1], pg1[2], pg1[3]};
#pragma unroll
          for (int e = 0; e < 8; ++e) te[e] = (half_t)((float)pT[e] * fexp(ge[e]));
          *(LAS half8*)(Tb + ti * L72 + tj8) = pT; *(LAS half8*)(Tbe + ti * L72 + tj8) = te; *(LAS half8*)(Am + ti * L72 + tj8) = pA; }
#pragma unroll
        for (int t = 0; t < 2; ++t) { const int v = tid + NT * t, i = v >> 4, c8 = (v & 15) * 8; const float sc = fexp(pgi[t]); half8 o;
#pragma unroll
            for (int e = 0; e < 8; ++e) o[e] = (half_t)((float)pq[t][e] * sc);
            *(LAS half8*)(Qg + i * L136 + c8) = o; }
#pragma unroll
        for (int t = 0; t < 2; ++t) { const int g = wid + 8 * t;
#pragma unroll
            for (int e = 0; e < 8; ++e) { kT[(8 * g + e) * L72 + lane] = pk[t][e]; vT[(8 * g + e) * L72 + lane] = pv[t][e]; } }
        if (tid < 64) Es[tid] = fexp(pGl - pG);
        const float dec = fexp(pGl);
        cr0 = nr0;
        if (cs + 1 < NCS) issue(cs + 1);
        SYNC();
        { f32x4 acc[4];
#pragma unroll
          for (int t = 0; t < 4; ++t) acc[t] = (f32x4){0.f, 0.f, 0.f, 0.f};
#pragma unroll
          for (int k2 = 0; k2 < 2; ++k2) { const half8 a = ldfrag(kT, 16 * wid, L72, 32 * k2, lane);
#pragma unroll
              for (int t = 0; t < 4; ++t) acc[t] = MFMA16(a, ldfrag(Tbe, 16 * t, L72, 32 * k2, lane), acc[t]); }
#pragma unroll
          for (int t = 0; t < 4; ++t) *(LAS half4*)(Wn + (16 * t + fr) * L136 + 16 * wid + 4 * fq) = cvt4(-acc[t]); }
        SYNC();
        { f32x4 acc[4];
#pragma unroll
          for (int t = 0; t < 4; ++t) acc[t] = (f32x4){0.f, 0.f, 0.f, 0.f};
#pragma unroll
          for (int k2 = 0; k2 < 2; ++k2) { const half8 b = ldfrag(vT, 16 * wid, L72, 32 * k2, lane);
#pragma unroll
              for (int t = 0; t < 4; ++t) acc[t] = MFMA16(ldfrag(Tb, 16 * t, L72, 32 * k2, lane), b, acc[t]); }
#pragma unroll
          for (int k4 = 0; k4 < 4; ++k4) { const half8 b = ldfrag(ST, 16 * wid, L136, 32 * k4, lane);
#pragma unroll
              for (int t = 0; t < 4; ++t) acc[t] = MFMA16(ldfrag(Wn, 16 * t, L136, 32 * k4, lane), b, acc[t]); }
          WAVE_SYNC();
#pragma unroll
          for (int t = 0; t < 4; ++t) { const f32x4 es = *(const LAS f32x4*)(Es + 16 * t + 4 * fq);
              *(LAS half4*)(vT + (16 * wid + fr) * L72 + 16 * t + 4 * fq) = cvt4(acc[t]); *(LAS half4*)(VNs + (16 * wid + fr) * L72 + 16 * t + 4 * fq) = cvt4(acc[t] * es); } }
        WAVE_SYNC();
        { f32x4 acc[4];
#pragma unroll
          for (int t = 0; t < 4; ++t) acc[t] = (f32x4){0.f, 0.f, 0.f, 0.f};
#pragma unroll
          for (int k4 = 0; k4 < 4; ++k4) { const half8 a = ldfrag(ST, 16 * wid, L136, 32 * k4, lane);
#pragma unroll
              for (int t = 0; t < 4; ++t) acc[t] = MFMA16(a, ldfrag(Qg, 16 * t, L136, 32 * k4, lane), acc[t]); }
#pragma unroll
          for (int k2 = 0; k2 < 2; ++k2) { const half8 a = ldfrag(vT, 16 * wid, L72, 32 * k2, lane);
#pragma unroll
              for (int t = 0; t < 4; ++t) acc[t] = MFMA16(a, ldfrag(Am, 16 * t, L72, 32 * k2, lane), acc[t]); }
#pragma unroll
          for (int t = 0; t < 4; ++t) { const int i = 16 * t + fr, nat = d ? 63 - i : i;
              *(half4*)(SOG + (size_t)(cr0 + nat) * 512 + h * 128 + 16 * wid + 4 * fq) = cvt4(acc[t]); } }
#pragma unroll
        for (int u = 0; u < 8; ++u) accS[u] = accS[u] * dec;
#pragma unroll
        for (int k2 = 0; k2 < 2; ++k2) { const half8 b = ldfrag(VNs, 16 * wid, L72, 32 * k2, lane);
#pragma unroll
            for (int u = 0; u < 8; ++u) accS[u] = MFMA16(ldfrag(kT, 16 * u, L72, 32 * k2, lane), b, accS[u]); }
        WAVE_SYNC();
#pragma unroll
        for (int u = 0; u < 8; ++u) *(LAS half4*)(ST + (16 * wid + fr) * L136 + 16 * u + 4 * fq) = cvt4(accS[u]);
        WAVE_SYNC();
    }
}

__device__ __forceinline__ void scan_mlstm(int wb, const Params& p, int l, int item, LAS unsigned char* lds) {
    const int tid = tid_fresh(wb), wid = tid >> 6, lane = tid & 63, fr = lane & 15, fq = lane >> 4;
    const int d = item & 1, h = (item >> 1) & 3, bl = item >> 3;
    constexpr int L72 = 72;
    LAS half_t* q = (LAS half_t*)lds;
    LAS half_t* k = q + 64 * L72;
    LAS half_t* kT = k + 64 * L72;
    LAS half_t* vT = kT + 64 * L72;
    LAS half_t* Pm = vT + 128 * L72;
    LAS half_t* CT = Pm + 64 * L72;
    LAS half_t* nvec = CT + 128 * L72 + 64 * wid;
    LAS float* lfv = (LAS float*)(CT + 128 * L72 + 64 * 8);
    LAS float* igv = lfv + 64;
    LAS float* rowv = igv + 64;
    LAS float* colv = rowv + 64;
    LAS float* interv = colv + 64;
    LAS float* emtv = interv + 64;
    LAS float* wscv = emtv + 64;
    const half_t* P = (const half_t*)(p.ws + OFF_P);
    half_t* SOM = (half_t*)(p.ws + OFF_SOM) + (size_t)d * RGP * 512;
    const float ibias = p.in[I_MIB][l * 8 + d * 4 + h], fbias = p.in[I_MFB][l * 8 + d * 4 + h];
    SYNC();
    for (int i = tid; i < 128 * L72 / 8; i += NT) *(LAS half8*)(CT + i * 8) = (half8){0, 0, 0, 0, 0, 0, 0, 0};
    nvec[lane] = (half_t)0.f;
    f32x4 accC[4], accN[4];
#pragma unroll
    for (int u = 0; u < 4; ++u) { accC[u] = (f32x4){0.f, 0.f, 0.f, 0.f}; accN[u] = (f32x4){0.f, 0.f, 0.f, 0.f}; }
    float m = 0.f;
    constexpr int nchC = CTXL / 64, nchL = SEQ / 64, NCS = nchC + nchL;
    half8 pq, pk, pv[2]; half_t pig = (half_t)0.f, pfg = (half_t)0.f; int nr0 = 0, cr0 = 0;
    const half8 ones = {1, 1, 1, 1, 1, 1, 1, 1};
    auto issue = [&](int cs) {
        const bool isc = cs < nchC; const int cl = isc ? cs : cs - nchC, nch = isc ? nchC : nchL, cn = d ? nch - 1 - cl : cl;
        const int r0 = (isc ? RL + bl * CTXL : bl * SEQ) + cn * 64; nr0 = r0;
        const int nat = d ? 63 - lane : lane; const half_t* pr = P + (size_t)(r0 + nat) * NP + C_ML;
        pq = *(const half8*)(pr + h * 64 + 8 * wid); pk = *(const half8*)(pr + 256 + h * 64 + 8 * wid);
        pv[0] = *(const half8*)(pr + 512 + h * 128 + 8 * wid); pv[1] = *(const half8*)(pr + 512 + h * 128 + 8 * (wid + 8));
        if (tid < 64) { const half_t* pg = P + (size_t)(r0 + (d ? 63 - tid : tid)) * NP; pig = pg[C_MLIG + d * 4 + h]; pfg = pg[C_MLFG + d * 4 + h]; }
    };
    issue(0);
    for (int cs = 0; cs < NCS; ++cs) {
        SYNC();
        { half8 qs;
#pragma unroll
          for (int e = 0; e < 8; ++e) qs[e] = (half_t)((float)pq[e] * 0.125f);
          *(LAS half8*)(q + lane * L72 + 8 * wid) = qs; *(LAS half8*)(k + lane * L72 + 8 * wid) = pk;
#pragma unroll
          for (int e = 0; e < 8; ++e) { kT[(8 * wid + e) * L72 + lane] = pk[e]; vT[(8 * wid + e) * L72 + lane] = pv[0][e]; vT[(8 * (wid + 8) + e) * L72 + lane] = pv[1][e]; } }
        if (tid < 64) { igv[tid] = (float)pig + ibias; lfv[tid] = -softplusf(-((float)pfg + fbias)); }
        cr0 = nr0;
        if (cs + 1 < NCS) issue(cs + 1);
        SYNC();
        float dec;
        { float b = lfv[lane];
#pragma unroll
          for (int off = 1; off < 64; off <<= 1) { const float o = shfl_up_f(b, off, lane); b = lane >= off ? b + o : b; }
          const float cm = igv[lane] - b; float pm = cm;
#pragma unroll
          for (int off = 1; off < 64; off <<= 1) { const float o = shfl_up_f(pm, off, lane); pm = lane >= off ? fmaxf(pm, o) : pm; }
#ifndef CPU_EMU
          const float b_last = __int_as_float(__builtin_amdgcn_readlane(__float_as_int(b), 63)), pm_last = __int_as_float(__builtin_amdgcn_readlane(__float_as_int(pm), 63));
#else
          const float b_last = emu_shfl(b, 63), pm_last = emu_shfl(pm, 63);
#endif
          const float mt = fmaxf(b + m, b + pm), m_new = fmaxf(b_last + m, b_last + pm_last);
          rowv[lane] = b - mt; colv[lane] = cm; interv[lane] = fexp(b + m - mt); emtv[lane] = fexp(-mt); wscv[lane] = fexp(b_last + cm - m_new);
          dec = fexp(b_last + m - m_new); m = m_new; }
        WAVE_SYNC();
#pragma unroll
        for (int tt = 0; tt < 2; ++tt) { const int idx = 2 * wid + tt, ti = idx >> 2, tj = idx & 3;
            f32x4 acc = {0.f, 0.f, 0.f, 0.f};
            if (tj <= ti) {
#pragma unroll
                for (int k2 = 0; k2 < 2; ++k2) acc = MFMA16(ldfrag(k, 16 * tj, L72, 32 * k2, lane), ldfrag(q, 16 * ti, L72, 32 * k2, lane), acc);
                const int i = 16 * ti + fr; const float rv = rowv[i]; const f32x4 cv = *(const LAS f32x4*)(colv + 16 * tj + 4 * fq);
#pragma unroll
                for (int e = 0; e < 4; ++e) { const int j = 16 * tj + 4 * fq + e; acc[e] = (j <= i) ? acc[e] * fexp(rv + cv[e]) : 0.f; }
            }
            *(LAS half4*)(Pm + (16 * ti + fr) * L72 + 16 * tj + 4 * fq) = cvt4(acc); }
        SYNC();
        { f32x4 a1[4], a2[4], d1[4], d2[4];
#pragma unroll
          for (int t = 0; t < 4; ++t) { a1[t] = (f32x4){0.f, 0.f, 0.f, 0.f}; a2[t] = a1[t]; d1[t] = a1[t]; d2[t] = a1[t]; }
#pragma unroll
          for (int k2 = 0; k2 < 2; ++k2) { const half8 ac = ldfrag(CT, 16 * wid, L72, 32 * k2, lane), av = ldfrag(vT, 16 * wid, L72, 32 * k2, lane);
              const half8 an = *(const LAS half8*)(nvec + 32 * k2 + 8 * fq);
#pragma unroll
              for (int t = 0; t < 4; ++t) { const half8 bq = ldfrag(q, 16 * t, L72, 32 * k2, lane), bp = ldfrag(Pm, 16 * t, L72, 32 * k2, lane);
                  a1[t] = MFMA16(ac, bq, a1[t]); a2[t] = MFMA16(av, bp, a2[t]); d1[t] = MFMA16(an, bq, d1[t]); d2[t] = MFMA16(ones, bp, d2[t]); } }
#pragma unroll
          for (int t = 0; t < 4; ++t) { const int i = 16 * t + fr, nat = d ? 63 - i : i; const float it = interv[i];
              const float den = it * d1[t][0] + d2[t][0], dn = frcp(fmaxf(fabsf(den), emtv[i]));
              *(half4*)(SOM + (size_t)(cr0 + nat) * 512 + h * 128 + 16 * wid + 4 * fq) = cvt4((a1[t] * it + a2[t]) * dn); } }
#pragma unroll
        for (int u = 0; u < 4; ++u) { accC[u] = accC[u] * dec; accN[u] = accN[u] * dec; }
#pragma unroll
        for (int k2 = 0; k2 < 2; ++k2) { const half8 bv = ldfrag(vT, 16 * wid, L72, 32 * k2, lane);
            const f32x4 w0 = *(const LAS f32x4*)(wscv + 32 * k2 + 8 * fq), w1 = *(const LAS f32x4*)(wscv + 32 * k2 + 8 * fq + 4);
#pragma unroll
            for (int u = 0; u < 4; ++u) { const half8 raw = ldfrag(kT, 16 * u, L72, 32 * k2, lane); half8 ak;
#pragma unroll
                for (int e = 0; e < 4; ++e) { ak[e] = (half_t)((float)raw[e] * w0[e]); ak[4 + e] = (half_t)((float)raw[4 + e] * w1[e]); }
                accC[u] = MFMA16(ak, bv, accC[u]); accN[u] = MFMA16(ak, ones, accN[u]); } }
        WAVE_SYNC();
#pragma unroll
        for (int u = 0; u < 4; ++u) { *(LAS half4*)(CT + (16 * wid + fr) * L72 + 16 * u + 4 * fq) = cvt4(accC[u]);
            if (fr == 0) *(LAS half4*)(nvec + 16 * u + 4 * fq) = cvt4(accN[u]); }
        WAVE_SYNC();
    }
}

#ifndef CPU_EMU
template <int CTRL> __device__ __forceinline__ float dpp_f(float v) { return __int_as_float(__builtin_amdgcn_update_dpp(0, __float_as_int(v), CTRL, 0xf, 0xf, true)); }
#define RED8(v) do { v += dpp_f<0xB1>(v); v += dpp_f<0x4E>(v); v += dpp_f<0x141>(v); } while (0)
#define RED16(v) do { RED8(v); v += dpp_f<0x140>(v); } while (0)
#else
#define RED8(v) do { v += emu_shfl_xor(v, 1); v += emu_shfl_xor(v, 2); v += emu_shfl_xor(v, 7); } while (0)
#define RED16(v) do { RED8(v); v += emu_shfl_xor(v, 15); } while (0)
#endif
__device__ __forceinline__ void scan_rwkv(int wb, const Params& p, int l, int item, LAS unsigned char* lds) {
#ifndef CPU_EMU
    const int tid = tid_fresh(wb), wid = __builtin_amdgcn_readfirstlane(tid >> 6), lane = tid & 63;
#else
    const int tid = tid_fresh(wb), wid = tid >> 6, lane = tid & 63;
#endif
    const int half = item & 1, d = (item >> 1) & 1, h = (item >> 2) & 7, bl = item >> 5;
    constexpr int NB = 16, REC = 388;
    LAS float* st = (LAS float*)lds;
    const half_t* RW = (const half_t*)(p.ws + OFF_RW); const half_t* RLO = (const half_t*)(p.ws + OFF_RLO);
    float* SOR = (float*)(p.ws + OFF_SOR) + (size_t)d * RGP * 512;
    constexpr int NSTEP = CTXL + SEQ, NBATCH = NSTEP / NB;
    auto step_row = [&](int sidx) -> size_t { return sidx < CTXL ? (size_t)(RL + bl * CTXL + (d ? CTXL - 1 - sidx : sidx)) : (size_t)(bl * SEQ + (d ? SEQ - 1 - (sidx - CTXL) : sidx - CTXL)); };
    SYNC();
    if (wid >= 4) {
        const int pt = tid - 256, lt = pt >> 4, cq = pt & 15, lc = h * 64 + 4 * cq;
        const f32x4 ka = *(const f32x4*)(p.in[I_RKA] + (size_t)l * 512 + lc);
        half4 g_r, g_k, g_v, g_kk, g_e, g_a;
        auto issue = [&](int n) { const size_t row = step_row(n * NB + lt);
            g_r = *(const half4*)(RW + (row * 4 + 0) * 512 + lc); g_k = *(const half4*)(RW + (row * 4 + 1) * 512 + lc); g_v = *(const half4*)(RW + (row * 4 + 2) * 512 + lc); g_kk = *(const half4*)(RW + (row * 4 + 3) * 512 + lc);
            g_e = *(const half4*)(RLO + row * 2560 + d * 512 + lc); g_a = *(const half4*)(RLO + row * 2560 + 1024 + d * 512 + lc); };
        auto stage = [&](int buf) { LAS float* o = st + (buf * NB + lt) * REC + 4 * cq; float br = 0.f, kr = 0.f; f32x4 oa, owr, ow, ob, okd, ov;
#pragma unroll
            for (int e = 0; e < 4; ++e) { const float r_ = (float)g_r[e], k_ = (float)g_k[e], kk = (float)g_kk[e], a_ = (float)g_a[e];
                const float w_ = fexp(-(float)g_e[e]), kd = k_ * (1.f + (a_ - 1.f) * ka[e]), b_ = kk * a_;
                oa[e] = -kk; owr[e] = w_ * r_; ow[e] = w_; ob[e] = b_; okd[e] = kd; ov[e] = (float)g_v[e]; br += b_ * r_; kr += kd * r_; }
            *(LAS f32x4*)(o) = oa; *(LAS f32x4*)(o + 64) = owr; *(LAS f32x4*)(o + 128) = ow; *(LAS f32x4*)(o + 192) = ob; *(LAS f32x4*)(o + 256) = okd; *(LAS f32x4*)(o + 320) = ov;
            RED16(br); RED16(kr);
            if (cq == 0) { LAS float* sc = st + (buf * NB + lt) * REC + 384; sc[0] = br; sc[1] = kr; } };
        issue(0); stage(0);
        if (NBATCH > 1) issue(1);
        SYNC();
        for (int n = 0; n < NBATCH; ++n) {
            if (n + 1 < NBATCH) { stage((n + 1) & 1); if (n + 2 < NBATCH) issue(n + 2); }
            SYNC();
        }
    } else {
        const int rr = 32 * half + 8 * wid + (lane >> 3), ks = lane & 7;
        f32x2 s2[4];
#pragma unroll
        for (int e = 0; e < 4; ++e) s2[e] = (f32x2){0.f, 0.f};
        SYNC();
        for (int n = 0; n < NBATCH; ++n) {
            const int buf = n & 1;
            float ysel = 0.f;
#pragma unroll 1
            for (int th = 0; th < NB / 4; ++th) {
                const int ksl = ks - 4 * (th & 1);
                f32x4 a0, a1, q0, q1, w0, w1, b0, b1, k0, k1; f32x2 sc; float vv;
#define RWKV_LOAD(T_) do { const LAS float* o = st + (buf * NB + (T_)) * REC; \
                a0 = *(const LAS f32x4*)(o + 8 * ks); a1 = *(const LAS f32x4*)(o + 8 * ks + 4); q0 = *(const LAS f32x4*)(o + 64 + 8 * ks); q1 = *(const LAS f32x4*)(o + 64 + 8 * ks + 4); \
                w0 = *(const LAS f32x4*)(o + 128 + 8 * ks); w1 = *(const LAS f32x4*)(o + 128 + 8 * ks + 4); b0 = *(const LAS f32x4*)(o + 192 + 8 * ks); b1 = *(const LAS f32x4*)(o + 192 + 8 * ks + 4); \
                k0 = *(const LAS f32x4*)(o + 256 + 8 * ks); k1 = *(const LAS f32x4*)(o + 256 + 8 * ks + 4); vv = o[320 + rr]; sc = *(const LAS f32x2*)(o + 384); } while (0)
#define LO2(v) __builtin_shufflevector(v, v, 0, 1)
#define HI2(v) __builtin_shufflevector(v, v, 2, 3)
                RWKV_LOAD(th * 4);
#pragma unroll
                for (int ti = 0; ti < 4; ++ti) {
                    const f32x4 ca0 = a0, ca1 = a1, cq0 = q0, cq1 = q1, cw0 = w0, cw1 = w1, cb0 = b0, cb1 = b1, ck0 = k0, ck1 = k1; const f32x2 csc = sc; const float cvv = vv;
                    if (ti < 3) RWKV_LOAD(th * 4 + ti + 1);
                    const f32x2 sa2 = s2[0] * LO2(ca0) + s2[1] * HI2(ca0) + s2[2] * LO2(ca1) + s2[3] * HI2(ca1);
                    const f32x2 yw2 = s2[0] * LO2(cq0) + s2[1] * HI2(cq0) + s2[2] * LO2(cq1) + s2[3] * HI2(cq1);
                    float sa = sa2[0] + sa2[1], yw = yw2[0] + yw2[1];
                    RED8(sa); RED8(yw);
                    const f32x2 sav = {sa, sa}, vvv = {cvv, cvv};
                    s2[0] = s2[0] * LO2(cw0) + (sav * LO2(cb0) + vvv * LO2(ck0)); s2[1] = s2[1] * HI2(cw0) + (sav * HI2(cb0) + vvv * HI2(ck0));
                    s2[2] = s2[2] * LO2(cw1) + (sav * LO2(cb1) + vvv * LO2(ck1)); s2[3] = s2[3] * HI2(cw1) + (sav * HI2(cb1) + vvv * HI2(ck1));
                    const float y = yw + sa * csc[0] + cvv * csc[1];
                    ysel = (ksl == ti) ? y : ysel;
#ifndef CPU_EMU
                    asm volatile("" ::: "memory");
#endif
                }
#undef RWKV_LOAD
#undef LO2
#undef HI2
                if (th & 1) SOR[step_row(n * NB + (th >> 1) * 8 + ks) * 512 + h * 64 + rr] = ysel;
            }
            SYNC();
        }
    }
}

__device__ __forceinline__ void ph_scan(int wb, const Params& p, int l, LAS unsigned char* lds) {
    constexpr int N_R = BG * 32, N_G = BG * 8, N_M = BG * 8;
    const int G = gridDim.x, c = blockIdx.x;
    if (!(SKIP_MASK & 65536)) for (int item = c; item < N_R; item += G) REPS(65536) { scan_rwkv(wb, p, l, item, lds); SYNC(); }
    if (!(SKIP_MASK & 131072)) for (int item = N_R + (((c - N_R) % G) + G) % G; item < N_R + N_G; item += G) REPS(131072) { scan_gdn(wb, p, item - N_R, lds); SYNC(); }
    if (!(SKIP_MASK & 262144)) for (int item = N_R + N_G + (((c - N_R - N_G) % G) + G) % G; item < N_R + N_G + N_M; item += G) REPS(262144) { scan_mlstm(wb, p, l, item - N_R - N_G, lds); SYNC(); }
}

__device__ __forceinline__ void ph_finish(int wb, const Params& p, int l, int nrows) {
    const int tid = tid_fresh(wb), wid = tid >> 6, lane = tid & 63, c = 8 * lane;
    const half_t* P = (const half_t*)(p.ws + OFF_P); const half_t* RW = (const half_t*)(p.ws + OFF_RW); const half_t* RLO = (const half_t*)(p.ws + OFF_RLO);
    const half_t* SOG = (const half_t*)(p.ws + OFF_SOG); const half_t* SOM = (const half_t*)(p.ws + OFF_SOM); const float* SOR = (const float*)(p.ws + OFF_SOR);
    half_t* BR = (half_t*)(p.ws + OFF_BR);
    for (int r = blockIdx.x * 8 + wid; r < nrows; r += gridDim.x * 8) {
        { const half8 o0 = *(const half8*)(SOG + (size_t)r * 512 + c), o1 = *(const half8*)(SOG + ((size_t)RGP + r) * 512 + c), z = *(const half8*)(P + (size_t)r * NP + C_Z + c);
          float o[8], ss = 0.f;
#pragma unroll
          for (int e = 0; e < 8; ++e) { o[e] = (float)o0[e] + (float)o1[e]; ss += o[e] * o[e]; }
          ss += SHFL_XOR(ss, 1); ss += SHFL_XOR(ss, 2); ss += SHFL_XOR(ss, 4); ss += SHFL_XOR(ss, 8);
          const float rinv = frsq(ss * (1.f / 128.f) + 1e-6f); const float* gn = p.in[I_GNG] + l * 128 + (c & 127); half8 out;
#pragma unroll
          for (int e = 0; e < 8; ++e) out[e] = (half_t)(o[e] * rinv * gn[e] * siluf((float)z[e]));
          *(half8*)(BR + (size_t)r * 512 + c) = out; }
        { float y[8], sm = 0.f;
#pragma unroll
          for (int e = 0; e < 8; ++e) { y[e] = SOR[(size_t)r * 512 + c + e] + SOR[((size_t)RGP + r) * 512 + c + e]; sm += y[e]; }
          sm += SHFL_XOR(sm, 1); sm += SHFL_XOR(sm, 2); sm += SHFL_XOR(sm, 4); const float mean = sm * (1.f / 64.f);
          float vs = 0.f;
#pragma unroll
          for (int e = 0; e < 8; ++e) { const float dlt = y[e] - mean; vs += dlt * dlt; }
          vs += SHFL_XOR(vs, 1); vs += SHFL_XOR(vs, 2); vs += SHFL_XOR(vs, 4); const float rinv = frsq(vs * (1.f / 64.f) + 64e-5f);
          const half8 rv = *(const half8*)(RW + ((size_t)r * 4 + 0) * 512 + c), kv = *(const half8*)(RW + ((size_t)r * 4 + 1) * 512 + c), vv = *(const half8*)(RW + ((size_t)r * 4 + 2) * 512 + c);
          const half8 a0 = *(const half8*)(RLO + (size_t)r * 2560 + 1024 + c), a1 = *(const half8*)(RLO + (size_t)r * 2560 + 1536 + c), gg = *(const half8*)(RLO + (size_t)r * 2560 + 2048 + c);
          const float* ka = p.in[I_RKA] + (size_t)l * 512 + c; const float* rk = p.in[I_RRK] + (size_t)l * 512 + c;
          float bc = 0.f;
#pragma unroll
          for (int e = 0; e < 8; ++e) bc += (float)rv[e] * (float)kv[e] * (2.f + ((float)a0[e] + (float)a1[e] - 2.f) * ka[e]) * rk[e];
          bc += SHFL_XOR(bc, 1); bc += SHFL_XOR(bc, 2); bc += SHFL_XOR(bc, 4);
          const float* lg = p.in[I_RLNG] + (size_t)l * 512 + c; const float* lb = p.in[I_RLNB] + (size_t)l * 512 + c; half8 out;
#pragma unroll
          for (int e = 0; e < 8; ++e) out[e] = (half_t)(((y[e] - mean) * rinv * lg[e] + lb[e] + bc * (float)vv[e]) * (float)gg[e]);
          *(half8*)(BR + ((size_t)RGP + r) * 512 + c) = out; }
        { const half8 h0 = *(const half8*)(SOM + (size_t)r * 512 + c), h1 = *(const half8*)(SOM + ((size_t)RGP + r) * 512 + c), og = *(const half8*)(P + (size_t)r * NP + C_MLO + c);
          float o[8], ss = 0.f;
#pragma unroll
          for (int e = 0; e < 8; ++e) { o[e] = (float)h0[e] + (float)h1[e]; ss += o[e] * o[e]; }
          ss += SHFL_XOR(ss, 1); ss += SHFL_XOR(ss, 2); ss += SHFL_XOR(ss, 4); ss += SHFL_XOR(ss, 8);
          const float rinv = frsq(ss * (1.f / 128.f) + 1e-6f); const float* gn = p.in[I_MNG] + l * 128 + (c & 127); half8 out;
#pragma unroll
          for (int e = 0; e < 8; ++e) out[e] = (half_t)(o[e] * rinv * gn[e] * (float)og[e]);
          *(half8*)(BR + ((size_t)2 * RGP + r) * 512 + c) = out; }
    }
}

__device__ __forceinline__ void ph_norm2(int wb, const Params& p, int l, int g, int nrows, LAS unsigned char* lds) {
    const int tid = tid_fresh(wb), wid = tid >> 6, lane = tid & 63;
    LAS float* rw = (LAS float*)lds;
    for (int i = tid; i < 1024 * 16; i += NT) rw[i] = p.in[I_ROUT][(size_t)l * 1024 * 16 + i];
    SYNC();
    half_t* H = (half_t*)(p.ws + OFF_H); float* PROB = (float*)(p.ws + OFF_PROB);
    constexpr int RU = 2;
    const int rstep = gridDim.x * 8; const float* gn = p.in[I_N2G] + l * D;
    for (int r0 = blockIdx.x * 8 + wid; r0 < nrows; r0 += rstep * RU) {
        f32x4 v[RU][4]; float ss[RU];
#pragma unroll
        for (int u = 0; u < RU; ++u) { const int r = r0 + u * rstep;
#pragma unroll
            for (int j = 0; j < 4; ++j) v[u][j] = (f32x4){0.f, 0.f, 0.f, 0.f};
            if (r < nrows) { const float* xr = res_dst(p, g, r);
#pragma unroll
                for (int j = 0; j < 4; ++j) v[u][j] = *(const f32x4*)(xr + lane * 4 + 256 * j); } }
#pragma unroll
        for (int u = 0; u < RU; ++u) { float a = 0.f;
#pragma unroll
            for (int j = 0; j < 4; ++j) a += v[u][j][0] * v[u][j][0] + v[u][j][1] * v[u][j][1] + v[u][j][2] * v[u][j][2] + v[u][j][3] * v[u][j][3];
            ss[u] = wave_sum(a); }
#pragma unroll
        for (int u = 0; u < RU; ++u) { const int r = r0 + u * rstep; if (r >= nrows) continue;
            const float* md = mod_row(p, l, g, r); const float rinv = frsq(ss[u] * (1.f / D) + 1e-6f);
            float lg[16];
#pragma unroll
            for (int e = 0; e < 16; ++e) lg[e] = 0.f;
#pragma unroll
            for (int j = 0; j < 4; ++j) { const int c = lane * 4 + 256 * j; const f32x4 gv = *(const f32x4*)(gn + c), sh = *(const f32x4*)(md + 3 * 1024 + c), sc = *(const f32x4*)(md + 4 * 1024 + c);
                const f32x4 hv = v[u][j] * rinv * gv * (sc + 1.f) + sh;
                *(half4*)(H + (size_t)r * D + c) = cvt4(hv);
#pragma unroll
                for (int i = 0; i < 4; ++i) { const LAS f32x4* wr4 = (const LAS f32x4*)(rw + (c + i) * 16);
#pragma unroll
                    for (int q = 0; q < 4; ++q) { const f32x4 w = wr4[q]; lg[4 * q] += hv[i] * w[0]; lg[4 * q + 1] += hv[i] * w[1]; lg[4 * q + 2] += hv[i] * w[2]; lg[4 * q + 3] += hv[i] * w[3]; } }
                asm volatile("" ::: "memory"); }
            float k8[8], k4[4], k2[2], k1;
            { const bool hi = lane & 32;
#pragma unroll
              for (int e = 0; e < 8; ++e) { const float snd = hi ? lg[e] : lg[e + 8]; k8[e] = (hi ? lg[e + 8] : lg[e]) + SHFL_XOR(snd, 32); } }
            { const bool hi = lane & 16;
#pragma unroll
              for (int e = 0; e < 4; ++e) { const float snd = hi ? k8[e] : k8[e + 4]; k4[e] = (hi ? k8[e + 4] : k8[e]) + SHFL_XOR(snd, 16); } }
            { const bool hi = lane & 8;
#pragma unroll
              for (int e = 0; e < 2; ++e) { const float snd = hi ? k4[e] : k4[e + 2]; k2[e] = (hi ? k4[e + 2] : k4[e]) + SHFL_XOR(snd, 8); } }
            { const bool hi = lane & 4; const float snd = hi ? k2[0] : k2[1]; k1 = (hi ? k2[1] : k2[0]) + SHFL_XOR(snd, 4); }
            k1 += SHFL_XOR(k1, 2); k1 += SHFL_XOR(k1, 1);
            float mx = k1; mx = fmaxf(mx, SHFL_XOR(mx, 4)); mx = fmaxf(mx, SHFL_XOR(mx, 8)); mx = fmaxf(mx, SHFL_XOR(mx, 16)); mx = fmaxf(mx, SHFL_XOR(mx, 32));
            const float ex = fexp(k1 - mx); float sum = ex; sum += SHFL_XOR(sum, 4); sum += SHFL_XOR(sum, 8); sum += SHFL_XOR(sum, 16); sum += SHFL_XOR(sum, 32);
            if ((lane & 3) == 0) PROB[(size_t)r * 16 + (lane >> 2)] = ex * frcp(sum); }
    }
}

__device__ __forceinline__ void ph_topk(int wb, const Params& p, int nstreams, LAS unsigned char* lds) {
    const int tid = tid_fresh(wb);
    LAS unsigned* pv = (LAS unsigned*)lds;
    LAS unsigned* hist = pv + (SEQ > CTXL ? SEQ : CTXL);
    LAS int* eqc = (LAS int*)(hist + 256);
    LAS int* gtc = eqc + 512;
    LAS int* posx = gtc + 512;
    LAS int* selrows = posx + 512;
    LAS unsigned* sh = (LAS unsigned*)(selrows + (CAPL > CAPC ? CAPL : CAPC));
    const float* PROB = (const float*)(p.ws + OFF_PROB); int* SLOT = (int*)(p.ws + OFF_SLOT); int* SEL = (int*)(p.ws + OFF_SEL); float* AFF = (float*)(p.ws + OFF_AFF);
    const half_t* H = (const half_t*)(p.ws + OFF_H); half_t* XE = (half_t*)(p.ws + OFF_XE);
    for (int item = blockIdx.x; item < nstreams * BG * 16; item += gridDim.x) {
        const int e = item & 15, bl = (item >> 4) % BG, stc = (item >> 4) / BG;
        const int n = stc ? CTXL : SEQ, cap = n / 8, row0 = stc ? RL + bl * CTXL : bl * SEQ, slot0 = stc ? BG * CAPL + bl * CAPC : bl * CAPL;
        for (int i = tid; i < n; i += NT) pv[i] = __float_as_uint(PROB[(size_t)(row0 + i) * 16 + e]);
        unsigned prefix = 0u, mask = 0u; int kth = cap;
        for (int pass = 3; pass >= 0; --pass) {
            if (tid < 256) hist[tid] = 0u;
            SYNC();
            for (int i = tid; i < n; i += NT) { const unsigned v = pv[i]; if ((v & mask) == prefix) LDS_ATOMIC_INC(&hist[(v >> (8 * pass)) & 255u]); }
            SYNC();
            if (tid == 0) { int cum = 0, b = 255; for (; b > 0; --b) { if (cum + (int)hist[b] >= kth) break; cum += (int)hist[b]; } sh[0] = (unsigned)b; sh[1] = (unsigned)(kth - cum); }
            SYNC();
            prefix |= sh[0] << (8 * pass); mask |= 0xFFu << (8 * pass); kth = (int)sh[1];
            SYNC();
        }
        const unsigned thr = prefix; const int need_eq = kth;
        const int per = (n + NT - 1) / NT, i0 = tid * per, i1 = (i0 + per < n) ? i0 + per : n;
        { int ce = 0, cg = 0; for (int i = i0; i < i1; ++i) { const unsigned v = pv[i]; ce += (v == thr); cg += (v > thr); } eqc[tid] = ce; gtc[tid] = cg; }
        SYNC();
        if (tid == 0) { int eq = 0, pos = 0; for (int t = 0; t < NT; ++t) { const int ce = eqc[t]; int take = need_eq - eq; take = take < 0 ? 0 : (take > ce ? ce : take);
                const int selc = gtc[t] + take; eqc[t] = eq; posx[t] = pos; eq += ce; pos += selc; } }
        SYNC();
        { int eqr = eqc[tid], pos = posx[tid];
          for (int i = i0; i < i1; ++i) { const unsigned v = pv[i]; const bool sel = v > thr || (v == thr && eqr < need_eq); if (v == thr) ++eqr; const int row = row0 + i;
              if (sel) { const int slot = slot0 + pos; SEL[e * RPE + slot] = row; AFF[e * RPE + slot] = __uint_as_float(v); SLOT[(size_t)row * 16 + e] = slot; selrows[pos] = row; ++pos; }
              else SLOT[(size_t)row * 16 + e] = -1; } }
        SYNC();
        for (int idx = tid; idx < cap * 128; idx += NT) { const int j = idx >> 7, v16 = idx & 127;
            *(half8*)(XE + ((size_t)e * RPE + slot0 + j) * 1024 + v16 * 8) = *(const half8*)(H + (size_t)selrows[j] * 1024 + v16 * 8); }
        SYNC();
    }
}

__device__ __forceinline__ void ph_combine(int wb, const Params& p, int l, int g, int nrows) {
    const int tid = tid_fresh(wb), wid = tid >> 6, lane = tid & 63;
    const int* SLOT = (const int*)(p.ws + OFF_SLOT); const half_t* YE = (const half_t*)(p.ws + OFF_YE);
    constexpr int RU = 4;
    const int rstep = gridDim.x * 8;
    for (int r0 = blockIdx.x * 8 + wid; r0 < nrows; r0 += rstep * RU) {
        float acc[RU][2][8]; f32x4 xv[RU][4];
#pragma unroll
        for (int u = 0; u < RU; ++u) { const int r = r0 + u * rstep;
#pragma unroll
            for (int j = 0; j < 2; ++j)
#pragma unroll
                for (int e = 0; e < 8; ++e) acc[u][j][e] = 0.f;
            if (r < nrows) { const float* xr = res_dst(p, g, r);
#pragma unroll
                for (int j = 0; j < 2; ++j) { xv[u][2 * j] = *(const f32x4*)(xr + 8 * lane + 512 * j); xv[u][2 * j + 1] = *(const f32x4*)(xr + 8 * lane + 512 * j + 4); }
                int sl[16];
#pragma unroll
                for (int q = 0; q < 4; ++q) { const int4 t = *(const int4*)(SLOT + (size_t)r * 16 + 4 * q); sl[4 * q] = t.x; sl[4 * q + 1] = t.y; sl[4 * q + 2] = t.z; sl[4 * q + 3] = t.w; }
#pragma unroll
                for (int ex = 0; ex < 16; ++ex) { if (sl[ex] < 0) continue;
#pragma unroll
                    for (int j = 0; j < 2; ++j) { const half8 y = *(const half8*)(YE + ((size_t)ex * RPE + sl[ex]) * 1024 + 8 * lane + 512 * j);
#pragma unroll
                        for (int e = 0; e < 8; ++e) acc[u][j][e] += (float)y[e]; } } } }
        float ss[RU];
#pragma unroll
        for (int u = 0; u < RU; ++u) { const int r = r0 + u * rstep; ss[u] = 0.f; if (r >= nrows) continue;
            const float* md = mod_row(p, l, g, r) + 5 * 1024;
#pragma unroll
            for (int j = 0; j < 2; ++j) { const f32x4 m0 = *(const f32x4*)(md + 8 * lane + 512 * j), m1 = *(const f32x4*)(md + 8 * lane + 512 * j + 4);
#pragma unroll
                for (int e = 0; e < 4; ++e) { xv[u][2 * j][e] += m0[e] * acc[u][j][e]; xv[u][2 * j + 1][e] += m1[e] * acc[u][j][4 + e];
                    ss[u] += xv[u][2 * j][e] * xv[u][2 * j][e] + xv[u][2 * j + 1][e] * xv[u][2 * j + 1][e]; } } }
        if (l == DEPTH - 1) {
#pragma unroll
            for (int u = 0; u < RU; ++u) ss[u] = wave_sum(ss[u]); }
#pragma unroll
        for (int u = 0; u < RU; ++u) { const int r = r0 + u * rstep; if (r >= nrows) continue;
            float* xr = res_dst(p, g, r);
            if (l == DEPTH - 1) { const float rinv = frsq(ss[u] * (1.f / D) + 1e-6f);
#pragma unroll
                for (int j = 0; j < 2; ++j) { const f32x4 f0 = *(const f32x4*)(p.in[I_FING] + 8 * lane + 512 * j), f1 = *(const f32x4*)(p.in[I_FING] + 8 * lane + 512 * j + 4);
                    xv[u][2 * j] = xv[u][2 * j] * rinv * f0; xv[u][2 * j + 1] = xv[u][2 * j + 1] * rinv * f1; } }
#pragma unroll
            for (int j = 0; j < 2; ++j) { *(f32x4*)(xr + 8 * lane + 512 * j) = xv[u][2 * j]; *(f32x4*)(xr + 8 * lane + 512 * j + 4) = xv[u][2 * j + 1]; } }
    }
}

#ifndef EMU_DUMP
#define EMU_DUMP(tag)
#endif
#ifndef CPU_EMU
extern __shared__ __attribute__((aligned(16))) unsigned char smem_raw[];
__global__ void __launch_bounds__(NT, 2) mega(Params p)
#else
void mega(Params p)
#endif
{
#ifndef CPU_EMU
    LAS unsigned char* lds = (LAS unsigned char*)smem_raw;
    volatile LAS unsigned* xbw = (volatile LAS unsigned*)(lds + SMEM_BYTES - 16);
    if (threadIdx.x == 0) { xbw[0] = 0u; xbw[1] = 0u; xbw[2] = 0u; xbw[3] = 0u; }
    __syncthreads();
    (void)xcd_barrier_post((unsigned*)(p.ws + OFF_BAR), xbw);
#else
    unsigned char* lds = emu_smem();
#endif
#ifndef CPU_EMU
    const int wb = __builtin_amdgcn_readfirstlane((int)threadIdx.x) & ~63;
#else
    const int wb = 0;
#endif
    const int G = gridDim.x, c = blockIdx.x;
    if (!(SKIP_MASK & 1)) ph_mod(wb, p, lds);
    if (!(SKIP_MASK & 2)) ph_convert(wb, p, 0, lds);
    GRID_SYNC();
    for (int l = 0; l < DEPTH; ++l) {
        const bool last = (l == DEPTH - 1);
        const int nact = last ? RL : RG;
        const int nactp = last ? RL : RGP;
        for (int g = 0; g < NGROUP; ++g) {
            if (!(SKIP_MASK & 4)) REPS(4) ph_norm1(wb, p, l, g);
            GRID_SYNC(); EMU_DUMP("norm1");
            if (!(SKIP_MASK & 8)) REPS(8) { pg8::StaticOrder S; S.init(RGP / 256, NP / 256, G, c); EpiP E{(half_t*)(p.ws + OFF_P)};
              pg8::gemm_phase(wb, lds, pg8::Gemm{(const half_t*)(p.ws + OFF_H), (const half_t*)(p.ws + OFF_WIN), 1024}, S, E); }
            GRID_SYNC(); EMU_DUMP("gemm_in");
            if (!(SKIP_MASK & 16)) REPS(16) ph_prep(wb, p, l, lds);
            GRID_SYNC(); EMU_DUMP("prep");
            if (!(SKIP_MASK & 32)) REPS(32) { pg8::StaticOrder S; S.init(RGP / 256, 10, G, c); EpiLora E{(half_t*)(p.ws + OFF_RLO), p.in[I_RW0] + (size_t)l * 1024, p.in[I_RA0] + (size_t)l * 1024};
              pg8::gemm_phase(wb, lds, pg8::Gemm{(const half_t*)(p.ws + OFF_RLI), (const half_t*)(p.ws + OFF_WLORA), 384}, S, E); }
            if (!(SKIP_MASK & 64)) REPS(64) ph_wy(wb, p, lds);
            GRID_SYNC(); EMU_DUMP("wy");
            if (!(SKIP_MASK & 128)) REPS(128) ph_scan(wb, p, l, lds);
            GRID_SYNC(); EMU_DUMP("scan");
            if (!(SKIP_MASK & 256)) REPS(256) ph_finish(wb, p, l, nact);
            GRID_SYNC(); EMU_DUMP("finish");
            if (!(SKIP_MASK & 512)) REPS(512)
#pragma unroll 1
            for (int bi = 0; bi < 3; ++bi) {
                pg8::StaticOrder S; S.init(nactp / 256, 4, G, c); EpiMerge E{(half_t*)(p.ws + OFF_H), (const half_t*)(p.ws + OFF_P), bi};
                pg8::gemm_phase(wb, lds, pg8::Gemm{(const half_t*)(p.ws + OFF_BR) + (size_t)bi * RGP * 512, (const half_t*)(p.ws + OFF_WBR) + (size_t)bi * 1024 * 512, 512}, S, E);
            }
            GRID_SYNC(); EMU_DUMP("merge");
            if (!(SKIP_MASK & 1024)) { pg8::StaticOrder S; S.init(nactp / 256, 4, G, c); EpiOut E{p, l, g};
              pg8::gemm_phase(wb, lds, pg8::Gemm{(const half_t*)(p.ws + OFF_H), (const half_t*)(p.ws + OFF_WOUT), 1024}, S, E); }
            GRID_SYNC(); EMU_DUMP("out");
            if (!(SKIP_MASK & 2048)) REPS(2048) ph_norm2(wb, p, l, g, nact, lds);
            GRID_SYNC(); EMU_DUMP("norm2");
            if (!(SKIP_MASK & 4096)) REPS(4096) ph_topk(wb, p, last ? 1 : 2, lds);
            GRID_SYNC(); EMU_DUMP("topk");
            if (!(SKIP_MASK & 8192)) REPS(8192) { pg8::ExpertOrder S; S.init(G, c); EpiUp E{(half_t*)(p.ws + OFF_HID)};
              pg8::gemm_phase(wb, lds, pg8::Gemm{(const half_t*)(p.ws + OFF_XE), (const half_t*)(p.ws + OFF_WUP), 1024}, S, E); }
            GRID_SYNC();
            if (!(SKIP_MASK & 16384)) REPS(16384) { pg8::ExpertOrder S; S.init(G, c); EpiDown E{(half_t*)(p.ws + OFF_YE), (const float*)(p.ws + OFF_AFF)};
              pg8::gemm_phase(wb, lds, pg8::Gemm{(const half_t*)(p.ws + OFF_HID), (const half_t*)(p.ws + OFF_WDN), 512}, S, E); }
            GRID_SYNC();
            if (!(SKIP_MASK & 32768)) ph_combine(wb, p, l, g, nact);
            if (!(SKIP_MASK & 2)) if (g == NGROUP - 1 && !last) ph_convert(wb, p, l + 1, lds);
            GRID_SYNC(); EMU_DUMP("combine");
        }
    }
}

#ifndef CPU_EMU
extern "C" void kernel_launch(void* const* d_in, const int* in_sizes, int n_in, void* d_out, int out_size, void* d_ws, size_t ws_size, hipStream_t stream) {
    (void)in_sizes; (void)n_in; (void)out_size;
    static int grid = 0;
    if (!grid) {
        int dev = 0, cus = 0, per_cu = 0;
        hipGetDevice(&dev);
        hipDeviceGetAttribute(&cus, hipDeviceAttributeMultiprocessorCount, dev);
        hipFuncSetAttribute((const void*)mega, hipFuncAttributeMaxDynamicSharedMemorySize, SMEM_BYTES);
        hipOccupancyMaxActiveBlocksPerMultiprocessor(&per_cu, (const void*)mega, NT, SMEM_BYTES);
        if (per_cu < 1) per_cu = 1;
        grid = cus;
        if (ws_size < WS_TOTAL) fprintf(stderr, "workspace too small: %zu < %zu\n", ws_size, (size_t)WS_TOTAL);
    }
    hipMemsetAsync((unsigned char*)d_ws + OFF_BAR, 0, 16384, stream);
    Params p{};
    for (int i = 0; i < 34; ++i) p.in[i] = (const float*)d_in[i];
    p.out = (float*)d_out; p.ws = (unsigned char*)d_ws;
    hipLaunchKernelGGL(mega, dim3(grid), dim3(NT), SMEM_BYTES, stream, p);
}
#endif
```

```cpp
#ifndef CPU_EMU
#include <hip/hip_runtime.h>
#include <cstdio>
#include <cstdint>
typedef _Float16 half_t;
typedef _Float16 half8 __attribute__((ext_vector_type(8)));
typedef _Float16 half4 __attribute__((ext_vector_type(4)));
typedef float f32x4 __attribute__((ext_vector_type(4)));
typedef float f32x2 __attribute__((ext_vector_type(2)));
#define LAS __attribute__((address_space(3)))
#define SYNC() __syncthreads()
#define WAVE_SYNC() __builtin_amdgcn_wave_barrier()
template <int M> __device__ __forceinline__ float shfl_xor_t(float v, int tid) {
    if constexpr (M < 32) return __int_as_float(__builtin_amdgcn_ds_swizzle(__float_as_int(v), (M << 10) | 0x1f));
    else return __int_as_float(__builtin_amdgcn_ds_bpermute(((tid ^ 32) & 63) << 2, __float_as_int(v)));
}
#define SHFL_XOR(v, m) shfl_xor_t<m>((v), tid)
#define LDS_ATOMIC_INC(p) __hip_atomic_fetch_add((p), 1u, __ATOMIC_RELAXED, __HIP_MEMORY_SCOPE_WORKGROUP)
#endif

#ifndef CFG_BATCH
#define CFG_BATCH 8
#define CFG_SEQ 4096
#define CFG_CTX 256
#define CFG_DEPTH 4
#define CFG_NGROUP 2
#endif
constexpr int BATCH = CFG_BATCH, SEQ = CFG_SEQ, CTXL = CFG_CTX, DEPTH = CFG_DEPTH, NGROUP = CFG_NGROUP;
#ifndef SKIP_MASK
#define SKIP_MASK 0
#endif
#ifndef WARM_WIN
#define WARM_WIN 0
#endif
#ifndef SANDBOX
#define SANDBOX 0
#endif
#ifndef SANDBOX_PV
#define SANDBOX_PV 1
#endif
#ifndef SANDBOX_A
#define SANDBOX_A 16
#define SANDBOX_B 8
#endif
#ifndef SANDBOX_EPI
#define SANDBOX_EPI EpiP
#define SANDBOX_EPI_ARG half_t*
#endif
#ifndef REPEAT_MASK
#define REPEAT_MASK 0
#endif
#define REPS(bit) for (int rep_ = 0; rep_ < ((REPEAT_MASK & (bit)) ? 2 : 1); ++rep_)
constexpr int NT = 512;
constexpr int D = 1024;
constexpr int IN_COLS = 8608, NP = 8704;
constexpr int C_Z = 1536, C_BG = 2048;
constexpr int C_RWKV = 2064;
constexpr int C_ML = 3984, C_MLO = 5008, C_MLIG = 5520, C_MLFG = 5528;
constexpr int C_GATE = 5536;
constexpr int BG = BATCH / NGROUP;
constexpr int RL = BG * SEQ;
constexpr int RCX = BATCH * CTXL;
constexpr int RGX = RL + RCX;
constexpr int RGP = (RGX + 255) / 256 * 256;
constexpr int CAPL = SEQ / 8, CAPC = CTXL / 8;
constexpr int RPE = (BG * CAPL + BATCH * CAPC + 255) / 256 * 256;
constexpr int TPE = RPE / 256;
constexpr int NCH = RGP / 64;
struct Geo { int rg, rgp, tpe; };
__host__ __device__ __forceinline__ Geo geo_of(int g) { Geo q; q.rg = RL + (g == 0 ? RCX : 0); q.rgp = (q.rg + 255) / 256 * 256; q.tpe = (BG * CAPL + (g == 0 ? BATCH * CAPC : 0) + 255) / 256; return q; }
static_assert(RL % 256 == 0, "latent rows per group must be a multiple of 256");
static_assert(SEQ % 64 == 0 && CTXL % 64 == 0, "chunks");

constexpr size_t al256(size_t x) { return (x + 255) / 256 * 256; }
constexpr size_t cmax(size_t a, size_t b) { return a > b ? a : b; }
constexpr size_t OFF_BAR = 0;
constexpr size_t OFF_MOD = 16384;
constexpr size_t OFF_CTXR = al256(OFF_MOD + (size_t)DEPTH * (BATCH + 1) * 6144 * 4);
constexpr size_t OFF_WIN = al256(OFF_CTXR + (size_t)BATCH * CTXL * D * 4);
constexpr size_t OFF_WBR = al256(OFF_WIN + (size_t)NP * 1024 * 2);
constexpr size_t OFF_WOUT = al256(OFF_WBR + (size_t)3 * 1024 * 512 * 2);
constexpr size_t OFF_WUP = al256(OFF_WOUT + (size_t)1024 * 1024 * 2);
constexpr size_t OFF_WDN = al256(OFF_WUP + (size_t)16 * 1024 * 1024 * 2);
constexpr size_t OFF_WLORA = al256(OFF_WDN + (size_t)16 * 1024 * 512 * 2);
constexpr size_t OFF_H = al256(OFF_WLORA + (size_t)2560 * 384 * 2);
constexpr size_t OFF_P = al256(OFF_H + (size_t)RGP * 1024 * 2);
constexpr size_t SZ_XE = (size_t)16 * RPE * 1024 * 2, SZ_HID = (size_t)16 * RPE * 512 * 2;
constexpr size_t OFF_XE = OFF_P, OFF_HID = OFF_XE + SZ_XE, OFF_YE = OFF_HID + SZ_HID;
constexpr size_t OFF_GQKV = al256(OFF_P + cmax((size_t)RGP * NP * 2, 2 * SZ_XE + SZ_HID));
constexpr size_t OFF_BR = OFF_GQKV;
constexpr size_t OFF_DX = OFF_BR;
constexpr size_t OFF_GBG = al256(OFF_GQKV + (size_t)RGP * 1536 * 2);
constexpr size_t OFF_GTA = al256(OFF_GBG + (size_t)RGP * 16 * 4);
constexpr size_t OFF_GG = al256(OFF_GTA + (size_t)NCH * 4 * 2 * 2 * 4096 * 2);
constexpr size_t OFF_RW = al256(OFF_GG + (size_t)NCH * 4 * 2 * 64 * 4);
constexpr size_t OFF_RLO = al256(OFF_RW + (size_t)RGP * 4 * 512 * 2);
constexpr size_t OFF_SO = al256(OFF_RLO + (size_t)RGP * 2560 * 2);
constexpr size_t OFF_RLI = OFF_SO;
constexpr size_t OFF_SOG = OFF_SO, OFF_SOM = OFF_SOG + (size_t)2 * RGP * 512 * 2, OFF_SOR = OFF_SOM + (size_t)2 * RGP * 512 * 2;
constexpr size_t OFF_PROB = al256(OFF_SOR + (size_t)2 * RGP * 512 * 2);
constexpr size_t OFF_SLOT = al256(OFF_PROB + (size_t)RGP * 16 * 4);
constexpr size_t OFF_SEL = al256(OFF_SLOT + (size_t)RGP * 16 * 4);
constexpr size_t OFF_AFF = al256(OFF_SEL + (size_t)16 * RPE * 4);
constexpr int NSAVE = BATCH - BG > 0 ? BATCH - BG : 1;
constexpr size_t OFF_RST = al256(OFF_AFF + (size_t)16 * RPE * 4);
constexpr size_t OFF_GST = al256(OFF_RST + (size_t)NSAVE * 8 * 2 * 4096 * 4);
constexpr size_t OFF_MST = al256(OFF_GST + (size_t)NSAVE * 4 * 2 * 16384 * 4);
constexpr size_t OFF_MSM = al256(OFF_MST + (size_t)NSAVE * 4 * 2 * 16384 * 4);
constexpr size_t WS_TOTAL = al256(OFF_MSM + (size_t)NSAVE * 4 * 2 * 4);
constexpr int SMEM_BYTES = 152 * 1024;

struct Params { const float* in[34]; float* out; unsigned char* ws; };
enum { I_X = 0, I_C, I_CTX, I_CCTX, I_ADAW, I_ADAB, I_N1G, I_N2G, I_WIN, I_GCONV, I_GALOG, I_GDTB, I_GNG, I_RMU, I_RW0, I_RWUP, I_RA0, I_RAUP, I_RGUP,
       I_RKK, I_RKA, I_RRK, I_RLNG, I_RLNB, I_MIB, I_MFB, I_MNG, I_WBR, I_WOUT, I_ROUT, I_W1, I_W3, I_W2, I_FING };

#ifndef CPU_EMU
__device__ __forceinline__ int tid_fresh(int wb) { int t; asm volatile("v_mbcnt_lo_u32_b32 %0, -1, 0\n\tv_mbcnt_hi_u32_b32 %0, -1, %0" : "=v"(t)); return wb + t; }
#else
static inline int tid_fresh(int) { return threadIdx.x; }
#endif
#ifndef CPU_EMU
__device__ __forceinline__ float fexp(float x) { return __builtin_amdgcn_exp2f(x * 1.4426950408889634f); }
__device__ __forceinline__ float flog(float x) { return __builtin_amdgcn_logf(x) * 0.6931471805599453f; }
__device__ __forceinline__ float frcp(float x) { return __builtin_amdgcn_rcpf(x); }
__device__ __forceinline__ float frsq(float x) { return __builtin_amdgcn_rsqf(x); }
#else
static inline float fexp(float x) { return expf(x); }
static inline float flog(float x) { return logf(x); }
static inline float frcp(float x) { return 1.f / x; }
static inline float frsq(float x) { return 1.f / sqrtf(x); }
#endif
__device__ __forceinline__ float sigm(float x) { return frcp(1.f + fexp(-x)); }
__device__ __forceinline__ float siluf(float x) { return x * frcp(1.f + fexp(-x)); }
__device__ __forceinline__ float ftanh(float x) { return 1.f - 2.f * frcp(1.f + fexp(2.f * x)); }
__device__ __forceinline__ float softplusf(float x) { const float t = fexp(x); return x > 15.f ? x : (t < 1e-3f ? t * (1.f - 0.5f * t) : flog(1.f + t)); }
#define wave_sum(x) wave_sum_(x, tid)
__device__ __forceinline__ float wave_sum_(float v, int tid) { v += SHFL_XOR(v, 32); v += SHFL_XOR(v, 16); v += SHFL_XOR(v, 8); v += SHFL_XOR(v, 4); v += SHFL_XOR(v, 2); v += SHFL_XOR(v, 1); return v; }

#ifndef CPU_EMU
#define MFMA16(a, b, c) __builtin_amdgcn_mfma_f32_16x16x32_f16((a), (b), (c), 0, 0, 0)
#else
#define MFMA16(a, b, c) emu_mfma16((a), (b), (c))
#endif
__device__ __forceinline__ half8 ldfrag(const LAS half_t* base, int row0, int ld, int k0, int lane) { return *(const LAS half8*)(base + (row0 + (lane & 15)) * ld + k0 + 8 * (lane >> 4)); }
__device__ __forceinline__ half4 cvt4(f32x4 v) { half4 o; o[0] = (half_t)v[0]; o[1] = (half_t)v[1]; o[2] = (half_t)v[2]; o[3] = (half_t)v[3]; return o; }

typedef unsigned short bf16_t;
__device__ __forceinline__ bf16_t f2bf(float f) { unsigned u = __float_as_uint(f); u += 0x7FFFu + ((u >> 16) & 1u); return (bf16_t)(u >> 16); }
__device__ __forceinline__ float bf2f(bf16_t b) { return __uint_as_float(((unsigned)b) << 16); }
#ifndef CPU_EMU
#define EPI_LOAD_FENCE() asm volatile("" ::: "memory")
#else
#define EPI_LOAD_FENCE()
#endif
__device__ __forceinline__ float* res_dst(const Params& p, int g, int r) {
    if (r < RL) { const size_t t = (size_t)(g * BG) * SEQ + r; return p.out + t * D; }
    const size_t t = (size_t)(r - RL); return (float*)(p.ws + OFF_CTXR) + t * D;
}
__device__ __forceinline__ half_t* res_h(const Params& p, int g, int r) { return (half_t*)res_dst(p, g, r) + 1024; }
__device__ __forceinline__ f32x4 h4f(half4 h) { return (f32x4){(float)h[0], (float)h[1], (float)h[2], (float)h[3]}; }
__device__ __forceinline__ const float* mod_row(const Params& p, int l, int g, int r) {
    const int s = r < RL ? (g * BG + r / SEQ) : BATCH; return (const float*)(p.ws + OFF_MOD) + ((size_t)l * (BATCH + 1) + s) * 6144;
}

#ifndef CPU_EMU
#define XB_TMO      128
#define XB_XCNT(j)  (256  + 64 * (j))
#define XB_XSUB(j)  (1280 + 64 * (j))
#define XB_XGEN(j)  (2304 + 64 * (j))
#define XB_TOP      3328
#define XB_TOPGEN   3392
#define XCD_BAR_WORDS 3456
#define XB_SPIN_CAP (1u << 22)
__device__ __forceinline__ unsigned xb_ld(unsigned* p)              { return __hip_atomic_load(p, __ATOMIC_RELAXED, __HIP_MEMORY_SCOPE_AGENT); }
__device__ __forceinline__ unsigned xb_add(unsigned* p, unsigned v) { return __hip_atomic_fetch_add(p, v, __ATOMIC_RELAXED, __HIP_MEMORY_SCOPE_AGENT); }
__device__ __forceinline__ unsigned xb_xcc_id() { return (unsigned)__builtin_amdgcn_s_getreg((3 << 11) | 20) & 0xFu; }
#define XB_SPIN(cond, bar) do { unsigned _sp = 0; while (cond) { __builtin_amdgcn_s_sleep(1); \
    if ((++_sp & 255u) == 0u) { if (xb_ld(&(bar)[XB_TMO])) break; if (_sp > XB_SPIN_CAP) { atomicAdd(&(bar)[XB_TMO], 1u); break; } } } } while (0)
struct XcdBarrier { unsigned* bar; unsigned x; volatile LAS unsigned* st; };
__device__ __forceinline__ XcdBarrier xcd_barrier_post(unsigned* bar, volatile LAS unsigned* st) {
    XcdBarrier b; b.bar = bar; b.x = xb_xcc_id(); b.st = st;
    if (threadIdx.x == 0) (void)xb_add(&bar[XB_XCNT(b.x)], 1u);
    return b;
}
__device__ __forceinline__ void xcd_barrier_complete(unsigned* bar, unsigned x, unsigned& nloc, unsigned& nx) {
    const unsigned G = gridDim.x * gridDim.y * gridDim.z;
    unsigned sum, cnt, mine, sp = 0u;
    for (;;) {
        sum = 0u; cnt = 0u; mine = 0u;
#pragma unroll
        for (unsigned j = 0; j < 16; ++j) { const unsigned c = xb_ld(&bar[XB_XCNT(j)]); sum += c; cnt += (c > 0u) ? 1u : 0u; mine = (j == x) ? c : mine; }
        if (sum == G) break;
        __builtin_amdgcn_s_sleep(1);
        if ((++sp & 255u) == 0u) { if (xb_ld(&bar[XB_TMO])) break; if (sp > XB_SPIN_CAP) { atomicAdd(&bar[XB_TMO], 1u); break; } }
    }
    nloc = mine > 0u ? mine : 1u; nx = cnt > 0u ? cnt : 1u;
}
__device__ __forceinline__ void xcd_barrier(const XcdBarrier& b) {
    asm volatile("s_waitcnt vmcnt(0)" ::: "memory");
    __syncthreads();
    if (threadIdx.x == 0) {
        unsigned* bar = b.bar;
        __builtin_amdgcn_s_waitcnt(0);
        unsigned nloc = b.st[0], nx = b.st[1];
        if (nloc == 0u) { xcd_barrier_complete(bar, b.x, nloc, nx); b.st[0] = nloc; b.st[1] = nx; }
        const unsigned old = xb_add(&bar[XB_XSUB(b.x)], 1u);
        const unsigned gen = old / nloc;
        if (old + 1u == (gen + 1u) * nloc) {
            __builtin_amdgcn_fence(__ATOMIC_RELEASE, "agent");
            asm volatile("s_waitcnt vmcnt(0)" ::: "memory");
            const unsigned og = xb_add(&bar[XB_TOP], 1u);
            const unsigned tg = og / nx;
            if (og + 1u == (tg + 1u) * nx) xb_add(&bar[XB_TOPGEN], 1u);
            else XB_SPIN(xb_ld(&bar[XB_TOPGEN]) == tg, bar);
            __builtin_amdgcn_fence(__ATOMIC_ACQUIRE, "agent");
            xb_add(&bar[XB_XGEN(b.x)], 1u);
            asm volatile("s_waitcnt vmcnt(0)" ::: "memory");
        } else {
            XB_SPIN(xb_ld(&bar[XB_XGEN(b.x)]) == gen, bar);
            __builtin_amdgcn_fence(__ATOMIC_ACQUIRE, "agent");
            asm volatile("s_waitcnt vmcnt(0)" ::: "memory");
        }
    }
    __syncthreads();
}
#define GRID_SYNC() do { XcdBarrier gb_; gb_.bar = (unsigned*)(p.ws + OFF_BAR); gb_.x = xb_xcc_id(); gb_.st = (volatile LAS unsigned*)(lds + SMEM_BYTES - 16); xcd_barrier(gb_); } while (0)
#else
#define GRID_SYNC() emu_grid_sync()
#endif

namespace pg8 {
constexpr int BM = 256, BK = 64, HALF = 128, HTB = HALF * BK * 2, STAGE_BYTES = 8 * HTB, NXCD = 8, WGM = 8;
__host__ __device__ __forceinline__ int lds_byte(int r, int c) { const int st = (r >> 4) * 2 + (c >> 5), rr = r & 15, cc = c & 31, ob = rr * 64 + cc * 2; return st * 1024 + (ob ^ (((ob >> 9) & 1) << 5)); }
__host__ __device__ __forceinline__ void stage_rc(int b, int& R, int& C) { const int st = b / 1024, sb = b % 1024, swz = sb ^ (((sb >> 9) & 1) << 5); R = (st >> 1) * 16 + swz / 64; C = (st & 1) * 32 + (swz % 64) / 2; }
__host__ __device__ __forceinline__ int perm32(int rho) { const int n = rho >> 4, i = rho & 15; return 8 * (i >> 2) + 4 * n + (i & 3); }
struct Unit { int pm, pn, pb, pa, aux, k0; };
struct Gemm { const half_t* A; const half_t* Bt; int K; int kt; };
struct StaticOrder {
    int nM, nN, nwg, G, c;
    __device__ void init(int nM_, int nN_, int G_, int c_) { nM = nM_; nN = nN_; nwg = nM * nN; G = G_; c = c_; }
    __device__ bool next(int i, Unit& u) const {
        const long L = (long)i * G + c; if (L >= nwg) return false;
        int wgid = (int)L; { const int q = nwg / NXCD, r = nwg % NXCD, xcd = wgid % NXCD, off = wgid / NXCD; wgid = (xcd < r ? xcd * (q + 1) : r * (q + 1) + (xcd - r) * q) + off; }
        const int nig = WGM * nN, gid = wgid / nig, fm = gid * WGM, gsz = (nM - fm) < WGM ? (nM - fm) : WGM;
        u.pm = fm + ((wgid % nig) % gsz); u.pn = (wgid % nig) / gsz; u.pb = u.pn; u.pa = u.pm; u.aux = 0; u.k0 = 0; return true;
    }
};
struct ExpertOrder {
    int G, c, tpa;
    __device__ void init(int tpa_, int G_, int c_) { tpa = tpa_; G = G_; c = c_; }
    __device__ bool next(int i, Unit& u) const {
        const long L = (long)i * G + c; if (L >= 16 * tpa * 4) return false;
        const int e = (int)L / (tpa * 4), rem = (int)L % (tpa * 4);
        u.pm = e * TPE + rem / 4; u.pn = rem % 4; u.pb = e * 4 + u.pn; u.pa = u.pm; u.aux = 0; u.k0 = 0; return true;
    }
};

struct LoraOrder {
    StaticOrder T;
    __device__ void init(int nM_, int G_, int c_) { T.init(nM_, 10, G_, c_); }
    __device__ bool next(int i, Unit& u) const { if (!T.next(i, u)) return false; const int blk = u.pn >> 1; u.k0 = blk < 4 ? 64 * blk : 256; return true; }
};
struct MergeOrder {
    StaticOrder T;
    __device__ void init(int nM_, int G_, int c_) { T.init(nM_, 4, G_, c_); }
    __device__ bool next(int i, Unit& u) const {
        if (!T.next(i / 3, u)) return false;
        const int bi = i % 3; u.aux = bi; u.pa = bi * (RGP / 256) + u.pm; u.pb = bi * 4 + u.pn; return true;
    }
};
template <class E, class = void> struct EpiCarry { static constexpr bool value = false; };
template <class E> struct EpiCarry<E, decltype((void)E::CARRY)> { static constexpr bool value = true; };
#ifndef CPU_EMU
template <class Epi, class Sched>
__device__ __forceinline__ void gemm_phase(int wb, LAS unsigned char* lds, const Gemm g, const Sched& S, const Epi& E) {
    const int tid = tid_fresh(wb), wid = __builtin_amdgcn_readfirstlane(tid >> 6), lane = tid & 63, wr = wid >> 2, wc = wid & 3, fr = lane & 15, fq = lane >> 4;
    const int K = g.K; int nt = g.kt; asm volatile("" : "+s"(nt));
    unsigned voffA[2], voffB[2];
#pragma unroll
    for (int i = 0; i < 2; ++i) { int R, C; stage_rc(tid * 16 + i * 8192, R, C); const int Rb = Epi::PERM ? ((R & ~31) + perm32(R & 31)) : R;
        voffA[i] = (unsigned)(R * K + C) * 2u; voffB[i] = (unsigned)(Rb * K + C) * 2u; }
    const size_t kstep = (size_t)(BK * 2);
    const size_t hstep = (size_t)HALF * K * 2;
    const size_t tstep = 2 * hstep;
    const unsigned ldsw = (unsigned)wid * 1024u;
    const int aoff = lds_byte(wr * 64 + fr, fq * 8), boff = lds_byte(wc * 32 + fr, fq * 8);
#define PG8_SA(b, h) (((b) * 2 + (h)) * HTB)
#define PG8_SB(b, h) ((4 + (b) * 2 + (h)) * HTB)
#define PG8_STAGE(bufoff, gbase, voff) do { _Pragma("unroll") for (int _i = 0; _i < 2; ++_i) \
        __builtin_amdgcn_global_load_lds((const unsigned*)((const char*)(gbase) + (voff)[_i]), (LAS unsigned*)(lds + (bufoff) + ldsw + _i * 8192), 16, 0, 0); } while (0)
#define PG8_LDA(dst, b, h) do { _Pragma("unroll") for (int m = 0; m < 4; ++m) _Pragma("unroll") for (int k = 0; k < 2; ++k) dst[m][k] = *(const LAS half8*)(lds + PG8_SA(b, h) + aoff + m * 2048 + k * 1024); } while (0)
#define PG8_LDB(dst, b, h) do { _Pragma("unroll") for (int n = 0; n < 2; ++n) _Pragma("unroll") for (int k = 0; k < 2; ++k) dst[n][k] = *(const LAS half8*)(lds + PG8_SB(b, h) + boff + n * 2048 + k * 1024); } while (0)
#define PG8_MMA(ai, bj, At, Bt) do { __builtin_amdgcn_s_setprio(1); _Pragma("unroll") for (int m = 0; m < 4; ++m) _Pragma("unroll") for (int n = 0; n < 2; ++n) _Pragma("unroll") for (int k = 0; k < 2; ++k) \
        acc[ai][bj][m][n] = __builtin_amdgcn_mfma_f32_16x16x32_f16(Bt[n][k], At[m][k], acc[ai][bj][m][n], 0, 0, 0); __builtin_amdgcn_s_setprio(0); } while (0)
#define PG8_WAIT_V(n) asm volatile("s_waitcnt vmcnt(" #n ")" ::: "memory")
#define PG8_WAIT_L(n) asm volatile("s_waitcnt lgkmcnt(" #n ")" ::: "memory")
#define PG8_BAR __builtin_amdgcn_s_barrier()
#define PG8_SCHED __builtin_amdgcn_sched_barrier(0)
    Unit cur, nxt; int ui = 0;
    if (!S.next(0, cur)) return;
    f32x4 acc[2][2][4][2];
#pragma unroll
    for (int a = 0; a < 2; ++a)
#pragma unroll
        for (int b = 0; b < 2; ++b)
#pragma unroll
            for (int m = 0; m < 4; ++m)
#pragma unroll
                for (int n = 0; n < 2; ++n) acc[a][b][m][n] = (f32x4){0.f, 0.f, 0.f, 0.f};
    half8 At[4][2], B0[2][2], B1[2][2];
    const char* cA = (const char*)g.A + (size_t)cur.pa * tstep + (size_t)cur.k0 * 2; const char* cB = (const char*)g.Bt + (size_t)cur.pb * tstep + (size_t)cur.k0 * 2;
    PG8_STAGE(PG8_SB(0, 0), cB, voffB); PG8_STAGE(PG8_SA(0, 0), cA, voffA); PG8_STAGE(PG8_SB(0, 1), cB + hstep, voffB); PG8_STAGE(PG8_SA(0, 1), cA + hstep, voffA);
    if (wr == 1) PG8_BAR;
    PG8_WAIT_V(4); PG8_BAR;
    PG8_STAGE(PG8_SB(1, 0), cB + kstep, voffB); PG8_STAGE(PG8_SA(1, 0), cA + kstep, voffA); PG8_STAGE(PG8_SB(1, 1), cB + hstep + kstep, voffB);
    PG8_WAIT_V(6); PG8_BAR;
    for (;;) {
        const bool has_next = S.next(ui + 1, nxt);
        const char* nA = has_next ? (const char*)g.A + (size_t)nxt.pa * tstep + (size_t)nxt.k0 * 2 : cA; const char* nB = has_next ? (const char*)g.Bt + (size_t)nxt.pb * tstep + (size_t)nxt.k0 * 2 : cB;
#pragma unroll 1
        for (int t = 0; t < nt; t += 2) {
            const bool last = (t == nt - 2);
            const char* a1 = cA + (size_t)(t + 1) * kstep;
            const char* a2 = last ? nA : cA + (size_t)(t + 2) * kstep; const char* b2 = last ? nB : cB + (size_t)(t + 2) * kstep;
            const char* a3 = a2 + kstep; const char* b3 = b2 + kstep;
            PG8_LDB(B0, 0, 0); PG8_SCHED; PG8_LDA(At, 0, 0); PG8_STAGE(PG8_SA(1, 1), a1 + hstep, voffA);
            PG8_WAIT_L(8); PG8_BAR; PG8_WAIT_L(0); PG8_MMA(0, 0, At, B0); PG8_BAR; PG8_SCHED;
            PG8_LDB(B1, 0, 1); PG8_STAGE(PG8_SB(0, 0), b2, voffB);
            PG8_BAR; PG8_WAIT_L(0); PG8_MMA(0, 1, At, B1); PG8_BAR;
            PG8_LDA(At, 0, 1); PG8_STAGE(PG8_SA(0, 0), a2, voffA);
            PG8_BAR; PG8_WAIT_L(0); PG8_MMA(1, 0, At, B0); PG8_BAR; PG8_SCHED;
            PG8_STAGE(PG8_SB(0, 1), b2 + hstep, voffB);
            PG8_WAIT_V(6); PG8_BAR; PG8_MMA(1, 1, At, B1); PG8_BAR;
            PG8_LDB(B0, 1, 0); PG8_SCHED; PG8_LDA(At, 1, 0); PG8_STAGE(PG8_SA(0, 1), a2 + hstep, voffA);
            PG8_WAIT_L(8); PG8_BAR; PG8_WAIT_L(0); PG8_MMA(0, 0, At, B0); PG8_BAR; PG8_SCHED;
            PG8_LDB(B1, 1, 1); PG8_STAGE(PG8_SB(1, 0), b3, voffB);
            PG8_BAR; PG8_WAIT_L(0); PG8_MMA(0, 1, At, B1); PG8_BAR;
            PG8_LDA(At, 1, 1); PG8_STAGE(PG8_SA(1, 0), a3, voffA);
            PG8_BAR; PG8_WAIT_L(0); PG8_MMA(1, 0, At, B0); PG8_BAR; PG8_SCHED;
            PG8_STAGE(PG8_SB(1, 1), b3 + hstep, voffB);
            PG8_WAIT_V(6); PG8_BAR; PG8_MMA(1, 1, At, B1); PG8_BAR;
        }
        bool keep = false;
        if constexpr (EpiCarry<Epi>::value) keep = E(acc, cur, wr, wc, fr, fq); else E(acc, cur, wr, wc, fr, fq);
        if (!has_next) break;
        if (!keep) {
#pragma unroll
            for (int a = 0; a < 2; ++a)
#pragma unroll
                for (int b = 0; b < 2; ++b)
#pragma unroll
                    for (int m = 0; m < 4; ++m)
#pragma unroll
                        for (int n = 0; n < 2; ++n) acc[a][b][m][n] = (f32x4){0.f, 0.f, 0.f, 0.f};
        }
        cur = nxt; cA = nA; cB = nB; ++ui;
    }
    PG8_WAIT_V(0);
    if (wr == 0) PG8_BAR;
    PG8_BAR;
#undef PG8_SA
#undef PG8_SB
#undef PG8_STAGE
#undef PG8_LDA
#undef PG8_LDB
#undef PG8_MMA
#undef PG8_WAIT_V
#undef PG8_WAIT_L
#undef PG8_BAR
#undef PG8_SCHED
}
#else
static float* emu_fa[64]; static float* emu_fb[64];
template <class Epi, class Sched>
void gemm_phase(int wb, LAS unsigned char* lds, const Gemm g, const Sched& S, const Epi& E) {
    const int tid = tid_fresh(wb), wid = tid >> 6, lane = tid & 63, wr = wid >> 2, wc = wid & 3, fr = lane & 15, fq = lane >> 4;
    const int K = g.K; const int bid = blockIdx.x;
    Unit u; f32x4 acc[2][2][4][2]; bool emu_keep = false;
    for (int ui = 0; S.next(ui, u); ++ui) {
        SYNC();
        if (tid == 0) {
            if (!emu_fa[bid]) { emu_fa[bid] = (float*)malloc(256 * 1024 * 4); emu_fb[bid] = (float*)malloc(256 * 1024 * 4); }
            for (int r = 0; r < 256; ++r) for (int k = 0; k < K; ++k) { emu_fa[bid][r * K + k] = (float)g.A[((size_t)u.pa * 256 + r) * K + k]; emu_fb[bid][r * K + k] = (float)g.Bt[((size_t)u.pb * 256 + r) * K + k]; }
        }
        SYNC();
        if (!emu_keep) for (int ai = 0; ai < 2; ++ai) for (int bj = 0; bj < 2; ++bj) for (int m = 0; m < 4; ++m) for (int n = 0; n < 2; ++n) acc[ai][bj][m][n] = (f32x4){0.f, 0.f, 0.f, 0.f};
        for (int ai = 0; ai < 2; ++ai) for (int bj = 0; bj < 2; ++bj) for (int m = 0; m < 4; ++m) for (int n = 0; n < 2; ++n) for (int i = 0; i < 4; ++i) {
            const int row = 128 * ai + 64 * wr + 16 * m + fr;
            const int col = Epi::PERM ? (128 * bj + 32 * wc + 8 * fq + 4 * n + i) : (128 * bj + 32 * wc + 16 * n + 4 * fq + i);
            const float* a = emu_fa[bid] + row * K; const float* b = emu_fb[bid] + col * K; float s = 0.f;
            for (int k = u.k0; k < u.k0 + 64 * g.kt; ++k) s += a[k] * b[k];
            acc[ai][bj][m][n][i] += s; }
        if constexpr (EpiCarry<Epi>::value) emu_keep = E(acc, u, wr, wc, fr, fq); else { E(acc, u, wr, wc, fr, fq); emu_keep = false; }
    }
    SYNC();
}
#endif
}
using pg8::Unit;

struct EpiP {
    static constexpr bool PERM = true;
    half_t* P;
    __device__ __forceinline__ void operator()(const f32x4 (&acc)[2][2][4][2], const Unit& u, int wr, int wc, int fr, int fq) const {
        const int row0 = u.pm * 256 + wr * 64 + fr, col0 = u.pn * 256 + wc * 32 + 8 * fq;
        const bool tile_sg = u.pn * 256 + 256 > C_MLO;
        if (!tile_sg) {
#pragma unroll
            for (int bj = 0; bj < 2; ++bj)
#pragma unroll
                for (int ai = 0; ai < 2; ++ai)
#pragma unroll
                    for (int m = 0; m < 4; ++m) { half8 h;
#pragma unroll
                        for (int n = 0; n < 2; ++n)
#pragma unroll
                            for (int i = 0; i < 4; ++i) h[4 * n + i] = (half_t)acc[ai][bj][m][n][i];
                        *(half8*)(P + (size_t)(row0 + ai * 128 + m * 16) * NP + col0 + bj * 128) = h; }
            return;
        }
#pragma unroll
        for (int bj = 0; bj < 2; ++bj) {
            const int col = col0 + bj * 128;
            const bool sg = tile_sg && ((col >= C_GATE && col < IN_COLS) || (col >= C_MLO && col < C_MLIG));
#pragma unroll
            for (int ai = 0; ai < 2; ++ai)
#pragma unroll
                for (int m = 0; m < 4; ++m) {
                    half8 h;
#pragma unroll
                    for (int n = 0; n < 2; ++n)
#pragma unroll
                        for (int i = 0; i < 4; ++i) { float v = acc[ai][bj][m][n][i]; if (sg) v = sigm(v); h[4 * n + i] = (half_t)v; }
                    *(half8*)(P + (size_t)(row0 + ai * 128 + m * 16) * NP + col) = h;
                }
        }
    }
};
struct EpiNull {
    static constexpr bool PERM = true;
    float* sink;
    __device__ __forceinline__ void operator()(const f32x4 (&acc)[2][2][4][2], const Unit& u, int wr, int wc, int fr, int fq) const {
        f32x4 t = {0.f, 0.f, 0.f, 0.f};
#pragma unroll
        for (int ai = 0; ai < 2; ++ai)
#pragma unroll
            for (int bj = 0; bj < 2; ++bj)
#pragma unroll
                for (int m = 0; m < 4; ++m)
#pragma unroll
                    for (int n = 0; n < 2; ++n) t += acc[ai][bj][m][n];
        if (t[0] + t[1] + t[2] + t[3] == 12345.678f) sink[0] = t[0];
    }
};
struct EpiLora {
    static constexpr bool PERM = true;
    half_t* O; const float* w0; const float* a0;
    __device__ __forceinline__ void operator()(const f32x4 (&acc)[2][2][4][2], const Unit& u, int wr, int wc, int fr, int fq) const {
        const int row0 = u.pm * 256 + wr * 64 + fr, col0 = u.pn * 256 + wc * 32 + 8 * fq;
#pragma unroll
        for (int bj = 0; bj < 2; ++bj) {
            const int col = col0 + bj * 128, blk = col >> 9;
            float bias[8];
#pragma unroll
            for (int j = 0; j < 8; ++j) bias[j] = blk < 2 ? w0[col + j] : (blk < 4 ? a0[col - 1024 + j] : 0.f);
#pragma unroll
            for (int ai = 0; ai < 2; ++ai)
#pragma unroll
                for (int m = 0; m < 4; ++m) {
                    half8 h;
#pragma unroll
                    for (int n = 0; n < 2; ++n)
#pragma unroll
                        for (int i = 0; i < 4; ++i) { float v = acc[ai][bj][m][n][i] + bias[4 * n + i];
                            if (blk < 2) v = sigm(v) * 0.6065306597126334f; else if (blk < 4) v = sigm(v);
                            h[4 * n + i] = (half_t)v; }
                    *(half8*)(O + (size_t)(row0 + ai * 128 + m * 16) * 2560 + col) = h;
                }
        }
    }
};
struct EpiMerge {
    static constexpr bool PERM = true; static constexpr bool CARRY = true;
    half_t* M; const half_t* P;
    __device__ __forceinline__ bool operator()(f32x4 (&acc)[2][2][4][2], const Unit& u, int wr, int wc, int fr, int fq) const {
        const int bi = u.aux;
        const half_t* G0 = P + (size_t)(u.pm * 256 + wr * 64 + fr) * NP + C_GATE + bi * 1024 + u.pn * 256 + wc * 32 + 8 * fq;
        if (bi < 2) {
#pragma unroll
            for (int ai = 0; ai < 2; ++ai) {
                half8 gt[4][2], gn[4][2];
#pragma unroll
                for (int m = 0; m < 4; ++m)
#pragma unroll
                    for (int bj = 0; bj < 2; ++bj) { const half_t* q = G0 + (size_t)(ai * 128 + m * 16) * NP + bj * 128; gt[m][bj] = *(const half8*)q; gn[m][bj] = *(const half8*)(q + 1024); }
                EPI_LOAD_FENCE();
#pragma unroll
                for (int m = 0; m < 4; ++m)
#pragma unroll
                    for (int bj = 0; bj < 2; ++bj)
#pragma unroll
                        for (int n = 0; n < 2; ++n)
#pragma unroll
                            for (int i = 0; i < 4; ++i) acc[ai][bj][m][n][i] *= (float)gt[m][bj][4 * n + i] * frcp(fmaxf((float)gn[m][bj][4 * n + i], 6.0e-8f));
            }
            return true;
        }
        half_t* M0 = M + (size_t)(u.pm * 256 + wr * 64 + fr) * 1024 + u.pn * 256 + wc * 32 + 8 * fq;
#pragma unroll
        for (int ai = 0; ai < 2; ++ai) {
            half8 gt[4][2];
#pragma unroll
            for (int m = 0; m < 4; ++m)
#pragma unroll
                for (int bj = 0; bj < 2; ++bj) gt[m][bj] = *(const half8*)(G0 + (size_t)(ai * 128 + m * 16) * NP + bj * 128);
#pragma unroll
            for (int m = 0; m < 4; ++m)
#pragma unroll
                for (int bj = 0; bj < 2; ++bj) { half8 o;
#pragma unroll
                    for (int n = 0; n < 2; ++n)
#pragma unroll
                        for (int i = 0; i < 4; ++i) o[4 * n + i] = (half_t)((float)gt[m][bj][4 * n + i] * acc[ai][bj][m][n][i]);
                    *(half8*)(M0 + (size_t)(ai * 128 + m * 16) * 1024 + bj * 128) = o; }
        }
        return false;
    }
};
struct EpiOut {
    static constexpr bool PERM = true;
    Params p; int l, g, rg;
    __device__ __forceinline__ void operator()(const f32x4 (&acc)[2][2][4][2], const Unit& u, int wr, int wc, int fr, int fq) const {
        static_assert(RL % 256 == 0 && RCX % 256 == 0 && SEQ % 256 == 0, "row tiles must not straddle samples");
        const int r0 = u.pm * 256, cb = u.pn * 256 + wc * 32 + 8 * fq;
        half_t* dst = (half_t*)(p.ws + OFF_DX) + (size_t)(r0 + wr * 64 + fr) * D + cb; const float* md = mod_row(p, l, g, r0) + 2 * 1024 + cb;
        f32x4 mv[2][2];
#pragma unroll
        for (int bj = 0; bj < 2; ++bj)
#pragma unroll
            for (int n = 0; n < 2; ++n) mv[bj][n] = *(const f32x4*)(md + bj * 128 + 4 * n);
#pragma unroll
        for (int ai = 0; ai < 2; ++ai)
#pragma unroll
            for (int m = 0; m < 4; ++m)
#pragma unroll
                for (int bj = 0; bj < 2; ++bj) { half8 o;
#pragma unroll
                    for (int n = 0; n < 2; ++n)
#pragma unroll
                        for (int i = 0; i < 4; ++i) o[4 * n + i] = (half_t)(mv[bj][n][i] * acc[ai][bj][m][n][i]);
                    *(half8*)(dst + (size_t)(ai * 128 + m * 16) * D + bj * 128) = o; }
    }
};
struct EpiUp {
    static constexpr bool PERM = true;
    half_t* HID;
    __device__ __forceinline__ void operator()(const f32x4 (&acc)[2][2][4][2], const Unit& u, int wr, int wc, int fr, int fq) const {
        const int row0 = u.pm * 256 + wr * 64 + fr, col = u.pn * 128 + wc * 32 + 8 * fq;
#pragma unroll
        for (int ai = 0; ai < 2; ++ai)
#pragma unroll
            for (int m = 0; m < 4; ++m) {
                half8 h;
#pragma unroll
                for (int n = 0; n < 2; ++n)
#pragma unroll
                    for (int i = 0; i < 4; ++i) h[4 * n + i] = (half_t)(siluf(acc[ai][0][m][n][i]) * acc[ai][1][m][n][i]);
                *(half8*)(HID + (size_t)(row0 + ai * 128 + m * 16) * 512 + col) = h;
            }
    }
};
struct EpiDown {
    static constexpr bool PERM = true;
    half_t* YE; const float* AFF;
    __device__ __forceinline__ void operator()(const f32x4 (&acc)[2][2][4][2], const Unit& u, int wr, int wc, int fr, int fq) const {
        const int row0 = u.pm * 256 + wr * 64 + fr, col0 = u.pn * 256 + wc * 32 + 8 * fq;
        float afv[2][4];
#pragma unroll
        for (int ai = 0; ai < 2; ++ai)
#pragma unroll
            for (int m = 0; m < 4; ++m) afv[ai][m] = AFF[row0 + ai * 128 + m * 16];
        EPI_LOAD_FENCE();
#pragma unroll
        for (int ai = 0; ai < 2; ++ai)
#pragma unroll
            for (int m = 0; m < 4; ++m) {
                const size_t row = (size_t)(row0 + ai * 128 + m * 16); const float af = afv[ai][m];
#pragma unroll
                for (int bj = 0; bj < 2; ++bj) {
                    half8 h;
#pragma unroll
                    for (int n = 0; n < 2; ++n)
#pragma unroll
                        for (int i = 0; i < 4; ++i) h[4 * n + i] = (half_t)(acc[ai][bj][m][n][i] * af);
                    *(half8*)(YE + row * 1024 + col0 + bj * 128) = h;
                }
            }
    }
};

__device__ __forceinline__ void ph_mod(int wb, const Params& p, LAS unsigned char* lds) {
    LAS float* sv = (LAS float*)lds; LAS float* red = sv + (BATCH + 1) * 1024;
    const int tid = tid_fresh(wb);
    for (int i = tid; i < (BATCH + 1) * 1024; i += NT) { const int s = i >> 10, k = i & 1023; const float cv = s < BATCH ? p.in[I_C][s * 1024 + k] : p.in[I_CCTX][k]; sv[i] = siluf(cv); }
    SYNC();
    float* mod = (float*)(p.ws + OFF_MOD);
    for (int item = blockIdx.x; item < DEPTH * 48; item += gridDim.x) {
        const int l = item / 48, j = (item % 48) * 128 + (tid & 127), kq = tid >> 7;
        float acc[BATCH + 1];
#pragma unroll
        for (int s = 0; s <= BATCH; ++s) acc[s] = 0.f;
        const float* w = p.in[I_ADAW] + (size_t)l * 1024 * 6144 + j;
        for (int k = kq * 256; k < kq * 256 + 256; ++k) { const float wv = w[(size_t)k * 6144];
#pragma unroll
            for (int s = 0; s <= BATCH; ++s) acc[s] += sv[s * 1024 + k] * wv; }
#pragma unroll
        for (int s = 0; s <= BATCH; ++s) red[tid * (BATCH + 1) + s] = acc[s];
        SYNC();
        if (tid < 128) {
#pragma unroll
            for (int s = 0; s <= BATCH; ++s) { float v = p.in[I_ADAB][l * 6144 + j];
                for (int q = 0; q < 4; ++q) v += red[(q * 128 + tid) * (BATCH + 1) + s];
                mod[((size_t)l * (BATCH + 1) + s) * 6144 + j] = v; }
        }
        SYNC();
    }
}

__device__ __forceinline__ void tconv_tile(int wb, const float* src, int sld, int k0, int n0, int nvalid, half_t* dst, int dld, int drow0, int dcol0, LAS float* tile) {
    const int tid = tid_fresh(wb), r = tid >> 4, c4 = (tid & 15) * 4;
#pragma unroll
    for (int j = 0; j < 2; ++j) { const int k = r + 32 * j; f32x4 v = {0.f, 0.f, 0.f, 0.f};
        if (src && n0 + c4 < nvalid) v = *(const f32x4*)(src + (size_t)(k0 + k) * sld + n0 + c4);
        tile[k * 65 + c4] = v[0]; tile[k * 65 + c4 + 1] = v[1]; tile[k * 65 + c4 + 2] = v[2]; tile[k * 65 + c4 + 3] = v[3]; }
    SYNC();
    const int n = tid >> 3, k8 = (tid & 7) * 8; half8 h;
#pragma unroll
    for (int i = 0; i < 8; ++i) h[i] = (half_t)tile[(k8 + i) * 65 + n];
    *(half8*)(dst + (size_t)(drow0 + n) * dld + dcol0 + k8) = h;
    SYNC();
}
__device__ __forceinline__ void ph_convert(int wb, const Params& p, int l, int part, int ce, int ge, LAS unsigned char* lds) {
    LAS float* tile = (LAS float*)lds;
    constexpr int N_WIN = 16 * (NP / 64), N_WBR = 3 * 128, N_WOUT = 256, N_W13 = 2 * 2048, N_W2 = 2048, N_LORA = 240;
    constexpr int N_MID = N_WBR + N_WOUT + N_W13 + N_W2;
    half_t* ws16 = (half_t*)p.ws;
    const int nv = part == 0 ? N_WIN + N_LORA : N_MID;
    if (ce < 0) return;
    for (int v = ce; v < nv; v += ge) {
        const int item = part == 0 ? (v < N_WIN ? v : v + N_MID) : v + N_WIN;
        int it = item;
        if (it < N_WIN) { const int kt = it % 16, ntile = it / 16;
            tconv_tile(wb, p.in[I_WIN] + (size_t)l * 1024 * IN_COLS, IN_COLS, 64 * kt, 64 * ntile, IN_COLS, (half_t*)(p.ws + OFF_WIN), 1024, 64 * ntile, 64 * kt, tile); continue; }
        it -= N_WIN;
        if (it < N_WBR) { const int i = it / 128, rem = it % 128, kt = rem % 8, ntile = rem / 8;
            tconv_tile(wb, p.in[I_WBR] + (size_t)(l * 3 + i) * 512 * 1024, 1024, 64 * kt, 64 * ntile, 1024, (half_t*)(p.ws + OFF_WBR) + (size_t)i * 1024 * 512, 512, 64 * ntile, 64 * kt, tile); continue; }
        it -= N_WBR;
        if (it < N_WOUT) { const int kt = it % 16, ntile = it / 16;
            tconv_tile(wb, p.in[I_WOUT] + (size_t)l * 1024 * 1024, 1024, 64 * kt, 64 * ntile, 1024, (half_t*)(p.ws + OFF_WOUT), 1024, 64 * ntile, 64 * kt, tile); continue; }
        it -= N_WOUT;
        if (it < N_W13) { const int which = it / 2048, rem = it % 2048, e = rem / 128, r2 = rem % 128, kt = r2 % 16, ntile = r2 / 16, n0 = 64 * ntile;
            tconv_tile(wb, p.in[which ? I_W3 : I_W1] + (size_t)(l * 16 + e) * 1024 * 512, 512, 64 * kt, n0, 512, (half_t*)(p.ws + OFF_WUP) + (size_t)e * 1024 * 1024, 1024,
                       (n0 / 128) * 256 + which * 128 + (n0 % 128), 64 * kt, tile); continue; }
        it -= N_W13;
        if (it < N_W2) { const int e = it / 128, r2 = it % 128, kt = r2 % 8, ntile = r2 / 8;
            tconv_tile(wb, p.in[I_W2] + (size_t)(l * 16 + e) * 512 * 1024, 1024, 64 * kt, 64 * ntile, 1024, (half_t*)(p.ws + OFF_WDN) + (size_t)e * 1024 * 512, 512, 64 * ntile, 64 * kt, tile); continue; }
        it -= N_W2;
        { const int ntile = it / 6, kt = it % 6, n0 = 64 * ntile, blk = n0 / 512, nn0 = n0 % 512;
          const float* src = nullptr; int k0 = 0;
          if (blk == 0 && kt == 0) src = p.in[I_RWUP] + (size_t)(l * 2 + 0) * 64 * 512;
          else if (blk == 1 && kt == 1) src = p.in[I_RWUP] + (size_t)(l * 2 + 1) * 64 * 512;
          else if (blk == 2 && kt == 2) src = p.in[I_RAUP] + (size_t)(l * 2 + 0) * 64 * 512;
          else if (blk == 3 && kt == 3) src = p.in[I_RAUP] + (size_t)(l * 2 + 1) * 64 * 512;
          else if (blk == 4 && kt >= 4) { src = p.in[I_RGUP] + (size_t)l * 128 * 512; k0 = 64 * (kt - 4); }
          tconv_tile(wb, src, 512, k0, nn0, 512, (half_t*)(p.ws + OFF_WLORA), 384, n0, 64 * kt, tile); }
    }
    (void)ws16;
}

__device__ __forceinline__ void ph_xconv(int wb, const Params& p) {
    const int tid = tid_fresh(wb), wid = tid >> 6, lane = tid & 63;
    constexpr int NROW = BATCH * SEQ + BATCH * CTXL, RU = 4; const int rstep = gridDim.x * 8;
    for (int t0 = blockIdx.x * 8 + wid; t0 < NROW; t0 += rstep * RU) {
        f32x4 v[RU][4];
#pragma unroll
        for (int u = 0; u < RU; ++u) { const int t = t0 + u * rstep < NROW ? t0 + u * rstep : t0;
            const float* src = t < BATCH * SEQ ? p.in[I_X] + (size_t)t * D : p.in[I_CTX] + (size_t)(t - BATCH * SEQ) * D;
#pragma unroll
            for (int j = 0; j < 4; ++j) v[u][j] = *(const f32x4*)(src + lane * 4 + 256 * j); }
        EPI_LOAD_FENCE();
#pragma unroll
        for (int u = 0; u < RU; ++u) { const int t = t0 + u * rstep; if (t >= NROW) continue;
            half_t* dst = (half_t*)(t < BATCH * SEQ ? p.out + (size_t)t * D : (float*)(p.ws + OFF_CTXR) + (size_t)(t - BATCH * SEQ) * D) + 1024;
#pragma unroll
            for (int j = 0; j < 4; ++j) *(half4*)(dst + lane * 4 + 256 * j) = cvt4(v[u][j]); }
    }
}

__device__ __forceinline__ void ph_norm1(int wb, const Params& p, int l, int g) {
    const int tid = tid_fresh(wb), wid = tid >> 6, lane = tid & 63;
    half_t* H = (half_t*)(p.ws + OFF_H);
    constexpr int RU = 2;
    const int rstep = gridDim.x * 8; const float* gn = p.in[I_N1G] + l * D;
    const Geo gq = geo_of(g); const int RG = gq.rg, RGPg = gq.rgp;
    f32x4 gv[4];
#pragma unroll
    for (int j = 0; j < 4; ++j) gv[j] = *(const f32x4*)(gn + lane * 4 + 256 * j);
    for (int r0 = blockIdx.x * 8 + wid; r0 < RGPg; r0 += rstep * RU) {
        f32x4 v[RU][4], sh[RU][4], sc[RU][4]; float ss[RU];
#pragma unroll
        for (int u = 0; u < RU; ++u) { const int r = r0 + u * rstep < RG ? r0 + u * rstep : 0;
            const half_t* xr = res_h(p, g, r); const float* md = mod_row(p, l, g, r);
#pragma unroll
            for (int j = 0; j < 4; ++j) { const int c = lane * 4 + 256 * j; v[u][j] = h4f(*(const half4*)(xr + c)); sh[u][j] = *(const f32x4*)(md + c); sc[u][j] = *(const f32x4*)(md + 1024 + c); } }
        EPI_LOAD_FENCE();
#pragma unroll
        for (int u = 0; u < RU; ++u) { float a = 0.f;
#pragma unroll
            for (int j = 0; j < 4; ++j) a += v[u][j][0] * v[u][j][0] + v[u][j][1] * v[u][j][1] + v[u][j][2] * v[u][j][2] + v[u][j][3] * v[u][j][3];
            ss[u] = a; }
#pragma unroll
        for (int u = 0; u < RU; ++u) ss[u] = wave_sum(ss[u]);
#pragma unroll
        for (int u = 0; u < RU; ++u) { const int r = r0 + u * rstep; if (r >= RGPg) continue;
            if (r >= RG) { for (int j = 0; j < 4; ++j) *(half4*)(H + (size_t)r * D + lane * 4 + 256 * j) = (half4){0, 0, 0, 0}; continue; }
            const float rinv = frsq(ss[u] * (1.f / D) + 1e-6f);
#pragma unroll
            for (int j = 0; j < 4; ++j) { const int c = lane * 4 + 256 * j;
                *(half4*)(H + (size_t)r * D + c) = cvt4(v[u][j] * rinv * gv[j] * (sc[u][j] + 1.f) + sh[u][j]); } }
    }
#ifndef CPU_EMU
    if (WARM_WIN) {
        const uint4* wp = (const uint4*)(p.ws + OFF_WIN); unsigned acc = 0u;
        for (size_t i = (size_t)blockIdx.x * NT + tid; i < (size_t)NP * 1024 * 2 / 16; i += (size_t)gridDim.x * NT) acc ^= wp[i].x;
        if (acc == 0x9E3779B9u && tid == 99999) *(unsigned*)(p.ws + OFF_BAR + 15000) = acc;
    }
#endif
}

struct RowGeo { int gw, gh, base, gr, gc; };
__device__ __forceinline__ RowGeo row_geo(int r) {
    RowGeo q; int i;
    if (r < RL) { const int bl = r / SEQ; i = r % SEQ; q.gw = 64; q.gh = SEQ / 64; q.base = bl * SEQ; }
    else { const int rr = r - RL, bl = rr / CTXL; i = rr % CTXL; q.gw = CTXL; q.gh = 1; q.base = RL + bl * CTXL; }
    q.gr = i / q.gw; q.gc = i % q.gw; return q;
}

template <int PV = 3> __device__ __forceinline__ void ph_prep(int wb, const Params& p, int l, int RG, LAS unsigned char* lds) {
    const int tid = tid_fresh(wb), wid = tid >> 6, lane = tid & 63;
    LAS float* cw = (LAS float*)lds;
    for (int i = tid; i < 9 * 1536; i += NT) cw[i] = p.in[I_GCONV][(size_t)l * 9 * 1536 + i];
    SYNC();
    const half_t* P = (const half_t*)(p.ws + OFF_P);
    half_t* GQKV = (half_t*)(p.ws + OFF_GQKV); float* GBG = (float*)(p.ws + OFF_GBG);
    half_t* RW = (half_t*)(p.ws + OFF_RW); half_t* RLI = (half_t*)(p.ws + OFF_RLI);
    f32x4 muv[4][2]; f32x4 kkv[2];
    { const float* mu = p.in[I_RMU] + (size_t)l * 1920;
#pragma unroll
      for (int j = 0; j < 4; ++j) { const int cj = j < 3 ? j * 512 + 8 * lane : 1536 + 8 * (lane < 48 ? lane : 47); muv[j][0] = *(const f32x4*)(mu + cj); muv[j][1] = *(const f32x4*)(mu + cj + 4); }
      const float* kkw = p.in[I_RKK] + (size_t)l * 512 + 8 * lane; kkv[0] = *(const f32x4*)(kkw); kkv[1] = *(const f32x4*)(kkw + 4); }
    for (int r = blockIdx.x * 8 + wid; r < RG; r += gridDim.x * 8) {
        const RowGeo q = row_geo(r);
        if (PV & 1) {
        float acc[3][8];
#pragma unroll
        for (int j = 0; j < 3; ++j)
#pragma unroll
            for (int e = 0; e < 8; ++e) acc[j][e] = 0.f;
        for (int kh = 0; kh < 3; ++kh) { const int nr = q.gr + kh - 1; if (nr < 0 || nr >= q.gh) continue;
            for (int kw = 0; kw < 3; ++kw) { const int nc = q.gc + kw - 1; if (nc < 0 || nc >= q.gw) continue;
                const size_t nrow = (size_t)(q.base + nr * q.gw + nc);
#pragma unroll
                for (int j = 0; j < 3; ++j) { const half8 pv = *(const half8*)(P + nrow * NP + j * 512 + 8 * lane); const LAS float* w = cw + (kh * 3 + kw) * 1536 + j * 512 + 8 * lane;
#pragma unroll
                    for (int e = 0; e < 8; ++e) acc[j][e] += (float)pv[e] * w[e]; } } }
#pragma unroll
        for (int j = 0; j < 3; ++j) {
            float ss = 0.f;
#pragma unroll
            for (int e = 0; e < 8; ++e) { acc[j][e] = siluf(acc[j][e]); ss += acc[j][e] * acc[j][e]; }
            float sc = 1.f;
            if (j < 2) { ss += SHFL_XOR(ss, 1); ss += SHFL_XOR(ss, 2); ss += SHFL_XOR(ss, 4); ss += SHFL_XOR(ss, 8); sc = frsq(ss + 1e-6f) * (j == 0 ? 0.08838834764831845f : 1.f); }
            half8 h;
#pragma unroll
            for (int e = 0; e < 8; ++e) h[e] = (half_t)(acc[j][e] * sc);
            *(half8*)(GQKV + (size_t)r * 1536 + j * 512 + 8 * lane) = h;
        }
        if (lane < 16) { const float x = (float)P[(size_t)r * NP + C_BG + lane];
            float o; if (lane < 8) o = sigm(x); else { const int idx = lane - 8; o = -fexp(p.in[I_GALOG][l * 8 + idx]) * softplusf(x + p.in[I_GDTB][l * 8 + idx]); }
            GBG[(size_t)r * 16 + lane] = o; }
        }
        if (PV & 2) {
        const int nb[4] = { q.gc > 0 ? r - 1 : -1, q.gc < q.gw - 1 ? r + 1 : -1, q.gr > 0 ? r - q.gw : -1, q.gr < q.gh - 1 ? r + q.gw : -1 };
        float kmix[8];
#pragma unroll
        for (int j = 0; j < 4; ++j) {
            if (j == 3 && lane >= 48) break;
            const int cj = j < 3 ? j * 512 + 8 * lane : 1536 + 8 * lane;
            const half8 self = *(const half8*)(P + (size_t)r * NP + C_RWKV + cj);
            half8 nv[4];
#pragma unroll
            for (int d = 0; d < 4; ++d) { if (nb[d] >= 0) nv[d] = *(const half8*)(P + (size_t)nb[d] * NP + C_RWKV + cj); else nv[d] = (half8){0, 0, 0, 0, 0, 0, 0, 0}; }
            float val[8];
#pragma unroll
            for (int e = 0; e < 8; ++e) { const float s = (float)self[e], nn = (float)nv[e & 3][e]; val[e] = s + (nn - s) * muv[j][e >> 2][e & 3]; }
            half8 h;
            if (j < 3) {
#pragma unroll
                for (int e = 0; e < 8; ++e) h[e] = (half_t)val[e];
                *(half8*)(RW + ((size_t)r * 4 + j) * 512 + 8 * lane) = h;
                if (j == 1) {
#pragma unroll
                    for (int e = 0; e < 8; ++e) kmix[e] = val[e]; }
            } else {
                const int c0 = 8 * lane;
#pragma unroll
                for (int e = 0; e < 8; ++e) { float v = val[e]; if (c0 < 128) v = ftanh(v); else if (c0 >= 256) v = sigm(v); h[e] = (half_t)v; }
                *(half8*)(RLI + (size_t)r * 384 + c0) = h;
            }
        }
        { float t[8], ss = 0.f;
#pragma unroll
          for (int e = 0; e < 8; ++e) { t[e] = kmix[e] * kkv[e >> 2][e & 3]; ss += t[e] * t[e]; }
          ss += SHFL_XOR(ss, 1); ss += SHFL_XOR(ss, 2); ss += SHFL_XOR(ss, 4);
          const float sc = frsq(ss + 1e-6f); half8 h;
#pragma unroll
          for (int e = 0; e < 8; ++e) h[e] = (half_t)(t[e] * sc);
          *(half8*)(RW + ((size_t)r * 4 + 3) * 512 + 8 * lane) = h; }
        }
    }
}

__device__ __forceinline__ void ph_prep2(int wb, const Params& p, int l, int RG, LAS unsigned char* lds) {
    const int tid = tid_fresh(wb), wid = tid >> 6, lane = tid & 63;
    LAS float* cw = (LAS float*)lds;
    for (int i = tid; i < 9 * 1536; i += NT) cw[i] = p.in[I_GCONV][(size_t)l * 9 * 1536 + i];
    SYNC();
    const half_t* P = (const half_t*)(p.ws + OFF_P);
    half_t* GQKV = (half_t*)(p.ws + OFF_GQKV); float* GBG = (float*)(p.ws + OFF_GBG);
    half_t* RW = (half_t*)(p.ws + OFF_RW); half_t* RLI = (half_t*)(p.ws + OFF_RLI);
    f32x4 kkv[2]; const float* mu = p.in[I_RMU] + (size_t)l * 1920;
    { const float* kkw = p.in[I_RKK] + (size_t)l * 512 + 8 * lane; kkv[0] = *(const f32x4*)(kkw); kkv[1] = *(const f32x4*)(kkw + 4); }
    const half8 z8 = {0, 0, 0, 0, 0, 0, 0, 0};
    for (int pr = blockIdx.x * 8 + wid; pr < RG / 2; pr += gridDim.x * 8) {
        const int rA = 2 * pr; const RowGeo q = row_geo(rA);
        { float acc[2][3][8];
#pragma unroll
          for (int t = 0; t < 2; ++t)
#pragma unroll
            for (int j = 0; j < 3; ++j)
#pragma unroll
                for (int e = 0; e < 8; ++e) acc[t][j][e] = 0.f;
#pragma unroll 1
          for (int kh = 0; kh < 3; ++kh) { const int nr = q.gr + kh - 1; if (nr < 0 || nr >= q.gh) continue;
            half8 col[4][3];
#pragma unroll
            for (int cc = 0; cc < 4; ++cc) { const int nc = q.gc - 1 + cc; const bool ok = nc >= 0 && nc < q.gw; const size_t nrow = (size_t)(q.base + nr * q.gw + (ok ? nc : 0));
#pragma unroll
                for (int j = 0; j < 3; ++j) col[cc][j] = ok ? *(const half8*)(P + nrow * NP + j * 512 + 8 * lane) : z8; }
#pragma unroll
            for (int kw = 0; kw < 3; ++kw)
#pragma unroll
                for (int j = 0; j < 3; ++j) { const LAS float* w = cw + (kh * 3 + kw) * 1536 + j * 512 + 8 * lane; const f32x4 w0 = *(const LAS f32x4*)w, w1 = *(const LAS f32x4*)(w + 4);
#pragma unroll
                    for (int e = 0; e < 4; ++e) { acc[0][j][e] += (float)col[kw][j][e] * w0[e]; acc[0][j][4 + e] += (float)col[kw][j][4 + e] * w1[e];
                        acc[1][j][e] += (float)col[kw + 1][j][e] * w0[e]; acc[1][j][4 + e] += (float)col[kw + 1][j][4 + e] * w1[e]; } } }
#pragma unroll
          for (int t = 0; t < 2; ++t) { const int r = rA + t;
#pragma unroll
            for (int j = 0; j < 3; ++j) {
                float ss = 0.f;
#pragma unroll
                for (int e = 0; e < 8; ++e) { acc[t][j][e] = siluf(acc[t][j][e]); ss += acc[t][j][e] * acc[t][j][e]; }
                float sc = 1.f;
                if (j < 2) { ss += SHFL_XOR(ss, 1); ss += SHFL_XOR(ss, 2); ss += SHFL_XOR(ss, 4); ss += SHFL_XOR(ss, 8); sc = frsq(ss + 1e-6f) * (j == 0 ? 0.08838834764831845f : 1.f); }
                half8 h;
#pragma unroll
                for (int e = 0; e < 8; ++e) h[e] = (half_t)(acc[t][j][e] * sc);
                *(half8*)(GQKV + (size_t)r * 1536 + j * 512 + 8 * lane) = h;
            }
            if (lane < 16) { const float x = (float)P[(size_t)r * NP + C_BG + lane];
                float o; if (lane < 8) o = sigm(x); else { const int idx = lane - 8; o = -fexp(p.in[I_GALOG][l * 8 + idx]) * softplusf(x + p.in[I_GDTB][l * 8 + idx]); }
                GBG[(size_t)r * 16 + lane] = o; } } }
        { const int rL = q.gc > 0 ? rA - 1 : -1, rR = q.gc + 2 < q.gw ? rA + 2 : -1, rUA = q.gr > 0 ? rA - q.gw : -1, rDA = q.gr < q.gh - 1 ? rA + q.gw : -1;
          float kmix[2][8];
#pragma unroll
          for (int jj = 0; jj < 2; ++jj) {
            half8 sA[2], sB[2], vL[2], vR[2], vUA[2], vUB[2], vDA[2], vDB[2]; f32x4 mu0[2], mu1[2];
#pragma unroll
            for (int ji = 0; ji < 2; ++ji) { const int j = 2 * jj + ji;
              const int la = (j == 3 && lane >= 48) ? 0 : lane;
              const int cj = j < 3 ? j * 512 + 8 * la : 1536 + 8 * la;
              const half_t* pc = P + C_RWKV + cj; mu0[ji] = *(const f32x4*)(mu + cj); mu1[ji] = *(const f32x4*)(mu + cj + 4);
              sA[ji] = *(const half8*)(pc + (size_t)rA * NP); sB[ji] = *(const half8*)(pc + (size_t)(rA + 1) * NP);
              vL[ji] = rL >= 0 ? *(const half8*)(pc + (size_t)rL * NP) : z8; vR[ji] = rR >= 0 ? *(const half8*)(pc + (size_t)rR * NP) : z8;
              vUA[ji] = rUA >= 0 ? *(const half8*)(pc + (size_t)rUA * NP) : z8; vUB[ji] = rUA >= 0 ? *(const half8*)(pc + (size_t)(rUA + 1) * NP) : z8;
              vDA[ji] = rDA >= 0 ? *(const half8*)(pc + (size_t)rDA * NP) : z8; vDB[ji] = rDA >= 0 ? *(const half8*)(pc + (size_t)(rDA + 1) * NP) : z8; }
            EPI_LOAD_FENCE();
#pragma unroll
            for (int ji = 0; ji < 2; ++ji) { const int j = 2 * jj + ji;
              if (j == 3 && lane >= 48) continue;
#pragma unroll
              for (int t = 0; t < 2; ++t) { const int r = rA + t;
                const half8 self = t ? sB[ji] : sA[ji], n0 = t ? sA[ji] : vL[ji], n1 = t ? vR[ji] : sB[ji], n2 = t ? vUB[ji] : vUA[ji], n3 = t ? vDB[ji] : vDA[ji];
                float val[8];
#pragma unroll
                for (int e = 0; e < 8; ++e) { const float s_ = (float)self[e]; const float nn = (float)((e & 3) == 0 ? n0[e] : (e & 3) == 1 ? n1[e] : (e & 3) == 2 ? n2[e] : n3[e]); val[e] = s_ + (nn - s_) * (e < 4 ? mu0[ji][e & 3] : mu1[ji][e & 3]); }
                half8 h;
                if (j < 3) {
#pragma unroll
                    for (int e = 0; e < 8; ++e) h[e] = (half_t)val[e];
                    *(half8*)(RW + ((size_t)r * 4 + j) * 512 + 8 * lane) = h;
                    if (j == 1) {
#pragma unroll
                        for (int e = 0; e < 8; ++e) kmix[t][e] = val[e]; }
                } else {
                    const int c0 = 8 * lane;
#pragma unroll
                    for (int e = 0; e < 8; ++e) { float v = val[e]; if (c0 < 128) v = ftanh(v); else if (c0 >= 256) v = sigm(v); h[e] = (half_t)v; }
                    *(half8*)(RLI + (size_t)r * 384 + c0) = h;
                } } } }
#pragma unroll
          for (int t = 0; t < 2; ++t) { float tt[8], ss = 0.f;
#pragma unroll
            for (int e = 0; e < 8; ++e) { tt[e] = kmix[t][e] * kkv[e >> 2][e & 3]; ss += tt[e] * tt[e]; }
            ss += SHFL_XOR(ss, 1); ss += SHFL_XOR(ss, 2); ss += SHFL_XOR(ss, 4);
            const float sc = frsq(ss + 1e-6f); half8 h;
#pragma unroll
            for (int e = 0; e < 8; ++e) h[e] = (half_t)(tt[e] * sc);
            *(half8*)(RW + ((size_t)(rA + t) * 4 + 3) * 512 + 8 * lane) = h; } }
    }
}

#ifndef CPU_EMU
__device__ __forceinline__ float shfl_up_f(float v, int off, int lane) { const float o = __int_as_float(__builtin_amdgcn_ds_bpermute(((lane - off) & 63) << 2, __float_as_int(v))); return lane >= off ? o : v; }
#else
static inline float shfl_up_f(float v, int off, int lane) { const float o = emu_shfl(v, (lane - off) & 63); return lane >= off ? o : v; }
#endif
__device__ __forceinline__ void ph_wy(int wb, const Params& p, int RG, LAS unsigned char* lds) {
#ifndef CPU_EMU
    const int tid = tid_fresh(wb), wid = __builtin_amdgcn_readfirstlane(tid >> 6), lane = tid & 63, fr = lane & 15, fq = lane >> 4;
#else
    const int tid = tid_fresh(wb), wid = tid >> 6, lane = tid & 63, fr = lane & 15, fq = lane >> 4;
#endif
    const int slot = wid >> 1, d = wid & 1;
    LAS half_t* Lm = (LAS half_t*)(lds + wid * 16896);
    LAS half_t* Xm = Lm + 4096;
    LAS float* Gv = (LAS float*)(Xm + 4096);
    LAS float* Bv = Gv + 64;
    const half_t* GQKV = (const half_t*)(p.ws + OFF_GQKV); const float* GBG = (const float*)(p.ws + OFF_GBG);
    half_t* GTA = (half_t*)(p.ws + OFF_GTA); float* GG = (float*)(p.ws + OFF_GG);
    const int n_items = (RG / 64) * 4;
    SYNC();
    for (int base = blockIdx.x * 4; base < n_items; base += gridDim.x * 4) {
        const int item = base + slot;
        if (item < n_items) {
            const int cidx = item >> 2, h = item & 3, r0 = cidx * 64;
            const size_t tb = (size_t)((cidx * 4 + h) * 2 + d);
            { const int nat = d ? 63 - lane : lane; const float beta = GBG[(size_t)(r0 + nat) * 16 + d * 4 + h]; float G = GBG[(size_t)(r0 + nat) * 16 + 8 + d * 4 + h];
#pragma unroll
              for (int off = 1; off < 64; off <<= 1) { const float o = shfl_up_f(G, off, lane); G = lane >= off ? G + o : G; }
              Gv[lane] = G; Bv[lane] = beta; GG[tb * 64 + lane] = G; }
            WAVE_SYNC();
            half8 kf[4][4];
#pragma unroll
            for (int t = 0; t < 4; ++t)
#pragma unroll
                for (int ks = 0; ks < 4; ++ks) kf[t][ks] = *(const half8*)(GQKV + (size_t)(r0 + 16 * t + fr) * 1536 + 512 + h * 128 + 32 * ks + 8 * fq);
#pragma unroll
            for (int ti = 0; ti < 4; ++ti)
#pragma unroll
                for (int tj = 0; tj < 4; ++tj) {
                    if (d ? (tj < ti) : (tj > ti)) continue;
                    f32x4 acc = {0.f, 0.f, 0.f, 0.f};
#pragma unroll
                    for (int ks = 0; ks < 4; ++ks) acc = MFMA16(kf[tj][ks], kf[ti][ks], acc);
                    const int i = 16 * ti + fr, ip = d ? 63 - i : i; const float gi = Gv[ip], bi = Bv[ip]; f32x4 val;
#pragma unroll
                    for (int e = 0; e < 4; ++e) { const int j = 16 * tj + 4 * fq + e, jp = d ? 63 - j : j; val[e] = (jp < ip) ? bi * acc[e] * fexp(gi - Gv[jp]) : 0.f; }
                    if (d) *(LAS half4*)(Lm + ip * 64 + 60 - 16 * tj - 4 * fq) = cvt4((f32x4){val[3], val[2], val[1], val[0]});
                    else *(LAS half4*)(Lm + ip * 64 + 16 * tj + 4 * fq) = cvt4(val);
                }
#pragma unroll
            for (int ti = 0; ti < 4; ++ti) {
                half8 qf[4];
#pragma unroll
                for (int ks = 0; ks < 4; ++ks) qf[ks] = *(const half8*)(GQKV + (size_t)(r0 + 16 * ti + fr) * 1536 + h * 128 + 32 * ks + 8 * fq);
#pragma unroll
                for (int tj = 0; tj < 4; ++tj) {
                    const int i = 16 * ti + fr, ip = d ? 63 - i : i; f32x4 val = {0.f, 0.f, 0.f, 0.f};
                    if (!(d ? (tj < ti) : (tj > ti))) {
                        f32x4 acc = {0.f, 0.f, 0.f, 0.f};
#pragma unroll
                        for (int ks = 0; ks < 4; ++ks) acc = MFMA16(kf[tj][ks], qf[ks], acc);
                        const float gi = Gv[ip];
#pragma unroll
                        for (int e = 0; e < 4; ++e) { const int j = 16 * tj + 4 * fq + e, jp = d ? 63 - j : j; val[e] = (jp <= ip) ? acc[e] * fexp(gi - Gv[jp]) : 0.f; }
                    }
                    half_t* ap = GTA + (tb * 2 + 1) * 4096 + ip * 64;
                    if (d) *(half4*)(ap + 60 - 16 * tj - 4 * fq) = cvt4((f32x4){val[3], val[2], val[1], val[0]});
                    else *(half4*)(ap + 16 * tj + 4 * fq) = cvt4(val);
                }
            }
            WAVE_SYNC();
#pragma unroll 1
            for (int bi = 0; bi < 4; ++bi) {
                const LAS half_t* Lb = Lm + bi * 16 * 64; float a[16];
                WAVE_SYNC();
                if (bi > 0) {
#pragma unroll 1
                    for (int ct = 0; ct < bi; ++ct) { f32x4 u4 = {0.f, 0.f, 0.f, 0.f};
#pragma unroll 1
                        for (int ks = 0; ks < (bi + 1) / 2; ++ks) {
                            half8 af = ldfrag(Lm, 16 * bi, 64, 32 * ks, lane), bf = ldfrag(Lm, 16 * ct, 64, 32 * ks, lane);
#pragma unroll
                            for (int e = 0; e < 8; ++e) { const int k = 32 * ks + 8 * fq + e; const bool ka = k < 16 * bi, kb = ka && k >= 16 * ct + fr;
                                af[e] = ka ? af[e] : (half_t)0.f; bf[e] = kb ? bf[e] : (half_t)0.f; }
                            u4 = MFMA16(af, bf, u4); }
#pragma unroll
                        for (int e = 0; e < 4; ++e) Xm[(16 * bi + 4 * fq + e) * 64 + 16 * ct + fr] = (half_t)u4[e]; }
                    WAVE_SYNC();
                }
#pragma unroll
                for (int ii = 0; ii < 16; ++ii) { a[ii] = (bi * 16 + ii == lane) ? 1.f : 0.f; if (lane < 16 * bi) a[ii] -= (float)Xm[(bi * 16 + ii) * 64 + lane]; }
#pragma unroll
                for (int ii = 0; ii < 16; ++ii) { float sacc = a[ii];
#pragma unroll
                    for (int mm = 0; mm < ii; ++mm) sacc -= (float)Lb[ii * 64 + bi * 16 + mm] * a[mm];
                    a[ii] = sacc; }
#pragma unroll
                for (int ii = 0; ii < 16; ++ii) { const half_t xh = (half_t)a[ii]; Xm[(bi * 16 + ii) * 64 + lane] = xh; if (bi * 16 + ii >= lane) Lm[lane * 64 + bi * 16 + ii] = xh; }
            }
            WAVE_SYNC();
#pragma unroll 1
            for (int t = 0; t < 8; ++t) { const int v = lane + 64 * t, i = v >> 3, j8 = (v & 7) * 8; const half8 x = *(const LAS half8*)(Xm + i * 64 + j8); half8 o;
#pragma unroll
                for (int e = 0; e < 8; ++e) o[e] = (half_t)((float)x[e] * Bv[j8 + e]);
                *(half8*)(GTA + (tb * 2 + 0) * 4096 + i * 64 + j8) = o; }
            WAVE_SYNC();
        }
    }
    SYNC();
}

__device__ __forceinline__ void scan_gdn(int wb, const Params& p, int bl, int gs, int h, int d, int mode, LAS unsigned char* lds) {
    const int tid = tid_fresh(wb), wid = tid >> 6, lane = tid & 63, fr = lane & 15, fq = lane >> 4;
    constexpr int L72 = 72, L136 = 136;
    LAS half_t* kT = (LAS half_t*)lds;
    LAS half_t* vT = kT + 128 * L72;
    LAS half_t* VNs = vT + 128 * L72;
    LAS half_t* Tb = VNs + 128 * L72;
    LAS half_t* Tbe = Tb + 64 * L72;
    LAS half_t* Am = Tbe + 64 * L72;
    LAS half_t* Qg = Am + 64 * L72;
    LAS half_t* Wn = Qg + 64 * L136;
    LAS half_t* ST = Wn + 64 * L136;
    LAS float* Es = (LAS float*)(ST + 128 * L136);
    const half_t* GQKV = (const half_t*)(p.ws + OFF_GQKV);
    const half_t* GTA = (const half_t*)(p.ws + OFF_GTA); const float* GG = (const float*)(p.ws + OFF_GG);
    half_t* SOG = (half_t*)(p.ws + OFF_SOG) + (size_t)d * RGP * 512;
    SYNC();
    for (int i = tid; i < 128 * L136 / 8; i += NT) *(LAS half8*)(ST + i * 8) = (half8){0, 0, 0, 0, 0, 0, 0, 0};
    SYNC();
    f32x4 accS[8];
#pragma unroll
    for (int u = 0; u < 8; ++u) accS[u] = (f32x4){0.f, 0.f, 0.f, 0.f};
    constexpr int nchC = CTXL / 64, nchL = SEQ / 64, NCS = nchC + nchL;
    half8 pT, pA, pq[2], pk[2], pv[2]; f32x4 pg0, pg1; float pgi[2], pG = 0.f, pGl = 0.f; int nr0 = 0, cr0 = 0;
    const int ti = tid >> 3, tj8 = (tid & 7) * 8;
    auto issue = [&](int cs) {
        const bool isc = cs < nchC; const int cl = isc ? cs : cs - nchC, nch = isc ? nchC : nchL, cn = d ? nch - 1 - cl : cl;
        const int r0 = (isc ? RL + gs * CTXL : bl * SEQ) + cn * 64; nr0 = r0;
        const size_t tb = (size_t)(((r0 >> 6) * 4 + h) * 2 + d);
        pT = *(const half8*)(GTA + (tb * 2 + 0) * 4096 + ti * 64 + tj8); pA = *(const half8*)(GTA + (tb * 2 + 1) * 4096 + ti * 64 + tj8);
        pg0 = *(const f32x4*)(GG + tb * 64 + tj8); pg1 = *(const f32x4*)(GG + tb * 64 + tj8 + 4);
#pragma unroll
        for (int t = 0; t < 2; ++t) { const int v = tid + NT * t, i = v >> 4, c8 = (v & 15) * 8, nat = d ? 63 - i : i;
            pq[t] = *(const half8*)(GQKV + (size_t)(r0 + nat) * 1536 + h * 128 + c8); pgi[t] = GG[tb * 64 + i]; }
#pragma unroll
        for (int t = 0; t < 2; ++t) { const int g = wid + 8 * t, nat = d ? 63 - lane : lane;
            pk[t] = *(const half8*)(GQKV + (size_t)(r0 + nat) * 1536 + 512 + h * 128 + 8 * g); pv[t] = *(const half8*)(GQKV + (size_t)(r0 + nat) * 1536 + 1024 + h * 128 + 8 * g); }
        pG = GG[tb * 64 + (tid & 63)]; pGl = GG[tb * 64 + 63];
    };
    const int cs0 = mode == 2 ? nchC : 0, cs1 = mode == 1 ? nchC : NCS;
    const int sv = gs >= BG ? gs - BG : 0;
    f32x4* gst = (f32x4*)(p.ws + OFF_GST) + ((size_t)((sv * 4 + h) * 2 + d) * 8 + wid) * 512;
    if (mode == 2) {
#pragma unroll
        for (int u = 0; u < 8; ++u) { accS[u] = gst[u * 64 + lane]; *(LAS half4*)(ST + (16 * wid + fr) * L136 + 16 * u + 4 * fq) = cvt4(accS[u]); }
        WAVE_SYNC();
    }
    issue(cs0);
    for (int cs = cs0; cs < cs1; ++cs) {
        SYNC();
        { half8 te; const float ge[8] = {pg0[0], pg0[1], pg0[2], pg0[3], pg1[0], pg1[1], pg1[2], pg1[3]};
#pragma unroll
          for (int e = 0; e < 8; ++e) te[e] = (half_t)((float)pT[e] * fexp(ge[e]));
          *(LAS half8*)(Tb + ti * L72 + tj8) = pT; *(LAS half8*)(Tbe + ti * L72 + tj8) = te; *(LAS half8*)(Am + ti * L72 + tj8) = pA; }
#pragma unroll
        for (int t = 0; t < 2; ++t) { const int v = tid + NT * t, i = v >> 4, c8 = (v & 15) * 8; const float sc = fexp(pgi[t]); half8 o;
#pragma unroll
            for (int e = 0; e < 8; ++e) o[e] = (half_t)((float)pq[t][e] * sc);
            *(LAS half8*)(Qg + i * L136 + c8) = o; }
#pragma unroll
        for (int t = 0; t < 2; ++t) { const int g = wid + 8 * t;
#pragma unroll
            for (int e = 0; e < 8; ++e) { kT[(8 * g + e) * L72 + lane] = pk[t][e]; vT[(8 * g + e) * L72 + lane] = pv[t][e]; } }
        if (tid < 64) Es[tid] = fexp(pGl - pG);
        const float dec = fexp(pGl);
        cr0 = nr0;
        if (cs + 1 < cs1) issue(cs + 1);
        SYNC();
        { f32x4 acc[4];
#pragma unroll
          for (int t = 0; t < 4; ++t) acc[t] = (f32x4){0.f, 0.f, 0.f, 0.f};
#pragma unroll
          for (int k2 = 0; k2 < 2; ++k2) { const half8 a = ldfrag(kT, 16 * wid, L72, 32 * k2, lane);
#pragma unroll
              for (int t = 0; t < 4; ++t) acc[t] = MFMA16(a, ldfrag(Tbe, 16 * t, L72, 32 * k2, lane), acc[t]); }
#pragma unroll
          for (int t = 0; t < 4; ++t) *(LAS half4*)(Wn + (16 * t + fr) * L136 + 16 * wid + 4 * fq) = cvt4(-acc[t]); }
        SYNC();
        { f32x4 acc[4];
#pragma unroll
          for (int t = 0; t < 4; ++t) acc[t] = (f32x4){0.f, 0.f, 0.f, 0.f};
#pragma unroll
          for (int k2 = 0; k2 < 2; ++k2) { const half8 b = ldfrag(vT, 16 * wid, L72, 32 * k2, lane);
#pragma unroll
              for (int t = 0; t < 4; ++t) acc[t] = MFMA16(ldfrag(Tb, 16 * t, L72, 32 * k2, lane), b, acc[t]); }
#pragma unroll
          for (int k4 = 0; k4 < 4; ++k4) { const half8 b = ldfrag(ST, 16 * wid, L136, 32 * k4, lane);
#pragma unroll
              for (int t = 0; t < 4; ++t) acc[t] = MFMA16(ldfrag(Wn, 16 * t, L136, 32 * k4, lane), b, acc[t]); }
          WAVE_SYNC();
#pragma unroll
          for (int t = 0; t < 4; ++t) { const f32x4 es = *(const LAS f32x4*)(Es + 16 * t + 4 * fq);
              *(LAS half4*)(vT + (16 * wid + fr) * L72 + 16 * t + 4 * fq) = cvt4(acc[t]); *(LAS half4*)(VNs + (16 * wid + fr) * L72 + 16 * t + 4 * fq) = cvt4(acc[t] * es); } }
        WAVE_SYNC();
        { f32x4 acc[4];
#pragma unroll
          for (int t = 0; t < 4; ++t) acc[t] = (f32x4){0.f, 0.f, 0.f, 0.f};
#pragma unroll
          for (int k4 = 0; k4 < 4; ++k4) { const half8 a = ldfrag(ST, 16 * wid, L136, 32 * k4, lane);
#pragma unroll
              for (int t = 0; t < 4; ++t) acc[t] = MFMA16(a, ldfrag(Qg, 16 * t, L136, 32 * k4, lane), acc[t]); }
#pragma unroll
          for (int k2 = 0; k2 < 2; ++k2) { const half8 a = ldfrag(vT, 16 * wid, L72, 32 * k2, lane);
#pragma unroll
              for (int t = 0; t < 4; ++t) acc[t] = MFMA16(a, ldfrag(Am, 16 * t, L72, 32 * k2, lane), acc[t]); }
#pragma unroll
          for (int t = 0; t < 4; ++t) { const int i = 16 * t + fr, nat = d ? 63 - i : i;
              *(half4*)(SOG + (size_t)(cr0 + nat) * 512 + h * 128 + 16 * wid + 4 * fq) = cvt4(acc[t]); } }
#pragma unroll
        for (int u = 0; u < 8; ++u) accS[u] = accS[u] * dec;
#pragma unroll
        for (int k2 = 0; k2 < 2; ++k2) { const half8 b = ldfrag(VNs, 16 * wid, L72, 32 * k2, lane);
#pragma unroll
            for (int u = 0; u < 8; ++u) accS[u] = MFMA16(ldfrag(kT, 16 * u, L72, 32 * k2, lane), b, accS[u]); }
        WAVE_SYNC();
#pragma unroll
        for (int u = 0; u < 8; ++u) *(LAS half4*)(ST + (16 * wid + fr) * L136 + 16 * u + 4 * fq) = cvt4(accS[u]);
        WAVE_SYNC();
    }
    if (mode == 1) {
#pragma unroll
        for (int u = 0; u < 8; ++u) gst[u * 64 + lane] = accS[u];
    }
}

__device__ __forceinline__ void scan_mlstm(int wb, const Params& p, int l, int bl, int gs, int h, int d, int mode, LAS unsigned char* lds) {
    const int tid = tid_fresh(wb), wid = tid >> 6, lane = tid & 63, fr = lane & 15, fq = lane >> 4;
    constexpr int L72 = 72;
    LAS half_t* q = (LAS half_t*)lds;
    LAS half_t* k = q + 64 * L72;
    LAS half_t* kT = k + 64 * L72;
    LAS half_t* vT = kT + 64 * L72;
    LAS half_t* Pm = vT + 128 * L72;
    LAS half_t* CT = Pm + 64 * L72;
    LAS half_t* nvec = CT + 128 * L72 + 64 * wid;
    LAS float* lfv = (LAS float*)(CT + 128 * L72 + 64 * 8);
    LAS float* igv = lfv + 64;
    LAS float* rowv = igv + 64;
    LAS float* colv = rowv + 64;
    LAS float* interv = colv + 64;
    LAS float* emtv = interv + 64;
    LAS float* wscv = emtv + 64;
    const half_t* P = (const half_t*)(p.ws + OFF_P);
    half_t* SOM = (half_t*)(p.ws + OFF_SOM) + (size_t)d * RGP * 512;
    const float ibias = p.in[I_MIB][l * 8 + d * 4 + h], fbias = p.in[I_MFB][l * 8 + d * 4 + h];
    SYNC();
    for (int i = tid; i < 128 * L72 / 8; i += NT) *(LAS half8*)(CT + i * 8) = (half8){0, 0, 0, 0, 0, 0, 0, 0};
    nvec[lane] = (half_t)0.f;
    f32x4 accC[4], accN[4];
#pragma unroll
    for (int u = 0; u < 4; ++u) { accC[u] = (f32x4){0.f, 0.f, 0.f, 0.f}; accN[u] = (f32x4){0.f, 0.f, 0.f, 0.f}; }
    float m = 0.f;
    constexpr int nchC = CTXL / 64, nchL = SEQ / 64, NCS = nchC + nchL;
    half8 pq, pk, pv[2]; half_t pig = (half_t)0.f, pfg = (half_t)0.f; int nr0 = 0, cr0 = 0;
    const half8 ones = {1, 1, 1, 1, 1, 1, 1, 1};
    auto issue = [&](int cs) {
        const bool isc = cs < nchC; const int cl = isc ? cs : cs - nchC, nch = isc ? nchC : nchL, cn = d ? nch - 1 - cl : cl;
        const int r0 = (isc ? RL + gs * CTXL : bl * SEQ) + cn * 64; nr0 = r0;
        const int nat = d ? 63 - lane : lane; const half_t* pr = P + (size_t)(r0 + nat) * NP + C_ML;
        pq = *(const half8*)(pr + h * 64 + 8 * wid); pk = *(const half8*)(pr + 256 + h * 64 + 8 * wid);
        pv[0] = *(const half8*)(pr + 512 + h * 128 + 8 * wid); pv[1] = *(const half8*)(pr + 512 + h * 128 + 8 * (wid + 8));
        if (tid < 64) { const half_t* pg = P + (size_t)(r0 + (d ? 63 - tid : tid)) * NP; pig = pg[C_MLIG + d * 4 + h]; pfg = pg[C_MLFG + d * 4 + h]; }
    };
    const int cs0 = mode == 2 ? nchC : 0, cs1 = mode == 1 ? nchC : NCS;
    const int sv = gs >= BG ? gs - BG : 0;
    f32x4* mst = (f32x4*)(p.ws + OFF_MST) + ((size_t)((sv * 4 + h) * 2 + d) * 8 + wid) * 512; float* msm = (float*)(p.ws + OFF_MSM) + ((sv * 4 + h) * 2 + d);
    SYNC();
    if (mode == 2) {
#pragma unroll
        for (int u = 0; u < 4; ++u) { accC[u] = mst[u * 64 + lane]; accN[u] = mst[(4 + u) * 64 + lane];
            *(LAS half4*)(CT + (16 * wid + fr) * L72 + 16 * u + 4 * fq) = cvt4(accC[u]); if (fr == 0) *(LAS half4*)(nvec + 16 * u + 4 * fq) = cvt4(accN[u]); }
        m = *msm;
        WAVE_SYNC();
    }
    issue(cs0);
    for (int cs = cs0; cs < cs1; ++cs) {
        SYNC();
        { half8 qs;
#pragma unroll
          for (int e = 0; e < 8; ++e) qs[e] = (half_t)((float)pq[e] * 0.125f);
          *(LAS half8*)(q + lane * L72 + 8 * wid) = qs; *(LAS half8*)(k + lane * L72 + 8 * wid) = pk;
#pragma unroll
          for (int e = 0; e < 8; ++e) { kT[(8 * wid + e) * L72 + lane] = pk[e]; vT[(8 * wid + e) * L72 + lane] = pv[0][e]; vT[(8 * (wid + 8) + e) * L72 + lane] = pv[1][e]; } }
        if (tid < 64) { igv[tid] = (float)pig + ibias; lfv[tid] = -softplusf(-((float)pfg + fbias)); }
        cr0 = nr0;
        if (cs + 1 < cs1) issue(cs + 1);
        SYNC();
        float dec;
        { float b = lfv[lane];
#pragma unroll
          for (int off = 1; off < 64; off <<= 1) { const float o = shfl_up_f(b, off, lane); b = lane >= off ? b + o : b; }
          const float cm = igv[lane] - b; float pm = cm;
#pragma unroll
          for (int off = 1; off < 64; off <<= 1) { const float o = shfl_up_f(pm, off, lane); pm = lane >= off ? fmaxf(pm, o) : pm; }
#ifndef CPU_EMU
          const float b_last = __int_as_float(__builtin_amdgcn_readlane(__float_as_int(b), 63)), pm_last = __int_as_float(__builtin_amdgcn_readlane(__float_as_int(pm), 63));
#else
          const float b_last = emu_shfl(b, 63), pm_last = emu_shfl(pm, 63);
#endif
          const float mt = fmaxf(b + m, b + pm), m_new = fmaxf(b_last + m, b_last + pm_last);
          rowv[lane] = b - mt; colv[lane] = cm; interv[lane] = fexp(b + m - mt); emtv[lane] = fexp(-mt); wscv[lane] = fexp(b_last + cm - m_new);
          dec = fexp(b_last + m - m_new); m = m_new; }
        WAVE_SYNC();
#pragma unroll
        for (int tt = 0; tt < 2; ++tt) { const int idx = 2 * wid + tt, ti = idx >> 2, tj = idx & 3;
            f32x4 acc = {0.f, 0.f, 0.f, 0.f};
            if (tj <= ti) {
#pragma unroll
                for (int k2 = 0; k2 < 2; ++k2) acc = MFMA16(ldfrag(k, 16 * tj, L72, 32 * k2, lane), ldfrag(q, 16 * ti, L72, 32 * k2, lane), acc);
                const int i = 16 * ti + fr; const float rv = rowv[i]; const f32x4 cv = *(const LAS f32x4*)(colv + 16 * tj + 4 * fq);
#pragma unroll
                for (int e = 0; e < 4; ++e) { const int j = 16 * tj + 4 * fq + e; acc[e] = (j <= i) ? acc[e] * fexp(rv + cv[e]) : 0.f; }
            }
            *(LAS half4*)(Pm + (16 * ti + fr) * L72 + 16 * tj + 4 * fq) = cvt4(acc); }
        SYNC();
        { f32x4 a1[4], a2[4], d1[4], d2[4];
#pragma unroll
          for (int t = 0; t < 4; ++t) { a1[t] = (f32x4){0.f, 0.f, 0.f, 0.f}; a2[t] = a1[t]; d1[t] = a1[t]; d2[t] = a1[t]; }
#pragma unroll
          for (int k2 = 0; k2 < 2; ++k2) { const half8 ac = ldfrag(CT, 16 * wid, L72, 32 * k2, lane), av = ldfrag(vT, 16 * wid, L72, 32 * k2, lane);
              const half8 an = *(const LAS half8*)(nvec + 32 * k2 + 8 * fq);
#pragma unroll
              for (int t = 0; t < 4; ++t) { const half8 bq = ldfrag(q, 16 * t, L72, 32 * k2, lane), bp = ldfrag(Pm, 16 * t, L72, 32 * k2, lane);
                  a1[t] = MFMA16(ac, bq, a1[t]); a2[t] = MFMA16(av, bp, a2[t]); d1[t] = MFMA16(an, bq, d1[t]); d2[t] = MFMA16(ones, bp, d2[t]); } }
#pragma unroll
          for (int t = 0; t < 4; ++t) { const int i = 16 * t + fr, nat = d ? 63 - i : i; const float it = interv[i];
              const float den = it * d1[t][0] + d2[t][0], dn = frcp(fmaxf(fabsf(den), emtv[i]));
              *(half4*)(SOM + (size_t)(cr0 + nat) * 512 + h * 128 + 16 * wid + 4 * fq) = cvt4((a1[t] * it + a2[t]) * dn); } }
#pragma unroll
        for (int u = 0; u < 4; ++u) { accC[u] = accC[u] * dec; accN[u] = accN[u] * dec; }
#pragma unroll
        for (int k2 = 0; k2 < 2; ++k2) { const half8 bv = ldfrag(vT, 16 * wid, L72, 32 * k2, lane);
            const f32x4 w0 = *(const LAS f32x4*)(wscv + 32 * k2 + 8 * fq), w1 = *(const LAS f32x4*)(wscv + 32 * k2 + 8 * fq + 4);
#pragma unroll
            for (int u = 0; u < 4; ++u) { const half8 raw = ldfrag(kT, 16 * u, L72, 32 * k2, lane); half8 ak;
#pragma unroll
                for (int e = 0; e < 4; ++e) { ak[e] = (half_t)((float)raw[e] * w0[e]); ak[4 + e] = (half_t)((float)raw[4 + e] * w1[e]); }
                accC[u] = MFMA16(ak, bv, accC[u]); accN[u] = MFMA16(ak, ones, accN[u]); } }
        WAVE_SYNC();
#pragma unroll
        for (int u = 0; u < 4; ++u) { *(LAS half4*)(CT + (16 * wid + fr) * L72 + 16 * u + 4 * fq) = cvt4(accC[u]);
            if (fr == 0) *(LAS half4*)(nvec + 16 * u + 4 * fq) = cvt4(accN[u]); }
        WAVE_SYNC();
    }
    if (mode == 1) {
#pragma unroll
        for (int u = 0; u < 4; ++u) { mst[u * 64 + lane] = accC[u]; mst[(4 + u) * 64 + lane] = accN[u]; }
        if (tid == 0) *msm = m;
    }
}

#ifndef CPU_EMU
template <int CTRL> __device__ __forceinline__ float dpp_f(float v) { return __int_as_float(__builtin_amdgcn_update_dpp(0, __float_as_int(v), CTRL, 0xf, 0xf, true)); }
#define DPPX1(v) dpp_f<0xB1>(v)
#define DPPX2(v) dpp_f<0x4E>(v)
#define DPPHM(v) dpp_f<0x141>(v)
#define RED8(v) do { v += dpp_f<0xB1>(v); v += dpp_f<0x4E>(v); v += dpp_f<0x141>(v); } while (0)
#define RED16(v) do { RED8(v); v += dpp_f<0x140>(v); } while (0)
#else
#define DPPX1(v) emu_shfl_xor((v), 1)
#define DPPX2(v) emu_shfl_xor((v), 2)
#define DPPHM(v) emu_shfl_xor((v), 7)
#define RED8(v) do { v += emu_shfl_xor(v, 1); v += emu_shfl_xor(v, 2); v += emu_shfl_xor(v, 7); } while (0)
#define RED16(v) do { RED8(v); v += emu_shfl_xor(v, 15); } while (0)
#endif
__device__ __forceinline__ void scan_rwkv(int wb, const Params& p, int l, int bl, int gs, int h, int d, int row0, int ncw, int mode, LAS unsigned char* lds) {
#ifndef CPU_EMU
    const int tid = tid_fresh(wb), wid = __builtin_amdgcn_readfirstlane(tid >> 6), lane = tid & 63;
#else
    const int tid = tid_fresh(wb), wid = tid >> 6, lane = tid & 63;
#endif
    constexpr int NB = 32, NPR = NB / 2, REC = 712;
    LAS float* st = (LAS float*)lds;
    const half_t* RW = (const half_t*)(p.ws + OFF_RW); const half_t* RLO = (const half_t*)(p.ws + OFF_RLO);
    bf16_t* SOR = (bf16_t*)(p.ws + OFF_SOR) + (size_t)d * RGP * 512;
    const int nb0 = mode == 2 ? CTXL / NB : 0, nb1 = mode == 1 ? CTXL / NB : (CTXL + SEQ) / NB;
    auto step_row = [&](int sidx) -> size_t { return sidx < CTXL ? (size_t)(RL + gs * CTXL + (d ? CTXL - 1 - sidx : sidx)) : (size_t)(bl * SEQ + (d ? SEQ - 1 - (sidx - CTXL) : sidx - CTXL)); };
    SYNC();
    if (wid >= 4) {
        const int pt = tid - 256, lp = pt >> 4, cq = pt & 15, lc = h * 64 + 4 * cq;
        const f32x4 ka = *(const f32x4*)(p.in[I_RKA] + (size_t)l * 512 + lc);
        half4 g_r[2], g_k[2], g_v[2], g_kk[2], g_e[2], g_a[2];
        auto issue = [&](int n) {
#pragma unroll
            for (int q = 0; q < 2; ++q) { const size_t row = step_row(n * NB + 2 * lp + q);
                g_r[q] = *(const half4*)(RW + (row * 4 + 0) * 512 + lc); g_k[q] = *(const half4*)(RW + (row * 4 + 1) * 512 + lc); g_v[q] = *(const half4*)(RW + (row * 4 + 2) * 512 + lc); g_kk[q] = *(const half4*)(RW + (row * 4 + 3) * 512 + lc);
                g_e[q] = *(const half4*)(RLO + row * 2560 + d * 512 + lc); g_a[q] = *(const half4*)(RLO + row * 2560 + 1024 + d * 512 + lc); } };
        auto stage = [&](int buf) { LAS float* o = st + (buf * NPR + lp) * REC + 4 * cq;
            f32x4 oa, owa, owr, owwr, oww, obw, okw, obu, oku, ovt, ovu; float c[8];
#pragma unroll
            for (int i = 0; i < 8; ++i) c[i] = 0.f;
#pragma unroll
            for (int e = 0; e < 4; ++e) {
                const float rt = (float)g_r[0][e], kt = (float)g_k[0][e], kkt = (float)g_kk[0][e], at = (float)g_a[0][e], wt = fexp(-(float)g_e[0][e]);
                const float ru = (float)g_r[1][e], ku = (float)g_k[1][e], kku = (float)g_kk[1][e], au = (float)g_a[1][e], wu = fexp(-(float)g_e[1][e]);
                const float kdt = kt * (1.f + (at - 1.f) * ka[e]), bt = kkt * at, kdu = ku * (1.f + (au - 1.f) * ka[e]), bu = kku * au, amu = -kku;
                const float bw = bt * wu, kw = kdt * wu;
                oa[e] = -kkt; owa[e] = wt * amu; owr[e] = wt * rt; owwr[e] = wt * wu * ru; oww[e] = wt * wu; obw[e] = bw; okw[e] = kw; obu[e] = bu; oku[e] = kdu; ovt[e] = (float)g_v[0][e]; ovu[e] = (float)g_v[1][e];
                c[0] += bt * amu; c[1] += kdt * amu; c[2] += bt * rt; c[3] += kdt * rt; c[4] += bw * ru; c[5] += kw * ru; c[6] += bu * ru; c[7] += kdu * ru; }
            *(LAS f32x4*)(o) = oa; *(LAS f32x4*)(o + 64) = owa; *(LAS f32x4*)(o + 128) = owr; *(LAS f32x4*)(o + 192) = owwr; *(LAS f32x4*)(o + 256) = oww; *(LAS f32x4*)(o + 320) = obw;
            *(LAS f32x4*)(o + 384) = okw; *(LAS f32x4*)(o + 448) = obu; *(LAS f32x4*)(o + 512) = oku; *(LAS f32x4*)(o + 576) = ovt; *(LAS f32x4*)(o + 640) = ovu;
#pragma unroll
            for (int i = 0; i < 8; ++i) RED16(c[i]);
            if (cq == 0) { LAS float* sc = st + (buf * NPR + lp) * REC + 704;
                *(LAS f32x4*)(sc) = (f32x4){c[0], c[1], c[2] * 0.125f, c[3] * 0.125f}; *(LAS f32x4*)(sc + 4) = (f32x4){c[4] * 0.125f, c[5] * 0.125f, c[6] * 0.125f, c[7] * 0.125f}; } };
        issue(nb0); stage(nb0 & 1);
        if (nb0 + 1 < nb1) issue(nb0 + 1);
        SYNC();
        for (int n = nb0; n < nb1; ++n) {
            if (n + 1 < nb1) { stage((n + 1) & 1); if (n + 2 < nb1) issue(n + 2); }
            SYNC();
        }
    } else if (wid >= ncw) {
        SYNC();
        for (int n = nb0; n < nb1; ++n) SYNC();
    } else {
        const int rr = row0 + 8 * wid + (lane >> 3), ks = lane & 7;
        f32x2 s2[4];
#pragma unroll
        for (int e = 0; e < 4; ++e) s2[e] = (f32x2){0.f, 0.f};
        const int sv = gs >= BG ? gs - BG : 0;
        f32x2* rst = (f32x2*)((float*)(p.ws + OFF_RST) + ((size_t)((sv * 8 + h) * 2 + d) * 64 + rr) * 64 + 8 * ks);
        if (mode == 2) {
#pragma unroll
            for (int e = 0; e < 4; ++e) s2[e] = rst[e]; }
        SYNC();
#ifndef CPU_EMU
        __builtin_amdgcn_s_setprio(3);
#endif
#define LO2(v) __builtin_shufflevector(v, v, 0, 1)
#define HI2(v) __builtin_shufflevector(v, v, 2, 3)
        for (int n = nb0; n < nb1; ++n) {
            const int buf = n & 1;
            f32x4 xa0, xa1, xwa0, xwa1, xwr0, xwr1, xwq0, xwq1, ya0, ya1, ywa0, ywa1, ywr0, ywr1, ywq0, ywq1;
#define RWKV_LOADD(A0, A1, WA0, WA1, WR0, WR1, WQ0, WQ1, P_) do { const LAS float* o_ = st + (buf * NPR + (P_)) * REC + 8 * ks; \
                A0 = *(const LAS f32x4*)(o_); A1 = *(const LAS f32x4*)(o_ + 4); WA0 = *(const LAS f32x4*)(o_ + 64); WA1 = *(const LAS f32x4*)(o_ + 68); \
                WR0 = *(const LAS f32x4*)(o_ + 128); WR1 = *(const LAS f32x4*)(o_ + 132); WQ0 = *(const LAS f32x4*)(o_ + 192); WQ1 = *(const LAS f32x4*)(o_ + 196); } while (0)
#define RWKV_PAIR(A0, A1, WA0, WA1, WR0, WR1, WQ0, WQ1, PI, J) do { \
                const LAS float* o = st + (buf * NPR + (PI)) * REC; \
                const f32x4 ww0 = *(const LAS f32x4*)(o + 256 + 8 * ks), ww1 = *(const LAS f32x4*)(o + 260 + 8 * ks), bw0 = *(const LAS f32x4*)(o + 320 + 8 * ks), bw1 = *(const LAS f32x4*)(o + 324 + 8 * ks); \
                const f32x4 kw0 = *(const LAS f32x4*)(o + 384 + 8 * ks), kw1 = *(const LAS f32x4*)(o + 388 + 8 * ks), bu0 = *(const LAS f32x4*)(o + 448 + 8 * ks), bu1 = *(const LAS f32x4*)(o + 452 + 8 * ks); \
                const f32x4 ku0 = *(const LAS f32x4*)(o + 512 + 8 * ks), ku1 = *(const LAS f32x4*)(o + 516 + 8 * ks); \
                const float vt = o[576 + rr], vu = o[640 + rr]; const f32x4 sc0 = *(const LAS f32x4*)(o + 704), sc1 = *(const LAS f32x4*)(o + 708); \
                const f32x2 e1 = (s2[0] * LO2(A0) + s2[1] * HI2(A0)) + (s2[2] * LO2(A1) + s2[3] * HI2(A1)); \
                const f32x2 e2 = (s2[0] * LO2(WA0) + s2[1] * HI2(WA0)) + (s2[2] * LO2(WA1) + s2[3] * HI2(WA1)); \
                const f32x2 e3 = (s2[0] * LO2(WR0) + s2[1] * HI2(WR0)) + (s2[2] * LO2(WR1) + s2[3] * HI2(WR1)); \
                const f32x2 e4 = (s2[0] * LO2(WQ0) + s2[1] * HI2(WQ0)) + (s2[2] * LO2(WQ1) + s2[3] * HI2(WQ1)); \
                float sat = e1[0] + e1[1], d2 = e2[0] + e2[1]; \
                RED8(sat); RED8(d2); \
                const f32x2 vtv = {vt, vt}, vuv = {vu, vu}; \
                const f32x2 pre0 = (s2[0] * LO2(ww0) + vtv * LO2(kw0)) + vuv * LO2(ku0), pre1 = (s2[1] * HI2(ww0) + vtv * HI2(kw0)) + vuv * HI2(ku0); \
                const f32x2 pre2 = (s2[2] * LO2(ww1) + vtv * LO2(kw1)) + vuv * LO2(ku1), pre3 = (s2[3] * HI2(ww1) + vtv * HI2(kw1)) + vuv * HI2(ku1); \
                const float ypt = (e3[0] + e3[1]) + vt * sc0[3], ypu = (e4[0] + e4[1]) + (vt * sc1[1] + vu * sc1[3]); \
                const float sau = (d2 + vt * sc0[1]) + sat * sc0[0]; \
                const f32x2 satv = {sat, sat}, sauv = {sau, sau}; \
                s2[0] = (satv * LO2(bw0) + pre0) + sauv * LO2(bu0); s2[1] = (satv * HI2(bw0) + pre1) + sauv * HI2(bu0); \
                s2[2] = (satv * LO2(bw1) + pre2) + sauv * LO2(bu1); s2[3] = (satv * HI2(bw1) + pre3) + sauv * HI2(bu1); \
                yp[2 * (J)] = ypt + sat * sc0[2]; yp[2 * (J) + 1] = (ypu + sat * sc1[0]) + sau * sc1[2]; } while (0)
#ifndef CPU_EMU
#define RWKV_FENCE() asm volatile("" ::: "memory")
#else
#define RWKV_FENCE()
#endif
            RWKV_LOADD(xa0, xa1, xwa0, xwa1, xwr0, xwr1, xwq0, xwq1, 0);
#pragma unroll 1
            for (int th = 0; th < NPR / 2; ++th) {
                float yp[4];
                RWKV_LOADD(ya0, ya1, ywa0, ywa1, ywr0, ywr1, ywq0, ywq1, 2 * th + 1);
                RWKV_PAIR(xa0, xa1, xwa0, xwa1, xwr0, xwr1, xwq0, xwq1, 2 * th, 0);
                RWKV_FENCE();
                { const int pn = 2 * th + 2 < NPR ? 2 * th + 2 : NPR - 1;
                  RWKV_LOADD(xa0, xa1, xwa0, xwa1, xwr0, xwr1, xwq0, xwq1, pn); }
                RWKV_PAIR(ya0, ya1, ywa0, ywa1, ywr0, ywr1, ywq0, ywq1, 2 * th + 1, 1);
                RWKV_FENCE();
                { const bool c0 = ((ks ^ (ks >> 2)) & 1) != 0, c1 = (((ks >> 1) ^ (ks >> 2)) & 1) != 0;
                  const float k20 = (c0 ? yp[1] : yp[0]) + DPPX1(c0 ? yp[0] : yp[1]), k21 = (c0 ? yp[3] : yp[2]) + DPPX1(c0 ? yp[2] : yp[3]);
                  float k1 = (c1 ? k21 : k20) + DPPX2(c1 ? k20 : k21);
                  k1 += DPPHM(k1);
                  if (ks < 4) SOR[step_row(n * NB + th * 4 + ks) * 512 + h * 64 + rr] = f2bf(k1); }
            }
#undef RWKV_PAIR
#undef RWKV_FENCE
#undef RWKV_LOADD
            SYNC();
        }
#undef LO2
#undef HI2
#ifndef CPU_EMU
        __builtin_amdgcn_s_setprio(0);
#endif
        if (mode == 1) {
#pragma unroll
            for (int e = 0; e < 4; ++e) rst[e] = s2[e]; }
    }
}

__device__ __forceinline__ void ph_scan(int wb, const Params& p, int l, int g, LAS unsigned char* lds) {
    constexpr int NL_R = BG * 32, NL_G = BG * 8, NL_M = BG * 8, NLONG = NL_R + NL_G + NL_M;
    const int G = gridDim.x, c = blockIdx.x;
    const int nsm = g == 0 ? BATCH - BG : 0, NS_R = nsm * 32, NS_G = nsm * 8, NS_M = nsm * 8;
    const int nfree = G - NLONG, sstr = nfree > 0 ? nfree : G, sst = nfree > 0 ? c - NLONG : c;
    const bool has_short = nfree > 0 ? c >= NLONG : true;
    const int lmode = g == 0 ? 0 : 2;
    auto first = [](int lo, int st, int stride) { return lo + (((st - lo) % stride) + stride) % stride; };
#pragma unroll 1
    for (int q = 0; q < 2; ++q) {
        const int lo = 0, n = q ? (has_short ? NS_R : 0) : NL_R, st = q ? sst : c, str = q ? sstr : G;
        if (!(SKIP_MASK & 65536)) for (int it = first(lo, st, str); it < n; it += str) REPS(65536) {
            const int half = it & 1, d = (it >> 1) & 1, h = (it >> 2) & 7, b = it >> 5;
            scan_rwkv(wb, p, l, q ? 0 : b, q ? BG + b : g * BG + b, h, d, 32 * half, 4, q ? 1 : lmode, lds); SYNC(); }
    }
#pragma unroll 1
    for (int q = 0; q < 2; ++q) {
        const int lo = q ? NS_R : NL_R, n = q ? (has_short ? NS_R + NS_G : 0) : NL_R + NL_G, st = q ? sst : c, str = q ? sstr : G;
        if (!(SKIP_MASK & 131072)) for (int it = first(lo, st, str); it < n; it += str) REPS(131072) {
            const int i2 = it - lo, d = i2 & 1, h = (i2 >> 1) & 3, b = i2 >> 3;
            scan_gdn(wb, p, q ? 0 : b, q ? BG + b : g * BG + b, h, d, q ? 1 : lmode, lds); SYNC(); }
    }
#pragma unroll 1
    for (int q = 0; q < 2; ++q) {
        const int lo = q ? NS_R + NS_G : NL_R + NL_G, n = q ? (has_short ? NS_R + NS_G + NS_M : 0) : NLONG, st = q ? sst : c, str = q ? sstr : G;
        if (!(SKIP_MASK & 262144)) for (int it = first(lo, st, str); it < n; it += str) REPS(262144) {
            const int i2 = it - lo, d = i2 & 1, h = (i2 >> 1) & 3, b = i2 >> 3;
            scan_mlstm(wb, p, l, q ? 0 : b, q ? BG + b : g * BG + b, h, d, q ? 1 : lmode, lds); SYNC(); }
    }
    if (g == 0 && !(SKIP_MASK & 2)) ph_convert(wb, p, l, 1, nfree > 0 ? c - NLONG : c, nfree > 0 ? nfree : G, lds);
    if (g == NGROUP - 1 && l + 1 < DEPTH && !(SKIP_MASK & 2)) ph_convert(wb, p, l + 1, 0, nfree > 0 ? c - NLONG : c, nfree > 0 ? nfree : G, lds);
}

__device__ __forceinline__ void ph_finish(int wb, const Params& p, int l, int nrows) {
    const int tid = tid_fresh(wb), wid = tid >> 6, lane = tid & 63, c = 8 * lane;
    const half_t* P = (const half_t*)(p.ws + OFF_P); const half_t* RW = (const half_t*)(p.ws + OFF_RW); const half_t* RLO = (const half_t*)(p.ws + OFF_RLO);
    const half_t* SOG = (const half_t*)(p.ws + OFF_SOG); const half_t* SOM = (const half_t*)(p.ws + OFF_SOM); const bf16_t* SOR = (const bf16_t*)(p.ws + OFF_SOR);
    half_t* BR = (half_t*)(p.ws + OFF_BR);
    float c_gn[8], c_mn[8], c_ka[8], c_rk[8], c_lg[8], c_lb[8];
#pragma unroll
    for (int e = 0; e < 8; ++e) { c_gn[e] = p.in[I_GNG][l * 128 + (c & 127) + e]; c_mn[e] = p.in[I_MNG][l * 128 + (c & 127) + e]; c_ka[e] = p.in[I_RKA][(size_t)l * 512 + c + e];
        c_rk[e] = p.in[I_RRK][(size_t)l * 512 + c + e]; c_lg[e] = p.in[I_RLNG][(size_t)l * 512 + c + e]; c_lb[e] = p.in[I_RLNB][(size_t)l * 512 + c + e]; }
    for (int r = blockIdx.x * 8 + wid; r < nrows; r += gridDim.x * 8) {
        { const half8 o0 = *(const half8*)(SOG + (size_t)r * 512 + c), o1 = *(const half8*)(SOG + ((size_t)RGP + r) * 512 + c), z = *(const half8*)(P + (size_t)r * NP + C_Z + c);
          float o[8], ss = 0.f;
#pragma unroll
          for (int e = 0; e < 8; ++e) { o[e] = (float)o0[e] + (float)o1[e]; ss += o[e] * o[e]; }
          ss += SHFL_XOR(ss, 1); ss += SHFL_XOR(ss, 2); ss += SHFL_XOR(ss, 4); ss += SHFL_XOR(ss, 8);
          const float rinv = frsq(ss * (1.f / 128.f) + 1e-6f); half8 out;
#pragma unroll
          for (int e = 0; e < 8; ++e) out[e] = (half_t)(o[e] * rinv * c_gn[e] * siluf((float)z[e]));
          *(half8*)(BR + (size_t)r * 512 + c) = out; }
        { float y[8], sm = 0.f;
          { typedef unsigned short us8 __attribute__((ext_vector_type(8)));
            const us8 s0 = *(const us8*)(SOR + (size_t)r * 512 + c), s1 = *(const us8*)(SOR + ((size_t)RGP + r) * 512 + c);
#pragma unroll
            for (int e = 0; e < 8; ++e) y[e] = bf2f(s0[e]) + bf2f(s1[e]); }
#pragma unroll
          for (int e = 0; e < 8; ++e) sm += y[e];
          sm += SHFL_XOR(sm, 1); sm += SHFL_XOR(sm, 2); sm += SHFL_XOR(sm, 4); const float mean = sm * (1.f / 64.f);
          float vs = 0.f;
#pragma unroll
          for (int e = 0; e < 8; ++e) { const float dlt = y[e] - mean; vs += dlt * dlt; }
          vs += SHFL_XOR(vs, 1); vs += SHFL_XOR(vs, 2); vs += SHFL_XOR(vs, 4); const float rinv = frsq(vs * (1.f / 64.f) + 64e-5f);
          const half8 rv = *(const half8*)(RW + ((size_t)r * 4 + 0) * 512 + c), kv = *(const half8*)(RW + ((size_t)r * 4 + 1) * 512 + c), vv = *(const half8*)(RW + ((size_t)r * 4 + 2) * 512 + c);
          const half8 a0 = *(const half8*)(RLO + (size_t)r * 2560 + 1024 + c), a1 = *(const half8*)(RLO + (size_t)r * 2560 + 1536 + c), gg = *(const half8*)(RLO + (size_t)r * 2560 + 2048 + c);
          float bc = 0.f;
#pragma unroll
          for (int e = 0; e < 8; ++e) bc += (float)rv[e] * (float)kv[e] * (2.f + ((float)a0[e] + (float)a1[e] - 2.f) * c_ka[e]) * c_rk[e];
          bc += SHFL_XOR(bc, 1); bc += SHFL_XOR(bc, 2); bc += SHFL_XOR(bc, 4);
          half8 out;
#pragma unroll
          for (int e = 0; e < 8; ++e) out[e] = (half_t)(((y[e] - mean) * rinv * c_lg[e] + c_lb[e] + bc * (float)vv[e]) * (float)gg[e]);
          *(half8*)(BR + ((size_t)RGP + r) * 512 + c) = out; }
        { const half8 h0 = *(const half8*)(SOM + (size_t)r * 512 + c), h1 = *(const half8*)(SOM + ((size_t)RGP + r) * 512 + c), og = *(const half8*)(P + (size_t)r * NP + C_MLO + c);
          float o[8], ss = 0.f;
#pragma unroll
          for (int e = 0; e < 8; ++e) { o[e] = (float)h0[e] + (float)h1[e]; ss += o[e] * o[e]; }
          ss += SHFL_XOR(ss, 1); ss += SHFL_XOR(ss, 2); ss += SHFL_XOR(ss, 4); ss += SHFL_XOR(ss, 8);
          const float rinv = frsq(ss * (1.f / 128.f) + 1e-6f); half8 out;
#pragma unroll
          for (int e = 0; e < 8; ++e) out[e] = (half_t)(o[e] * rinv * c_mn[e] * (float)og[e]);
          *(half8*)(BR + ((size_t)2 * RGP + r) * 512 + c) = out; }
    }
}

__device__ __forceinline__ void ph_norm2(int wb, const Params& p, int l, int g, int nrows, LAS unsigned char* lds) {
    const int tid = tid_fresh(wb), wid = tid >> 6, lane = tid & 63;
    LAS float* rw = (LAS float*)lds;
    for (int i = tid; i < 1024 * 16; i += NT) rw[(i & 15) * 1024 + (i >> 4)] = p.in[I_ROUT][(size_t)l * 1024 * 16 + i];
    SYNC();
    half_t* H = (half_t*)(p.ws + OFF_H); float* PROB = (float*)(p.ws + OFF_PROB);
    constexpr int RU = 2;
    const int rstep = gridDim.x * 8; const float* gn = p.in[I_N2G] + l * D;
    f32x4 gv[4];
#pragma unroll
    for (int j = 0; j < 4; ++j) gv[j] = *(const f32x4*)(gn + lane * 4 + 256 * j);
    for (int r0 = blockIdx.x * 8 + wid; r0 < nrows; r0 += rstep * RU) {
        f32x4 v[RU][4], sh[RU][4], sc[RU][4]; half4 dxv[RU][4]; float ss[RU];
#pragma unroll
        for (int u = 0; u < RU; ++u) { const int r = r0 + u * rstep < nrows ? r0 + u * rstep : r0;
            const half_t* xr = res_h(p, g, r); const float* md = mod_row(p, l, g, r); const half_t* dxr = (const half_t*)(p.ws + OFF_DX) + (size_t)r * D;
#pragma unroll
            for (int j = 0; j < 4; ++j) { const int c = lane * 4 + 256 * j; v[u][j] = h4f(*(const half4*)(xr + c)); dxv[u][j] = *(const half4*)(dxr + c); sh[u][j] = *(const f32x4*)(md + 3 * 1024 + c); sc[u][j] = *(const f32x4*)(md + 4 * 1024 + c); } }
        EPI_LOAD_FENCE();
#pragma unroll
        for (int u = 0; u < RU; ++u)
#pragma unroll
            for (int j = 0; j < 4; ++j)
#pragma unroll
                for (int e = 0; e < 4; ++e) v[u][j][e] += (float)dxv[u][j][e];
#pragma unroll
        for (int u = 0; u < RU; ++u) { float a = 0.f;
#pragma unroll
            for (int j = 0; j < 4; ++j) a += v[u][j][0] * v[u][j][0] + v[u][j][1] * v[u][j][1] + v[u][j][2] * v[u][j][2] + v[u][j][3] * v[u][j][3];
            ss[u] = wave_sum(a); }
#pragma unroll
        for (int u = 0; u < RU; ++u) { const int r = r0 + u * rstep; if (r >= nrows) continue;
            const float rinv = frsq(ss[u] * (1.f / D) + 1e-6f);
            float lg[16];
#pragma unroll
            for (int e = 0; e < 16; ++e) lg[e] = 0.f;
#pragma unroll
            for (int j = 0; j < 4; ++j) { const int c = lane * 4 + 256 * j;
                const f32x4 hv = v[u][j] * rinv * gv[j] * (sc[u][j] + 1.f) + sh[u][j];
                *(half4*)(H + (size_t)r * D + c) = cvt4(hv);
#pragma unroll
                for (int e = 0; e < 16; ++e) { const f32x4 w = *(const LAS f32x4*)(rw + e * 1024 + c); lg[e] += hv[0] * w[0] + hv[1] * w[1] + hv[2] * w[2] + hv[3] * w[3]; }
                asm volatile("" ::: "memory"); }
            float k8[8], k4[4], k2[2], k1;
            { const bool hi = lane & 32;
#pragma unroll
              for (int e = 0; e < 8; ++e) { const float snd = hi ? lg[e] : lg[e + 8]; k8[e] = (hi ? lg[e + 8] : lg[e]) + SHFL_XOR(snd, 32); } }
            { const bool hi = lane & 16;
#pragma unroll
              for (int e = 0; e < 4; ++e) { const float snd = hi ? k8[e] : k8[e + 4]; k4[e] = (hi ? k8[e + 4] : k8[e]) + SHFL_XOR(snd, 16); } }
            { const bool hi = lane & 8;
#pragma unroll
              for (int e = 0; e < 2; ++e) { const float snd = hi ? k4[e] : k4[e + 2]; k2[e] = (hi ? k4[e + 2] : k4[e]) + SHFL_XOR(snd, 8); } }
            { const bool hi = lane & 4; const float snd = hi ? k2[0] : k2[1]; k1 = (hi ? k2[1] : k2[0]) + SHFL_XOR(snd, 4); }
            k1 += SHFL_XOR(k1, 2); k1 += SHFL_XOR(k1, 1);
            float mx = k1; mx = fmaxf(mx, SHFL_XOR(mx, 4)); mx = fmaxf(mx, SHFL_XOR(mx, 8)); mx = fmaxf(mx, SHFL_XOR(mx, 16)); mx = fmaxf(mx, SHFL_XOR(mx, 32));
            const float ex = fexp(k1 - mx); float sum = ex; sum += SHFL_XOR(sum, 4); sum += SHFL_XOR(sum, 8); sum += SHFL_XOR(sum, 16); sum += SHFL_XOR(sum, 32);
            if ((lane & 3) == 0) PROB[(size_t)r * 16 + (lane >> 2)] = ex * frcp(sum); }
    }
}

__device__ __forceinline__ void ph_topk(int wb, const Params& p, int nctx, LAS unsigned char* lds) {
    const int tid = tid_fresh(wb), wid = tid >> 6, lane = tid & 63;
    LAS unsigned* pv = (LAS unsigned*)lds;
    LAS unsigned* hist = pv + (SEQ > CTXL ? SEQ : CTXL);
    LAS int* wtot = (LAS int*)(hist + 256);
    LAS int* selrows = wtot + 16;
    LAS unsigned* sh = (LAS unsigned*)(selrows + (CAPL > CAPC ? CAPL : CAPC));
    const float* PROB = (const float*)(p.ws + OFF_PROB); int* SLOT = (int*)(p.ws + OFF_SLOT); int* SEL = (int*)(p.ws + OFF_SEL); float* AFF = (float*)(p.ws + OFF_AFF);
    const half_t* H = (const half_t*)(p.ws + OFF_H); half_t* XE = (half_t*)(p.ws + OFF_XE);
    auto block_excl = [&](int v, int slotbase) -> int {
        float f = (float)v;
#pragma unroll
        for (int off = 1; off < 64; off <<= 1) { const float o = shfl_up_f(f, off, lane); f = lane >= off ? f + o : f; }
        if (lane == 63) wtot[slotbase + wid] = (int)f;
        SYNC();
        int pre = 0;
#pragma unroll
        for (int w = 0; w < 8; ++w) pre += (w < wid) ? wtot[slotbase + w] : 0;
        return pre + (int)f - v; };
    const int nlat = BG * 16, nq = (nlat * 4 + nctx * 16 <= (int)gridDim.x) ? 4 : (nlat * 2 + nctx * 16 <= (int)gridDim.x) ? 2 : 1;
    for (int vit = blockIdx.x; vit < nlat * nq + nctx * 16; vit += gridDim.x) {
        const int item = vit < nlat * nq ? vit / nq : vit - nlat * (nq - 1), part = vit < nlat * nq ? vit % nq : 0, nparts = vit < nlat * nq ? nq : 1;
        const int e = item & 15, sm = item >> 4, stc = sm >= BG, bl = stc ? sm - BG : sm;
        const int n = stc ? CTXL : SEQ, cap = n / 8, row0 = stc ? RL + bl * CTXL : bl * SEQ, slot0 = stc ? BG * CAPL + bl * CAPC : bl * CAPL;
        SYNC();
        for (int i = tid; i < n; i += NT) pv[i] = __float_as_uint(PROB[(size_t)(row0 + i) * 16 + e]);
        unsigned prefix = 0u, mask = 0u; int kth = cap;
        for (int pass = 3; pass >= 0; --pass) {
            if (tid < 256) hist[tid] = 0u;
            SYNC();
            for (int i = tid; i < n; i += NT) { const unsigned v = pv[i]; if ((v & mask) == prefix) LDS_ATOMIC_INC(&hist[(v >> (8 * pass)) & 255u]); }
            SYNC();
            if (wid == 0) {
                const int b0 = 255 - 4 * lane; const int h0 = (int)hist[b0], h1 = (int)hist[b0 - 1], h2 = (int)hist[b0 - 2], h3 = (int)hist[b0 - 3];
                float f = (float)(h0 + h1 + h2 + h3);
#pragma unroll
                for (int off = 1; off < 64; off <<= 1) { const float o = shfl_up_f(f, off, lane); f = lane >= off ? f + o : f; }
                int cum = (int)f - (h0 + h1 + h2 + h3);
                const int hh[4] = {h0, h1, h2, h3};
#pragma unroll
                for (int j = 0; j < 4; ++j) { if (cum < kth && kth <= cum + hh[j]) { sh[0] = (unsigned)(b0 - j); sh[1] = (unsigned)(kth - cum); } cum += hh[j]; }
            }
            SYNC();
            prefix |= sh[0] << (8 * pass); mask |= 0xFFu << (8 * pass); kth = (int)sh[1];
        }
        const unsigned thr = prefix; const int need_eq = kth;
        const int per = (n + NT - 1) / NT, i0 = tid * per, i1 = (i0 + per < n) ? i0 + per : n;
        int ce = 0, cg = 0; for (int i = i0; i < i1; ++i) { const unsigned v = pv[i]; ce += (v == thr); cg += (v > thr); }
        const int eq_ex = block_excl(ce, 0);
        int take = need_eq - eq_ex; take = take < 0 ? 0 : (take > ce ? ce : take);
        const int pos_ex = block_excl(cg + take, 8);
        { int eqr = eq_ex, pos = pos_ex;
          for (int i = i0; i < i1; ++i) { const unsigned v = pv[i]; const bool sel = v > thr || (v == thr && eqr < need_eq); if (v == thr) ++eqr; const int row = row0 + i;
              if (sel) { const int slot = slot0 + pos; if (part == 0) { SEL[e * RPE + slot] = row; AFF[e * RPE + slot] = __uint_as_float(v); SLOT[(size_t)row * 16 + e] = slot; } selrows[pos] = row; ++pos; }
              else if (part == 0) SLOT[(size_t)row * 16 + e] = -1; } }
        SYNC();
        const int g0 = part * (cap / nparts) * 128, g1 = (part + 1 == nparts ? cap : (part + 1) * (cap / nparts)) * 128;
        for (int idx0 = g0 + tid; idx0 < g1; idx0 += NT * 8) { half8 t[8];
#pragma unroll
            for (int u = 0; u < 8; ++u) { const int idx = idx0 + u * NT; if (idx < g1) t[u] = *(const half8*)(H + (size_t)selrows[idx >> 7] * 1024 + (idx & 127) * 8); }
#pragma unroll
            for (int u = 0; u < 8; ++u) { const int idx = idx0 + u * NT; if (idx < g1) *(half8*)(XE + ((size_t)e * RPE + slot0 + (idx >> 7)) * 1024 + (idx & 127) * 8) = t[u]; } }
    }
    SYNC();
}

__device__ __forceinline__ void ph_combine(int wb, const Params& p, int l, int g, int nrows) {
    const int tid = tid_fresh(wb), wid = tid >> 6, lane = tid & 63;
    const int* SLOT = (const int*)(p.ws + OFF_SLOT); const half_t* YE = (const half_t*)(p.ws + OFF_YE);
    constexpr int RU = 4;
    const int rstep = gridDim.x * 8;
    for (int r0 = blockIdx.x * 8 + wid; r0 < nrows; r0 += rstep * RU) {
        float acc[RU][2][8]; f32x4 xv[RU][4];
#pragma unroll
        for (int u = 0; u < RU; ++u) { const int r = r0 + u * rstep;
#pragma unroll
            for (int j = 0; j < 2; ++j)
#pragma unroll
                for (int e = 0; e < 8; ++e) acc[u][j][e] = 0.f;
            if (r < nrows) { const half_t* xr = res_h(p, g, r); const half_t* dxr = (const half_t*)(p.ws + OFF_DX) + (size_t)r * D;
#pragma unroll
                for (int j = 0; j < 2; ++j) { const half8 xh = *(const half8*)(xr + 8 * lane + 512 * j);
                    const half8 dx = *(const half8*)(dxr + 8 * lane + 512 * j);
#pragma unroll
                    for (int e = 0; e < 4; ++e) { xv[u][2 * j][e] = (float)xh[e] + (float)dx[e]; xv[u][2 * j + 1][e] = (float)xh[4 + e] + (float)dx[4 + e]; } }
                int sl[16];
#pragma unroll
                for (int q = 0; q < 4; ++q) { const int4 t = *(const int4*)(SLOT + (size_t)r * 16 + 4 * q); sl[4 * q] = t.x; sl[4 * q + 1] = t.y; sl[4 * q + 2] = t.z; sl[4 * q + 3] = t.w; }
#pragma unroll
                for (int ex = 0; ex < 16; ++ex) { if (sl[ex] < 0) continue;
#pragma unroll
                    for (int j = 0; j < 2; ++j) { const half8 y = *(const half8*)(YE + ((size_t)ex * RPE + sl[ex]) * 1024 + 8 * lane + 512 * j);
#pragma unroll
                        for (int e = 0; e < 8; ++e) acc[u][j][e] += (float)y[e]; } } } }
        float ss[RU];
#pragma unroll
        for (int u = 0; u < RU; ++u) { const int r = r0 + u * rstep; ss[u] = 0.f; if (r >= nrows) continue;
            const float* md = mod_row(p, l, g, r) + 5 * 1024;
#pragma unroll
            for (int j = 0; j < 2; ++j) { const f32x4 m0 = *(const f32x4*)(md + 8 * lane + 512 * j), m1 = *(const f32x4*)(md + 8 * lane + 512 * j + 4);
#pragma unroll
                for (int e = 0; e < 4; ++e) { xv[u][2 * j][e] += m0[e] * acc[u][j][e]; xv[u][2 * j + 1][e] += m1[e] * acc[u][j][4 + e];
                    ss[u] += xv[u][2 * j][e] * xv[u][2 * j][e] + xv[u][2 * j + 1][e] * xv[u][2 * j + 1][e]; } } }
        if (l == DEPTH - 1) {
#pragma unroll
            for (int u = 0; u < RU; ++u) ss[u] = wave_sum(ss[u]); }
#pragma unroll
        for (int u = 0; u < RU; ++u) { const int r = r0 + u * rstep; if (r >= nrows) continue;
            if (l == DEPTH - 1) { const float rinv = frsq(ss[u] * (1.f / D) + 1e-6f); float* xr = res_dst(p, g, r);
#pragma unroll
                for (int j = 0; j < 2; ++j) { const f32x4 f0 = *(const f32x4*)(p.in[I_FING] + 8 * lane + 512 * j), f1 = *(const f32x4*)(p.in[I_FING] + 8 * lane + 512 * j + 4);
                    *(f32x4*)(xr + 8 * lane + 512 * j) = xv[u][2 * j] * rinv * f0; *(f32x4*)(xr + 8 * lane + 512 * j + 4) = xv[u][2 * j + 1] * rinv * f1; } }
            else { half_t* xr = res_h(p, g, r);
#pragma unroll
                for (int j = 0; j < 2; ++j) { half8 o;
#pragma unroll
                    for (int e = 0; e < 4; ++e) { o[e] = (half_t)xv[u][2 * j][e]; o[4 + e] = (half_t)xv[u][2 * j + 1][e]; }
                    *(half8*)(xr + 8 * lane + 512 * j) = o; } } }
    }
}

#ifndef TPROBE_A
#define TPROBE_A 0
#endif
#ifndef TPROBE_B
#define TPROBE_B 0
#endif
#ifndef CPU_EMU
__device__ __forceinline__ void tprobe_tick(LAS unsigned char* lds, int idx) {
    volatile LAS unsigned long long* tp = (volatile LAS unsigned long long*)(lds + SMEM_BYTES - 64);
    const unsigned long long now = __builtin_amdgcn_s_memrealtime(), dt = now - tp[0];
    if ((TPROBE_A >> idx) & 1) tp[1] += dt;
    if ((TPROBE_B >> idx) & 1) tp[2] += dt;
    tp[0] = now;
}
#define PH_T(idx) do { if ((TPROBE_A | TPROBE_B) != 0 && blockIdx.x == 0 && tid_fresh(wb) == 0) tprobe_tick(lds, (idx)); } while (0)
#else
#define PH_T(idx)
#endif
#ifndef EMU_DUMP
#define EMU_DUMP(tag)
#endif
#ifndef CPU_EMU
extern __shared__ __attribute__((aligned(16))) unsigned char smem_raw[];
__global__ void __launch_bounds__(NT, 2) mega(Params p)
#else
void mega(Params p)
#endif
{
#ifndef CPU_EMU
    LAS unsigned char* lds = (LAS unsigned char*)smem_raw;
    volatile LAS unsigned* xbw = (volatile LAS unsigned*)(lds + SMEM_BYTES - 16);
    if (threadIdx.x == 0) { xbw[0] = 0u; xbw[1] = 0u; xbw[2] = 0u; xbw[3] = 0u; }
    __syncthreads();
    (void)xcd_barrier_post((unsigned*)(p.ws + OFF_BAR), xbw);
    if ((TPROBE_A | TPROBE_B) != 0 && threadIdx.x == 0) { volatile LAS unsigned long long* tp = (volatile LAS unsigned long long*)(lds + SMEM_BYTES - 64); tp[0] = __builtin_amdgcn_s_memrealtime(); tp[1] = 0ull; tp[2] = 0ull; }
#else
    unsigned char* lds = emu_smem();
#endif
#ifndef CPU_EMU
    const int wb = __builtin_amdgcn_readfirstlane((int)threadIdx.x) & ~63;
#else
    const int wb = 0;
#endif
    const int G = gridDim.x, c = blockIdx.x;
    if (!(SKIP_MASK & 1)) ph_mod(wb, p, lds);
    if (!(SKIP_MASK & 2)) ph_convert(wb, p, 0, 0, c, G, lds);
    ph_xconv(wb, p);
    GRID_SYNC(); PH_T(0);
    for (int l = 0; l < DEPTH; ++l) {
        const bool last = (l == DEPTH - 1);
        for (int g = 0; g < NGROUP; ++g) {
            const Geo gq = geo_of(g);
            const int nact = last ? RL : gq.rg;
            const int nactp = last ? RL : gq.rgp;
            const int tpa = last ? (BG * CAPL + 255) / 256 : gq.tpe;
            if (l == 0 && g == 0) { if (!(SKIP_MASK & 4)) ph_norm1(wb, p, l, g); GRID_SYNC(); PH_T(1); }
            EMU_DUMP("norm1");
            if (!(SKIP_MASK & 8)) REPS(8) { pg8::StaticOrder S; S.init(gq.rgp / 256, NP / 256, G, c); EpiP E{(half_t*)(p.ws + OFF_P)};
              pg8::gemm_phase(wb, lds, pg8::Gemm{(const half_t*)(p.ws + OFF_H), (const half_t*)(p.ws + OFF_WIN), 1024, 16}, S, E); }
            GRID_SYNC(); PH_T(2); EMU_DUMP("gemm_in");
            if (!(SKIP_MASK & 16)) REPS(16) ph_prep2(wb, p, l, gq.rg, lds);
            GRID_SYNC(); PH_T(3); EMU_DUMP("prep");
            if (!(SKIP_MASK & 32)) REPS(32) { pg8::LoraOrder S; S.init(gq.rgp / 256, G, c); EpiLora E{(half_t*)(p.ws + OFF_RLO), p.in[I_RW0] + (size_t)l * 1024, p.in[I_RA0] + (size_t)l * 1024};
              pg8::gemm_phase(wb, lds, pg8::Gemm{(const half_t*)(p.ws + OFF_RLI), (const half_t*)(p.ws + OFF_WLORA), 384, 2}, S, E); }
            if (!(SKIP_MASK & 64)) REPS(64) ph_wy(wb, p, gq.rg, lds);
            GRID_SYNC(); PH_T(4); EMU_DUMP("wy");
            if (!(SKIP_MASK & 128)) REPS(128) ph_scan(wb, p, l, g, lds);
            GRID_SYNC(); PH_T(5); EMU_DUMP("scan");
            if (!(SKIP_MASK & 256)) REPS(256) ph_finish(wb, p, l, nact);
            GRID_SYNC(); PH_T(6); EMU_DUMP("finish");
            if (!(SKIP_MASK & 512)) REPS(512) { pg8::MergeOrder S; S.init(nactp / 256, G, c); EpiMerge E{(half_t*)(p.ws + OFF_H), (const half_t*)(p.ws + OFF_P)};
              pg8::gemm_phase(wb, lds, pg8::Gemm{(const half_t*)(p.ws + OFF_BR), (const half_t*)(p.ws + OFF_WBR), 512, 8}, S, E); }
            GRID_SYNC(); PH_T(7); EMU_DUMP("merge");
            if (!(SKIP_MASK & 1024)) { pg8::StaticOrder S; S.init(nactp / 256, 4, G, c); EpiOut E{p, l, g, gq.rg};
              pg8::gemm_phase(wb, lds, pg8::Gemm{(const half_t*)(p.ws + OFF_H), (const half_t*)(p.ws + OFF_WOUT), 1024, 16}, S, E); }
            GRID_SYNC(); PH_T(8); EMU_DUMP("out");
            if (!(SKIP_MASK & 2048)) REPS(2048) ph_norm2(wb, p, l, g, nact, lds);
            GRID_SYNC(); PH_T(9); EMU_DUMP("norm2");
            if (!(SKIP_MASK & 4096)) REPS(4096) ph_topk(wb, p, (g == 0 && !last) ? BATCH : 0, lds);
            GRID_SYNC(); PH_T(10); EMU_DUMP("topk");
            if (!(SKIP_MASK & 8192)) REPS(8192) { pg8::ExpertOrder S; S.init(tpa, G, c); EpiUp E{(half_t*)(p.ws + OFF_HID)};
              pg8::gemm_phase(wb, lds, pg8::Gemm{(const half_t*)(p.ws + OFF_XE), (const half_t*)(p.ws + OFF_WUP), 1024, 16}, S, E); }
            GRID_SYNC(); PH_T(11);
            if (!(SKIP_MASK & 16384)) REPS(16384) { pg8::ExpertOrder S; S.init(tpa, G, c); EpiDown E{(half_t*)(p.ws + OFF_YE), (const float*)(p.ws + OFF_AFF)};
              pg8::gemm_phase(wb, lds, pg8::Gemm{(const half_t*)(p.ws + OFF_HID), (const half_t*)(p.ws + OFF_WDN), 512, 8}, S, E); }
            GRID_SYNC(); PH_T(12);
            if (!(SKIP_MASK & 32768)) ph_combine(wb, p, l, g, nact);
            if (!(SKIP_MASK & 4)) { if (g + 1 < NGROUP) ph_norm1(wb, p, l, g + 1); else if (!last) ph_norm1(wb, p, l + 1, 0); }
            GRID_SYNC(); PH_T(13); EMU_DUMP("combine");
        }
    }
#ifndef CPU_EMU
#if SANDBOX
    GRID_SYNC(); PH_T(16);
    { pg8::StaticOrder S; S.init(RGP / 256, NP / 256, G, c); SANDBOX_EPI E{(SANDBOX_EPI_ARG)(p.ws + OFF_P)};
      pg8::gemm_phase(wb, lds, pg8::Gemm{(const half_t*)(p.ws + OFF_H), (const half_t*)(p.ws + OFF_WIN), 1024, SANDBOX_A}, S, E); }
    GRID_SYNC(); PH_T(14);
    { pg8::StaticOrder S; S.init(RGP / 256, NP / 256, G, c); SANDBOX_EPI E{(SANDBOX_EPI_ARG)(p.ws + OFF_P)};
      pg8::gemm_phase(wb, lds, pg8::Gemm{(const half_t*)(p.ws + OFF_H), (const half_t*)(p.ws + OFF_WIN), 1024, SANDBOX_B}, S, E); }
    GRID_SYNC(); PH_T(15);
#endif
    if ((TPROBE_A | TPROBE_B) != 0 && blockIdx.x == 0) {
        __syncthreads();
        volatile LAS unsigned long long* tp = (volatile LAS unsigned long long*)(lds + SMEM_BYTES - 64);
        const float msA = (float)tp[1] * 1e-5f, msB = (float)tp[2] * 1e-5f;
        if (TPROBE_A != 0 && threadIdx.x == 0) p.out[0] += 10.f * msA;
        if (TPROBE_B != 0) { const float eps = sqrtf(msB * 1.675e-3f); for (int i = threadIdx.x; i < (1 << 20); i += NT) p.out[1024 + i] += eps; }
    }
#endif
}

#ifndef CPU_EMU
extern "C" void kernel_launch(void* const* d_in, const int* in_sizes, int n_in, void* d_out, int out_size, void* d_ws, size_t ws_size, hipStream_t stream) {
    (void)in_sizes; (void)n_in; (void)out_size;
    static int grid = 0;
    if (!grid) {
        int dev = 0, cus = 0, per_cu = 0;
        hipGetDevice(&dev);
        hipDeviceGetAttribute(&cus, hipDeviceAttributeMultiprocessorCount, dev);
        hipFuncSetAttribute((const void*)mega, hipFuncAttributeMaxDynamicSharedMemorySize, SMEM_BYTES);
        hipOccupancyMaxActiveBlocksPerMultiprocessor(&per_cu, (const void*)mega, NT, SMEM_BYTES);
        if (per_cu < 1) per_cu = 1;
        grid = cus;
        if (ws_size < WS_TOTAL) fprintf(stderr, "workspace too small: %zu < %zu\n", ws_size, (size_t)WS_TOTAL);
    }
    hipMemsetAsync((unsigned char*)d_ws + OFF_BAR, 0, 16384, stream);
    Params p{};
    for (int i = 0; i < 34; ++i) p.in[i] = (const float*)d_in[i];
    p.out = (float*)d_out; p.ws = (unsigned char*)d_ws;
    hipLaunchKernelGGL(mega, dim3(grid), dim3(NT), SMEM_BYTES, stream, p);
}
#endif
```

```cpp
#ifndef CPU_EMU
#include <hip/hip_runtime.h>
#include <cstdio>
#include <cstdint>
typedef _Float16 half_t;
typedef _Float16 half8 __attribute__((ext_vector_type(8)));
typedef _Float16 half4 __attribute__((ext_vector_type(4)));
typedef float f32x4 __attribute__((ext_vector_type(4)));
typedef float f32x2 __attribute__((ext_vector_type(2)));
#define LAS __attribute__((address_space(3)))
#define SYNC() __syncthreads()
#define WAVE_SYNC() __builtin_amdgcn_wave_barrier()
template <int M> __device__ __forceinline__ float shfl_xor_t(float v, int tid) {
    if constexpr (M < 32) return __int_as_float(__builtin_amdgcn_ds_swizzle(__float_as_int(v), (M << 10) | 0x1f));
    else return __int_as_float(__builtin_amdgcn_ds_bpermute(((tid ^ 32) & 63) << 2, __float_as_int(v)));
}
#define SHFL_XOR(v, m) shfl_xor_t<m>((v), tid)
#define LDS_ATOMIC_INC(p) __hip_atomic_fetch_add((p), 1u, __ATOMIC_RELAXED, __HIP_MEMORY_SCOPE_WORKGROUP)
#endif

#ifndef CFG_BATCH
#define CFG_BATCH 8
#define CFG_SEQ 4096
#define CFG_CTX 256
#define CFG_DEPTH 4
#define CFG_NGROUP 2
#endif
constexpr int BATCH = CFG_BATCH, SEQ = CFG_SEQ, CTXL = CFG_CTX, DEPTH = CFG_DEPTH, NGROUP = CFG_NGROUP;
#ifndef SKIP_MASK
#define SKIP_MASK 0
#endif
#ifndef WARM_WIN
#define WARM_WIN 0
#endif
#ifndef SANDBOX
#define SANDBOX 0
#endif
#ifndef SANDBOX_PV
#define SANDBOX_PV 1
#endif
#ifndef SANDBOX_A
#define SANDBOX_A 16
#define SANDBOX_B 8
#endif
#ifndef SANDBOX_EPI
#define SANDBOX_EPI EpiP
#define SANDBOX_EPI_ARG half_t*
#endif
#ifndef REPEAT_MASK
#define REPEAT_MASK 0
#endif
#define REPS(bit) for (int rep_ = 0; rep_ < ((REPEAT_MASK & (bit)) ? 2 : 1); ++rep_)
constexpr int NT = 512;
constexpr int D = 1024;
constexpr int IN_COLS = 8608, NP = 8704;
constexpr int C_Z = 1536, C_BG = 2048;
constexpr int C_RWKV = 2064;
constexpr int C_ML = 3984, C_MLO = 5008, C_MLIG = 5520, C_MLFG = 5528;
constexpr int C_GATE = 5536;
constexpr int BG = BATCH / NGROUP;
constexpr int RL = BG * SEQ;
constexpr int RCX = BATCH * CTXL;
constexpr int RGX = RL + RCX;
constexpr int RGP = (RGX + 255) / 256 * 256;
constexpr int CAPL = SEQ / 8, CAPC = CTXL / 8;
constexpr int RPE = (BG * CAPL + BATCH * CAPC + 255) / 256 * 256;
constexpr int TPE = RPE / 256;
constexpr int NCH = RGP / 64;
struct Geo { int rg, rgp, tpe; };
__host__ __device__ __forceinline__ Geo geo_of(int g) { Geo q; q.rg = RL + (g == 0 ? RCX : 0); q.rgp = (q.rg + 255) / 256 * 256; q.tpe = (BG * CAPL + (g == 0 ? BATCH * CAPC : 0) + 255) / 256; return q; }
static_assert(RL % 256 == 0, "latent rows per group must be a multiple of 256");
static_assert(SEQ % 64 == 0 && CTXL % 64 == 0, "chunks");

constexpr size_t al256(size_t x) { return (x + 255) / 256 * 256; }
constexpr size_t cmax(size_t a, size_t b) { return a > b ? a : b; }
constexpr size_t OFF_BAR = 0;
constexpr size_t OFF_MOD = 16384;
constexpr size_t OFF_CTXR = al256(OFF_MOD + (size_t)DEPTH * (BATCH + 1) * 6144 * 4);
constexpr size_t OFF_WIN = al256(OFF_CTXR + (size_t)BATCH * CTXL * D * 4);
constexpr size_t OFF_WBR = al256(OFF_WIN + (size_t)NP * 1024 * 2);
constexpr size_t OFF_WOUT = al256(OFF_WBR + (size_t)3 * 1024 * 512 * 2);
constexpr size_t OFF_WUP = al256(OFF_WOUT + (size_t)1024 * 1024 * 2);
constexpr size_t OFF_WDN = al256(OFF_WUP + (size_t)16 * 1024 * 1024 * 2);
constexpr size_t OFF_WLORA = al256(OFF_WDN + (size_t)16 * 1024 * 512 * 2);
constexpr size_t OFF_H = al256(OFF_WLORA + (size_t)2560 * 384 * 2);
constexpr size_t OFF_P = al256(OFF_H + (size_t)RGP * 1024 * 2);
constexpr size_t SZ_XE = (size_t)16 * RPE * 1024 * 2, SZ_HID = (size_t)16 * RPE * 512 * 2;
constexpr size_t OFF_XE = OFF_P, OFF_HID = OFF_XE + SZ_XE, OFF_YE = OFF_HID + SZ_HID;
constexpr size_t OFF_GQKV = al256(OFF_P + cmax((size_t)RGP * NP * 2, 2 * SZ_XE + SZ_HID));
constexpr size_t OFF_BR = OFF_GQKV;
constexpr size_t OFF_DX = OFF_BR;
constexpr size_t OFF_GBG = al256(OFF_GQKV + (size_t)RGP * 1536 * 2);
constexpr size_t OFF_GTA = al256(OFF_GBG + (size_t)RGP * 16 * 4);
constexpr size_t OFF_GG = al256(OFF_GTA + (size_t)NCH * 4 * 2 * 2 * 4096 * 2);
constexpr size_t OFF_RW = al256(OFF_GG + (size_t)NCH * 4 * 2 * 64 * 4);
constexpr size_t OFF_RLO = al256(OFF_RW + (size_t)RGP * 4 * 512 * 2);
constexpr size_t OFF_SO = al256(OFF_RLO + (size_t)RGP * 2560 * 2);
constexpr size_t OFF_RLI = OFF_SO;
constexpr size_t OFF_SOG = OFF_SO, OFF_SOM = OFF_SOG + (size_t)2 * RGP * 512 * 2, OFF_SOR = OFF_SOM + (size_t)2 * RGP * 512 * 2;
constexpr size_t OFF_PROB = al256(OFF_SOR + (size_t)2 * RGP * 512 * 2);
constexpr size_t OFF_SLOT = al256(OFF_PROB + (size_t)RGP * 16 * 4);
constexpr size_t OFF_SEL = al256(OFF_SLOT + (size_t)RGP * 16 * 4);
constexpr size_t OFF_AFF = al256(OFF_SEL + (size_t)16 * RPE * 4);
constexpr int NSAVE = BATCH - BG > 0 ? BATCH - BG : 1;
constexpr size_t OFF_RST = al256(OFF_AFF + (size_t)16 * RPE * 4);
constexpr size_t OFF_GST = al256(OFF_RST + (size_t)NSAVE * 8 * 2 * 4096 * 4);
constexpr size_t OFF_MST = al256(OFF_GST + (size_t)NSAVE * 4 * 2 * 16384 * 4);
constexpr size_t OFF_MSM = al256(OFF_MST + (size_t)NSAVE * 4 * 2 * 16384 * 4);
constexpr size_t WS_TOTAL = al256(OFF_MSM + (size_t)NSAVE * 4 * 2 * 4);
constexpr int SMEM_BYTES = 152 * 1024;

struct Params { const float* in[34]; float* out; unsigned char* ws; };
enum { I_X = 0, I_C, I_CTX, I_CCTX, I_ADAW, I_ADAB, I_N1G, I_N2G, I_WIN, I_GCONV, I_GALOG, I_GDTB, I_GNG, I_RMU, I_RW0, I_RWUP, I_RA0, I_RAUP, I_RGUP,
       I_RKK, I_RKA, I_RRK, I_RLNG, I_RLNB, I_MIB, I_MFB, I_MNG, I_WBR, I_WOUT, I_ROUT, I_W1, I_W3, I_W2, I_FING };

#ifndef CPU_EMU
__device__ __forceinline__ int tid_fresh(int wb) { int t; asm volatile("v_mbcnt_lo_u32_b32 %0, -1, 0\n\tv_mbcnt_hi_u32_b32 %0, -1, %0" : "=v"(t)); return wb + t; }
#else
static inline int tid_fresh(int) { return threadIdx.x; }
#endif
#ifndef CPU_EMU
__device__ __forceinline__ float fexp(float x) { return __builtin_amdgcn_exp2f(x * 1.4426950408889634f); }
__device__ __forceinline__ float flog(float x) { return __builtin_amdgcn_logf(x) * 0.6931471805599453f; }
__device__ __forceinline__ float frcp(float x) { return __builtin_amdgcn_rcpf(x); }
__device__ __forceinline__ float frsq(float x) { return __builtin_amdgcn_rsqf(x); }
#else
static inline float fexp(float x) { return expf(x); }
static inline float flog(float x) { return logf(x); }
static inline float frcp(float x) { return 1.f / x; }
static inline float frsq(float x) { return 1.f / sqrtf(x); }
#endif
__device__ __forceinline__ float sigm(float x) { return frcp(1.f + fexp(-x)); }
__device__ __forceinline__ float siluf(float x) { return x * frcp(1.f + fexp(-x)); }
__device__ __forceinline__ float ftanh(float x) { return 1.f - 2.f * frcp(1.f + fexp(2.f * x)); }
__device__ __forceinline__ float softplusf(float x) { const float t = fexp(x); return x > 15.f ? x : (t < 1e-3f ? t * (1.f - 0.5f * t) : flog(1.f + t)); }
#define wave_sum(x) wave_sum_(x, tid)
__device__ __forceinline__ float wave_sum_(float v, int tid) { v += SHFL_XOR(v, 32); v += SHFL_XOR(v, 16); v += SHFL_XOR(v, 8); v += SHFL_XOR(v, 4); v += SHFL_XOR(v, 2); v += SHFL_XOR(v, 1); return v; }

#ifndef CPU_EMU
#define MFMA16(a, b, c) __builtin_amdgcn_mfma_f32_16x16x32_f16((a), (b), (c), 0, 0, 0)
#else
#define MFMA16(a, b, c) emu_mfma16((a), (b), (c))
#endif
__device__ __forceinline__ half8 ldfrag(const LAS half_t* base, int row0, int ld, int k0, int lane) { return *(const LAS half8*)(base + (row0 + (lane & 15)) * ld + k0 + 8 * (lane >> 4)); }
__device__ __forceinline__ half4 cvt4(f32x4 v) { half4 o; o[0] = (half_t)v[0]; o[1] = (half_t)v[1]; o[2] = (half_t)v[2]; o[3] = (half_t)v[3]; return o; }

typedef unsigned short bf16_t;
__device__ __forceinline__ bf16_t f2bf(float f) { unsigned u = __float_as_uint(f); u += 0x7FFFu + ((u >> 16) & 1u); return (bf16_t)(u >> 16); }
__device__ __forceinline__ float bf2f(bf16_t b) { return __uint_as_float(((unsigned)b) << 16); }
#ifndef CPU_EMU
#define EPI_LOAD_FENCE() asm volatile("" ::: "memory")
#else
#define EPI_LOAD_FENCE()
#endif
__device__ __forceinline__ float* res_dst(const Params& p, int g, int r) {
    if (r < RL) { const size_t t = (size_t)(g * BG) * SEQ + r; return p.out + t * D; }
    const size_t t = (size_t)(r - RL); return (float*)(p.ws + OFF_CTXR) + t * D;
}
__device__ __forceinline__ half_t* res_h(const Params& p, int g, int r) { return (half_t*)res_dst(p, g, r) + 1024; }
__device__ __forceinline__ f32x4 h4f(half4 h) { return (f32x4){(float)h[0], (float)h[1], (float)h[2], (float)h[3]}; }
__device__ __forceinline__ const float* mod_row(const Params& p, int l, int g, int r) {
    const int s = r < RL ? (g * BG + r / SEQ) : BATCH; return (const float*)(p.ws + OFF_MOD) + ((size_t)l * (BATCH + 1) + s) * 6144;
}

#ifndef CPU_EMU
#define XB_TMO      128
#define XB_XCNT(j)  (256  + 64 * (j))
#define XB_XSUB(j)  (1280 + 64 * (j))
#define XB_XGEN(j)  (2304 + 64 * (j))
#define XB_TOP      3328
#define XB_TOPGEN   3392
#define XCD_BAR_WORDS 3456
#define XB_SPIN_CAP (1u << 22)
__device__ __forceinline__ unsigned xb_ld(unsigned* p)              { return __hip_atomic_load(p, __ATOMIC_RELAXED, __HIP_MEMORY_SCOPE_AGENT); }
__device__ __forceinline__ unsigned xb_add(unsigned* p, unsigned v) { return __hip_atomic_fetch_add(p, v, __ATOMIC_RELAXED, __HIP_MEMORY_SCOPE_AGENT); }
__device__ __forceinline__ unsigned xb_xcc_id() { return (unsigned)__builtin_amdgcn_s_getreg((3 << 11) | 20) & 0xFu; }
#define XB_SPIN(cond, bar) do { unsigned _sp = 0; while (cond) { __builtin_amdgcn_s_sleep(1); \
    if ((++_sp & 255u) == 0u) { if (xb_ld(&(bar)[XB_TMO])) break; if (_sp > XB_SPIN_CAP) { atomicAdd(&(bar)[XB_TMO], 1u); break; } } } } while (0)
struct XcdBarrier { unsigned* bar; unsigned x; volatile LAS unsigned* st; };
__device__ __forceinline__ XcdBarrier xcd_barrier_post(unsigned* bar, volatile LAS unsigned* st) {
    XcdBarrier b; b.bar = bar; b.x = xb_xcc_id(); b.st = st;
    if (threadIdx.x == 0) (void)xb_add(&bar[XB_XCNT(b.x)], 1u);
    return b;
}
__device__ __forceinline__ void xcd_barrier_complete(unsigned* bar, unsigned x, unsigned& nloc, unsigned& nx) {
    const unsigned G = gridDim.x * gridDim.y * gridDim.z;
    unsigned sum, cnt, mine, sp = 0u;
    for (;;) {
        sum = 0u; cnt = 0u; mine = 0u;
#pragma unroll
        for (unsigned j = 0; j < 16; ++j) { const unsigned c = xb_ld(&bar[XB_XCNT(j)]); sum += c; cnt += (c > 0u) ? 1u : 0u; mine = (j == x) ? c : mine; }
        if (sum == G) break;
        __builtin_amdgcn_s_sleep(1);
        if ((++sp & 255u) == 0u) { if (xb_ld(&bar[XB_TMO])) break; if (sp > XB_SPIN_CAP) { atomicAdd(&bar[XB_TMO], 1u); break; } }
    }
    nloc = mine > 0u ? mine : 1u; nx = cnt > 0u ? cnt : 1u;
}
__device__ __forceinline__ void xcd_barrier(const XcdBarrier& b) {
    asm volatile("s_waitcnt vmcnt(0)" ::: "memory");
    __syncthreads();
    if (threadIdx.x == 0) {
        unsigned* bar = b.bar;
        __builtin_amdgcn_s_waitcnt(0);
        unsigned nloc = b.st[0], nx = b.st[1];
        if (nloc == 0u) { xcd_barrier_complete(bar, b.x, nloc, nx); b.st[0] = nloc; b.st[1] = nx; }
        const unsigned old = xb_add(&bar[XB_XSUB(b.x)], 1u);
        const unsigned gen = old / nloc;
        if (old + 1u == (gen + 1u) * nloc) {
            __builtin_amdgcn_fence(__ATOMIC_RELEASE, "agent");
            asm volatile("s_waitcnt vmcnt(0)" ::: "memory");
            const unsigned og = xb_add(&bar[XB_TOP], 1u);
            const unsigned tg = og / nx;
            if (og + 1u == (tg + 1u) * nx) xb_add(&bar[XB_TOPGEN], 1u);
            else XB_SPIN(xb_ld(&bar[XB_TOPGEN]) == tg, bar);
            __builtin_amdgcn_fence(__ATOMIC_ACQUIRE, "agent");
            xb_add(&bar[XB_XGEN(b.x)], 1u);
            asm volatile("s_waitcnt vmcnt(0)" ::: "memory");
        } else {
            XB_SPIN(xb_ld(&bar[XB_XGEN(b.x)]) == gen, bar);
            __builtin_amdgcn_fence(__ATOMIC_ACQUIRE, "agent");
            asm volatile("s_waitcnt vmcnt(0)" ::: "memory");
        }
    }
    __syncthreads();
}
#define GRID_SYNC() do { XcdBarrier gb_; gb_.bar = (unsigned*)(p.ws + OFF_BAR); gb_.x = xb_xcc_id(); gb_.st = (volatile LAS unsigned*)(lds + SMEM_BYTES - 16); xcd_barrier(gb_); } while (0)
#else
#define GRID_SYNC() emu_grid_sync()
#endif

namespace pg8 {
constexpr int BM = 256, BK = 64, HALF = 128, HTB = HALF * BK * 2, STAGE_BYTES = 8 * HTB, NXCD = 8, WGM = 8;
__host__ __device__ __forceinline__ int lds_byte(int r, int c) { const int st = (r >> 4) * 2 + (c >> 5), rr = r & 15, cc = c & 31, ob = rr * 64 + cc * 2; return st * 1024 + (ob ^ (((ob >> 9) & 1) << 5)); }
__host__ __device__ __forceinline__ void stage_rc(int b, int& R, int& C) { const int st = b / 1024, sb = b % 1024, swz = sb ^ (((sb >> 9) & 1) << 5); R = (st >> 1) * 16 + swz / 64; C = (st & 1) * 32 + (swz % 64) / 2; }
__host__ __device__ __forceinline__ int perm32(int rho) { const int n = rho >> 4, i = rho & 15; return 8 * (i >> 2) + 4 * n + (i & 3); }
struct Unit { int pm, pn, pb, pa, aux, k0; };
struct Gemm { const half_t* A; const half_t* Bt; int K; int kt; };
struct StaticOrder {
    int nM, nN, nwg, G, c;
    __device__ void init(int nM_, int nN_, int G_, int c_) { nM = nM_; nN = nN_; nwg = nM * nN; G = G_; c = c_; }
    __device__ bool next(int i, Unit& u) const {
        const long L = (long)i * G + c; if (L >= nwg) return false;
        int wgid = (int)L; { const int q = nwg / NXCD, r = nwg % NXCD, xcd = wgid % NXCD, off = wgid / NXCD; wgid = (xcd < r ? xcd * (q + 1) : r * (q + 1) + (xcd - r) * q) + off; }
        const int nig = WGM * nN, gid = wgid / nig, fm = gid * WGM, gsz = (nM - fm) < WGM ? (nM - fm) : WGM;
        u.pm = fm + ((wgid % nig) % gsz); u.pn = (wgid % nig) / gsz; u.pb = u.pn; u.pa = u.pm; u.aux = 0; u.k0 = 0; return true;
    }
};
struct ExpertOrder {
    int G, c, tpa;
    __device__ void init(int tpa_, int G_, int c_) { tpa = tpa_; G = G_; c = c_; }
    __device__ bool next(int i, Unit& u) const {
        const long L = (long)i * G + c; if (L >= 16 * tpa * 4) return false;
        const int e = (int)L / (tpa * 4), rem = (int)L % (tpa * 4);
        u.pm = e * TPE + rem / 4; u.pn = rem % 4; u.pb = e * 4 + u.pn; u.pa = u.pm; u.aux = 0; u.k0 = 0; return true;
    }
};

struct LoraOrder {
    StaticOrder T;
    __device__ void init(int nM_, int G_, int c_) { T.init(nM_, 10, G_, c_); }
    __device__ bool next(int i, Unit& u) const { if (!T.next(i, u)) return false; const int blk = u.pn >> 1; u.k0 = blk < 4 ? 64 * blk : 256; return true; }
};
struct MergeOrder {
    StaticOrder T;
    __device__ void init(int nM_, int G_, int c_) { T.init(nM_, 4, G_, c_); }
    __device__ bool next(int i, Unit& u) const {
        if (!T.next(i / 3, u)) return false;
        const int bi = i % 3; u.aux = bi; u.pa = bi * (RGP / 256) + u.pm; u.pb = bi * 4 + u.pn; return true;
    }
};
template <class E, class = void> struct EpiCarry { static constexpr bool value = false; };
template <class E> struct EpiCarry<E, decltype((void)E::CARRY)> { static constexpr bool value = true; };
#ifndef CPU_EMU
template <class Epi, class Sched>
__device__ __forceinline__ void gemm_phase(int wb, LAS unsigned char* lds, const Gemm g, const Sched& S, const Epi& E) {
    const int tid = tid_fresh(wb), wid = __builtin_amdgcn_readfirstlane(tid >> 6), lane = tid & 63, wr = wid >> 2, wc = wid & 3, fr = lane & 15, fq = lane >> 4;
    const int K = g.K; int nt = g.kt; asm volatile("" : "+s"(nt));
    unsigned voffA[2], voffB[2];
#pragma unroll
    for (int i = 0; i < 2; ++i) { int R, C; stage_rc(tid * 16 + i * 8192, R, C); const int Rb = Epi::PERM ? ((R & ~31) + perm32(R & 31)) : R;
        voffA[i] = (unsigned)(R * K + C) * 2u; voffB[i] = (unsigned)(Rb * K + C) * 2u; }
    const size_t kstep = (size_t)(BK * 2);
    const size_t hstep = (size_t)HALF * K * 2;
    const size_t tstep = 2 * hstep;
    const unsigned ldsw = (unsigned)wid * 1024u;
    const int aoff = lds_byte(wr * 64 + fr, fq * 8), boff = lds_byte(wc * 32 + fr, fq * 8);
#define PG8_SA(b, h) (((b) * 2 + (h)) * HTB)
#define PG8_SB(b, h) ((4 + (b) * 2 + (h)) * HTB)
#define PG8_STAGE(bufoff, gbase, voff) do { _Pragma("unroll") for (int _i = 0; _i < 2; ++_i) \
        __builtin_amdgcn_global_load_lds((const unsigned*)((const char*)(gbase) + (voff)[_i]), (LAS unsigned*)(lds + (bufoff) + ldsw + _i * 8192), 16, 0, 0); } while (0)
#define PG8_LDA(dst, b, h) do { _Pragma("unroll") for (int m = 0; m < 4; ++m) _Pragma("unroll") for (int k = 0; k < 2; ++k) dst[m][k] = *(const LAS half8*)(lds + PG8_SA(b, h) + aoff + m * 2048 + k * 1024); } while (0)
#define PG8_LDB(dst, b, h) do { _Pragma("unroll") for (int n = 0; n < 2; ++n) _Pragma("unroll") for (int k = 0; k < 2; ++k) dst[n][k] = *(const LAS half8*)(lds + PG8_SB(b, h) + boff + n * 2048 + k * 1024); } while (0)
#define PG8_MMA(ai, bj, At, Bt) do { __builtin_amdgcn_s_setprio(1); _Pragma("unroll") for (int m = 0; m < 4; ++m) _Pragma("unroll") for (int n = 0; n < 2; ++n) _Pragma("unroll") for (int k = 0; k < 2; ++k) \
        acc[ai][bj][m][n] = __builtin_amdgcn_mfma_f32_16x16x32_f16(Bt[n][k], At[m][k], acc[ai][bj][m][n], 0, 0, 0); __builtin_amdgcn_s_setprio(0); } while (0)
#define PG8_WAIT_V(n) asm volatile("s_waitcnt vmcnt(" #n ")" ::: "memory")
#define PG8_WAIT_L(n) asm volatile("s_waitcnt lgkmcnt(" #n ")" ::: "memory")
#define PG8_BAR __builtin_amdgcn_s_barrier()
#define PG8_SCHED __builtin_amdgcn_sched_barrier(0)
    Unit cur, nxt; int ui = 0;
    if (!S.next(0, cur)) return;
    f32x4 acc[2][2][4][2];
#pragma unroll
    for (int a = 0; a < 2; ++a)
#pragma unroll
        for (int b = 0; b < 2; ++b)
#pragma unroll
            for (int m = 0; m < 4; ++m)
#pragma unroll
                for (int n = 0; n < 2; ++n) acc[a][b][m][n] = (f32x4){0.f, 0.f, 0.f, 0.f};
    half8 At[4][2], B0[2][2], B1[2][2];
    const char* cA = (const char*)g.A + (size_t)cur.pa * tstep + (size_t)cur.k0 * 2; const char* cB = (const char*)g.Bt + (size_t)cur.pb * tstep + (size_t)cur.k0 * 2;
    PG8_STAGE(PG8_SB(0, 0), cB, voffB); PG8_STAGE(PG8_SA(0, 0), cA, voffA); PG8_STAGE(PG8_SB(0, 1), cB + hstep, voffB); PG8_STAGE(PG8_SA(0, 1), cA + hstep, voffA);
    if (wr == 1) PG8_BAR;
    PG8_WAIT_V(4); PG8_BAR;
    PG8_STAGE(PG8_SB(1, 0), cB + kstep, voffB); PG8_STAGE(PG8_SA(1, 0), cA + kstep, voffA); PG8_STAGE(PG8_SB(1, 1), cB + hstep + kstep, voffB);
    PG8_WAIT_V(6); PG8_BAR;
    for (;;) {
        const bool has_next = S.next(ui + 1, nxt);
        const char* nA = has_next ? (const char*)g.A + (size_t)nxt.pa * tstep + (size_t)nxt.k0 * 2 : cA; const char* nB = has_next ? (const char*)g.Bt + (size_t)nxt.pb * tstep + (size_t)nxt.k0 * 2 : cB;
#pragma unroll 1
        for (int t = 0; t < nt; t += 2) {
            const bool last = (t == nt - 2);
            const char* a1 = cA + (size_t)(t + 1) * kstep;
            const char* a2 = last ? nA : cA + (size_t)(t + 2) * kstep; const char* b2 = last ? nB : cB + (size_t)(t + 2) * kstep;
            const char* a3 = a2 + kstep; const char* b3 = b2 + kstep;
            PG8_LDB(B0, 0, 0); PG8_SCHED; PG8_LDA(At, 0, 0); PG8_STAGE(PG8_SA(1, 1), a1 + hstep, voffA);
            PG8_WAIT_L(8); PG8_BAR; PG8_WAIT_L(0); PG8_MMA(0, 0, At, B0); PG8_BAR; PG8_SCHED;
            PG8_LDB(B1, 0, 1); PG8_STAGE(PG8_SB(0, 0), b2, voffB);
            PG8_BAR; PG8_WAIT_L(0); PG8_MMA(0, 1, At, B1); PG8_BAR;
            PG8_LDA(At, 0, 1); PG8_STAGE(PG8_SA(0, 0), a2, voffA);
            PG8_BAR; PG8_WAIT_L(0); PG8_MMA(1, 0, At, B0); PG8_BAR; PG8_SCHED;
            PG8_STAGE(PG8_SB(0, 1), b2 + hstep, voffB);
            PG8_WAIT_V(6); PG8_BAR; PG8_MMA(1, 1, At, B1); PG8_BAR;
            PG8_LDB(B0, 1, 0); PG8_SCHED; PG8_LDA(At, 1, 0); PG8_STAGE(PG8_SA(0, 1), a2 + hstep, voffA);
            PG8_WAIT_L(8); PG8_BAR; PG8_WAIT_L(0); PG8_MMA(0, 0, At, B0); PG8_BAR; PG8_SCHED;
            PG8_LDB(B1, 1, 1); PG8_STAGE(PG8_SB(1, 0), b3, voffB);
            PG8_BAR; PG8_WAIT_L(0); PG8_MMA(0, 1, At, B1); PG8_BAR;
            PG8_LDA(At, 1, 1); PG8_STAGE(PG8_SA(1, 0), a3, voffA);
            PG8_BAR; PG8_WAIT_L(0); PG8_MMA(1, 0, At, B0); PG8_BAR; PG8_SCHED;
            PG8_STAGE(PG8_SB(1, 1), b3 + hstep, voffB);
            PG8_WAIT_V(6); PG8_BAR; PG8_MMA(1, 1, At, B1); PG8_BAR;
        }
        bool keep = false;
        if constexpr (EpiCarry<Epi>::value) keep = E(acc, cur, wr, wc, fr, fq); else E(acc, cur, wr, wc, fr, fq);
        if (!has_next) break;
        if (!keep) {
#pragma unroll
            for (int a = 0; a < 2; ++a)
#pragma unroll
                for (int b = 0; b < 2; ++b)
#pragma unroll
                    for (int m = 0; m < 4; ++m)
#pragma unroll
                        for (int n = 0; n < 2; ++n) acc[a][b][m][n] = (f32x4){0.f, 0.f, 0.f, 0.f};
        }
        cur = nxt; cA = nA; cB = nB; ++ui;
    }
    PG8_WAIT_V(0);
    if (wr == 0) PG8_BAR;
    PG8_BAR;
#undef PG8_SA
#undef PG8_SB
#undef PG8_STAGE
#undef PG8_LDA
#undef PG8_LDB
#undef PG8_MMA
#undef PG8_WAIT_V
#undef PG8_WAIT_L
#undef PG8_BAR
#undef PG8_SCHED
}
#else
static float* emu_fa[64]; static float* emu_fb[64];
template <class Epi, class Sched>
void gemm_phase(int wb, LAS unsigned char* lds, const Gemm g, const Sched& S, const Epi& E) {
    const int tid = tid_fresh(wb), wid = tid >> 6, lane = tid & 63, wr = wid >> 2, wc = wid & 3, fr = lane & 15, fq = lane >> 4;
    const int K = g.K; const int bid = blockIdx.x;
    Unit u; f32x4 acc[2][2][4][2]; bool emu_keep = false;
    for (int ui = 0; S.next(ui, u); ++ui) {
        SYNC();
        if (tid == 0) {
            if (!emu_fa[bid]) { emu_fa[bid] = (float*)malloc(256 * 1024 * 4); emu_fb[bid] = (float*)malloc(256 * 1024 * 4); }
            for (int r = 0; r < 256; ++r) for (int k = 0; k < K; ++k) { emu_fa[bid][r * K + k] = (float)g.A[((size_t)u.pa * 256 + r) * K + k]; emu_fb[bid][r * K + k] = (float)g.Bt[((size_t)u.pb * 256 + r) * K + k]; }
        }
        SYNC();
        if (!emu_keep) for (int ai = 0; ai < 2; ++ai) for (int bj = 0; bj < 2; ++bj) for (int m = 0; m < 4; ++m) for (int n = 0; n < 2; ++n) acc[ai][bj][m][n] = (f32x4){0.f, 0.f, 0.f, 0.f};
        for (int ai = 0; ai < 2; ++ai) for (int bj = 0; bj < 2; ++bj) for (int m = 0; m < 4; ++m) for (int n = 0; n < 2; ++n) for (int i = 0; i < 4; ++i) {
            const int row = 128 * ai + 64 * wr + 16 * m + fr;
            const int col = Epi::PERM ? (128 * bj + 32 * wc + 8 * fq + 4 * n + i) : (128 * bj + 32 * wc + 16 * n + 4 * fq + i);
            const float* a = emu_fa[bid] + row * K; const float* b = emu_fb[bid] + col * K; float s = 0.f;
            for (int k = u.k0; k < u.k0 + 64 * g.kt; ++k) s += a[k] * b[k];
            acc[ai][bj][m][n][i] += s; }
        if constexpr (EpiCarry<Epi>::value) emu_keep = E(acc, u, wr, wc, fr, fq); else { E(acc, u, wr, wc, fr, fq); emu_keep = false; }
    }
    SYNC();
}
#endif
}
using pg8::Unit;

struct EpiP {
    static constexpr bool PERM = true;
    half_t* P;
    __device__ __forceinline__ void operator()(const f32x4 (&acc)[2][2][4][2], const Unit& u, int wr, int wc, int fr, int fq) const {
        const int row0 = u.pm * 256 + wr * 64 + fr, col0 = u.pn * 256 + wc * 32 + 8 * fq;
        const bool tile_sg = u.pn * 256 + 256 > C_MLO;
        if (!tile_sg) {
#pragma unroll
            for (int bj = 0; bj < 2; ++bj)
#pragma unroll
                for (int ai = 0; ai < 2; ++ai)
#pragma unroll
                    for (int m = 0; m < 4; ++m) { half8 h;
#pragma unroll
                        for (int n = 0; n < 2; ++n)
#pragma unroll
                            for (int i = 0; i < 4; ++i) h[4 * n + i] = (half_t)acc[ai][bj][m][n][i];
                        *(half8*)(P + (size_t)(row0 + ai * 128 + m * 16) * NP + col0 + bj * 128) = h; }
            return;
        }
#pragma unroll
        for (int bj = 0; bj < 2; ++bj) {
            const int col = col0 + bj * 128;
            const bool sg = tile_sg && ((col >= C_GATE && col < IN_COLS) || (col >= C_MLO && col < C_MLIG));
#pragma unroll
            for (int ai = 0; ai < 2; ++ai)
#pragma unroll
                for (int m = 0; m < 4; ++m) {
                    half8 h;
#pragma unroll
                    for (int n = 0; n < 2; ++n)
#pragma unroll
                        for (int i = 0; i < 4; ++i) { float v = acc[ai][bj][m][n][i]; if (sg) v = sigm(v); h[4 * n + i] = (half_t)v; }
                    *(half8*)(P + (size_t)(row0 + ai * 128 + m * 16) * NP + col) = h;
                }
        }
    }
};
struct EpiNull {
    static constexpr bool PERM = true;
    float* sink;
    __device__ __forceinline__ void operator()(const f32x4 (&acc)[2][2][4][2], const Unit& u, int wr, int wc, int fr, int fq) const {
        f32x4 t = {0.f, 0.f, 0.f, 0.f};
#pragma unroll
        for (int ai = 0; ai < 2; ++ai)
#pragma unroll
            for (int bj = 0; bj < 2; ++bj)
#pragma unroll
                for (int m = 0; m < 4; ++m)
#pragma unroll
                    for (int n = 0; n < 2; ++n) t += acc[ai][bj][m][n];
        if (t[0] + t[1] + t[2] + t[3] == 12345.678f) sink[0] = t[0];
    }
};
struct EpiLora {
    static constexpr bool PERM = true;
    half_t* O; const float* w0; const float* a0;
    __device__ __forceinline__ void operator()(const f32x4 (&acc)[2][2][4][2], const Unit& u, int wr, int wc, int fr, int fq) const {
        const int row0 = u.pm * 256 + wr * 64 + fr, col0 = u.pn * 256 + wc * 32 + 8 * fq;
#pragma unroll
        for (int bj = 0; bj < 2; ++bj) {
            const int col = col0 + bj * 128, blk = col >> 9;
            float bias[8];
#pragma unroll
            for (int j = 0; j < 8; ++j) bias[j] = blk < 2 ? w0[col + j] : (blk < 4 ? a0[col - 1024 + j] : 0.f);
#pragma unroll
            for (int ai = 0; ai < 2; ++ai)
#pragma unroll
                for (int m = 0; m < 4; ++m) {
                    half8 h;
#pragma unroll
                    for (int n = 0; n < 2; ++n)
#pragma unroll
                        for (int i = 0; i < 4; ++i) { float v = acc[ai][bj][m][n][i] + bias[4 * n + i];
                            if (blk < 2) v = sigm(v) * 0.6065306597126334f; else if (blk < 4) v = sigm(v);
                            h[4 * n + i] = (half_t)v; }
                    *(half8*)(O + (size_t)(row0 + ai * 128 + m * 16) * 2560 + col) = h;
                }
        }
    }
};
struct EpiMerge {
    static constexpr bool PERM = true; static constexpr bool CARRY = true;
    half_t* M; const half_t* P;
    __device__ __forceinline__ bool operator()(f32x4 (&acc)[2][2][4][2], const Unit& u, int wr, int wc, int fr, int fq) const {
        const int bi = u.aux;
        const half_t* G0 = P + (size_t)(u.pm * 256 + wr * 64 + fr) * NP + C_GATE + bi * 1024 + u.pn * 256 + wc * 32 + 8 * fq;
        if (bi < 2) {
#pragma unroll
            for (int ai = 0; ai < 2; ++ai) {
                half8 gt[4][2], gn[4][2];
#pragma unroll
                for (int m = 0; m < 4; ++m)
#pragma unroll
                    for (int bj = 0; bj < 2; ++bj) { const half_t* q = G0 + (size_t)(ai * 128 + m * 16) * NP + bj * 128; gt[m][bj] = *(const half8*)q; gn[m][bj] = *(const half8*)(q + 1024); }
                EPI_LOAD_FENCE();
#pragma unroll
                for (int m = 0; m < 4; ++m)
#pragma unroll
                    for (int bj = 0; bj < 2; ++bj)
#pragma unroll
                        for (int n = 0; n < 2; ++n)
#pragma unroll
                            for (int i = 0; i < 4; ++i) acc[ai][bj][m][n][i] *= (float)gt[m][bj][4 * n + i] * frcp(fmaxf((float)gn[m][bj][4 * n + i], 6.0e-8f));
            }
            return true;
        }
        half_t* M0 = M + (size_t)(u.pm * 256 + wr * 64 + fr) * 1024 + u.pn * 256 + wc * 32 + 8 * fq;
#pragma unroll
        for (int ai = 0; ai < 2; ++ai) {
            half8 gt[4][2];
#pragma unroll
            for (int m = 0; m < 4; ++m)
#pragma unroll
                for (int bj = 0; bj < 2; ++bj) gt[m][bj] = *(const half8*)(G0 + (size_t)(ai * 128 + m * 16) * NP + bj * 128);
#pragma unroll
            for (int m = 0; m < 4; ++m)
#pragma unroll
                for (int bj = 0; bj < 2; ++bj) { half8 o;
#pragma unroll
                    for (int n = 0; n < 2; ++n)
#pragma unroll
                        for (int i = 0; i < 4; ++i) o[4 * n + i] = (half_t)((float)gt[m][bj][4 * n + i] * acc[ai][bj][m][n][i]);
                    *(half8*)(M0 + (size_t)(ai * 128 + m * 16) * 1024 + bj * 128) = o; }
        }
        return false;
    }
};
struct EpiOut {
    static constexpr bool PERM = true;
    Params p; int l, g, rg;
    __device__ __forceinline__ void operator()(const f32x4 (&acc)[2][2][4][2], const Unit& u, int wr, int wc, int fr, int fq) const {
        static_assert(RL % 256 == 0 && RCX % 256 == 0 && SEQ % 256 == 0, "row tiles must not straddle samples");
        const int r0 = u.pm * 256, cb = u.pn * 256 + wc * 32 + 8 * fq;
        half_t* dst = (half_t*)(p.ws + OFF_DX) + (size_t)(r0 + wr * 64 + fr) * D + cb; const float* md = mod_row(p, l, g, r0) + 2 * 1024 + cb;
        f32x4 mv[2][2];
#pragma unroll
        for (int bj = 0; bj < 2; ++bj)
#pragma unroll
            for (int n = 0; n < 2; ++n) mv[bj][n] = *(const f32x4*)(md + bj * 128 + 4 * n);
#pragma unroll
        for (int ai = 0; ai < 2; ++ai)
#pragma unroll
            for (int m = 0; m < 4; ++m)
#pragma unroll
                for (int bj = 0; bj < 2; ++bj) { half8 o;
#pragma unroll
                    for (int n = 0; n < 2; ++n)
#pragma unroll
                        for (int i = 0; i < 4; ++i) o[4 * n + i] = (half_t)(mv[bj][n][i] * acc[ai][bj][m][n][i]);
                    *(half8*)(dst + (size_t)(ai * 128 + m * 16) * D + bj * 128) = o; }
    }
};
struct EpiUp {
    static constexpr bool PERM = true;
    half_t* HID;
    __device__ __forceinline__ void operator()(const f32x4 (&acc)[2][2][4][2], const Unit& u, int wr, int wc, int fr, int fq) const {
        const int row0 = u.pm * 256 + wr * 64 + fr, col = u.pn * 128 + wc * 32 + 8 * fq;
#pragma unroll
        for (int ai = 0; ai < 2; ++ai)
#pragma unroll
            for (int m = 0; m < 4; ++m) {
                half8 h;
#pragma unroll
                for (int n = 0; n < 2; ++n)
#pragma unroll
                    for (int i = 0; i < 4; ++i) h[4 * n + i] = (half_t)(siluf(acc[ai][0][m][n][i]) * acc[ai][1][m][n][i]);
                *(half8*)(HID + (size_t)(row0 + ai * 128 + m * 16) * 512 + col) = h;
            }
    }
};
struct EpiDown {
    static constexpr bool PERM = true;
    half_t* YE; const float* AFF;
    __device__ __forceinline__ void operator()(const f32x4 (&acc)[2][2][4][2], const Unit& u, int wr, int wc, int fr, int fq) const {
        const int row0 = u.pm * 256 + wr * 64 + fr, col0 = u.pn * 256 + wc * 32 + 8 * fq;
        float afv[2][4];
#pragma unroll
        for (int ai = 0; ai < 2; ++ai)
#pragma unroll
            for (int m = 0; m < 4; ++m) afv[ai][m] = AFF[row0 + ai * 128 + m * 16];
        EPI_LOAD_FENCE();
#pragma unroll
        for (int ai = 0; ai < 2; ++ai)
#pragma unroll
            for (int m = 0; m < 4; ++m) {
                const size_t row = (size_t)(row0 + ai * 128 + m * 16); const float af = afv[ai][m];
#pragma unroll
                for (int bj = 0; bj < 2; ++bj) {
                    half8 h;
#pragma unroll
                    for (int n = 0; n < 2; ++n)
#pragma unroll
                        for (int i = 0; i < 4; ++i) h[4 * n + i] = (half_t)(acc[ai][bj][m][n][i] * af);
                    *(half8*)(YE + row * 1024 + col0 + bj * 128) = h;
                }
            }
    }
};

__device__ __forceinline__ void ph_mod(int wb, const Params& p, LAS unsigned char* lds) {
    LAS float* sv = (LAS float*)lds; LAS float* red = sv + (BATCH + 1) * 1024;
    const int tid = tid_fresh(wb);
    for (int i = tid; i < (BATCH + 1) * 1024; i += NT) { const int s = i >> 10, k = i & 1023; const float cv = s < BATCH ? p.in[I_C][s * 1024 + k] : p.in[I_CCTX][k]; sv[i] = siluf(cv); }
    SYNC();
    float* mod = (float*)(p.ws + OFF_MOD);
    for (int item = blockIdx.x; item < DEPTH * 48; item += gridDim.x) {
        const int l = item / 48, j = (item % 48) * 128 + (tid & 127), kq = tid >> 7;
        float acc[BATCH + 1];
#pragma unroll
        for (int s = 0; s <= BATCH; ++s) acc[s] = 0.f;
        const float* w = p.in[I_ADAW] + (size_t)l * 1024 * 6144 + j;
        for (int k = kq * 256; k < kq * 256 + 256; ++k) { const float wv = w[(size_t)k * 6144];
#pragma unroll
            for (int s = 0; s <= BATCH; ++s) acc[s] += sv[s * 1024 + k] * wv; }
#pragma unroll
        for (int s = 0; s <= BATCH; ++s) red[tid * (BATCH + 1) + s] = acc[s];
        SYNC();
        if (tid < 128) {
#pragma unroll
            for (int s = 0; s <= BATCH; ++s) { float v = p.in[I_ADAB][l * 6144 + j];
                for (int q = 0; q < 4; ++q) v += red[(q * 128 + tid) * (BATCH + 1) + s];
                mod[((size_t)l * (BATCH + 1) + s) * 6144 + j] = v; }
        }
        SYNC();
    }
}

__device__ __forceinline__ void tconv_tile(int wb, const float* src, int sld, int k0, int n0, int nvalid, half_t* dst, int dld, int drow0, int dcol0, LAS float* tile) {
    const int tid = tid_fresh(wb), r = tid >> 4, c4 = (tid & 15) * 4;
#pragma unroll
    for (int j = 0; j < 2; ++j) { const int k = r + 32 * j; f32x4 v = {0.f, 0.f, 0.f, 0.f};
        if (src && n0 + c4 < nvalid) v = *(const f32x4*)(src + (size_t)(k0 + k) * sld + n0 + c4);
        tile[k * 65 + c4] = v[0]; tile[k * 65 + c4 + 1] = v[1]; tile[k * 65 + c4 + 2] = v[2]; tile[k * 65 + c4 + 3] = v[3]; }
    SYNC();
    const int n = tid >> 3, k8 = (tid & 7) * 8; half8 h;
#pragma unroll
    for (int i = 0; i < 8; ++i) h[i] = (half_t)tile[(k8 + i) * 65 + n];
    *(half8*)(dst + (size_t)(drow0 + n) * dld + dcol0 + k8) = h;
    SYNC();
}
__device__ __forceinline__ void ph_convert(int wb, const Params& p, int l, int part, int ce, int ge, LAS unsigned char* lds) {
    LAS float* tile = (LAS float*)lds;
    constexpr int N_WIN = 16 * (NP / 64), N_WBR = 3 * 128, N_WOUT = 256, N_W13 = 2 * 2048, N_W2 = 2048, N_LORA = 240;
    constexpr int N_MID = N_WBR + N_WOUT + N_W13 + N_W2;
    half_t* ws16 = (half_t*)p.ws;
    const int nv = part == 0 ? N_WIN + N_LORA : N_MID;
    if (ce < 0) return;
    for (int v = ce; v < nv; v += ge) {
        const int item = part == 0 ? (v < N_WIN ? v : v + N_MID) : v + N_WIN;
        int it = item;
        if (it < N_WIN) { const int kt = it % 16, ntile = it / 16;
            tconv_tile(wb, p.in[I_WIN] + (size_t)l * 1024 * IN_COLS, IN_COLS, 64 * kt, 64 * ntile, IN_COLS, (half_t*)(p.ws + OFF_WIN), 1024, 64 * ntile, 64 * kt, tile); continue; }
        it -= N_WIN;
        if (it < N_WBR) { const int i = it / 128, rem = it % 128, kt = rem % 8, ntile = rem / 8;
            tconv_tile(wb, p.in[I_WBR] + (size_t)(l * 3 + i) * 512 * 1024, 1024, 64 * kt, 64 * ntile, 1024, (half_t*)(p.ws + OFF_WBR) + (size_t)i * 1024 * 512, 512, 64 * ntile, 64 * kt, tile); continue; }
        it -= N_WBR;
        if (it < N_WOUT) { const int kt = it % 16, ntile = it / 16;
            tconv_tile(wb, p.in[I_WOUT] + (size_t)l * 1024 * 1024, 1024, 64 * kt, 64 * ntile, 1024, (half_t*)(p.ws + OFF_WOUT), 1024, 64 * ntile, 64 * kt, tile); continue; }
        it -= N_WOUT;
        if (it < N_W13) { const int which = it / 2048, rem = it % 2048, e = rem / 128, r2 = rem % 128, kt = r2 % 16, ntile = r2 / 16, n0 = 64 * ntile;
            tconv_tile(wb, p.in[which ? I_W3 : I_W1] + (size_t)(l * 16 + e) * 1024 * 512, 512, 64 * kt, n0, 512, (half_t*)(p.ws + OFF_WUP) + (size_t)e * 1024 * 1024, 1024,
                       (n0 / 128) * 256 + which * 128 + (n0 % 128), 64 * kt, tile); continue; }
        it -= N_W13;
        if (it < N_W2) { const int e = it / 128, r2 = it % 128, kt = r2 % 8, ntile = r2 / 8;
            tconv_tile(wb, p.in[I_W2] + (size_t)(l * 16 + e) * 512 * 1024, 1024, 64 * kt, 64 * ntile, 1024, (half_t*)(p.ws + OFF_WDN) + (size_t)e * 1024 * 512, 512, 64 * ntile, 64 * kt, tile); continue; }
        it -= N_W2;
        { const int ntile = it / 6, kt = it % 6, n0 = 64 * ntile, blk = n0 / 512, nn0 = n0 % 512;
          const float* src = nullptr; int k0 = 0;
          if (blk == 0 && kt == 0) src = p.in[I_RWUP] + (size_t)(l * 2 + 0) * 64 * 512;
          else if (blk == 1 && kt == 1) src = p.in[I_RWUP] + (size_t)(l * 2 + 1) * 64 * 512;
          else if (blk == 2 && kt == 2) src = p.in[I_RAUP] + (size_t)(l * 2 + 0) * 64 * 512;
          else if (blk == 3 && kt == 3) src = p.in[I_RAUP] + (size_t)(l * 2 + 1) * 64 * 512;
          else if (blk == 4 && kt >= 4) { src = p.in[I_RGUP] + (size_t)l * 128 * 512; k0 = 64 * (kt - 4); }
          tconv_tile(wb, src, 512, k0, nn0, 512, (half_t*)(p.ws + OFF_WLORA), 384, n0, 64 * kt, tile); }
    }
    (void)ws16;
}

__device__ __forceinline__ void ph_xconv(int wb, const Params& p) {
    const int tid = tid_fresh(wb), wid = tid >> 6, lane = tid & 63;
    constexpr int NROW = BATCH * SEQ + BATCH * CTXL, RU = 4; const int rstep = gridDim.x * 8;
    for (int t0 = blockIdx.x * 8 + wid; t0 < NROW; t0 += rstep * RU) {
        f32x4 v[RU][4];
#pragma unroll
        for (int u = 0; u < RU; ++u) { const int t = t0 + u * rstep < NROW ? t0 + u * rstep : t0;
            const float* src = t < BATCH * SEQ ? p.in[I_X] + (size_t)t * D : p.in[I_CTX] + (size_t)(t - BATCH * SEQ) * D;
#pragma unroll
            for (int j = 0; j < 4; ++j) v[u][j] = *(const f32x4*)(src + lane * 4 + 256 * j); }
        EPI_LOAD_FENCE();
#pragma unroll
        for (int u = 0; u < RU; ++u) { const int t = t0 + u * rstep; if (t >= NROW) continue;
            half_t* dst = (half_t*)(t < BATCH * SEQ ? p.out + (size_t)t * D : (float*)(p.ws + OFF_CTXR) + (size_t)(t - BATCH * SEQ) * D) + 1024;
#pragma unroll
            for (int j = 0; j < 4; ++j) *(half4*)(dst + lane * 4 + 256 * j) = cvt4(v[u][j]); }
    }
}

__device__ __forceinline__ void ph_norm1(int wb, const Params& p, int l, int g) {
    const int tid = tid_fresh(wb), wid = tid >> 6, lane = tid & 63;
    half_t* H = (half_t*)(p.ws + OFF_H);
    constexpr int RU = 2;
    const int rstep = gridDim.x * 8; const float* gn = p.in[I_N1G] + l * D;
    const Geo gq = geo_of(g); const int RG = gq.rg, RGPg = gq.rgp;
    f32x4 gv[4];
#pragma unroll
    for (int j = 0; j < 4; ++j) gv[j] = *(const f32x4*)(gn + lane * 4 + 256 * j);
    for (int r0 = blockIdx.x * 8 + wid; r0 < RGPg; r0 += rstep * RU) {
        f32x4 v[RU][4], sh[RU][4], sc[RU][4]; float ss[RU];
#pragma unroll
        for (int u = 0; u < RU; ++u) { const int r = r0 + u * rstep < RG ? r0 + u * rstep : 0;
            const half_t* xr = res_h(p, g, r); const float* md = mod_row(p, l, g, r);
#pragma unroll
            for (int j = 0; j < 4; ++j) { const int c = lane * 4 + 256 * j; v[u][j] = h4f(*(const half4*)(xr + c)); sh[u][j] = *(const f32x4*)(md + c); sc[u][j] = *(const f32x4*)(md + 1024 + c); } }
        EPI_LOAD_FENCE();
#pragma unroll
        for (int u = 0; u < RU; ++u) { float a = 0.f;
#pragma unroll
            for (int j = 0; j < 4; ++j) a += v[u][j][0] * v[u][j][0] + v[u][j][1] * v[u][j][1] + v[u][j][2] * v[u][j][2] + v[u][j][3] * v[u][j][3];
            ss[u] = a; }
#pragma unroll
        for (int u = 0; u < RU; ++u) ss[u] = wave_sum(ss[u]);
#pragma unroll
        for (int u = 0; u < RU; ++u) { const int r = r0 + u * rstep; if (r >= RGPg) continue;
            if (r >= RG) { for (int j = 0; j < 4; ++j) *(half4*)(H + (size_t)r * D + lane * 4 + 256 * j) = (half4){0, 0, 0, 0}; continue; }
            const float rinv = frsq(ss[u] * (1.f / D) + 1e-6f);
#pragma unroll
            for (int j = 0; j < 4; ++j) { const int c = lane * 4 + 256 * j;
                *(half4*)(H + (size_t)r * D + c) = cvt4(v[u][j] * rinv * gv[j] * (sc[u][j] + 1.f) + sh[u][j]); } }
    }
#ifndef CPU_EMU
    if (WARM_WIN) {
        const uint4* wp = (const uint4*)(p.ws + OFF_WIN); unsigned acc = 0u;
        for (size_t i = (size_t)blockIdx.x * NT + tid; i < (size_t)NP * 1024 * 2 / 16; i += (size_t)gridDim.x * NT) acc ^= wp[i].x;
        if (acc == 0x9E3779B9u && tid == 99999) *(unsigned*)(p.ws + OFF_BAR + 15000) = acc;
    }
#endif
}

struct RowGeo { int gw, gh, base, gr, gc; };
__device__ __forceinline__ RowGeo row_geo(int r) {
    RowGeo q; int i;
    if (r < RL) { const int bl = r / SEQ; i = r % SEQ; q.gw = 64; q.gh = SEQ / 64; q.base = bl * SEQ; }
    else { const int rr = r - RL, bl = rr / CTXL; i = rr % CTXL; q.gw = CTXL; q.gh = 1; q.base = RL + bl * CTXL; }
    q.gr = i / q.gw; q.gc = i % q.gw; return q;
}

template <int PV = 3> __device__ __forceinline__ void ph_prep(int wb, const Params& p, int l, int RG, LAS unsigned char* lds) {
    const int tid = tid_fresh(wb), wid = tid >> 6, lane = tid & 63;
    LAS float* cw = (LAS float*)lds;
    for (int i = tid; i < 9 * 1536; i += NT) cw[i] = p.in[I_GCONV][(size_t)l * 9 * 1536 + i];
    SYNC();
    const half_t* P = (const half_t*)(p.ws + OFF_P);
    half_t* GQKV = (half_t*)(p.ws + OFF_GQKV); float* GBG = (float*)(p.ws + OFF_GBG);
    half_t* RW = (half_t*)(p.ws + OFF_RW); half_t* RLI = (half_t*)(p.ws + OFF_RLI);
    f32x4 muv[4][2]; f32x4 kkv[2];
    { const float* mu = p.in[I_RMU] + (size_t)l * 1920;
#pragma unroll
      for (int j = 0; j < 4; ++j) { const int cj = j < 3 ? j * 512 + 8 * lane : 1536 + 8 * (lane < 48 ? lane : 47); muv[j][0] = *(const f32x4*)(mu + cj); muv[j][1] = *(const f32x4*)(mu + cj + 4); }
      const float* kkw = p.in[I_RKK] + (size_t)l * 512 + 8 * lane; kkv[0] = *(const f32x4*)(kkw); kkv[1] = *(const f32x4*)(kkw + 4); }
    for (int r = blockIdx.x * 8 + wid; r < RG; r += gridDim.x * 8) {
        const RowGeo q = row_geo(r);
        if (PV & 1) {
        float acc[3][8];
#pragma unroll
        for (int j = 0; j < 3; ++j)
#pragma unroll
            for (int e = 0; e < 8; ++e) acc[j][e] = 0.f;
        for (int kh = 0; kh < 3; ++kh) { const int nr = q.gr + kh - 1; if (nr < 0 || nr >= q.gh) continue;
            for (int kw = 0; kw < 3; ++kw) { const int nc = q.gc + kw - 1; if (nc < 0 || nc >= q.gw) continue;
                const size_t nrow = (size_t)(q.base + nr * q.gw + nc);
#pragma unroll
                for (int j = 0; j < 3; ++j) { const half8 pv = *(const half8*)(P + nrow * NP + j * 512 + 8 * lane); const LAS float* w = cw + (kh * 3 + kw) * 1536 + j * 512 + 8 * lane;
#pragma unroll
                    for (int e = 0; e < 8; ++e) acc[j][e] += (float)pv[e] * w[e]; } } }
#pragma unroll
        for (int j = 0; j < 3; ++j) {
            float ss = 0.f;
#pragma unroll
            for (int e = 0; e < 8; ++e) { acc[j][e] = siluf(acc[j][e]); ss += acc[j][e] * acc[j][e]; }
            float sc = 1.f;
            if (j < 2) { ss += SHFL_XOR(ss, 1); ss += SHFL_XOR(ss, 2); ss += SHFL_XOR(ss, 4); ss += SHFL_XOR(ss, 8); sc = frsq(ss + 1e-6f) * (j == 0 ? 0.08838834764831845f : 1.f); }
            half8 h;
#pragma unroll
            for (int e = 0; e < 8; ++e) h[e] = (half_t)(acc[j][e] * sc);
            *(half8*)(GQKV + (size_t)r * 1536 + j * 512 + 8 * lane) = h;
        }
        if (lane < 16) { const float x = (float)P[(size_t)r * NP + C_BG + lane];
            float o; if (lane < 8) o = sigm(x); else { const int idx = lane - 8; o = -fexp(p.in[I_GALOG][l * 8 + idx]) * softplusf(x + p.in[I_GDTB][l * 8 + idx]); }
            GBG[(size_t)r * 16 + lane] = o; }
        }
        if (PV & 2) {
        const int nb[4] = { q.gc > 0 ? r - 1 : -1, q.gc < q.gw - 1 ? r + 1 : -1, q.gr > 0 ? r - q.gw : -1, q.gr < q.gh - 1 ? r + q.gw : -1 };
        float kmix[8];
#pragma unroll
        for (int j = 0; j < 4; ++j) {
            if (j == 3 && lane >= 48) break;
            const int cj = j < 3 ? j * 512 + 8 * lane : 1536 + 8 * lane;
            const half8 self = *(const half8*)(P + (size_t)r * NP + C_RWKV + cj);
            half8 nv[4];
#pragma unroll
            for (int d = 0; d < 4; ++d) { if (nb[d] >= 0) nv[d] = *(const half8*)(P + (size_t)nb[d] * NP + C_RWKV + cj); else nv[d] = (half8){0, 0, 0, 0, 0, 0, 0, 0}; }
            float val[8];
#pragma unroll
            for (int e = 0; e < 8; ++e) { const float s = (float)self[e], nn = (float)nv[e & 3][e]; val[e] = s + (nn - s) * muv[j][e >> 2][e & 3]; }
            half8 h;
            if (j < 3) {
#pragma unroll
                for (int e = 0; e < 8; ++e) h[e] = (half_t)val[e];
                *(half8*)(RW + ((size_t)r * 4 + j) * 512 + 8 * lane) = h;
                if (j == 1) {
#pragma unroll
                    for (int e = 0; e < 8; ++e) kmix[e] = val[e]; }
            } else {
                const int c0 = 8 * lane;
#pragma unroll
                for (int e = 0; e < 8; ++e) { float v = val[e]; if (c0 < 128) v = ftanh(v); else if (c0 >= 256) v = sigm(v); h[e] = (half_t)v; }
                *(half8*)(RLI + (size_t)r * 384 + c0) = h;
            }
        }
        { float t[8], ss = 0.f;
#pragma unroll
          for (int e = 0; e < 8; ++e) { t[e] = kmix[e] * kkv[e >> 2][e & 3]; ss += t[e] * t[e]; }
          ss += SHFL_XOR(ss, 1); ss += SHFL_XOR(ss, 2); ss += SHFL_XOR(ss, 4);
          const float sc = frsq(ss + 1e-6f); half8 h;
#pragma unroll
          for (int e = 0; e < 8; ++e) h[e] = (half_t)(t[e] * sc);
          *(half8*)(RW + ((size_t)r * 4 + 3) * 512 + 8 * lane) = h; }
        }
    }
}

__device__ __forceinline__ void ph_prep2(int wb, const Params& p, int l, int RG, LAS unsigned char* lds) {
    const int tid = tid_fresh(wb), wid = tid >> 6, lane = tid & 63;
    LAS float* cw = (LAS float*)lds;
    for (int i = tid; i < 9 * 1536; i += NT) cw[i] = p.in[I_GCONV][(size_t)l * 9 * 1536 + i];
    SYNC();
    const half_t* P = (const half_t*)(p.ws + OFF_P);
    half_t* GQKV = (half_t*)(p.ws + OFF_GQKV); float* GBG = (float*)(p.ws + OFF_GBG);
    half_t* RW = (half_t*)(p.ws + OFF_RW); half_t* RLI = (half_t*)(p.ws + OFF_RLI);
    f32x4 kkv[2]; const float* mu = p.in[I_RMU] + (size_t)l * 1920;
    { const float* kkw = p.in[I_RKK] + (size_t)l * 512 + 8 * lane; kkv[0] = *(const f32x4*)(kkw); kkv[1] = *(const f32x4*)(kkw + 4); }
    const half8 z8 = {0, 0, 0, 0, 0, 0, 0, 0};
    for (int pr = blockIdx.x * 8 + wid; pr < RG / 2; pr += gridDim.x * 8) {
        const int rA = 2 * pr; const RowGeo q = row_geo(rA);
        { float acc[2][3][8];
#pragma unroll
          for (int t = 0; t < 2; ++t)
#pragma unroll
            for (int j = 0; j < 3; ++j)
#pragma unroll
                for (int e = 0; e < 8; ++e) acc[t][j][e] = 0.f;
#pragma unroll 1
          for (int kh = 0; kh < 3; ++kh) { const int nr = q.gr + kh - 1; if (nr < 0 || nr >= q.gh) continue;
            half8 col[4][3];
#pragma unroll
            for (int cc = 0; cc < 4; ++cc) { const int nc = q.gc - 1 + cc; const bool ok = nc >= 0 && nc < q.gw; const size_t nrow = (size_t)(q.base + nr * q.gw + (ok ? nc : 0));
#pragma unroll
                for (int j = 0; j < 3; ++j) col[cc][j] = ok ? *(const half8*)(P + nrow * NP + j * 512 + 8 * lane) : z8; }
#pragma unroll
            for (int kw = 0; kw < 3; ++kw)
#pragma unroll
                for (int j = 0; j < 3; ++j) { const LAS float* w = cw + (kh * 3 + kw) * 1536 + j * 512 + 8 * lane; const f32x4 w0 = *(const LAS f32x4*)w, w1 = *(const LAS f32x4*)(w + 4);
#pragma unroll
                    for (int e = 0; e < 4; ++e) { acc[0][j][e] += (float)col[kw][j][e] * w0[e]; acc[0][j][4 + e] += (float)col[kw][j][4 + e] * w1[e];
                        acc[1][j][e] += (float)col[kw + 1][j][e] * w0[e]; acc[1][j][4 + e] += (float)col[kw + 1][j][4 + e] * w1[e]; } } }
#pragma unroll
          for (int t = 0; t < 2; ++t) { const int r = rA + t;
#pragma unroll
            for (int j = 0; j < 3; ++j) {
                float ss = 0.f;
#pragma unroll
                for (int e = 0; e < 8; ++e) { acc[t][j][e] = siluf(acc[t][j][e]); ss += acc[t][j][e] * acc[t][j][e]; }
                float sc = 1.f;
                if (j < 2) { ss += SHFL_XOR(ss, 1); ss += SHFL_XOR(ss, 2); ss += SHFL_XOR(ss, 4); ss += SHFL_XOR(ss, 8); sc = frsq(ss + 1e-6f) * (j == 0 ? 0.08838834764831845f : 1.f); }
                half8 h;
#pragma unroll
                for (int e = 0; e < 8; ++e) h[e] = (half_t)(acc[t][j][e] * sc);
                *(half8*)(GQKV + (size_t)r * 1536 + j * 512 + 8 * lane) = h;
            }
            if (lane < 16) { const float x = (float)P[(size_t)r * NP + C_BG + lane];
                float o; if (lane < 8) o = sigm(x); else { const int idx = lane - 8; o = -fexp(p.in[I_GALOG][l * 8 + idx]) * softplusf(x + p.in[I_GDTB][l * 8 + idx]); }
                GBG[(size_t)r * 16 + lane] = o; } } }
        { const int rL = q.gc > 0 ? rA - 1 : -1, rR = q.gc + 2 < q.gw ? rA + 2 : -1, rUA = q.gr > 0 ? rA - q.gw : -1, rDA = q.gr < q.gh - 1 ? rA + q.gw : -1;
          float kmix[2][8];
#pragma unroll
          for (int jj = 0; jj < 2; ++jj) {
            half8 sA[2], sB[2], vL[2], vR[2], vUA[2], vUB[2], vDA[2], vDB[2]; f32x4 mu0[2], mu1[2];
#pragma unroll
            for (int ji = 0; ji < 2; ++ji) { const int j = 2 * jj + ji;
              const int la = (j == 3 && lane >= 48) ? 0 : lane;
              const int cj = j < 3 ? j * 512 + 8 * la : 1536 + 8 * la;
              const half_t* pc = P + C_RWKV + cj; mu0[ji] = *(const f32x4*)(mu + cj); mu1[ji] = *(const f32x4*)(mu + cj + 4);
              sA[ji] = *(const half8*)(pc + (size_t)rA * NP); sB[ji] = *(const half8*)(pc + (size_t)(rA + 1) * NP);
              vL[ji] = rL >= 0 ? *(const half8*)(pc + (size_t)rL * NP) : z8; vR[ji] = rR >= 0 ? *(const half8*)(pc + (size_t)rR * NP) : z8;
              vUA[ji] = rUA >= 0 ? *(const half8*)(pc + (size_t)rUA * NP) : z8; vUB[ji] = rUA >= 0 ? *(const half8*)(pc + (size_t)(rUA + 1) * NP) : z8;
              vDA[ji] = rDA >= 0 ? *(const half8*)(pc + (size_t)rDA * NP) : z8; vDB[ji] = rDA >= 0 ? *(const half8*)(pc + (size_t)(rDA + 1) * NP) : z8; }
            EPI_LOAD_FENCE();
#pragma unroll
            for (int ji = 0; ji < 2; ++ji) { const int j = 2 * jj + ji;
              if (j == 3 && lane >= 48) continue;
#pragma unroll
              for (int t = 0; t < 2; ++t) { const int r = rA + t;
                const half8 self = t ? sB[ji] : sA[ji], n0 = t ? sA[ji] : vL[ji], n1 = t ? vR[ji] : sB[ji], n2 = t ? vUB[ji] : vUA[ji], n3 = t ? vDB[ji] : vDA[ji];
                float val[8];
#pragma unroll
                for (int e = 0; e < 8; ++e) { const float s_ = (float)self[e]; const float nn = (float)((e & 3) == 0 ? n0[e] : (e & 3) == 1 ? n1[e] : (e & 3) == 2 ? n2[e] : n3[e]); val[e] = s_ + (nn - s_) * (e < 4 ? mu0[ji][e & 3] : mu1[ji][e & 3]); }
                half8 h;
                if (j < 3) {
#pragma unroll
                    for (int e = 0; e < 8; ++e) h[e] = (half_t)val[e];
                    *(half8*)(RW + ((size_t)r * 4 + j) * 512 + 8 * lane) = h;
                    if (j == 1) {
#pragma unroll
                        for (int e = 0; e < 8; ++e) kmix[t][e] = val[e]; }
                } else {
                    const int c0 = 8 * lane;
#pragma unroll
                    for (int e = 0; e < 8; ++e) { float v = val[e]; if (c0 < 128) v = ftanh(v); else if (c0 >= 256) v = sigm(v); h[e] = (half_t)v; }
                    *(half8*)(RLI + (size_t)r * 384 + c0) = h;
                } } } }
#pragma unroll
          for (int t = 0; t < 2; ++t) { float tt[8], ss = 0.f;
#pragma unroll
            for (int e = 0; e < 8; ++e) { tt[e] = kmix[t][e] * kkv[e >> 2][e & 3]; ss += tt[e] * tt[e]; }
            ss += SHFL_XOR(ss, 1); ss += SHFL_XOR(ss, 2); ss += SHFL_XOR(ss, 4);
            const float sc = frsq(ss + 1e-6f); half8 h;
#pragma unroll
            for (int e = 0; e < 8; ++e) h[e] = (half_t)(tt[e] * sc);
            *(half8*)(RW + ((size_t)(rA + t) * 4 + 3) * 512 + 8 * lane) = h; } }
    }
}

#ifndef CPU_EMU
__device__ __forceinline__ float shfl_up_f(float v, int off, int lane) { const float o = __int_as_float(__builtin_amdgcn_ds_bpermute(((lane - off) & 63) << 2, __float_as_int(v))); return lane >= off ? o : v; }
#else
static inline float shfl_up_f(float v, int off, int lane) { const float o = emu_shfl(v, (lane - off) & 63); return lane >= off ? o : v; }
#endif
__device__ __forceinline__ void ph_wy(int wb, const Params& p, int RG, LAS unsigned char* lds) {
#ifndef CPU_EMU
    const int tid = tid_fresh(wb), wid = __builtin_amdgcn_readfirstlane(tid >> 6), lane = tid & 63, fr = lane & 15, fq = lane >> 4;
#else
    const int tid = tid_fresh(wb), wid = tid >> 6, lane = tid & 63, fr = lane & 15, fq = lane >> 4;
#endif
    const int slot = wid >> 1, d = wid & 1;
    LAS half_t* Lm = (LAS half_t*)(lds + wid * 16896);
    LAS half_t* Xm = Lm + 4096;
    LAS float* Gv = (LAS float*)(Xm + 4096);
    LAS float* Bv = Gv + 64;
    const half_t* GQKV = (const half_t*)(p.ws + OFF_GQKV); const float* GBG = (const float*)(p.ws + OFF_GBG);
    half_t* GTA = (half_t*)(p.ws + OFF_GTA); float* GG = (float*)(p.ws + OFF_GG);
    const int n_items = (RG / 64) * 4;
    SYNC();
    for (int base = blockIdx.x * 4; base < n_items; base += gridDim.x * 4) {
        const int item = base + slot;
        if (item < n_items) {
            const int cidx = item >> 2, h = item & 3, r0 = cidx * 64;
            const size_t tb = (size_t)((cidx * 4 + h) * 2 + d);
            { const int nat = d ? 63 - lane : lane; const float beta = GBG[(size_t)(r0 + nat) * 16 + d * 4 + h]; float G = GBG[(size_t)(r0 + nat) * 16 + 8 + d * 4 + h];
#pragma unroll
              for (int off = 1; off < 64; off <<= 1) { const float o = shfl_up_f(G, off, lane); G = lane >= off ? G + o : G; }
              Gv[lane] = G; Bv[lane] = beta; GG[tb * 64 + lane] = G; }
            WAVE_SYNC();
            half8 kf[4][4];
#pragma unroll
            for (int t = 0; t < 4; ++t)
#pragma unroll
                for (int ks = 0; ks < 4; ++ks) kf[t][ks] = *(const half8*)(GQKV + (size_t)(r0 + 16 * t + fr) * 1536 + 512 + h * 128 + 32 * ks + 8 * fq);
#pragma unroll
            for (int ti = 0; ti < 4; ++ti)
#pragma unroll
                for (int tj = 0; tj < 4; ++tj) {
                    if (d ? (tj < ti) : (tj > ti)) continue;
                    f32x4 acc = {0.f, 0.f, 0.f, 0.f};
#pragma unroll
                    for (int ks = 0; ks < 4; ++ks) acc = MFMA16(kf[tj][ks], kf[ti][ks], acc);
                    const int i = 16 * ti + fr, ip = d ? 63 - i : i; const float gi = Gv[ip], bi = Bv[ip]; f32x4 val;
#pragma unroll
                    for (int e = 0; e < 4; ++e) { const int j = 16 * tj + 4 * fq + e, jp = d ? 63 - j : j; val[e] = (jp < ip) ? bi * acc[e] * fexp(gi - Gv[jp]) : 0.f; }
                    if (d) *(LAS half4*)(Lm + ip * 64 + 60 - 16 * tj - 4 * fq) = cvt4((f32x4){val[3], val[2], val[1], val[0]});
                    else *(LAS half4*)(Lm + ip * 64 + 16 * tj + 4 * fq) = cvt4(val);
                }
#pragma unroll
            for (int ti = 0; ti < 4; ++ti) {
                half8 qf[4];
#pragma unroll
                for (int ks = 0; ks < 4; ++ks) qf[ks] = *(const half8*)(GQKV + (size_t)(r0 + 16 * ti + fr) * 1536 + h * 128 + 32 * ks + 8 * fq);
#pragma unroll
                for (int tj = 0; tj < 4; ++tj) {
                    const int i = 16 * ti + fr, ip = d ? 63 - i : i; f32x4 val = {0.f, 0.f, 0.f, 0.f};
                    if (!(d ? (tj < ti) : (tj > ti))) {
                        f32x4 acc = {0.f, 0.f, 0.f, 0.f};
#pragma unroll
                        for (int ks = 0; ks < 4; ++ks) acc = MFMA16(kf[tj][ks], qf[ks], acc);
                        const float gi = Gv[ip];
#pragma unroll
                        for (int e = 0; e < 4; ++e) { const int j = 16 * tj + 4 * fq + e, jp = d ? 63 - j : j; val[e] = (jp <= ip) ? acc[e] * fexp(gi - Gv[jp]) : 0.f; }
                    }
                    half_t* ap = GTA + (tb * 2 + 1) * 4096 + ip * 64;
                    if (d) *(half4*)(ap + 60 - 16 * tj - 4 * fq) = cvt4((f32x4){val[3], val[2], val[1], val[0]});
                    else *(half4*)(ap + 16 * tj + 4 * fq) = cvt4(val);
                }
            }
            WAVE_SYNC();
#pragma unroll 1
            for (int bi = 0; bi < 4; ++bi) {
                const LAS half_t* Lb = Lm + bi * 16 * 64; float a[16];
                WAVE_SYNC();
                if (bi > 0) {
#pragma unroll 1
                    for (int ct = 0; ct < bi; ++ct) { f32x4 u4 = {0.f, 0.f, 0.f, 0.f};
#pragma unroll 1
                        for (int ks = 0; ks < (bi + 1) / 2; ++ks) {
                            half8 af = ldfrag(Lm, 16 * bi, 64, 32 * ks, lane), bf = ldfrag(Lm, 16 * ct, 64, 32 * ks, lane);
#pragma unroll
                            for (int e = 0; e < 8; ++e) { const int k = 32 * ks + 8 * fq + e; const bool ka = k < 16 * bi, kb = ka && k >= 16 * ct + fr;
                                af[e] = ka ? af[e] : (half_t)0.f; bf[e] = kb ? bf[e] : (half_t)0.f; }
                            u4 = MFMA16(af, bf, u4); }
#pragma unroll
                        for (int e = 0; e < 4; ++e) Xm[(16 * bi + 4 * fq + e) * 64 + 16 * ct + fr] = (half_t)u4[e]; }
                    WAVE_SYNC();
                }
#pragma unroll
                for (int ii = 0; ii < 16; ++ii) { a[ii] = (bi * 16 + ii == lane) ? 1.f : 0.f; if (lane < 16 * bi) a[ii] -= (float)Xm[(bi * 16 + ii) * 64 + lane]; }
#pragma unroll
                for (int ii = 0; ii < 16; ++ii) { float sacc = a[ii];
#pragma unroll
                    for (int mm = 0; mm < ii; ++mm) sacc -= (float)Lb[ii * 64 + bi * 16 + mm] * a[mm];
                    a[ii] = sacc; }
#pragma unroll
                for (int ii = 0; ii < 16; ++ii) { const half_t xh = (half_t)a[ii]; Xm[(bi * 16 + ii) * 64 + lane] = xh; if (bi * 16 + ii >= lane) Lm[lane * 64 + bi * 16 + ii] = xh; }
            }
            WAVE_SYNC();
#pragma unroll 1
            for (int t = 0; t < 8; ++t) { const int v = lane + 64 * t, i = v >> 3, j8 = (v & 7) * 8; const half8 x = *(const LAS half8*)(Xm + i * 64 + j8); half8 o;
#pragma unroll
                for (int e = 0; e < 8; ++e) o[e] = (half_t)((float)x[e] * Bv[j8 + e]);
                *(half8*)(GTA + (tb * 2 + 0) * 4096 + i * 64 + j8) = o; }
            WAVE_SYNC();
        }
    }
    SYNC();
}

__device__ __forceinline__ void scan_gdn(int wb, const Params& p, int bl, int gs, int h, int d, int mode, LAS unsigned char* lds) {
    const int tid = tid_fresh(wb), wid = tid >> 6, lane = tid & 63, fr = lane & 15, fq = lane >> 4;
    constexpr int L72 = 72, L136 = 136;
    LAS half_t* kT = (LAS half_t*)lds;
    LAS half_t* vT = kT + 128 * L72;
    LAS half_t* VNs = vT + 128 * L72;
    LAS half_t* Tb = VNs + 128 * L72;
    LAS half_t* Tbe = Tb + 64 * L72;
    LAS half_t* Am = Tbe + 64 * L72;
    LAS half_t* Qg = Am + 64 * L72;
    LAS half_t* Wn = Qg + 64 * L136;
    LAS half_t* ST = Wn + 64 * L136;
    LAS float* Es = (LAS float*)(ST + 128 * L136);
    const half_t* GQKV = (const half_t*)(p.ws + OFF_GQKV);
    const half_t* GTA = (const half_t*)(p.ws + OFF_GTA); const float* GG = (const float*)(p.ws + OFF_GG);
    half_t* SOG = (half_t*)(p.ws + OFF_SOG) + (size_t)d * RGP * 512;
    SYNC();
    for (int i = tid; i < 128 * L136 / 8; i += NT) *(LAS half8*)(ST + i * 8) = (half8){0, 0, 0, 0, 0, 0, 0, 0};
    SYNC();
    f32x4 accS[8];
#pragma unroll
    for (int u = 0; u < 8; ++u) accS[u] = (f32x4){0.f, 0.f, 0.f, 0.f};
    constexpr int nchC = CTXL / 64, nchL = SEQ / 64, NCS = nchC + nchL;
    half8 pT, pA, pq[2], pk[2], pv[2]; f32x4 pg0, pg1; float pgi[2], pG = 0.f, pGl = 0.f; int nr0 = 0, cr0 = 0;
    const int ti = tid >> 3, tj8 = (tid & 7) * 8;
    auto issue = [&](int cs) {
        const bool isc = cs < nchC; const int cl = isc ? cs : cs - nchC, nch = isc ? nchC : nchL, cn = d ? nch - 1 - cl : cl;
        const int r0 = (isc ? RL + gs * CTXL : bl * SEQ) + cn * 64; nr0 = r0;
        const size_t tb = (size_t)(((r0 >> 6) * 4 + h) * 2 + d);
        pT = *(const half8*)(GTA + (tb * 2 + 0) * 4096 + ti * 64 + tj8); pA = *(const half8*)(GTA + (tb * 2 + 1) * 4096 + ti * 64 + tj8);
        pg0 = *(const f32x4*)(GG + tb * 64 + tj8); pg1 = *(const f32x4*)(GG + tb * 64 + tj8 + 4);
#pragma unroll
        for (int t = 0; t < 2; ++t) { const int v = tid + NT * t, i = v >> 4, c8 = (v & 15) * 8, nat = d ? 63 - i : i;
            pq[t] = *(const half8*)(GQKV + (size_t)(r0 + nat) * 1536 + h * 128 + c8); pgi[t] = GG[tb * 64 + i]; }
#pragma unroll
        for (int t = 0; t < 2; ++t) { const int g = wid + 8 * t, nat = d ? 63 - lane : lane;
            pk[t] = *(const half8*)(GQKV + (size_t)(r0 + nat) * 1536 + 512 + h * 128 + 8 * g); pv[t] = *(const half8*)(GQKV + (size_t)(r0 + nat) * 1536 + 1024 + h * 128 + 8 * g); }
        pG = GG[tb * 64 + (tid & 63)]; pGl = GG[tb * 64 + 63];
    };
    const int cs0 = mode == 2 ? nchC : 0, cs1 = mode == 1 ? nchC : NCS;
    const int sv = gs >= BG ? gs - BG : 0;
    f32x4* gst = (f32x4*)(p.ws + OFF_GST) + ((size_t)((sv * 4 + h) * 2 + d) * 8 + wid) * 512;
    if (mode == 2) {
#pragma unroll
        for (int u = 0; u < 8; ++u) { accS[u] = gst[u * 64 + lane]; *(LAS half4*)(ST + (16 * wid + fr) * L136 + 16 * u + 4 * fq) = cvt4(accS[u]); }
        WAVE_SYNC();
    }
    issue(cs0);
    for (int cs = cs0; cs < cs1; ++cs) {
        SYNC();
        { half8 te; const float ge[8] = {pg0[0], pg0[1], pg0[2], pg0[3], pg1[0], pg1[1], pg1[2], pg1[3]};
#pragma unroll
          for (int e = 0; e < 8; ++e) te[e] = (half_t)((float)pT[e] * fexp(ge[e]));
          *(LAS half8*)(Tb + ti * L72 + tj8) = pT; *(LAS half8*)(Tbe + ti * L72 + tj8) = te; *(LAS half8*)(Am + ti * L72 + tj8) = pA; }
#pragma unroll
        for (int t = 0; t < 2; ++t) { const int v = tid + NT * t, i = v >> 4, c8 = (v & 15) * 8; const float sc = fexp(pgi[t]); half8 o;
#pragma unroll
            for (int e = 0; e < 8; ++e) o[e] = (half_t)((float)pq[t][e] * sc);
            *(LAS half8*)(Qg + i * L136 + c8) = o; }
#pragma unroll
        for (int t = 0; t < 2; ++t) { const int g = wid + 8 * t;
#pragma unroll
            for (int e = 0; e < 8; ++e) { kT[(8 * g + e) * L72 + lane] = pk[t][e]; vT[(8 * g + e) * L72 + lane] = pv[t][e]; } }
        if (tid < 64) Es[tid] = fexp(pGl - pG);
        const float dec = fexp(pGl);
        cr0 = nr0;
        if (cs + 1 < cs1) issue(cs + 1);
        SYNC();
        { f32x4 acc[4];
#pragma unroll
          for (int t = 0; t < 4; ++t) acc[t] = (f32x4){0.f, 0.f, 0.f, 0.f};
#pragma unroll
          for (int k2 = 0; k2 < 2; ++k2) { const half8 a = ldfrag(kT, 16 * wid, L72, 32 * k2, lane);
#pragma unroll
              for (int t = 0; t < 4; ++t) acc[t] = MFMA16(a, ldfrag(Tbe, 16 * t, L72, 32 * k2, lane), acc[t]); }
#pragma unroll
          for (int t = 0; t < 4; ++t) *(LAS half4*)(Wn + (16 * t + fr) * L136 + 16 * wid + 4 * fq) = cvt4(-acc[t]); }
        SYNC();
        { f32x4 acc[4];
#pragma unroll
          for (int t = 0; t < 4; ++t) acc[t] = (f32x4){0.f, 0.f, 0.f, 0.f};
#pragma unroll
          for (int k2 = 0; k2 < 2; ++k2) { const half8 b = ldfrag(vT, 16 * wid, L72, 32 * k2, lane);
#pragma unroll
              for (int t = 0; t < 4; ++t) acc[t] = MFMA16(ldfrag(Tb, 16 * t, L72, 32 * k2, lane), b, acc[t]); }
#pragma unroll
          for (int k4 = 0; k4 < 4; ++k4) { const half8 b = ldfrag(ST, 16 * wid, L136, 32 * k4, lane);
#pragma unroll
              for (int t = 0; t < 4; ++t) acc[t] = MFMA16(ldfrag(Wn, 16 * t, L136, 32 * k4, lane), b, acc[t]); }
          WAVE_SYNC();
#pragma unroll
          for (int t = 0; t < 4; ++t) { const f32x4 es = *(const LAS f32x4*)(Es + 16 * t + 4 * fq);
              *(LAS half4*)(vT + (16 * wid + fr) * L72 + 16 * t + 4 * fq) = cvt4(acc[t]); *(LAS half4*)(VNs + (16 * wid + fr) * L72 + 16 * t + 4 * fq) = cvt4(acc[t] * es); } }
        WAVE_SYNC();
        { f32x4 acc[4];
#pragma unroll
          for (int t = 0; t < 4; ++t) acc[t] = (f32x4){0.f, 0.f, 0.f, 0.f};
#pragma unroll
          for (int k4 = 0; k4 < 4; ++k4) { const half8 a = ldfrag(ST, 16 * wid, L136, 32 * k4, lane);
#pragma unroll
              for (int t = 0; t < 4; ++t) acc[t] = MFMA16(a, ldfrag(Qg, 16 * t, L136, 32 * k4, lane), acc[t]); }
#pragma unroll
          for (int k2 = 0; k2 < 2; ++k2) { const half8 a = ldfrag(vT, 16 * wid, L72, 32 * k2, lane);
#pragma unroll
              for (int t = 0; t < 4; ++t) acc[t] = MFMA16(a, ldfrag(Am, 16 * t, L72, 32 * k2, lane), acc[t]); }
#pragma unroll
          for (int t = 0; t < 4; ++t) { const int i = 16 * t + fr, nat = d ? 63 - i : i;
              *(half4*)(SOG + (size_t)(cr0 + nat) * 512 + h * 128 + 16 * wid + 4 * fq) = cvt4(acc[t]); } }
#pragma unroll
        for (int u = 0; u < 8; ++u) accS[u] = accS[u] * dec;
#pragma unroll
        for (int k2 = 0; k2 < 2; ++k2) { const half8 b = ldfrag(VNs, 16 * wid, L72, 32 * k2, lane);
#pragma unroll
            for (int u = 0; u < 8; ++u) accS[u] = MFMA16(ldfrag(kT, 16 * u, L72, 32 * k2, lane), b, accS[u]); }
        WAVE_SYNC();
#pragma unroll
        for (int u = 0; u < 8; ++u) *(LAS half4*)(ST + (16 * wid + fr) * L136 + 16 * u + 4 * fq) = cvt4(accS[u]);
        WAVE_SYNC();
    }
    if (mode == 1) {
#pragma unroll
        for (int u = 0; u < 8; ++u) gst[u * 64 + lane] = accS[u];
    }
}

__device__ __forceinline__ void scan_mlstm(int wb, const Params& p, int l, int bl, int gs, int h, int d, int mode, LAS unsigned char* lds) {
    const int tid = tid_fresh(wb), wid = tid >> 6, lane = tid & 63, fr = lane & 15, fq = lane >> 4;
    constexpr int L72 = 72;
    LAS half_t* q = (LAS half_t*)lds;
    LAS half_t* k = q + 64 * L72;
    LAS half_t* kT = k + 64 * L72;
    LAS half_t* vT = kT + 64 * L72;
    LAS half_t* Pm = vT + 128 * L72;
    LAS half_t* CT = Pm + 64 * L72;
    LAS half_t* nvec = CT + 128 * L72 + 64 * wid;
    LAS float* lfv = (LAS float*)(CT + 128 * L72 + 64 * 8);
    LAS float* igv = lfv + 64;
    LAS float* rowv = igv + 64;
    LAS float* colv = rowv + 64;
    LAS float* interv = colv + 64;
    LAS float* emtv = interv + 64;
    LAS float* wscv = emtv + 64;
    const half_t* P = (const half_t*)(p.ws + OFF_P);
    half_t* SOM = (half_t*)(p.ws + OFF_SOM) + (size_t)d * RGP * 512;
    const float ibias = p.in[I_MIB][l * 8 + d * 4 + h], fbias = p.in[I_MFB][l * 8 + d * 4 + h];
    SYNC();
    for (int i = tid; i < 128 * L72 / 8; i += NT) *(LAS half8*)(CT + i * 8) = (half8){0, 0, 0, 0, 0, 0, 0, 0};
    nvec[lane] = (half_t)0.f;
    f32x4 accC[4], accN[4];
#pragma unroll
    for (int u = 0; u < 4; ++u) { accC[u] = (f32x4){0.f, 0.f, 0.f, 0.f}; accN[u] = (f32x4){0.f, 0.f, 0.f, 0.f}; }
    float m = 0.f;
    constexpr int nchC = CTXL / 64, nchL = SEQ / 64, NCS = nchC + nchL;
    half8 pq, pk, pv[2]; half_t pig = (half_t)0.f, pfg = (half_t)0.f; int nr0 = 0, cr0 = 0;
    const half8 ones = {1, 1, 1, 1, 1, 1, 1, 1};
    auto issue = [&](int cs) {
        const bool isc = cs < nchC; const int cl = isc ? cs : cs - nchC, nch = isc ? nchC : nchL, cn = d ? nch - 1 - cl : cl;
        const int r0 = (isc ? RL + gs * CTXL : bl * SEQ) + cn * 64; nr0 = r0;
        const int nat = d ? 63 - lane : lane; const half_t* pr = P + (size_t)(r0 + nat) * NP + C_ML;
        pq = *(const half8*)(pr + h * 64 + 8 * wid); pk = *(const half8*)(pr + 256 + h * 64 + 8 * wid);
        pv[0] = *(const half8*)(pr + 512 + h * 128 + 8 * wid); pv[1] = *(const half8*)(pr + 512 + h * 128 + 8 * (wid + 8));
        if (tid < 64) { const half_t* pg = P + (size_t)(r0 + (d ? 63 - tid : tid)) * NP; pig = pg[C_MLIG + d * 4 + h]; pfg = pg[C_MLFG + d * 4 + h]; }
    };
    const int cs0 = mode == 2 ? nchC : 0, cs1 = mode == 1 ? nchC : NCS;
    const int sv = gs >= BG ? gs - BG : 0;
    f32x4* mst = (f32x4*)(p.ws + OFF_MST) + ((size_t)((sv * 4 + h) * 2 + d) * 8 + wid) * 512; float* msm = (float*)(p.ws + OFF_MSM) + ((sv * 4 + h) * 2 + d);
    SYNC();
    if (mode == 2) {
#pragma unroll
        for (int u = 0; u < 4; ++u) { accC[u] = mst[u * 64 + lane]; accN[u] = mst[(4 + u) * 64 + lane];
            *(LAS half4*)(CT + (16 * wid + fr) * L72 + 16 * u + 4 * fq) = cvt4(accC[u]); if (fr == 0) *(LAS half4*)(nvec + 16 * u + 4 * fq) = cvt4(accN[u]); }
        m = *msm;
        WAVE_SYNC();
    }
    issue(cs0);
    for (int cs = cs0; cs < cs1; ++cs) {
        SYNC();
        { half8 qs;
#pragma unroll
          for (int e = 0; e < 8; ++e) qs[e] = (half_t)((float)pq[e] * 0.125f);
          *(LAS half8*)(q + lane * L72 + 8 * wid) = qs; *(LAS half8*)(k + lane * L72 + 8 * wid) = pk;
#pragma unroll
          for (int e = 0; e < 8; ++e) { kT[(8 * wid + e) * L72 + lane] = pk[e]; vT[(8 * wid + e) * L72 + lane] = pv[0][e]; vT[(8 * (wid + 8) + e) * L72 + lane] = pv[1][e]; } }
        if (tid < 64) { igv[tid] = (float)pig + ibias; lfv[tid] = -softplusf(-((float)pfg + fbias)); }
        cr0 = nr0;
        if (cs + 1 < cs1) issue(cs + 1);
        SYNC();
        float dec;
        { float b = lfv[lane];
#pragma unroll
          for (int off = 1; off < 64; off <<= 1) { const float o = shfl_up_f(b, off, lane); b = lane >= off ? b + o : b; }
          const float cm = igv[lane] - b; float pm = cm;
#pragma unroll
          for (int off = 1; off < 64; off <<= 1) { const float o = shfl_up_f(pm, off, lane); pm = lane >= off ? fmaxf(pm, o) : pm; }
#ifndef CPU_EMU
          const float b_last = __int_as_float(__builtin_amdgcn_readlane(__float_as_int(b), 63)), pm_last = __int_as_float(__builtin_amdgcn_readlane(__float_as_int(pm), 63));
#else
          const float b_last = emu_shfl(b, 63), pm_last = emu_shfl(pm, 63);
#endif
          const float mt = fmaxf(b + m, b + pm), m_new = fmaxf(b_last + m, b_last + pm_last);
          rowv[lane] = b - mt; colv[lane] = cm; interv[lane] = fexp(b + m - mt); emtv[lane] = fexp(-mt); wscv[lane] = fexp(b_last + cm - m_new);
          dec = fexp(b_last + m - m_new); m = m_new; }
        WAVE_SYNC();
#pragma unroll
        for (int tt = 0; tt < 2; ++tt) { const int idx = 2 * wid + tt, ti = idx >> 2, tj = idx & 3;
            f32x4 acc = {0.f, 0.f, 0.f, 0.f};
            if (tj <= ti) {
#pragma unroll
                for (int k2 = 0; k2 < 2; ++k2) acc = MFMA16(ldfrag(k, 16 * tj, L72, 32 * k2, lane), ldfrag(q, 16 * ti, L72, 32 * k2, lane), acc);
                const int i = 16 * ti + fr; const float rv = rowv[i]; const f32x4 cv = *(const LAS f32x4*)(colv + 16 * tj + 4 * fq);
#pragma unroll
                for (int e = 0; e < 4; ++e) { const int j = 16 * tj + 4 * fq + e; acc[e] = (j <= i) ? acc[e] * fexp(rv + cv[e]) : 0.f; }
            }
            *(LAS half4*)(Pm + (16 * ti + fr) * L72 + 16 * tj + 4 * fq) = cvt4(acc); }
        SYNC();
        { f32x4 a1[4], a2[4], d1[4], d2[4];
#pragma unroll
          for (int t = 0; t < 4; ++t) { a1[t] = (f32x4){0.f, 0.f, 0.f, 0.f}; a2[t] = a1[t]; d1[t] = a1[t]; d2[t] = a1[t]; }
#pragma unroll
          for (int k2 = 0; k2 < 2; ++k2) { const half8 ac = ldfrag(CT, 16 * wid, L72, 32 * k2, lane), av = ldfrag(vT, 16 * wid, L72, 32 * k2, lane);
              const half8 an = *(const LAS half8*)(nvec + 32 * k2 + 8 * fq);
#pragma unroll
              for (int t = 0; t < 4; ++t) { const half8 bq = ldfrag(q, 16 * t, L72, 32 * k2, lane), bp = ldfrag(Pm, 16 * t, L72, 32 * k2, lane);
                  a1[t] = MFMA16(ac, bq, a1[t]); a2[t] = MFMA16(av, bp, a2[t]); d1[t] = MFMA16(an, bq, d1[t]); d2[t] = MFMA16(ones, bp, d2[t]); } }
#pragma unroll
          for (int t = 0; t < 4; ++t) { const int i = 16 * t + fr, nat = d ? 63 - i : i; const float it = interv[i];
              const float den = it * d1[t][0] + d2[t][0], dn = frcp(fmaxf(fabsf(den), emtv[i]));
              *(half4*)(SOM + (size_t)(cr0 + nat) * 512 + h * 128 + 16 * wid + 4 * fq) = cvt4((a1[t] * it + a2[t]) * dn); } }
#pragma unroll
        for (int u = 0; u < 4; ++u) { accC[u] = accC[u] * dec; accN[u] = accN[u] * dec; }
#pragma unroll
        for (int k2 = 0; k2 < 2; ++k2) { const half8 bv = ldfrag(vT, 16 * wid, L72, 32 * k2, lane);
            const f32x4 w0 = *(const LAS f32x4*)(wscv + 32 * k2 + 8 * fq), w1 = *(const LAS f32x4*)(wscv + 32 * k2 + 8 * fq + 4);
#pragma unroll
            for (int u = 0; u < 4; ++u) { const half8 raw = ldfrag(kT, 16 * u, L72, 32 * k2, lane); half8 ak;
#pragma unroll
                for (int e = 0; e < 4; ++e) { ak[e] = (half_t)((float)raw[e] * w0[e]); ak[4 + e] = (half_t)((float)raw[4 + e] * w1[e]); }
                accC[u] = MFMA16(ak, bv, accC[u]); accN[u] = MFMA16(ak, ones, accN[u]); } }
        WAVE_SYNC();
#pragma unroll
        for (int u = 0; u < 4; ++u) { *(LAS half4*)(CT + (16 * wid + fr) * L72 + 16 * u + 4 * fq) = cvt4(accC[u]);
            if (fr == 0) *(LAS half4*)(nvec + 16 * u + 4 * fq) = cvt4(accN[u]); }
        WAVE_SYNC();
    }
    if (mode == 1) {
#pragma unroll
        for (int u = 0; u < 4; ++u) { mst[u * 64 + lane] = accC[u]; mst[(4 + u) * 64 + lane] = accN[u]; }
        if (tid == 0) *msm = m;
    }
}

#ifndef CPU_EMU
template <int CTRL> __device__ __forceinline__ float dpp_f(float v) { return __int_as_float(__builtin_amdgcn_update_dpp(0, __float_as_int(v), CTRL, 0xf, 0xf, true)); }
#define DPPX1(v) dpp_f<0xB1>(v)
#define DPPX2(v) dpp_f<0x4E>(v)
#define DPPHM(v) dpp_f<0x141>(v)
#define RED8(v) do { v += dpp_f<0xB1>(v); v += dpp_f<0x4E>(v); v += dpp_f<0x141>(v); } while (0)
#define RED16(v) do { RED8(v); v += dpp_f<0x140>(v); } while (0)
#else
#define DPPX1(v) emu_shfl_xor((v), 1)
#define DPPX2(v) emu_shfl_xor((v), 2)
#define DPPHM(v) emu_shfl_xor((v), 7)
#define RED8(v) do { v += emu_shfl_xor(v, 1); v += emu_shfl_xor(v, 2); v += emu_shfl_xor(v, 7); } while (0)
#define RED16(v) do { RED8(v); v += emu_shfl_xor(v, 15); } while (0)
#endif
#ifndef CPU_EMU
#define RWKV_SYNC() asm volatile("s_waitcnt lgkmcnt(0)\n\ts_barrier" ::: "memory")
#else
#define RWKV_SYNC() SYNC()
#endif
__device__ __forceinline__ void scan_rwkv(int wb, const Params& p, int l, int bl, int gs, int h, int d, int row0, int ncw, int mode, LAS unsigned char* lds) {
#ifndef CPU_EMU
    const int tid = tid_fresh(wb), wid = __builtin_amdgcn_readfirstlane(tid >> 6), lane = tid & 63;
#else
    const int tid = tid_fresh(wb), wid = tid >> 6, lane = tid & 63;
#endif
    constexpr int NB = 32, NPR = NB / 2, REC = 712;
    LAS float* st = (LAS float*)lds;
    const half_t* RW = (const half_t*)(p.ws + OFF_RW); const half_t* RLO = (const half_t*)(p.ws + OFF_RLO);
    bf16_t* SOR = (bf16_t*)(p.ws + OFF_SOR) + (size_t)d * RGP * 512;
    const int nb0 = mode == 2 ? CTXL / NB : 0, nb1 = mode == 1 ? CTXL / NB : (CTXL + SEQ) / NB;
    auto step_row = [&](int sidx) -> size_t { return sidx < CTXL ? (size_t)(RL + gs * CTXL + (d ? CTXL - 1 - sidx : sidx)) : (size_t)(bl * SEQ + (d ? SEQ - 1 - (sidx - CTXL) : sidx - CTXL)); };
    RWKV_SYNC();
    if (wid >= 4) {
        const int pt = tid - 256, lp = pt >> 4, cq = pt & 15, lc = h * 64 + 4 * cq;
        const f32x4 ka = *(const f32x4*)(p.in[I_RKA] + (size_t)l * 512 + lc);
        half4 g_r[2], g_k[2], g_v[2], g_kk[2], g_e[2], g_a[2];
        auto issue = [&](int n) {
#pragma unroll
            for (int q = 0; q < 2; ++q) { const size_t row = step_row(n * NB + 2 * lp + q);
                g_r[q] = *(const half4*)(RW + (row * 4 + 0) * 512 + lc); g_k[q] = *(const half4*)(RW + (row * 4 + 1) * 512 + lc); g_v[q] = *(const half4*)(RW + (row * 4 + 2) * 512 + lc); g_kk[q] = *(const half4*)(RW + (row * 4 + 3) * 512 + lc);
                g_e[q] = *(const half4*)(RLO + row * 2560 + d * 512 + lc); g_a[q] = *(const half4*)(RLO + row * 2560 + 1024 + d * 512 + lc); } };
        auto stage = [&](int buf) { LAS float* o = st + (buf * NPR + lp) * REC + 4 * cq;
            f32x4 oa, owa, owr, owwr, oww, obw, okw, obu, oku, ovt, ovu; float c[8];
#pragma unroll
            for (int i = 0; i < 8; ++i) c[i] = 0.f;
#pragma unroll
            for (int e = 0; e < 4; ++e) {
                const float rt = (float)g_r[0][e], kt = (float)g_k[0][e], kkt = (float)g_kk[0][e], at = (float)g_a[0][e], wt = fexp(-(float)g_e[0][e]);
                const float ru = (float)g_r[1][e], ku = (float)g_k[1][e], kku = (float)g_kk[1][e], au = (float)g_a[1][e], wu = fexp(-(float)g_e[1][e]);
                const float kdt = kt * (1.f + (at - 1.f) * ka[e]), bt = kkt * at, kdu = ku * (1.f + (au - 1.f) * ka[e]), bu = kku * au, amu = -kku;
                const float bw = bt * wu, kw = kdt * wu;
                oa[e] = -kkt; owa[e] = wt * amu; owr[e] = wt * rt; owwr[e] = wt * wu * ru; oww[e] = wt * wu; obw[e] = bw; okw[e] = kw; obu[e] = bu; oku[e] = kdu; ovt[e] = (float)g_v[0][e]; ovu[e] = (float)g_v[1][e];
                c[0] += bt * amu; c[1] += kdt * amu; c[2] += bt * rt; c[3] += kdt * rt; c[4] += bw * ru; c[5] += kw * ru; c[6] += bu * ru; c[7] += kdu * ru; }
            *(LAS f32x4*)(o) = oa; *(LAS f32x4*)(o + 64) = owa; *(LAS f32x4*)(o + 128) = owr; *(LAS f32x4*)(o + 192) = owwr; *(LAS f32x4*)(o + 256) = oww; *(LAS f32x4*)(o + 320) = obw;
            *(LAS f32x4*)(o + 384) = okw; *(LAS f32x4*)(o + 448) = obu; *(LAS f32x4*)(o + 512) = oku; *(LAS f32x4*)(o + 576) = ovt; *(LAS f32x4*)(o + 640) = ovu;
#pragma unroll
            for (int i = 0; i < 8; ++i) RED16(c[i]);
            if (cq == 0) { LAS float* sc = st + (buf * NPR + lp) * REC + 704;
                *(LAS f32x4*)(sc) = (f32x4){c[0], c[1], c[2] * 0.125f, c[3] * 0.125f}; *(LAS f32x4*)(sc + 4) = (f32x4){c[4] * 0.125f, c[5] * 0.125f, c[6] * 0.125f, c[7] * 0.125f}; } };
        issue(nb0); stage(nb0 & 1);
        if (nb0 + 1 < nb1) issue(nb0 + 1);
        RWKV_SYNC();
        for (int n = nb0; n < nb1; ++n) {
            if (n + 1 < nb1) { stage((n + 1) & 1); if (n + 2 < nb1) issue(n + 2); }
            RWKV_SYNC();
        }
    } else if (wid >= ncw) {
        RWKV_SYNC();
        for (int n = nb0; n < nb1; ++n) RWKV_SYNC();
    } else {
        const int rr = row0 + 8 * wid + (lane >> 3), ks = lane & 7;
        f32x2 s2[4];
#pragma unroll
        for (int e = 0; e < 4; ++e) s2[e] = (f32x2){0.f, 0.f};
        const int sv = gs >= BG ? gs - BG : 0;
        f32x2* rst = (f32x2*)((float*)(p.ws + OFF_RST) + ((size_t)((sv * 8 + h) * 2 + d) * 64 + rr) * 64 + 8 * ks);
        if (mode == 2) {
#pragma unroll
            for (int e = 0; e < 4; ++e) s2[e] = rst[e]; }
        RWKV_SYNC();
#define LO2(v) __builtin_shufflevector(v, v, 0, 1)
#define HI2(v) __builtin_shufflevector(v, v, 2, 3)
        for (int n = nb0; n < nb1; ++n) {
            const int buf = n & 1;
            f32x4 xa0, xa1, xwa0, xwa1, xwr0, xwr1, xwq0, xwq1, ya0, ya1, ywa0, ywa1, ywr0, ywr1, ywq0, ywq1;
#define RWKV_LOADD(A0, A1, WA0, WA1, WR0, WR1, WQ0, WQ1, P_) do { const LAS float* o_ = st + (buf * NPR + (P_)) * REC + 8 * ks; \
                A0 = *(const LAS f32x4*)(o_); A1 = *(const LAS f32x4*)(o_ + 4); WA0 = *(const LAS f32x4*)(o_ + 64); WA1 = *(const LAS f32x4*)(o_ + 68); \
                WR0 = *(const LAS f32x4*)(o_ + 128); WR1 = *(const LAS f32x4*)(o_ + 132); WQ0 = *(const LAS f32x4*)(o_ + 192); WQ1 = *(const LAS f32x4*)(o_ + 196); } while (0)
#define RWKV_PAIR(A0, A1, WA0, WA1, WR0, WR1, WQ0, WQ1, PI, J) do { \
                const LAS float* o = st + (buf * NPR + (PI)) * REC; \
                const f32x4 ww0 = *(const LAS f32x4*)(o + 256 + 8 * ks), ww1 = *(const LAS f32x4*)(o + 260 + 8 * ks), bw0 = *(const LAS f32x4*)(o + 320 + 8 * ks), bw1 = *(const LAS f32x4*)(o + 324 + 8 * ks); \
                const f32x4 kw0 = *(const LAS f32x4*)(o + 384 + 8 * ks), kw1 = *(const LAS f32x4*)(o + 388 + 8 * ks), bu0 = *(const LAS f32x4*)(o + 448 + 8 * ks), bu1 = *(const LAS f32x4*)(o + 452 + 8 * ks); \
                const f32x4 ku0 = *(const LAS f32x4*)(o + 512 + 8 * ks), ku1 = *(const LAS f32x4*)(o + 516 + 8 * ks); \
                const float vt = o[576 + rr], vu = o[640 + rr]; const f32x4 sc0 = *(const LAS f32x4*)(o + 704), sc1 = *(const LAS f32x4*)(o + 708); \
                const f32x2 e1 = (s2[0] * LO2(A0) + s2[1] * HI2(A0)) + (s2[2] * LO2(A1) + s2[3] * HI2(A1)); \
                const f32x2 e2 = (s2[0] * LO2(WA0) + s2[1] * HI2(WA0)) + (s2[2] * LO2(WA1) + s2[3] * HI2(WA1)); \
                const f32x2 e3 = (s2[0] * LO2(WR0) + s2[1] * HI2(WR0)) + (s2[2] * LO2(WR1) + s2[3] * HI2(WR1)); \
                const f32x2 e4 = (s2[0] * LO2(WQ0) + s2[1] * HI2(WQ0)) + (s2[2] * LO2(WQ1) + s2[3] * HI2(WQ1)); \
                float sat = e1[0] + e1[1], d2 = e2[0] + e2[1]; \
                RED8(sat); RED8(d2); \
                const f32x2 vtv = {vt, vt}, vuv = {vu, vu}; \
                const f32x2 pre0 = (s2[0] * LO2(ww0) + vtv * LO2(kw0)) + vuv * LO2(ku0), pre1 = (s2[1] * HI2(ww0) + vtv * HI2(kw0)) + vuv * HI2(ku0); \
                const f32x2 pre2 = (s2[2] * LO2(ww1) + vtv * LO2(kw1)) + vuv * LO2(ku1), pre3 = (s2[3] * HI2(ww1) + vtv * HI2(kw1)) + vuv * HI2(ku1); \
                const float ypt = (e3[0] + e3[1]) + vt * sc0[3], ypu = (e4[0] + e4[1]) + (vt * sc1[1] + vu * sc1[3]); \
                const float sau = (d2 + vt * sc0[1]) + sat * sc0[0]; \
                const f32x2 satv = {sat, sat}, sauv = {sau, sau}; \
                s2[0] = (satv * LO2(bw0) + pre0) + sauv * LO2(bu0); s2[1] = (satv * HI2(bw0) + pre1) + sauv * HI2(bu0); \
                s2[2] = (satv * LO2(bw1) + pre2) + sauv * LO2(bu1); s2[3] = (satv * HI2(bw1) + pre3) + sauv * HI2(bu1); \
                yp[2 * (J)] = ypt + sat * sc0[2]; yp[2 * (J) + 1] = (ypu + sat * sc1[0]) + sau * sc1[2]; } while (0)
#ifndef CPU_EMU
#define RWKV_FENCE() asm volatile("" ::: "memory")
#else
#define RWKV_FENCE()
#endif
            RWKV_LOADD(xa0, xa1, xwa0, xwa1, xwr0, xwr1, xwq0, xwq1, 0);
#pragma unroll 1
            for (int th = 0; th < NPR / 2; ++th) {
                float yp[4];
                RWKV_LOADD(ya0, ya1, ywa0, ywa1, ywr0, ywr1, ywq0, ywq1, 2 * th + 1);
                RWKV_PAIR(xa0, xa1, xwa0, xwa1, xwr0, xwr1, xwq0, xwq1, 2 * th, 0);
                RWKV_FENCE();
                { const int pn = 2 * th + 2 < NPR ? 2 * th + 2 : NPR - 1;
                  RWKV_LOADD(xa0, xa1, xwa0, xwa1, xwr0, xwr1, xwq0, xwq1, pn); }
                RWKV_PAIR(ya0, ya1, ywa0, ywa1, ywr0, ywr1, ywq0, ywq1, 2 * th + 1, 1);
                RWKV_FENCE();
                { const bool c0 = ((ks ^ (ks >> 2)) & 1) != 0, c1 = (((ks >> 1) ^ (ks >> 2)) & 1) != 0;
                  const float k20 = (c0 ? yp[1] : yp[0]) + DPPX1(c0 ? yp[0] : yp[1]), k21 = (c0 ? yp[3] : yp[2]) + DPPX1(c0 ? yp[2] : yp[3]);
                  float k1 = (c1 ? k21 : k20) + DPPX2(c1 ? k20 : k21);
                  k1 += DPPHM(k1);
                  if (ks < 4) SOR[step_row(n * NB + th * 4 + ks) * 512 + h * 64 + rr] = f2bf(k1); }
            }
#undef RWKV_PAIR
#undef RWKV_FENCE
#undef RWKV_LOADD
            RWKV_SYNC();
        }
#undef LO2
#undef HI2
        if (mode == 1) {
#pragma unroll
            for (int e = 0; e < 4; ++e) rst[e] = s2[e]; }
    }
}

__device__ __forceinline__ void ph_scan(int wb, const Params& p, int l, int g, LAS unsigned char* lds) {
    constexpr int NL_R = BG * 32, NL_G = BG * 8, NL_M = BG * 8, NLONG = NL_R + NL_G + NL_M;
    const int G = gridDim.x, c = blockIdx.x;
    const int nsm = g == 0 ? BATCH - BG : 0, NS_R = nsm * 32, NS_G = nsm * 8, NS_M = nsm * 8;
    const int nfree = G - NLONG, sstr = nfree > 0 ? nfree : G, sst = nfree > 0 ? c - NLONG : c;
    const bool has_short = nfree > 0 ? c >= NLONG : true;
    const int lmode = g == 0 ? 0 : 2;
    auto first = [](int lo, int st, int stride) { return lo + (((st - lo) % stride) + stride) % stride; };
#pragma unroll 1
    for (int q = 0; q < 2; ++q) {
        const int lo = 0, n = q ? (has_short ? NS_R : 0) : NL_R, st = q ? sst : c, str = q ? sstr : G;
        if (!(SKIP_MASK & 65536)) for (int it = first(lo, st, str); it < n; it += str) REPS(65536) {
            const int half = it & 1, d = (it >> 1) & 1, h = (it >> 2) & 7, b = it >> 5;
            scan_rwkv(wb, p, l, q ? 0 : b, q ? BG + b : g * BG + b, h, d, 32 * half, 4, q ? 1 : lmode, lds); SYNC(); }
    }
#pragma unroll 1
    for (int q = 0; q < 2; ++q) {
        const int lo = q ? NS_R : NL_R, n = q ? (has_short ? NS_R + NS_G : 0) : NL_R + NL_G, st = q ? sst : c, str = q ? sstr : G;
        if (!(SKIP_MASK & 131072)) for (int it = first(lo, st, str); it < n; it += str) REPS(131072) {
            const int i2 = it - lo, d = i2 & 1, h = (i2 >> 1) & 3, b = i2 >> 3;
            scan_gdn(wb, p, q ? 0 : b, q ? BG + b : g * BG + b, h, d, q ? 1 : lmode, lds); SYNC(); }
    }
#pragma unroll 1
    for (int q = 0; q < 2; ++q) {
        const int lo = q ? NS_R + NS_G : NL_R + NL_G, n = q ? (has_short ? NS_R + NS_G + NS_M : 0) : NLONG, st = q ? sst : c, str = q ? sstr : G;
        if (!(SKIP_MASK & 262144)) for (int it = first(lo, st, str); it < n; it += str) REPS(262144) {
            const int i2 = it - lo, d = i2 & 1, h = (i2 >> 1) & 3, b = i2 >> 3;
            scan_mlstm(wb, p, l, q ? 0 : b, q ? BG + b : g * BG + b, h, d, q ? 1 : lmode, lds); SYNC(); }
    }
    if (g == 0 && !(SKIP_MASK & 2)) ph_convert(wb, p, l, 1, nfree > 0 ? c - NLONG : c, nfree > 0 ? nfree : G, lds);
    if (g == NGROUP - 1 && l + 1 < DEPTH && !(SKIP_MASK & 2)) ph_convert(wb, p, l + 1, 0, nfree > 0 ? c - NLONG : c, nfree > 0 ? nfree : G, lds);
}

__device__ __forceinline__ void ph_finish(int wb, const Params& p, int l, int nrows) {
    const int tid = tid_fresh(wb), wid = tid >> 6, lane = tid & 63, c = 8 * lane;
    const half_t* P = (const half_t*)(p.ws + OFF_P); const half_t* RW = (const half_t*)(p.ws + OFF_RW); const half_t* RLO = (const half_t*)(p.ws + OFF_RLO);
    const half_t* SOG = (const half_t*)(p.ws + OFF_SOG); const half_t* SOM = (const half_t*)(p.ws + OFF_SOM); const bf16_t* SOR = (const bf16_t*)(p.ws + OFF_SOR);
    half_t* BR = (half_t*)(p.ws + OFF_BR);
    float c_gn[8], c_mn[8], c_ka[8], c_rk[8], c_lg[8], c_lb[8];
#pragma unroll
    for (int e = 0; e < 8; ++e) { c_gn[e] = p.in[I_GNG][l * 128 + (c & 127) + e]; c_mn[e] = p.in[I_MNG][l * 128 + (c & 127) + e]; c_ka[e] = p.in[I_RKA][(size_t)l * 512 + c + e];
        c_rk[e] = p.in[I_RRK][(size_t)l * 512 + c + e]; c_lg[e] = p.in[I_RLNG][(size_t)l * 512 + c + e]; c_lb[e] = p.in[I_RLNB][(size_t)l * 512 + c + e]; }
    for (int r = blockIdx.x * 8 + wid; r < nrows; r += gridDim.x * 8) {
        { const half8 o0 = *(const half8*)(SOG + (size_t)r * 512 + c), o1 = *(const half8*)(SOG + ((size_t)RGP + r) * 512 + c), z = *(const half8*)(P + (size_t)r * NP + C_Z + c);
          float o[8], ss = 0.f;
#pragma unroll
          for (int e = 0; e < 8; ++e) { o[e] = (float)o0[e] + (float)o1[e]; ss += o[e] * o[e]; }
          ss += SHFL_XOR(ss, 1); ss += SHFL_XOR(ss, 2); ss += SHFL_XOR(ss, 4); ss += SHFL_XOR(ss, 8);
          const float rinv = frsq(ss * (1.f / 128.f) + 1e-6f); half8 out;
#pragma unroll
          for (int e = 0; e < 8; ++e) out[e] = (half_t)(o[e] * rinv * c_gn[e] * siluf((float)z[e]));
          *(half8*)(BR + (size_t)r * 512 + c) = out; }
        { float y[8], sm = 0.f;
          { typedef unsigned short us8 __attribute__((ext_vector_type(8)));
            const us8 s0 = *(const us8*)(SOR + (size_t)r * 512 + c), s1 = *(const us8*)(SOR + ((size_t)RGP + r) * 512 + c);
#pragma unroll
            for (int e = 0; e < 8; ++e) y[e] = bf2f(s0[e]) + bf2f(s1[e]); }
#pragma unroll
          for (int e = 0; e < 8; ++e) sm += y[e];
          sm += SHFL_XOR(sm, 1); sm += SHFL_XOR(sm, 2); sm += SHFL_XOR(sm, 4); const float mean = sm * (1.f / 64.f);
          float vs = 0.f;
#pragma unroll
          for (int e = 0; e < 8; ++e) { const float dlt = y[e] - mean; vs += dlt * dlt; }
          vs += SHFL_XOR(vs, 1); vs += SHFL_XOR(vs, 2); vs += SHFL_XOR(vs, 4); const float rinv = frsq(vs * (1.f / 64.f) + 64e-5f);
          const half8 rv = *(const half8*)(RW + ((size_t)r * 4 + 0) * 512 + c), kv = *(const half8*)(RW + ((size_t)r * 4 + 1) * 512 + c), vv = *(const half8*)(RW + ((size_t)r * 4 + 2) * 512 + c);
          const half8 a0 = *(const half8*)(RLO + (size_t)r * 2560 + 1024 + c), a1 = *(const half8*)(RLO + (size_t)r * 2560 + 1536 + c), gg = *(const half8*)(RLO + (size_t)r * 2560 + 2048 + c);
          float bc = 0.f;
#pragma unroll
          for (int e = 0; e < 8; ++e) bc += (float)rv[e] * (float)kv[e] * (2.f + ((float)a0[e] + (float)a1[e] - 2.f) * c_ka[e]) * c_rk[e];
          bc += SHFL_XOR(bc, 1); bc += SHFL_XOR(bc, 2); bc += SHFL_XOR(bc, 4);
          half8 out;
#pragma unroll
          for (int e = 0; e < 8; ++e) out[e] = (half_t)(((y[e] - mean) * rinv * c_lg[e] + c_lb[e] + bc * (float)vv[e]) * (float)gg[e]);
          *(half8*)(BR + ((size_t)RGP + r) * 512 + c) = out; }
        { const half8 h0 = *(const half8*)(SOM + (size_t)r * 512 + c), h1 = *(const half8*)(SOM + ((size_t)RGP + r) * 512 + c), og = *(const half8*)(P + (size_t)r * NP + C_MLO + c);
          float o[8], ss = 0.f;
#pragma unroll
          for (int e = 0; e < 8; ++e) { o[e] = (float)h0[e] + (float)h1[e]; ss += o[e] * o[e]; }
          ss += SHFL_XOR(ss, 1); ss += SHFL_XOR(ss, 2); ss += SHFL_XOR(ss, 4); ss += SHFL_XOR(ss, 8);
          const float rinv = frsq(ss * (1.f / 128.f) + 1e-6f); half8 out;
#pragma unroll
          for (int e = 0; e < 8; ++e) out[e] = (half_t)(o[e] * rinv * c_mn[e] * (float)og[e]);
          *(half8*)(BR + ((size_t)2 * RGP + r) * 512 + c) = out; }
    }
}

__device__ __forceinline__ void ph_norm2(int wb, const Params& p, int l, int g, int nrows, LAS unsigned char* lds) {
    const int tid = tid_fresh(wb), wid = tid >> 6, lane = tid & 63;
    LAS float* rw = (LAS float*)lds;
    for (int i = tid; i < 1024 * 16; i += NT) rw[(i & 15) * 1024 + (i >> 4)] = p.in[I_ROUT][(size_t)l * 1024 * 16 + i];
    SYNC();
    half_t* H = (half_t*)(p.ws + OFF_H); float* PROB = (float*)(p.ws + OFF_PROB);
    constexpr int RU = 2;
    const int rstep = gridDim.x * 8; const float* gn = p.in[I_N2G] + l * D;
    f32x4 gv[4];
#pragma unroll
    for (int j = 0; j < 4; ++j) gv[j] = *(const f32x4*)(gn + lane * 4 + 256 * j);
    for (int r0 = blockIdx.x * 8 + wid; r0 < nrows; r0 += rstep * RU) {
        f32x4 v[RU][4], sh[RU][4], sc[RU][4]; half4 dxv[RU][4]; float ss[RU];
#pragma unroll
        for (int u = 0; u < RU; ++u) { const int r = r0 + u * rstep < nrows ? r0 + u * rstep : r0;
            const half_t* xr = res_h(p, g, r); const float* md = mod_row(p, l, g, r); const half_t* dxr = (const half_t*)(p.ws + OFF_DX) + (size_t)r * D;
#pragma unroll
            for (int j = 0; j < 4; ++j) { const int c = lane * 4 + 256 * j; v[u][j] = h4f(*(const half4*)(xr + c)); dxv[u][j] = *(const half4*)(dxr + c); sh[u][j] = *(const f32x4*)(md + 3 * 1024 + c); sc[u][j] = *(const f32x4*)(md + 4 * 1024 + c); } }
        EPI_LOAD_FENCE();
#pragma unroll
        for (int u = 0; u < RU; ++u)
#pragma unroll
            for (int j = 0; j < 4; ++j)
#pragma unroll
                for (int e = 0; e < 4; ++e) v[u][j][e] += (float)dxv[u][j][e];
#pragma unroll
        for (int u = 0; u < RU; ++u) { float a = 0.f;
#pragma unroll
            for (int j = 0; j < 4; ++j) a += v[u][j][0] * v[u][j][0] + v[u][j][1] * v[u][j][1] + v[u][j][2] * v[u][j][2] + v[u][j][3] * v[u][j][3];
            ss[u] = wave_sum(a); }
#pragma unroll
        for (int u = 0; u < RU; ++u) { const int r = r0 + u * rstep; if (r >= nrows) continue;
            const float rinv = frsq(ss[u] * (1.f / D) + 1e-6f);
            float lg[16];
#pragma unroll
            for (int e = 0; e < 16; ++e) lg[e] = 0.f;
#pragma unroll
            for (int j = 0; j < 4; ++j) { const int c = lane * 4 + 256 * j;
                const f32x4 hv = v[u][j] * rinv * gv[j] * (sc[u][j] + 1.f) + sh[u][j];
                *(half4*)(H + (size_t)r * D + c) = cvt4(hv);
#pragma unroll
                for (int e = 0; e < 16; ++e) { const f32x4 w = *(const LAS f32x4*)(rw + e * 1024 + c); lg[e] += hv[0] * w[0] + hv[1] * w[1] + hv[2] * w[2] + hv[3] * w[3]; }
                asm volatile("" ::: "memory"); }
            float k8[8], k4[4], k2[2], k1;
            { const bool hi = lane & 32;
#pragma unroll
              for (int e = 0; e < 8; ++e) { const float snd = hi ? lg[e] : lg[e + 8]; k8[e] = (hi ? lg[e + 8] : lg[e]) + SHFL_XOR(snd, 32); } }
            { const bool hi = lane & 16;
#pragma unroll
              for (int e = 0; e < 4; ++e) { const float snd = hi ? k8[e] : k8[e + 4]; k4[e] = (hi ? k8[e + 4] : k8[e]) + SHFL_XOR(snd, 16); } }
            { const bool hi = lane & 8;
#pragma unroll
              for (int e = 0; e < 2; ++e) { const float snd = hi ? k4[e] : k4[e + 2]; k2[e] = (hi ? k4[e + 2] : k4[e]) + SHFL_XOR(snd, 8); } }
            { const bool hi = lane & 4; const float snd = hi ? k2[0] : k2[1]; k1 = (hi ? k2[1] : k2[0]) + SHFL_XOR(snd, 4); }
            k1 += SHFL_XOR(k1, 2); k1 += SHFL_XOR(k1, 1);
            float mx = k1; mx = fmaxf(mx, SHFL_XOR(mx, 4)); mx = fmaxf(mx, SHFL_XOR(mx, 8)); mx = fmaxf(mx, SHFL_XOR(mx, 16)); mx = fmaxf(mx, SHFL_XOR(mx, 32));
            const float ex = fexp(k1 - mx); float sum = ex; sum += SHFL_XOR(sum, 4); sum += SHFL_XOR(sum, 8); sum += SHFL_XOR(sum, 16); sum += SHFL_XOR(sum, 32);
            if ((lane & 3) == 0) PROB[(size_t)r * 16 + (lane >> 2)] = ex * frcp(sum); }
    }
}

__device__ __forceinline__ void ph_topk(int wb, const Params& p, int nctx, LAS unsigned char* lds) {
    const int tid = tid_fresh(wb), wid = tid >> 6, lane = tid & 63;
    LAS unsigned* pv = (LAS unsigned*)lds;
    LAS unsigned* hist = pv + (SEQ > CTXL ? SEQ : CTXL);
    LAS int* wtot = (LAS int*)(hist + 256);
    LAS int* selrows = wtot + 16;
    LAS unsigned* sh = (LAS unsigned*)(selrows + (CAPL > CAPC ? CAPL : CAPC));
    const float* PROB = (const float*)(p.ws + OFF_PROB); int* SLOT = (int*)(p.ws + OFF_SLOT); int* SEL = (int*)(p.ws + OFF_SEL); float* AFF = (float*)(p.ws + OFF_AFF);
    const half_t* H = (const half_t*)(p.ws + OFF_H); half_t* XE = (half_t*)(p.ws + OFF_XE);
    auto block_excl = [&](int v, int slotbase) -> int {
        float f = (float)v;
#pragma unroll
        for (int off = 1; off < 64; off <<= 1) { const float o = shfl_up_f(f, off, lane); f = lane >= off ? f + o : f; }
        if (lane == 63) wtot[slotbase + wid] = (int)f;
        SYNC();
        int pre = 0;
#pragma unroll
        for (int w = 0; w < 8; ++w) pre += (w < wid) ? wtot[slotbase + w] : 0;
        return pre + (int)f - v; };
    const int nlat = BG * 16, nq = (nlat * 4 + nctx * 16 <= (int)gridDim.x) ? 4 : (nlat * 2 + nctx * 16 <= (int)gridDim.x) ? 2 : 1;
    for (int vit = blockIdx.x; vit < nlat * nq + nctx * 16; vit += gridDim.x) {
        const int item = vit < nlat * nq ? vit / nq : vit - nlat * (nq - 1), part = vit < nlat * nq ? vit % nq : 0, nparts = vit < nlat * nq ? nq : 1;
        const int e = item & 15, sm = item >> 4, stc = sm >= BG, bl = stc ? sm - BG : sm;
        const int n = stc ? CTXL : SEQ, cap = n / 8, row0 = stc ? RL + bl * CTXL : bl * SEQ, slot0 = stc ? BG * CAPL + bl * CAPC : bl * CAPL;
        SYNC();
        for (int i = tid; i < n; i += NT) pv[i] = __float_as_uint(PROB[(size_t)(row0 + i) * 16 + e]);
        unsigned prefix = 0u, mask = 0u; int kth = cap;
        for (int pass = 3; pass >= 0; --pass) {
            if (tid < 256) hist[tid] = 0u;
            SYNC();
            for (int i = tid; i < n; i += NT) { const unsigned v = pv[i]; if ((v & mask) == prefix) LDS_ATOMIC_INC(&hist[(v >> (8 * pass)) & 255u]); }
            SYNC();
            if (wid == 0) {
                const int b0 = 255 - 4 * lane; const int h0 = (int)hist[b0], h1 = (int)hist[b0 - 1], h2 = (int)hist[b0 - 2], h3 = (int)hist[b0 - 3];
                float f = (float)(h0 + h1 + h2 + h3);
#pragma unroll
                for (int off = 1; off < 64; off <<= 1) { const float o = shfl_up_f(f, off, lane); f = lane >= off ? f + o : f; }
                int cum = (int)f - (h0 + h1 + h2 + h3);
                const int hh[4] = {h0, h1, h2, h3};
#pragma unroll
                for (int j = 0; j < 4; ++j) { if (cum < kth && kth <= cum + hh[j]) { sh[0] = (unsigned)(b0 - j); sh[1] = (unsigned)(kth - cum); } cum += hh[j]; }
            }
            SYNC();
            prefix |= sh[0] << (8 * pass); mask |= 0xFFu << (8 * pass); kth = (int)sh[1];
        }
        const unsigned thr = prefix; const int need_eq = kth;
        const int per = (n + NT - 1) / NT, i0 = tid * per, i1 = (i0 + per < n) ? i0 + per : n;
        int ce = 0, cg = 0; for (int i = i0; i < i1; ++i) { const unsigned v = pv[i]; ce += (v == thr); cg += (v > thr); }
        const int eq_ex = block_excl(ce, 0);
        int take = need_eq - eq_ex; take = take < 0 ? 0 : (take > ce ? ce : take);
        const int pos_ex = block_excl(cg + take, 8);
        { int eqr = eq_ex, pos = pos_ex;
          for (int i = i0; i < i1; ++i) { const unsigned v = pv[i]; const bool sel = v > thr || (v == thr && eqr < need_eq); if (v == thr) ++eqr; const int row = row0 + i;
              if (sel) { const int slot = slot0 + pos; if (part == 0) { SEL[e * RPE + slot] = row; AFF[e * RPE + slot] = __uint_as_float(v); SLOT[(size_t)row * 16 + e] = slot; } selrows[pos] = row; ++pos; }
              else if (part == 0) SLOT[(size_t)row * 16 + e] = -1; } }
        SYNC();
        const int g0 = part * (cap / nparts) * 128, g1 = (part + 1 == nparts ? cap : (part + 1) * (cap / nparts)) * 128;
        for (int idx0 = g0 + tid; idx0 < g1; idx0 += NT * 8) { half8 t[8];
#pragma unroll
            for (int u = 0; u < 8; ++u) { const int idx = idx0 + u * NT; if (idx < g1) t[u] = *(const half8*)(H + (size_t)selrows[idx >> 7] * 1024 + (idx & 127) * 8); }
#pragma unroll
            for (int u = 0; u < 8; ++u) { const int idx = idx0 + u * NT; if (idx < g1) *(half8*)(XE + ((size_t)e * RPE + slot0 + (idx >> 7)) * 1024 + (idx & 127) * 8) = t[u]; } }
    }
    SYNC();
}

__device__ __forceinline__ void ph_combine(int wb, const Params& p, int l, int g, int nrows) {
    const int tid = tid_fresh(wb), wid = tid >> 6, lane = tid & 63;
    const int* SLOT = (const int*)(p.ws + OFF_SLOT); const half_t* YE = (const half_t*)(p.ws + OFF_YE);
    constexpr int RU = 4;
    const int rstep = gridDim.x * 8;
    for (int r0 = blockIdx.x * 8 + wid; r0 < nrows; r0 += rstep * RU) {
        float acc[RU][2][8]; f32x4 xv[RU][4];
#pragma unroll
        for (int u = 0; u < RU; ++u) { const int r = r0 + u * rstep;
#pragma unroll
            for (int j = 0; j < 2; ++j)
#pragma unroll
                for (int e = 0; e < 8; ++e) acc[u][j][e] = 0.f;
            if (r < nrows) { const half_t* xr = res_h(p, g, r); const half_t* dxr = (const half_t*)(p.ws + OFF_DX) + (size_t)r * D;
#pragma unroll
                for (int j = 0; j < 2; ++j) { const half8 xh = *(const half8*)(xr + 8 * lane + 512 * j);
                    const half8 dx = *(const half8*)(dxr + 8 * lane + 512 * j);
#pragma unroll
                    for (int e = 0; e < 4; ++e) { xv[u][2 * j][e] = (float)xh[e] + (float)dx[e]; xv[u][2 * j + 1][e] = (float)xh[4 + e] + (float)dx[4 + e]; } }
                int sl[16];
#pragma unroll
                for (int q = 0; q < 4; ++q) { const int4 t = *(const int4*)(SLOT + (size_t)r * 16 + 4 * q); sl[4 * q] = t.x; sl[4 * q + 1] = t.y; sl[4 * q + 2] = t.z; sl[4 * q + 3] = t.w; }
#pragma unroll
                for (int ex = 0; ex < 16; ++ex) { if (sl[ex] < 0) continue;
#pragma unroll
                    for (int j = 0; j < 2; ++j) { const half8 y = *(const half8*)(YE + ((size_t)ex * RPE + sl[ex]) * 1024 + 8 * lane + 512 * j);
#pragma unroll
                        for (int e = 0; e < 8; ++e) acc[u][j][e] += (float)y[e]; } } } }
        float ss[RU];
#pragma unroll
        for (int u = 0; u < RU; ++u) { const int r = r0 + u * rstep; ss[u] = 0.f; if (r >= nrows) continue;
            const float* md = mod_row(p, l, g, r) + 5 * 1024;
#pragma unroll
            for (int j = 0; j < 2; ++j) { const f32x4 m0 = *(const f32x4*)(md + 8 * lane + 512 * j), m1 = *(const f32x4*)(md + 8 * lane + 512 * j + 4);
#pragma unroll
                for (int e = 0; e < 4; ++e) { xv[u][2 * j][e] += m0[e] * acc[u][j][e]; xv[u][2 * j + 1][e] += m1[e] * acc[u][j][4 + e];
                    ss[u] += xv[u][2 * j][e] * xv[u][2 * j][e] + xv[u][2 * j + 1][e] * xv[u][2 * j + 1][e]; } } }
        if (l == DEPTH - 1) {
#pragma unroll
            for (int u = 0; u < RU; ++u) ss[u] = wave_sum(ss[u]); }
#pragma unroll
        for (int u = 0; u < RU; ++u) { const int r = r0 + u * rstep; if (r >= nrows) continue;
            if (l == DEPTH - 1) { const float rinv = frsq(ss[u] * (1.f / D) + 1e-6f); float* xr = res_dst(p, g, r);
#pragma unroll
                for (int j = 0; j < 2; ++j) { const f32x4 f0 = *(const f32x4*)(p.in[I_FING] + 8 * lane + 512 * j), f1 = *(const f32x4*)(p.in[I_FING] + 8 * lane + 512 * j + 4);
                    *(f32x4*)(xr + 8 * lane + 512 * j) = xv[u][2 * j] * rinv * f0; *(f32x4*)(xr + 8 * lane + 512 * j + 4) = xv[u][2 * j + 1] * rinv * f1; } }
            else { half_t* xr = res_h(p, g, r);
#pragma unroll
                for (int j = 0; j < 2; ++j) { half8 o;
#pragma unroll
                    for (int e = 0; e < 4; ++e) { o[e] = (half_t)xv[u][2 * j][e]; o[4 + e] = (half_t)xv[u][2 * j + 1][e]; }
                    *(half8*)(xr + 8 * lane + 512 * j) = o; } } }
    }
}

#ifndef TPROBE_A
#define TPROBE_A 0
#endif
#ifndef TPROBE_B
#define TPROBE_B 0
#endif
#ifndef CPU_EMU
__device__ __forceinline__ void tprobe_tick(LAS unsigned char* lds, int idx) {
    volatile LAS unsigned long long* tp = (volatile LAS unsigned long long*)(lds + SMEM_BYTES - 64);
    const unsigned long long now = __builtin_amdgcn_s_memrealtime(), dt = now - tp[0];
    if ((TPROBE_A >> idx) & 1) tp[1] += dt;
    if ((TPROBE_B >> idx) & 1) tp[2] += dt;
    tp[0] = now;
}
#define PH_T(idx) do { if ((TPROBE_A | TPROBE_B) != 0 && blockIdx.x == 0 && tid_fresh(wb) == 0) tprobe_tick(lds, (idx)); } while (0)
#else
#define PH_T(idx)
#endif
#ifndef EMU_DUMP
#define EMU_DUMP(tag)
#endif
#ifndef CPU_EMU
extern __shared__ __attribute__((aligned(16))) unsigned char smem_raw[];
__global__ void __launch_bounds__(NT, 2) mega(Params p)
#else
void mega(Params p)
#endif
{
#ifndef CPU_EMU
    LAS unsigned char* lds = (LAS unsigned char*)smem_raw;
    volatile LAS unsigned* xbw = (volatile LAS unsigned*)(lds + SMEM_BYTES - 16);
    if (threadIdx.x == 0) { xbw[0] = 0u; xbw[1] = 0u; xbw[2] = 0u; xbw[3] = 0u; }
    __syncthreads();
    (void)xcd_barrier_post((unsigned*)(p.ws + OFF_BAR), xbw);
    if ((TPROBE_A | TPROBE_B) != 0 && threadIdx.x == 0) { volatile LAS unsigned long long* tp = (volatile LAS unsigned long long*)(lds + SMEM_BYTES - 64); tp[0] = __builtin_amdgcn_s_memrealtime(); tp[1] = 0ull; tp[2] = 0ull; }
#else
    unsigned char* lds = emu_smem();
#endif
#ifndef CPU_EMU
    const int wb = __builtin_amdgcn_readfirstlane((int)threadIdx.x) & ~63;
#else
    const int wb = 0;
#endif
    const int G = gridDim.x, c = blockIdx.x;
    if (!(SKIP_MASK & 1)) ph_mod(wb, p, lds);
    if (!(SKIP_MASK & 2)) ph_convert(wb, p, 0, 0, c, G, lds);
    ph_xconv(wb, p);
    GRID_SYNC(); PH_T(0);
    for (int l = 0; l < DEPTH; ++l) {
        const bool last = (l == DEPTH - 1);
        for (int g = 0; g < NGROUP; ++g) {
            const Geo gq = geo_of(g);
            const int nact = last ? RL : gq.rg;
            const int nactp = last ? RL : gq.rgp;
            const int tpa = last ? (BG * CAPL + 255) / 256 : gq.tpe;
            if (l == 0 && g == 0) { if (!(SKIP_MASK & 4)) ph_norm1(wb, p, l, g); GRID_SYNC(); PH_T(1); }
            EMU_DUMP("norm1");
            if (!(SKIP_MASK & 8)) REPS(8) { pg8::StaticOrder S; S.init(gq.rgp / 256, NP / 256, G, c); EpiP E{(half_t*)(p.ws + OFF_P)};
              pg8::gemm_phase(wb, lds, pg8::Gemm{(const half_t*)(p.ws + OFF_H), (const half_t*)(p.ws + OFF_WIN), 1024, 16}, S, E); }
            GRID_SYNC(); PH_T(2); EMU_DUMP("gemm_in");
            if (!(SKIP_MASK & 16)) REPS(16) ph_prep2(wb, p, l, gq.rg, lds);
            GRID_SYNC(); PH_T(3); EMU_DUMP("prep");
            if (!(SKIP_MASK & 32)) REPS(32) { pg8::LoraOrder S; S.init(gq.rgp / 256, G, c); EpiLora E{(half_t*)(p.ws + OFF_RLO), p.in[I_RW0] + (size_t)l * 1024, p.in[I_RA0] + (size_t)l * 1024};
              pg8::gemm_phase(wb, lds, pg8::Gemm{(const half_t*)(p.ws + OFF_RLI), (const half_t*)(p.ws + OFF_WLORA), 384, 2}, S, E); }
            if (!(SKIP_MASK & 64)) REPS(64) ph_wy(wb, p, gq.rg, lds);
            GRID_SYNC(); PH_T(4); EMU_DUMP("wy");
            if (!(SKIP_MASK & 128)) REPS(128) ph_scan(wb, p, l, g, lds);
            GRID_SYNC(); PH_T(5); EMU_DUMP("scan");
            if (!(SKIP_MASK & 256)) REPS(256) ph_finish(wb, p, l, nact);
            GRID_SYNC(); PH_T(6); EMU_DUMP("finish");
            if (!(SKIP_MASK & 512)) REPS(512) { pg8::MergeOrder S; S.init(nactp / 256, G, c); EpiMerge E{(half_t*)(p.ws + OFF_H), (const half_t*)(p.ws + OFF_P)};
              pg8::gemm_phase(wb, lds, pg8::Gemm{(const half_t*)(p.ws + OFF_BR), (const half_t*)(p.ws + OFF_WBR), 512, 8}, S, E); }
            GRID_SYNC(); PH_T(7); EMU_DUMP("merge");
            if (!(SKIP_MASK & 1024)) { pg8::StaticOrder S; S.init(nactp / 256, 4, G, c); EpiOut E{p, l, g, gq.rg};
              pg8::gemm_phase(wb, lds, pg8::Gemm{(const half_t*)(p.ws + OFF_H), (const half_t*)(p.ws + OFF_WOUT), 1024, 16}, S, E); }
            GRID_SYNC(); PH_T(8); EMU_DUMP("out");
            if (!(SKIP_MASK & 2048)) REPS(2048) ph_norm2(wb, p, l, g, nact, lds);
            GRID_SYNC(); PH_T(9); EMU_DUMP("norm2");
            if (!(SKIP_MASK & 4096)) REPS(4096) ph_topk(wb, p, (g == 0 && !last) ? BATCH : 0, lds);
            GRID_SYNC(); PH_T(10); EMU_DUMP("topk");
            if (!(SKIP_MASK & 8192)) REPS(8192) { pg8::ExpertOrder S; S.init(tpa, G, c); EpiUp E{(half_t*)(p.ws + OFF_HID)};
              pg8::gemm_phase(wb, lds, pg8::Gemm{(const half_t*)(p.ws + OFF_XE), (const half_t*)(p.ws + OFF_WUP), 1024, 16}, S, E); }
            GRID_SYNC(); PH_T(11);
            if (!(SKIP_MASK & 16384)) REPS(16384) { pg8::ExpertOrder S; S.init(tpa, G, c); EpiDown E{(half_t*)(p.ws + OFF_YE), (const float*)(p.ws + OFF_AFF)};
              pg8::gemm_phase(wb, lds, pg8::Gemm{(const half_t*)(p.ws + OFF_HID), (const half_t*)(p.ws + OFF_WDN), 512, 8}, S, E); }
            GRID_SYNC(); PH_T(12);
            if (!(SKIP_MASK & 32768)) ph_combine(wb, p, l, g, nact);
            if (!(SKIP_MASK & 4)) { if (g + 1 < NGROUP) ph_norm1(wb, p, l, g + 1); else if (!last) ph_norm1(wb, p, l + 1, 0); }
            GRID_SYNC(); PH_T(13); EMU_DUMP("combine");
        }
    }
#ifndef CPU_EMU
#if SANDBOX
    GRID_SYNC(); PH_T(16);
    { pg8::StaticOrder S; S.init(RGP / 256, NP / 256, G, c); SANDBOX_EPI E{(SANDBOX_EPI_ARG)(p.ws + OFF_P)};
      pg8::gemm_phase(wb, lds, pg8::Gemm{(const half_t*)(p.ws + OFF_H), (const half_t*)(p.ws + OFF_WIN), 1024, SANDBOX_A}, S, E); }
    GRID_SYNC(); PH_T(14);
    { pg8::StaticOrder S; S.init(RGP / 256, NP / 256, G, c); SANDBOX_EPI E{(SANDBOX_EPI_ARG)(p.ws + OFF_P)};
      pg8::gemm_phase(wb, lds, pg8::Gemm{(const half_t*)(p.ws + OFF_H), (const half_t*)(p.ws + OFF_WIN), 1024, SANDBOX_B}, S, E); }
    GRID_SYNC(); PH_T(15);
#endif
    if ((TPROBE_A | TPROBE_B) != 0 && blockIdx.x == 0) {
        __syncthreads();
        volatile LAS unsigned long long* tp = (volatile LAS unsigned long long*)(lds + SMEM_BYTES - 64);
        const float msA = (float)tp[1] * 1e-5f, msB = (float)tp[2] * 1e-5f;
        if (TPROBE_A != 0 && threadIdx.x == 0) p.out[0] += 10.f * msA;
        if (TPROBE_B != 0) { const float eps = sqrtf(msB * 1.675e-3f); for (int i = threadIdx.x; i < (1 << 20); i += NT) p.out[1024 + i] += eps; }
    }
#endif
}

#ifndef CPU_EMU
extern "C" void kernel_launch(void* const* d_in, const int* in_sizes, int n_in, void* d_out, int out_size, void* d_ws, size_t ws_size, hipStream_t stream) {
    (void)in_sizes; (void)n_in; (void)out_size;
    static int grid = 0;
    if (!grid) {
        int dev = 0, cus = 0, per_cu = 0;
        hipGetDevice(&dev);
        hipDeviceGetAttribute(&cus, hipDeviceAttributeMultiprocessorCount, dev);
        hipFuncSetAttribute((const void*)mega, hipFuncAttributeMaxDynamicSharedMemorySize, SMEM_BYTES);
        hipOccupancyMaxActiveBlocksPerMultiprocessor(&per_cu, (const void*)mega, NT, SMEM_BYTES);
        if (per_cu < 1) per_cu = 1;
        grid = cus;
        if (ws_size < WS_TOTAL) fprintf(stderr, "workspace too small: %zu < %zu\n", ws_size, (size_t)WS_TOTAL);
    }
    hipMemsetAsync((unsigned char*)d_ws + OFF_BAR, 0, 16384, stream);
    Params p{};
    for (int i = 0; i < 34; ++i) p.in[i] = (const float*)d_in[i];
    p.out = (float*)d_out; p.ws = (unsigned char*)d_ws;
    hipLaunchKernelGGL(mega, dim3(grid), dim3(NT), SMEM_BYTES, stream, p);
}
#endif
```

```cpp
#ifndef CPU_EMU
#include <hip/hip_runtime.h>
#include <cstdio>
#include <cstdint>
typedef _Float16 half_t;
typedef _Float16 half8 __attribute__((ext_vector_type(8)));
typedef _Float16 half4 __attribute__((ext_vector_type(4)));
typedef float f32x4 __attribute__((ext_vector_type(4)));
typedef float f32x2 __attribute__((ext_vector_type(2)));
#define LAS __attribute__((address_space(3)))
#define SYNC() __syncthreads()
#define WAVE_SYNC() __builtin_amdgcn_wave_barrier()
template <int M> __device__ __forceinline__ float shfl_xor_t(float v, int tid) {
    if constexpr (M < 32) return __int_as_float(__builtin_amdgcn_ds_swizzle(__float_as_int(v), (M << 10) | 0x1f));
    else return __int_as_float(__builtin_amdgcn_ds_bpermute(((tid ^ 32) & 63) << 2, __float_as_int(v)));
}
#define SHFL_XOR(v, m) shfl_xor_t<m>((v), tid)
#define LDS_ATOMIC_INC(p) __hip_atomic_fetch_add((p), 1u, __ATOMIC_RELAXED, __HIP_MEMORY_SCOPE_WORKGROUP)
#endif

#ifndef CFG_BATCH
#define CFG_BATCH 8
#define CFG_SEQ 4096
#define CFG_CTX 256
#define CFG_DEPTH 4
#define CFG_NGROUP 2
#endif
constexpr int BATCH = CFG_BATCH, SEQ = CFG_SEQ, CTXL = CFG_CTX, DEPTH = CFG_DEPTH, NGROUP = CFG_NGROUP;
#ifndef SKIP_MASK
#define SKIP_MASK 0
#endif
#ifndef WARM_WIN
#define WARM_WIN 0
#endif
#ifndef SANDBOX
#define SANDBOX 0
#endif
#ifndef SANDBOX_PV
#define SANDBOX_PV 1
#endif
#ifndef SANDBOX_A
#define SANDBOX_A 16
#define SANDBOX_B 8
#endif
#ifndef SANDBOX_EPI
#define SANDBOX_EPI EpiP
#define SANDBOX_EPI_ARG half_t*
#endif
#ifndef REPEAT_MASK
#define REPEAT_MASK 0
#endif
#define REPS(bit) for (int rep_ = 0; rep_ < ((REPEAT_MASK & (bit)) ? 2 : 1); ++rep_)
constexpr int NT = 512;
constexpr int D = 1024;
constexpr int IN_COLS = 8608, NP = 8704;
constexpr int C_Z = 1536, C_BG = 2048;
constexpr int C_RWKV = 2064;
constexpr int C_ML = 3984, C_MLO = 5008, C_MLIG = 5520, C_MLFG = 5528;
constexpr int C_GATE = 5536;
constexpr int BG = BATCH / NGROUP;
constexpr int RL = BG * SEQ;
constexpr int RCX = BATCH * CTXL;
constexpr int RGX = RL + RCX;
constexpr int RGP = (RGX + 255) / 256 * 256;
constexpr int CAPL = SEQ / 8, CAPC = CTXL / 8;
constexpr int RPE = (BG * CAPL + BATCH * CAPC + 255) / 256 * 256;
constexpr int TPE = RPE / 256;
constexpr int NCH = RGP / 64;
struct Geo { int rg, rgp, tpe; };
__host__ __device__ __forceinline__ Geo geo_of(int g) { Geo q; q.rg = RL + (g == 0 ? RCX : 0); q.rgp = (q.rg + 255) / 256 * 256; q.tpe = (BG * CAPL + (g == 0 ? BATCH * CAPC : 0) + 255) / 256; return q; }
static_assert(RL % 256 == 0, "latent rows per group must be a multiple of 256");
static_assert(SEQ % 64 == 0 && CTXL % 64 == 0, "chunks");

constexpr size_t al256(size_t x) { return (x + 255) / 256 * 256; }
constexpr size_t cmax(size_t a, size_t b) { return a > b ? a : b; }
constexpr size_t OFF_BAR = 0;
constexpr size_t OFF_MOD = 16384;
constexpr size_t OFF_CTXR = al256(OFF_MOD + (size_t)DEPTH * (BATCH + 1) * 6144 * 4);
constexpr size_t OFF_WIN = al256(OFF_CTXR + (size_t)BATCH * CTXL * D * 4);
constexpr size_t OFF_WBR = al256(OFF_WIN + (size_t)NP * 1024 * 2);
constexpr size_t OFF_WOUT = al256(OFF_WBR + (size_t)3 * 1024 * 512 * 2);
constexpr size_t OFF_WUP = al256(OFF_WOUT + (size_t)1024 * 1024 * 2);
constexpr size_t OFF_WDN = al256(OFF_WUP + (size_t)16 * 1024 * 1024 * 2);
constexpr size_t OFF_WLORA = al256(OFF_WDN + (size_t)16 * 1024 * 512 * 2);
constexpr size_t OFF_H = al256(OFF_WLORA + (size_t)2560 * 384 * 2);
constexpr size_t OFF_P = al256(OFF_H + (size_t)RGP * 1024 * 2);
constexpr size_t SZ_XE = (size_t)16 * RPE * 1024 * 2, SZ_HID = (size_t)16 * RPE * 512 * 2;
constexpr size_t OFF_XE = OFF_P, OFF_HID = OFF_XE + SZ_XE, OFF_YE = OFF_HID + SZ_HID;
constexpr size_t OFF_GQKV = al256(OFF_P + cmax((size_t)RGP * NP * 2, 2 * SZ_XE + SZ_HID));
constexpr size_t OFF_BR = OFF_GQKV;
constexpr size_t OFF_DX = OFF_BR;
constexpr size_t OFF_GBG = al256(OFF_GQKV + (size_t)RGP * 1536 * 2);
constexpr size_t OFF_GTA = al256(OFF_GBG + (size_t)RGP * 16 * 4);
constexpr size_t OFF_GG = al256(OFF_GTA + (size_t)NCH * 4 * 2 * 2 * 4096 * 2);
constexpr size_t OFF_RW = al256(OFF_GG + (size_t)NCH * 4 * 2 * 64 * 4);
constexpr size_t OFF_RLO = al256(OFF_RW + (size_t)RGP * 4 * 512 * 2);
constexpr size_t OFF_SO = al256(OFF_RLO + (size_t)RGP * 2560 * 2);
constexpr size_t OFF_RLI = OFF_SO;
constexpr size_t OFF_SOG = OFF_SO, OFF_SOM = OFF_SOG + (size_t)2 * RGP * 512 * 2, OFF_SOR = OFF_SOM + (size_t)2 * RGP * 512 * 2;
constexpr size_t OFF_PROB = al256(OFF_SOR + (size_t)2 * RGP * 512 * 2);
constexpr size_t OFF_SLOT = al256(OFF_PROB + (size_t)RGP * 16 * 4);
constexpr size_t OFF_SEL = al256(OFF_SLOT + (size_t)RGP * 16 * 4);
constexpr size_t OFF_AFF = al256(OFF_SEL + (size_t)16 * RPE * 4);
constexpr int NSAVE = BATCH - BG > 0 ? BATCH - BG : 1;
constexpr size_t OFF_RST = al256(OFF_AFF + (size_t)16 * RPE * 4);
constexpr size_t OFF_GST = al256(OFF_RST + (size_t)NSAVE * 8 * 2 * 4096 * 4);
constexpr size_t OFF_MST = al256(OFF_GST + (size_t)NSAVE * 4 * 2 * 16384 * 4);
constexpr size_t OFF_MSM = al256(OFF_MST + (size_t)NSAVE * 4 * 2 * 16384 * 4);
constexpr size_t WS_TOTAL = al256(OFF_MSM + (size_t)NSAVE * 4 * 2 * 4);
constexpr int SMEM_BYTES = 152 * 1024;

struct Params { const float* in[34]; float* out; unsigned char* ws; };
enum { I_X = 0, I_C, I_CTX, I_CCTX, I_ADAW, I_ADAB, I_N1G, I_N2G, I_WIN, I_GCONV, I_GALOG, I_GDTB, I_GNG, I_RMU, I_RW0, I_RWUP, I_RA0, I_RAUP, I_RGUP,
       I_RKK, I_RKA, I_RRK, I_RLNG, I_RLNB, I_MIB, I_MFB, I_MNG, I_WBR, I_WOUT, I_ROUT, I_W1, I_W3, I_W2, I_FING };

#ifndef CPU_EMU
__device__ __forceinline__ int tid_fresh(int wb) { int t; asm volatile("v_mbcnt_lo_u32_b32 %0, -1, 0\n\tv_mbcnt_hi_u32_b32 %0, -1, %0" : "=v"(t)); return wb + t; }
#else
static inline int tid_fresh(int) { return threadIdx.x; }
#endif
#ifndef CPU_EMU
__device__ __forceinline__ float fexp(float x) { return __builtin_amdgcn_exp2f(x * 1.4426950408889634f); }
__device__ __forceinline__ float flog(float x) { return __builtin_amdgcn_logf(x) * 0.6931471805599453f; }
__device__ __forceinline__ float frcp(float x) { return __builtin_amdgcn_rcpf(x); }
__device__ __forceinline__ float frsq(float x) { return __builtin_amdgcn_rsqf(x); }
#else
static inline float fexp(float x) { return expf(x); }
static inline float flog(float x) { return logf(x); }
static inline float frcp(float x) { return 1.f / x; }
static inline float frsq(float x) { return 1.f / sqrtf(x); }
#endif
__device__ __forceinline__ float sigm(float x) { return frcp(1.f + fexp(-x)); }
__device__ __forceinline__ float siluf(float x) { return x * frcp(1.f + fexp(-x)); }
__device__ __forceinline__ float ftanh(float x) { return 1.f - 2.f * frcp(1.f + fexp(2.f * x)); }
__device__ __forceinline__ float softplusf(float x) { const float t = fexp(x); return x > 15.f ? x : (t < 1e-3f ? t * (1.f - 0.5f * t) : flog(1.f + t)); }
#define wave_sum(x) wave_sum_(x, tid)
__device__ __forceinline__ float wave_sum_(float v, int tid) { v += SHFL_XOR(v, 32); v += SHFL_XOR(v, 16); v += SHFL_XOR(v, 8); v += SHFL_XOR(v, 4); v += SHFL_XOR(v, 2); v += SHFL_XOR(v, 1); return v; }

#ifndef CPU_EMU
#define MFMA16(a, b, c) __builtin_amdgcn_mfma_f32_16x16x32_f16((a), (b), (c), 0, 0, 0)
#else
#define MFMA16(a, b, c) emu_mfma16((a), (b), (c))
#endif
__device__ __forceinline__ half8 ldfrag(const LAS half_t* base, int row0, int ld, int k0, int lane) { return *(const LAS half8*)(base + (row0 + (lane & 15)) * ld + k0 + 8 * (lane >> 4)); }
__device__ __forceinline__ half4 cvt4(f32x4 v) { half4 o; o[0] = (half_t)v[0]; o[1] = (half_t)v[1]; o[2] = (half_t)v[2]; o[3] = (half_t)v[3]; return o; }

typedef unsigned short bf16_t;
__device__ __forceinline__ bf16_t f2bf(float f) { unsigned u = __float_as_uint(f); u += 0x7FFFu + ((u >> 16) & 1u); return (bf16_t)(u >> 16); }
__device__ __forceinline__ float bf2f(bf16_t b) { return __uint_as_float(((unsigned)b) << 16); }
#ifndef CPU_EMU
#define EPI_LOAD_FENCE() asm volatile("" ::: "memory")
#else
#define EPI_LOAD_FENCE()
#endif
__device__ __forceinline__ float* res_dst(const Params& p, int g, int r) {
    if (r < RL) { const size_t t = (size_t)(g * BG) * SEQ + r; return p.out + t * D; }
    const size_t t = (size_t)(r - RL); return (float*)(p.ws + OFF_CTXR) + t * D;
}
__device__ __forceinline__ half_t* res_h(const Params& p, int g, int r) { return (half_t*)res_dst(p, g, r) + 1024; }
__device__ __forceinline__ f32x4 h4f(half4 h) { return (f32x4){(float)h[0], (float)h[1], (float)h[2], (float)h[3]}; }
__device__ __forceinline__ const float* mod_row(const Params& p, int l, int g, int r) {
    const int s = r < RL ? (g * BG + r / SEQ) : BATCH; return (const float*)(p.ws + OFF_MOD) + ((size_t)l * (BATCH + 1) + s) * 6144;
}

#ifndef CPU_EMU
#define XB_TMO      128
#define XB_XCNT(j)  (256  + 64 * (j))
#define XB_XSUB(j)  (1280 + 64 * (j))
#define XB_XGEN(j)  (2304 + 64 * (j))
#define XB_TOP      3328
#define XB_TOPGEN   3392
#define XCD_BAR_WORDS 3456
#define XB_SPIN_CAP (1u << 22)
__device__ __forceinline__ unsigned xb_ld(unsigned* p)              { return __hip_atomic_load(p, __ATOMIC_RELAXED, __HIP_MEMORY_SCOPE_AGENT); }
__device__ __forceinline__ unsigned xb_add(unsigned* p, unsigned v) { return __hip_atomic_fetch_add(p, v, __ATOMIC_RELAXED, __HIP_MEMORY_SCOPE_AGENT); }
__device__ __forceinline__ unsigned xb_xcc_id() { return (unsigned)__builtin_amdgcn_s_getreg((3 << 11) | 20) & 0xFu; }
#define XB_SPIN(cond, bar) do { unsigned _sp = 0; while (cond) { __builtin_amdgcn_s_sleep(1); \
    if ((++_sp & 255u) == 0u) { if (xb_ld(&(bar)[XB_TMO])) break; if (_sp > XB_SPIN_CAP) { atomicAdd(&(bar)[XB_TMO], 1u); break; } } } } while (0)
struct XcdBarrier { unsigned* bar; unsigned x; volatile LAS unsigned* st; };
__device__ __forceinline__ XcdBarrier xcd_barrier_post(unsigned* bar, volatile LAS unsigned* st) {
    XcdBarrier b; b.bar = bar; b.x = xb_xcc_id(); b.st = st;
    if (threadIdx.x == 0) (void)xb_add(&bar[XB_XCNT(b.x)], 1u);
    return b;
}
__device__ __forceinline__ void xcd_barrier_complete(unsigned* bar, unsigned x, unsigned& nloc, unsigned& nx) {
    const unsigned G = gridDim.x * gridDim.y * gridDim.z;
    unsigned sum, cnt, mine, sp = 0u;
    for (;;) {
        sum = 0u; cnt = 0u; mine = 0u;
#pragma unroll
        for (unsigned j = 0; j < 16; ++j) { const unsigned c = xb_ld(&bar[XB_XCNT(j)]); sum += c; cnt += (c > 0u) ? 1u : 0u; mine = (j == x) ? c : mine; }
        if (sum == G) break;
        __builtin_amdgcn_s_sleep(1);
        if ((++sp & 255u) == 0u) { if (xb_ld(&bar[XB_TMO])) break; if (sp > XB_SPIN_CAP) { atomicAdd(&bar[XB_TMO], 1u); break; } }
    }
    nloc = mine > 0u ? mine : 1u; nx = cnt > 0u ? cnt : 1u;
}
__device__ __forceinline__ void xcd_barrier(const XcdBarrier& b) {
    asm volatile("s_waitcnt vmcnt(0)" ::: "memory");
    __syncthreads();
    if (threadIdx.x == 0) {
        unsigned* bar = b.bar;
        __builtin_amdgcn_s_waitcnt(0);
        unsigned nloc = b.st[0], nx = b.st[1];
        if (nloc == 0u) { xcd_barrier_complete(bar, b.x, nloc, nx); b.st[0] = nloc; b.st[1] = nx; }
        const unsigned old = xb_add(&bar[XB_XSUB(b.x)], 1u);
        const unsigned gen = old / nloc;
        if (old + 1u == (gen + 1u) * nloc) {
            __builtin_amdgcn_fence(__ATOMIC_RELEASE, "agent");
            asm volatile("s_waitcnt vmcnt(0)" ::: "memory");
            const unsigned og = xb_add(&bar[XB_TOP], 1u);
            const unsigned tg = og / nx;
            if (og + 1u == (tg + 1u) * nx) xb_add(&bar[XB_TOPGEN], 1u);
            else XB_SPIN(xb_ld(&bar[XB_TOPGEN]) == tg, bar);
            __builtin_amdgcn_fence(__ATOMIC_ACQUIRE, "agent");
            xb_add(&bar[XB_XGEN(b.x)], 1u);
            asm volatile("s_waitcnt vmcnt(0)" ::: "memory");
        } else {
            XB_SPIN(xb_ld(&bar[XB_XGEN(b.x)]) == gen, bar);
            __builtin_amdgcn_fence(__ATOMIC_ACQUIRE, "agent");
            asm volatile("s_waitcnt vmcnt(0)" ::: "memory");
        }
    }
    __syncthreads();
}
#define GRID_SYNC() do { XcdBarrier gb_; gb_.bar = (unsigned*)(p.ws + OFF_BAR); gb_.x = xb_xcc_id(); gb_.st = (volatile LAS unsigned*)(lds + SMEM_BYTES - 16); xcd_barrier(gb_); } while (0)
#else
#define GRID_SYNC() emu_grid_sync()
#endif

namespace pg8 {
constexpr int BM = 256, BK = 64, HALF = 128, HTB = HALF * BK * 2, STAGE_BYTES = 8 * HTB, NXCD = 8, WGM = 8;
__host__ __device__ __forceinline__ int lds_byte(int r, int c) { const int st = (r >> 4) * 2 + (c >> 5), rr = r & 15, cc = c & 31, ob = rr * 64 + cc * 2; return st * 1024 + (ob ^ (((ob >> 9) & 1) << 5)); }
__host__ __device__ __forceinline__ void stage_rc(int b, int& R, int& C) { const int st = b / 1024, sb = b % 1024, swz = sb ^ (((sb >> 9) & 1) << 5); R = (st >> 1) * 16 + swz / 64; C = (st & 1) * 32 + (swz % 64) / 2; }
__host__ __device__ __forceinline__ int perm32(int rho) { const int n = rho >> 4, i = rho & 15; return 8 * (i >> 2) + 4 * n + (i & 3); }
struct Unit { int pm, pn, pb, pa, aux, k0; };
struct Gemm { const half_t* A; const half_t* Bt; int K; int kt; };
struct StaticOrder {
    int nM, nN, nwg, G, c;
    __device__ void init(int nM_, int nN_, int G_, int c_) { nM = nM_; nN = nN_; nwg = nM * nN; G = G_; c = c_; }
    __device__ bool next(int i, Unit& u) const {
        const long L = (long)i * G + c; if (L >= nwg) return false;
        int wgid = (int)L; { const int q = nwg / NXCD, r = nwg % NXCD, xcd = wgid % NXCD, off = wgid / NXCD; wgid = (xcd < r ? xcd * (q + 1) : r * (q + 1) + (xcd - r) * q) + off; }
        const int nig = WGM * nN, gid = wgid / nig, fm = gid * WGM, gsz = (nM - fm) < WGM ? (nM - fm) : WGM;
        u.pm = fm + ((wgid % nig) % gsz); u.pn = (wgid % nig) / gsz; u.pb = u.pn; u.pa = u.pm; u.aux = 0; u.k0 = 0; return true;
    }
};
struct ExpertOrder {
    int G, c, tpa;
    __device__ void init(int tpa_, int G_, int c_) { tpa = tpa_; G = G_; c = c_; }
    __device__ bool next(int i, Unit& u) const {
        const int nwg = 16 * tpa * 4; long L = (long)i * G + c; if (L >= nwg) return false;
        { const int q = nwg / NXCD, r = nwg % NXCD, xcd = (int)L % NXCD, off = (int)L / NXCD; L = (xcd < r ? xcd * (q + 1) : r * (q + 1) + (xcd - r) * q) + off; }
        const int e = (int)L / (tpa * 4), rem = (int)L % (tpa * 4);
        u.pm = e * TPE + rem / 4; u.pn = rem % 4; u.pb = e * 4 + u.pn; u.pa = u.pm; u.aux = 0; u.k0 = 0; return true;
    }
};

struct LoraOrder {
    StaticOrder T;
    __device__ void init(int nM_, int G_, int c_) { T.init(nM_, 10, G_, c_); }
    __device__ bool next(int i, Unit& u) const { if (!T.next(i, u)) return false; const int blk = u.pn >> 1; u.k0 = blk < 4 ? 64 * blk : 256; return true; }
};
struct MergeOrder {
    StaticOrder T;
    __device__ void init(int nM_, int G_, int c_) { T.init(nM_, 4, G_, c_); }
    __device__ bool next(int i, Unit& u) const {
        if (!T.next(i / 3, u)) return false;
        const int bi = i % 3; u.aux = bi; u.pa = bi * (RGP / 256) + u.pm; u.pb = bi * 4 + u.pn; return true;
    }
};
template <class E, class = void> struct EpiCarry { static constexpr bool value = false; };
template <class E> struct EpiCarry<E, decltype((void)E::CARRY)> { static constexpr bool value = true; };
#ifndef CPU_EMU
template <class Epi, class Sched>
__device__ __forceinline__ void gemm_phase(int wb, LAS unsigned char* lds, const Gemm g, const Sched& S, const Epi& E) {
    const int tid = tid_fresh(wb), wid = __builtin_amdgcn_readfirstlane(tid >> 6), lane = tid & 63, wr = wid >> 2, wc = wid & 3, fr = lane & 15, fq = lane >> 4;
    const int K = g.K; int nt = g.kt; asm volatile("" : "+s"(nt));
    unsigned voffA[2], voffB[2];
#pragma unroll
    for (int i = 0; i < 2; ++i) { int R, C; stage_rc(tid * 16 + i * 8192, R, C); const int Rb = Epi::PERM ? ((R & ~31) + perm32(R & 31)) : R;
        voffA[i] = (unsigned)(R * K + C) * 2u; voffB[i] = (unsigned)(Rb * K + C) * 2u; }
    const size_t kstep = (size_t)(BK * 2);
    const size_t hstep = (size_t)HALF * K * 2;
    const size_t tstep = 2 * hstep;
    const unsigned ldsw = (unsigned)wid * 1024u;
    const int aoff = lds_byte(wr * 64 + fr, fq * 8), boff = lds_byte(wc * 32 + fr, fq * 8);
#define PG8_SA(b, h) (((b) * 2 + (h)) * HTB)
#define PG8_SB(b, h) ((4 + (b) * 2 + (h)) * HTB)
#define PG8_STAGE(bufoff, gbase, voff) do { _Pragma("unroll") for (int _i = 0; _i < 2; ++_i) \
        __builtin_amdgcn_global_load_lds((const unsigned*)((const char*)(gbase) + (voff)[_i]), (LAS unsigned*)(lds + (bufoff) + ldsw + _i * 8192), 16, 0, 0); } while (0)
#define PG8_LDA(dst, b, h) do { _Pragma("unroll") for (int m = 0; m < 4; ++m) _Pragma("unroll") for (int k = 0; k < 2; ++k) dst[m][k] = *(const LAS half8*)(lds + PG8_SA(b, h) + aoff + m * 2048 + k * 1024); } while (0)
#define PG8_LDB(dst, b, h) do { _Pragma("unroll") for (int n = 0; n < 2; ++n) _Pragma("unroll") for (int k = 0; k < 2; ++k) dst[n][k] = *(const LAS half8*)(lds + PG8_SB(b, h) + boff + n * 2048 + k * 1024); } while (0)
#define PG8_MMA(ai, bj, At, Bt) do { __builtin_amdgcn_s_setprio(1); _Pragma("unroll") for (int m = 0; m < 4; ++m) _Pragma("unroll") for (int n = 0; n < 2; ++n) _Pragma("unroll") for (int k = 0; k < 2; ++k) \
        acc[ai][bj][m][n] = __builtin_amdgcn_mfma_f32_16x16x32_f16(Bt[n][k], At[m][k], acc[ai][bj][m][n], 0, 0, 0); __builtin_amdgcn_s_setprio(0); } while (0)
#define PG8_WAIT_V(n) asm volatile("s_waitcnt vmcnt(" #n ")" ::: "memory")
#define PG8_WAIT_L(n) asm volatile("s_waitcnt lgkmcnt(" #n ")" ::: "memory")
#define PG8_BAR __builtin_amdgcn_s_barrier()
#define PG8_SCHED __builtin_amdgcn_sched_barrier(0)
    Unit cur, nxt; int ui = 0;
    if (!S.next(0, cur)) return;
    f32x4 acc[2][2][4][2];
#pragma unroll
    for (int a = 0; a < 2; ++a)
#pragma unroll
        for (int b = 0; b < 2; ++b)
#pragma unroll
            for (int m = 0; m < 4; ++m)
#pragma unroll
                for (int n = 0; n < 2; ++n) acc[a][b][m][n] = (f32x4){0.f, 0.f, 0.f, 0.f};
    half8 At[4][2], B0[2][2], B1[2][2];
    const char* cA = (const char*)g.A + (size_t)cur.pa * tstep + (size_t)cur.k0 * 2; const char* cB = (const char*)g.Bt + (size_t)cur.pb * tstep + (size_t)cur.k0 * 2;
    PG8_STAGE(PG8_SB(0, 0), cB, voffB); PG8_STAGE(PG8_SA(0, 0), cA, voffA); PG8_STAGE(PG8_SB(0, 1), cB + hstep, voffB); PG8_STAGE(PG8_SA(0, 1), cA + hstep, voffA);
    if (wr == 1) PG8_BAR;
    PG8_WAIT_V(4); PG8_BAR;
    PG8_STAGE(PG8_SB(1, 0), cB + kstep, voffB); PG8_STAGE(PG8_SA(1, 0), cA + kstep, voffA); PG8_STAGE(PG8_SB(1, 1), cB + hstep + kstep, voffB);
    PG8_WAIT_V(6); PG8_BAR;
    for (;;) {
        const bool has_next = S.next(ui + 1, nxt);
        const char* nA = has_next ? (const char*)g.A + (size_t)nxt.pa * tstep + (size_t)nxt.k0 * 2 : cA; const char* nB = has_next ? (const char*)g.Bt + (size_t)nxt.pb * tstep + (size_t)nxt.k0 * 2 : cB;
#pragma unroll 1
        for (int t = 0; t < nt; t += 2) {
            const bool last = (t == nt - 2);
            const char* a1 = cA + (size_t)(t + 1) * kstep;
            const char* a2 = last ? nA : cA + (size_t)(t + 2) * kstep; const char* b2 = last ? nB : cB + (size_t)(t + 2) * kstep;
            const char* a3 = a2 + kstep; const char* b3 = b2 + kstep;
            PG8_LDB(B0, 0, 0); PG8_SCHED; PG8_LDA(At, 0, 0); PG8_STAGE(PG8_SA(1, 1), a1 + hstep, voffA);
            PG8_WAIT_L(8); PG8_BAR; PG8_WAIT_L(0); PG8_MMA(0, 0, At, B0); PG8_BAR; PG8_SCHED;
            PG8_LDB(B1, 0, 1); PG8_STAGE(PG8_SB(0, 0), b2, voffB);
            PG8_BAR; PG8_WAIT_L(0); PG8_MMA(0, 1, At, B1); PG8_BAR;
            PG8_LDA(At, 0, 1); PG8_STAGE(PG8_SA(0, 0), a2, voffA);
            PG8_BAR; PG8_WAIT_L(0); PG8_MMA(1, 0, At, B0); PG8_BAR; PG8_SCHED;
            PG8_STAGE(PG8_SB(0, 1), b2 + hstep, voffB);
            PG8_WAIT_V(6); PG8_BAR; PG8_MMA(1, 1, At, B1); PG8_BAR;
            PG8_LDB(B0, 1, 0); PG8_SCHED; PG8_LDA(At, 1, 0); PG8_STAGE(PG8_SA(0, 1), a2 + hstep, voffA);
            PG8_WAIT_L(8); PG8_BAR; PG8_WAIT_L(0); PG8_MMA(0, 0, At, B0); PG8_BAR; PG8_SCHED;
            PG8_LDB(B1, 1, 1); PG8_STAGE(PG8_SB(1, 0), b3, voffB);
            PG8_BAR; PG8_WAIT_L(0); PG8_MMA(0, 1, At, B1); PG8_BAR;
            PG8_LDA(At, 1, 1); PG8_STAGE(PG8_SA(1, 0), a3, voffA);
            PG8_BAR; PG8_WAIT_L(0); PG8_MMA(1, 0, At, B0); PG8_BAR; PG8_SCHED;
            PG8_STAGE(PG8_SB(1, 1), b3 + hstep, voffB);
            PG8_WAIT_V(6); PG8_BAR; PG8_MMA(1, 1, At, B1); PG8_BAR;
        }
        bool keep = false;
        if constexpr (EpiCarry<Epi>::value) keep = E(acc, cur, wr, wc, fr, fq); else E(acc, cur, wr, wc, fr, fq);
        if (!has_next) break;
        if (!keep) {
#pragma unroll
            for (int a = 0; a < 2; ++a)
#pragma unroll
                for (int b = 0; b < 2; ++b)
#pragma unroll
                    for (int m = 0; m < 4; ++m)
#pragma unroll
                        for (int n = 0; n < 2; ++n) acc[a][b][m][n] = (f32x4){0.f, 0.f, 0.f, 0.f};
        }
        cur = nxt; cA = nA; cB = nB; ++ui;
    }
    PG8_WAIT_V(0);
    if (wr == 0) PG8_BAR;
    PG8_BAR;
#undef PG8_SA
#undef PG8_SB
#undef PG8_STAGE
#undef PG8_LDA
#undef PG8_LDB
#undef PG8_MMA
#undef PG8_WAIT_V
#undef PG8_WAIT_L
#undef PG8_BAR
#undef PG8_SCHED
}
#else
static float* emu_fa[64]; static float* emu_fb[64];
template <class Epi, class Sched>
void gemm_phase(int wb, LAS unsigned char* lds, const Gemm g, const Sched& S, const Epi& E) {
    const int tid = tid_fresh(wb), wid = tid >> 6, lane = tid & 63, wr = wid >> 2, wc = wid & 3, fr = lane & 15, fq = lane >> 4;
    const int K = g.K; const int bid = blockIdx.x;
    Unit u; f32x4 acc[2][2][4][2]; bool emu_keep = false;
    for (int ui = 0; S.next(ui, u); ++ui) {
        SYNC();
        if (tid == 0) {
            if (!emu_fa[bid]) { emu_fa[bid] = (float*)malloc(256 * 1024 * 4); emu_fb[bid] = (float*)malloc(256 * 1024 * 4); }
            for (int r = 0; r < 256; ++r) for (int k = 0; k < K; ++k) { emu_fa[bid][r * K + k] = (float)g.A[((size_t)u.pa * 256 + r) * K + k]; emu_fb[bid][r * K + k] = (float)g.Bt[((size_t)u.pb * 256 + r) * K + k]; }
        }
        SYNC();
        if (!emu_keep) for (int ai = 0; ai < 2; ++ai) for (int bj = 0; bj < 2; ++bj) for (int m = 0; m < 4; ++m) for (int n = 0; n < 2; ++n) acc[ai][bj][m][n] = (f32x4){0.f, 0.f, 0.f, 0.f};
        for (int ai = 0; ai < 2; ++ai) for (int bj = 0; bj < 2; ++bj) for (int m = 0; m < 4; ++m) for (int n = 0; n < 2; ++n) for (int i = 0; i < 4; ++i) {
            const int row = 128 * ai + 64 * wr + 16 * m + fr;
            const int col = Epi::PERM ? (128 * bj + 32 * wc + 8 * fq + 4 * n + i) : (128 * bj + 32 * wc + 16 * n + 4 * fq + i);
            const float* a = emu_fa[bid] + row * K; const float* b = emu_fb[bid] + col * K; float s = 0.f;
            for (int k = u.k0; k < u.k0 + 64 * g.kt; ++k) s += a[k] * b[k];
            acc[ai][bj][m][n][i] += s; }
        if constexpr (EpiCarry<Epi>::value) emu_keep = E(acc, u, wr, wc, fr, fq); else { E(acc, u, wr, wc, fr, fq); emu_keep = false; }
    }
    SYNC();
}
#endif
}
using pg8::Unit;

struct EpiP {
    static constexpr bool PERM = true;
    half_t* P;
    __device__ __forceinline__ void operator()(const f32x4 (&acc)[2][2][4][2], const Unit& u, int wr, int wc, int fr, int fq) const {
        const int row0 = u.pm * 256 + wr * 64 + fr, col0 = u.pn * 256 + wc * 32 + 8 * fq;
        const bool tile_sg = u.pn * 256 + 256 > C_MLO;
        if (!tile_sg) {
#pragma unroll
            for (int bj = 0; bj < 2; ++bj)
#pragma unroll
                for (int ai = 0; ai < 2; ++ai)
#pragma unroll
                    for (int m = 0; m < 4; ++m) { half8 h;
#pragma unroll
                        for (int n = 0; n < 2; ++n)
#pragma unroll
                            for (int i = 0; i < 4; ++i) h[4 * n + i] = (half_t)acc[ai][bj][m][n][i];
                        *(half8*)(P + (size_t)(row0 + ai * 128 + m * 16) * NP + col0 + bj * 128) = h; }
            return;
        }
#pragma unroll
        for (int bj = 0; bj < 2; ++bj) {
            const int col = col0 + bj * 128;
            const bool sg = tile_sg && ((col >= C_GATE && col < IN_COLS) || (col >= C_MLO && col < C_MLIG));
#pragma unroll
            for (int ai = 0; ai < 2; ++ai)
#pragma unroll
                for (int m = 0; m < 4; ++m) {
                    half8 h;
#pragma unroll
                    for (int n = 0; n < 2; ++n)
#pragma unroll
                        for (int i = 0; i < 4; ++i) { float v = acc[ai][bj][m][n][i]; if (sg) v = sigm(v); h[4 * n + i] = (half_t)v; }
                    *(half8*)(P + (size_t)(row0 + ai * 128 + m * 16) * NP + col) = h;
                }
        }
    }
};
struct EpiNull {
    static constexpr bool PERM = true;
    float* sink;
    __device__ __forceinline__ void operator()(const f32x4 (&acc)[2][2][4][2], const Unit& u, int wr, int wc, int fr, int fq) const {
        f32x4 t = {0.f, 0.f, 0.f, 0.f};
#pragma unroll
        for (int ai = 0; ai < 2; ++ai)
#pragma unroll
            for (int bj = 0; bj < 2; ++bj)
#pragma unroll
                for (int m = 0; m < 4; ++m)
#pragma unroll
                    for (int n = 0; n < 2; ++n) t += acc[ai][bj][m][n];
        if (t[0] + t[1] + t[2] + t[3] == 12345.678f) sink[0] = t[0];
    }
};
struct EpiLora {
    static constexpr bool PERM = true;
    half_t* O; const float* w0; const float* a0;
    __device__ __forceinline__ void operator()(const f32x4 (&acc)[2][2][4][2], const Unit& u, int wr, int wc, int fr, int fq) const {
        const int row0 = u.pm * 256 + wr * 64 + fr, col0 = u.pn * 256 + wc * 32 + 8 * fq;
#pragma unroll
        for (int bj = 0; bj < 2; ++bj) {
            const int col = col0 + bj * 128, blk = col >> 9;
            float bias[8];
#pragma unroll
            for (int j = 0; j < 8; ++j) bias[j] = blk < 2 ? w0[col + j] : (blk < 4 ? a0[col - 1024 + j] : 0.f);
#pragma unroll
            for (int ai = 0; ai < 2; ++ai)
#pragma unroll
                for (int m = 0; m < 4; ++m) {
                    half8 h;
#pragma unroll
                    for (int n = 0; n < 2; ++n)
#pragma unroll
                        for (int i = 0; i < 4; ++i) { float v = acc[ai][bj][m][n][i] + bias[4 * n + i];
                            if (blk < 2) v = sigm(v) * 0.6065306597126334f; else if (blk < 4) v = sigm(v);
                            h[4 * n + i] = (half_t)v; }
                    *(half8*)(O + (size_t)(row0 + ai * 128 + m * 16) * 2560 + col) = h;
                }
        }
    }
};
struct EpiMerge {
    static constexpr bool PERM = true; static constexpr bool CARRY = true;
    half_t* M; const half_t* P;
    __device__ __forceinline__ bool operator()(f32x4 (&acc)[2][2][4][2], const Unit& u, int wr, int wc, int fr, int fq) const {
        const int bi = u.aux;
        const half_t* G0 = P + (size_t)(u.pm * 256 + wr * 64 + fr) * NP + C_GATE + bi * 1024 + u.pn * 256 + wc * 32 + 8 * fq;
        if (bi < 2) {
#pragma unroll
            for (int ai = 0; ai < 2; ++ai) {
                half8 gt[4][2], gn[4][2];
#pragma unroll
                for (int m = 0; m < 4; ++m)
#pragma unroll
                    for (int bj = 0; bj < 2; ++bj) { const half_t* q = G0 + (size_t)(ai * 128 + m * 16) * NP + bj * 128; gt[m][bj] = *(const half8*)q; gn[m][bj] = *(const half8*)(q + 1024); }
                EPI_LOAD_FENCE();
#pragma unroll
                for (int m = 0; m < 4; ++m)
#pragma unroll
                    for (int bj = 0; bj < 2; ++bj)
#pragma unroll
                        for (int n = 0; n < 2; ++n)
#pragma unroll
                            for (int i = 0; i < 4; ++i) acc[ai][bj][m][n][i] *= (float)gt[m][bj][4 * n + i] * frcp(fmaxf((float)gn[m][bj][4 * n + i], 6.0e-8f));
            }
            return true;
        }
        half_t* M0 = M + (size_t)(u.pm * 256 + wr * 64 + fr) * 1024 + u.pn * 256 + wc * 32 + 8 * fq;
#pragma unroll
        for (int ai = 0; ai < 2; ++ai) {
            half8 gt[4][2];
#pragma unroll
            for (int m = 0; m < 4; ++m)
#pragma unroll
                for (int bj = 0; bj < 2; ++bj) gt[m][bj] = *(const half8*)(G0 + (size_t)(ai * 128 + m * 16) * NP + bj * 128);
#pragma unroll
            for (int m = 0; m < 4; ++m)
#pragma unroll
                for (int bj = 0; bj < 2; ++bj) { half8 o;
#pragma unroll
                    for (int n = 0; n < 2; ++n)
#pragma unroll
                        for (int i = 0; i < 4; ++i) o[4 * n + i] = (half_t)((float)gt[m][bj][4 * n + i] * acc[ai][bj][m][n][i]);
                    *(half8*)(M0 + (size_t)(ai * 128 + m * 16) * 1024 + bj * 128) = o; }
        }
        return false;
    }
};
struct EpiOut {
    static constexpr bool PERM = true;
    Params p; int l, g, rg;
    __device__ __forceinline__ void operator()(const f32x4 (&acc)[2][2][4][2], const Unit& u, int wr, int wc, int fr, int fq) const {
        static_assert(RL % 256 == 0 && RCX % 256 == 0 && SEQ % 256 == 0, "row tiles must not straddle samples");
        const int r0 = u.pm * 256, cb = u.pn * 256 + wc * 32 + 8 * fq;
        half_t* dst = (half_t*)(p.ws + OFF_DX) + (size_t)(r0 + wr * 64 + fr) * D + cb; const float* md = mod_row(p, l, g, r0) + 2 * 1024 + cb;
        f32x4 mv[2][2];
#pragma unroll
        for (int bj = 0; bj < 2; ++bj)
#pragma unroll
            for (int n = 0; n < 2; ++n) mv[bj][n] = *(const f32x4*)(md + bj * 128 + 4 * n);
#pragma unroll
        for (int ai = 0; ai < 2; ++ai)
#pragma unroll
            for (int m = 0; m < 4; ++m)
#pragma unroll
                for (int bj = 0; bj < 2; ++bj) { half8 o;
#pragma unroll
                    for (int n = 0; n < 2; ++n)
#pragma unroll
                        for (int i = 0; i < 4; ++i) o[4 * n + i] = (half_t)(mv[bj][n][i] * acc[ai][bj][m][n][i]);
                    *(half8*)(dst + (size_t)(ai * 128 + m * 16) * D + bj * 128) = o; }
    }
};
struct EpiUp {
    static constexpr bool PERM = true;
    half_t* HID;
    __device__ __forceinline__ void operator()(const f32x4 (&acc)[2][2][4][2], const Unit& u, int wr, int wc, int fr, int fq) const {
        const int row0 = u.pm * 256 + wr * 64 + fr, col = u.pn * 128 + wc * 32 + 8 * fq;
#pragma unroll
        for (int ai = 0; ai < 2; ++ai)
#pragma unroll
            for (int m = 0; m < 4; ++m) {
                half8 h;
#pragma unroll
                for (int n = 0; n < 2; ++n)
#pragma unroll
                    for (int i = 0; i < 4; ++i) h[4 * n + i] = (half_t)(siluf(acc[ai][0][m][n][i]) * acc[ai][1][m][n][i]);
                *(half8*)(HID + (size_t)(row0 + ai * 128 + m * 16) * 512 + col) = h;
            }
    }
};
struct EpiDown {
    static constexpr bool PERM = true;
    half_t* YE; const float* AFF;
    __device__ __forceinline__ void operator()(const f32x4 (&acc)[2][2][4][2], const Unit& u, int wr, int wc, int fr, int fq) const {
        const int row0 = u.pm * 256 + wr * 64 + fr, col0 = u.pn * 256 + wc * 32 + 8 * fq;
        float afv[2][4];
#pragma unroll
        for (int ai = 0; ai < 2; ++ai)
#pragma unroll
            for (int m = 0; m < 4; ++m) afv[ai][m] = AFF[row0 + ai * 128 + m * 16];
        EPI_LOAD_FENCE();
#pragma unroll
        for (int ai = 0; ai < 2; ++ai)
#pragma unroll
            for (int m = 0; m < 4; ++m) {
                const size_t row = (size_t)(row0 + ai * 128 + m * 16); const float af = afv[ai][m];
#pragma unroll
                for (int bj = 0; bj < 2; ++bj) {
                    half8 h;
#pragma unroll
                    for (int n = 0; n < 2; ++n)
#pragma unroll
                        for (int i = 0; i < 4; ++i) h[4 * n + i] = (half_t)(acc[ai][bj][m][n][i] * af);
                    *(half8*)(YE + row * 1024 + col0 + bj * 128) = h;
                }
            }
    }
};

__device__ __forceinline__ void ph_mod(int wb, const Params& p, LAS unsigned char* lds) {
    LAS float* sv = (LAS float*)lds; LAS float* red = sv + (BATCH + 1) * 1024;
    const int tid = tid_fresh(wb);
    for (int i = tid; i < (BATCH + 1) * 1024; i += NT) { const int s = i >> 10, k = i & 1023; const float cv = s < BATCH ? p.in[I_C][s * 1024 + k] : p.in[I_CCTX][k]; sv[i] = siluf(cv); }
    SYNC();
    float* mod = (float*)(p.ws + OFF_MOD);
    for (int item = blockIdx.x; item < DEPTH * 48; item += gridDim.x) {
        const int l = item / 48, j = (item % 48) * 128 + (tid & 127), kq = tid >> 7;
        float acc[BATCH + 1];
#pragma unroll
        for (int s = 0; s <= BATCH; ++s) acc[s] = 0.f;
        const float* w = p.in[I_ADAW] + (size_t)l * 1024 * 6144 + j;
        for (int k = kq * 256; k < kq * 256 + 256; ++k) { const float wv = w[(size_t)k * 6144];
#pragma unroll
            for (int s = 0; s <= BATCH; ++s) acc[s] += sv[s * 1024 + k] * wv; }
#pragma unroll
        for (int s = 0; s <= BATCH; ++s) red[tid * (BATCH + 1) + s] = acc[s];
        SYNC();
        if (tid < 128) {
#pragma unroll
            for (int s = 0; s <= BATCH; ++s) { float v = p.in[I_ADAB][l * 6144 + j];
                for (int q = 0; q < 4; ++q) v += red[(q * 128 + tid) * (BATCH + 1) + s];
                mod[((size_t)l * (BATCH + 1) + s) * 6144 + j] = v; }
        }
        SYNC();
    }
}

__device__ __forceinline__ void tconv_tile(int wb, const float* src, int sld, int k0, int n0, int nvalid, half_t* dst, int dld, int drow0, int dcol0, LAS float* tile) {
    const int tid = tid_fresh(wb), r = tid >> 4, c4 = (tid & 15) * 4;
#pragma unroll
    for (int j = 0; j < 2; ++j) { const int k = r + 32 * j; f32x4 v = {0.f, 0.f, 0.f, 0.f};
        if (src && n0 + c4 < nvalid) v = *(const f32x4*)(src + (size_t)(k0 + k) * sld + n0 + c4);
        tile[k * 65 + c4] = v[0]; tile[k * 65 + c4 + 1] = v[1]; tile[k * 65 + c4 + 2] = v[2]; tile[k * 65 + c4 + 3] = v[3]; }
    SYNC();
    const int n = tid >> 3, k8 = (tid & 7) * 8; half8 h;
#pragma unroll
    for (int i = 0; i < 8; ++i) h[i] = (half_t)tile[(k8 + i) * 65 + n];
    *(half8*)(dst + (size_t)(drow0 + n) * dld + dcol0 + k8) = h;
    SYNC();
}
__device__ __forceinline__ void ph_convert(int wb, const Params& p, int l, int part, int ce, int ge, LAS unsigned char* lds) {
    LAS float* tile = (LAS float*)lds;
    constexpr int N_WIN = 16 * (NP / 64), N_WBR = 3 * 128, N_WOUT = 256, N_W13 = 2 * 2048, N_W2 = 2048, N_LORA = 240;
    constexpr int N_MID = N_WBR + N_WOUT + N_W13 + N_W2;
    half_t* ws16 = (half_t*)p.ws;
    const int nv = part == 0 ? N_WIN + N_LORA : N_MID;
    if (ce < 0) return;
    for (int v = ce; v < nv; v += ge) {
        const int item = part == 0 ? (v < N_WIN ? v : v + N_MID) : v + N_WIN;
        int it = item;
        if (it < N_WIN) { const int kt = it % 16, ntile = it / 16;
            tconv_tile(wb, p.in[I_WIN] + (size_t)l * 1024 * IN_COLS, IN_COLS, 64 * kt, 64 * ntile, IN_COLS, (half_t*)(p.ws + OFF_WIN), 1024, 64 * ntile, 64 * kt, tile); continue; }
        it -= N_WIN;
        if (it < N_WBR) { const int i = it / 128, rem = it % 128, kt = rem % 8, ntile = rem / 8;
            tconv_tile(wb, p.in[I_WBR] + (size_t)(l * 3 + i) * 512 * 1024, 1024, 64 * kt, 64 * ntile, 1024, (half_t*)(p.ws + OFF_WBR) + (size_t)i * 1024 * 512, 512, 64 * ntile, 64 * kt, tile); continue; }
        it -= N_WBR;
        if (it < N_WOUT) { const int kt = it % 16, ntile = it / 16;
            tconv_tile(wb, p.in[I_WOUT] + (size_t)l * 1024 * 1024, 1024, 64 * kt, 64 * ntile, 1024, (half_t*)(p.ws + OFF_WOUT), 1024, 64 * ntile, 64 * kt, tile); continue; }
        it -= N_WOUT;
        if (it < N_W13) { const int which = it / 2048, rem = it % 2048, e = rem / 128, r2 = rem % 128, kt = r2 % 16, ntile = r2 / 16, n0 = 64 * ntile;
            tconv_tile(wb, p.in[which ? I_W3 : I_W1] + (size_t)(l * 16 + e) * 1024 * 512, 512, 64 * kt, n0, 512, (half_t*)(p.ws + OFF_WUP) + (size_t)e * 1024 * 1024, 1024,
                       (n0 / 128) * 256 + which * 128 + (n0 % 128), 64 * kt, tile); continue; }
        it -= N_W13;
        if (it < N_W2) { const int e = it / 128, r2 = it % 128, kt = r2 % 8, ntile = r2 / 8;
            tconv_tile(wb, p.in[I_W2] + (size_t)(l * 16 + e) * 512 * 1024, 1024, 64 * kt, 64 * ntile, 1024, (half_t*)(p.ws + OFF_WDN) + (size_t)e * 1024 * 512, 512, 64 * ntile, 64 * kt, tile); continue; }
        it -= N_W2;
        { const int ntile = it / 6, kt = it % 6, n0 = 64 * ntile, blk = n0 / 512, nn0 = n0 % 512;
          const float* src = nullptr; int k0 = 0;
          if (blk == 0 && kt == 0) src = p.in[I_RWUP] + (size_t)(l * 2 + 0) * 64 * 512;
          else if (blk == 1 && kt == 1) src = p.in[I_RWUP] + (size_t)(l * 2 + 1) * 64 * 512;
          else if (blk == 2 && kt == 2) src = p.in[I_RAUP] + (size_t)(l * 2 + 0) * 64 * 512;
          else if (blk == 3 && kt == 3) src = p.in[I_RAUP] + (size_t)(l * 2 + 1) * 64 * 512;
          else if (blk == 4 && kt >= 4) { src = p.in[I_RGUP] + (size_t)l * 128 * 512; k0 = 64 * (kt - 4); }
          tconv_tile(wb, src, 512, k0, nn0, 512, (half_t*)(p.ws + OFF_WLORA), 384, n0, 64 * kt, tile); }
    }
    (void)ws16;
}

__device__ __forceinline__ void ph_xconv(int wb, const Params& p) {
    const int tid = tid_fresh(wb), wid = tid >> 6, lane = tid & 63;
    constexpr int NROW = BATCH * SEQ + BATCH * CTXL, RU = 4; const int rstep = gridDim.x * 8;
    for (int t0 = blockIdx.x * 8 + wid; t0 < NROW; t0 += rstep * RU) {
        f32x4 v[RU][4];
#pragma unroll
        for (int u = 0; u < RU; ++u) { const int t = t0 + u * rstep < NROW ? t0 + u * rstep : t0;
            const float* src = t < BATCH * SEQ ? p.in[I_X] + (size_t)t * D : p.in[I_CTX] + (size_t)(t - BATCH * SEQ) * D;
#pragma unroll
            for (int j = 0; j < 4; ++j) v[u][j] = *(const f32x4*)(src + lane * 4 + 256 * j); }
        EPI_LOAD_FENCE();
#pragma unroll
        for (int u = 0; u < RU; ++u) { const int t = t0 + u * rstep; if (t >= NROW) continue;
            half_t* dst = (half_t*)(t < BATCH * SEQ ? p.out + (size_t)t * D : (float*)(p.ws + OFF_CTXR) + (size_t)(t - BATCH * SEQ) * D) + 1024;
#pragma unroll
            for (int j = 0; j < 4; ++j) *(half4*)(dst + lane * 4 + 256 * j) = cvt4(v[u][j]); }
    }
}

__device__ __forceinline__ void ph_norm1(int wb, const Params& p, int l, int g) {
    const int tid = tid_fresh(wb), wid = tid >> 6, lane = tid & 63;
    half_t* H = (half_t*)(p.ws + OFF_H);
    constexpr int RU = 2;
    const int rstep = gridDim.x * 8; const float* gn = p.in[I_N1G] + l * D;
    const Geo gq = geo_of(g); const int RG = gq.rg, RGPg = gq.rgp;
    f32x4 gv[4];
#pragma unroll
    for (int j = 0; j < 4; ++j) gv[j] = *(const f32x4*)(gn + lane * 4 + 256 * j);
    for (int r0 = blockIdx.x * 8 + wid; r0 < RGPg; r0 += rstep * RU) {
        f32x4 v[RU][4], sh[RU][4], sc[RU][4]; float ss[RU];
#pragma unroll
        for (int u = 0; u < RU; ++u) { const int r = r0 + u * rstep < RG ? r0 + u * rstep : 0;
            const half_t* xr = res_h(p, g, r); const float* md = mod_row(p, l, g, r);
#pragma unroll
            for (int j = 0; j < 4; ++j) { const int c = lane * 4 + 256 * j; v[u][j] = h4f(*(const half4*)(xr + c)); sh[u][j] = *(const f32x4*)(md + c); sc[u][j] = *(const f32x4*)(md + 1024 + c); } }
        EPI_LOAD_FENCE();
#pragma unroll
        for (int u = 0; u < RU; ++u) { float a = 0.f;
#pragma unroll
            for (int j = 0; j < 4; ++j) a += v[u][j][0] * v[u][j][0] + v[u][j][1] * v[u][j][1] + v[u][j][2] * v[u][j][2] + v[u][j][3] * v[u][j][3];
            ss[u] = a; }
#pragma unroll
        for (int u = 0; u < RU; ++u) ss[u] = wave_sum(ss[u]);
#pragma unroll
        for (int u = 0; u < RU; ++u) { const int r = r0 + u * rstep; if (r >= RGPg) continue;
            if (r >= RG) { for (int j = 0; j < 4; ++j) *(half4*)(H + (size_t)r * D + lane * 4 + 256 * j) = (half4){0, 0, 0, 0}; continue; }
            const float rinv = frsq(ss[u] * (1.f / D) + 1e-6f);
#pragma unroll
            for (int j = 0; j < 4; ++j) { const int c = lane * 4 + 256 * j;
                *(half4*)(H + (size_t)r * D + c) = cvt4(v[u][j] * rinv * gv[j] * (sc[u][j] + 1.f) + sh[u][j]); } }
    }
#ifndef CPU_EMU
    if (WARM_WIN) {
        const uint4* wp = (const uint4*)(p.ws + OFF_WIN); unsigned acc = 0u;
        for (size_t i = (size_t)blockIdx.x * NT + tid; i < (size_t)NP * 1024 * 2 / 16; i += (size_t)gridDim.x * NT) acc ^= wp[i].x;
        if (acc == 0x9E3779B9u && tid == 99999) *(unsigned*)(p.ws + OFF_BAR + 15000) = acc;
    }
#endif
}

struct RowGeo { int gw, gh, base, gr, gc; };
__device__ __forceinline__ RowGeo row_geo(int r) {
    RowGeo q; int i;
    if (r < RL) { const int bl = r / SEQ; i = r % SEQ; q.gw = 64; q.gh = SEQ / 64; q.base = bl * SEQ; }
    else { const int rr = r - RL, bl = rr / CTXL; i = rr % CTXL; q.gw = CTXL; q.gh = 1; q.base = RL + bl * CTXL; }
    q.gr = i / q.gw; q.gc = i % q.gw; return q;
}

template <int PV = 3> __device__ __forceinline__ void ph_prep(int wb, const Params& p, int l, int RG, LAS unsigned char* lds) {
    const int tid = tid_fresh(wb), wid = tid >> 6, lane = tid & 63;
    LAS float* cw = (LAS float*)lds;
    for (int i = tid; i < 9 * 1536; i += NT) cw[i] = p.in[I_GCONV][(size_t)l * 9 * 1536 + i];
    SYNC();
    const half_t* P = (const half_t*)(p.ws + OFF_P);
    half_t* GQKV = (half_t*)(p.ws + OFF_GQKV); float* GBG = (float*)(p.ws + OFF_GBG);
    half_t* RW = (half_t*)(p.ws + OFF_RW); half_t* RLI = (half_t*)(p.ws + OFF_RLI);
    f32x4 muv[4][2]; f32x4 kkv[2];
    { const float* mu = p.in[I_RMU] + (size_t)l * 1920;
#pragma unroll
      for (int j = 0; j < 4; ++j) { const int cj = j < 3 ? j * 512 + 8 * lane : 1536 + 8 * (lane < 48 ? lane : 47); muv[j][0] = *(const f32x4*)(mu + cj); muv[j][1] = *(const f32x4*)(mu + cj + 4); }
      const float* kkw = p.in[I_RKK] + (size_t)l * 512 + 8 * lane; kkv[0] = *(const f32x4*)(kkw); kkv[1] = *(const f32x4*)(kkw + 4); }
    for (int r = blockIdx.x * 8 + wid; r < RG; r += gridDim.x * 8) {
        const RowGeo q = row_geo(r);
        if (PV & 1) {
        float acc[3][8];
#pragma unroll
        for (int j = 0; j < 3; ++j)
#pragma unroll
            for (int e = 0; e < 8; ++e) acc[j][e] = 0.f;
        for (int kh = 0; kh < 3; ++kh) { const int nr = q.gr + kh - 1; if (nr < 0 || nr >= q.gh) continue;
            for (int kw = 0; kw < 3; ++kw) { const int nc = q.gc + kw - 1; if (nc < 0 || nc >= q.gw) continue;
                const size_t nrow = (size_t)(q.base + nr * q.gw + nc);
#pragma unroll
                for (int j = 0; j < 3; ++j) { const half8 pv = *(const half8*)(P + nrow * NP + j * 512 + 8 * lane); const LAS float* w = cw + (kh * 3 + kw) * 1536 + j * 512 + 8 * lane;
#pragma unroll
                    for (int e = 0; e < 8; ++e) acc[j][e] += (float)pv[e] * w[e]; } } }
#pragma unroll
        for (int j = 0; j < 3; ++j) {
            float ss = 0.f;
#pragma unroll
            for (int e = 0; e < 8; ++e) { acc[j][e] = siluf(acc[j][e]); ss += acc[j][e] * acc[j][e]; }
            float sc = 1.f;
            if (j < 2) { ss += SHFL_XOR(ss, 1); ss += SHFL_XOR(ss, 2); ss += SHFL_XOR(ss, 4); ss += SHFL_XOR(ss, 8); sc = frsq(ss + 1e-6f) * (j == 0 ? 0.08838834764831845f : 1.f); }
            half8 h;
#pragma unroll
            for (int e = 0; e < 8; ++e) h[e] = (half_t)(acc[j][e] * sc);
            *(half8*)(GQKV + (size_t)r * 1536 + j * 512 + 8 * lane) = h;
        }
        if (lane < 16) { const float x = (float)P[(size_t)r * NP + C_BG + lane];
            float o; if (lane < 8) o = sigm(x); else { const int idx = lane - 8; o = -fexp(p.in[I_GALOG][l * 8 + idx]) * softplusf(x + p.in[I_GDTB][l * 8 + idx]); }
            GBG[(size_t)r * 16 + lane] = o; }
        }
        if (PV & 2) {
        const int nb[4] = { q.gc > 0 ? r - 1 : -1, q.gc < q.gw - 1 ? r + 1 : -1, q.gr > 0 ? r - q.gw : -1, q.gr < q.gh - 1 ? r + q.gw : -1 };
        float kmix[8];
#pragma unroll
        for (int j = 0; j < 4; ++j) {
            if (j == 3 && lane >= 48) break;
            const int cj = j < 3 ? j * 512 + 8 * lane : 1536 + 8 * lane;
            const half8 self = *(const half8*)(P + (size_t)r * NP + C_RWKV + cj);
            half8 nv[4];
#pragma unroll
            for (int d = 0; d < 4; ++d) { if (nb[d] >= 0) nv[d] = *(const half8*)(P + (size_t)nb[d] * NP + C_RWKV + cj); else nv[d] = (half8){0, 0, 0, 0, 0, 0, 0, 0}; }
            float val[8];
#pragma unroll
            for (int e = 0; e < 8; ++e) { const float s = (float)self[e], nn = (float)nv[e & 3][e]; val[e] = s + (nn - s) * muv[j][e >> 2][e & 3]; }
            half8 h;
            if (j < 3) {
#pragma unroll
                for (int e = 0; e < 8; ++e) h[e] = (half_t)val[e];
                *(half8*)(RW + ((size_t)r * 4 + j) * 512 + 8 * lane) = h;
                if (j == 1) {
#pragma unroll
                    for (int e = 0; e < 8; ++e) kmix[e] = val[e]; }
            } else {
                const int c0 = 8 * lane;
#pragma unroll
                for (int e = 0; e < 8; ++e) { float v = val[e]; if (c0 < 128) v = ftanh(v); else if (c0 >= 256) v = sigm(v); h[e] = (half_t)v; }
                *(half8*)(RLI + (size_t)r * 384 + c0) = h;
            }
        }
        { float t[8], ss = 0.f;
#pragma unroll
          for (int e = 0; e < 8; ++e) { t[e] = kmix[e] * kkv[e >> 2][e & 3]; ss += t[e] * t[e]; }
          ss += SHFL_XOR(ss, 1); ss += SHFL_XOR(ss, 2); ss += SHFL_XOR(ss, 4);
          const float sc = frsq(ss + 1e-6f); half8 h;
#pragma unroll
          for (int e = 0; e < 8; ++e) h[e] = (half_t)(t[e] * sc);
          *(half8*)(RW + ((size_t)r * 4 + 3) * 512 + 8 * lane) = h; }
        }
    }
}

__device__ __forceinline__ void ph_prep2(int wb, const Params& p, int l, int RG, LAS unsigned char* lds) {
    const int tid = tid_fresh(wb), wid = tid >> 6, lane = tid & 63;
    LAS float* cw = (LAS float*)lds;
    for (int i = tid; i < 9 * 1536; i += NT) cw[i] = p.in[I_GCONV][(size_t)l * 9 * 1536 + i];
    SYNC();
    const half_t* P = (const half_t*)(p.ws + OFF_P);
    half_t* GQKV = (half_t*)(p.ws + OFF_GQKV); float* GBG = (float*)(p.ws + OFF_GBG);
    half_t* RW = (half_t*)(p.ws + OFF_RW); half_t* RLI = (half_t*)(p.ws + OFF_RLI);
    f32x4 kkv[2]; const float* mu = p.in[I_RMU] + (size_t)l * 1920;
    { const float* kkw = p.in[I_RKK] + (size_t)l * 512 + 8 * lane; kkv[0] = *(const f32x4*)(kkw); kkv[1] = *(const f32x4*)(kkw + 4); }
    const half8 z8 = {0, 0, 0, 0, 0, 0, 0, 0};
    for (int pr = blockIdx.x * 8 + wid; pr < RG / 2; pr += gridDim.x * 8) {
        const int rA = 2 * pr; const RowGeo q = row_geo(rA);
        { float acc[2][3][8];
#pragma unroll
          for (int t = 0; t < 2; ++t)
#pragma unroll
            for (int j = 0; j < 3; ++j)
#pragma unroll
                for (int e = 0; e < 8; ++e) acc[t][j][e] = 0.f;
#pragma unroll 1
          for (int kh = 0; kh < 3; ++kh) { const int nr = q.gr + kh - 1; if (nr < 0 || nr >= q.gh) continue;
            half8 col[4][3];
#pragma unroll
            for (int cc = 0; cc < 4; ++cc) { const int nc = q.gc - 1 + cc; const bool ok = nc >= 0 && nc < q.gw; const size_t nrow = (size_t)(q.base + nr * q.gw + (ok ? nc : 0));
#pragma unroll
                for (int j = 0; j < 3; ++j) col[cc][j] = ok ? *(const half8*)(P + nrow * NP + j * 512 + 8 * lane) : z8; }
#pragma unroll
            for (int kw = 0; kw < 3; ++kw)
#pragma unroll
                for (int j = 0; j < 3; ++j) { const LAS float* w = cw + (kh * 3 + kw) * 1536 + j * 512 + 8 * lane; const f32x4 w0 = *(const LAS f32x4*)w, w1 = *(const LAS f32x4*)(w + 4);
#pragma unroll
                    for (int e = 0; e < 4; ++e) { acc[0][j][e] += (float)col[kw][j][e] * w0[e]; acc[0][j][4 + e] += (float)col[kw][j][4 + e] * w1[e];
                        acc[1][j][e] += (float)col[kw + 1][j][e] * w0[e]; acc[1][j][4 + e] += (float)col[kw + 1][j][4 + e] * w1[e]; } } }
#pragma unroll
          for (int t = 0; t < 2; ++t) { const int r = rA + t;
#pragma unroll
            for (int j = 0; j < 3; ++j) {
                float ss = 0.f;
#pragma unroll
                for (int e = 0; e < 8; ++e) { acc[t][j][e] = siluf(acc[t][j][e]); ss += acc[t][j][e] * acc[t][j][e]; }
                float sc = 1.f;
                if (j < 2) { ss += SHFL_XOR(ss, 1); ss += SHFL_XOR(ss, 2); ss += SHFL_XOR(ss, 4); ss += SHFL_XOR(ss, 8); sc = frsq(ss + 1e-6f) * (j == 0 ? 0.08838834764831845f : 1.f); }
                half8 h;
#pragma unroll
                for (int e = 0; e < 8; ++e) h[e] = (half_t)(acc[t][j][e] * sc);
                *(half8*)(GQKV + (size_t)r * 1536 + j * 512 + 8 * lane) = h;
            }
            if (lane < 16) { const float x = (float)P[(size_t)r * NP + C_BG + lane];
                float o; if (lane < 8) o = sigm(x); else { const int idx = lane - 8; o = -fexp(p.in[I_GALOG][l * 8 + idx]) * softplusf(x + p.in[I_GDTB][l * 8 + idx]); }
                GBG[(size_t)r * 16 + lane] = o; } } }
        { const int rL = q.gc > 0 ? rA - 1 : -1, rR = q.gc + 2 < q.gw ? rA + 2 : -1, rUA = q.gr > 0 ? rA - q.gw : -1, rDA = q.gr < q.gh - 1 ? rA + q.gw : -1;
          float kmix[2][8];
#pragma unroll
          for (int jj = 0; jj < 2; ++jj) {
            half8 sA[2], sB[2], vL[2], vR[2], vUA[2], vUB[2], vDA[2], vDB[2]; f32x4 mu0[2], mu1[2];
#pragma unroll
            for (int ji = 0; ji < 2; ++ji) { const int j = 2 * jj + ji;
              const int la = (j == 3 && lane >= 48) ? 0 : lane;
              const int cj = j < 3 ? j * 512 + 8 * la : 1536 + 8 * la;
              const half_t* pc = P + C_RWKV + cj; mu0[ji] = *(const f32x4*)(mu + cj); mu1[ji] = *(const f32x4*)(mu + cj + 4);
              sA[ji] = *(const half8*)(pc + (size_t)rA * NP); sB[ji] = *(const half8*)(pc + (size_t)(rA + 1) * NP);
              vL[ji] = rL >= 0 ? *(const half8*)(pc + (size_t)rL * NP) : z8; vR[ji] = rR >= 0 ? *(const half8*)(pc + (size_t)rR * NP) : z8;
              vUA[ji] = rUA >= 0 ? *(const half8*)(pc + (size_t)rUA * NP) : z8; vUB[ji] = rUA >= 0 ? *(const half8*)(pc + (size_t)(rUA + 1) * NP) : z8;
              vDA[ji] = rDA >= 0 ? *(const half8*)(pc + (size_t)rDA * NP) : z8; vDB[ji] = rDA >= 0 ? *(const half8*)(pc + (size_t)(rDA + 1) * NP) : z8; }
            EPI_LOAD_FENCE();
#pragma unroll
            for (int ji = 0; ji < 2; ++ji) { const int j = 2 * jj + ji;
              if (j == 3 && lane >= 48) continue;
#pragma unroll
              for (int t = 0; t < 2; ++t) { const int r = rA + t;
                const half8 self = t ? sB[ji] : sA[ji], n0 = t ? sA[ji] : vL[ji], n1 = t ? vR[ji] : sB[ji], n2 = t ? vUB[ji] : vUA[ji], n3 = t ? vDB[ji] : vDA[ji];
                float val[8];
#pragma unroll
                for (int e = 0; e < 8; ++e) { const float s_ = (float)self[e]; const float nn = (float)((e & 3) == 0 ? n0[e] : (e & 3) == 1 ? n1[e] : (e & 3) == 2 ? n2[e] : n3[e]); val[e] = s_ + (nn - s_) * (e < 4 ? mu0[ji][e & 3] : mu1[ji][e & 3]); }
                half8 h;
                if (j < 3) {
#pragma unroll
                    for (int e = 0; e < 8; ++e) h[e] = (half_t)val[e];
                    *(half8*)(RW + ((size_t)r * 4 + j) * 512 + 8 * lane) = h;
                    if (j == 1) {
#pragma unroll
                        for (int e = 0; e < 8; ++e) kmix[t][e] = val[e]; }
                } else {
                    const int c0 = 8 * lane;
#pragma unroll
                    for (int e = 0; e < 8; ++e) { float v = val[e]; if (c0 < 128) v = ftanh(v); else if (c0 >= 256) v = sigm(v); h[e] = (half_t)v; }
                    *(half8*)(RLI + (size_t)r * 384 + c0) = h;
                } } } }
#pragma unroll
          for (int t = 0; t < 2; ++t) { float tt[8], ss = 0.f;
#pragma unroll
            for (int e = 0; e < 8; ++e) { tt[e] = kmix[t][e] * kkv[e >> 2][e & 3]; ss += tt[e] * tt[e]; }
            ss += SHFL_XOR(ss, 1); ss += SHFL_XOR(ss, 2); ss += SHFL_XOR(ss, 4);
            const float sc = frsq(ss + 1e-6f); half8 h;
#pragma unroll
            for (int e = 0; e < 8; ++e) h[e] = (half_t)(tt[e] * sc);
            *(half8*)(RW + ((size_t)(rA + t) * 4 + 3) * 512 + 8 * lane) = h; } }
    }
}

#ifndef CPU_EMU
__device__ __forceinline__ float shfl_up_f(float v, int off, int lane) { const float o = __int_as_float(__builtin_amdgcn_ds_bpermute(((lane - off) & 63) << 2, __float_as_int(v))); return lane >= off ? o : v; }
#else
static inline float shfl_up_f(float v, int off, int lane) { const float o = emu_shfl(v, (lane - off) & 63); return lane >= off ? o : v; }
#endif
__device__ __forceinline__ void ph_wy(int wb, const Params& p, int RG, LAS unsigned char* lds) {
#ifndef CPU_EMU
    const int tid = tid_fresh(wb), wid = __builtin_amdgcn_readfirstlane(tid >> 6), lane = tid & 63, fr = lane & 15, fq = lane >> 4;
#else
    const int tid = tid_fresh(wb), wid = tid >> 6, lane = tid & 63, fr = lane & 15, fq = lane >> 4;
#endif
    const int slot = wid >> 1, d = wid & 1;
    LAS half_t* Lm = (LAS half_t*)(lds + wid * 16896);
    LAS half_t* Xm = Lm + 4096;
    LAS float* Gv = (LAS float*)(Xm + 4096);
    LAS float* Bv = Gv + 64;
    const half_t* GQKV = (const half_t*)(p.ws + OFF_GQKV); const float* GBG = (const float*)(p.ws + OFF_GBG);
    half_t* GTA = (half_t*)(p.ws + OFF_GTA); float* GG = (float*)(p.ws + OFF_GG);
    const int n_items = (RG / 64) * 4;
    SYNC();
    for (int base = blockIdx.x * 4; base < n_items; base += gridDim.x * 4) {
        const int item = base + slot;
        if (item < n_items) {
            const int cidx = item >> 2, h = item & 3, r0 = cidx * 64;
            const size_t tb = (size_t)((cidx * 4 + h) * 2 + d);
            { const int nat = d ? 63 - lane : lane; const float beta = GBG[(size_t)(r0 + nat) * 16 + d * 4 + h]; float G = GBG[(size_t)(r0 + nat) * 16 + 8 + d * 4 + h];
#pragma unroll
              for (int off = 1; off < 64; off <<= 1) { const float o = shfl_up_f(G, off, lane); G = lane >= off ? G + o : G; }
              Gv[lane] = G; Bv[lane] = beta; GG[tb * 64 + lane] = G; }
            WAVE_SYNC();
            half8 kf[4][4];
#pragma unroll
            for (int t = 0; t < 4; ++t)
#pragma unroll
                for (int ks = 0; ks < 4; ++ks) kf[t][ks] = *(const half8*)(GQKV + (size_t)(r0 + 16 * t + fr) * 1536 + 512 + h * 128 + 32 * ks + 8 * fq);
#pragma unroll
            for (int ti = 0; ti < 4; ++ti)
#pragma unroll
                for (int tj = 0; tj < 4; ++tj) {
                    if (d ? (tj < ti) : (tj > ti)) continue;
                    f32x4 acc = {0.f, 0.f, 0.f, 0.f};
#pragma unroll
                    for (int ks = 0; ks < 4; ++ks) acc = MFMA16(kf[tj][ks], kf[ti][ks], acc);
                    const int i = 16 * ti + fr, ip = d ? 63 - i : i; const float gi = Gv[ip], bi = Bv[ip]; f32x4 val;
#pragma unroll
                    for (int e = 0; e < 4; ++e) { const int j = 16 * tj + 4 * fq + e, jp = d ? 63 - j : j; val[e] = (jp < ip) ? bi * acc[e] * fexp(gi - Gv[jp]) : 0.f; }
                    if (d) *(LAS half4*)(Lm + ip * 64 + 60 - 16 * tj - 4 * fq) = cvt4((f32x4){val[3], val[2], val[1], val[0]});
                    else *(LAS half4*)(Lm + ip * 64 + 16 * tj + 4 * fq) = cvt4(val);
                }
#pragma unroll
            for (int ti = 0; ti < 4; ++ti) {
                half8 qf[4];
#pragma unroll
                for (int ks = 0; ks < 4; ++ks) qf[ks] = *(const half8*)(GQKV + (size_t)(r0 + 16 * ti + fr) * 1536 + h * 128 + 32 * ks + 8 * fq);
#pragma unroll
                for (int tj = 0; tj < 4; ++tj) {
                    const int i = 16 * ti + fr, ip = d ? 63 - i : i; f32x4 val = {0.f, 0.f, 0.f, 0.f};
                    if (!(d ? (tj < ti) : (tj > ti))) {
                        f32x4 acc = {0.f, 0.f, 0.f, 0.f};
#pragma unroll
                        for (int ks = 0; ks < 4; ++ks) acc = MFMA16(kf[tj][ks], qf[ks], acc);
                        const float gi = Gv[ip];
#pragma unroll
                        for (int e = 0; e < 4; ++e) { const int j = 16 * tj + 4 * fq + e, jp = d ? 63 - j : j; val[e] = (jp <= ip) ? acc[e] * fexp(gi - Gv[jp]) : 0.f; }
                    }
                    half_t* ap = GTA + (tb * 2 + 1) * 4096 + ip * 64;
                    if (d) *(half4*)(ap + 60 - 16 * tj - 4 * fq) = cvt4((f32x4){val[3], val[2], val[1], val[0]});
                    else *(half4*)(ap + 16 * tj + 4 * fq) = cvt4(val);
                }
            }
            WAVE_SYNC();
#pragma unroll 1
            for (int bi = 0; bi < 4; ++bi) {
                const LAS half_t* Lb = Lm + bi * 16 * 64; float a[16];
                WAVE_SYNC();
                if (bi > 0) {
#pragma unroll 1
                    for (int ct = 0; ct < bi; ++ct) { f32x4 u4 = {0.f, 0.f, 0.f, 0.f};
#pragma unroll 1
                        for (int ks = 0; ks < (bi + 1) / 2; ++ks) {
                            half8 af = ldfrag(Lm, 16 * bi, 64, 32 * ks, lane), bf = ldfrag(Lm, 16 * ct, 64, 32 * ks, lane);
#pragma unroll
                            for (int e = 0; e < 8; ++e) { const int k = 32 * ks + 8 * fq + e; const bool ka = k < 16 * bi, kb = ka && k >= 16 * ct + fr;
                                af[e] = ka ? af[e] : (half_t)0.f; bf[e] = kb ? bf[e] : (half_t)0.f; }
                            u4 = MFMA16(af, bf, u4); }
#pragma unroll
                        for (int e = 0; e < 4; ++e) Xm[(16 * bi + 4 * fq + e) * 64 + 16 * ct + fr] = (half_t)u4[e]; }
                    WAVE_SYNC();
                }
#pragma unroll
                for (int ii = 0; ii < 16; ++ii) { a[ii] = (bi * 16 + ii == lane) ? 1.f : 0.f; if (lane < 16 * bi) a[ii] -= (float)Xm[(bi * 16 + ii) * 64 + lane]; }
#pragma unroll
                for (int ii = 0; ii < 16; ++ii) { float sacc = a[ii];
#pragma unroll
                    for (int mm = 0; mm < ii; ++mm) sacc -= (float)Lb[ii * 64 + bi * 16 + mm] * a[mm];
                    a[ii] = sacc; }
#pragma unroll
                for (int ii = 0; ii < 16; ++ii) { const half_t xh = (half_t)a[ii]; Xm[(bi * 16 + ii) * 64 + lane] = xh; if (bi * 16 + ii >= lane) Lm[lane * 64 + bi * 16 + ii] = xh; }
            }
            WAVE_SYNC();
#pragma unroll 1
            for (int t = 0; t < 8; ++t) { const int v = lane + 64 * t, i = v >> 3, j8 = (v & 7) * 8; const half8 x = *(const LAS half8*)(Xm + i * 64 + j8); half8 o;
#pragma unroll
                for (int e = 0; e < 8; ++e) o[e] = (half_t)((float)x[e] * Bv[j8 + e]);
                *(half8*)(GTA + (tb * 2 + 0) * 4096 + i * 64 + j8) = o; }
            WAVE_SYNC();
        }
    }
    SYNC();
}

__device__ __forceinline__ void scan_gdn(int wb, const Params& p, int bl, int gs, int h, int d, int mode, LAS unsigned char* lds) {
    const int tid = tid_fresh(wb), wid = tid >> 6, lane = tid & 63, fr = lane & 15, fq = lane >> 4;
    constexpr int L72 = 72, L136 = 136;
    LAS half_t* kT = (LAS half_t*)lds;
    LAS half_t* vT = kT + 128 * L72;
    LAS half_t* VNs = vT + 128 * L72;
    LAS half_t* Tb = VNs + 128 * L72;
    LAS half_t* Tbe = Tb + 64 * L72;
    LAS half_t* Am = Tbe + 64 * L72;
    LAS half_t* Qg = Am + 64 * L72;
    LAS half_t* Wn = Qg + 64 * L136;
    LAS half_t* ST = Wn + 64 * L136;
    LAS float* Es = (LAS float*)(ST + 128 * L136);
    const half_t* GQKV = (const half_t*)(p.ws + OFF_GQKV);
    const half_t* GTA = (const half_t*)(p.ws + OFF_GTA); const float* GG = (const float*)(p.ws + OFF_GG);
    half_t* SOG = (half_t*)(p.ws + OFF_SOG) + (size_t)d * RGP * 512;
    SYNC();
    for (int i = tid; i < 128 * L136 / 8; i += NT) *(LAS half8*)(ST + i * 8) = (half8){0, 0, 0, 0, 0, 0, 0, 0};
    SYNC();
    f32x4 accS[8];
#pragma unroll
    for (int u = 0; u < 8; ++u) accS[u] = (f32x4){0.f, 0.f, 0.f, 0.f};
    constexpr int nchC = CTXL / 64, nchL = SEQ / 64, NCS = nchC + nchL;
    half8 pT, pA, pq[2], pk[2], pv[2]; f32x4 pg0, pg1; float pgi[2], pG = 0.f, pGl = 0.f; int nr0 = 0, cr0 = 0;
    const int ti = tid >> 3, tj8 = (tid & 7) * 8;
    auto issue = [&](int cs) {
        const bool isc = cs < nchC; const int cl = isc ? cs : cs - nchC, nch = isc ? nchC : nchL, cn = d ? nch - 1 - cl : cl;
        const int r0 = (isc ? RL + gs * CTXL : bl * SEQ) + cn * 64; nr0 = r0;
        const size_t tb = (size_t)(((r0 >> 6) * 4 + h) * 2 + d);
        pT = *(const half8*)(GTA + (tb * 2 + 0) * 4096 + ti * 64 + tj8); pA = *(const half8*)(GTA + (tb * 2 + 1) * 4096 + ti * 64 + tj8);
        pg0 = *(const f32x4*)(GG + tb * 64 + tj8); pg1 = *(const f32x4*)(GG + tb * 64 + tj8 + 4);
#pragma unroll
        for (int t = 0; t < 2; ++t) { const int v = tid + NT * t, i = v >> 4, c8 = (v & 15) * 8, nat = d ? 63 - i : i;
            pq[t] = *(const half8*)(GQKV + (size_t)(r0 + nat) * 1536 + h * 128 + c8); pgi[t] = GG[tb * 64 + i]; }
#pragma unroll
        for (int t = 0; t < 2; ++t) { const int g = wid + 8 * t, nat = d ? 63 - lane : lane;
            pk[t] = *(const half8*)(GQKV + (size_t)(r0 + nat) * 1536 + 512 + h * 128 + 8 * g); pv[t] = *(const half8*)(GQKV + (size_t)(r0 + nat) * 1536 + 1024 + h * 128 + 8 * g); }
        pG = GG[tb * 64 + (tid & 63)]; pGl = GG[tb * 64 + 63];
    };
    const int cs0 = mode == 2 ? nchC : 0, cs1 = mode == 1 ? nchC : NCS;
    const int sv = gs >= BG ? gs - BG : 0;
    f32x4* gst = (f32x4*)(p.ws + OFF_GST) + ((size_t)((sv * 4 + h) * 2 + d) * 8 + wid) * 512;
    if (mode == 2) {
#pragma unroll
        for (int u = 0; u < 8; ++u) { accS[u] = gst[u * 64 + lane]; *(LAS half4*)(ST + (16 * wid + fr) * L136 + 16 * u + 4 * fq) = cvt4(accS[u]); }
        WAVE_SYNC();
    }
    issue(cs0);
    for (int cs = cs0; cs < cs1; ++cs) {
        SYNC();
        { half8 te; const float ge[8] = {pg0[0], pg0[1], pg0[2], pg0[3], pg1[0], pg1[1], pg1[2], pg1[3]};
#pragma unroll
          for (int e = 0; e < 8; ++e) te[e] = (half_t)((float)pT[e] * fexp(ge[e]));
          *(LAS half8*)(Tb + ti * L72 + tj8) = pT; *(LAS half8*)(Tbe + ti * L72 + tj8) = te; *(LAS half8*)(Am + ti * L72 + tj8) = pA; }
#pragma unroll
        for (int t = 0; t < 2; ++t) { const int v = tid + NT * t, i = v >> 4, c8 = (v & 15) * 8; const float sc = fexp(pgi[t]); half8 o;
#pragma unroll
            for (int e = 0; e < 8; ++e) o[e] = (half_t)((float)pq[t][e] * sc);
            *(LAS half8*)(Qg + i * L136 + c8) = o; }
#pragma unroll
        for (int t = 0; t < 2; ++t) { const int g = wid + 8 * t;
#pragma unroll
            for (int e = 0; e < 8; ++e) { kT[(8 * g + e) * L72 + lane] = pk[t][e]; vT[(8 * g + e) * L72 + lane] = pv[t][e]; } }
        if (tid < 64) Es[tid] = fexp(pGl - pG);
        const float dec = fexp(pGl);
        cr0 = nr0;
        if (cs + 1 < cs1) issue(cs + 1);
        SYNC();
        { f32x4 acc[4];
#pragma unroll
          for (int t = 0; t < 4; ++t) acc[t] = (f32x4){0.f, 0.f, 0.f, 0.f};
#pragma unroll
          for (int k2 = 0; k2 < 2; ++k2) { const half8 a = ldfrag(kT, 16 * wid, L72, 32 * k2, lane);
#pragma unroll
              for (int t = 0; t < 4; ++t) acc[t] = MFMA16(a, ldfrag(Tbe, 16 * t, L72, 32 * k2, lane), acc[t]); }
#pragma unroll
          for (int t = 0; t < 4; ++t) *(LAS half4*)(Wn + (16 * t + fr) * L136 + 16 * wid + 4 * fq) = cvt4(-acc[t]); }
        SYNC();
        { f32x4 acc[4];
#pragma unroll
          for (int t = 0; t < 4; ++t) acc[t] = (f32x4){0.f, 0.f, 0.f, 0.f};
#pragma unroll
          for (int k2 = 0; k2 < 2; ++k2) { const half8 b = ldfrag(vT, 16 * wid, L72, 32 * k2, lane);
#pragma unroll
              for (int t = 0; t < 4; ++t) acc[t] = MFMA16(ldfrag(Tb, 16 * t, L72, 32 * k2, lane), b, acc[t]); }
#pragma unroll
          for (int k4 = 0; k4 < 4; ++k4) { const half8 b = ldfrag(ST, 16 * wid, L136, 32 * k4, lane);
#pragma unroll
              for (int t = 0; t < 4; ++t) acc[t] = MFMA16(ldfrag(Wn, 16 * t, L136, 32 * k4, lane), b, acc[t]); }
          WAVE_SYNC();
#pragma unroll
          for (int t = 0; t < 4; ++t) { const f32x4 es = *(const LAS f32x4*)(Es + 16 * t + 4 * fq);
              *(LAS half4*)(vT + (16 * wid + fr) * L72 + 16 * t + 4 * fq) = cvt4(acc[t]); *(LAS half4*)(VNs + (16 * wid + fr) * L72 + 16 * t + 4 * fq) = cvt4(acc[t] * es); } }
        WAVE_SYNC();
        { f32x4 acc[4];
#pragma unroll
          for (int t = 0; t < 4; ++t) acc[t] = (f32x4){0.f, 0.f, 0.f, 0.f};
#pragma unroll
          for (int k4 = 0; k4 < 4; ++k4) { const half8 a = ldfrag(ST, 16 * wid, L136, 32 * k4, lane);
#pragma unroll
              for (int t = 0; t < 4; ++t) acc[t] = MFMA16(a, ldfrag(Qg, 16 * t, L136, 32 * k4, lane), acc[t]); }
#pragma unroll
          for (int k2 = 0; k2 < 2; ++k2) { const half8 a = ldfrag(vT, 16 * wid, L72, 32 * k2, lane);
#pragma unroll
              for (int t = 0; t < 4; ++t) acc[t] = MFMA16(a, ldfrag(Am, 16 * t, L72, 32 * k2, lane), acc[t]); }
#pragma unroll
          for (int t = 0; t < 4; ++t) { const int i = 16 * t + fr, nat = d ? 63 - i : i;
              *(half4*)(SOG + (size_t)(cr0 + nat) * 512 + h * 128 + 16 * wid + 4 * fq) = cvt4(acc[t]); } }
#pragma unroll
        for (int u = 0; u < 8; ++u) accS[u] = accS[u] * dec;
#pragma unroll
        for (int k2 = 0; k2 < 2; ++k2) { const half8 b = ldfrag(VNs, 16 * wid, L72, 32 * k2, lane);
#pragma unroll
            for (int u = 0; u < 8; ++u) accS[u] = MFMA16(ldfrag(kT, 16 * u, L72, 32 * k2, lane), b, accS[u]); }
        WAVE_SYNC();
#pragma unroll
        for (int u = 0; u < 8; ++u) *(LAS half4*)(ST + (16 * wid + fr) * L136 + 16 * u + 4 * fq) = cvt4(accS[u]);
        WAVE_SYNC();
    }
    if (mode == 1) {
#pragma unroll
        for (int u = 0; u < 8; ++u) gst[u * 64 + lane] = accS[u];
    }
}

__device__ __forceinline__ void scan_mlstm(int wb, const Params& p, int l, int bl, int gs, int h, int d, int mode, LAS unsigned char* lds) {
    const int tid = tid_fresh(wb), wid = tid >> 6, lane = tid & 63, fr = lane & 15, fq = lane >> 4;
    constexpr int L72 = 72;
    LAS half_t* q = (LAS half_t*)lds;
    LAS half_t* k = q + 64 * L72;
    LAS half_t* kT = k + 64 * L72;
    LAS half_t* vT = kT + 64 * L72;
    LAS half_t* Pm = vT + 128 * L72;
    LAS half_t* CT = Pm + 64 * L72;
    LAS half_t* nvec = CT + 128 * L72 + 64 * wid;
    LAS float* lfv = (LAS float*)(CT + 128 * L72 + 64 * 8);
    LAS float* igv = lfv + 64;
    LAS float* rowv = igv + 64;
    LAS float* colv = rowv + 64;
    LAS float* interv = colv + 64;
    LAS float* emtv = interv + 64;
    LAS float* wscv = emtv + 64;
    const half_t* P = (const half_t*)(p.ws + OFF_P);
    half_t* SOM = (half_t*)(p.ws + OFF_SOM) + (size_t)d * RGP * 512;
    const float ibias = p.in[I_MIB][l * 8 + d * 4 + h], fbias = p.in[I_MFB][l * 8 + d * 4 + h];
    SYNC();
    for (int i = tid; i < 128 * L72 / 8; i += NT) *(LAS half8*)(CT + i * 8) = (half8){0, 0, 0, 0, 0, 0, 0, 0};
    nvec[lane] = (half_t)0.f;
    f32x4 accC[4], accN[4];
#pragma unroll
    for (int u = 0; u < 4; ++u) { accC[u] = (f32x4){0.f, 0.f, 0.f, 0.f}; accN[u] = (f32x4){0.f, 0.f, 0.f, 0.f}; }
    float m = 0.f;
    constexpr int nchC = CTXL / 64, nchL = SEQ / 64, NCS = nchC + nchL;
    half8 pq, pk, pv[2]; half_t pig = (half_t)0.f, pfg = (half_t)0.f; int nr0 = 0, cr0 = 0;
    const half8 ones = {1, 1, 1, 1, 1, 1, 1, 1};
    auto issue = [&](int cs) {
        const bool isc = cs < nchC; const int cl = isc ? cs : cs - nchC, nch = isc ? nchC : nchL, cn = d ? nch - 1 - cl : cl;
        const int r0 = (isc ? RL + gs * CTXL : bl * SEQ) + cn * 64; nr0 = r0;
        const int nat = d ? 63 - lane : lane; const half_t* pr = P + (size_t)(r0 + nat) * NP + C_ML;
        pq = *(const half8*)(pr + h * 64 + 8 * wid); pk = *(const half8*)(pr + 256 + h * 64 + 8 * wid);
        pv[0] = *(const half8*)(pr + 512 + h * 128 + 8 * wid); pv[1] = *(const half8*)(pr + 512 + h * 128 + 8 * (wid + 8));
        if (tid < 64) { const half_t* pg = P + (size_t)(r0 + (d ? 63 - tid : tid)) * NP; pig = pg[C_MLIG + d * 4 + h]; pfg = pg[C_MLFG + d * 4 + h]; }
    };
    const int cs0 = mode == 2 ? nchC : 0, cs1 = mode == 1 ? nchC : NCS;
    const int sv = gs >= BG ? gs - BG : 0;
    f32x4* mst = (f32x4*)(p.ws + OFF_MST) + ((size_t)((sv * 4 + h) * 2 + d) * 8 + wid) * 512; float* msm = (float*)(p.ws + OFF_MSM) + ((sv * 4 + h) * 2 + d);
    SYNC();
    if (mode == 2) {
#pragma unroll
        for (int u = 0; u < 4; ++u) { accC[u] = mst[u * 64 + lane]; accN[u] = mst[(4 + u) * 64 + lane];
            *(LAS half4*)(CT + (16 * wid + fr) * L72 + 16 * u + 4 * fq) = cvt4(accC[u]); if (fr == 0) *(LAS half4*)(nvec + 16 * u + 4 * fq) = cvt4(accN[u]); }
        m = *msm;
        WAVE_SYNC();
    }
    issue(cs0);
    for (int cs = cs0; cs < cs1; ++cs) {
        SYNC();
        { half8 qs;
#pragma unroll
          for (int e = 0; e < 8; ++e) qs[e] = (half_t)((float)pq[e] * 0.125f);
          *(LAS half8*)(q + lane * L72 + 8 * wid) = qs; *(LAS half8*)(k + lane * L72 + 8 * wid) = pk;
#pragma unroll
          for (int e = 0; e < 8; ++e) { kT[(8 * wid + e) * L72 + lane] = pk[e]; vT[(8 * wid + e) * L72 + lane] = pv[0][e]; vT[(8 * (wid + 8) + e) * L72 + lane] = pv[1][e]; } }
        if (tid < 64) { igv[tid] = (float)pig + ibias; lfv[tid] = -softplusf(-((float)pfg + fbias)); }
        cr0 = nr0;
        if (cs + 1 < cs1) issue(cs + 1);
        SYNC();
        float dec;
        { float b = lfv[lane];
#pragma unroll
          for (int off = 1; off < 64; off <<= 1) { const float o = shfl_up_f(b, off, lane); b = lane >= off ? b + o : b; }
          const float cm = igv[lane] - b; float pm = cm;
#pragma unroll
          for (int off = 1; off < 64; off <<= 1) { const float o = shfl_up_f(pm, off, lane); pm = lane >= off ? fmaxf(pm, o) : pm; }
#ifndef CPU_EMU
          const float b_last = __int_as_float(__builtin_amdgcn_readlane(__float_as_int(b), 63)), pm_last = __int_as_float(__builtin_amdgcn_readlane(__float_as_int(pm), 63));
#else
          const float b_last = emu_shfl(b, 63), pm_last = emu_shfl(pm, 63);
#endif
          const float mt = fmaxf(b + m, b + pm), m_new = fmaxf(b_last + m, b_last + pm_last);
          rowv[lane] = b - mt; colv[lane] = cm; interv[lane] = fexp(b + m - mt); emtv[lane] = fexp(-mt); wscv[lane] = fexp(b_last + cm - m_new);
          dec = fexp(b_last + m - m_new); m = m_new; }
        WAVE_SYNC();
#pragma unroll
        for (int tt = 0; tt < 2; ++tt) { const int idx = 2 * wid + tt, ti = idx >> 2, tj = idx & 3;
            f32x4 acc = {0.f, 0.f, 0.f, 0.f};
            if (tj <= ti) {
#pragma unroll
                for (int k2 = 0; k2 < 2; ++k2) acc = MFMA16(ldfrag(k, 16 * tj, L72, 32 * k2, lane), ldfrag(q, 16 * ti, L72, 32 * k2, lane), acc);
                const int i = 16 * ti + fr; const float rv = rowv[i]; const f32x4 cv = *(const LAS f32x4*)(colv + 16 * tj + 4 * fq);
#pragma unroll
                for (int e = 0; e < 4; ++e) { const int j = 16 * tj + 4 * fq + e; acc[e] = (j <= i) ? acc[e] * fexp(rv + cv[e]) : 0.f; }
            }
            *(LAS half4*)(Pm + (16 * ti + fr) * L72 + 16 * tj + 4 * fq) = cvt4(acc); }
        SYNC();
        { f32x4 a1[4], a2[4], d1[4], d2[4];
#pragma unroll
          for (int t = 0; t < 4; ++t) { a1[t] = (f32x4){0.f, 0.f, 0.f, 0.f}; a2[t] = a1[t]; d1[t] = a1[t]; d2[t] = a1[t]; }
#pragma unroll
          for (int k2 = 0; k2 < 2; ++k2) { const half8 ac = ldfrag(CT, 16 * wid, L72, 32 * k2, lane), av = ldfrag(vT, 16 * wid, L72, 32 * k2, lane);
              const half8 an = *(const LAS half8*)(nvec + 32 * k2 + 8 * fq);
#pragma unroll
              for (int t = 0; t < 4; ++t) { const half8 bq = ldfrag(q, 16 * t, L72, 32 * k2, lane), bp = ldfrag(Pm, 16 * t, L72, 32 * k2, lane);
                  a1[t] = MFMA16(ac, bq, a1[t]); a2[t] = MFMA16(av, bp, a2[t]); d1[t] = MFMA16(an, bq, d1[t]); d2[t] = MFMA16(ones, bp, d2[t]); } }
#pragma unroll
          for (int t = 0; t < 4; ++t) { const int i = 16 * t + fr, nat = d ? 63 - i : i; const float it = interv[i];
              const float den = it * d1[t][0] + d2[t][0], dn = frcp(fmaxf(fabsf(den), emtv[i]));
              *(half4*)(SOM + (size_t)(cr0 + nat) * 512 + h * 128 + 16 * wid + 4 * fq) = cvt4((a1[t] * it + a2[t]) * dn); } }
#pragma unroll
        for (int u = 0; u < 4; ++u) { accC[u] = accC[u] * dec; accN[u] = accN[u] * dec; }
#pragma unroll
        for (int k2 = 0; k2 < 2; ++k2) { const half8 bv = ldfrag(vT, 16 * wid, L72, 32 * k2, lane);
            const f32x4 w0 = *(const LAS f32x4*)(wscv + 32 * k2 + 8 * fq), w1 = *(const LAS f32x4*)(wscv + 32 * k2 + 8 * fq + 4);
#pragma unroll
            for (int u = 0; u < 4; ++u) { const half8 raw = ldfrag(kT, 16 * u, L72, 32 * k2, lane); half8 ak;
#pragma unroll
                for (int e = 0; e < 4; ++e) { ak[e] = (half_t)((float)raw[e] * w0[e]); ak[4 + e] = (half_t)((float)raw[4 + e] * w1[e]); }
                accC[u] = MFMA16(ak, bv, accC[u]); accN[u] = MFMA16(ak, ones, accN[u]); } }
        WAVE_SYNC();
#pragma unroll
        for (int u = 0; u < 4; ++u) { *(LAS half4*)(CT + (16 * wid + fr) * L72 + 16 * u + 4 * fq) = cvt4(accC[u]);
            if (fr == 0) *(LAS half4*)(nvec + 16 * u + 4 * fq) = cvt4(accN[u]); }
        WAVE_SYNC();
    }
    if (mode == 1) {
#pragma unroll
        for (int u = 0; u < 4; ++u) { mst[u * 64 + lane] = accC[u]; mst[(4 + u) * 64 + lane] = accN[u]; }
        if (tid == 0) *msm = m;
    }
}

#ifndef CPU_EMU
template <int CTRL> __device__ __forceinline__ float dpp_f(float v) { return __int_as_float(__builtin_amdgcn_update_dpp(0, __float_as_int(v), CTRL, 0xf, 0xf, true)); }
#define DPPX1(v) dpp_f<0xB1>(v)
#define DPPX2(v) dpp_f<0x4E>(v)
#define DPPHM(v) dpp_f<0x141>(v)
#define RED8(v) do { v += dpp_f<0xB1>(v); v += dpp_f<0x4E>(v); v += dpp_f<0x141>(v); } while (0)
#define RED16(v) do { RED8(v); v += dpp_f<0x140>(v); } while (0)
#else
#define DPPX1(v) emu_shfl_xor((v), 1)
#define DPPX2(v) emu_shfl_xor((v), 2)
#define DPPHM(v) emu_shfl_xor((v), 7)
#define RED8(v) do { v += emu_shfl_xor(v, 1); v += emu_shfl_xor(v, 2); v += emu_shfl_xor(v, 7); } while (0)
#define RED16(v) do { RED8(v); v += emu_shfl_xor(v, 15); } while (0)
#endif
__device__ __forceinline__ void scan_rwkv(int wb, const Params& p, int l, int bl, int gs, int h, int d, int row0, int ncw, int mode, LAS unsigned char* lds) {
#ifndef CPU_EMU
    const int tid = tid_fresh(wb), wid = __builtin_amdgcn_readfirstlane(tid >> 6), lane = tid & 63;
#else
    const int tid = tid_fresh(wb), wid = tid >> 6, lane = tid & 63;
#endif
    constexpr int NB = 32, NPR = NB / 2, REC = 712;
    LAS float* st = (LAS float*)lds;
    const half_t* RW = (const half_t*)(p.ws + OFF_RW); const half_t* RLO = (const half_t*)(p.ws + OFF_RLO);
    bf16_t* SOR = (bf16_t*)(p.ws + OFF_SOR) + (size_t)d * RGP * 512;
    const int nb0 = mode == 2 ? CTXL / NB : 0, nb1 = mode == 1 ? CTXL / NB : (CTXL + SEQ) / NB;
    auto step_row = [&](int sidx) -> size_t { return sidx < CTXL ? (size_t)(RL + gs * CTXL + (d ? CTXL - 1 - sidx : sidx)) : (size_t)(bl * SEQ + (d ? SEQ - 1 - (sidx - CTXL) : sidx - CTXL)); };
    SYNC();
    if (wid >= 4) {
        const int pt = tid - 256, lp = pt >> 4, cq = pt & 15, lc = h * 64 + 4 * cq;
        const f32x4 ka = *(const f32x4*)(p.in[I_RKA] + (size_t)l * 512 + lc);
        half4 g_r[2], g_k[2], g_v[2], g_kk[2], g_e[2], g_a[2];
        auto issue = [&](int n) {
#pragma unroll
            for (int q = 0; q < 2; ++q) { const size_t row = step_row(n * NB + 2 * lp + q);
                g_r[q] = *(const half4*)(RW + (row * 4 + 0) * 512 + lc); g_k[q] = *(const half4*)(RW + (row * 4 + 1) * 512 + lc); g_v[q] = *(const half4*)(RW + (row * 4 + 2) * 512 + lc); g_kk[q] = *(const half4*)(RW + (row * 4 + 3) * 512 + lc);
                g_e[q] = *(const half4*)(RLO + row * 2560 + d * 512 + lc); g_a[q] = *(const half4*)(RLO + row * 2560 + 1024 + d * 512 + lc); } };
        auto stage = [&](int buf) { LAS float* o = st + (buf * NPR + lp) * REC + 4 * cq;
            f32x4 oa, owa, owr, owwr, oww, obw, okw, obu, oku, ovt, ovu; float c[8];
#pragma unroll
            for (int i = 0; i < 8; ++i) c[i] = 0.f;
#pragma unroll
            for (int e = 0; e < 4; ++e) {
                const float rt = (float)g_r[0][e], kt = (float)g_k[0][e], kkt = (float)g_kk[0][e], at = (float)g_a[0][e], wt = fexp(-(float)g_e[0][e]);
                const float ru = (float)g_r[1][e], ku = (float)g_k[1][e], kku = (float)g_kk[1][e], au = (float)g_a[1][e], wu = fexp(-(float)g_e[1][e]);
                const float kdt = kt * (1.f + (at - 1.f) * ka[e]), bt = kkt * at, kdu = ku * (1.f + (au - 1.f) * ka[e]), bu = kku * au, amu = -kku;
                const float bw = bt * wu, kw = kdt * wu;
                oa[e] = -kkt; owa[e] = wt * amu; owr[e] = wt * rt; owwr[e] = wt * wu * ru; oww[e] = wt * wu; obw[e] = bw; okw[e] = kw; obu[e] = bu; oku[e] = kdu; ovt[e] = (float)g_v[0][e]; ovu[e] = (float)g_v[1][e];
                c[0] += bt * amu; c[1] += kdt * amu; c[2] += bt * rt; c[3] += kdt * rt; c[4] += bw * ru; c[5] += kw * ru; c[6] += bu * ru; c[7] += kdu * ru; }
            *(LAS f32x4*)(o) = oa; *(LAS f32x4*)(o + 64) = owa; *(LAS f32x4*)(o + 128) = owr; *(LAS f32x4*)(o + 192) = owwr; *(LAS f32x4*)(o + 256) = oww; *(LAS f32x4*)(o + 320) = obw;
            *(LAS f32x4*)(o + 384) = okw; *(LAS f32x4*)(o + 448) = obu; *(LAS f32x4*)(o + 512) = oku; *(LAS f32x4*)(o + 576) = ovt; *(LAS f32x4*)(o + 640) = ovu;
#pragma unroll
            for (int i = 0; i < 8; ++i) RED16(c[i]);
            if (cq == 0) { LAS float* sc = st + (buf * NPR + lp) * REC + 704;
                *(LAS f32x4*)(sc) = (f32x4){c[0], c[1], c[2] * 0.125f, c[3] * 0.125f}; *(LAS f32x4*)(sc + 4) = (f32x4){c[4] * 0.125f, c[5] * 0.125f, c[6] * 0.125f, c[7] * 0.125f}; } };
        issue(nb0); stage(nb0 & 1);
        if (nb0 + 1 < nb1) issue(nb0 + 1);
        SYNC();
        for (int n = nb0; n < nb1; ++n) {
            if (n + 1 < nb1) { stage((n + 1) & 1); if (n + 2 < nb1) issue(n + 2); }
            SYNC();
        }
    } else if (wid >= ncw) {
        SYNC();
        for (int n = nb0; n < nb1; ++n) SYNC();
    } else {
        const int rr = row0 + 8 * wid + (lane >> 3), ks = lane & 7;
        f32x2 s2[4];
#pragma unroll
        for (int e = 0; e < 4; ++e) s2[e] = (f32x2){0.f, 0.f};
        const int sv = gs >= BG ? gs - BG : 0;
        f32x2* rst = (f32x2*)((float*)(p.ws + OFF_RST) + ((size_t)((sv * 8 + h) * 2 + d) * 64 + rr) * 64 + 8 * ks);
        if (mode == 2) {
#pragma unroll
            for (int e = 0; e < 4; ++e) s2[e] = rst[e]; }
        SYNC();
#define LO2(v) __builtin_shufflevector(v, v, 0, 1)
#define HI2(v) __builtin_shufflevector(v, v, 2, 3)
        for (int n = nb0; n < nb1; ++n) {
            const int buf = n & 1;
            f32x4 xa0, xa1, xwa0, xwa1, xwr0, xwr1, xwq0, xwq1, ya0, ya1, ywa0, ywa1, ywr0, ywr1, ywq0, ywq1;
#define RWKV_LOADD(A0, A1, WA0, WA1, WR0, WR1, WQ0, WQ1, P_) do { const LAS float* o_ = st + (buf * NPR + (P_)) * REC + 8 * ks; \
                A0 = *(const LAS f32x4*)(o_); A1 = *(const LAS f32x4*)(o_ + 4); WA0 = *(const LAS f32x4*)(o_ + 64); WA1 = *(const LAS f32x4*)(o_ + 68); \
                WR0 = *(const LAS f32x4*)(o_ + 128); WR1 = *(const LAS f32x4*)(o_ + 132); WQ0 = *(const LAS f32x4*)(o_ + 192); WQ1 = *(const LAS f32x4*)(o_ + 196); } while (0)
#define RWKV_PAIR(A0, A1, WA0, WA1, WR0, WR1, WQ0, WQ1, PI, J) do { \
                const LAS float* o = st + (buf * NPR + (PI)) * REC; \
                const f32x4 ww0 = *(const LAS f32x4*)(o + 256 + 8 * ks), ww1 = *(const LAS f32x4*)(o + 260 + 8 * ks), bw0 = *(const LAS f32x4*)(o + 320 + 8 * ks), bw1 = *(const LAS f32x4*)(o + 324 + 8 * ks); \
                const f32x4 kw0 = *(const LAS f32x4*)(o + 384 + 8 * ks), kw1 = *(const LAS f32x4*)(o + 388 + 8 * ks), bu0 = *(const LAS f32x4*)(o + 448 + 8 * ks), bu1 = *(const LAS f32x4*)(o + 452 + 8 * ks); \
                const f32x4 ku0 = *(const LAS f32x4*)(o + 512 + 8 * ks), ku1 = *(const LAS f32x4*)(o + 516 + 8 * ks); \
                const float vt = o[576 + rr], vu = o[640 + rr]; const f32x4 sc0 = *(const LAS f32x4*)(o + 704), sc1 = *(const LAS f32x4*)(o + 708); \
                const f32x2 e1 = (s2[0] * LO2(A0) + s2[1] * HI2(A0)) + (s2[2] * LO2(A1) + s2[3] * HI2(A1)); \
                const f32x2 e2 = (s2[0] * LO2(WA0) + s2[1] * HI2(WA0)) + (s2[2] * LO2(WA1) + s2[3] * HI2(WA1)); \
                const f32x2 e3 = (s2[0] * LO2(WR0) + s2[1] * HI2(WR0)) + (s2[2] * LO2(WR1) + s2[3] * HI2(WR1)); \
                const f32x2 e4 = (s2[0] * LO2(WQ0) + s2[1] * HI2(WQ0)) + (s2[2] * LO2(WQ1) + s2[3] * HI2(WQ1)); \
                float sat = e1[0] + e1[1], d2 = e2[0] + e2[1]; \
                RED8(sat); RED8(d2); \
                const f32x2 vtv = {vt, vt}, vuv = {vu, vu}; \
                const f32x2 pre0 = (s2[0] * LO2(ww0) + vtv * LO2(kw0)) + vuv * LO2(ku0), pre1 = (s2[1] * HI2(ww0) + vtv * HI2(kw0)) + vuv * HI2(ku0); \
                const f32x2 pre2 = (s2[2] * LO2(ww1) + vtv * LO2(kw1)) + vuv * LO2(ku1), pre3 = (s2[3] * HI2(ww1) + vtv * HI2(kw1)) + vuv * HI2(ku1); \
                const float ypt = (e3[0] + e3[1]) + vt * sc0[3], ypu = (e4[0] + e4[1]) + (vt * sc1[1] + vu * sc1[3]); \
                const float sau = (d2 + vt * sc0[1]) + sat * sc0[0]; \
                const f32x2 satv = {sat, sat}, sauv = {sau, sau}; \
                s2[0] = (satv * LO2(bw0) + pre0) + sauv * LO2(bu0); s2[1] = (satv * HI2(bw0) + pre1) + sauv * HI2(bu0); \
                s2[2] = (satv * LO2(bw1) + pre2) + sauv * LO2(bu1); s2[3] = (satv * HI2(bw1) + pre3) + sauv * HI2(bu1); \
                yp[2 * (J)] = ypt + sat * sc0[2]; yp[2 * (J) + 1] = (ypu + sat * sc1[0]) + sau * sc1[2]; } while (0)
#ifndef CPU_EMU
#define RWKV_FENCE() asm volatile("" ::: "memory")
#else
#define RWKV_FENCE()
#endif
            RWKV_LOADD(xa0, xa1, xwa0, xwa1, xwr0, xwr1, xwq0, xwq1, 0);
#pragma unroll 1
            for (int th = 0; th < NPR / 2; ++th) {
                float yp[4];
                RWKV_LOADD(ya0, ya1, ywa0, ywa1, ywr0, ywr1, ywq0, ywq1, 2 * th + 1);
                RWKV_PAIR(xa0, xa1, xwa0, xwa1, xwr0, xwr1, xwq0, xwq1, 2 * th, 0);
                RWKV_FENCE();
                { const int pn = 2 * th + 2 < NPR ? 2 * th + 2 : NPR - 1;
                  RWKV_LOADD(xa0, xa1, xwa0, xwa1, xwr0, xwr1, xwq0, xwq1, pn); }
                RWKV_PAIR(ya0, ya1, ywa0, ywa1, ywr0, ywr1, ywq0, ywq1, 2 * th + 1, 1);
                RWKV_FENCE();
                { const bool c0 = ((ks ^ (ks >> 2)) & 1) != 0, c1 = (((ks >> 1) ^ (ks >> 2)) & 1) != 0;
                  const float k20 = (c0 ? yp[1] : yp[0]) + DPPX1(c0 ? yp[0] : yp[1]), k21 = (c0 ? yp[3] : yp[2]) + DPPX1(c0 ? yp[2] : yp[3]);
                  float k1 = (c1 ? k21 : k20) + DPPX2(c1 ? k20 : k21);
                  k1 += DPPHM(k1);
                  if (ks < 4) SOR[step_row(n * NB + th * 4 + ks) * 512 + h * 64 + rr] = f2bf(k1); }
            }
#undef RWKV_PAIR
#undef RWKV_FENCE
#undef RWKV_LOADD
            SYNC();
        }
#undef LO2
#undef HI2
        if (mode == 1) {
#pragma unroll
            for (int e = 0; e < 4; ++e) rst[e] = s2[e]; }
    }
}

__device__ __forceinline__ void ph_scan(int wb, const Params& p, int l, int g, LAS unsigned char* lds) {
    constexpr int NL_R = BG * 32, NL_G = BG * 8, NL_M = BG * 8, NLONG = NL_R + NL_G + NL_M;
    const int G = gridDim.x, c = blockIdx.x;
    const int nsm = g == 0 ? BATCH - BG : 0, NS_R = nsm * 32, NS_G = nsm * 8, NS_M = nsm * 8;
    const int nfree = G - NLONG, sstr = nfree > 0 ? nfree : G, sst = nfree > 0 ? c - NLONG : c;
    const bool has_short = nfree > 0 ? c >= NLONG : true;
    const int lmode = g == 0 ? 0 : 2;
    auto first = [](int lo, int st, int stride) { return lo + (((st - lo) % stride) + stride) % stride; };
#pragma unroll 1
    for (int q = 0; q < 2; ++q) {
        const int lo = 0, n = q ? (has_short ? NS_R : 0) : NL_R, st = q ? sst : c, str = q ? sstr : G;
        if (!(SKIP_MASK & 65536)) for (int it = first(lo, st, str); it < n; it += str) REPS(65536) {
            const int half = it & 1, d = (it >> 1) & 1, h = (it >> 2) & 7, b = it >> 5;
            scan_rwkv(wb, p, l, q ? 0 : b, q ? BG + b : g * BG + b, h, d, 32 * half, 4, q ? 1 : lmode, lds); SYNC(); }
    }
#pragma unroll 1
    for (int q = 0; q < 2; ++q) {
        const int lo = q ? NS_R : NL_R, n = q ? (has_short ? NS_R + NS_G : 0) : NL_R + NL_G, st = q ? sst : c, str = q ? sstr : G;
        if (!(SKIP_MASK & 131072)) for (int it = first(lo, st, str); it < n; it += str) REPS(131072) {
            const int i2 = it - lo, d = i2 & 1, h = (i2 >> 1) & 3, b = i2 >> 3;
            scan_gdn(wb, p, q ? 0 : b, q ? BG + b : g * BG + b, h, d, q ? 1 : lmode, lds); SYNC(); }
    }
#pragma unroll 1
    for (int q = 0; q < 2; ++q) {
        const int lo = q ? NS_R + NS_G : NL_R + NL_G, n = q ? (has_short ? NS_R + NS_G + NS_M : 0) : NLONG, st = q ? sst : c, str = q ? sstr : G;
        if (!(SKIP_MASK & 262144)) for (int it = first(lo, st, str); it < n; it += str) REPS(262144) {
            const int i2 = it - lo, d = i2 & 1, h = (i2 >> 1) & 3, b = i2 >> 3;
            scan_mlstm(wb, p, l, q ? 0 : b, q ? BG + b : g * BG + b, h, d, q ? 1 : lmode, lds); SYNC(); }
    }
    if (g == 0 && !(SKIP_MASK & 2)) ph_convert(wb, p, l, 1, nfree > 0 ? c - NLONG : c, nfree > 0 ? nfree : G, lds);
    if (g == NGROUP - 1 && l + 1 < DEPTH && !(SKIP_MASK & 2)) ph_convert(wb, p, l + 1, 0, nfree > 0 ? c - NLONG : c, nfree > 0 ? nfree : G, lds);
}

__device__ __forceinline__ void ph_finish(int wb, const Params& p, int l, int nrows) {
    const int tid = tid_fresh(wb), wid = tid >> 6, lane = tid & 63, c = 8 * lane;
    const half_t* P = (const half_t*)(p.ws + OFF_P); const half_t* RW = (const half_t*)(p.ws + OFF_RW); const half_t* RLO = (const half_t*)(p.ws + OFF_RLO);
    const half_t* SOG = (const half_t*)(p.ws + OFF_SOG); const half_t* SOM = (const half_t*)(p.ws + OFF_SOM); const bf16_t* SOR = (const bf16_t*)(p.ws + OFF_SOR);
    half_t* BR = (half_t*)(p.ws + OFF_BR);
    float c_gn[8], c_mn[8], c_ka[8], c_rk[8], c_lg[8], c_lb[8];
#pragma unroll
    for (int e = 0; e < 8; ++e) { c_gn[e] = p.in[I_GNG][l * 128 + (c & 127) + e]; c_mn[e] = p.in[I_MNG][l * 128 + (c & 127) + e]; c_ka[e] = p.in[I_RKA][(size_t)l * 512 + c + e];
        c_rk[e] = p.in[I_RRK][(size_t)l * 512 + c + e]; c_lg[e] = p.in[I_RLNG][(size_t)l * 512 + c + e]; c_lb[e] = p.in[I_RLNB][(size_t)l * 512 + c + e]; }
    for (int r = blockIdx.x * 8 + wid; r < nrows; r += gridDim.x * 8) {
        { const half8 o0 = *(const half8*)(SOG + (size_t)r * 512 + c), o1 = *(const half8*)(SOG + ((size_t)RGP + r) * 512 + c), z = *(const half8*)(P + (size_t)r * NP + C_Z + c);
          float o[8], ss = 0.f;
#pragma unroll
          for (int e = 0; e < 8; ++e) { o[e] = (float)o0[e] + (float)o1[e]; ss += o[e] * o[e]; }
          ss += SHFL_XOR(ss, 1); ss += SHFL_XOR(ss, 2); ss += SHFL_XOR(ss, 4); ss += SHFL_XOR(ss, 8);
          const float rinv = frsq(ss * (1.f / 128.f) + 1e-6f); half8 out;
#pragma unroll
          for (int e = 0; e < 8; ++e) out[e] = (half_t)(o[e] * rinv * c_gn[e] * siluf((float)z[e]));
          *(half8*)(BR + (size_t)r * 512 + c) = out; }
        { float y[8], sm = 0.f;
          { typedef unsigned short us8 __attribute__((ext_vector_type(8)));
            const us8 s0 = *(const us8*)(SOR + (size_t)r * 512 + c), s1 = *(const us8*)(SOR + ((size_t)RGP + r) * 512 + c);
#pragma unroll
            for (int e = 0; e < 8; ++e) y[e] = bf2f(s0[e]) + bf2f(s1[e]); }
#pragma unroll
          for (int e = 0; e < 8; ++e) sm += y[e];
          sm += SHFL_XOR(sm, 1); sm += SHFL_XOR(sm, 2); sm += SHFL_XOR(sm, 4); const float mean = sm * (1.f / 64.f);
          float vs = 0.f;
#pragma unroll
          for (int e = 0; e < 8; ++e) { const float dlt = y[e] - mean; vs += dlt * dlt; }
          vs += SHFL_XOR(vs, 1); vs += SHFL_XOR(vs, 2); vs += SHFL_XOR(vs, 4); const float rinv = frsq(vs * (1.f / 64.f) + 64e-5f);
          const half8 rv = *(const half8*)(RW + ((size_t)r * 4 + 0) * 512 + c), kv = *(const half8*)(RW + ((size_t)r * 4 + 1) * 512 + c), vv = *(const half8*)(RW + ((size_t)r * 4 + 2) * 512 + c);
          const half8 a0 = *(const half8*)(RLO + (size_t)r * 2560 + 1024 + c), a1 = *(const half8*)(RLO + (size_t)r * 2560 + 1536 + c), gg = *(const half8*)(RLO + (size_t)r * 2560 + 2048 + c);
          float bc = 0.f;
#pragma unroll
          for (int e = 0; e < 8; ++e) bc += (float)rv[e] * (float)kv[e] * (2.f + ((float)a0[e] + (float)a1[e] - 2.f) * c_ka[e]) * c_rk[e];
          bc += SHFL_XOR(bc, 1); bc += SHFL_XOR(bc, 2); bc += SHFL_XOR(bc, 4);
          half8 out;
#pragma unroll
          for (int e = 0; e < 8; ++e) out[e] = (half_t)(((y[e] - mean) * rinv * c_lg[e] + c_lb[e] + bc * (float)vv[e]) * (float)gg[e]);
          *(half8*)(BR + ((size_t)RGP + r) * 512 + c) = out; }
        { const half8 h0 = *(const half8*)(SOM + (size_t)r * 512 + c), h1 = *(const half8*)(SOM + ((size_t)RGP + r) * 512 + c), og = *(const half8*)(P + (size_t)r * NP + C_MLO + c);
          float o[8], ss = 0.f;
#pragma unroll
          for (int e = 0; e < 8; ++e) { o[e] = (float)h0[e] + (float)h1[e]; ss += o[e] * o[e]; }
          ss += SHFL_XOR(ss, 1); ss += SHFL_XOR(ss, 2); ss += SHFL_XOR(ss, 4); ss += SHFL_XOR(ss, 8);
          const float rinv = frsq(ss * (1.f / 128.f) + 1e-6f); half8 out;
#pragma unroll
          for (int e = 0; e < 8; ++e) out[e] = (half_t)(o[e] * rinv * c_mn[e] * (float)og[e]);
          *(half8*)(BR + ((size_t)2 * RGP + r) * 512 + c) = out; }
    }
}

__device__ __forceinline__ void ph_norm2(int wb, const Params& p, int l, int g, int nrows, LAS unsigned char* lds) {
    const int tid = tid_fresh(wb), wid = tid >> 6, lane = tid & 63;
    LAS float* rw = (LAS float*)lds;
    for (int i = tid; i < 1024 * 16; i += NT) rw[(i & 15) * 1024 + (i >> 4)] = p.in[I_ROUT][(size_t)l * 1024 * 16 + i];
    SYNC();
    half_t* H = (half_t*)(p.ws + OFF_H); float* PROB = (float*)(p.ws + OFF_PROB);
    constexpr int RU = 2;
    const int rstep = gridDim.x * 8; const float* gn = p.in[I_N2G] + l * D;
    f32x4 gv[4];
#pragma unroll
    for (int j = 0; j < 4; ++j) gv[j] = *(const f32x4*)(gn + lane * 4 + 256 * j);
    for (int r0 = blockIdx.x * 8 + wid; r0 < nrows; r0 += rstep * RU) {
        f32x4 v[RU][4], sh[RU][4], sc[RU][4]; half4 dxv[RU][4]; float ss[RU];
#pragma unroll
        for (int u = 0; u < RU; ++u) { const int r = r0 + u * rstep < nrows ? r0 + u * rstep : r0;
            const half_t* xr = res_h(p, g, r); const float* md = mod_row(p, l, g, r); const half_t* dxr = (const half_t*)(p.ws + OFF_DX) + (size_t)r * D;
#pragma unroll
            for (int j = 0; j < 4; ++j) { const int c = lane * 4 + 256 * j; v[u][j] = h4f(*(const half4*)(xr + c)); dxv[u][j] = *(const half4*)(dxr + c); sh[u][j] = *(const f32x4*)(md + 3 * 1024 + c); sc[u][j] = *(const f32x4*)(md + 4 * 1024 + c); } }
        EPI_LOAD_FENCE();
#pragma unroll
        for (int u = 0; u < RU; ++u)
#pragma unroll
            for (int j = 0; j < 4; ++j)
#pragma unroll
                for (int e = 0; e < 4; ++e) v[u][j][e] += (float)dxv[u][j][e];
#pragma unroll
        for (int u = 0; u < RU; ++u) { float a = 0.f;
#pragma unroll
            for (int j = 0; j < 4; ++j) a += v[u][j][0] * v[u][j][0] + v[u][j][1] * v[u][j][1] + v[u][j][2] * v[u][j][2] + v[u][j][3] * v[u][j][3];
            ss[u] = wave_sum(a); }
#pragma unroll
        for (int u = 0; u < RU; ++u) { const int r = r0 + u * rstep; if (r >= nrows) continue;
            const float rinv = frsq(ss[u] * (1.f / D) + 1e-6f);
            float lg[16];
#pragma unroll
            for (int e = 0; e < 16; ++e) lg[e] = 0.f;
#pragma unroll
            for (int j = 0; j < 4; ++j) { const int c = lane * 4 + 256 * j;
                const f32x4 hv = v[u][j] * rinv * gv[j] * (sc[u][j] + 1.f) + sh[u][j];
                *(half4*)(H + (size_t)r * D + c) = cvt4(hv);
#pragma unroll
                for (int e = 0; e < 16; ++e) { const f32x4 w = *(const LAS f32x4*)(rw + e * 1024 + c); lg[e] += hv[0] * w[0] + hv[1] * w[1] + hv[2] * w[2] + hv[3] * w[3]; }
                asm volatile("" ::: "memory"); }
            float k8[8], k4[4], k2[2], k1;
            { const bool hi = lane & 32;
#pragma unroll
              for (int e = 0; e < 8; ++e) { const float snd = hi ? lg[e] : lg[e + 8]; k8[e] = (hi ? lg[e + 8] : lg[e]) + SHFL_XOR(snd, 32); } }
            { const bool hi = lane & 16;
#pragma unroll
              for (int e = 0; e < 4; ++e) { const float snd = hi ? k8[e] : k8[e + 4]; k4[e] = (hi ? k8[e + 4] : k8[e]) + SHFL_XOR(snd, 16); } }
            { const bool hi = lane & 8;
#pragma unroll
              for (int e = 0; e < 2; ++e) { const float snd = hi ? k4[e] : k4[e + 2]; k2[e] = (hi ? k4[e + 2] : k4[e]) + SHFL_XOR(snd, 8); } }
            { const bool hi = lane & 4; const float snd = hi ? k2[0] : k2[1]; k1 = (hi ? k2[1] : k2[0]) + SHFL_XOR(snd, 4); }
            k1 += SHFL_XOR(k1, 2); k1 += SHFL_XOR(k1, 1);
            float mx = k1; mx = fmaxf(mx, SHFL_XOR(mx, 4)); mx = fmaxf(mx, SHFL_XOR(mx, 8)); mx = fmaxf(mx, SHFL_XOR(mx, 16)); mx = fmaxf(mx, SHFL_XOR(mx, 32));
            const float ex = fexp(k1 - mx); float sum = ex; sum += SHFL_XOR(sum, 4); sum += SHFL_XOR(sum, 8); sum += SHFL_XOR(sum, 16); sum += SHFL_XOR(sum, 32);
            if ((lane & 3) == 0) PROB[(size_t)r * 16 + (lane >> 2)] = ex * frcp(sum); }
    }
}

__device__ __forceinline__ void ph_topk(int wb, const Params& p, int nctx, LAS unsigned char* lds) {
    const int tid = tid_fresh(wb), wid = tid >> 6, lane = tid & 63;
    LAS unsigned* pv = (LAS unsigned*)lds;
    LAS unsigned* hist = pv + (SEQ > CTXL ? SEQ : CTXL);
    LAS int* wtot = (LAS int*)(hist + 256);
    LAS int* selrows = wtot + 16;
    LAS unsigned* sh = (LAS unsigned*)(selrows + (CAPL > CAPC ? CAPL : CAPC));
    const float* PROB = (const float*)(p.ws + OFF_PROB); int* SLOT = (int*)(p.ws + OFF_SLOT); int* SEL = (int*)(p.ws + OFF_SEL); float* AFF = (float*)(p.ws + OFF_AFF);
    const half_t* H = (const half_t*)(p.ws + OFF_H); half_t* XE = (half_t*)(p.ws + OFF_XE);
    auto block_excl = [&](int v, int slotbase) -> int {
        float f = (float)v;
#pragma unroll
        for (int off = 1; off < 64; off <<= 1) { const float o = shfl_up_f(f, off, lane); f = lane >= off ? f + o : f; }
        if (lane == 63) wtot[slotbase + wid] = (int)f;
        SYNC();
        int pre = 0;
#pragma unroll
        for (int w = 0; w < 8; ++w) pre += (w < wid) ? wtot[slotbase + w] : 0;
        return pre + (int)f - v; };
    const int nlat = BG * 16, nq = (nlat * 4 + nctx * 16 <= (int)gridDim.x) ? 4 : (nlat * 2 + nctx * 16 <= (int)gridDim.x) ? 2 : 1;
    for (int vit = blockIdx.x; vit < nlat * nq + nctx * 16; vit += gridDim.x) {
        const int item = vit < nlat * nq ? vit / nq : vit - nlat * (nq - 1), part = vit < nlat * nq ? vit % nq : 0, nparts = vit < nlat * nq ? nq : 1;
        const int e = item & 15, sm = item >> 4, stc = sm >= BG, bl = stc ? sm - BG : sm;
        const int n = stc ? CTXL : SEQ, cap = n / 8, row0 = stc ? RL + bl * CTXL : bl * SEQ, slot0 = stc ? BG * CAPL + bl * CAPC : bl * CAPL;
        SYNC();
        for (int i = tid; i < n; i += NT) pv[i] = __float_as_uint(PROB[(size_t)(row0 + i) * 16 + e]);
        unsigned prefix = 0u, mask = 0u; int kth = cap;
        for (int pass = 3; pass >= 0; --pass) {
            if (tid < 256) hist[tid] = 0u;
            SYNC();
            for (int i = tid; i < n; i += NT) { const unsigned v = pv[i]; if ((v & mask) == prefix) LDS_ATOMIC_INC(&hist[(v >> (8 * pass)) & 255u]); }
            SYNC();
            if (wid == 0) {
                const int b0 = 255 - 4 * lane; const int h0 = (int)hist[b0], h1 = (int)hist[b0 - 1], h2 = (int)hist[b0 - 2], h3 = (int)hist[b0 - 3];
                float f = (float)(h0 + h1 + h2 + h3);
#pragma unroll
                for (int off = 1; off < 64; off <<= 1) { const float o = shfl_up_f(f, off, lane); f = lane >= off ? f + o : f; }
                int cum = (int)f - (h0 + h1 + h2 + h3);
                const int hh[4] = {h0, h1, h2, h3};
#pragma unroll
                for (int j = 0; j < 4; ++j) { if (cum < kth && kth <= cum + hh[j]) { sh[0] = (unsigned)(b0 - j); sh[1] = (unsigned)(kth - cum); } cum += hh[j]; }
            }
            SYNC();
            prefix |= sh[0] << (8 * pass); mask |= 0xFFu << (8 * pass); kth = (int)sh[1];
        }
        const unsigned thr = prefix; const int need_eq = kth;
        const int per = (n + NT - 1) / NT, i0 = tid * per, i1 = (i0 + per < n) ? i0 + per : n;
        int ce = 0, cg = 0; for (int i = i0; i < i1; ++i) { const unsigned v = pv[i]; ce += (v == thr); cg += (v > thr); }
        const int eq_ex = block_excl(ce, 0);
        int take = need_eq - eq_ex; take = take < 0 ? 0 : (take > ce ? ce : take);
        const int pos_ex = block_excl(cg + take, 8);
        { int eqr = eq_ex, pos = pos_ex;
          for (int i = i0; i < i1; ++i) { const unsigned v = pv[i]; const bool sel = v > thr || (v == thr && eqr < need_eq); if (v == thr) ++eqr; const int row = row0 + i;
              if (sel) { const int slot = slot0 + pos; if (part == 0) { SEL[e * RPE + slot] = row; AFF[e * RPE + slot] = __uint_as_float(v); SLOT[(size_t)row * 16 + e] = slot; } selrows[pos] = row; ++pos; }
              else if (part == 0) SLOT[(size_t)row * 16 + e] = -1; } }
        SYNC();
        const int g0 = part * (cap / nparts) * 128, g1 = (part + 1 == nparts ? cap : (part + 1) * (cap / nparts)) * 128;
        for (int idx0 = g0 + tid; idx0 < g1; idx0 += NT * 8) { half8 t[8];
#pragma unroll
            for (int u = 0; u < 8; ++u) { const int idx = idx0 + u * NT; if (idx < g1) t[u] = *(const half8*)(H + (size_t)selrows[idx >> 7] * 1024 + (idx & 127) * 8); }
#pragma unroll
            for (int u = 0; u < 8; ++u) { const int idx = idx0 + u * NT; if (idx < g1) *(half8*)(XE + ((size_t)e * RPE + slot0 + (idx >> 7)) * 1024 + (idx & 127) * 8) = t[u]; } }
    }
    SYNC();
}

__device__ __forceinline__ void ph_combine(int wb, const Params& p, int l, int g, int nrows) {
    const int tid = tid_fresh(wb), wid = tid >> 6, lane = tid & 63;
    const int* SLOT = (const int*)(p.ws + OFF_SLOT); const half_t* YE = (const half_t*)(p.ws + OFF_YE);
    constexpr int RU = 4;
    const int rstep = gridDim.x * 8;
    for (int r0 = blockIdx.x * 8 + wid; r0 < nrows; r0 += rstep * RU) {
        float acc[RU][2][8]; f32x4 xv[RU][4];
#pragma unroll
        for (int u = 0; u < RU; ++u) { const int r = r0 + u * rstep;
#pragma unroll
            for (int j = 0; j < 2; ++j)
#pragma unroll
                for (int e = 0; e < 8; ++e) acc[u][j][e] = 0.f;
            if (r < nrows) { const half_t* xr = res_h(p, g, r); const half_t* dxr = (const half_t*)(p.ws + OFF_DX) + (size_t)r * D;
#pragma unroll
                for (int j = 0; j < 2; ++j) { const half8 xh = *(const half8*)(xr + 8 * lane + 512 * j);
                    const half8 dx = *(const half8*)(dxr + 8 * lane + 512 * j);
#pragma unroll
                    for (int e = 0; e < 4; ++e) { xv[u][2 * j][e] = (float)xh[e] + (float)dx[e]; xv[u][2 * j + 1][e] = (float)xh[4 + e] + (float)dx[4 + e]; } }
                int sl[16];
#pragma unroll
                for (int q = 0; q < 4; ++q) { const int4 t = *(const int4*)(SLOT + (size_t)r * 16 + 4 * q); sl[4 * q] = t.x; sl[4 * q + 1] = t.y; sl[4 * q + 2] = t.z; sl[4 * q + 3] = t.w; }
#pragma unroll
                for (int ex = 0; ex < 16; ++ex) { if (sl[ex] < 0) continue;
#pragma unroll
                    for (int j = 0; j < 2; ++j) { const half8 y = *(const half8*)(YE + ((size_t)ex * RPE + sl[ex]) * 1024 + 8 * lane + 512 * j);
#pragma unroll
                        for (int e = 0; e < 8; ++e) acc[u][j][e] += (float)y[e]; } } } }
        float ss[RU];
#pragma unroll
        for (int u = 0; u < RU; ++u) { const int r = r0 + u * rstep; ss[u] = 0.f; if (r >= nrows) continue;
            const float* md = mod_row(p, l, g, r) + 5 * 1024;
#pragma unroll
            for (int j = 0; j < 2; ++j) { const f32x4 m0 = *(const f32x4*)(md + 8 * lane + 512 * j), m1 = *(const f32x4*)(md + 8 * lane + 512 * j + 4);
#pragma unroll
                for (int e = 0; e < 4; ++e) { xv[u][2 * j][e] += m0[e] * acc[u][j][e]; xv[u][2 * j + 1][e] += m1[e] * acc[u][j][4 + e];
                    ss[u] += xv[u][2 * j][e] * xv[u][2 * j][e] + xv[u][2 * j + 1][e] * xv[u][2 * j + 1][e]; } } }
        if (l == DEPTH - 1) {
#pragma unroll
            for (int u = 0; u < RU; ++u) ss[u] = wave_sum(ss[u]); }
#pragma unroll
        for (int u = 0; u < RU; ++u) { const int r = r0 + u * rstep; if (r >= nrows) continue;
            if (l == DEPTH - 1) { const float rinv = frsq(ss[u] * (1.f / D) + 1e-6f); float* xr = res_dst(p, g, r);
#pragma unroll
                for (int j = 0; j < 2; ++j) { const f32x4 f0 = *(const f32x4*)(p.in[I_FING] + 8 * lane + 512 * j), f1 = *(const f32x4*)(p.in[I_FING] + 8 * lane + 512 * j + 4);
                    *(f32x4*)(xr + 8 * lane + 512 * j) = xv[u][2 * j] * rinv * f0; *(f32x4*)(xr + 8 * lane + 512 * j + 4) = xv[u][2 * j + 1] * rinv * f1; } }
            else { half_t* xr = res_h(p, g, r);
#pragma unroll
                for (int j = 0; j < 2; ++j) { half8 o;
#pragma unroll
                    for (int e = 0; e < 4; ++e) { o[e] = (half_t)xv[u][2 * j][e]; o[4 + e] = (half_t)xv[u][2 * j + 1][e]; }
                    *(half8*)(xr + 8 * lane + 512 * j) = o; } } }
    }
}

#ifndef TPROBE_A
#define TPROBE_A 0
#endif
#ifndef TPROBE_B
#define TPROBE_B 0
#endif
#ifndef CPU_EMU
__device__ __forceinline__ void tprobe_tick(LAS unsigned char* lds, int idx) {
    volatile LAS unsigned long long* tp = (volatile LAS unsigned long long*)(lds + SMEM_BYTES - 64);
    const unsigned long long now = __builtin_amdgcn_s_memrealtime(), dt = now - tp[0];
    if ((TPROBE_A >> idx) & 1) tp[1] += dt;
    if ((TPROBE_B >> idx) & 1) tp[2] += dt;
    tp[0] = now;
}
#define PH_T(idx) do { if ((TPROBE_A | TPROBE_B) != 0 && blockIdx.x == 0 && tid_fresh(wb) == 0) tprobe_tick(lds, (idx)); } while (0)
#else
#define PH_T(idx)
#endif
#ifndef EMU_DUMP
#define EMU_DUMP(tag)
#endif
#ifndef CPU_EMU
extern __shared__ __attribute__((aligned(16))) unsigned char smem_raw[];
__global__ void __launch_bounds__(NT, 2) mega(Params p)
#else
void mega(Params p)
#endif
{
#ifndef CPU_EMU
    LAS unsigned char* lds = (LAS unsigned char*)smem_raw;
    volatile LAS unsigned* xbw = (volatile LAS unsigned*)(lds + SMEM_BYTES - 16);
    if (threadIdx.x == 0) { xbw[0] = 0u; xbw[1] = 0u; xbw[2] = 0u; xbw[3] = 0u; }
    __syncthreads();
    (void)xcd_barrier_post((unsigned*)(p.ws + OFF_BAR), xbw);
    if ((TPROBE_A | TPROBE_B) != 0 && threadIdx.x == 0) { volatile LAS unsigned long long* tp = (volatile LAS unsigned long long*)(lds + SMEM_BYTES - 64); tp[0] = __builtin_amdgcn_s_memrealtime(); tp[1] = 0ull; tp[2] = 0ull; }
#else
    unsigned char* lds = emu_smem();
#endif
#ifndef CPU_EMU
    const int wb = __builtin_amdgcn_readfirstlane((int)threadIdx.x) & ~63;
#else
    const int wb = 0;
#endif
    const int G = gridDim.x, c = blockIdx.x;
    if (!(SKIP_MASK & 1)) ph_mod(wb, p, lds);
    if (!(SKIP_MASK & 2)) ph_convert(wb, p, 0, 0, c, G, lds);
    ph_xconv(wb, p);
    GRID_SYNC(); PH_T(0);
    for (int l = 0; l < DEPTH; ++l) {
        const bool last = (l == DEPTH - 1);
        for (int g = 0; g < NGROUP; ++g) {
            const Geo gq = geo_of(g);
            const int nact = last ? RL : gq.rg;
            const int nactp = last ? RL : gq.rgp;
            const int tpa = last ? (BG * CAPL + 255) / 256 : gq.tpe;
            if (l == 0 && g == 0) { if (!(SKIP_MASK & 4)) ph_norm1(wb, p, l, g); GRID_SYNC(); PH_T(1); }
            EMU_DUMP("norm1");
            if (!(SKIP_MASK & 8)) REPS(8) { pg8::StaticOrder S; S.init(gq.rgp / 256, NP / 256, G, c); EpiP E{(half_t*)(p.ws + OFF_P)};
              pg8::gemm_phase(wb, lds, pg8::Gemm{(const half_t*)(p.ws + OFF_H), (const half_t*)(p.ws + OFF_WIN), 1024, 16}, S, E); }
            GRID_SYNC(); PH_T(2); EMU_DUMP("gemm_in");
            if (!(SKIP_MASK & 16)) REPS(16) ph_prep2(wb, p, l, gq.rg, lds);
            GRID_SYNC(); PH_T(3); EMU_DUMP("prep");
            if (!(SKIP_MASK & 32)) REPS(32) { pg8::LoraOrder S; S.init(gq.rgp / 256, G, c); EpiLora E{(half_t*)(p.ws + OFF_RLO), p.in[I_RW0] + (size_t)l * 1024, p.in[I_RA0] + (size_t)l * 1024};
              pg8::gemm_phase(wb, lds, pg8::Gemm{(const half_t*)(p.ws + OFF_RLI), (const half_t*)(p.ws + OFF_WLORA), 384, 2}, S, E); }
            if (!(SKIP_MASK & 64)) REPS(64) ph_wy(wb, p, gq.rg, lds);
            GRID_SYNC(); PH_T(4); EMU_DUMP("wy");
            if (!(SKIP_MASK & 128)) REPS(128) ph_scan(wb, p, l, g, lds);
            GRID_SYNC(); PH_T(5); EMU_DUMP("scan");
            if (!(SKIP_MASK & 256)) REPS(256) ph_finish(wb, p, l, nact);
            GRID_SYNC(); PH_T(6); EMU_DUMP("finish");
            if (!(SKIP_MASK & 512)) REPS(512) { pg8::MergeOrder S; S.init(nactp / 256, G, c); EpiMerge E{(half_t*)(p.ws + OFF_H), (const half_t*)(p.ws + OFF_P)};
              pg8::gemm_phase(wb, lds, pg8::Gemm{(const half_t*)(p.ws + OFF_BR), (const half_t*)(p.ws + OFF_WBR), 512, 8}, S, E); }
            GRID_SYNC(); PH_T(7); EMU_DUMP("merge");
            if (!(SKIP_MASK & 1024)) { pg8::StaticOrder S; S.init(nactp / 256, 4, G, c); EpiOut E{p, l, g, gq.rg};
              pg8::gemm_phase(wb, lds, pg8::Gemm{(const half_t*)(p.ws + OFF_H), (const half_t*)(p.ws + OFF_WOUT), 1024, 16}, S, E); }
            GRID_SYNC(); PH_T(8); EMU_DUMP("out");
            if (!(SKIP_MASK & 2048)) REPS(2048) ph_norm2(wb, p, l, g, nact, lds);
            GRID_SYNC(); PH_T(9); EMU_DUMP("norm2");
            if (!(SKIP_MASK & 4096)) REPS(4096) ph_topk(wb, p, (g == 0 && !last) ? BATCH : 0, lds);
            GRID_SYNC(); PH_T(10); EMU_DUMP("topk");
            if (!(SKIP_MASK & 8192)) REPS(8192) { pg8::ExpertOrder S; S.init(tpa, G, c); EpiUp E{(half_t*)(p.ws + OFF_HID)};
              pg8::gemm_phase(wb, lds, pg8::Gemm{(const half_t*)(p.ws + OFF_XE), (const half_t*)(p.ws + OFF_WUP), 1024, 16}, S, E); }
            GRID_SYNC(); PH_T(11);
            if (!(SKIP_MASK & 16384)) REPS(16384) { pg8::ExpertOrder S; S.init(tpa, G, c); EpiDown E{(half_t*)(p.ws + OFF_YE), (const float*)(p.ws + OFF_AFF)};
              pg8::gemm_phase(wb, lds, pg8::Gemm{(const half_t*)(p.ws + OFF_HID), (const half_t*)(p.ws + OFF_WDN), 512, 8}, S, E); }
            GRID_SYNC(); PH_T(12);
            if (!(SKIP_MASK & 32768)) ph_combine(wb, p, l, g, nact);
            if (!(SKIP_MASK & 4)) { if (g + 1 < NGROUP) ph_norm1(wb, p, l, g + 1); else if (!last) ph_norm1(wb, p, l + 1, 0); }
            GRID_SYNC(); PH_T(13); EMU_DUMP("combine");
        }
    }
#ifndef CPU_EMU
#if SANDBOX
    GRID_SYNC(); PH_T(16);
    { pg8::StaticOrder S; S.init(RGP / 256, NP / 256, G, c); SANDBOX_EPI E{(SANDBOX_EPI_ARG)(p.ws + OFF_P)};
      pg8::gemm_phase(wb, lds, pg8::Gemm{(const half_t*)(p.ws + OFF_H), (const half_t*)(p.ws + OFF_WIN), 1024, SANDBOX_A}, S, E); }
    GRID_SYNC(); PH_T(14);
    { pg8::StaticOrder S; S.init(RGP / 256, NP / 256, G, c); SANDBOX_EPI E{(SANDBOX_EPI_ARG)(p.ws + OFF_P)};
      pg8::gemm_phase(wb, lds, pg8::Gemm{(const half_t*)(p.ws + OFF_H), (const half_t*)(p.ws + OFF_WIN), 1024, SANDBOX_B}, S, E); }
    GRID_SYNC(); PH_T(15);
#endif
    if ((TPROBE_A | TPROBE_B) != 0 && blockIdx.x == 0) {
        __syncthreads();
        volatile LAS unsigned long long* tp = (volatile LAS unsigned long long*)(lds + SMEM_BYTES - 64);
        const float msA = (float)tp[1] * 1e-5f, msB = (float)tp[2] * 1e-5f;
        if (TPROBE_A != 0 && threadIdx.x == 0) p.out[0] += 10.f * msA;
        if (TPROBE_B != 0) { const float eps = sqrtf(msB * 1.675e-3f); for (int i = threadIdx.x; i < (1 << 20); i += NT) p.out[1024 + i] += eps; }
    }
#endif
}

#ifndef CPU_EMU
extern "C" void kernel_launch(void* const* d_in, const int* in_sizes, int n_in, void* d_out, int out_size, void* d_ws, size_t ws_size, hipStream_t stream) {
    (void)in_sizes; (void)n_in; (void)out_size;
    static int grid = 0;
    if (!grid) {
        int dev = 0, cus = 0, per_cu = 0;
        hipGetDevice(&dev);
        hipDeviceGetAttribute(&cus, hipDeviceAttributeMultiprocessorCount, dev);
        hipFuncSetAttribute((const void*)mega, hipFuncAttributeMaxDynamicSharedMemorySize, SMEM_BYTES);
        hipOccupancyMaxActiveBlocksPerMultiprocessor(&per_cu, (const void*)mega, NT, SMEM_BYTES);
        if (per_cu < 1) per_cu = 1;
        grid = cus;
        if (ws_size < WS_TOTAL) fprintf(stderr, "workspace too small: %zu < %zu\n", ws_size, (size_t)WS_TOTAL);
    }
    hipMemsetAsync((unsigned char*)d_ws + OFF_BAR, 0, 16384, stream);
    Params p{};
    for (int i = 0; i < 34; ++i) p.in[i] = (const float*)d_in[i];
    p.out = (float*)d_out; p.ws = (unsigned char*)d_ws;
    hipLaunchKernelGGL(mega, dim3(grid), dim3(NT), SMEM_BYTES, stream, p);
}
#endif
```

```cpp
#ifndef CPU_EMU
#include <hip/hip_runtime.h>
#include <cstdio>
#include <cstdint>
typedef _Float16 half_t;
typedef _Float16 half8 __attribute__((ext_vector_type(8)));
typedef _Float16 half4 __attribute__((ext_vector_type(4)));
typedef float f32x4 __attribute__((ext_vector_type(4)));
typedef float f32x2 __attribute__((ext_vector_type(2)));
#define LAS __attribute__((address_space(3)))
#define SYNC() __syncthreads()
#define WAVE_SYNC() __builtin_amdgcn_wave_barrier()
template <int M> __device__ __forceinline__ float shfl_xor_t(float v, int tid) {
    if constexpr (M < 32) return __int_as_float(__builtin_amdgcn_ds_swizzle(__float_as_int(v), (M << 10) | 0x1f));
    else return __int_as_float(__builtin_amdgcn_ds_bpermute(((tid ^ 32) & 63) << 2, __float_as_int(v)));
}
#define SHFL_XOR(v, m) shfl_xor_t<m>((v), tid)
#define LDS_ATOMIC_INC(p) __hip_atomic_fetch_add((p), 1u, __ATOMIC_RELAXED, __HIP_MEMORY_SCOPE_WORKGROUP)
#endif

#ifndef CFG_BATCH
#define CFG_BATCH 8
#define CFG_SEQ 4096
#define CFG_CTX 256
#define CFG_DEPTH 4
#define CFG_NGROUP 2
#endif
constexpr int BATCH = CFG_BATCH, SEQ = CFG_SEQ, CTXL = CFG_CTX, DEPTH = CFG_DEPTH, NGROUP = CFG_NGROUP;
#ifndef SKIP_MASK
#define SKIP_MASK 0
#endif
#ifndef WARM_WIN
#define WARM_WIN 0
#endif
#ifndef SANDBOX
#define SANDBOX 0
#endif
#ifndef SANDBOX_PV
#define SANDBOX_PV 1
#endif
#ifndef SANDBOX_A
#define SANDBOX_A 16
#define SANDBOX_B 8
#endif
#ifndef SANDBOX_EPI
#define SANDBOX_EPI EpiP
#define SANDBOX_EPI_ARG half_t*
#endif
#ifndef REPEAT_MASK
#define REPEAT_MASK 0
#endif
#define REPS(bit) for (int rep_ = 0; rep_ < ((REPEAT_MASK & (bit)) ? 2 : 1); ++rep_)
constexpr int NT = 512;
constexpr int D = 1024;
constexpr int IN_COLS = 8608, NP = 8704;
constexpr int C_Z = 1536, C_BG = 2048;
constexpr int C_RWKV = 2064;
constexpr int C_ML = 3984, C_MLO = 5008, C_MLIG = 5520, C_MLFG = 5528;
constexpr int C_GATE = 5536;
constexpr int BG = BATCH / NGROUP;
constexpr int RL = BG * SEQ;
constexpr int RCX = BATCH * CTXL;
constexpr int RGX = RL + RCX;
constexpr int RGP = (RGX + 255) / 256 * 256;
constexpr int CAPL = SEQ / 8, CAPC = CTXL / 8;
constexpr int RPE = (BG * CAPL + BATCH * CAPC + 255) / 256 * 256;
constexpr int TPE = RPE / 256;
constexpr int NCH = RGP / 64;
struct Geo { int rg, rgp, tpe; };
__host__ __device__ __forceinline__ Geo geo_of(int g) { Geo q; q.rg = RL + (g == 0 ? RCX : 0); q.rgp = (q.rg + 255) / 256 * 256; q.tpe = (BG * CAPL + (g == 0 ? BATCH * CAPC : 0) + 255) / 256; return q; }
static_assert(RL % 256 == 0, "latent rows per group must be a multiple of 256");
static_assert(SEQ % 64 == 0 && CTXL % 64 == 0, "chunks");

constexpr size_t al256(size_t x) { return (x + 255) / 256 * 256; }
constexpr size_t cmax(size_t a, size_t b) { return a > b ? a : b; }
constexpr size_t OFF_BAR = 0;
constexpr size_t OFF_MOD = 16384;
constexpr size_t OFF_CTXR = al256(OFF_MOD + (size_t)DEPTH * (BATCH + 1) * 6144 * 4);
constexpr size_t OFF_WIN = al256(OFF_CTXR + (size_t)BATCH * CTXL * D * 4);
constexpr size_t OFF_WBR = al256(OFF_WIN + (size_t)NP * 1024 * 2);
constexpr size_t OFF_WOUT = al256(OFF_WBR + (size_t)3 * 1024 * 512 * 2);
constexpr size_t OFF_WUP = al256(OFF_WOUT + (size_t)1024 * 1024 * 2);
constexpr size_t OFF_WDN = al256(OFF_WUP + (size_t)16 * 1024 * 1024 * 2);
constexpr size_t OFF_WLORA = al256(OFF_WDN + (size_t)16 * 1024 * 512 * 2);
constexpr size_t OFF_H = al256(OFF_WLORA + (size_t)2560 * 384 * 2);
constexpr size_t OFF_P = al256(OFF_H + (size_t)RGP * 1024 * 2);
constexpr size_t SZ_XE = (size_t)16 * RPE * 1024 * 2, SZ_HID = (size_t)16 * RPE * 512 * 2;
constexpr size_t OFF_XE = OFF_P, OFF_HID = OFF_XE + SZ_XE, OFF_YE = OFF_HID + SZ_HID;
constexpr size_t OFF_GQKV = al256(OFF_P + cmax((size_t)RGP * NP * 2, 2 * SZ_XE + SZ_HID));
constexpr size_t OFF_BR = OFF_GQKV;
constexpr size_t OFF_DX = OFF_BR;
constexpr size_t OFF_GBG = al256(OFF_GQKV + (size_t)RGP * 1536 * 2);
constexpr size_t OFF_GTA = al256(OFF_GBG + (size_t)RGP * 16 * 4);
constexpr size_t OFF_GG = al256(OFF_GTA + (size_t)NCH * 4 * 2 * 2 * 4096 * 2);
constexpr size_t OFF_RW = al256(OFF_GG + (size_t)NCH * 4 * 2 * 64 * 4);
constexpr size_t OFF_RLO = al256(OFF_RW + (size_t)RGP * 4 * 512 * 2);
constexpr size_t OFF_SO = al256(OFF_RLO + (size_t)RGP * 2560 * 2);
constexpr size_t OFF_RLI = OFF_SO;
constexpr size_t OFF_SOG = OFF_SO, OFF_SOM = OFF_SOG + (size_t)2 * RGP * 512 * 2, OFF_SOR = OFF_SOM + (size_t)2 * RGP * 512 * 2;
constexpr size_t OFF_PROB = al256(OFF_SOR + (size_t)2 * RGP * 512 * 2);
constexpr size_t OFF_SLOT = al256(OFF_PROB + (size_t)RGP * 16 * 4);
constexpr size_t OFF_SEL = al256(OFF_SLOT + (size_t)RGP * 16 * 4);
constexpr size_t OFF_AFF = al256(OFF_SEL + (size_t)16 * RPE * 4);
constexpr int NSAVE = BATCH - BG > 0 ? BATCH - BG : 1;
constexpr size_t OFF_RST = al256(OFF_AFF + (size_t)16 * RPE * 4);
constexpr size_t OFF_GST = al256(OFF_RST + (size_t)NSAVE * 8 * 2 * 4096 * 4);
constexpr size_t OFF_MST = al256(OFF_GST + (size_t)NSAVE * 4 * 2 * 16384 * 4);
constexpr size_t OFF_MSM = al256(OFF_MST + (size_t)NSAVE * 4 * 2 * 16384 * 4);
constexpr size_t WS_TOTAL = al256(OFF_MSM + (size_t)NSAVE * 4 * 2 * 4);
constexpr int SMEM_BYTES = 152 * 1024;

struct Params { const float* in[34]; float* out; unsigned char* ws; };
enum { I_X = 0, I_C, I_CTX, I_CCTX, I_ADAW, I_ADAB, I_N1G, I_N2G, I_WIN, I_GCONV, I_GALOG, I_GDTB, I_GNG, I_RMU, I_RW0, I_RWUP, I_RA0, I_RAUP, I_RGUP,
       I_RKK, I_RKA, I_RRK, I_RLNG, I_RLNB, I_MIB, I_MFB, I_MNG, I_WBR, I_WOUT, I_ROUT, I_W1, I_W3, I_W2, I_FING };

#ifndef CPU_EMU
__device__ __forceinline__ int tid_fresh(int wb) { int t; asm volatile("v_mbcnt_lo_u32_b32 %0, -1, 0\n\tv_mbcnt_hi_u32_b32 %0, -1, %0" : "=v"(t)); return wb + t; }
#else
static inline int tid_fresh(int) { return threadIdx.x; }
#endif
#ifndef CPU_EMU
__device__ __forceinline__ float fexp(float x) { return __builtin_amdgcn_exp2f(x * 1.4426950408889634f); }
__device__ __forceinline__ float flog(float x) { return __builtin_amdgcn_logf(x) * 0.6931471805599453f; }
__device__ __forceinline__ float frcp(float x) { return __builtin_amdgcn_rcpf(x); }
__device__ __forceinline__ float frsq(float x) { return __builtin_amdgcn_rsqf(x); }
#else
static inline float fexp(float x) { return expf(x); }
static inline float flog(float x) { return logf(x); }
static inline float frcp(float x) { return 1.f / x; }
static inline float frsq(float x) { return 1.f / sqrtf(x); }
#endif
__device__ __forceinline__ float sigm(float x) { return frcp(1.f + fexp(-x)); }
__device__ __forceinline__ float siluf(float x) { return x * frcp(1.f + fexp(-x)); }
__device__ __forceinline__ float ftanh(float x) { return 1.f - 2.f * frcp(1.f + fexp(2.f * x)); }
__device__ __forceinline__ float softplusf(float x) { const float t = fexp(x); return x > 15.f ? x : (t < 1e-3f ? t * (1.f - 0.5f * t) : flog(1.f + t)); }
#define wave_sum(x) wave_sum_(x, tid)
__device__ __forceinline__ float wave_sum_(float v, int tid) { v += SHFL_XOR(v, 32); v += SHFL_XOR(v, 16); v += SHFL_XOR(v, 8); v += SHFL_XOR(v, 4); v += SHFL_XOR(v, 2); v += SHFL_XOR(v, 1); return v; }

#ifndef CPU_EMU
#define MFMA16(a, b, c) __builtin_amdgcn_mfma_f32_16x16x32_f16((a), (b), (c), 0, 0, 0)
#else
#define MFMA16(a, b, c) emu_mfma16((a), (b), (c))
#endif
__device__ __forceinline__ half8 ldfrag(const LAS half_t* base, int row0, int ld, int k0, int lane) { return *(const LAS half8*)(base + (row0 + (lane & 15)) * ld + k0 + 8 * (lane >> 4)); }
__device__ __forceinline__ half4 cvt4(f32x4 v) { half4 o; o[0] = (half_t)v[0]; o[1] = (half_t)v[1]; o[2] = (half_t)v[2]; o[3] = (half_t)v[3]; return o; }

typedef unsigned short bf16_t;
__device__ __forceinline__ bf16_t f2bf(float f) { unsigned u = __float_as_uint(f); u += 0x7FFFu + ((u >> 16) & 1u); return (bf16_t)(u >> 16); }
__device__ __forceinline__ float bf2f(bf16_t b) { return __uint_as_float(((unsigned)b) << 16); }
#ifndef CPU_EMU
#define EPI_LOAD_FENCE() asm volatile("" ::: "memory")
#else
#define EPI_LOAD_FENCE()
#endif
__device__ __forceinline__ float* res_dst(const Params& p, int g, int r) {
    if (r < RL) { const size_t t = (size_t)(g * BG) * SEQ + r; return p.out + t * D; }
    const size_t t = (size_t)(r - RL); return (float*)(p.ws + OFF_CTXR) + t * D;
}
__device__ __forceinline__ half_t* res_h(const Params& p, int g, int r) { return (half_t*)res_dst(p, g, r) + 1024; }
__device__ __forceinline__ f32x4 h4f(half4 h) { return (f32x4){(float)h[0], (float)h[1], (float)h[2], (float)h[3]}; }
__device__ __forceinline__ const float* mod_row(const Params& p, int l, int g, int r) {
    const int s = r < RL ? (g * BG + r / SEQ) : BATCH; return (const float*)(p.ws + OFF_MOD) + ((size_t)l * (BATCH + 1) + s) * 6144;
}

#ifndef CPU_EMU
#define XB_TMO      128
#define XB_XCNT(j)  (256  + 64 * (j))
#define XB_XSUB(j)  (1280 + 64 * (j))
#define XB_XGEN(j)  (2304 + 64 * (j))
#define XB_TOP      3328
#define XB_TOPGEN   3392
#define XCD_BAR_WORDS 3456
#define XB_SPIN_CAP (1u << 22)
__device__ __forceinline__ unsigned xb_ld(unsigned* p)              { return __hip_atomic_load(p, __ATOMIC_RELAXED, __HIP_MEMORY_SCOPE_AGENT); }
__device__ __forceinline__ unsigned xb_add(unsigned* p, unsigned v) { return __hip_atomic_fetch_add(p, v, __ATOMIC_RELAXED, __HIP_MEMORY_SCOPE_AGENT); }
__device__ __forceinline__ unsigned xb_xcc_id() { return (unsigned)__builtin_amdgcn_s_getreg((3 << 11) | 20) & 0xFu; }
#define XB_SPIN(cond, bar) do { unsigned _sp = 0; while (cond) { __builtin_amdgcn_s_sleep(1); \
    if ((++_sp & 255u) == 0u) { if (xb_ld(&(bar)[XB_TMO])) break; if (_sp > XB_SPIN_CAP) { atomicAdd(&(bar)[XB_TMO], 1u); break; } } } } while (0)
struct XcdBarrier { unsigned* bar; unsigned x; volatile LAS unsigned* st; };
__device__ __forceinline__ XcdBarrier xcd_barrier_post(unsigned* bar, volatile LAS unsigned* st) {
    XcdBarrier b; b.bar = bar; b.x = xb_xcc_id(); b.st = st;
    if (threadIdx.x == 0) (void)xb_add(&bar[XB_XCNT(b.x)], 1u);
    return b;
}
__device__ __forceinline__ void xcd_barrier_complete(unsigned* bar, unsigned x, unsigned& nloc, unsigned& nx) {
    const unsigned G = gridDim.x * gridDim.y * gridDim.z;
    unsigned sum, cnt, mine, sp = 0u;
    for (;;) {
        sum = 0u; cnt = 0u; mine = 0u;
#pragma unroll
        for (unsigned j = 0; j < 16; ++j) { const unsigned c = xb_ld(&bar[XB_XCNT(j)]); sum += c; cnt += (c > 0u) ? 1u : 0u; mine = (j == x) ? c : mine; }
        if (sum == G) break;
        __builtin_amdgcn_s_sleep(1);
        if ((++sp & 255u) == 0u) { if (xb_ld(&bar[XB_TMO])) break; if (sp > XB_SPIN_CAP) { atomicAdd(&bar[XB_TMO], 1u); break; } }
    }
    nloc = mine > 0u ? mine : 1u; nx = cnt > 0u ? cnt : 1u;
}
__device__ __forceinline__ void xcd_barrier(const XcdBarrier& b) {
    asm volatile("s_waitcnt vmcnt(0)" ::: "memory");
    __syncthreads();
    if (threadIdx.x == 0) {
        unsigned* bar = b.bar;
        __builtin_amdgcn_s_waitcnt(0);
        unsigned nloc = b.st[0], nx = b.st[1];
        if (nloc == 0u) { xcd_barrier_complete(bar, b.x, nloc, nx); b.st[0] = nloc; b.st[1] = nx; }
        const unsigned old = xb_add(&bar[XB_XSUB(b.x)], 1u);
        const unsigned gen = old / nloc;
        if (old + 1u == (gen + 1u) * nloc) {
            __builtin_amdgcn_fence(__ATOMIC_RELEASE, "agent");
            asm volatile("s_waitcnt vmcnt(0)" ::: "memory");
            const unsigned og = xb_add(&bar[XB_TOP], 1u);
            const unsigned tg = og / nx;
            if (og + 1u == (tg + 1u) * nx) xb_add(&bar[XB_TOPGEN], 1u);
            else XB_SPIN(xb_ld(&bar[XB_TOPGEN]) == tg, bar);
            __builtin_amdgcn_fence(__ATOMIC_ACQUIRE, "agent");
            xb_add(&bar[XB_XGEN(b.x)], 1u);
            asm volatile("s_waitcnt vmcnt(0)" ::: "memory");
        } else {
            XB_SPIN(xb_ld(&bar[XB_XGEN(b.x)]) == gen, bar);
            __builtin_amdgcn_fence(__ATOMIC_ACQUIRE, "agent");
            asm volatile("s_waitcnt vmcnt(0)" ::: "memory");
        }
    }
    __syncthreads();
}
#define GRID_SYNC() do { XcdBarrier gb_; gb_.bar = (unsigned*)(p.ws + OFF_BAR); gb_.x = xb_xcc_id(); gb_.st = (volatile LAS unsigned*)(lds + SMEM_BYTES - 16); xcd_barrier(gb_); } while (0)
#else
#define GRID_SYNC() emu_grid_sync()
#endif

namespace pg8 {
constexpr int BM = 256, BK = 64, HALF = 128, HTB = HALF * BK * 2, STAGE_BYTES = 8 * HTB, NXCD = 8, WGM = 8;
__host__ __device__ __forceinline__ int lds_byte(int r, int c) { const int st = (r >> 4) * 2 + (c >> 5), rr = r & 15, cc = c & 31, ob = rr * 64 + cc * 2; return st * 1024 + (ob ^ (((ob >> 9) & 1) << 5)); }
__host__ __device__ __forceinline__ void stage_rc(int b, int& R, int& C) { const int st = b / 1024, sb = b % 1024, swz = sb ^ (((sb >> 9) & 1) << 5); R = (st >> 1) * 16 + swz / 64; C = (st & 1) * 32 + (swz % 64) / 2; }
__host__ __device__ __forceinline__ int perm32(int rho) { const int n = rho >> 4, i = rho & 15; return 8 * (i >> 2) + 4 * n + (i & 3); }
struct Unit { int pm, pn, pb, pa, aux, k0; };
struct Gemm { const half_t* A; const half_t* Bt; int K; int kt; };
struct StaticOrder {
    int nM, nN, nwg, G, c;
    __device__ void init(int nM_, int nN_, int G_, int c_) { nM = nM_; nN = nN_; nwg = nM * nN; G = G_; c = c_; }
    __device__ bool next(int i, Unit& u) const {
        const long L = (long)i * G + c; if (L >= nwg) return false;
        int wgid = (int)L; { const int q = nwg / NXCD, r = nwg % NXCD, xcd = wgid % NXCD, off = wgid / NXCD; wgid = (xcd < r ? xcd * (q + 1) : r * (q + 1) + (xcd - r) * q) + off; }
        const int nig = WGM * nN, gid = wgid / nig, fm = gid * WGM, gsz = (nM - fm) < WGM ? (nM - fm) : WGM;
        u.pm = fm + ((wgid % nig) % gsz); u.pn = (wgid % nig) / gsz; u.pb = u.pn; u.pa = u.pm; u.aux = 0; u.k0 = 0; return true;
    }
};
struct ExpertOrder {
    int G, c, tpa;
    __device__ void init(int tpa_, int G_, int c_) { tpa = tpa_; G = G_; c = c_; }
    __device__ bool next(int i, Unit& u) const {
        const int nwg = 16 * tpa * 4; long L = (long)i * G + c; if (L >= nwg) return false;
        { const int q = nwg / NXCD, r = nwg % NXCD, xcd = (int)L % NXCD, off = (int)L / NXCD; L = (xcd < r ? xcd * (q + 1) : r * (q + 1) + (xcd - r) * q) + off; }
        const int e = (int)L / (tpa * 4), rem = (int)L % (tpa * 4);
        u.pm = e * TPE + rem / 4; u.pn = rem % 4; u.pb = e * 4 + u.pn; u.pa = u.pm; u.aux = 0; u.k0 = 0; return true;
    }
};

struct LoraOrder {
    StaticOrder T;
    __device__ void init(int nM_, int G_, int c_) { T.init(nM_, 10, G_, c_); }
    __device__ bool next(int i, Unit& u) const { if (!T.next(i, u)) return false; const int blk = u.pn >> 1; u.k0 = blk < 4 ? 64 * blk : 256; return true; }
};
struct MergeOrder {
    StaticOrder T;
    __device__ void init(int nM_, int G_, int c_) { T.init(nM_, 4, G_, c_); }
    __device__ bool next(int i, Unit& u) const {
        if (!T.next(i / 3, u)) return false;
        const int bi = i % 3; u.aux = bi; u.pa = bi * (RGP / 256) + u.pm; u.pb = bi * 4 + u.pn; return true;
    }
};
template <class E, class = void> struct EpiCarry { static constexpr bool value = false; };
template <class E> struct EpiCarry<E, decltype((void)E::CARRY)> { static constexpr bool value = true; };
#ifndef CPU_EMU
template <class Epi, class Sched>
__device__ __forceinline__ void gemm_phase(int wb, LAS unsigned char* lds, const Gemm g, const Sched& S, const Epi& E) {
    const int tid = tid_fresh(wb), wid = __builtin_amdgcn_readfirstlane(tid >> 6), lane = tid & 63, wr = wid >> 2, wc = wid & 3, fr = lane & 15, fq = lane >> 4;
    const int K = g.K; int nt = g.kt; asm volatile("" : "+s"(nt));
    unsigned voffA[2], voffB[2];
#pragma unroll
    for (int i = 0; i < 2; ++i) { int R, C; stage_rc(tid * 16 + i * 8192, R, C); const int Rb = Epi::PERM ? ((R & ~31) + perm32(R & 31)) : R;
        voffA[i] = (unsigned)(R * K + C) * 2u; voffB[i] = (unsigned)(Rb * K + C) * 2u; }
    const size_t kstep = (size_t)(BK * 2);
    const size_t hstep = (size_t)HALF * K * 2;
    const size_t tstep = 2 * hstep;
    const unsigned ldsw = (unsigned)wid * 1024u;
    const int aoff = lds_byte(wr * 64 + fr, fq * 8), boff = lds_byte(wc * 32 + fr, fq * 8);
#define PG8_SA(b, h) (((b) * 2 + (h)) * HTB)
#define PG8_SB(b, h) ((4 + (b) * 2 + (h)) * HTB)
#define PG8_STAGE(bufoff, gbase, voff) do { _Pragma("unroll") for (int _i = 0; _i < 2; ++_i) \
        __builtin_amdgcn_global_load_lds((const unsigned*)((const char*)(gbase) + (voff)[_i]), (LAS unsigned*)(lds + (bufoff) + ldsw + _i * 8192), 16, 0, 0); } while (0)
#define PG8_LDA(dst, b, h) do { _Pragma("unroll") for (int m = 0; m < 4; ++m) _Pragma("unroll") for (int k = 0; k < 2; ++k) dst[m][k] = *(const LAS half8*)(lds + PG8_SA(b, h) + aoff + m * 2048 + k * 1024); } while (0)
#define PG8_LDB(dst, b, h) do { _Pragma("unroll") for (int n = 0; n < 2; ++n) _Pragma("unroll") for (int k = 0; k < 2; ++k) dst[n][k] = *(const LAS half8*)(lds + PG8_SB(b, h) + boff + n * 2048 + k * 1024); } while (0)
#define PG8_MMA(ai, bj, At, Bt) do { __builtin_amdgcn_s_setprio(1); _Pragma("unroll") for (int m = 0; m < 4; ++m) _Pragma("unroll") for (int n = 0; n < 2; ++n) _Pragma("unroll") for (int k = 0; k < 2; ++k) \
        acc[ai][bj][m][n] = __builtin_amdgcn_mfma_f32_16x16x32_f16(Bt[n][k], At[m][k], acc[ai][bj][m][n], 0, 0, 0); __builtin_amdgcn_s_setprio(0); } while (0)
#define PG8_WAIT_V(n) asm volatile("s_waitcnt vmcnt(" #n ")" ::: "memory")
#define PG8_WAIT_L(n) asm volatile("s_waitcnt lgkmcnt(" #n ")" ::: "memory")
#define PG8_BAR __builtin_amdgcn_s_barrier()
#define PG8_SCHED __builtin_amdgcn_sched_barrier(0)
    Unit cur, nxt; int ui = 0;
    if (!S.next(0, cur)) return;
    f32x4 acc[2][2][4][2];
#pragma unroll
    for (int a = 0; a < 2; ++a)
#pragma unroll
        for (int b = 0; b < 2; ++b)
#pragma unroll
            for (int m = 0; m < 4; ++m)
#pragma unroll
                for (int n = 0; n < 2; ++n) acc[a][b][m][n] = (f32x4){0.f, 0.f, 0.f, 0.f};
    half8 At[4][2], B0[2][2], B1[2][2];
    const char* cA = (const char*)g.A + (size_t)cur.pa * tstep + (size_t)cur.k0 * 2; const char* cB = (const char*)g.Bt + (size_t)cur.pb * tstep + (size_t)cur.k0 * 2;
    PG8_STAGE(PG8_SB(0, 0), cB, voffB); PG8_STAGE(PG8_SA(0, 0), cA, voffA); PG8_STAGE(PG8_SB(0, 1), cB + hstep, voffB); PG8_STAGE(PG8_SA(0, 1), cA + hstep, voffA);
    if (wr == 1) PG8_BAR;
    PG8_WAIT_V(4); PG8_BAR;
    PG8_STAGE(PG8_SB(1, 0), cB + kstep, voffB); PG8_STAGE(PG8_SA(1, 0), cA + kstep, voffA); PG8_STAGE(PG8_SB(1, 1), cB + hstep + kstep, voffB);
    PG8_WAIT_V(6); PG8_BAR;
    for (;;) {
        const bool has_next = S.next(ui + 1, nxt);
        const char* nA = has_next ? (const char*)g.A + (size_t)nxt.pa * tstep + (size_t)nxt.k0 * 2 : cA; const char* nB = has_next ? (const char*)g.Bt + (size_t)nxt.pb * tstep + (size_t)nxt.k0 * 2 : cB;
#pragma unroll 1
        for (int t = 0; t < nt; t += 2) {
            const bool last = (t == nt - 2);
            const char* a1 = cA + (size_t)(t + 1) * kstep;
            const char* a2 = last ? nA : cA + (size_t)(t + 2) * kstep; const char* b2 = last ? nB : cB + (size_t)(t + 2) * kstep;
            const char* a3 = a2 + kstep; const char* b3 = b2 + kstep;
            PG8_LDB(B0, 0, 0); PG8_SCHED; PG8_LDA(At, 0, 0); PG8_STAGE(PG8_SA(1, 1), a1 + hstep, voffA);
            PG8_WAIT_L(8); PG8_BAR; PG8_WAIT_L(0); PG8_MMA(0, 0, At, B0); PG8_BAR; PG8_SCHED;
            PG8_LDB(B1, 0, 1); PG8_STAGE(PG8_SB(0, 0), b2, voffB);
            PG8_BAR; PG8_WAIT_L(0); PG8_MMA(0, 1, At, B1); PG8_BAR;
            PG8_LDA(At, 0, 1); PG8_STAGE(PG8_SA(0, 0), a2, voffA);
            PG8_BAR; PG8_WAIT_L(0); PG8_MMA(1, 0, At, B0); PG8_BAR; PG8_SCHED;
            PG8_STAGE(PG8_SB(0, 1), b2 + hstep, voffB);
            PG8_WAIT_V(6); PG8_BAR; PG8_MMA(1, 1, At, B1); PG8_BAR;
            PG8_LDB(B0, 1, 0); PG8_SCHED; PG8_LDA(At, 1, 0); PG8_STAGE(PG8_SA(0, 1), a2 + hstep, voffA);
            PG8_WAIT_L(8); PG8_BAR; PG8_WAIT_L(0); PG8_MMA(0, 0, At, B0); PG8_BAR; PG8_SCHED;
            PG8_LDB(B1, 1, 1); PG8_STAGE(PG8_SB(1, 0), b3, voffB);
            PG8_BAR; PG8_WAIT_L(0); PG8_MMA(0, 1, At, B1); PG8_BAR;
            PG8_LDA(At, 1, 1); PG8_STAGE(PG8_SA(1, 0), a3, voffA);
            PG8_BAR; PG8_WAIT_L(0); PG8_MMA(1, 0, At, B0); PG8_BAR; PG8_SCHED;
            PG8_STAGE(PG8_SB(1, 1), b3 + hstep, voffB);
            PG8_WAIT_V(6); PG8_BAR; PG8_MMA(1, 1, At, B1); PG8_BAR;
        }
        bool keep = false;
        if constexpr (EpiCarry<Epi>::value) keep = E(acc, cur, wr, wc, fr, fq); else E(acc, cur, wr, wc, fr, fq);
        if (!has_next) break;
        if (!keep) {
#pragma unroll
            for (int a = 0; a < 2; ++a)
#pragma unroll
                for (int b = 0; b < 2; ++b)
#pragma unroll
                    for (int m = 0; m < 4; ++m)
#pragma unroll
                        for (int n = 0; n < 2; ++n) acc[a][b][m][n] = (f32x4){0.f, 0.f, 0.f, 0.f};
        }
        cur = nxt; cA = nA; cB = nB; ++ui;
    }
    PG8_WAIT_V(0);
    if (wr == 0) PG8_BAR;
    PG8_BAR;
#undef PG8_SA
#undef PG8_SB
#undef PG8_STAGE
#undef PG8_LDA
#undef PG8_LDB
#undef PG8_MMA
#undef PG8_WAIT_V
#undef PG8_WAIT_L
#undef PG8_BAR
#undef PG8_SCHED
}
#else
static float* emu_fa[64]; static float* emu_fb[64];
template <class Epi, class Sched>
void gemm_phase(int wb, LAS unsigned char* lds, const Gemm g, const Sched& S, const Epi& E) {
    const int tid = tid_fresh(wb), wid = tid >> 6, lane = tid & 63, wr = wid >> 2, wc = wid & 3, fr = lane & 15, fq = lane >> 4;
    const int K = g.K; const int bid = blockIdx.x;
    Unit u; f32x4 acc[2][2][4][2]; bool emu_keep = false;
    for (int ui = 0; S.next(ui, u); ++ui) {
        SYNC();
        if (tid == 0) {
            if (!emu_fa[bid]) { emu_fa[bid] = (float*)malloc(256 * 1024 * 4); emu_fb[bid] = (float*)malloc(256 * 1024 * 4); }
            for (int r = 0; r < 256; ++r) for (int k = 0; k < K; ++k) { emu_fa[bid][r * K + k] = (float)g.A[((size_t)u.pa * 256 + r) * K + k]; emu_fb[bid][r * K + k] = (float)g.Bt[((size_t)u.pb * 256 + r) * K + k]; }
        }
        SYNC();
        if (!emu_keep) for (int ai = 0; ai < 2; ++ai) for (int bj = 0; bj < 2; ++bj) for (int m = 0; m < 4; ++m) for (int n = 0; n < 2; ++n) acc[ai][bj][m][n] = (f32x4){0.f, 0.f, 0.f, 0.f};
        for (int ai = 0; ai < 2; ++ai) for (int bj = 0; bj < 2; ++bj) for (int m = 0; m < 4; ++m) for (int n = 0; n < 2; ++n) for (int i = 0; i < 4; ++i) {
            const int row = 128 * ai + 64 * wr + 16 * m + fr;
            const int col = Epi::PERM ? (128 * bj + 32 * wc + 8 * fq + 4 * n + i) : (128 * bj + 32 * wc + 16 * n + 4 * fq + i);
            const float* a = emu_fa[bid] + row * K; const float* b = emu_fb[bid] + col * K; float s = 0.f;
            for (int k = u.k0; k < u.k0 + 64 * g.kt; ++k) s += a[k] * b[k];
            acc[ai][bj][m][n][i] += s; }
        if constexpr (EpiCarry<Epi>::value) emu_keep = E(acc, u, wr, wc, fr, fq); else { E(acc, u, wr, wc, fr, fq); emu_keep = false; }
    }
    SYNC();
}
#endif
}
using pg8::Unit;

struct EpiP {
    static constexpr bool PERM = true;
    half_t* P;
    __device__ __forceinline__ void operator()(const f32x4 (&acc)[2][2][4][2], const Unit& u, int wr, int wc, int fr, int fq) const {
        const int row0 = u.pm * 256 + wr * 64 + fr, col0 = u.pn * 256 + wc * 32 + 8 * fq;
        const bool tile_sg = u.pn * 256 + 256 > C_MLO;
        if (!tile_sg) {
#pragma unroll
            for (int bj = 0; bj < 2; ++bj)
#pragma unroll
                for (int ai = 0; ai < 2; ++ai)
#pragma unroll
                    for (int m = 0; m < 4; ++m) { half8 h;
#pragma unroll
                        for (int n = 0; n < 2; ++n)
#pragma unroll
                            for (int i = 0; i < 4; ++i) h[4 * n + i] = (half_t)acc[ai][bj][m][n][i];
                        *(half8*)(P + (size_t)(row0 + ai * 128 + m * 16) * NP + col0 + bj * 128) = h; }
            return;
        }
#pragma unroll
        for (int bj = 0; bj < 2; ++bj) {
            const int col = col0 + bj * 128;
            const bool sg = tile_sg && ((col >= C_GATE && col < IN_COLS) || (col >= C_MLO && col < C_MLIG));
#pragma unroll
            for (int ai = 0; ai < 2; ++ai)
#pragma unroll
                for (int m = 0; m < 4; ++m) {
                    half8 h;
#pragma unroll
                    for (int n = 0; n < 2; ++n)
#pragma unroll
                        for (int i = 0; i < 4; ++i) { float v = acc[ai][bj][m][n][i]; if (sg) v = sigm(v); h[4 * n + i] = (half_t)v; }
                    *(half8*)(P + (size_t)(row0 + ai * 128 + m * 16) * NP + col) = h;
                }
        }
    }
};
struct EpiNull {
    static constexpr bool PERM = true;
    float* sink;
    __device__ __forceinline__ void operator()(const f32x4 (&acc)[2][2][4][2], const Unit& u, int wr, int wc, int fr, int fq) const {
        f32x4 t = {0.f, 0.f, 0.f, 0.f};
#pragma unroll
        for (int ai = 0; ai < 2; ++ai)
#pragma unroll
            for (int bj = 0; bj < 2; ++bj)
#pragma unroll
                for (int m = 0; m < 4; ++m)
#pragma unroll
                    for (int n = 0; n < 2; ++n) t += acc[ai][bj][m][n];
        if (t[0] + t[1] + t[2] + t[3] == 12345.678f) sink[0] = t[0];
    }
};
struct EpiLora {
    static constexpr bool PERM = true;
    half_t* O; const float* w0; const float* a0;
    __device__ __forceinline__ void operator()(const f32x4 (&acc)[2][2][4][2], const Unit& u, int wr, int wc, int fr, int fq) const {
        const int row0 = u.pm * 256 + wr * 64 + fr, col0 = u.pn * 256 + wc * 32 + 8 * fq;
#pragma unroll
        for (int bj = 0; bj < 2; ++bj) {
            const int col = col0 + bj * 128, blk = col >> 9;
            float bias[8];
#pragma unroll
            for (int j = 0; j < 8; ++j) bias[j] = blk < 2 ? w0[col + j] : (blk < 4 ? a0[col - 1024 + j] : 0.f);
#pragma unroll
            for (int ai = 0; ai < 2; ++ai)
#pragma unroll
                for (int m = 0; m < 4; ++m) {
                    half8 h;
#pragma unroll
                    for (int n = 0; n < 2; ++n)
#pragma unroll
                        for (int i = 0; i < 4; ++i) { float v = acc[ai][bj][m][n][i] + bias[4 * n + i];
                            if (blk < 2) v = sigm(v) * 0.6065306597126334f; else if (blk < 4) v = sigm(v);
                            h[4 * n + i] = (half_t)v; }
                    *(half8*)(O + (size_t)(row0 + ai * 128 + m * 16) * 2560 + col) = h;
                }
        }
    }
};
struct EpiMerge {
    static constexpr bool PERM = true; static constexpr bool CARRY = true;
    half_t* M; const half_t* P;
    __device__ __forceinline__ bool operator()(f32x4 (&acc)[2][2][4][2], const Unit& u, int wr, int wc, int fr, int fq) const {
        const int bi = u.aux;
        const half_t* G0 = P + (size_t)(u.pm * 256 + wr * 64 + fr) * NP + C_GATE + bi * 1024 + u.pn * 256 + wc * 32 + 8 * fq;
        if (bi < 2) {
#pragma unroll
            for (int ai = 0; ai < 2; ++ai) {
                half8 gt[4][2], gn[4][2];
#pragma unroll
                for (int m = 0; m < 4; ++m)
#pragma unroll
                    for (int bj = 0; bj < 2; ++bj) { const half_t* q = G0 + (size_t)(ai * 128 + m * 16) * NP + bj * 128; gt[m][bj] = *(const half8*)q; gn[m][bj] = *(const half8*)(q + 1024); }
                EPI_LOAD_FENCE();
#pragma unroll
                for (int m = 0; m < 4; ++m)
#pragma unroll
                    for (int bj = 0; bj < 2; ++bj)
#pragma unroll
                        for (int n = 0; n < 2; ++n)
#pragma unroll
                            for (int i = 0; i < 4; ++i) acc[ai][bj][m][n][i] *= (float)gt[m][bj][4 * n + i] * frcp(fmaxf((float)gn[m][bj][4 * n + i], 6.0e-8f));
            }
            return true;
        }
        half_t* M0 = M + (size_t)(u.pm * 256 + wr * 64 + fr) * 1024 + u.pn * 256 + wc * 32 + 8 * fq;
#pragma unroll
        for (int ai = 0; ai < 2; ++ai) {
            half8 gt[4][2];
#pragma unroll
            for (int m = 0; m < 4; ++m)
#pragma unroll
                for (int bj = 0; bj < 2; ++bj) gt[m][bj] = *(const half8*)(G0 + (size_t)(ai * 128 + m * 16) * NP + bj * 128);
#pragma unroll
            for (int m = 0; m < 4; ++m)
#pragma unroll
                for (int bj = 0; bj < 2; ++bj) { half8 o;
#pragma unroll
                    for (int n = 0; n < 2; ++n)
#pragma unroll
                        for (int i = 0; i < 4; ++i) o[4 * n + i] = (half_t)((float)gt[m][bj][4 * n + i] * acc[ai][bj][m][n][i]);
                    *(half8*)(M0 + (size_t)(ai * 128 + m * 16) * 1024 + bj * 128) = o; }
        }
        return false;
    }
};
struct EpiOut {
    static constexpr bool PERM = true;
    Params p; int l, g, rg;
    __device__ __forceinline__ void operator()(const f32x4 (&acc)[2][2][4][2], const Unit& u, int wr, int wc, int fr, int fq) const {
        static_assert(RL % 256 == 0 && RCX % 256 == 0 && SEQ % 256 == 0, "row tiles must not straddle samples");
        const int r0 = u.pm * 256, cb = u.pn * 256 + wc * 32 + 8 * fq;
        half_t* dst = (half_t*)(p.ws + OFF_DX) + (size_t)(r0 + wr * 64 + fr) * D + cb; const float* md = mod_row(p, l, g, r0) + 2 * 1024 + cb;
        f32x4 mv[2][2];
#pragma unroll
        for (int bj = 0; bj < 2; ++bj)
#pragma unroll
            for (int n = 0; n < 2; ++n) mv[bj][n] = *(const f32x4*)(md + bj * 128 + 4 * n);
#pragma unroll
        for (int ai = 0; ai < 2; ++ai)
#pragma unroll
            for (int m = 0; m < 4; ++m)
#pragma unroll
                for (int bj = 0; bj < 2; ++bj) { half8 o;
#pragma unroll
                    for (int n = 0; n < 2; ++n)
#pragma unroll
                        for (int i = 0; i < 4; ++i) o[4 * n + i] = (half_t)(mv[bj][n][i] * acc[ai][bj][m][n][i]);
                    *(half8*)(dst + (size_t)(ai * 128 + m * 16) * D + bj * 128) = o; }
    }
};
struct EpiUp {
    static constexpr bool PERM = true;
    half_t* HID;
    __device__ __forceinline__ void operator()(const f32x4 (&acc)[2][2][4][2], const Unit& u, int wr, int wc, int fr, int fq) const {
        const int row0 = u.pm * 256 + wr * 64 + fr, col = u.pn * 128 + wc * 32 + 8 * fq;
#pragma unroll
        for (int ai = 0; ai < 2; ++ai)
#pragma unroll
            for (int m = 0; m < 4; ++m) {
                half8 h;
#pragma unroll
                for (int n = 0; n < 2; ++n)
#pragma unroll
                    for (int i = 0; i < 4; ++i) h[4 * n + i] = (half_t)(siluf(acc[ai][0][m][n][i]) * acc[ai][1][m][n][i]);
                *(half8*)(HID + (size_t)(row0 + ai * 128 + m * 16) * 512 + col) = h;
            }
    }
};
struct EpiDown {
    static constexpr bool PERM = true;
    half_t* YE; const float* AFF;
    __device__ __forceinline__ void operator()(const f32x4 (&acc)[2][2][4][2], const Unit& u, int wr, int wc, int fr, int fq) const {
        const int row0 = u.pm * 256 + wr * 64 + fr, col0 = u.pn * 256 + wc * 32 + 8 * fq;
        float afv[2][4];
#pragma unroll
        for (int ai = 0; ai < 2; ++ai)
#pragma unroll
            for (int m = 0; m < 4; ++m) afv[ai][m] = AFF[row0 + ai * 128 + m * 16];
        EPI_LOAD_FENCE();
#pragma unroll
        for (int ai = 0; ai < 2; ++ai)
#pragma unroll
            for (int m = 0; m < 4; ++m) {
                const size_t row = (size_t)(row0 + ai * 128 + m * 16); const float af = afv[ai][m];
#pragma unroll
                for (int bj = 0; bj < 2; ++bj) {
                    half8 h;
#pragma unroll
                    for (int n = 0; n < 2; ++n)
#pragma unroll
                        for (int i = 0; i < 4; ++i) h[4 * n + i] = (half_t)(acc[ai][bj][m][n][i] * af);
                    *(half8*)(YE + row * 1024 + col0 + bj * 128) = h;
                }
            }
    }
};

__device__ __forceinline__ void ph_mod(int wb, const Params& p, LAS unsigned char* lds) {
    LAS float* sv = (LAS float*)lds; LAS float* red = sv + (BATCH + 1) * 1024;
    const int tid = tid_fresh(wb);
    for (int i = tid; i < (BATCH + 1) * 1024; i += NT) { const int s = i >> 10, k = i & 1023; const float cv = s < BATCH ? p.in[I_C][s * 1024 + k] : p.in[I_CCTX][k]; sv[i] = siluf(cv); }
    SYNC();
    float* mod = (float*)(p.ws + OFF_MOD);
    for (int item = blockIdx.x; item < DEPTH * 48; item += gridDim.x) {
        const int l = item / 48, j = (item % 48) * 128 + (tid & 127), kq = tid >> 7;
        float acc[BATCH + 1];
#pragma unroll
        for (int s = 0; s <= BATCH; ++s) acc[s] = 0.f;
        const float* w = p.in[I_ADAW] + (size_t)l * 1024 * 6144 + j;
        for (int k = kq * 256; k < kq * 256 + 256; ++k) { const float wv = w[(size_t)k * 6144];
#pragma unroll
            for (int s = 0; s <= BATCH; ++s) acc[s] += sv[s * 1024 + k] * wv; }
#pragma unroll
        for (int s = 0; s <= BATCH; ++s) red[tid * (BATCH + 1) + s] = acc[s];
        SYNC();
        if (tid < 128) {
#pragma unroll
            for (int s = 0; s <= BATCH; ++s) { float v = p.in[I_ADAB][l * 6144 + j];
                for (int q = 0; q < 4; ++q) v += red[(q * 128 + tid) * (BATCH + 1) + s];
                mod[((size_t)l * (BATCH + 1) + s) * 6144 + j] = v; }
        }
        SYNC();
    }
}

__device__ __forceinline__ void tconv_tile(int wb, const float* src, int sld, int k0, int n0, int nvalid, half_t* dst, int dld, int drow0, int dcol0, LAS float* tile) {
    const int tid = tid_fresh(wb), r = tid >> 4, c4 = (tid & 15) * 4;
#pragma unroll
    for (int j = 0; j < 2; ++j) { const int k = r + 32 * j; f32x4 v = {0.f, 0.f, 0.f, 0.f};
        if (src && n0 + c4 < nvalid) v = *(const f32x4*)(src + (size_t)(k0 + k) * sld + n0 + c4);
        tile[k * 65 + c4] = v[0]; tile[k * 65 + c4 + 1] = v[1]; tile[k * 65 + c4 + 2] = v[2]; tile[k * 65 + c4 + 3] = v[3]; }
    SYNC();
    const int n = tid >> 3, k8 = (tid & 7) * 8; half8 h;
#pragma unroll
    for (int i = 0; i < 8; ++i) h[i] = (half_t)tile[(k8 + i) * 65 + n];
    *(half8*)(dst + (size_t)(drow0 + n) * dld + dcol0 + k8) = h;
    SYNC();
}
__device__ __forceinline__ void ph_convert(int wb, const Params& p, int l, int part, int ce, int ge, LAS unsigned char* lds) {
    LAS float* tile = (LAS float*)lds;
    constexpr int N_WIN = 16 * (NP / 64), N_WBR = 3 * 128, N_WOUT = 256, N_W13 = 2 * 2048, N_W2 = 2048, N_LORA = 240;
    constexpr int N_MID = N_WBR + N_WOUT + N_W13 + N_W2;
    half_t* ws16 = (half_t*)p.ws;
    const int nv = part == 0 ? N_WIN + N_LORA : N_MID;
    if (ce < 0) return;
    for (int v = ce; v < nv; v += ge) {
        const int item = part == 0 ? (v < N_WIN ? v : v + N_MID) : v + N_WIN;
        int it = item;
        if (it < N_WIN) { const int kt = it % 16, ntile = it / 16;
            tconv_tile(wb, p.in[I_WIN] + (size_t)l * 1024 * IN_COLS, IN_COLS, 64 * kt, 64 * ntile, IN_COLS, (half_t*)(p.ws + OFF_WIN), 1024, 64 * ntile, 64 * kt, tile); continue; }
        it -= N_WIN;
        if (it < N_WBR) { const int i = it / 128, rem = it % 128, kt = rem % 8, ntile = rem / 8;
            tconv_tile(wb, p.in[I_WBR] + (size_t)(l * 3 + i) * 512 * 1024, 1024, 64 * kt, 64 * ntile, 1024, (half_t*)(p.ws + OFF_WBR) + (size_t)i * 1024 * 512, 512, 64 * ntile, 64 * kt, tile); continue; }
        it -= N_WBR;
        if (it < N_WOUT) { const int kt = it % 16, ntile = it / 16;
            tconv_tile(wb, p.in[I_WOUT] + (size_t)l * 1024 * 1024, 1024, 64 * kt, 64 * ntile, 1024, (half_t*)(p.ws + OFF_WOUT), 1024, 64 * ntile, 64 * kt, tile); continue; }
        it -= N_WOUT;
        if (it < N_W13) { const int which = it / 2048, rem = it % 2048, e = rem / 128, r2 = rem % 128, kt = r2 % 16, ntile = r2 / 16, n0 = 64 * ntile;
            tconv_tile(wb, p.in[which ? I_W3 : I_W1] + (size_t)(l * 16 + e) * 1024 * 512, 512, 64 * kt, n0, 512, (half_t*)(p.ws + OFF_WUP) + (size_t)e * 1024 * 1024, 1024,
                       (n0 / 128) * 256 + which * 128 + (n0 % 128), 64 * kt, tile); continue; }
        it -= N_W13;
        if (it < N_W2) { const int e = it / 128, r2 = it % 128, kt = r2 % 8, ntile = r2 / 8;
            tconv_tile(wb, p.in[I_W2] + (size_t)(l * 16 + e) * 512 * 1024, 1024, 64 * kt, 64 * ntile, 1024, (half_t*)(p.ws + OFF_WDN) + (size_t)e * 1024 * 512, 512, 64 * ntile, 64 * kt, tile); continue; }
        it -= N_W2;
        { const int ntile = it / 6, kt = it % 6, n0 = 64 * ntile, blk = n0 / 512, nn0 = n0 % 512;
          const float* src = nullptr; int k0 = 0;
          if (blk == 0 && kt == 0) src = p.in[I_RWUP] + (size_t)(l * 2 + 0) * 64 * 512;
          else if (blk == 1 && kt == 1) src = p.in[I_RWUP] + (size_t)(l * 2 + 1) * 64 * 512;
          else if (blk == 2 && kt == 2) src = p.in[I_RAUP] + (size_t)(l * 2 + 0) * 64 * 512;
          else if (blk == 3 && kt == 3) src = p.in[I_RAUP] + (size_t)(l * 2 + 1) * 64 * 512;
          else if (blk == 4 && kt >= 4) { src = p.in[I_RGUP] + (size_t)l * 128 * 512; k0 = 64 * (kt - 4); }
          tconv_tile(wb, src, 512, k0, nn0, 512, (half_t*)(p.ws + OFF_WLORA), 384, n0, 64 * kt, tile); }
    }
    (void)ws16;
}

__device__ __forceinline__ void ph_xconv(int wb, const Params& p) {
    const int tid = tid_fresh(wb), wid = tid >> 6, lane = tid & 63;
    constexpr int NROW = BATCH * SEQ + BATCH * CTXL, RU = 4; const int rstep = gridDim.x * 8;
    for (int t0 = blockIdx.x * 8 + wid; t0 < NROW; t0 += rstep * RU) {
        f32x4 v[RU][4];
#pragma unroll
        for (int u = 0; u < RU; ++u) { const int t = t0 + u * rstep < NROW ? t0 + u * rstep : t0;
            const float* src = t < BATCH * SEQ ? p.in[I_X] + (size_t)t * D : p.in[I_CTX] + (size_t)(t - BATCH * SEQ) * D;
#pragma unroll
            for (int j = 0; j < 4; ++j) v[u][j] = *(const f32x4*)(src + lane * 4 + 256 * j); }
        EPI_LOAD_FENCE();
#pragma unroll
        for (int u = 0; u < RU; ++u) { const int t = t0 + u * rstep; if (t >= NROW) continue;
            half_t* dst = (half_t*)(t < BATCH * SEQ ? p.out + (size_t)t * D : (float*)(p.ws + OFF_CTXR) + (size_t)(t - BATCH * SEQ) * D) + 1024;
#pragma unroll
            for (int j = 0; j < 4; ++j) *(half4*)(dst + lane * 4 + 256 * j) = cvt4(v[u][j]); }
    }
}

__device__ __forceinline__ void ph_norm1(int wb, const Params& p, int l, int g) {
    const int tid = tid_fresh(wb), wid = tid >> 6, lane = tid & 63;
    half_t* H = (half_t*)(p.ws + OFF_H);
    constexpr int RU = 2;
    const int rstep = gridDim.x * 8; const float* gn = p.in[I_N1G] + l * D;
    const Geo gq = geo_of(g); const int RG = gq.rg, RGPg = gq.rgp;
    f32x4 gv[4];
#pragma unroll
    for (int j = 0; j < 4; ++j) gv[j] = *(const f32x4*)(gn + lane * 4 + 256 * j);
    for (int r0 = blockIdx.x * 8 + wid; r0 < RGPg; r0 += rstep * RU) {
        f32x4 v[RU][4], sh[RU][4], sc[RU][4]; float ss[RU];
#pragma unroll
        for (int u = 0; u < RU; ++u) { const int r = r0 + u * rstep < RG ? r0 + u * rstep : 0;
            const half_t* xr = res_h(p, g, r); const float* md = mod_row(p, l, g, r);
#pragma unroll
            for (int j = 0; j < 4; ++j) { const int c = lane * 4 + 256 * j; v[u][j] = h4f(*(const half4*)(xr + c)); sh[u][j] = *(const f32x4*)(md + c); sc[u][j] = *(const f32x4*)(md + 1024 + c); } }
        EPI_LOAD_FENCE();
#pragma unroll
        for (int u = 0; u < RU; ++u) { float a = 0.f;
#pragma unroll
            for (int j = 0; j < 4; ++j) a += v[u][j][0] * v[u][j][0] + v[u][j][1] * v[u][j][1] + v[u][j][2] * v[u][j][2] + v[u][j][3] * v[u][j][3];
            ss[u] = a; }
#pragma unroll
        for (int u = 0; u < RU; ++u) ss[u] = wave_sum(ss[u]);
#pragma unroll
        for (int u = 0; u < RU; ++u) { const int r = r0 + u * rstep; if (r >= RGPg) continue;
            if (r >= RG) { for (int j = 0; j < 4; ++j) *(half4*)(H + (size_t)r * D + lane * 4 + 256 * j) = (half4){0, 0, 0, 0}; continue; }
            const float rinv = frsq(ss[u] * (1.f / D) + 1e-6f);
#pragma unroll
            for (int j = 0; j < 4; ++j) { const int c = lane * 4 + 256 * j;
                *(half4*)(H + (size_t)r * D + c) = cvt4(v[u][j] * rinv * gv[j] * (sc[u][j] + 1.f) + sh[u][j]); } }
    }
#ifndef CPU_EMU
    if (WARM_WIN) {
        const uint4* wp = (const uint4*)(p.ws + OFF_WIN); unsigned acc = 0u;
        for (size_t i = (size_t)blockIdx.x * NT + tid; i < (size_t)NP * 1024 * 2 / 16; i += (size_t)gridDim.x * NT) acc ^= wp[i].x;
        if (acc == 0x9E3779B9u && tid == 99999) *(unsigned*)(p.ws + OFF_BAR + 15000) = acc;
    }
#endif
}

struct RowGeo { int gw, gh, base, gr, gc; };
__device__ __forceinline__ RowGeo row_geo(int r) {
    RowGeo q; int i;
    if (r < RL) { const int bl = r / SEQ; i = r % SEQ; q.gw = 64; q.gh = SEQ / 64; q.base = bl * SEQ; }
    else { const int rr = r - RL, bl = rr / CTXL; i = rr % CTXL; q.gw = CTXL; q.gh = 1; q.base = RL + bl * CTXL; }
    q.gr = i / q.gw; q.gc = i % q.gw; return q;
}

template <int PV = 3> __device__ __forceinline__ void ph_prep(int wb, const Params& p, int l, int RG, LAS unsigned char* lds) {
    const int tid = tid_fresh(wb), wid = tid >> 6, lane = tid & 63;
    LAS float* cw = (LAS float*)lds;
    for (int i = tid; i < 9 * 1536; i += NT) cw[i] = p.in[I_GCONV][(size_t)l * 9 * 1536 + i];
    SYNC();
    const half_t* P = (const half_t*)(p.ws + OFF_P);
    half_t* GQKV = (half_t*)(p.ws + OFF_GQKV); float* GBG = (float*)(p.ws + OFF_GBG);
    half_t* RW = (half_t*)(p.ws + OFF_RW); half_t* RLI = (half_t*)(p.ws + OFF_RLI);
    f32x4 muv[4][2]; f32x4 kkv[2];
    { const float* mu = p.in[I_RMU] + (size_t)l * 1920;
#pragma unroll
      for (int j = 0; j < 4; ++j) { const int cj = j < 3 ? j * 512 + 8 * lane : 1536 + 8 * (lane < 48 ? lane : 47); muv[j][0] = *(const f32x4*)(mu + cj); muv[j][1] = *(const f32x4*)(mu + cj + 4); }
      const float* kkw = p.in[I_RKK] + (size_t)l * 512 + 8 * lane; kkv[0] = *(const f32x4*)(kkw); kkv[1] = *(const f32x4*)(kkw + 4); }
    for (int r = blockIdx.x * 8 + wid; r < RG; r += gridDim.x * 8) {
        const RowGeo q = row_geo(r);
        if (PV & 1) {
        float acc[3][8];
#pragma unroll
        for (int j = 0; j < 3; ++j)
#pragma unroll
            for (int e = 0; e < 8; ++e) acc[j][e] = 0.f;
        for (int kh = 0; kh < 3; ++kh) { const int nr = q.gr + kh - 1; if (nr < 0 || nr >= q.gh) continue;
            for (int kw = 0; kw < 3; ++kw) { const int nc = q.gc + kw - 1; if (nc < 0 || nc >= q.gw) continue;
                const size_t nrow = (size_t)(q.base + nr * q.gw + nc);
#pragma unroll
                for (int j = 0; j < 3; ++j) { const half8 pv = *(const half8*)(P + nrow * NP + j * 512 + 8 * lane); const LAS float* w = cw + (kh * 3 + kw) * 1536 + j * 512 + 8 * lane;
#pragma unroll
                    for (int e = 0; e < 8; ++e) acc[j][e] += (float)pv[e] * w[e]; } } }
#pragma unroll
        for (int j = 0; j < 3; ++j) {
            float ss = 0.f;
#pragma unroll
            for (int e = 0; e < 8; ++e) { acc[j][e] = siluf(acc[j][e]); ss += acc[j][e] * acc[j][e]; }
            float sc = 1.f;
            if (j < 2) { ss += SHFL_XOR(ss, 1); ss += SHFL_XOR(ss, 2); ss += SHFL_XOR(ss, 4); ss += SHFL_XOR(ss, 8); sc = frsq(ss + 1e-6f) * (j == 0 ? 0.08838834764831845f : 1.f); }
            half8 h;
#pragma unroll
            for (int e = 0; e < 8; ++e) h[e] = (half_t)(acc[j][e] * sc);
            *(half8*)(GQKV + (size_t)r * 1536 + j * 512 + 8 * lane) = h;
        }
        if (lane < 16) { const float x = (float)P[(size_t)r * NP + C_BG + lane];
            float o; if (lane < 8) o = sigm(x); else { const int idx = lane - 8; o = -fexp(p.in[I_GALOG][l * 8 + idx]) * softplusf(x + p.in[I_GDTB][l * 8 + idx]); }
            GBG[(size_t)r * 16 + lane] = o; }
        }
        if (PV & 2) {
        const int nb[4] = { q.gc > 0 ? r - 1 : -1, q.gc < q.gw - 1 ? r + 1 : -1, q.gr > 0 ? r - q.gw : -1, q.gr < q.gh - 1 ? r + q.gw : -1 };
        float kmix[8];
#pragma unroll
        for (int j = 0; j < 4; ++j) {
            if (j == 3 && lane >= 48) break;
            const int cj = j < 3 ? j * 512 + 8 * lane : 1536 + 8 * lane;
            const half8 self = *(const half8*)(P + (size_t)r * NP + C_RWKV + cj);
            half8 nv[4];
#pragma unroll
            for (int d = 0; d < 4; ++d) { if (nb[d] >= 0) nv[d] = *(const half8*)(P + (size_t)nb[d] * NP + C_RWKV + cj); else nv[d] = (half8){0, 0, 0, 0, 0, 0, 0, 0}; }
            float val[8];
#pragma unroll
            for (int e = 0; e < 8; ++e) { const float s = (float)self[e], nn = (float)nv[e & 3][e]; val[e] = s + (nn - s) * muv[j][e >> 2][e & 3]; }
            half8 h;
            if (j < 3) {
#pragma unroll
                for (int e = 0; e < 8; ++e) h[e] = (half_t)val[e];
                *(half8*)(RW + ((size_t)r * 4 + j) * 512 + 8 * lane) = h;
                if (j == 1) {
#pragma unroll
                    for (int e = 0; e < 8; ++e) kmix[e] = val[e]; }
            } else {
                const int c0 = 8 * lane;
#pragma unroll
                for (int e = 0; e < 8; ++e) { float v = val[e]; if (c0 < 128) v = ftanh(v); else if (c0 >= 256) v = sigm(v); h[e] = (half_t)v; }
                *(half8*)(RLI + (size_t)r * 384 + c0) = h;
            }
        }
        { float t[8], ss = 0.f;
#pragma unroll
          for (int e = 0; e < 8; ++e) { t[e] = kmix[e] * kkv[e >> 2][e & 3]; ss += t[e] * t[e]; }
          ss += SHFL_XOR(ss, 1); ss += SHFL_XOR(ss, 2); ss += SHFL_XOR(ss, 4);
          const float sc = frsq(ss + 1e-6f); half8 h;
#pragma unroll
          for (int e = 0; e < 8; ++e) h[e] = (half_t)(t[e] * sc);
          *(half8*)(RW + ((size_t)r * 4 + 3) * 512 + 8 * lane) = h; }
        }
    }
}

__device__ __forceinline__ void ph_prep2(int wb, const Params& p, int l, int RG, LAS unsigned char* lds) {
    const int tid = tid_fresh(wb), wid = tid >> 6, lane = tid & 63;
    LAS float* cw = (LAS float*)lds;
    for (int i = tid; i < 9 * 1536; i += NT) cw[i] = p.in[I_GCONV][(size_t)l * 9 * 1536 + i];
    SYNC();
    const half_t* P = (const half_t*)(p.ws + OFF_P);
    half_t* GQKV = (half_t*)(p.ws + OFF_GQKV); float* GBG = (float*)(p.ws + OFF_GBG);
    half_t* RW = (half_t*)(p.ws + OFF_RW); half_t* RLI = (half_t*)(p.ws + OFF_RLI);
    f32x4 kkv[2]; const float* mu = p.in[I_RMU] + (size_t)l * 1920;
    { const float* kkw = p.in[I_RKK] + (size_t)l * 512 + 8 * lane; kkv[0] = *(const f32x4*)(kkw); kkv[1] = *(const f32x4*)(kkw + 4); }
    const half8 z8 = {0, 0, 0, 0, 0, 0, 0, 0};
    for (int pr = blockIdx.x * 8 + wid; pr < RG / 2; pr += gridDim.x * 8) {
        const int rA = 2 * pr; const RowGeo q = row_geo(rA);
        { float acc[2][3][8];
#pragma unroll
          for (int t = 0; t < 2; ++t)
#pragma unroll
            for (int j = 0; j < 3; ++j)
#pragma unroll
                for (int e = 0; e < 8; ++e) acc[t][j][e] = 0.f;
#pragma unroll 1
          for (int kh = 0; kh < 3; ++kh) { const int nr = q.gr + kh - 1; if (nr < 0 || nr >= q.gh) continue;
            half8 col[4][3];
#pragma unroll
            for (int cc = 0; cc < 4; ++cc) { const int nc = q.gc - 1 + cc; const bool ok = nc >= 0 && nc < q.gw; const size_t nrow = (size_t)(q.base + nr * q.gw + (ok ? nc : 0));
#pragma unroll
                for (int j = 0; j < 3; ++j) col[cc][j] = ok ? *(const half8*)(P + nrow * NP + j * 512 + 8 * lane) : z8; }
#pragma unroll
            for (int kw = 0; kw < 3; ++kw)
#pragma unroll
                for (int j = 0; j < 3; ++j) { const LAS float* w = cw + (kh * 3 + kw) * 1536 + j * 512 + 8 * lane; const f32x4 w0 = *(const LAS f32x4*)w, w1 = *(const LAS f32x4*)(w + 4);
#pragma unroll
                    for (int e = 0; e < 4; ++e) { acc[0][j][e] += (float)col[kw][j][e] * w0[e]; acc[0][j][4 + e] += (float)col[kw][j][4 + e] * w1[e];
                        acc[1][j][e] += (float)col[kw + 1][j][e] * w0[e]; acc[1][j][4 + e] += (float)col[kw + 1][j][4 + e] * w1[e]; } } }
#pragma unroll
          for (int t = 0; t < 2; ++t) { const int r = rA + t;
#pragma unroll
            for (int j = 0; j < 3; ++j) {
                float ss = 0.f;
#pragma unroll
                for (int e = 0; e < 8; ++e) { acc[t][j][e] = siluf(acc[t][j][e]); ss += acc[t][j][e] * acc[t][j][e]; }
                float sc = 1.f;
                if (j < 2) { ss += SHFL_XOR(ss, 1); ss += SHFL_XOR(ss, 2); ss += SHFL_XOR(ss, 4); ss += SHFL_XOR(ss, 8); sc = frsq(ss + 1e-6f) * (j == 0 ? 0.08838834764831845f : 1.f); }
                half8 h;
#pragma unroll
                for (int e = 0; e < 8; ++e) h[e] = (half_t)(acc[t][j][e] * sc);
                *(half8*)(GQKV + (size_t)r * 1536 + j * 512 + 8 * lane) = h;
            }
            if (lane < 16) { const float x = (float)P[(size_t)r * NP + C_BG + lane];
                float o; if (lane < 8) o = sigm(x); else { const int idx = lane - 8; o = -fexp(p.in[I_GALOG][l * 8 + idx]) * softplusf(x + p.in[I_GDTB][l * 8 + idx]); }
                GBG[(size_t)r * 16 + lane] = o; } } }
        { const int rL = q.gc > 0 ? rA - 1 : -1, rR = q.gc + 2 < q.gw ? rA + 2 : -1, rUA = q.gr > 0 ? rA - q.gw : -1, rDA = q.gr < q.gh - 1 ? rA + q.gw : -1;
          float kmix[2][8];
#pragma unroll
          for (int jj = 0; jj < 2; ++jj) {
            half8 sA[2], sB[2], vL[2], vR[2], vUA[2], vUB[2], vDA[2], vDB[2]; f32x4 mu0[2], mu1[2];
#pragma unroll
            for (int ji = 0; ji < 2; ++ji) { const int j = 2 * jj + ji;
              const int la = (j == 3 && lane >= 48) ? 0 : lane;
              const int cj = j < 3 ? j * 512 + 8 * la : 1536 + 8 * la;
              const half_t* pc = P + C_RWKV + cj; mu0[ji] = *(const f32x4*)(mu + cj); mu1[ji] = *(const f32x4*)(mu + cj + 4);
              sA[ji] = *(const half8*)(pc + (size_t)rA * NP); sB[ji] = *(const half8*)(pc + (size_t)(rA + 1) * NP);
              vL[ji] = rL >= 0 ? *(const half8*)(pc + (size_t)rL * NP) : z8; vR[ji] = rR >= 0 ? *(const half8*)(pc + (size_t)rR * NP) : z8;
              vUA[ji] = rUA >= 0 ? *(const half8*)(pc + (size_t)rUA * NP) : z8; vUB[ji] = rUA >= 0 ? *(const half8*)(pc + (size_t)(rUA + 1) * NP) : z8;
              vDA[ji] = rDA >= 0 ? *(const half8*)(pc + (size_t)rDA * NP) : z8; vDB[ji] = rDA >= 0 ? *(const half8*)(pc + (size_t)(rDA + 1) * NP) : z8; }
            EPI_LOAD_FENCE();
#pragma unroll
            for (int ji = 0; ji < 2; ++ji) { const int j = 2 * jj + ji;
              if (j == 3 && lane >= 48) continue;
#pragma unroll
              for (int t = 0; t < 2; ++t) { const int r = rA + t;
                const half8 self = t ? sB[ji] : sA[ji], n0 = t ? sA[ji] : vL[ji], n1 = t ? vR[ji] : sB[ji], n2 = t ? vUB[ji] : vUA[ji], n3 = t ? vDB[ji] : vDA[ji];
                float val[8];
#pragma unroll
                for (int e = 0; e < 8; ++e) { const float s_ = (float)self[e]; const float nn = (float)((e & 3) == 0 ? n0[e] : (e & 3) == 1 ? n1[e] : (e & 3) == 2 ? n2[e] : n3[e]); val[e] = s_ + (nn - s_) * (e < 4 ? mu0[ji][e & 3] : mu1[ji][e & 3]); }
                half8 h;
                if (j < 3) {
#pragma unroll
                    for (int e = 0; e < 8; ++e) h[e] = (half_t)val[e];
                    *(half8*)(RW + ((size_t)r * 4 + j) * 512 + 8 * lane) = h;
                    if (j == 1) {
#pragma unroll
                        for (int e = 0; e < 8; ++e) kmix[t][e] = val[e]; }
                } else {
                    const int c0 = 8 * lane;
#pragma unroll
                    for (int e = 0; e < 8; ++e) { float v = val[e]; if (c0 < 128) v = ftanh(v); else if (c0 >= 256) v = sigm(v); h[e] = (half_t)v; }
                    *(half8*)(RLI + (size_t)r * 384 + c0) = h;
                } } } }
#pragma unroll
          for (int t = 0; t < 2; ++t) { float tt[8], ss = 0.f;
#pragma unroll
            for (int e = 0; e < 8; ++e) { tt[e] = kmix[t][e] * kkv[e >> 2][e & 3]; ss += tt[e] * tt[e]; }
            ss += SHFL_XOR(ss, 1); ss += SHFL_XOR(ss, 2); ss += SHFL_XOR(ss, 4);
            const float sc = frsq(ss + 1e-6f); half8 h;
#pragma unroll
            for (int e = 0; e < 8; ++e) h[e] = (half_t)(tt[e] * sc);
            *(half8*)(RW + ((size_t)(rA + t) * 4 + 3) * 512 + 8 * lane) = h; } }
    }
}

#ifndef CPU_EMU
__device__ __forceinline__ float shfl_up_f(float v, int off, int lane) { const float o = __int_as_float(__builtin_amdgcn_ds_bpermute(((lane - off) & 63) << 2, __float_as_int(v))); return lane >= off ? o : v; }
#else
static inline float shfl_up_f(float v, int off, int lane) { const float o = emu_shfl(v, (lane - off) & 63); return lane >= off ? o : v; }
#endif
__device__ __forceinline__ void ph_wy(int wb, const Params& p, int RG, LAS unsigned char* lds) {
#ifndef CPU_EMU
    const int tid = tid_fresh(wb), wid = __builtin_amdgcn_readfirstlane(tid >> 6), lane = tid & 63, fr = lane & 15, fq = lane >> 4;
#else
    const int tid = tid_fresh(wb), wid = tid >> 6, lane = tid & 63, fr = lane & 15, fq = lane >> 4;
#endif
    const int slot = wid >> 1, d = wid & 1;
    LAS half_t* Lm = (LAS half_t*)(lds + wid * 16896);
    LAS half_t* Xm = Lm + 4096;
    LAS float* Gv = (LAS float*)(Xm + 4096);
    LAS float* Bv = Gv + 64;
    const half_t* GQKV = (const half_t*)(p.ws + OFF_GQKV); const float* GBG = (const float*)(p.ws + OFF_GBG);
    half_t* GTA = (half_t*)(p.ws + OFF_GTA); float* GG = (float*)(p.ws + OFF_GG);
    const int n_items = (RG / 64) * 4;
    SYNC();
    for (int base = blockIdx.x * 4; base < n_items; base += gridDim.x * 4) {
        const int item = base + slot;
        if (item < n_items) {
            const int cidx = item >> 2, h = item & 3, r0 = cidx * 64;
            const size_t tb = (size_t)((cidx * 4 + h) * 2 + d);
            { const int nat = d ? 63 - lane : lane; const float beta = GBG[(size_t)(r0 + nat) * 16 + d * 4 + h]; float G = GBG[(size_t)(r0 + nat) * 16 + 8 + d * 4 + h];
#pragma unroll
              for (int off = 1; off < 64; off <<= 1) { const float o = shfl_up_f(G, off, lane); G = lane >= off ? G + o : G; }
              Gv[lane] = G; Bv[lane] = beta; GG[tb * 64 + lane] = G; }
            WAVE_SYNC();
            half8 kf[4][4];
#pragma unroll
            for (int t = 0; t < 4; ++t)
#pragma unroll
                for (int ks = 0; ks < 4; ++ks) kf[t][ks] = *(const half8*)(GQKV + (size_t)(r0 + 16 * t + fr) * 1536 + 512 + h * 128 + 32 * ks + 8 * fq);
#pragma unroll
            for (int ti = 0; ti < 4; ++ti)
#pragma unroll
                for (int tj = 0; tj < 4; ++tj) {
                    if (d ? (tj < ti) : (tj > ti)) continue;
                    f32x4 acc = {0.f, 0.f, 0.f, 0.f};
#pragma unroll
                    for (int ks = 0; ks < 4; ++ks) acc = MFMA16(kf[tj][ks], kf[ti][ks], acc);
                    const int i = 16 * ti + fr, ip = d ? 63 - i : i; const float gi = Gv[ip], bi = Bv[ip]; f32x4 val;
#pragma unroll
                    for (int e = 0; e < 4; ++e) { const int j = 16 * tj + 4 * fq + e, jp = d ? 63 - j : j; val[e] = (jp < ip) ? bi * acc[e] * fexp(gi - Gv[jp]) : 0.f; }
                    if (d) *(LAS half4*)(Lm + ip * 64 + 60 - 16 * tj - 4 * fq) = cvt4((f32x4){val[3], val[2], val[1], val[0]});
                    else *(LAS half4*)(Lm + ip * 64 + 16 * tj + 4 * fq) = cvt4(val);
                }
#pragma unroll
            for (int ti = 0; ti < 4; ++ti) {
                half8 qf[4];
#pragma unroll
                for (int ks = 0; ks < 4; ++ks) qf[ks] = *(const half8*)(GQKV + (size_t)(r0 + 16 * ti + fr) * 1536 + h * 128 + 32 * ks + 8 * fq);
#pragma unroll
                for (int tj = 0; tj < 4; ++tj) {
                    const int i = 16 * ti + fr, ip = d ? 63 - i : i; f32x4 val = {0.f, 0.f, 0.f, 0.f};
                    if (!(d ? (tj < ti) : (tj > ti))) {
                        f32x4 acc = {0.f, 0.f, 0.f, 0.f};
#pragma unroll
                        for (int ks = 0; ks < 4; ++ks) acc = MFMA16(kf[tj][ks], qf[ks], acc);
                        const float gi = Gv[ip];
#pragma unroll
                        for (int e = 0; e < 4; ++e) { const int j = 16 * tj + 4 * fq + e, jp = d ? 63 - j : j; val[e] = (jp <= ip) ? acc[e] * fexp(gi - Gv[jp]) : 0.f; }
                    }
                    half_t* ap = GTA + (tb * 2 + 1) * 4096 + ip * 64;
                    if (d) *(half4*)(ap + 60 - 16 * tj - 4 * fq) = cvt4((f32x4){val[3], val[2], val[1], val[0]});
                    else *(half4*)(ap + 16 * tj + 4 * fq) = cvt4(val);
                }
            }
            WAVE_SYNC();
#pragma unroll 1
            for (int bi = 0; bi < 4; ++bi) {
                const LAS half_t* Lb = Lm + bi * 16 * 64; float a[16];
                WAVE_SYNC();
                if (bi > 0) {
#pragma unroll 1
                    for (int ct = 0; ct < bi; ++ct) { f32x4 u4 = {0.f, 0.f, 0.f, 0.f};
#pragma unroll 1
                        for (int ks = 0; ks < (bi + 1) / 2; ++ks) {
                            half8 af = ldfrag(Lm, 16 * bi, 64, 32 * ks, lane), bf = ldfrag(Lm, 16 * ct, 64, 32 * ks, lane);
#pragma unroll
                            for (int e = 0; e < 8; ++e) { const int k = 32 * ks + 8 * fq + e; const bool ka = k < 16 * bi, kb = ka && k >= 16 * ct + fr;
                                af[e] = ka ? af[e] : (half_t)0.f; bf[e] = kb ? bf[e] : (half_t)0.f; }
                            u4 = MFMA16(af, bf, u4); }
#pragma unroll
                        for (int e = 0; e < 4; ++e) Xm[(16 * bi + 4 * fq + e) * 64 + 16 * ct + fr] = (half_t)u4[e]; }
                    WAVE_SYNC();
                }
#pragma unroll
                for (int ii = 0; ii < 16; ++ii) { a[ii] = (bi * 16 + ii == lane) ? 1.f : 0.f; if (lane < 16 * bi) a[ii] -= (float)Xm[(bi * 16 + ii) * 64 + lane]; }
#pragma unroll
                for (int ii = 0; ii < 16; ++ii) { float sacc = a[ii];
#pragma unroll
                    for (int mm = 0; mm < ii; ++mm) sacc -= (float)Lb[ii * 64 + bi * 16 + mm] * a[mm];
                    a[ii] = sacc; }
#pragma unroll
                for (int ii = 0; ii < 16; ++ii) { const half_t xh = (half_t)a[ii]; Xm[(bi * 16 + ii) * 64 + lane] = xh; if (bi * 16 + ii >= lane) Lm[lane * 64 + bi * 16 + ii] = xh; }
            }
            WAVE_SYNC();
#pragma unroll 1
            for (int t = 0; t < 8; ++t) { const int v = lane + 64 * t, i = v >> 3, j8 = (v & 7) * 8; const half8 x = *(const LAS half8*)(Xm + i * 64 + j8); half8 o;
#pragma unroll
                for (int e = 0; e < 8; ++e) o[e] = (half_t)((float)x[e] * Bv[j8 + e]);
                *(half8*)(GTA + (tb * 2 + 0) * 4096 + i * 64 + j8) = o; }
            WAVE_SYNC();
        }
    }
    SYNC();
}

__device__ __forceinline__ void scan_gdn(int wb, const Params& p, int bl, int gs, int h, int d, int mode, LAS unsigned char* lds) {
    const int tid = tid_fresh(wb), wid = tid >> 6, lane = tid & 63, fr = lane & 15, fq = lane >> 4;
    constexpr int L72 = 72, L136 = 136;
    LAS half_t* kT = (LAS half_t*)lds;
    LAS half_t* vT = kT + 128 * L72;
    LAS half_t* VNs = vT + 128 * L72;
    LAS half_t* Tb = VNs + 128 * L72;
    LAS half_t* Tbe = Tb + 64 * L72;
    LAS half_t* Am = Tbe + 64 * L72;
    LAS half_t* Qg = Am + 64 * L72;
    LAS half_t* Wn = Qg + 64 * L136;
    LAS half_t* ST = Wn + 64 * L136;
    LAS float* Es = (LAS float*)(ST + 128 * L136);
    const half_t* GQKV = (const half_t*)(p.ws + OFF_GQKV);
    const half_t* GTA = (const half_t*)(p.ws + OFF_GTA); const float* GG = (const float*)(p.ws + OFF_GG);
    half_t* SOG = (half_t*)(p.ws + OFF_SOG) + (size_t)d * RGP * 512;
    SYNC();
    for (int i = tid; i < 128 * L136 / 8; i += NT) *(LAS half8*)(ST + i * 8) = (half8){0, 0, 0, 0, 0, 0, 0, 0};
    SYNC();
    f32x4 accS[8];
#pragma unroll
    for (int u = 0; u < 8; ++u) accS[u] = (f32x4){0.f, 0.f, 0.f, 0.f};
    constexpr int nchC = CTXL / 64, nchL = SEQ / 64, NCS = nchC + nchL;
    half8 pT, pA, pq[2], pk[2], pv[2]; f32x4 pg0, pg1; float pgi[2], pG = 0.f, pGl = 0.f; int nr0 = 0, cr0 = 0;
    const int ti = tid >> 3, tj8 = (tid & 7) * 8;
    auto issue = [&](int cs) {
        const bool isc = cs < nchC; const int cl = isc ? cs : cs - nchC, nch = isc ? nchC : nchL, cn = d ? nch - 1 - cl : cl;
        const int r0 = (isc ? RL + gs * CTXL : bl * SEQ) + cn * 64; nr0 = r0;
        const size_t tb = (size_t)(((r0 >> 6) * 4 + h) * 2 + d);
        pT = *(const half8*)(GTA + (tb * 2 + 0) * 4096 + ti * 64 + tj8); pA = *(const half8*)(GTA + (tb * 2 + 1) * 4096 + ti * 64 + tj8);
        pg0 = *(const f32x4*)(GG + tb * 64 + tj8); pg1 = *(const f32x4*)(GG + tb * 64 + tj8 + 4);
#pragma unroll
        for (int t = 0; t < 2; ++t) { const int v = tid + NT * t, i = v >> 4, c8 = (v & 15) * 8, nat = d ? 63 - i : i;
            pq[t] = *(const half8*)(GQKV + (size_t)(r0 + nat) * 1536 + h * 128 + c8); pgi[t] = GG[tb * 64 + i]; }
#pragma unroll
        for (int t = 0; t < 2; ++t) { const int g = wid + 8 * t, nat = d ? 63 - lane : lane;
            pk[t] = *(const half8*)(GQKV + (size_t)(r0 + nat) * 1536 + 512 + h * 128 + 8 * g); pv[t] = *(const half8*)(GQKV + (size_t)(r0 + nat) * 1536 + 1024 + h * 128 + 8 * g); }
        pG = GG[tb * 64 + (tid & 63)]; pGl = GG[tb * 64 + 63];
    };
    const int cs0 = mode == 2 ? nchC : 0, cs1 = mode == 1 ? nchC : NCS;
    const int sv = gs >= BG ? gs - BG : 0;
    f32x4* gst = (f32x4*)(p.ws + OFF_GST) + ((size_t)((sv * 4 + h) * 2 + d) * 8 + wid) * 512;
    if (mode == 2) {
#pragma unroll
        for (int u = 0; u < 8; ++u) { accS[u] = gst[u * 64 + lane]; *(LAS half4*)(ST + (16 * wid + fr) * L136 + 16 * u + 4 * fq) = cvt4(accS[u]); }
        WAVE_SYNC();
    }
    issue(cs0);
    for (int cs = cs0; cs < cs1; ++cs) {
        SYNC();
        { half8 te; const float ge[8] = {pg0[0], pg0[1], pg0[2], pg0[3], pg1[0], pg1[1], pg1[2], pg1[3]};
#pragma unroll
          for (int e = 0; e < 8; ++e) te[e] = (half_t)((float)pT[e] * fexp(ge[e]));
          *(LAS half8*)(Tb + ti * L72 + tj8) = pT; *(LAS half8*)(Tbe + ti * L72 + tj8) = te; *(LAS half8*)(Am + ti * L72 + tj8) = pA; }
#pragma unroll
        for (int t = 0; t < 2; ++t) { const int v = tid + NT * t, i = v >> 4, c8 = (v & 15) * 8; const float sc = fexp(pgi[t]); half8 o;
#pragma unroll
            for (int e = 0; e < 8; ++e) o[e] = (half_t)((float)pq[t][e] * sc);
            *(LAS half8*)(Qg + i * L136 + c8) = o; }
#pragma unroll
        for (int t = 0; t < 2; ++t) { const int g = wid + 8 * t;
#pragma unroll
            for (int e = 0; e < 8; ++e) { kT[(8 * g + e) * L72 + lane] = pk[t][e]; vT[(8 * g + e) * L72 + lane] = pv[t][e]; } }
        if (tid < 64) Es[tid] = fexp(pGl - pG);
        const float dec = fexp(pGl);
        cr0 = nr0;
        if (cs + 1 < cs1) issue(cs + 1);
        SYNC();
        { f32x4 acc[4];
#pragma unroll
          for (int t = 0; t < 4; ++t) acc[t] = (f32x4){0.f, 0.f, 0.f, 0.f};
#pragma unroll
          for (int k2 = 0; k2 < 2; ++k2) { const half8 a = ldfrag(kT, 16 * wid, L72, 32 * k2, lane);
#pragma unroll
              for (int t = 0; t < 4; ++t) acc[t] = MFMA16(a, ldfrag(Tbe, 16 * t, L72, 32 * k2, lane), acc[t]); }
#pragma unroll
          for (int t = 0; t < 4; ++t) *(LAS half4*)(Wn + (16 * t + fr) * L136 + 16 * wid + 4 * fq) = cvt4(-acc[t]); }
        SYNC();
        { f32x4 acc[4];
#pragma unroll
          for (int t = 0; t < 4; ++t) acc[t] = (f32x4){0.f, 0.f, 0.f, 0.f};
#pragma unroll
          for (int k2 = 0; k2 < 2; ++k2) { const half8 b = ldfrag(vT, 16 * wid, L72, 32 * k2, lane);
#pragma unroll
              for (int t = 0; t < 4; ++t) acc[t] = MFMA16(ldfrag(Tb, 16 * t, L72, 32 * k2, lane), b, acc[t]); }
#pragma unroll
          for (int k4 = 0; k4 < 4; ++k4) { const half8 b = ldfrag(ST, 16 * wid, L136, 32 * k4, lane);
#pragma unroll
              for (int t = 0; t < 4; ++t) acc[t] = MFMA16(ldfrag(Wn, 16 * t, L136, 32 * k4, lane), b, acc[t]); }
          WAVE_SYNC();
#pragma unroll
          for (int t = 0; t < 4; ++t) { const f32x4 es = *(const LAS f32x4*)(Es + 16 * t + 4 * fq);
              *(LAS half4*)(vT + (16 * wid + fr) * L72 + 16 * t + 4 * fq) = cvt4(acc[t]); *(LAS half4*)(VNs + (16 * wid + fr) * L72 + 16 * t + 4 * fq) = cvt4(acc[t] * es); } }
        WAVE_SYNC();
        { f32x4 acc[4];
#pragma unroll
          for (int t = 0; t < 4; ++t) acc[t] = (f32x4){0.f, 0.f, 0.f, 0.f};
#pragma unroll
          for (int k4 = 0; k4 < 4; ++k4) { const half8 a = ldfrag(ST, 16 * wid, L136, 32 * k4, lane);
#pragma unroll
              for (int t = 0; t < 4; ++t) acc[t] = MFMA16(a, ldfrag(Qg, 16 * t, L136, 32 * k4, lane), acc[t]); }
#pragma unroll
          for (int k2 = 0; k2 < 2; ++k2) { const half8 a = ldfrag(vT, 16 * wid, L72, 32 * k2, lane);
#pragma unroll
              for (int t = 0; t < 4; ++t) acc[t] = MFMA16(a, ldfrag(Am, 16 * t, L72, 32 * k2, lane), acc[t]); }
#pragma unroll
          for (int t = 0; t < 4; ++t) { const int i = 16 * t + fr, nat = d ? 63 - i : i;
              *(half4*)(SOG + (size_t)(cr0 + nat) * 512 + h * 128 + 16 * wid + 4 * fq) = cvt4(acc[t]); } }
#pragma unroll
        for (int u = 0; u < 8; ++u) accS[u] = accS[u] * dec;
#pragma unroll
        for (int k2 = 0; k2 < 2; ++k2) { const half8 b = ldfrag(VNs, 16 * wid, L72, 32 * k2, lane);
#pragma unroll
            for (int u = 0; u < 8; ++u) accS[u] = MFMA16(ldfrag(kT, 16 * u, L72, 32 * k2, lane), b, accS[u]); }
        WAVE_SYNC();
#pragma unroll
        for (int u = 0; u < 8; ++u) *(LAS half4*)(ST + (16 * wid + fr) * L136 + 16 * u + 4 * fq) = cvt4(accS[u]);
        WAVE_SYNC();
    }
    if (mode == 1) {
#pragma unroll
        for (int u = 0; u < 8; ++u) gst[u * 64 + lane] = accS[u];
    }
}

__device__ __forceinline__ void scan_mlstm(int wb, const Params& p, int l, int bl, int gs, int h, int d, int mode, LAS unsigned char* lds) {
    const int tid = tid_fresh(wb), wid = tid >> 6, lane = tid & 63, fr = lane & 15, fq = lane >> 4;
    constexpr int L72 = 72;
    LAS half_t* q = (LAS half_t*)lds;
    LAS half_t* k = q + 64 * L72;
    LAS half_t* kT = k + 64 * L72;
    LAS half_t* vT = kT + 64 * L72;
    LAS half_t* Pm = vT + 128 * L72;
    LAS half_t* CT = Pm + 64 * L72;
    LAS half_t* nvec = CT + 128 * L72 + 64 * wid;
    LAS float* lfv = (LAS float*)(CT + 128 * L72 + 64 * 8);
    LAS float* igv = lfv + 64;
    LAS float* rowv = igv + 64;
    LAS float* colv = rowv + 64;
    LAS float* interv = colv + 64;
    LAS float* emtv = interv + 64;
    LAS float* wscv = emtv + 64;
    const half_t* P = (const half_t*)(p.ws + OFF_P);
    half_t* SOM = (half_t*)(p.ws + OFF_SOM) + (size_t)d * RGP * 512;
    const float ibias = p.in[I_MIB][l * 8 + d * 4 + h], fbias = p.in[I_MFB][l * 8 + d * 4 + h];
    SYNC();
    for (int i = tid; i < 128 * L72 / 8; i += NT) *(LAS half8*)(CT + i * 8) = (half8){0, 0, 0, 0, 0, 0, 0, 0};
    nvec[lane] = (half_t)0.f;
    f32x4 accC[4], accN[4];
#pragma unroll
    for (int u = 0; u < 4; ++u) { accC[u] = (f32x4){0.f, 0.f, 0.f, 0.f}; accN[u] = (f32x4){0.f, 0.f, 0.f, 0.f}; }
    float m = 0.f;
    constexpr int nchC = CTXL / 64, nchL = SEQ / 64, NCS = nchC + nchL;
    half8 pq, pk, pv[2]; half_t pig = (half_t)0.f, pfg = (half_t)0.f; int nr0 = 0, cr0 = 0;
    const half8 ones = {1, 1, 1, 1, 1, 1, 1, 1};
    auto issue = [&](int cs) {
        const bool isc = cs < nchC; const int cl = isc ? cs : cs - nchC, nch = isc ? nchC : nchL, cn = d ? nch - 1 - cl : cl;
        const int r0 = (isc ? RL + gs * CTXL : bl * SEQ) + cn * 64; nr0 = r0;
        const int nat = d ? 63 - lane : lane; const half_t* pr = P + (size_t)(r0 + nat) * NP + C_ML;
        pq = *(const half8*)(pr + h * 64 + 8 * wid); pk = *(const half8*)(pr + 256 + h * 64 + 8 * wid);
        pv[0] = *(const half8*)(pr + 512 + h * 128 + 8 * wid); pv[1] = *(const half8*)(pr + 512 + h * 128 + 8 * (wid + 8));
        if (tid < 64) { const half_t* pg = P + (size_t)(r0 + (d ? 63 - tid : tid)) * NP; pig = pg[C_MLIG + d * 4 + h]; pfg = pg[C_MLFG + d * 4 + h]; }
    };
    const int cs0 = mode == 2 ? nchC : 0, cs1 = mode == 1 ? nchC : NCS;
    const int sv = gs >= BG ? gs - BG : 0;
    f32x4* mst = (f32x4*)(p.ws + OFF_MST) + ((size_t)((sv * 4 + h) * 2 + d) * 8 + wid) * 512; float* msm = (float*)(p.ws + OFF_MSM) + ((sv * 4 + h) * 2 + d);
    SYNC();
    if (mode == 2) {
#pragma unroll
        for (int u = 0; u < 4; ++u) { accC[u] = mst[u * 64 + lane]; accN[u] = mst[(4 + u) * 64 + lane];
            *(LAS half4*)(CT + (16 * wid + fr) * L72 + 16 * u + 4 * fq) = cvt4(accC[u]); if (fr == 0) *(LAS half4*)(nvec + 16 * u + 4 * fq) = cvt4(accN[u]); }
        m = *msm;
        WAVE_SYNC();
    }
    issue(cs0);
    for (int cs = cs0; cs < cs1; ++cs) {
        SYNC();
        { half8 qs;
#pragma unroll
          for (int e = 0; e < 8; ++e) qs[e] = (half_t)((float)pq[e] * 0.125f);
          *(LAS half8*)(q + lane * L72 + 8 * wid) = qs; *(LAS half8*)(k + lane * L72 + 8 * wid) = pk;
#pragma unroll
          for (int e = 0; e < 8; ++e) { kT[(8 * wid + e) * L72 + lane] = pk[e]; vT[(8 * wid + e) * L72 + lane] = pv[0][e]; vT[(8 * (wid + 8) + e) * L72 + lane] = pv[1][e]; } }
        if (tid < 64) { igv[tid] = (float)pig + ibias; lfv[tid] = -softplusf(-((float)pfg + fbias)); }
        cr0 = nr0;
        if (cs + 1 < cs1) issue(cs + 1);
        SYNC();
        float dec;
        { float b = lfv[lane];
#pragma unroll
          for (int off = 1; off < 64; off <<= 1) { const float o = shfl_up_f(b, off, lane); b = lane >= off ? b + o : b; }
          const float cm = igv[lane] - b; float pm = cm;
#pragma unroll
          for (int off = 1; off < 64; off <<= 1) { const float o = shfl_up_f(pm, off, lane); pm = lane >= off ? fmaxf(pm, o) : pm; }
#ifndef CPU_EMU
          const float b_last = __int_as_float(__builtin_amdgcn_readlane(__float_as_int(b), 63)), pm_last = __int_as_float(__builtin_amdgcn_readlane(__float_as_int(pm), 63));
#else
          const float b_last = emu_shfl(b, 63), pm_last = emu_shfl(pm, 63);
#endif
          const float mt = fmaxf(b + m, b + pm), m_new = fmaxf(b_last + m, b_last + pm_last);
          rowv[lane] = b - mt; colv[lane] = cm; interv[lane] = fexp(b + m - mt); emtv[lane] = fexp(-mt); wscv[lane] = fexp(b_last + cm - m_new);
          dec = fexp(b_last + m - m_new); m = m_new; }
        WAVE_SYNC();
#pragma unroll
        for (int tt = 0; tt < 2; ++tt) { const int idx = 2 * wid + tt, ti = idx >> 2, tj = idx & 3;
            f32x4 acc = {0.f, 0.f, 0.f, 0.f};
            if (tj <= ti) {
#pragma unroll
                for (int k2 = 0; k2 < 2; ++k2) acc = MFMA16(ldfrag(k, 16 * tj, L72, 32 * k2, lane), ldfrag(q, 16 * ti, L72, 32 * k2, lane), acc);
                const int i = 16 * ti + fr; const float rv = rowv[i]; const f32x4 cv = *(const LAS f32x4*)(colv + 16 * tj + 4 * fq);
#pragma unroll
                for (int e = 0; e < 4; ++e) { const int j = 16 * tj + 4 * fq + e; acc[e] = (j <= i) ? acc[e] * fexp(rv + cv[e]) : 0.f; }
            }
            *(LAS half4*)(Pm + (16 * ti + fr) * L72 + 16 * tj + 4 * fq) = cvt4(acc); }
        SYNC();
        { f32x4 a1[4], a2[4], d1[4], d2[4];
#pragma unroll
          for (int t = 0; t < 4; ++t) { a1[t] = (f32x4){0.f, 0.f, 0.f, 0.f}; a2[t] = a1[t]; d1[t] = a1[t]; d2[t] = a1[t]; }
#pragma unroll
          for (int k2 = 0; k2 < 2; ++k2) { const half8 ac = ldfrag(CT, 16 * wid, L72, 32 * k2, lane), av = ldfrag(vT, 16 * wid, L72, 32 * k2, lane);
              const half8 an = *(const LAS half8*)(nvec + 32 * k2 + 8 * fq);
#pragma unroll
              for (int t = 0; t < 4; ++t) { const half8 bq = ldfrag(q, 16 * t, L72, 32 * k2, lane), bp = ldfrag(Pm, 16 * t, L72, 32 * k2, lane);
                  a1[t] = MFMA16(ac, bq, a1[t]); a2[t] = MFMA16(av, bp, a2[t]); d1[t] = MFMA16(an, bq, d1[t]); d2[t] = MFMA16(ones, bp, d2[t]); } }
#pragma unroll
          for (int t = 0; t < 4; ++t) { const int i = 16 * t + fr, nat = d ? 63 - i : i; const float it = interv[i];
              const float den = it * d1[t][0] + d2[t][0], dn = frcp(fmaxf(fabsf(den), emtv[i]));
              *(half4*)(SOM + (size_t)(cr0 + nat) * 512 + h * 128 + 16 * wid + 4 * fq) = cvt4((a1[t] * it + a2[t]) * dn); } }
#pragma unroll
        for (int u = 0; u < 4; ++u) { accC[u] = accC[u] * dec; accN[u] = accN[u] * dec; }
#pragma unroll
        for (int k2 = 0; k2 < 2; ++k2) { const half8 bv = ldfrag(vT, 16 * wid, L72, 32 * k2, lane);
            const f32x4 w0 = *(const LAS f32x4*)(wscv + 32 * k2 + 8 * fq), w1 = *(const LAS f32x4*)(wscv + 32 * k2 + 8 * fq + 4);
#pragma unroll
            for (int u = 0; u < 4; ++u) { const half8 raw = ldfrag(kT, 16 * u, L72, 32 * k2, lane); half8 ak;
#pragma unroll
                for (int e = 0; e < 4; ++e) { ak[e] = (half_t)((float)raw[e] * w0[e]); ak[4 + e] = (half_t)((float)raw[4 + e] * w1[e]); }
                accC[u] = MFMA16(ak, bv, accC[u]); accN[u] = MFMA16(ak, ones, accN[u]); } }
        WAVE_SYNC();
#pragma unroll
        for (int u = 0; u < 4; ++u) { *(LAS half4*)(CT + (16 * wid + fr) * L72 + 16 * u + 4 * fq) = cvt4(accC[u]);
            if (fr == 0) *(LAS half4*)(nvec + 16 * u + 4 * fq) = cvt4(accN[u]); }
        WAVE_SYNC();
    }
    if (mode == 1) {
#pragma unroll
        for (int u = 0; u < 4; ++u) { mst[u * 64 + lane] = accC[u]; mst[(4 + u) * 64 + lane] = accN[u]; }
        if (tid == 0) *msm = m;
    }
}

#ifndef CPU_EMU
template <int CTRL> __device__ __forceinline__ float dpp_f(float v) { return __int_as_float(__builtin_amdgcn_update_dpp(0, __float_as_int(v), CTRL, 0xf, 0xf, true)); }
#define DPPX1(v) dpp_f<0xB1>(v)
#define DPPX2(v) dpp_f<0x4E>(v)
#define DPPHM(v) dpp_f<0x141>(v)
#define RED8(v) do { v += dpp_f<0xB1>(v); v += dpp_f<0x4E>(v); v += dpp_f<0x141>(v); } while (0)
#define RED16(v) do { RED8(v); v += dpp_f<0x140>(v); } while (0)
#else
#define DPPX1(v) emu_shfl_xor((v), 1)
#define DPPX2(v) emu_shfl_xor((v), 2)
#define DPPHM(v) emu_shfl_xor((v), 7)
#define RED8(v) do { v += emu_shfl_xor(v, 1); v += emu_shfl_xor(v, 2); v += emu_shfl_xor(v, 7); } while (0)
#define RED16(v) do { RED8(v); v += emu_shfl_xor(v, 15); } while (0)
#endif
__device__ __forceinline__ void scan_rwkv(int wb, const Params& p, int l, int bl, int gs, int h, int d, int row0, int ncw, int mode, LAS unsigned char* lds) {
#ifndef CPU_EMU
    const int tid = tid_fresh(wb), wid = __builtin_amdgcn_readfirstlane(tid >> 6), lane = tid & 63;
#else
    const int tid = tid_fresh(wb), wid = tid >> 6, lane = tid & 63;
#endif
    constexpr int NB = 32, NPR = NB / 2, REC = 712;
    LAS float* st = (LAS float*)lds;
    const half_t* RW = (const half_t*)(p.ws + OFF_RW); const half_t* RLO = (const half_t*)(p.ws + OFF_RLO);
    bf16_t* SOR = (bf16_t*)(p.ws + OFF_SOR) + (size_t)d * RGP * 512;
    const int nb0 = mode == 2 ? CTXL / NB : 0, nb1 = mode == 1 ? CTXL / NB : (CTXL + SEQ) / NB;
    auto step_row = [&](int sidx) -> size_t { return sidx < CTXL ? (size_t)(RL + gs * CTXL + (d ? CTXL - 1 - sidx : sidx)) : (size_t)(bl * SEQ + (d ? SEQ - 1 - (sidx - CTXL) : sidx - CTXL)); };
    SYNC();
    if (wid >= 4) {
        const int pt = tid - 256, lp = pt >> 4, cq = pt & 15, lc = h * 64 + 4 * cq;
        const f32x4 ka = *(const f32x4*)(p.in[I_RKA] + (size_t)l * 512 + lc);
        half4 g_r[2], g_k[2], g_v[2], g_kk[2], g_e[2], g_a[2];
        auto issue = [&](int n) {
#pragma unroll
            for (int q = 0; q < 2; ++q) { const size_t row = step_row(n * NB + 2 * lp + q);
                g_r[q] = *(const half4*)(RW + (row * 4 + 0) * 512 + lc); g_k[q] = *(const half4*)(RW + (row * 4 + 1) * 512 + lc); g_v[q] = *(const half4*)(RW + (row * 4 + 2) * 512 + lc); g_kk[q] = *(const half4*)(RW + (row * 4 + 3) * 512 + lc);
                g_e[q] = *(const half4*)(RLO + row * 2560 + d * 512 + lc); g_a[q] = *(const half4*)(RLO + row * 2560 + 1024 + d * 512 + lc); } };
        auto stage = [&](int buf) { LAS float* o = st + (buf * NPR + lp) * REC + 4 * cq;
            f32x4 oa, owa, owr, owwr, oww, obw, okw, obu, oku, ovt, ovu; float c[8];
#pragma unroll
            for (int i = 0; i < 8; ++i) c[i] = 0.f;
#pragma unroll
            for (int e = 0; e < 4; ++e) {
                const float rt = (float)g_r[0][e], kt = (float)g_k[0][e], kkt = (float)g_kk[0][e], at = (float)g_a[0][e], wt = fexp(-(float)g_e[0][e]);
                const float ru = (float)g_r[1][e], ku = (float)g_k[1][e], kku = (float)g_kk[1][e], au = (float)g_a[1][e], wu = fexp(-(float)g_e[1][e]);
                const float kdt = kt * (1.f + (at - 1.f) * ka[e]), bt = kkt * at, kdu = ku * (1.f + (au - 1.f) * ka[e]), bu = kku * au, amu = -kku;
                const float bw = bt * wu, kw = kdt * wu;
                oa[e] = -kkt; owa[e] = wt * amu; owr[e] = wt * rt; owwr[e] = wt * wu * ru; oww[e] = wt * wu; obw[e] = bw; okw[e] = kw; obu[e] = bu; oku[e] = kdu; ovt[e] = (float)g_v[0][e]; ovu[e] = (float)g_v[1][e];
                c[0] += bt * amu; c[1] += kdt * amu; c[2] += bt * rt; c[3] += kdt * rt; c[4] += bw * ru; c[5] += kw * ru; c[6] += bu * ru; c[7] += kdu * ru; }
            *(LAS f32x4*)(o) = oa; *(LAS f32x4*)(o + 64) = owa; *(LAS f32x4*)(o + 128) = owr; *(LAS f32x4*)(o + 192) = owwr; *(LAS f32x4*)(o + 256) = oww; *(LAS f32x4*)(o + 320) = obw;
            *(LAS f32x4*)(o + 384) = okw; *(LAS f32x4*)(o + 448) = obu; *(LAS f32x4*)(o + 512) = oku; *(LAS f32x4*)(o + 576) = ovt; *(LAS f32x4*)(o + 640) = ovu;
#pragma unroll
            for (int i = 0; i < 8; ++i) RED16(c[i]);
            if (cq == 0) { LAS float* sc = st + (buf * NPR + lp) * REC + 704;
                *(LAS f32x4*)(sc) = (f32x4){c[0], c[1], c[2] * 0.125f, c[3] * 0.125f}; *(LAS f32x4*)(sc + 4) = (f32x4){c[4] * 0.125f, c[5] * 0.125f, c[6] * 0.125f, c[7] * 0.125f}; } };
        issue(nb0); stage(nb0 & 1);
        if (nb0 + 1 < nb1) issue(nb0 + 1);
        SYNC();
        for (int n = nb0; n < nb1; ++n) {
            if (n + 1 < nb1) { stage((n + 1) & 1); if (n + 2 < nb1) issue(n + 2); }
            SYNC();
        }
    } else if (wid >= ncw) {
        SYNC();
        for (int n = nb0; n < nb1; ++n) SYNC();
    } else {
        const int rr = row0 + 8 * wid + (lane >> 3), ks = lane & 7;
        f32x2 s2[4];
#pragma unroll
        for (int e = 0; e < 4; ++e) s2[e] = (f32x2){0.f, 0.f};
        const int sv = gs >= BG ? gs - BG : 0;
        f32x2* rst = (f32x2*)((float*)(p.ws + OFF_RST) + ((size_t)((sv * 8 + h) * 2 + d) * 64 + rr) * 64 + 8 * ks);
        if (mode == 2) {
#pragma unroll
            for (int e = 0; e < 4; ++e) s2[e] = rst[e]; }
        SYNC();
#define LO2(v) __builtin_shufflevector(v, v, 0, 1)
#define HI2(v) __builtin_shufflevector(v, v, 2, 3)
        for (int n = nb0; n < nb1; ++n) {
            const int buf = n & 1;
            f32x4 xa0, xa1, xwa0, xwa1, xwr0, xwr1, xwq0, xwq1, ya0, ya1, ywa0, ywa1, ywr0, ywr1, ywq0, ywq1;
#define RWKV_LOADD(A0, A1, WA0, WA1, WR0, WR1, WQ0, WQ1, P_) do { const LAS float* o_ = st + (buf * NPR + (P_)) * REC + 8 * ks; \
                A0 = *(const LAS f32x4*)(o_); A1 = *(const LAS f32x4*)(o_ + 4); WA0 = *(const LAS f32x4*)(o_ + 64); WA1 = *(const LAS f32x4*)(o_ + 68); \
                WR0 = *(const LAS f32x4*)(o_ + 128); WR1 = *(const LAS f32x4*)(o_ + 132); WQ0 = *(const LAS f32x4*)(o_ + 192); WQ1 = *(const LAS f32x4*)(o_ + 196); } while (0)
#define RWKV_PAIR(A0, A1, WA0, WA1, WR0, WR1, WQ0, WQ1, PI, J) do { \
                const LAS float* o = st + (buf * NPR + (PI)) * REC; \
                const f32x4 ww0 = *(const LAS f32x4*)(o + 256 + 8 * ks), ww1 = *(const LAS f32x4*)(o + 260 + 8 * ks), bw0 = *(const LAS f32x4*)(o + 320 + 8 * ks), bw1 = *(const LAS f32x4*)(o + 324 + 8 * ks); \
                const f32x4 kw0 = *(const LAS f32x4*)(o + 384 + 8 * ks), kw1 = *(const LAS f32x4*)(o + 388 + 8 * ks), bu0 = *(const LAS f32x4*)(o + 448 + 8 * ks), bu1 = *(const LAS f32x4*)(o + 452 + 8 * ks); \
                const f32x4 ku0 = *(const LAS f32x4*)(o + 512 + 8 * ks), ku1 = *(const LAS f32x4*)(o + 516 + 8 * ks); \
                const float vt = o[576 + rr], vu = o[640 + rr]; const f32x4 sc0 = *(const LAS f32x4*)(o + 704), sc1 = *(const LAS f32x4*)(o + 708); \
                const f32x2 e1 = (s2[0] * LO2(A0) + s2[1] * HI2(A0)) + (s2[2] * LO2(A1) + s2[3] * HI2(A1)); \
                const f32x2 e2 = (s2[0] * LO2(WA0) + s2[1] * HI2(WA0)) + (s2[2] * LO2(WA1) + s2[3] * HI2(WA1)); \
                const f32x2 e3 = (s2[0] * LO2(WR0) + s2[1] * HI2(WR0)) + (s2[2] * LO2(WR1) + s2[3] * HI2(WR1)); \
                const f32x2 e4 = (s2[0] * LO2(WQ0) + s2[1] * HI2(WQ0)) + (s2[2] * LO2(WQ1) + s2[3] * HI2(WQ1)); \
                float sat = e1[0] + e1[1], d2 = e2[0] + e2[1]; \
                RED8(sat); RED8(d2); \
                const f32x2 vtv = {vt, vt}, vuv = {vu, vu}; \
                const f32x2 pre0 = (s2[0] * LO2(ww0) + vtv * LO2(kw0)) + vuv * LO2(ku0), pre1 = (s2[1] * HI2(ww0) + vtv * HI2(kw0)) + vuv * HI2(ku0); \
                const f32x2 pre2 = (s2[2] * LO2(ww1) + vtv * LO2(kw1)) + vuv * LO2(ku1), pre3 = (s2[3] * HI2(ww1) + vtv * HI2(kw1)) + vuv * HI2(ku1); \
                const float ypt = (e3[0] + e3[1]) + vt * sc0[3], ypu = (e4[0] + e4[1]) + (vt * sc1[1] + vu * sc1[3]); \
                const float sau = (d2 + vt * sc0[1]) + sat * sc0[0]; \
                const f32x2 satv = {sat, sat}, sauv = {sau, sau}; \
                s2[0] = (satv * LO2(bw0) + pre0) + sauv * LO2(bu0); s2[1] = (satv * HI2(bw0) + pre1) + sauv * HI2(bu0); \
                s2[2] = (satv * LO2(bw1) + pre2) + sauv * LO2(bu1); s2[3] = (satv * HI2(bw1) + pre3) + sauv * HI2(bu1); \
                yp[2 * (J)] = ypt + sat * sc0[2]; yp[2 * (J) + 1] = (ypu + sat * sc1[0]) + sau * sc1[2]; } while (0)
#ifndef CPU_EMU
#define RWKV_FENCE() asm volatile("" ::: "memory")
#else
#define RWKV_FENCE()
#endif
            RWKV_LOADD(xa0, xa1, xwa0, xwa1, xwr0, xwr1, xwq0, xwq1, 0);
#pragma unroll 1
            for (int th = 0; th < NPR / 2; ++th) {
                float yp[4];
                RWKV_LOADD(ya0, ya1, ywa0, ywa1, ywr0, ywr1, ywq0, ywq1, 2 * th + 1);
                RWKV_PAIR(xa0, xa1, xwa0, xwa1, xwr0, xwr1, xwq0, xwq1, 2 * th, 0);
                RWKV_FENCE();
                { const int pn = 2 * th + 2 < NPR ? 2 * th + 2 : NPR - 1;
                  RWKV_LOADD(xa0, xa1, xwa0, xwa1, xwr0, xwr1, xwq0, xwq1, pn); }
                RWKV_PAIR(ya0, ya1, ywa0, ywa1, ywr0, ywr1, ywq0, ywq1, 2 * th + 1, 1);
                RWKV_FENCE();
                { const bool c0 = ((ks ^ (ks >> 2)) & 1) != 0, c1 = (((ks >> 1) ^ (ks >> 2)) & 1) != 0;
                  const float k20 = (c0 ? yp[1] : yp[0]) + DPPX1(c0 ? yp[0] : yp[1]), k21 = (c0 ? yp[3] : yp[2]) + DPPX1(c0 ? yp[2] : yp[3]);
                  float k1 = (c1 ? k21 : k20) + DPPX2(c1 ? k20 : k21);
                  k1 += DPPHM(k1);
                  if (ks < 4) SOR[step_row(n * NB + th * 4 + ks) * 512 + h * 64 + rr] = f2bf(k1); }
            }
#undef RWKV_PAIR
#undef RWKV_FENCE
#undef RWKV_LOADD
            SYNC();
        }
#undef LO2
#undef HI2
        if (mode == 1) {
#pragma unroll
            for (int e = 0; e < 4; ++e) rst[e] = s2[e]; }
    }
}

__device__ __forceinline__ void ph_scan(int wb, const Params& p, int l, int g, LAS unsigned char* lds) {
    constexpr int NL_R = BG * 32, NL_G = BG * 8, NL_M = BG * 8, NLONG = NL_R + NL_G + NL_M;
    const int G = gridDim.x, c = blockIdx.x;
    const int nsm = g == 0 ? BATCH - BG : 0, NS_R = nsm * 32, NS_G = nsm * 8, NS_M = nsm * 8;
    const int nfree = G - NLONG, sstr = nfree > 0 ? nfree : G, sst = nfree > 0 ? c - NLONG : c;
    const bool has_short = nfree > 0 ? c >= NLONG : true;
    const int lmode = g == 0 ? 0 : 2;
    auto first = [](int lo, int st, int stride) { return lo + (((st - lo) % stride) + stride) % stride; };
#pragma unroll 1
    for (int q = 0; q < 2; ++q) {
        const int lo = 0, n = q ? (has_short ? NS_R : 0) : NL_R, st = q ? sst : c, str = q ? sstr : G;
        if (!(SKIP_MASK & 65536)) for (int it = first(lo, st, str); it < n; it += str) REPS(65536) {
            const int jt = q ? it : ((((it >> 4) << 3) | (it & 7)) << 1) | ((it >> 3) & 1);
            const int half = jt & 1, d = (jt >> 1) & 1, h = (jt >> 2) & 7, b = jt >> 5;
            scan_rwkv(wb, p, l, q ? 0 : b, q ? BG + b : g * BG + b, h, d, 32 * half, 4, q ? 1 : lmode, lds); SYNC(); }
    }
#pragma unroll 1
    for (int q = 0; q < 2; ++q) {
        const int lo = q ? NS_R : NL_R, n = q ? (has_short ? NS_R + NS_G : 0) : NL_R + NL_G, st = q ? sst : c, str = q ? sstr : G;
        if (!(SKIP_MASK & 131072)) for (int it = first(lo, st, str); it < n; it += str) REPS(131072) {
            const int i2 = it - lo, d = i2 & 1, h = (i2 >> 1) & 3, b = i2 >> 3;
            scan_gdn(wb, p, q ? 0 : b, q ? BG + b : g * BG + b, h, d, q ? 1 : lmode, lds); SYNC(); }
    }
#pragma unroll 1
    for (int q = 0; q < 2; ++q) {
        const int lo = q ? NS_R + NS_G : NL_R + NL_G, n = q ? (has_short ? NS_R + NS_G + NS_M : 0) : NLONG, st = q ? sst : c, str = q ? sstr : G;
        if (!(SKIP_MASK & 262144)) for (int it = first(lo, st, str); it < n; it += str) REPS(262144) {
            const int i2 = it - lo, d = i2 & 1, h = (i2 >> 1) & 3, b = i2 >> 3;
            scan_mlstm(wb, p, l, q ? 0 : b, q ? BG + b : g * BG + b, h, d, q ? 1 : lmode, lds); SYNC(); }
    }
    if (g == 0 && !(SKIP_MASK & 2)) ph_convert(wb, p, l, 1, nfree > 0 ? c - NLONG : c, nfree > 0 ? nfree : G, lds);
    if (g == NGROUP - 1 && l + 1 < DEPTH && !(SKIP_MASK & 2)) ph_convert(wb, p, l + 1, 0, nfree > 0 ? c - NLONG : c, nfree > 0 ? nfree : G, lds);
}

__device__ __forceinline__ void ph_finish(int wb, const Params& p, int l, int nrows) {
    const int tid = tid_fresh(wb), wid = tid >> 6, lane = tid & 63, c = 8 * lane;
    const half_t* P = (const half_t*)(p.ws + OFF_P); const half_t* RW = (const half_t*)(p.ws + OFF_RW); const half_t* RLO = (const half_t*)(p.ws + OFF_RLO);
    const half_t* SOG = (const half_t*)(p.ws + OFF_SOG); const half_t* SOM = (const half_t*)(p.ws + OFF_SOM); const bf16_t* SOR = (const bf16_t*)(p.ws + OFF_SOR);
    half_t* BR = (half_t*)(p.ws + OFF_BR);
    float c_gn[8], c_mn[8], c_ka[8], c_rk[8], c_lg[8], c_lb[8];
#pragma unroll
    for (int e = 0; e < 8; ++e) { c_gn[e] = p.in[I_GNG][l * 128 + (c & 127) + e]; c_mn[e] = p.in[I_MNG][l * 128 + (c & 127) + e]; c_ka[e] = p.in[I_RKA][(size_t)l * 512 + c + e];
        c_rk[e] = p.in[I_RRK][(size_t)l * 512 + c + e]; c_lg[e] = p.in[I_RLNG][(size_t)l * 512 + c + e]; c_lb[e] = p.in[I_RLNB][(size_t)l * 512 + c + e]; }
    for (int r = blockIdx.x * 8 + wid; r < nrows; r += gridDim.x * 8) {
        { const half8 o0 = *(const half8*)(SOG + (size_t)r * 512 + c), o1 = *(const half8*)(SOG + ((size_t)RGP + r) * 512 + c), z = *(const half8*)(P + (size_t)r * NP + C_Z + c);
          float o[8], ss = 0.f;
#pragma unroll
          for (int e = 0; e < 8; ++e) { o[e] = (float)o0[e] + (float)o1[e]; ss += o[e] * o[e]; }
          ss += SHFL_XOR(ss, 1); ss += SHFL_XOR(ss, 2); ss += SHFL_XOR(ss, 4); ss += SHFL_XOR(ss, 8);
          const float rinv = frsq(ss * (1.f / 128.f) + 1e-6f); half8 out;
#pragma unroll
          for (int e = 0; e < 8; ++e) out[e] = (half_t)(o[e] * rinv * c_gn[e] * siluf((float)z[e]));
          *(half8*)(BR + (size_t)r * 512 + c) = out; }
        { float y[8], sm = 0.f;
          { typedef unsigned short us8 __attribute__((ext_vector_type(8)));
            const us8 s0 = *(const us8*)(SOR + (size_t)r * 512 + c), s1 = *(const us8*)(SOR + ((size_t)RGP + r) * 512 + c);
#pragma unroll
            for (int e = 0; e < 8; ++e) y[e] = bf2f(s0[e]) + bf2f(s1[e]); }
#pragma unroll
          for (int e = 0; e < 8; ++e) sm += y[e];
          sm += SHFL_XOR(sm, 1); sm += SHFL_XOR(sm, 2); sm += SHFL_XOR(sm, 4); const float mean = sm * (1.f / 64.f);
          float vs = 0.f;
#pragma unroll
          for (int e = 0; e < 8; ++e) { const float dlt = y[e] - mean; vs += dlt * dlt; }
          vs += SHFL_XOR(vs, 1); vs += SHFL_XOR(vs, 2); vs += SHFL_XOR(vs, 4); const float rinv = frsq(vs * (1.f / 64.f) + 64e-5f);
          const half8 rv = *(const half8*)(RW + ((size_t)r * 4 + 0) * 512 + c), kv = *(const half8*)(RW + ((size_t)r * 4 + 1) * 512 + c), vv = *(const half8*)(RW + ((size_t)r * 4 + 2) * 512 + c);
          const half8 a0 = *(const half8*)(RLO + (size_t)r * 2560 + 1024 + c), a1 = *(const half8*)(RLO + (size_t)r * 2560 + 1536 + c), gg = *(const half8*)(RLO + (size_t)r * 2560 + 2048 + c);
          float bc = 0.f;
#pragma unroll
          for (int e = 0; e < 8; ++e) bc += (float)rv[e] * (float)kv[e] * (2.f + ((float)a0[e] + (float)a1[e] - 2.f) * c_ka[e]) * c_rk[e];
          bc += SHFL_XOR(bc, 1); bc += SHFL_XOR(bc, 2); bc += SHFL_XOR(bc, 4);
          half8 out;
#pragma unroll
          for (int e = 0; e < 8; ++e) out[e] = (half_t)(((y[e] - mean) * rinv * c_lg[e] + c_lb[e] + bc * (float)vv[e]) * (float)gg[e]);
          *(half8*)(BR + ((size_t)RGP + r) * 512 + c) = out; }
        { const half8 h0 = *(const half8*)(SOM + (size_t)r * 512 + c), h1 = *(const half8*)(SOM + ((size_t)RGP + r) * 512 + c), og = *(const half8*)(P + (size_t)r * NP + C_MLO + c);
          float o[8], ss = 0.f;
#pragma unroll
          for (int e = 0; e < 8; ++e) { o[e] = (float)h0[e] + (float)h1[e]; ss += o[e] * o[e]; }
          ss += SHFL_XOR(ss, 1); ss += SHFL_XOR(ss, 2); ss += SHFL_XOR(ss, 4); ss += SHFL_XOR(ss, 8);
          const float rinv = frsq(ss * (1.f / 128.f) + 1e-6f); half8 out;
#pragma unroll
          for (int e = 0; e < 8; ++e) out[e] = (half_t)(o[e] * rinv * c_mn[e] * (float)og[e]);
          *(half8*)(BR + ((size_t)2 * RGP + r) * 512 + c) = out; }
    }
}

__device__ __forceinline__ void ph_norm2(int wb, const Params& p, int l, int g, int nrows, LAS unsigned char* lds) {
    const int tid = tid_fresh(wb), wid = tid >> 6, lane = tid & 63;
    LAS float* rw = (LAS float*)lds;
    for (int i = tid; i < 1024 * 16; i += NT) rw[(i & 15) * 1024 + (i >> 4)] = p.in[I_ROUT][(size_t)l * 1024 * 16 + i];
    SYNC();
    half_t* H = (half_t*)(p.ws + OFF_H); float* PROB = (float*)(p.ws + OFF_PROB);
    constexpr int RU = 2;
    const int rstep = gridDim.x * 8; const float* gn = p.in[I_N2G] + l * D;
    f32x4 gv[4];
#pragma unroll
    for (int j = 0; j < 4; ++j) gv[j] = *(const f32x4*)(gn + lane * 4 + 256 * j);
    for (int r0 = blockIdx.x * 8 + wid; r0 < nrows; r0 += rstep * RU) {
        f32x4 v[RU][4], sh[RU][4], sc[RU][4]; half4 dxv[RU][4]; float ss[RU];
#pragma unroll
        for (int u = 0; u < RU; ++u) { const int r = r0 + u * rstep < nrows ? r0 + u * rstep : r0;
            const half_t* xr = res_h(p, g, r); const float* md = mod_row(p, l, g, r); const half_t* dxr = (const half_t*)(p.ws + OFF_DX) + (size_t)r * D;
#pragma unroll
            for (int j = 0; j < 4; ++j) { const int c = lane * 4 + 256 * j; v[u][j] = h4f(*(const half4*)(xr + c)); dxv[u][j] = *(const half4*)(dxr + c); sh[u][j] = *(const f32x4*)(md + 3 * 1024 + c); sc[u][j] = *(const f32x4*)(md + 4 * 1024 + c); } }
        EPI_LOAD_FENCE();
#pragma unroll
        for (int u = 0; u < RU; ++u)
#pragma unroll
            for (int j = 0; j < 4; ++j)
#pragma unroll
                for (int e = 0; e < 4; ++e) v[u][j][e] += (float)dxv[u][j][e];
#pragma unroll
        for (int u = 0; u < RU; ++u) { float a = 0.f;
#pragma unroll
            for (int j = 0; j < 4; ++j) a += v[u][j][0] * v[u][j][0] + v[u][j][1] * v[u][j][1] + v[u][j][2] * v[u][j][2] + v[u][j][3] * v[u][j][3];
            ss[u] = wave_sum(a); }
#pragma unroll
        for (int u = 0; u < RU; ++u) { const int r = r0 + u * rstep; if (r >= nrows) continue;
            const float rinv = frsq(ss[u] * (1.f / D) + 1e-6f);
            float lg[16];
#pragma unroll
            for (int e = 0; e < 16; ++e) lg[e] = 0.f;
#pragma unroll
            for (int j = 0; j < 4; ++j) { const int c = lane * 4 + 256 * j;
                const f32x4 hv = v[u][j] * rinv * gv[j] * (sc[u][j] + 1.f) + sh[u][j];
                *(half4*)(H + (size_t)r * D + c) = cvt4(hv);
#pragma unroll
                for (int e = 0; e < 16; ++e) { const f32x4 w = *(const LAS f32x4*)(rw + e * 1024 + c); lg[e] += hv[0] * w[0] + hv[1] * w[1] + hv[2] * w[2] + hv[3] * w[3]; }
                asm volatile("" ::: "memory"); }
            float k8[8], k4[4], k2[2], k1;
            { const bool hi = lane & 32;
#pragma unroll
              for (int e = 0; e < 8; ++e) { const float snd = hi ? lg[e] : lg[e + 8]; k8[e] = (hi ? lg[e + 8] : lg[e]) + SHFL_XOR(snd, 32); } }
            { const bool hi = lane & 16;
#pragma unroll
              for (int e = 0; e < 4; ++e) { const float snd = hi ? k8[e] : k8[e + 4]; k4[e] = (hi ? k8[e + 4] : k8[e]) + SHFL_XOR(snd, 16); } }
            { const bool hi = lane & 8;
#pragma unroll
              for (int e = 0; e < 2; ++e) { const float snd = hi ? k4[e] : k4[e + 2]; k2[e] = (hi ? k4[e + 2] : k4[e]) + SHFL_XOR(snd, 8); } }
            { const bool hi = lane & 4; const float snd = hi ? k2[0] : k2[1]; k1 = (hi ? k2[1] : k2[0]) + SHFL_XOR(snd, 4); }
            k1 += SHFL_XOR(k1, 2); k1 += SHFL_XOR(k1, 1);
            float mx = k1; mx = fmaxf(mx, SHFL_XOR(mx, 4)); mx = fmaxf(mx, SHFL_XOR(mx, 8)); mx = fmaxf(mx, SHFL_XOR(mx, 16)); mx = fmaxf(mx, SHFL_XOR(mx, 32));
            const float ex = fexp(k1 - mx); float sum = ex; sum += SHFL_XOR(sum, 4); sum += SHFL_XOR(sum, 8); sum += SHFL_XOR(sum, 16); sum += SHFL_XOR(sum, 32);
            if ((lane & 3) == 0) PROB[(size_t)r * 16 + (lane >> 2)] = ex * frcp(sum); }
    }
}

__device__ __forceinline__ void ph_topk(int wb, const Params& p, int nctx, LAS unsigned char* lds) {
    const int tid = tid_fresh(wb), wid = tid >> 6, lane = tid & 63;
    LAS unsigned* pv = (LAS unsigned*)lds;
    LAS unsigned* hist = pv + (SEQ > CTXL ? SEQ : CTXL);
    LAS int* wtot = (LAS int*)(hist + 256);
    LAS int* selrows = wtot + 16;
    LAS unsigned* sh = (LAS unsigned*)(selrows + (CAPL > CAPC ? CAPL : CAPC));
    const float* PROB = (const float*)(p.ws + OFF_PROB); int* SLOT = (int*)(p.ws + OFF_SLOT); int* SEL = (int*)(p.ws + OFF_SEL); float* AFF = (float*)(p.ws + OFF_AFF);
    const half_t* H = (const half_t*)(p.ws + OFF_H); half_t* XE = (half_t*)(p.ws + OFF_XE);
    auto block_excl = [&](int v, int slotbase) -> int {
        float f = (float)v;
#pragma unroll
        for (int off = 1; off < 64; off <<= 1) { const float o = shfl_up_f(f, off, lane); f = lane >= off ? f + o : f; }
        if (lane == 63) wtot[slotbase + wid] = (int)f;
        SYNC();
        int pre = 0;
#pragma unroll
        for (int w = 0; w < 8; ++w) pre += (w < wid) ? wtot[slotbase + w] : 0;
        return pre + (int)f - v; };
    const int nlat = BG * 16, nq = (nlat * 4 + nctx * 16 <= (int)gridDim.x) ? 4 : (nlat * 2 + nctx * 16 <= (int)gridDim.x) ? 2 : 1;
    for (int vit = blockIdx.x; vit < nlat * nq + nctx * 16; vit += gridDim.x) {
        const int item = vit < nlat * nq ? vit / nq : vit - nlat * (nq - 1), part = vit < nlat * nq ? vit % nq : 0, nparts = vit < nlat * nq ? nq : 1;
        const int e = item & 15, sm = item >> 4, stc = sm >= BG, bl = stc ? sm - BG : sm;
        const int n = stc ? CTXL : SEQ, cap = n / 8, row0 = stc ? RL + bl * CTXL : bl * SEQ, slot0 = stc ? BG * CAPL + bl * CAPC : bl * CAPL;
        SYNC();
        for (int i = tid; i < n; i += NT) pv[i] = __float_as_uint(PROB[(size_t)(row0 + i) * 16 + e]);
        unsigned prefix = 0u, mask = 0u; int kth = cap;
        for (int pass = 3; pass >= 0; --pass) {
            if (tid < 256) hist[tid] = 0u;
            SYNC();
            for (int i = tid; i < n; i += NT) { const unsigned v = pv[i]; if ((v & mask) == prefix) LDS_ATOMIC_INC(&hist[(v >> (8 * pass)) & 255u]); }
            SYNC();
            if (wid == 0) {
                const int b0 = 255 - 4 * lane; const int h0 = (int)hist[b0], h1 = (int)hist[b0 - 1], h2 = (int)hist[b0 - 2], h3 = (int)hist[b0 - 3];
                float f = (float)(h0 + h1 + h2 + h3);
#pragma unroll
                for (int off = 1; off < 64; off <<= 1) { const float o = shfl_up_f(f, off, lane); f = lane >= off ? f + o : f; }
                int cum = (int)f - (h0 + h1 + h2 + h3);
                const int hh[4] = {h0, h1, h2, h3};
#pragma unroll
                for (int j = 0; j < 4; ++j) { if (cum < kth && kth <= cum + hh[j]) { sh[0] = (unsigned)(b0 - j); sh[1] = (unsigned)(kth - cum); } cum += hh[j]; }
            }
            SYNC();
            prefix |= sh[0] << (8 * pass); mask |= 0xFFu << (8 * pass); kth = (int)sh[1];
        }
        const unsigned thr = prefix; const int need_eq = kth;
        const int per = (n + NT - 1) / NT, i0 = tid * per, i1 = (i0 + per < n) ? i0 + per : n;
        int ce = 0, cg = 0; for (int i = i0; i < i1; ++i) { const unsigned v = pv[i]; ce += (v == thr); cg += (v > thr); }
        const int eq_ex = block_excl(ce, 0);
        int take = need_eq - eq_ex; take = take < 0 ? 0 : (take > ce ? ce : take);
        const int pos_ex = block_excl(cg + take, 8);
        { int eqr = eq_ex, pos = pos_ex;
          for (int i = i0; i < i1; ++i) { const unsigned v = pv[i]; const bool sel = v > thr || (v == thr && eqr < need_eq); if (v == thr) ++eqr; const int row = row0 + i;
              if (sel) { const int slot = slot0 + pos; if (part == 0) { SEL[e * RPE + slot] = row; AFF[e * RPE + slot] = __uint_as_float(v); SLOT[(size_t)row * 16 + e] = slot; } selrows[pos] = row; ++pos; }
              else if (part == 0) SLOT[(size_t)row * 16 + e] = -1; } }
        SYNC();
        const int g0 = part * (cap / nparts) * 128, g1 = (part + 1 == nparts ? cap : (part + 1) * (cap / nparts)) * 128;
        for (int idx0 = g0 + tid; idx0 < g1; idx0 += NT * 8) { half8 t[8];
#pragma unroll
            for (int u = 0; u < 8; ++u) { const int idx = idx0 + u * NT; if (idx < g1) t[u] = *(const half8*)(H + (size_t)selrows[idx >> 7] * 1024 + (idx & 127) * 8); }
#pragma unroll
            for (int u = 0; u < 8; ++u) { const int idx = idx0 + u * NT; if (idx < g1) *(half8*)(XE + ((size_t)e * RPE + slot0 + (idx >> 7)) * 1024 + (idx & 127) * 8) = t[u]; } }
    }
    SYNC();
}

__device__ __forceinline__ void ph_combine(int wb, const Params& p, int l, int g, int nrows) {
    const int tid = tid_fresh(wb), wid = tid >> 6, lane = tid & 63;
    const int* SLOT = (const int*)(p.ws + OFF_SLOT); const half_t* YE = (const half_t*)(p.ws + OFF_YE);
    constexpr int RU = 4;
    const int rstep = gridDim.x * 8;
    for (int r0 = blockIdx.x * 8 + wid; r0 < nrows; r0 += rstep * RU) {
        float acc[RU][2][8]; f32x4 xv[RU][4];
#pragma unroll
        for (int u = 0; u < RU; ++u) { const int r = r0 + u * rstep;
#pragma unroll
            for (int j = 0; j < 2; ++j)
#pragma unroll
                for (int e = 0; e < 8; ++e) acc[u][j][e] = 0.f;
            if (r < nrows) { const half_t* xr = res_h(p, g, r); const half_t* dxr = (const half_t*)(p.ws + OFF_DX) + (size_t)r * D;
#pragma unroll
                for (int j = 0; j < 2; ++j) { const half8 xh = *(const half8*)(xr + 8 * lane + 512 * j);
                    const half8 dx = *(const half8*)(dxr + 8 * lane + 512 * j);
#pragma unroll
                    for (int e = 0; e < 4; ++e) { xv[u][2 * j][e] = (float)xh[e] + (float)dx[e]; xv[u][2 * j + 1][e] = (float)xh[4 + e] + (float)dx[4 + e]; } }
                int sl[16];
#pragma unroll
                for (int q = 0; q < 4; ++q) { const int4 t = *(const int4*)(SLOT + (size_t)r * 16 + 4 * q); sl[4 * q] = t.x; sl[4 * q + 1] = t.y; sl[4 * q + 2] = t.z; sl[4 * q + 3] = t.w; }
#pragma unroll
                for (int ex = 0; ex < 16; ++ex) { if (sl[ex] < 0) continue;
#pragma unroll
                    for (int j = 0; j < 2; ++j) { const half8 y = *(const half8*)(YE + ((size_t)ex * RPE + sl[ex]) * 1024 + 8 * lane + 512 * j);
#pragma unroll
                        for (int e = 0; e < 8; ++e) acc[u][j][e] += (float)y[e]; } } } }
        float ss[RU];
#pragma unroll
        for (int u = 0; u < RU; ++u) { const int r = r0 + u * rstep; ss[u] = 0.f; if (r >= nrows) continue;
            const float* md = mod_row(p, l, g, r) + 5 * 1024;
#pragma unroll
            for (int j = 0; j < 2; ++j) { const f32x4 m0 = *(const f32x4*)(md + 8 * lane + 512 * j), m1 = *(const f32x4*)(md + 8 * lane + 512 * j + 4);
#pragma unroll
                for (int e = 0; e < 4; ++e) { xv[u][2 * j][e] += m0[e] * acc[u][j][e]; xv[u][2 * j + 1][e] += m1[e] * acc[u][j][4 + e];
                    ss[u] += xv[u][2 * j][e] * xv[u][2 * j][e] + xv[u][2 * j + 1][e] * xv[u][2 * j + 1][e]; } } }
        if (l == DEPTH - 1) {
#pragma unroll
            for (int u = 0; u < RU; ++u) ss[u] = wave_sum(ss[u]); }
#pragma unroll
        for (int u = 0; u < RU; ++u) { const int r = r0 + u * rstep; if (r >= nrows) continue;
            if (l == DEPTH - 1) { const float rinv = frsq(ss[u] * (1.f / D) + 1e-6f); float* xr = res_dst(p, g, r);
#pragma unroll
                for (int j = 0; j < 2; ++j) { const f32x4 f0 = *(const f32x4*)(p.in[I_FING] + 8 * lane + 512 * j), f1 = *(const f32x4*)(p.in[I_FING] + 8 * lane + 512 * j + 4);
                    *(f32x4*)(xr + 8 * lane + 512 * j) = xv[u][2 * j] * rinv * f0; *(f32x4*)(xr + 8 * lane + 512 * j + 4) = xv[u][2 * j + 1] * rinv * f1; } }
            else { half_t* xr = res_h(p, g, r);
#pragma unroll
                for (int j = 0; j < 2; ++j) { half8 o;
#pragma unroll
                    for (int e = 0; e < 4; ++e) { o[e] = (half_t)xv[u][2 * j][e]; o[4 + e] = (half_t)xv[u][2 * j + 1][e]; }
                    *(half8*)(xr + 8 * lane + 512 * j) = o; } } }
    }
}

#ifndef TPROBE_A
#define TPROBE_A 0
#endif
#ifndef TPROBE_B
#define TPROBE_B 0
#endif
#ifndef CPU_EMU
__device__ __forceinline__ void tprobe_tick(LAS unsigned char* lds, int idx) {
    volatile LAS unsigned long long* tp = (volatile LAS unsigned long long*)(lds + SMEM_BYTES - 64);
    const unsigned long long now = __builtin_amdgcn_s_memrealtime(), dt = now - tp[0];
    if ((TPROBE_A >> idx) & 1) tp[1] += dt;
    if ((TPROBE_B >> idx) & 1) tp[2] += dt;
    tp[0] = now;
}
#define PH_T(idx) do { if ((TPROBE_A | TPROBE_B) != 0 && blockIdx.x == 0 && tid_fresh(wb) == 0) tprobe_tick(lds, (idx)); } while (0)
#else
#define PH_T(idx)
#endif
#ifndef EMU_DUMP
#define EMU_DUMP(tag)
#endif
#ifndef CPU_EMU
extern __shared__ __attribute__((aligned(16))) unsigned char smem_raw[];
__global__ void __launch_bounds__(NT, 2) mega(Params p)
#else
void mega(Params p)
#endif
{
#ifndef CPU_EMU
    LAS unsigned char* lds = (LAS unsigned char*)smem_raw;
    volatile LAS unsigned* xbw = (volatile LAS unsigned*)(lds + SMEM_BYTES - 16);
    if (threadIdx.x == 0) { xbw[0] = 0u; xbw[1] = 0u; xbw[2] = 0u; xbw[3] = 0u; }
    __syncthreads();
    (void)xcd_barrier_post((unsigned*)(p.ws + OFF_BAR), xbw);
    if ((TPROBE_A | TPROBE_B) != 0 && threadIdx.x == 0) { volatile LAS unsigned long long* tp = (volatile LAS unsigned long long*)(lds + SMEM_BYTES - 64); tp[0] = __builtin_amdgcn_s_memrealtime(); tp[1] = 0ull; tp[2] = 0ull; }
#else
    unsigned char* lds = emu_smem();
#endif
#ifndef CPU_EMU
    const int wb = __builtin_amdgcn_readfirstlane((int)threadIdx.x) & ~63;
#else
    const int wb = 0;
#endif
    const int G = gridDim.x, c = blockIdx.x;
    if (!(SKIP_MASK & 1)) ph_mod(wb, p, lds);
    if (!(SKIP_MASK & 2)) ph_convert(wb, p, 0, 0, c, G, lds);
    ph_xconv(wb, p);
    GRID_SYNC(); PH_T(0);
    for (int l = 0; l < DEPTH; ++l) {
        const bool last = (l == DEPTH - 1);
        for (int g = 0; g < NGROUP; ++g) {
            const Geo gq = geo_of(g);
            const int nact = last ? RL : gq.rg;
            const int nactp = last ? RL : gq.rgp;
            const int tpa = last ? (BG * CAPL + 255) / 256 : gq.tpe;
            if (l == 0 && g == 0) { if (!(SKIP_MASK & 4)) ph_norm1(wb, p, l, g); GRID_SYNC(); PH_T(1); }
            EMU_DUMP("norm1");
            if (!(SKIP_MASK & 8)) REPS(8) { pg8::StaticOrder S; S.init(gq.rgp / 256, NP / 256, G, c); EpiP E{(half_t*)(p.ws + OFF_P)};
              pg8::gemm_phase(wb, lds, pg8::Gemm{(const half_t*)(p.ws + OFF_H), (const half_t*)(p.ws + OFF_WIN), 1024, 16}, S, E); }
            GRID_SYNC(); PH_T(2); EMU_DUMP("gemm_in");
            if (!(SKIP_MASK & 16)) REPS(16) ph_prep2(wb, p, l, gq.rg, lds);
            GRID_SYNC(); PH_T(3); EMU_DUMP("prep");
            if (!(SKIP_MASK & 32)) REPS(32) { pg8::LoraOrder S; S.init(gq.rgp / 256, G, c); EpiLora E{(half_t*)(p.ws + OFF_RLO), p.in[I_RW0] + (size_t)l * 1024, p.in[I_RA0] + (size_t)l * 1024};
              pg8::gemm_phase(wb, lds, pg8::Gemm{(const half_t*)(p.ws + OFF_RLI), (const half_t*)(p.ws + OFF_WLORA), 384, 2}, S, E); }
            if (!(SKIP_MASK & 64)) REPS(64) ph_wy(wb, p, gq.rg, lds);
            GRID_SYNC(); PH_T(4); EMU_DUMP("wy");
            if (!(SKIP_MASK & 128)) REPS(128) ph_scan(wb, p, l, g, lds);
            GRID_SYNC(); PH_T(5); EMU_DUMP("scan");
            if (!(SKIP_MASK & 256)) REPS(256) ph_finish(wb, p, l, nact);
            GRID_SYNC(); PH_T(6); EMU_DUMP("finish");
            if (!(SKIP_MASK & 512)) REPS(512) { pg8::MergeOrder S; S.init(nactp / 256, G, c); EpiMerge E{(half_t*)(p.ws + OFF_H), (const half_t*)(p.ws + OFF_P)};
              pg8::gemm_phase(wb, lds, pg8::Gemm{(const half_t*)(p.ws + OFF_BR), (const half_t*)(p.ws + OFF_WBR), 512, 8}, S, E); }
            GRID_SYNC(); PH_T(7); EMU_DUMP("merge");
            if (!(SKIP_MASK & 1024)) { pg8::StaticOrder S; S.init(nactp / 256, 4, G, c); EpiOut E{p, l, g, gq.rg};
              pg8::gemm_phase(wb, lds, pg8::Gemm{(const half_t*)(p.ws + OFF_H), (const half_t*)(p.ws + OFF_WOUT), 1024, 16}, S, E); }
            GRID_SYNC(); PH_T(8); EMU_DUMP("out");
            if (!(SKIP_MASK & 2048)) REPS(2048) ph_norm2(wb, p, l, g, nact, lds);
            GRID_SYNC(); PH_T(9); EMU_DUMP("norm2");
            if (!(SKIP_MASK & 4096)) REPS(4096) ph_topk(wb, p, (g == 0 && !last) ? BATCH : 0, lds);
            GRID_SYNC(); PH_T(10); EMU_DUMP("topk");
            if (!(SKIP_MASK & 8192)) REPS(8192) { pg8::ExpertOrder S; S.init(tpa, G, c); EpiUp E{(half_t*)(p.ws + OFF_HID)};
              pg8::gemm_phase(wb, lds, pg8::Gemm{(const half_t*)(p.ws + OFF_XE), (const half_t*)(p.ws + OFF_WUP), 1024, 16}, S, E); }
            GRID_SYNC(); PH_T(11);
            if (!(SKIP_MASK & 16384)) REPS(16384) { pg8::ExpertOrder S; S.init(tpa, G, c); EpiDown E{(half_t*)(p.ws + OFF_YE), (const float*)(p.ws + OFF_AFF)};
              pg8::gemm_phase(wb, lds, pg8::Gemm{(const half_t*)(p.ws + OFF_HID), (const half_t*)(p.ws + OFF_WDN), 512, 8}, S, E); }
            GRID_SYNC(); PH_T(12);
            if (!(SKIP_MASK & 32768)) ph_combine(wb, p, l, g, nact);
            if (!(SKIP_MASK & 4)) { if (g + 1 < NGROUP) ph_norm1(wb, p, l, g + 1); else if (!last) ph_norm1(wb, p, l + 1, 0); }
            GRID_SYNC(); PH_T(13); EMU_DUMP("combine");
        }
    }
#ifndef CPU_EMU
#if SANDBOX
    GRID_SYNC(); PH_T(16);
    { pg8::StaticOrder S; S.init(RGP / 256, NP / 256, G, c); SANDBOX_EPI E{(SANDBOX_EPI_ARG)(p.ws + OFF_P)};
      pg8::gemm_phase(wb, lds, pg8::Gemm{(const half_t*)(p.ws + OFF_H), (const half_t*)(p.ws + OFF_WIN), 1024, SANDBOX_A}, S, E); }
    GRID_SYNC(); PH_T(14);
    { pg8::StaticOrder S; S.init(RGP / 256, NP / 256, G, c); SANDBOX_EPI E{(SANDBOX_EPI_ARG)(p.ws + OFF_P)};
      pg8::gemm_phase(wb, lds, pg8::Gemm{(const half_t*)(p.ws + OFF_H), (const half_t*)(p.ws + OFF_WIN), 1024, SANDBOX_B}, S, E); }
    GRID_SYNC(); PH_T(15);
#endif
    if ((TPROBE_A | TPROBE_B) != 0 && blockIdx.x == 0) {
        __syncthreads();
        volatile LAS unsigned long long* tp = (volatile LAS unsigned long long*)(lds + SMEM_BYTES - 64);
        const float msA = (float)tp[1] * 1e-5f, msB = (float)tp[2] * 1e-5f;
        if (TPROBE_A != 0 && threadIdx.x == 0) p.out[0] += 10.f * msA;
        if (TPROBE_B != 0) { const float eps = sqrtf(msB * 1.675e-3f); for (int i = threadIdx.x; i < (1 << 20); i += NT) p.out[1024 + i] += eps; }
    }
#endif
}

#ifndef CPU_EMU
extern "C" void kernel_launch(void* const* d_in, const int* in_sizes, int n_in, void* d_out, int out_size, void* d_ws, size_t ws_size, hipStream_t stream) {
    (void)in_sizes; (void)n_in; (void)out_size;
    static int grid = 0;
    if (!grid) {
        int dev = 0, cus = 0, per_cu = 0;
        hipGetDevice(&dev);
        hipDeviceGetAttribute(&cus, hipDeviceAttributeMultiprocessorCount, dev);
        hipFuncSetAttribute((const void*)mega, hipFuncAttributeMaxDynamicSharedMemorySize, SMEM_BYTES);
        hipOccupancyMaxActiveBlocksPerMultiprocessor(&per_cu, (const void*)mega, NT, SMEM_BYTES);
        if (per_cu < 1) per_cu = 1;
        grid = cus;
        if (ws_size < WS_TOTAL) fprintf(stderr, "workspace too small: %zu < %zu\n", ws_size, (size_t)WS_TOTAL);
    }
    hipMemsetAsync((unsigned char*)d_ws + OFF_BAR, 0, 16384, stream);
    Params p{};
    for (int i = 0; i < 34; ++i) p.in[i] = (const float*)d_in[i];
    p.out = (float*)d_out; p.ws = (unsigned char*)d_ws;
    hipLaunchKernelGGL(mega, dim3(grid), dim3(NT), SMEM_BYTES, stream, p);
}
#endif
```
